# Optimizing an MI355X kernel written in HIP

```python
import math
import jax, jax.numpy as jnp
from jax import lax
import numpy as np

D_MODEL = 1024
BATCH = 8
SEQ = 4096
DEPTH = 4

GRID_W = 64
CTX_LEN = 256
NORM_EPS = 1e-6
ROPE_THETA = 10000.0
Q_BLOCK = 128

HEAD_DIM = 64
GQA_HEADS = 4
GQA_KV_HEADS = 2
GMLP_GROUPS = 4
GMLP_CH = 64
GMLP_CHUNK = 128
DIFF_HEADS = 4
DIFF_DIM = 32
DN_HEADS = 4
DN_DK = 64
DN_DV = 64
DN_CONV = 3
DN_CHUNK = 64
N_EXPERTS = 32
TOP_K = 4
D_EXPERT = D_MODEL
SWIGLU_LIMIT = 7.0
SWIGLU_ALPHA = 1.702
MOE_BLOCK = 128

GQA_W = GQA_HEADS * HEAD_DIM
GMLP_W = GMLP_GROUPS * GMLP_CH
DIFF_W = DIFF_HEADS * 2 * DIFF_DIM
DN_W = DN_HEADS * DN_DV
DN_QKV = DN_HEADS * (2 * DN_DK + DN_DV)
MIX_WIDTH = GQA_W + GMLP_W + DIFF_W + DN_W
IN_SIZES = (GQA_W, GQA_KV_HEADS * HEAD_DIM, GQA_KV_HEADS * HEAD_DIM,
            GMLP_W, GMLP_W,
            DIFF_W, DIFF_W, DIFF_W,
            DN_QKV, DN_W, 2 * DN_HEADS, 2 * DN_HEADS)
D_IN = sum(IN_SIZES)
IN_OFFSETS = tuple(int(o) for o in np.cumsum(IN_SIZES)[:-1])

kernel_name = 'hybrid_head_group_diffusion_trunk'


def rms_norm(x, g):
    xf = x.astype(jnp.float32)
    y = xf * lax.rsqrt(jnp.mean(xf * xf, axis=-1, keepdims=True) + NORM_EPS)
    return (y * g.astype(jnp.float32)).astype(x.dtype)


def l2_norm(x):
    xf = x.astype(jnp.float32)
    return (xf * lax.rsqrt(jnp.sum(xf * xf, axis=-1, keepdims=True) + NORM_EPS)).astype(x.dtype)


def modulate(h, shift, scale):
    return h * (1.0 + scale) + shift


def heads(t, n):
    return t.reshape(*t.shape[:-1], n, t.shape[-1] // n)


def flip_t(t):
    return jnp.flip(t, axis=1)


def axial_rope(row_pos, col_pos, dim):
    n = dim // 4
    inv = jnp.power(ROPE_THETA, -jnp.arange(n, dtype=jnp.float32) / n)
    ang = jnp.concatenate([row_pos[:, None] * inv, col_pos[:, None] * inv], axis=-1)
    return jnp.cos(ang), jnp.sin(ang)


def apply_rope(x, rope):
    cos, sin = rope
    half = x.shape[-1] // 2
    x1, x2 = x[..., :half], x[..., half:]
    cs, sn = cos[:, None, :], sin[:, None, :]
    return jnp.concatenate([x1 * cs - x2 * sn, x1 * sn + x2 * cs], axis=-1).astype(x.dtype)


def sweep_query_blocks(fn, *qs):
    b, l = qs[0].shape[:2]
    nb = l // Q_BLOCK
    blocks = tuple(q.reshape(b, nb, Q_BLOCK, *q.shape[2:]).swapaxes(0, 1) for q in qs)
    out = lax.map(lambda args: fn(*args), blocks)
    return out.swapaxes(0, 1).reshape(b, l, *out.shape[3:])


def gqa_attend(q, k, v):
    scale = HEAD_DIM ** -0.5
    def one_block(qb):
        s = jnp.einsum('bqhgd,bkhd->bhgqk', qb, k).astype(jnp.float32) * scale
        p = jax.nn.softmax(s, axis=-1).astype(v.dtype)
        return jnp.einsum('bhgqk,bkhd->bqhgd', p, v)
    return sweep_query_blocks(one_block, q)


def diff_attend(q1, q2, k1, k2, v, lam):
    scale = DIFF_DIM ** -0.5
    def one_block(q1b, q2b):
        p1 = jax.nn.softmax(jnp.einsum('bqhd,bkhd->bhqk', q1b, k1).astype(jnp.float32) * scale, axis=-1)
        p2 = jax.nn.softmax(jnp.einsum('bqhd,bkhd->bhqk', q2b, k2).astype(jnp.float32) * scale, axis=-1)
        return jnp.einsum('bhqk,bkhd->bqhd', (p1 - lam * p2).astype(v.dtype), v)
    return sweep_query_blocks(one_block, q1, q2)


def gmlp_spatial(u, v, w_s, b_s, g_v):
    b, l, _ = v.shape
    vn = rms_norm(v, g_v).reshape(b, l // GMLP_CHUNK, GMLP_CHUNK, GMLP_GROUPS, GMLP_CH)
    sp = jnp.einsum('gij,bnjgc->bnigc', w_s, vn) + b_s.T[None, None, :, :, None]
    return u * sp.reshape(b, l, GMLP_W)


def short_conv(x, w):
    ch = x.shape[-1]
    y = lax.conv_general_dilated(x, w[:, None, :].astype(x.dtype), window_strides=(1,),
                                 padding=[(DN_CONV // 2, DN_CONV // 2)],
                                 dimension_numbers=('NWC', 'WIO', 'NWC'), feature_group_count=ch)
    return jax.nn.silu(y)


def gated_delta_chunked(q, k, v, beta, g, s0):
    b, l, h, dk = q.shape
    dv = v.shape[-1]
    n = l // DN_CHUNK

    def chunked(t):
        t = t.astype(jnp.float32).reshape(b, n, DN_CHUNK, h, *t.shape[3:])
        return jnp.moveaxis(t, 3, 1)

    qc, kc, vc, bc, gc = (chunked(t) for t in (q, k, v, beta, g))
    cum_g = jnp.cumsum(gc, axis=-1)
    idx = jnp.arange(DN_CHUNK)
    incl = idx[:, None] >= idx[None, :]
    strict = idx[:, None] > idx[None, :]
    decay = jnp.exp(jnp.where(incl, cum_g[..., :, None] - cum_g[..., None, :], -jnp.inf))
    a_mat = jnp.where(strict, jnp.einsum('bhnid,bhnjd->bhnij', kc, kc) * decay * bc[..., :, None], 0.0)
    t_mat = a_mat + jnp.eye(DN_CHUNK, dtype=jnp.float32)
    rhs = jnp.concatenate([bc[..., None] * vc, (bc * jnp.exp(cum_g))[..., None] * kc], axis=-1)
    sol = lax.linalg.triangular_solve(t_mat, rhs, left_side=True, lower=True, unit_diagonal=True)
    u_mat, w_mat = sol[..., :dv], sol[..., dv:]
    qk = jnp.einsum('bhnid,bhnjd->bhnij', qc, kc) * decay
    xs = tuple(jnp.moveaxis(t, 2, 0) for t in (qc, kc, u_mat, w_mat, cum_g, qk))

    def step(s, inp):
        q_, k_, u_, w_, g_, qk_ = inp
        new_v = u_ - jnp.einsum('bhck,bhvk->bhcv', w_, s)
        o = jnp.exp(g_)[..., None] * jnp.einsum('bhck,bhvk->bhcv', q_, s) + jnp.einsum('bhij,bhjv->bhiv', qk_, new_v)
        g_end = g_[..., -1:]
        s = jnp.exp(g_end)[..., None] * s + jnp.einsum('bhcv,bhck->bhvk', new_v * jnp.exp(g_end - g_)[..., None], k_)
        return s, o

    s_fin, o = lax.scan(step, s0.astype(jnp.float32), xs)
    o = o.transpose(1, 0, 3, 2, 4).reshape(b, l, h, dv)
    return o.astype(v.dtype), s_fin


def gdn_inputs(qkv_raw, b_raw, a_raw, conv_w, a_log, dt_bias):
    b, l, _ = qkv_raw.shape
    qkv = short_conv(qkv_raw, conv_w)
    q, k, v = jnp.split(qkv, [DN_HEADS * DN_DK, 2 * DN_HEADS * DN_DK], axis=-1)
    q = l2_norm(heads(q, DN_HEADS)) * (DN_DK ** -0.5)
    k = l2_norm(heads(k, DN_HEADS))
    v = heads(v, DN_HEADS)
    beta = jax.nn.sigmoid(b_raw.astype(jnp.float32)).reshape(b, l, 2, DN_HEADS)
    g = -jnp.exp(a_log) * jax.nn.softplus(a_raw.astype(jnp.float32).reshape(b, l, 2, DN_HEADS) + dt_bias)
    return q, k, v, beta, g


def gdn_bidirectional(ctx_in, lat_in, need_ctx):
    qc, kc, vc, bc, gc = ctx_in
    ql, kl, vl, bl, gl = lat_in
    s0 = jnp.zeros((qc.shape[0], DN_HEADS, DN_DV, DN_DK), jnp.float32)
    o_cf, s_f = gated_delta_chunked(qc, kc, vc, bc[:, :, 0], gc[:, :, 0], s0)
    o_cb, s_b = gated_delta_chunked(flip_t(qc), flip_t(kc), flip_t(vc), flip_t(bc[:, :, 1]), flip_t(gc[:, :, 1]), s0)
    o_lf, _ = gated_delta_chunked(ql, kl, vl, bl[:, :, 0], gl[:, :, 0], s_f)
    o_lb, _ = gated_delta_chunked(flip_t(ql), flip_t(kl), flip_t(vl), flip_t(bl[:, :, 1]), flip_t(gl[:, :, 1]), s_b)
    o_l = o_lf + flip_t(o_lb)
    o_c = (o_cf + flip_t(o_cb)) if need_ctx else None
    return o_c, o_l


def clamped_swiglu(hgu):
    gate, up = jnp.split(hgu, 2, axis=-1)
    gate = jnp.minimum(gate, SWIGLU_LIMIT)
    up = jnp.clip(up, -SWIGLU_LIMIT, SWIGLU_LIMIT)
    return gate * jax.nn.sigmoid(SWIGLU_ALPHA * gate) * (up + 1.0)


def moe_ffn(h, w_r, b_r, w_up, b_up, w_down, b_down):
    t, d = h.shape
    logits = (h @ w_r + b_r).astype(jnp.float32)
    top_val, top_idx = lax.top_k(logits, TOP_K)
    gates = jax.nn.softmax(top_val, axis=-1)
    m = t * TOP_K
    e_flat = top_idx.reshape(m)
    tok_flat = jnp.arange(m, dtype=jnp.int32) // TOP_K
    order = jnp.argsort(e_flat)
    e_sorted = e_flat[order]
    counts = jnp.bincount(e_flat, length=N_EXPERTS)
    starts = jnp.cumsum(counts) - counts
    padded = (counts + MOE_BLOCK - 1) // MOE_BLOCK * MOE_BLOCK
    ends_p = jnp.cumsum(padded)
    starts_p = ends_p - padded
    dest = starts_p[e_sorted] + jnp.arange(m, dtype=jnp.int32) - starts[e_sorted]
    n_blocks = (m + N_EXPERTS * (MOE_BLOCK - 1) + MOE_BLOCK - 1) // MOE_BLOCK
    p = n_blocks * MOE_BLOCK
    slot_tok = jnp.full((p,), t, jnp.int32).at[dest].set(tok_flat[order])
    slot_gate = jnp.zeros((p,), jnp.float32).at[dest].set(gates.reshape(m)[order])
    block_expert = jnp.minimum(jnp.searchsorted(ends_p, jnp.arange(n_blocks) * MOE_BLOCK, side='right'), N_EXPERTS - 1)
    h_pad = jnp.concatenate([h, jnp.zeros((1, d), h.dtype)], axis=0)

    def expert_block(args):
        tok, e = args
        xb = h_pad[tok]
        hid = clamped_swiglu(xb @ w_up[e] + b_up[e])
        return hid @ w_down[e] + b_down[e]

    ys = lax.map(expert_block, (slot_tok.reshape(n_blocks, MOE_BLOCK), block_expert))
    ys = ys.reshape(p, d) * slot_gate[:, None].astype(h.dtype)
    return jnp.zeros((t + 1, d), h.dtype).at[slot_tok].add(ys)[:t]


def hybrid_mixer(h_c, h_l, need_ctx, rope_a, rope_d, lam_init, w_in, w_out, q_norm, k_norm,
                 v_norm, w_s, b_s, lq1, lk1, lq2, lk2, subln, conv_w, a_log, dt_bias, out_norm):
    b, l, _ = h_l.shape
    lc = h_c.shape[1]
    grp = GQA_HEADS // GQA_KV_HEADS
    (aq_l, ak_l, av_l, bu_l, bv_l, cq_l, ck_l, cv_l, dqkv_l, dz_l, db_l, da_l) = jnp.split(h_l @ w_in, IN_OFFSETS, axis=-1)
    (aq_c, ak_c, av_c, bu_c, bv_c, cq_c, ck_c, cv_c, dqkv_c, dz_c, db_c, da_c) = jnp.split(h_c @ w_in, IN_OFFSETS, axis=-1)

    qa_l = apply_rope(rms_norm(heads(aq_l, GQA_HEADS), q_norm), rope_a)
    ka_l = apply_rope(rms_norm(heads(ak_l, GQA_KV_HEADS), k_norm), rope_a)
    ka_c = rms_norm(heads(ak_c, GQA_KV_HEADS), k_norm)
    va_l, va_c = heads(av_l, GQA_KV_HEADS), heads(av_c, GQA_KV_HEADS)
    out_a_l = gqa_attend(qa_l.reshape(b, l, GQA_KV_HEADS, grp, HEAD_DIM),
                         jnp.concatenate([ka_l, ka_c], axis=1), jnp.concatenate([va_l, va_c], axis=1)).reshape(b, l, GQA_W)

    out_b_l = gmlp_spatial(jax.nn.gelu(bu_l), jax.nn.gelu(bv_l), w_s, b_s, v_norm)

    lam = (jnp.exp(jnp.sum(lq1 * lk1).astype(jnp.float32)) - jnp.exp(jnp.sum(lq2 * lk2).astype(jnp.float32)) + lam_init)
    qd_l, kd_l, kd_c = heads(cq_l, DIFF_HEADS), heads(ck_l, DIFF_HEADS), heads(ck_c, DIFF_HEADS)
    q1_l, q2_l = apply_rope(qd_l[..., :DIFF_DIM], rope_d), apply_rope(qd_l[..., DIFF_DIM:], rope_d)
    k1_all = jnp.concatenate([apply_rope(kd_l[..., :DIFF_DIM], rope_d), kd_c[..., :DIFF_DIM]], axis=1)
    k2_all = jnp.concatenate([apply_rope(kd_l[..., DIFF_DIM:], rope_d), kd_c[..., DIFF_DIM:]], axis=1)
    vd_c = heads(cv_c, DIFF_HEADS)
    vd_all = jnp.concatenate([heads(cv_l, DIFF_HEADS), vd_c], axis=1)
    od_l = diff_attend(q1_l, q2_l, k1_all, k2_all, vd_all, lam)
    out_c_l = (rms_norm(od_l, subln) * (1.0 - lam_init)).reshape(b, l, DIFF_W)

    ctx_in = gdn_inputs(dqkv_c, db_c, da_c, conv_w, a_log, dt_bias)
    lat_in = gdn_inputs(dqkv_l, db_l, da_l, conv_w, a_log, dt_bias)
    o_c, o_l = gdn_bidirectional(ctx_in, lat_in, need_ctx)
    out_d_l = (rms_norm(o_l, out_norm) * jax.nn.silu(heads(dz_l, DN_HEADS))).reshape(b, l, DN_W)

    y_l = jnp.concatenate([out_a_l, out_b_l, out_c_l, out_d_l], axis=-1) @ w_out
    if not need_ctx:
        return None, y_l

    qa_c = rms_norm(heads(aq_c, GQA_HEADS), q_norm).reshape(b, lc, GQA_KV_HEADS, grp, HEAD_DIM)
    out_a_c = gqa_attend(qa_c, ka_c, va_c).reshape(b, lc, GQA_W)
    out_b_c = gmlp_spatial(jax.nn.gelu(bu_c), jax.nn.gelu(bv_c), w_s, b_s, v_norm)
    qd_c = heads(cq_c, DIFF_HEADS)
    od_c = diff_attend(qd_c[..., :DIFF_DIM], qd_c[..., DIFF_DIM:], kd_c[..., :DIFF_DIM], kd_c[..., DIFF_DIM:], vd_c, lam)
    out_c_c = (rms_norm(od_c, subln) * (1.0 - lam_init)).reshape(b, lc, DIFF_W)
    out_d_c = (rms_norm(o_c, out_norm) * jax.nn.silu(heads(dz_c, DN_HEADS))).reshape(b, lc, DN_W)
    y_c = jnp.concatenate([out_a_c, out_b_c, out_c_c, out_d_c], axis=-1) @ w_out
    return y_c, y_l


def setup_inputs(seed: int = 0) -> dict:
    key = jax.random.key(seed)
    ks = jax.random.split(key, 32)
    f32 = jnp.float32

    def nrm(k, shape, scale=1.0):
        return jax.random.normal(k, shape, f32) * scale

    def gain(k, shape):
        return 1.0 + 0.02 * jax.random.normal(k, shape, f32)

    dt = jnp.exp(jax.random.uniform(ks[23], (DEPTH, 2, DN_HEADS), f32, math.log(1e-3), math.log(1e-1)))
    return {
        'x': nrm(ks[0], (BATCH, SEQ, D_MODEL)),
        'c': nrm(ks[1], (BATCH, D_MODEL)),
        'ctx': nrm(ks[2], (BATCH, CTX_LEN, D_MODEL)),
        'c_ctx': nrm(ks[3], (D_MODEL,), 0.5),
        'w_ada': nrm(ks[4], (DEPTH, D_MODEL, 6 * D_MODEL), 0.5 * D_MODEL ** -0.5),
        'b_ada': nrm(ks[5], (DEPTH, 6 * D_MODEL), 0.01),
        'norm_mix': gain(ks[6], (DEPTH, D_MODEL)),
        'norm_ffn': gain(ks[7], (DEPTH, D_MODEL)),
        'w_in': nrm(ks[8], (DEPTH, D_MODEL, D_IN), D_MODEL ** -0.5),
        'w_out': nrm(ks[9], (DEPTH, MIX_WIDTH, D_MODEL), MIX_WIDTH ** -0.5),
        'gqa_q_norm': gain(ks[10], (DEPTH, HEAD_DIM)),
        'gqa_k_norm': gain(ks[11], (DEPTH, HEAD_DIM)),
        'gmlp_v_norm': gain(ks[12], (DEPTH, GMLP_W)),
        'gmlp_w_s': nrm(ks[13], (DEPTH, GMLP_GROUPS, GMLP_CHUNK, GMLP_CHUNK), GMLP_CHUNK ** -0.5),
        'gmlp_b_s': gain(ks[14], (DEPTH, GMLP_GROUPS, GMLP_CHUNK)),
        'diff_lambda_q1': nrm(ks[15], (DEPTH, DIFF_DIM), 0.1),
        'diff_lambda_k1': nrm(ks[16], (DEPTH, DIFF_DIM), 0.1),
        'diff_lambda_q2': nrm(ks[17], (DEPTH, DIFF_DIM), 0.1),
        'diff_lambda_k2': nrm(ks[18], (DEPTH, DIFF_DIM), 0.1),
        'diff_subln': gain(ks[19], (DEPTH, 2 * DIFF_DIM)),
        'dn_conv_w': nrm(ks[20], (DEPTH, DN_CONV, DN_QKV), DN_CONV ** -0.5),
        'dn_a_log': jnp.log(jax.random.uniform(ks[21], (DEPTH, 2, DN_HEADS), f32, 1.0, 16.0)),
        'dn_dt_bias': dt + jnp.log(-jnp.expm1(-dt)),
        'dn_out_norm': gain(ks[22], (DEPTH, DN_DV)),
        'router_w': nrm(ks[24], (DEPTH, D_MODEL, N_EXPERTS), D_MODEL ** -0.5),
        'router_b': nrm(ks[25], (DEPTH, N_EXPERTS), 0.01),
        'exp_w_up': nrm(ks[26], (DEPTH, N_EXPERTS, D_MODEL, 2 * D_EXPERT), D_MODEL ** -0.5),
        'exp_b_up': nrm(ks[27], (DEPTH, N_EXPERTS, 2 * D_EXPERT), 0.01),
        'exp_w_down': nrm(ks[28], (DEPTH, N_EXPERTS, D_EXPERT, D_MODEL), D_EXPERT ** -0.5),
        'exp_b_down': nrm(ks[29], (DEPTH, N_EXPERTS, D_MODEL), 0.01),
        'final_norm': gain(ks[30], (D_MODEL,)),
    }


def reference(x, c, ctx, c_ctx, w_ada, b_ada, norm_mix, norm_ffn, w_in, w_out, gqa_q_norm, gqa_k_norm,
              gmlp_v_norm, gmlp_w_s, gmlp_b_s, diff_lambda_q1, diff_lambda_k1, diff_lambda_q2, diff_lambda_k2,
              diff_subln, dn_conv_w, dn_a_log, dn_dt_bias, dn_out_norm, router_w, router_b,
              exp_w_up, exp_b_up, exp_w_down, exp_b_down, final_norm):
    b, l, d = x.shape
    lc = ctx.shape[1]
    rows = l // GRID_W
    r_idx, c_idx = jnp.meshgrid(jnp.arange(rows), jnp.arange(GRID_W), indexing='ij')
    row_pos = r_idx.reshape(-1).astype(jnp.float32)
    col_pos = c_idx.reshape(-1).astype(jnp.float32)
    rope_a = axial_rope(row_pos, col_pos, HEAD_DIM)
    rope_d = axial_rope(row_pos, col_pos, DIFF_DIM)
    silu_c = jax.nn.silu(c)
    silu_c_ctx = jax.nn.silu(c_ctx)

    for layer in range(DEPTH):
        need_ctx = layer < DEPTH - 1
        lam_init = 0.8 - 0.6 * math.exp(-0.3 * layer)
        mod = jnp.split(silu_c @ w_ada[layer] + b_ada[layer], 6, axis=-1)
        sh1, sc1, g1, sh2, sc2, g2 = (m[:, None, :] for m in mod)
        csh1, csc1, cg1, csh2, csc2, cg2 = jnp.split(silu_c_ctx @ w_ada[layer] + b_ada[layer], 6)

        h_l = modulate(rms_norm(x, norm_mix[layer]), sh1, sc1)
        h_c = modulate(rms_norm(ctx, norm_mix[layer]), csh1, csc1)
        y_c, y_l = hybrid_mixer(h_c, h_l, need_ctx, rope_a, rope_d, lam_init, w_in[layer], w_out[layer],
                                gqa_q_norm[layer], gqa_k_norm[layer], gmlp_v_norm[layer], gmlp_w_s[layer],
                                gmlp_b_s[layer], diff_lambda_q1[layer], diff_lambda_k1[layer],
                                diff_lambda_q2[layer], diff_lambda_k2[layer], diff_subln[layer],
                                dn_conv_w[layer], dn_a_log[layer], dn_dt_bias[layer], dn_out_norm[layer])
        x = x + g1 * y_l
        f_l = modulate(rms_norm(x, norm_ffn[layer]), sh2, sc2)
        if need_ctx:
            ctx = ctx + cg1 * y_c
            f_c = modulate(rms_norm(ctx, norm_ffn[layer]), csh2, csc2)
            tokens = jnp.concatenate([f_l.reshape(b * l, d), f_c.reshape(b * lc, d)], axis=0)
        else:
            tokens = f_l.reshape(b * l, d)
        ffn = moe_ffn(tokens, router_w[layer], router_b[layer], exp_w_up[layer], exp_b_up[layer],
                      exp_w_down[layer], exp_b_down[layer])
        x = x + g2 * ffn[:b * l].reshape(b, l, d)
        if need_ctx:
            ctx = ctx + cg2 * ffn[b * l:].reshape(b, lc, d)

    return rms_norm(x, final_norm)
```

```cpp
#ifndef EMU
#include <hip/hip_runtime.h>
#include <cstdio>
#include <cstdint>
#endif

#ifndef MK_N_LAUNCHES
#define MK_N_LAUNCHES 1
#endif

#ifndef CFG_BATCH
#define CFG_BATCH 8
#define CFG_SEQ 4096
#define CFG_CTX 256
#define CFG_DEPTH 4
#endif
constexpr int NB = CFG_BATCH, SEQ = CFG_SEQ, LC = CFG_CTX, DEPTH = CFG_DEPTH, D = 1024;
constexpr int GRID_W = 64;
constexpr int T_L = NB * SEQ, T_C = NB * LC, T_ALL = T_L + T_C;
constexpr int D_IN = 2832, N_PROJ = 2816;
constexpr int NKEY = SEQ + LC;
constexpr int NE = 32, TOPK = 4, DE = 1024;
constexpr int NCH_L = SEQ / 64, NCH_C = LC / 64, NCH = NCH_L + NCH_C;
constexpr int MAX_TILES = (T_ALL * TOPK) / 256 + NE;
constexpr int P_ROWS = MAX_TILES * 256;
constexpr float NORM_EPS = 1e-6f;
static_assert(SEQ % 256 == 0 && LC % 128 == 0 && T_ALL % 256 == 0 && (T_ALL * TOPK) % 256 == 0, "tiling");
constexpr int C_AQ = 0, C_AK = 256, C_AV = 384, C_BU = 512, C_BV = 768, C_CQ = 1024, C_CK = 1280, C_CV = 1536, C_DQKV = 1792, C_DZ = 2560, C_DB = 2816, C_DA = 2824;

#ifndef EMU
#define GAS __attribute__((address_space(1)))
#define LAS __attribute__((address_space(3)))
#define DEVI __device__ __forceinline__
#define LDS_WAIT() asm volatile("s_waitcnt lgkmcnt(0)" ::: "memory")
#define VM_WAIT() asm volatile("s_waitcnt vmcnt(0)" ::: "memory")
#define LAUNDER_V(x) asm volatile("" : "+v"(x))
#define LAUNDER_S(x) asm volatile("" : "+s"(x))
#endif
typedef unsigned short bf16;
typedef unsigned v4u __attribute__((ext_vector_type(4)));
typedef unsigned v2u __attribute__((ext_vector_type(2)));
typedef float f32x4 __attribute__((ext_vector_type(4)));
typedef float f32x2 __attribute__((ext_vector_type(2)));
typedef short bf16x8 __attribute__((ext_vector_type(8)));
typedef GAS unsigned gu32;
#define RLX_AGENT __ATOMIC_RELAXED, __HIP_MEMORY_SCOPE_AGENT
typedef __bf16 hbf2_t __attribute__((ext_vector_type(2)));
DEVI unsigned pk2(float lo, float hi) { const f32x2 v = {lo, hi}; return __builtin_bit_cast(unsigned, __builtin_convertvector(v, hbf2_t)); }
DEVI unsigned f2bf(float f) { return pk2(f, 0.f) & 0xffffu; }
DEVI float bf2f(unsigned h) { return __builtin_bit_cast(float, (h & 0xffffu) << 16); }
DEVI float bflo(unsigned w) { return __builtin_bit_cast(float, w << 16); }
DEVI float bfhi(unsigned w) { return __builtin_bit_cast(float, w & 0xffff0000u); }
DEVI float fast_exp(float x) { return __builtin_amdgcn_exp2f(x * 1.4426950408889634f); }
DEVI float fast_rcp(float x) { return __builtin_amdgcn_rcpf(x); }
DEVI float sigmoidf_(float x) { return fast_rcp(1.f + fast_exp(-x)); }
DEVI float siluf_(float x) { return x * sigmoidf_(x); }
DEVI float tanh_fast(float x) { const float e = fast_exp(-2.f * __builtin_fabsf(x)); const float t = (1.f - e) * fast_rcp(1.f + e); return x < 0.f ? -t : t; }
DEVI float gelu_tanh(float x) { return 0.5f * x * (1.f + tanh_fast(0.7978845608028654f * (x + 0.044715f * x * x * x))); }
DEVI float softplusf_(float x) { return x > 20.f ? x : __builtin_amdgcn_logf(1.f + fast_exp(x)) * 0.6931471805599453f; }
DEVI float wave_sum(float v) {
#pragma unroll
    for (int o = 1; o < 64; o <<= 1) v += __shfl_xor(v, o);
    return v;
}
template <int W> DEVI float group_sum(float v) {
#pragma unroll
    for (int o = 1; o < W; o <<= 1) v += __shfl_xor(v, o);
    return v;
}

constexpr size_t al256(size_t x) { return (x + 255) & ~(size_t)255; }
constexpr size_t WS_CTL = 0, CTL_ZERO_BYTES = 1u << 20;
constexpr size_t WS_MOD   = CTL_ZERO_BYTES;
constexpr size_t WS_WIN   = WS_MOD   + al256((size_t)DEPTH * 9 * 6 * D * 4);
constexpr size_t WS_WOUT  = WS_WIN   + al256((size_t)DEPTH * N_PROJ * D * 2);
constexpr size_t WS_WUP   = WS_WOUT  + al256((size_t)DEPTH * D * D * 2);
constexpr size_t WS_WDN   = WS_WUP   + al256((size_t)DEPTH * NE * 2 * DE * D * 2);
constexpr size_t WS_H     = WS_WDN   + al256((size_t)DEPTH * NE * D * DE * 2);
constexpr size_t WS_F     = WS_H     + al256((size_t)T_ALL * D * 2);
constexpr size_t WS_BA    = WS_F     + al256((size_t)T_ALL * D * 2);
constexpr size_t WS_PROJ  = WS_BA    + al256((size_t)T_ALL * 16 * 4);
constexpr size_t WS_XRES  = WS_PROJ  + al256((size_t)T_ALL * N_PROJ * 2);
constexpr size_t WS_MIX   = WS_XRES  + al256((size_t)T_ALL * D * 4);
constexpr size_t WS_QL    = WS_MIX   + al256((size_t)T_ALL * D * 2);
constexpr size_t WS_QC    = WS_QL    + al256((size_t)NB * 12 * SEQ * 64 * 2);
constexpr size_t WS_K     = WS_QC    + al256((size_t)NB * 12 * LC * 64 * 2);
constexpr size_t WS_V     = WS_K     + al256((size_t)NB * 6 * NKEY * 64 * 2);
constexpr size_t WS_OD    = WS_V     + al256((size_t)NB * 6 * NKEY * 64 * 2);
constexpr size_t WS_DNO   = WS_OD    + al256((size_t)2 * T_ALL * 256 * 2);
constexpr size_t WS_DNF   = WS_DNO   + al256((size_t)2 * T_ALL * 256 * 4);
constexpr size_t DN_UNIT_BYTES = 32768;
constexpr size_t WS_HID   = WS_DNF   + al256((size_t)NB * 2 * 4 * NCH * DN_UNIT_BYTES);
constexpr size_t WS_YS    = WS_HID   + al256((size_t)P_ROWS * DE * 2);
constexpr size_t WS_TOKE  = WS_YS    + al256((size_t)P_ROWS * D * 2);
constexpr size_t WS_TOKG  = WS_TOKE  + al256((size_t)T_ALL * 4 * 4);
constexpr size_t WS_TOKP  = WS_TOKG  + al256((size_t)T_ALL * 4 * 4);
constexpr size_t WS_SLOT  = WS_TOKP  + al256((size_t)T_ALL * 4 * 4);
constexpr size_t WS_BCNT  = WS_SLOT  + al256((size_t)T_ALL * 4 * 4);
constexpr size_t WS_TEXP  = WS_BCNT  + al256((size_t)1024 * 32 * 4);
constexpr size_t WS_RWP   = WS_TEXP  + al256((size_t)(MAX_TILES + 64) * 4);
constexpr size_t WS_RBP   = WS_RWP   + al256((size_t)DEPTH * 9 * NE * D * 4);
constexpr size_t WS_ROWMAP = WS_RBP  + al256((size_t)DEPTH * 9 * NE * 4);
constexpr size_t WS_ROPE  = WS_ROWMAP + al256((size_t)P_ROWS * 4);
constexpr size_t WS_END   = WS_ROPE  + al256((size_t)SEQ * 96 * 4);
constexpr int CW_TMO = 0, CW_CODE = 1, CW_BAR = 4096;
namespace pg8 {
#define PG8_LAS __attribute__((address_space(3)))
typedef unsigned short bf16_t;
typedef short bf16x8 __attribute__((ext_vector_type(8)));
typedef float f32x4 __attribute__((ext_vector_type(4)));
typedef unsigned u32x4 __attribute__((ext_vector_type(4)));
constexpr int BM = 256, BK = 64, HALF = 128, HTB = HALF * BK * 2  , STAGE_BYTES = 8 * HTB, NXCD = 8, WGM = 8;

__host__ __device__ __forceinline__ int lds_byte(int r, int c) { const int st = (r >> 4) * 2 + (c >> 5), rr = r & 15, cc = c & 31, ob = rr * 64 + cc * 2; return st * 1024 + (ob ^ (((ob >> 9) & 1) << 5)); }
__host__ __device__ __forceinline__ void stage_rc(int b, int& R, int& C) { const int st = b / 1024, sb = b % 1024, swz = sb ^ (((sb >> 9) & 1) << 5); R = (st >> 1) * 16 + swz / 64; C = (st & 1) * 32 + (swz % 64) / 2; }
__host__ __device__ __forceinline__ int perm32(int rho) { const int n = rho >> 4, i = rho & 15; return 8 * (i >> 2) + 4 * n + (i & 3); }

struct Unit { int pm, pn; };
struct Gemm { const bf16_t* A; const bf16_t* Bt; int M, N, K; const int* rowmap = nullptr; };

struct StaticOrder {
    int nM, nN, nwg, G, c;
    __host__ __device__ void init(int M, int N, int G_, int c_) { nM = M / BM; nN = N / BM; nwg = nM * nN; G = G_; c = c_; }
    __host__ __device__ bool next(int i, Unit& u) const {
        const long L = (long)i * G + c; if (L >= nwg) return false;
        int wgid = (int)L; { const int q = nwg / NXCD, r = nwg % NXCD, xcd = wgid % NXCD, off = wgid / NXCD; wgid = (xcd < r ? xcd * (q + 1) : r * (q + 1) + (xcd - r) * q) + off; }
        const int nig = WGM * nN, gid = wgid / nig, fm = gid * WGM, gsz = (nM - fm) < WGM ? (nM - fm) : WGM;
        u.pm = fm + ((wgid % nig) % gsz); u.pn = (wgid % nig) / gsz; return true;
    }
    __device__ __forceinline__ void a_ready(const Unit&) const {}
    __device__ __forceinline__ void done(const Unit&) const {}
};

#ifndef EMU
__device__ __forceinline__ unsigned cvt_pk_bf16(float lo, float hi) { unsigned r; asm volatile("v_cvt_pk_bf16_f32 %0, %1, %2" : "=v"(r) : "v"(lo), "v"(hi)); return r; }
#else
__device__ __forceinline__ unsigned cvt_pk_bf16(float lo, float hi) { return pk2(lo, hi); }
#endif
typedef float f32x2 __attribute__((ext_vector_type(2)));
__device__ __forceinline__ f32x2 gelu_pk(f32x2 v) {
    const f32x2 av = __builtin_elementwise_abs(v), d = av * 0.2316418882f + 1.0f;
    f32x2 t; t.x = __builtin_amdgcn_rcpf(d.x); t.y = __builtin_amdgcn_rcpf(d.y);
    f32x2 q = t * 0.5307027145f + (-0.7265760135f); q = q * t + 0.7107068705f; q = q * t + (-0.142248368f); q = q * t + 0.127414796f; q = q * t;
    const f32x2 s = (v * v) * (-0.72134752044f);
    f32x2 e; e.x = __builtin_amdgcn_exp2f(s.x); e.y = __builtin_amdgcn_exp2f(s.y);
    const f32x2 m = v * (q * e), r = v - m;
    f32x2 o; o.x = v.x < 0.f ? m.x : r.x; o.y = v.y < 0.f ? m.y : r.y; return o;
}

template <int ACT  > struct EpiBf16 {
    static constexpr bool PERM = true, AFTER_DRAIN = false; static_assert(ACT == 0 || ACT == 1, "EpiBf16: ACT is 0 (none) or 1 (gelu_pk)");
    bf16_t* O; int ldc; const float* bias; int split_cols; size_t split_stride; float scale0;
    __device__ __forceinline__ void operator()(const f32x4 (&acc)[2][2][4][2], const Unit& u, int wr, int wc, int fr, int fq) const {
        const int row0 = u.pm * BM + wr * 64 + fr; int colt = u.pn * BM; bf16_t* base = O;
        float sc = 1.f; if (split_cols) { const int t = colt / split_cols; base += (size_t)t * split_stride; colt -= t * split_cols; if (t == 0) sc = scale0; }
        const int col0 = colt + wc * 32 + 8 * fq, bcol0 = u.pn * BM + wc * 32 + 8 * fq;
        f32x4 bv[2][2];
#pragma unroll
        for (int bj = 0; bj < 2; ++bj)
#pragma unroll
            for (int n = 0; n < 2; ++n) bv[bj][n] = bias ? *(const f32x4*)(bias + bcol0 + bj * HALF + 4 * n) : (f32x4){0.f, 0.f, 0.f, 0.f};
#pragma unroll
        for (int ai = 0; ai < 2; ++ai)
#pragma unroll
            for (int m = 0; m < 4; ++m) { bf16_t* rowp = base + (size_t)(row0 + ai * HALF + m * 16) * ldc + col0;
#pragma unroll
                for (int bj = 0; bj < 2; ++bj) { f32x4 v0 = acc[ai][bj][m][0] + bv[bj][0], v1 = acc[ai][bj][m][1] + bv[bj][1];
                    if (ACT == 1) { f32x2 a = gelu_pk((f32x2){v0[0], v0[1]}), b = gelu_pk((f32x2){v0[2], v0[3]}), c = gelu_pk((f32x2){v1[0], v1[1]}), d = gelu_pk((f32x2){v1[2], v1[3]});
                        v0 = (f32x4){a.x, a.y, b.x, b.y}; v1 = (f32x4){c.x, c.y, d.x, d.y}; }
                    v0 = v0 * sc; v1 = v1 * sc; u32x4 w; w.x = cvt_pk_bf16(v0[0], v0[1]); w.y = cvt_pk_bf16(v0[2], v0[3]); w.z = cvt_pk_bf16(v1[0], v1[1]); w.w = cvt_pk_bf16(v1[2], v1[3]);
                    *(u32x4*)(rowp + bj * HALF) = w; } }
    }
};

template <bool IN_F32> struct EpiOutRes {
    static constexpr bool PERM = true, AFTER_DRAIN = false;
    const void* xin_l; const void* xin_c;
    bf16_t* xres; const float* mod;
    __device__ __forceinline__ void operator()(const f32x4 (&acc)[2][2][4][2], const Unit& u, int wr, int wc, int fr, int fq) const {
        const int rowt = u.pm * BM; const bool isc = rowt >= T_L; const int mrow = isc ? 8 : rowt / SEQ;
        const float* g = mod + (size_t)(mrow * 6 + 2) * D;
        const size_t inoff = isc ? (size_t)(rowt - T_L) * D : (size_t)rowt * D;
        const float* xf = (const float*)(isc ? xin_c : xin_l) + inoff; const bf16_t* xb = (const bf16_t*)(isc ? xin_c : xin_l) + inoff;
        bf16_t* xo = xres + (size_t)rowt * D;
        const int col0 = u.pn * BM + wc * 32 + 8 * fq;
        f32x4 gv[2][2];
#pragma unroll
        for (int bj = 0; bj < 2; ++bj)
#pragma unroll
            for (int n = 0; n < 2; ++n) gv[bj][n] = *(const f32x4*)(g + col0 + bj * HALF + 4 * n);
#pragma unroll
        for (int ai = 0; ai < 2; ++ai)
#pragma unroll
          for (int mp = 0; mp < 2; ++mp) {
            f32x4 xi[2][2][2];
#pragma unroll
            for (int m2 = 0; m2 < 2; ++m2) { const size_t ro = (size_t)(ai * HALF + wr * 64 + (2 * mp + m2) * 16 + fr) * D + col0;
#pragma unroll
                for (int bj = 0; bj < 2; ++bj) {
                    if constexpr (IN_F32) { xi[m2][bj][0] = *(const f32x4*)(xf + ro + bj * HALF); xi[m2][bj][1] = *(const f32x4*)(xf + ro + bj * HALF + 4); }
                    else { const u32x4 w = *(const u32x4*)(xb + ro + bj * HALF);
                        xi[m2][bj][0] = (f32x4){bflo(w.x), bfhi(w.x), bflo(w.y), bfhi(w.y)}; xi[m2][bj][1] = (f32x4){bflo(w.z), bfhi(w.z), bflo(w.w), bfhi(w.w)}; } } }
#pragma unroll
            for (int m2 = 0; m2 < 2; ++m2) { const int m = 2 * mp + m2; const size_t ro = (size_t)(ai * HALF + wr * 64 + m * 16 + fr) * D + col0;
#pragma unroll
                for (int bj = 0; bj < 2; ++bj) { const f32x4 v0 = xi[m2][bj][0] + gv[bj][0] * acc[ai][bj][m][0], v1 = xi[m2][bj][1] + gv[bj][1] * acc[ai][bj][m][1];
                    u32x4 w; w.x = cvt_pk_bf16(v0[0], v0[1]); w.y = cvt_pk_bf16(v0[2], v0[3]); w.z = cvt_pk_bf16(v1[0], v1[1]); w.w = cvt_pk_bf16(v1[2], v1[3]);
                    *(u32x4*)(xo + ro + bj * HALF) = w; } } }
    }
};
struct EpiSwiglu {
    static constexpr bool PERM = true, AFTER_DRAIN = false;
    bf16_t* hid; const float* bup;
    __device__ __forceinline__ void operator()(const f32x4 (&acc)[2][2][4][2], const Unit& u, int wr, int wc, int fr, int fq) const {
        const int e = u.pn >> 3, j = u.pn & 7; const int h0 = j * HALF + wc * 32 + 8 * fq;
        const float* bg = bup + (size_t)e * 2 * DE + h0; const float* bu = bg + DE;
        f32x4 vg[2], vu[2];
#pragma unroll
        for (int n = 0; n < 2; ++n) { vg[n] = *(const f32x4*)(bg + 4 * n); vu[n] = *(const f32x4*)(bu + 4 * n); }
#pragma unroll
        for (int ai = 0; ai < 2; ++ai)
#pragma unroll
            for (int m = 0; m < 4; ++m) { const size_t row = (size_t)u.pm * BM + ai * HALF + wr * 64 + m * 16 + fr; float o[8];
#pragma unroll
                for (int n = 0; n < 2; ++n) { const f32x4 gt = acc[ai][0][m][n] + vg[n], up = acc[ai][1][m][n] + vu[n];
#pragma unroll
                    for (int i = 0; i < 4; ++i) { const float gg = __builtin_fminf(gt[i], 7.0f); const float uu = __builtin_fminf(__builtin_fmaxf(up[i], -7.0f), 7.0f);
                        o[4 * n + i] = gg * sigmoidf_(1.702f * gg) * (uu + 1.0f); } }
                u32x4 w; w.x = cvt_pk_bf16(o[0], o[1]); w.y = cvt_pk_bf16(o[2], o[3]); w.z = cvt_pk_bf16(o[4], o[5]); w.w = cvt_pk_bf16(o[6], o[7]);
                *(u32x4*)(hid + row * DE + h0) = w; }
    }
};
struct EpiDown {
    static constexpr bool PERM = true, AFTER_DRAIN = false;
    unsigned char* ys; const float* bdn;
    __device__ __forceinline__ void operator()(const f32x4 (&acc)[2][2][4][2], const Unit& u, int wr, int wc, int fr, int fq) const {
        typedef unsigned u32x2v __attribute__((ext_vector_type(2)));
        const int e = u.pn >> 2, j = u.pn & 3; const int col0 = j * BM + wc * 32 + 8 * fq;
        f32x4 bv[2][2];
#pragma unroll
        for (int bj = 0; bj < 2; ++bj)
#pragma unroll
            for (int n = 0; n < 2; ++n) bv[bj][n] = *(const f32x4*)(bdn + (size_t)e * D + col0 + bj * HALF + 4 * n);
#pragma unroll
        for (int ai = 0; ai < 2; ++ai)
#pragma unroll
            for (int m = 0; m < 4; ++m) { const size_t row = (size_t)u.pm * BM + ai * HALF + wr * 64 + m * 16 + fr;
#pragma unroll
                for (int bj = 0; bj < 2; ++bj) { const f32x4 v0 = acc[ai][bj][m][0] + bv[bj][0], v1 = acc[ai][bj][m][1] + bv[bj][1];
                    int w0 = 0, w1 = 0;
                    w0 = __builtin_amdgcn_cvt_pk_fp8_f32(v0[0], v0[1], w0, false); w0 = __builtin_amdgcn_cvt_pk_fp8_f32(v0[2], v0[3], w0, true);
                    w1 = __builtin_amdgcn_cvt_pk_fp8_f32(v1[0], v1[1], w1, false); w1 = __builtin_amdgcn_cvt_pk_fp8_f32(v1[2], v1[3], w1, true);
                    *(u32x2v*)(ys + row * D + col0 + bj * HALF) = (u32x2v){(unsigned)w0, (unsigned)w1}; } }
    }
};
struct MoeOrder {
    const int* texp; int ntiles, nN, nwg, G, c;
    __device__ __forceinline__ void init(const int* texp_, int nN_, int G_, int c_) { texp = texp_; ntiles = texp_[0]; nN = nN_; nwg = ntiles * nN_; G = G_; c = c_; }
    __device__ __forceinline__ bool next(int i, Unit& u) const {
        const long L = (long)i * G + c; if (L >= nwg) return false;
        int wgid = (int)L; { const int q = nwg / NXCD, r = nwg % NXCD, xcd = wgid % NXCD, off = wgid / NXCD; wgid = (xcd < r ? xcd * (q + 1) : r * (q + 1) + (xcd - r) * q) + off; }
        const int nig = WGM * nN, gid = wgid / nig, fm = gid * WGM, gsz = (ntiles - fm) < WGM ? (ntiles - fm) : WGM;
        const int pm = fm + ((wgid % nig) % gsz); u.pm = pm; u.pn = texp[1 + pm] * nN + (wgid % nig) / gsz; return true;
    }
    __device__ __forceinline__ void a_ready(const Unit&) const {}
    __device__ __forceinline__ void done(const Unit&) const {}
};
#ifndef EMU
template <class Epi, class Sched, bool ALIGN_EPI = false, bool SP2 = false, bool GATHER = false>
__device__ __forceinline__ void gemm_phase(PG8_LAS unsigned char* lds, const Gemm g, const Sched& S, const Epi& E) {
    int tid_ = threadIdx.x; asm volatile("" : "+v"(tid_));
    const int tid = tid_, wid = __builtin_amdgcn_readfirstlane(tid >> 6), lane = tid & 63, wr = wid >> 2, wc = wid & 3, fr = lane & 15, fq = lane >> 4;
    const int K = g.K, nt = K / BK;
    unsigned voffA[2], voffB[2]; int gR[2], gC[2];
#pragma unroll
    for (int i = 0; i < 2; ++i) { int R, C; stage_rc(tid * 16 + i * 8192, R, C); const int Rb = Epi::PERM ? ((R & ~31) + perm32(R & 31)) : R;
        voffA[i] = (unsigned)(R * K + C) * 2u; voffB[i] = (unsigned)(Rb * K + C) * 2u; gR[i] = R; gC[i] = C; }
    unsigned voffC[2][2], voffN[2][2];
#define PG8_GOFF(dst, pm_) do { _Pragma("unroll") for (int h_ = 0; h_ < 2; ++h_) _Pragma("unroll") for (int i_ = 0; i_ < 2; ++i_) \
        dst[h_][i_] = (unsigned)(g.rowmap[(size_t)(pm_) * BM + h_ * HALF + gR[i_]] * K + gC[i_]) * 2u; } while (0)
    const size_t kstep = (size_t)(BK * 2);
    const size_t hstep = (size_t)HALF * K * 2;
    const size_t tstep = 2 * hstep;
    const unsigned ldsw = (unsigned)wid * 1024u;
    const int aoff = lds_byte(wr * 64 + fr, fq * 8), boff = lds_byte(wc * 32 + fr, fq * 8);
#define PG8_SA(b, h) (((b) * 2 + (h)) * HTB)
#define PG8_SB(b, h) ((4 + (b) * 2 + (h)) * HTB)
#define PG8_STAGE(bufoff, gbase, voff) do { _Pragma("unroll") for (int _i = 0; _i < 2; ++_i) \
        __builtin_amdgcn_global_load_lds((const unsigned*)((const char*)(gbase) + (voff)[_i]), (PG8_LAS unsigned*)(lds + (bufoff) + ldsw + _i * 8192), 16, 0, 0); } while (0)
#define PG8_LDA(dst, b, h) do { _Pragma("unroll") for (int m = 0; m < 4; ++m) _Pragma("unroll") for (int k = 0; k < 2; ++k) dst[m][k] = *(const PG8_LAS bf16x8*)(lds + PG8_SA(b, h) + aoff + m * 2048 + k * 1024); } while (0)
#define PG8_LDB(dst, b, h) do { _Pragma("unroll") for (int n = 0; n < 2; ++n) _Pragma("unroll") for (int k = 0; k < 2; ++k) dst[n][k] = *(const PG8_LAS bf16x8*)(lds + PG8_SB(b, h) + boff + n * 2048 + k * 1024); } while (0)
#define PG8_MMA(ai, bj, At, Bt) do { __builtin_amdgcn_s_setprio(1); _Pragma("unroll") for (int m = 0; m < 4; ++m) _Pragma("unroll") for (int n = 0; n < 2; ++n) _Pragma("unroll") for (int k = 0; k < 2; ++k) \
        acc[ai][bj][m][n] = __builtin_amdgcn_mfma_f32_16x16x32_bf16(Bt[n][k], At[m][k], acc[ai][bj][m][n], 0, 0, 0); __builtin_amdgcn_s_setprio(0); } while (0)
#define PG8_WAIT_V(n) asm volatile("s_waitcnt vmcnt(" #n ")" ::: "memory")
#define PG8_WAIT_L(n) asm volatile("s_waitcnt lgkmcnt(" #n ")" ::: "memory")
#define PG8_BAR __builtin_amdgcn_s_barrier()
#define PG8_SCHED __builtin_amdgcn_sched_barrier(0)
#define PG8_STAGEA(bufoff, gbase, h, nx) do { if constexpr (GATHER) { _Pragma("unroll") for (int _i = 0; _i < 2; ++_i) { const unsigned o_ = (nx) ? voffN[h][_i] : voffC[h][_i]; \
        __builtin_amdgcn_global_load_lds((const unsigned*)((const char*)(gbase) + o_), (PG8_LAS unsigned*)(lds + (bufoff) + ldsw + _i * 8192), 16, 0, 0); } } \
    else { PG8_STAGE(bufoff, (gbase) + (h) * hstep, voffA); } } while (0)
    Unit cur, nxt; int ui = 0;
    if (!S.next(0, cur)) return;
    f32x4 acc[2][2][4][2];
#pragma unroll
    for (int a = 0; a < 2; ++a)
#pragma unroll
        for (int b = 0; b < 2; ++b)
#pragma unroll
            for (int m = 0; m < 4; ++m)
#pragma unroll
                for (int n = 0; n < 2; ++n) acc[a][b][m][n] = (f32x4){0.f, 0.f, 0.f, 0.f};
    bf16x8 At[4][2], B0[2][2], B1[2][2];
    const char* cA = (const char*)g.A + (GATHER ? (size_t)0 : (size_t)cur.pm * tstep); if constexpr (GATHER) { PG8_GOFF(voffC, cur.pm); }
    const char* cB = (const char*)g.Bt + (size_t)cur.pn * tstep;
    S.a_ready(cur);
    if constexpr (SP2) {
        PG8_STAGE(PG8_SB(0, 0), cB, voffB); PG8_STAGE(PG8_SB(0, 1), cB + hstep, voffB); PG8_STAGEA(PG8_SA(0, 0), cA, 0, false); PG8_STAGEA(PG8_SA(0, 1), cA, 1, false);
        if (wr == 1) PG8_BAR;
        PG8_WAIT_V(2); PG8_BAR;
        PG8_STAGE(PG8_SB(1, 0), cB + kstep, voffB); PG8_STAGEA(PG8_SA(1, 0), cA + kstep, 0, false); PG8_STAGE(PG8_SB(1, 1), cB + hstep + kstep, voffB);
        PG8_WAIT_V(6); PG8_BAR;
    } else {
        PG8_STAGE(PG8_SB(0, 0), cB, voffB); PG8_STAGEA(PG8_SA(0, 0), cA, 0, false); PG8_STAGE(PG8_SB(0, 1), cB + hstep, voffB); PG8_STAGEA(PG8_SA(0, 1), cA, 1, false);
        if (wr == 1) PG8_BAR;
        PG8_WAIT_V(4); PG8_BAR;
        PG8_STAGE(PG8_SB(1, 0), cB + kstep, voffB); PG8_STAGEA(PG8_SA(1, 0), cA + kstep, 0, false); PG8_STAGE(PG8_SB(1, 1), cB + hstep + kstep, voffB);
        PG8_WAIT_V(6); PG8_BAR;
    }
    for (;;) {
        const bool has_next = S.next(ui + 1, nxt);
        if constexpr (GATHER) { if (has_next) { PG8_GOFF(voffN, nxt.pm); } else { _Pragma("unroll") for (int h_ = 0; h_ < 2; ++h_) _Pragma("unroll") for (int i_ = 0; i_ < 2; ++i_) voffN[h_][i_] = voffC[h_][i_]; } }
        const char* nA = (has_next && !GATHER) ? (const char*)g.A + (size_t)nxt.pm * tstep : cA; const char* nB = has_next ? (const char*)g.Bt + (size_t)nxt.pn * tstep : cB;
        for (int t = 0; t < nt; t += 2) {
            const bool last = (t == nt - 2);
            const char* a1 = cA + (size_t)(t + 1) * kstep;
            const char* a2 = last ? nA : cA + (size_t)(t + 2) * kstep; const char* b2 = last ? nB : cB + (size_t)(t + 2) * kstep;
            const char* a3 = a2 + kstep; const char* b3 = b2 + kstep;
            if (last && has_next) S.a_ready(nxt);
            if constexpr (SP2) {
            PG8_LDB(B0, 0, 0); PG8_LDB(B1, 0, 1); PG8_SCHED; PG8_LDA(At, 0, 0); PG8_STAGEA(PG8_SA(1, 1), a1, 1, false);
            PG8_WAIT_V(8); PG8_WAIT_L(0); PG8_BAR; PG8_MMA(0, 0, At, B0); PG8_MMA(0, 1, At, B1); PG8_BAR; PG8_SCHED;
            PG8_LDA(At, 0, 1); PG8_STAGE(PG8_SB(0, 0), b2, voffB); PG8_STAGE(PG8_SB(0, 1), b2 + hstep, voffB); PG8_STAGEA(PG8_SA(0, 0), a2, 0, last);
            PG8_WAIT_V(8); PG8_WAIT_L(0); PG8_BAR; PG8_MMA(1, 0, At, B0); PG8_MMA(1, 1, At, B1); PG8_BAR; PG8_SCHED;
            PG8_LDB(B0, 1, 0); PG8_LDB(B1, 1, 1); PG8_SCHED; PG8_LDA(At, 1, 0); PG8_STAGEA(PG8_SA(0, 1), a2, 1, last);
            PG8_WAIT_V(8); PG8_WAIT_L(0); PG8_BAR; PG8_MMA(0, 0, At, B0); PG8_MMA(0, 1, At, B1); PG8_BAR; PG8_SCHED;
            PG8_LDA(At, 1, 1); PG8_STAGE(PG8_SB(1, 0), b3, voffB); PG8_STAGE(PG8_SB(1, 1), b3 + hstep, voffB); PG8_STAGEA(PG8_SA(1, 0), a3, 0, last);
            PG8_WAIT_V(8); PG8_WAIT_L(0); PG8_BAR; PG8_MMA(1, 0, At, B0); PG8_MMA(1, 1, At, B1); PG8_BAR; PG8_SCHED;
            } else {
            PG8_LDB(B0, 0, 0); PG8_SCHED; PG8_LDA(At, 0, 0); PG8_STAGEA(PG8_SA(1, 1), a1, 1, false);
            PG8_WAIT_L(8); PG8_BAR; PG8_WAIT_L(0); PG8_MMA(0, 0, At, B0); PG8_BAR; PG8_SCHED;
            PG8_LDB(B1, 0, 1); PG8_STAGE(PG8_SB(0, 0), b2, voffB);
            PG8_BAR; PG8_WAIT_L(0); PG8_MMA(0, 1, At, B1); PG8_BAR;
            PG8_LDA(At, 0, 1); PG8_STAGEA(PG8_SA(0, 0), a2, 0, last);
            PG8_BAR; PG8_WAIT_L(0); PG8_MMA(1, 0, At, B0); PG8_BAR; PG8_SCHED;
            PG8_STAGE(PG8_SB(0, 1), b2 + hstep, voffB);
            PG8_WAIT_V(6); PG8_BAR; PG8_MMA(1, 1, At, B1); PG8_BAR;
            PG8_LDB(B0, 1, 0); PG8_SCHED; PG8_LDA(At, 1, 0); PG8_STAGEA(PG8_SA(0, 1), a2, 1, last);
            PG8_WAIT_L(8); PG8_BAR; PG8_WAIT_L(0); PG8_MMA(0, 0, At, B0); PG8_BAR; PG8_SCHED;
            PG8_LDB(B1, 1, 1); PG8_STAGE(PG8_SB(1, 0), b3, voffB);
            PG8_BAR; PG8_WAIT_L(0); PG8_MMA(0, 1, At, B1); PG8_BAR;
            PG8_LDA(At, 1, 1); PG8_STAGEA(PG8_SA(1, 0), a3, 0, last);
            PG8_BAR; PG8_WAIT_L(0); PG8_MMA(1, 0, At, B0); PG8_BAR; PG8_SCHED;
            PG8_STAGE(PG8_SB(1, 1), b3 + hstep, voffB);
            PG8_WAIT_V(6); PG8_BAR; PG8_MMA(1, 1, At, B1); PG8_BAR;
            }
        }
        if constexpr (ALIGN_EPI) { if (wr == 0) PG8_BAR; }
        if constexpr (!Epi::AFTER_DRAIN) { E(acc, cur, wr, wc, fr, fq); S.done(cur); }
        if (!has_next) break;
#pragma unroll
        for (int a = 0; a < 2; ++a)
#pragma unroll
            for (int b = 0; b < 2; ++b)
#pragma unroll
                for (int m = 0; m < 4; ++m)
#pragma unroll
                    for (int n = 0; n < 2; ++n) acc[a][b][m][n] = (f32x4){0.f, 0.f, 0.f, 0.f};
        cur = nxt; cA = nA; cB = nB; ++ui;
        if constexpr (GATHER) { _Pragma("unroll") for (int h_ = 0; h_ < 2; ++h_) _Pragma("unroll") for (int i_ = 0; i_ < 2; ++i_) voffC[h_][i_] = voffN[h_][i_]; }
        if constexpr (ALIGN_EPI) { if (wr == 1) PG8_BAR; }
    }
    PG8_WAIT_V(0);
    if constexpr (!ALIGN_EPI) { if (wr == 0) PG8_BAR; }
    PG8_BAR;
    if constexpr (Epi::AFTER_DRAIN) { E.fused(acc, cur, wr, wc, fr, fq, lds, wid, lane); S.done(cur); }
#undef PG8_SA
#undef PG8_SB
#undef PG8_STAGE
#undef PG8_STAGEA
#undef PG8_GOFF
#undef PG8_LDA
#undef PG8_LDB
#undef PG8_MMA
#undef PG8_WAIT_V
#undef PG8_WAIT_L
#undef PG8_BAR
#undef PG8_SCHED
}
#else
EMU_GEMM_PHASE
#endif
}
#ifndef EMU
namespace attn_body {
using bf16=unsigned short;
using bf16x8=__attribute__((ext_vector_type(8)))short;
using s16x4=__attribute__((ext_vector_type(4)))short;
using f32x16=__attribute__((ext_vector_type(16)))float;
using u32x4=__attribute__((ext_vector_type(4)))unsigned;
constexpr int D=64,DM=64;
constexpr int NW=8,QBLK=32,QB=QBLK*NW,KVBLK=64;
__device__ __forceinline__ int crow(int r,int hi){return (r&3)+8*(r>>2)+4*hi;}
#define SBAR() __builtin_amdgcn_sched_barrier(0)
constexpr int NSLOT=3, SLOTB=8192;
constexpr int LDS_K=0, LDS_V=NSLOT*SLOTB, LDS_WS=2*NSLOT*SLOTB, LDS_OST=LDS_WS+NW*64*4, LDS_BYTES=LDS_OST+NW*4096;
__device__ __forceinline__ void glds16(const void*gsrc,unsigned lds_dst){unsigned keep;
  asm volatile("s_mov_b32 %0, m0\n\ts_mov_b32 m0, %2\n\ts_nop 0\n\tglobal_load_lds_dwordx4 %1, off\n\ts_mov_b32 m0, %0":"=&s"(keep):"v"(gsrc),"s"(lds_dst):"memory");}
__device__ __forceinline__ float max3f(float a,float b,float c){float r;asm("v_max3_f32 %0, %1, %2, %3":"=v"(r):"v"(a),"v"(b),"v"(c));return r;}
__device__ __forceinline__ float max2f(float a,float b){float r;asm("v_max_f32_e32 %0, %1, %2":"=v"(r):"v"(a),"v"(b));return r;}
__device__ __forceinline__ float fadd_s(float a,float b){float r;asm("v_add_f32_e32 %0, %1, %2":"=v"(r):"v"(a),"v"(b));return r;}
__device__ __forceinline__ float fsub_s(float a,float b){float r;asm("v_sub_f32_e32 %0, %1, %2":"=v"(r):"v"(a),"v"(b));return r;}
typedef float f32x2_t __attribute__((ext_vector_type(2))); typedef __bf16 bf16x2_t __attribute__((ext_vector_type(2)));
__device__ __forceinline__ unsigned cvtpk_s(float lo,float hi){f32x2_t v={lo,hi};bf16x2_t b=__builtin_convertvector(v,bf16x2_t);return __builtin_bit_cast(unsigned,b);}
#define WAIT_BAR(N) asm volatile("s_waitcnt vmcnt(" #N ") lgkmcnt(0)\n\ts_barrier":::"memory")

template<int MODE> __device__ __forceinline__ constexpr bool d0_on(int d0){ return MODE==0 || (MODE==1 && d0<2) || (MODE==2 && d0>=2); }
template<int MODE> __device__ __forceinline__ void qkt(f32x16&p0,f32x16&p1,const char*Kslot,const bf16x8*qr,const f32x16&negm,int r32,int hi){
  const char*kb=Kslot+hi*1024+r32*16;
  constexpr int D0A=(MODE==2)?2:0, D0B=(MODE==1)?2:4;
  #pragma unroll
  for(int d0=D0A;d0<D0B;++d0){
    const bf16x8 b0=*reinterpret_cast<const bf16x8*>(kb+d0*2048);
    const bf16x8 b1=*reinterpret_cast<const bf16x8*>(kb+d0*2048+512);
    if(d0==D0A){p0=__builtin_amdgcn_mfma_f32_32x32x16_bf16(b0,qr[d0],negm,0,0,0);p1=__builtin_amdgcn_mfma_f32_32x32x16_bf16(b1,qr[d0],negm,0,0,0);}
    else{p0=__builtin_amdgcn_mfma_f32_32x32x16_bf16(b0,qr[d0],p0,0,0,0);p1=__builtin_amdgcn_mfma_f32_32x32x16_bf16(b1,qr[d0],p1,0,0,0);}}
}
template<int MODE,int IDX> __device__ __forceinline__ void qk_mf(f32x16&Cx,const bf16x8&k,const bf16x8&q,const f32x16&negm){
  if constexpr(d0_on<MODE>(IDX>>1)){ constexpr bool first=((IDX>>1)==((MODE==2)?2:0));
    if constexpr(first) Cx=__builtin_amdgcn_mfma_f32_32x32x16_bf16(k,q,negm,0,0,0); else Cx=__builtin_amdgcn_mfma_f32_32x32x16_bf16(k,q,Cx,0,0,0); }
}
typedef __attribute__((address_space(3))) const char* lds_cptr;
typedef short v4i16_t __attribute__((ext_vector_type(4)));
template<int MODE> __device__ __forceinline__ void kload8(bf16x8*kf,lds_cptr kp){
  #pragma unroll
  for(int j=0;j<4;++j) if(d0_on<MODE>(j)){ kf[2*j]=*(const __attribute__((address_space(3))) bf16x8*)(kp+j*2048); kf[2*j+1]=*(const __attribute__((address_space(3))) bf16x8*)(kp+j*2048+512); }
}
__device__ __forceinline__ void kload2(bf16x8*kf,lds_cptr kp,int j){ kf[2*j]=*(const __attribute__((address_space(3))) bf16x8*)(kp+j*2048); kf[2*j+1]=*(const __attribute__((address_space(3))) bf16x8*)(kp+j*2048+512); }
__device__ __forceinline__ s16x4 vtr(lds_cptr p){ return __builtin_bit_cast(s16x4,__builtin_amdgcn_ds_read_tr16_b64_v4i16((__attribute__((address_space(3))) v4i16_t*)p)); }
__device__ __forceinline__ float rowmax(const f32x16&p0,const f32x16&p1){
  float a=max3f(p0[0],p0[1],p1[0]),b=max3f(p0[2],p0[3],p1[1]);a=max3f(a,p1[2],p1[3]);
  #pragma unroll
  for(int r=4;r<16;r+=4){a=max3f(a,p0[r],p0[r+1]);b=max3f(b,p0[r+2],p0[r+3]);a=max3f(a,p1[r],p1[r+1]);b=max3f(b,p1[r+2],p1[r+3]);}
  const float m=max2f(a,b);
  auto rr=__builtin_amdgcn_permlane32_swap(__float_as_uint(m),__float_as_uint(m),false,false);
  return max2f(__uint_as_float(rr[0]),__uint_as_float(rr[1]));
}
__device__ __forceinline__ void pv(f32x16*o,int vb,bf16x8 pa0,bf16x8 pa1,bf16x8 pa2,bf16x8 pa3){
  #pragma unroll
  for(int d0=0;d0<2;++d0){s16x4 lo[4],hi[4];
    #pragma unroll
    for(int ks=0;ks<4;++ks){
      asm volatile("ds_read_b64_tr_b16 %0,%1 offset:%c2":"=&v"(lo[ks]):"v"(vb),"i"(d0*4096+ks*1024):"memory");
      asm volatile("ds_read_b64_tr_b16 %0,%1 offset:%c2":"=&v"(hi[ks]):"v"(vb),"i"(d0*4096+ks*1024+512):"memory");}
    asm volatile("s_waitcnt lgkmcnt(0)":::"memory");SBAR();
    #define PK(k) (bf16x8){lo[k][0],lo[k][1],lo[k][2],lo[k][3],hi[k][0],hi[k][1],hi[k][2],hi[k][3]}
    o[d0]=__builtin_amdgcn_mfma_f32_32x32x16_bf16(pa0,PK(0),o[d0],0,0,0);
    o[d0]=__builtin_amdgcn_mfma_f32_32x32x16_bf16(pa1,PK(1),o[d0],0,0,0);
    o[d0]=__builtin_amdgcn_mfma_f32_32x32x16_bf16(pa2,PK(2),o[d0],0,0,0);
    o[d0]=__builtin_amdgcn_mfma_f32_32x32x16_bf16(pa3,PK(3),o[d0],0,0,0);
    #undef PK
  }
}

#ifndef ATTN_STORE16
#define ATTN_STORE16(p,v) (*(u32x4*)(p)=(v))
#endif
template<int THRL,int MODE> __device__ __forceinline__ void attn_unit(const bf16*Qa,const bf16*Qb,const bf16*__restrict__ Kh,const bf16*__restrict__ Vh,bf16*Oa,bf16*Ob,int opitch,int NT,char*shm,float lam,float post,const float*subln){
  int tid_=threadIdx.x; asm volatile("":"+v"(tid_)); const int tid=tid_,lane=tid&63,r32=lane&31,hi=lane>>5; const int wid=__builtin_amdgcn_readfirstlane(tid>>6);
  const bf16*Qw=(wid<4?Qa:Qb)+(long)((wid&3)*QBLK)*DM;
  const unsigned lds0=(unsigned)(uintptr_t)shm;
  float*wsf=(float*)(shm+LDS_WS)+wid*64;
  const bf16*ksrc=Kh+(long)lane*DM+wid*8;
  const bf16*vsrc=Vh+(long)(16*(wid&3)+(lane>>2))*DM+(wid>>2)*32+(lane&3)*8;
  const unsigned kdst=lds0+LDS_K+wid*1024, vdst=lds0+LDS_V+wid*1024;
  #define DMA_K(t,slot) glds16(ksrc+(long)(t)*KVBLK*DM,(unsigned)__builtin_amdgcn_readfirstlane(kdst+(slot)))
  #define DMA_V(t,slot) glds16(vsrc+(long)(t)*KVBLK*DM,(unsigned)__builtin_amdgcn_readfirstlane(vdst+(slot)))
  const int vb0=(int)(lds0+LDS_V)+((lane>>4)&1)*32+(lane&3)*8+(4*hi+((lane&15)>>2))*64;
  const char*Kbase=shm+LDS_K; bf16x8 kf[8];
  const lds_cptr shm3=(lds_cptr)shm; const lds_cptr kp0=shm3+LDS_K+hi*1024+r32*16; const lds_cptr vp0=shm3+LDS_V+((lane>>4)&1)*32+(lane&3)*8+(4*hi+((lane&15)>>2))*64;
  DMA_K(0,0);DMA_V(0,0);DMA_K(1,SLOTB);
  bf16x8 qr[4];
  #pragma unroll
  for(int d0=0;d0<4;++d0)qr[d0]=*reinterpret_cast<const bf16x8*>(&Qw[(long)r32*DM+d0*16+hi*8]);
  float mhat=0.f,l_reg=0.f;f32x16 o[2];o[0]=f32x16{};o[1]=f32x16{};f32x16 negm=f32x16{};asm volatile("":"+v"(negm));
  #define CMASK(P0,P1,t) do{}while(0)
  bool resc=false;
  #define START(P0,P1) do{ const float rm=rowmax(P0,P1); resc=false; \
    { const float dl=rm; mhat=fadd_s(mhat,dl); \
      _Pragma("unroll") for(int r=0;r<16;++r){P0[r]=fsub_s(P0[r],dl);P1[r]=fsub_s(P1[r],dl);} \
      _Pragma("unroll") for(int r=0;r<16;++r)negm[r]=-mhat; asm volatile("":"+v"(negm)); } \
    _Pragma("unroll") for(int r=0;r<16;++r)P0[r]=__builtin_amdgcn_exp2f(P0[r]); }while(0)
  #define RESC() do{ if(resc){ asm volatile("s_waitcnt lgkmcnt(0)":::"memory"); \
      _Pragma("unroll") for(int d_=0;d_<2;++d_) _Pragma("unroll") for(int r=0;r<16;++r)o[d_][r]*=wsf[crow(r,hi)]; } }while(0)
  f32x16 pA0,pA1,pB0,pB1;
  int sl_prev=0,sl_cur=0,sl_next=SLOTB;
  #define ROT() do{sl_prev=sl_cur;sl_cur=sl_next;sl_next=(sl_next==(NSLOT-1)*SLOTB)?0:sl_next+SLOTB;}while(0)
  DMA_K(2,2*SLOTB);
  WAIT_BAR(3);
  qkt<MODE>(pA0,pA1,Kbase,qr,negm,r32,hi);asm volatile("s_nop 15\n\ts_nop 7":"+v"(pA0),"+v"(pA1));CMASK(pA0,pA1,0);
  START(pA0,pA1);
  _Pragma("unroll") for(int r=0;r<16;++r)pA1[r]=__builtin_amdgcn_exp2f(pA1[r]);
  WAIT_BAR(0);
  DMA_K(3,0);DMA_V(1,SLOTB);
  ROT();
  kload8<MODE>(kf,kp0+sl_cur);
  WAIT_BAR(2);
  s16x4 vlo[8],vhi[8]; u32x4 pw0,pw1,pw2,pw3;
  #define PKW(P,B) cvtpk_s(P[B],P[B+1])
  #define PAF(k) __builtin_bit_cast(bf16x8,pw##k)
  #define VFR(i) (bf16x8){vlo[i][0],vlo[i][1],vlo[i][2],vlo[i][3],vhi[i][0],vhi[i][1],vhi[i][2],vhi[i][3]}
  #define PIN(x) asm volatile("":"+v"(x))
  #define MX3(a,b,c) __builtin_fmaxf(__builtin_fmaxf((a),(b)),(c))
  #define GAPA(MF,A0,A1,A2,A3,W0,W1,PW) do{ MF; sacc+=A0; sacc+=A1; sacc+=A2; sacc+=A3; PIN(sacc); W0; W1; PIN(PW); SBAR(); }while(0)
  #define EX(v) __builtin_amdgcn_exp2f(v)
  #define GAPB(MF,X,B) do{ MF; X[B]=EX(X[B]); X[B+1]=EX(X[B+1]); X[B+2]=EX(X[B+2]); X[B+3]=EX(X[B+3]); PIN(X); SBAR(); }while(0)
  #define VRD(i) do{ vlo[i]=vtr(vp_+(((i)>>2)*4096+((i)&3)*1024)); vhi[i]=vtr(vp_+(((i)>>2)*4096+((i)&3)*1024+512)); }while(0)
  #define KRD(G,j) do{ if((G)&&d0_on<MODE>(j)){ kload2(kf,kp0+sl_next,j); SBAR(); } }while(0)
  #define STEP(C0,C1,P0,P1,t,GK,GV,GL) do{ SBAR(); \
    const lds_cptr vp_=vp0+sl_prev; \
    VRD(0); SBAR(); float sacc=(P0[0]+P0[1]); \
    GAPA((qk_mf<MODE,0>(C0,kf[0],qr[0],negm)), P0[2],P0[3],P0[4],P0[5],     pw0[0]=PKW(P0,0), pw0[1]=PKW(P0,2), pw0); \
    VRD(4); SBAR(); GAPA((qk_mf<MODE,1>(C1,kf[1],qr[0],negm)), P0[6],P0[7],P0[8],P0[9],     pw0[2]=PKW(P0,4), pw0[3]=PKW(P0,6), pw0); \
    VRD(1); SBAR(); GAPA((qk_mf<MODE,2>(C0,kf[2],qr[1],negm)),   P0[10],P0[11],P0[12],P0[13], pw1[0]=PKW(P0,8), pw1[1]=PKW(P0,10), pw1); \
    VRD(5); SBAR(); GAPA((qk_mf<MODE,3>(C1,kf[3],qr[1],negm)),   P0[14],P0[15],P1[0],P1[1],   pw1[2]=PKW(P0,12),pw1[3]=PKW(P0,14), pw1); \
    VRD(2); SBAR(); GAPA((qk_mf<MODE,4>(C0,kf[4],qr[2],negm)),   P1[2],P1[3],P1[4],P1[5],     pw2[0]=PKW(P1,0), pw2[1]=PKW(P1,2), pw2); \
    VRD(6); SBAR(); GAPA((qk_mf<MODE,5>(C1,kf[5],qr[2],negm)),   P1[6],P1[7],P1[8],P1[9],     pw2[2]=PKW(P1,4), pw2[3]=PKW(P1,6), pw2); \
    VRD(3); SBAR(); GAPA((qk_mf<MODE,6>(C0,kf[6],qr[3],negm)),   P1[10],P1[11],P1[12],P1[13], pw3[0]=PKW(P1,8), pw3[1]=PKW(P1,10), pw3); \
    VRD(7); SBAR(); GAPA((qk_mf<MODE,7>(C1,kf[7],qr[3],negm)),   P1[14],P1[15],0.f,0.f,       pw3[2]=PKW(P1,12),pw3[3]=PKW(P1,14), pw3); \
    l_reg+=sacc; \
    if(GK){DMA_K((t)+3,sl_cur);} if(GV){DMA_V((t)+1,sl_next);} \
    CMASK(C0,C1,t); \
    { float a=MX3(C0[0],C0[1],C1[0]),b=MX3(C0[2],C0[3],C1[1]); a=MX3(a,C1[2],C1[3]); \
      _Pragma("unroll") for(int r=4;r<16;r+=4){a=MX3(a,C0[r],C0[r+1]);b=MX3(b,C0[r+2],C0[r+3]);a=MX3(a,C1[r],C1[r+1]);b=MX3(b,C1[r+2],C1[r+3]);} \
      float rm=__builtin_fmaxf(a,b); { auto rr=__builtin_amdgcn_permlane32_swap(__float_as_uint(rm),__float_as_uint(rm),false,false); rm=__builtin_fmaxf(__uint_as_float(rr[0]),__uint_as_float(rr[1])); } \
      resc=false; \
      if(__builtin_expect(__any(rm>(float)THRL),0)){ const float dl=__builtin_fmaxf(rm,0.f); mhat+=dl; \
        _Pragma("unroll") for(int r=0;r<16;++r){C0[r]-=dl;C1[r]-=dl;} \
        _Pragma("unroll") for(int r=0;r<16;++r)negm[r]=-mhat; asm volatile("":"+v"(negm)); \
        const float f=__builtin_amdgcn_exp2f(-dl); l_reg*=f; if(hi==0)wsf[r32]=f; resc=true; } } \
    SBAR(); \
    GAPB(o[0]=__builtin_amdgcn_mfma_f32_32x32x16_bf16(PAF(0),VFR(0),o[0],0,0,0), C0,0); \
    GAPB(o[1]=__builtin_amdgcn_mfma_f32_32x32x16_bf16(PAF(0),VFR(4),o[1],0,0,0), C0,4); \
    KRD(GL,0); GAPB(o[0]=__builtin_amdgcn_mfma_f32_32x32x16_bf16(PAF(1),VFR(1),o[0],0,0,0), C0,8); \
    KRD(GL,1); GAPB(o[1]=__builtin_amdgcn_mfma_f32_32x32x16_bf16(PAF(1),VFR(5),o[1],0,0,0), C0,12); \
    KRD(GL,2); GAPB(o[0]=__builtin_amdgcn_mfma_f32_32x32x16_bf16(PAF(2),VFR(2),o[0],0,0,0), C1,0); \
    KRD(GL,3); GAPB(o[1]=__builtin_amdgcn_mfma_f32_32x32x16_bf16(PAF(2),VFR(6),o[1],0,0,0), C1,4); \
    GAPB(o[0]=__builtin_amdgcn_mfma_f32_32x32x16_bf16(PAF(3),VFR(3),o[0],0,0,0), C1,8); \
    GAPB(o[1]=__builtin_amdgcn_mfma_f32_32x32x16_bf16(PAF(3),VFR(7),o[1],0,0,0), C1,12); \
    }while(0)
  int t=1;
  for(;t+5<NT;t+=2){
    STEP(pB0,pB1,pA0,pA1,t,true,true,true);     WAIT_BAR(2); RESC(); ROT();
    STEP(pA0,pA1,pB0,pB1,t+1,true,true,true);   WAIT_BAR(2); RESC(); ROT();
  }
  #define ENDW(tt) do{ if((tt)+3<NT){WAIT_BAR(2);} else if((tt)+2<NT){WAIT_BAR(1);} else {WAIT_BAR(0);} }while(0)
  for(;t+1<NT;t+=2){
    STEP(pB0,pB1,pA0,pA1,t,(t+3<NT),(t+1<NT),(t+1<NT));       ENDW(t);   RESC(); ROT();
    STEP(pA0,pA1,pB0,pB1,t+1,(t+4<NT),(t+2<NT),(t+2<NT));     ENDW(t+1); RESC(); ROT();
  }
  STEP(pB0,pB1,pA0,pA1,NT-1,false,false,false); RESC();
  { float sacc=pB0[0]+pB0[1]; _Pragma("unroll") for(int r=2;r<16;++r)sacc+=pB0[r]; _Pragma("unroll") for(int r=0;r<16;++r)sacc+=pB1[r]; l_reg+=sacc;
    pw0=(u32x4){PKW(pB0,0),PKW(pB0,2),PKW(pB0,4),PKW(pB0,6)};pw1=(u32x4){PKW(pB0,8),PKW(pB0,10),PKW(pB0,12),PKW(pB0,14)};pw2=(u32x4){PKW(pB1,0),PKW(pB1,2),PKW(pB1,4),PKW(pB1,6)};pw3=(u32x4){PKW(pB1,8),PKW(pB1,10),PKW(pB1,12),PKW(pB1,14)};
    SBAR(); pv(o,vb0+sl_cur,PAF(0),PAF(1),PAF(2),PAF(3)); }
  #undef PKW
  #undef PAF
  #undef VFR
  #undef PIN
  #undef MX3
  #undef GAPA
  #undef GAPB
  #undef EX
  #undef VRD
  #undef KRD
  #undef STEP
  #undef ENDW
  {auto rr=__builtin_amdgcn_permlane32_swap(__float_as_uint(l_reg),__float_as_uint(l_reg),false,false);l_reg=__uint_as_float(rr[0])+__uint_as_float(rr[1]);}
  if(hi==0)wsf[32+r32]=l_reg;asm volatile("s_waitcnt lgkmcnt(0)":::"memory");
  float rli[16];
  #pragma unroll
  for(int r=0;r<16;++r)rli[r]=__builtin_amdgcn_rcpf(wsf[32+crow(r,hi)]);
  bf16*Ow=(wid<4?Oa:Ob)+(long)((wid&3)*QBLK)*opitch;
  { bf16*stg=(bf16*)(shm+LDS_OST)+wid*2048;
    #pragma unroll
    for(int r=0;r<16;++r){const int orow=crow(r,hi);
      #pragma unroll
      for(int d0=0;d0<2;++d0)stg[orow*64+d0*32+r32]=(bf16)f2bf(o[d0][r]*rli[r]);}
    asm volatile("s_waitcnt lgkmcnt(0)":::"memory");
    if constexpr(MODE==0){
      #pragma unroll
      for(int i=0;i<4;++i){const int row=i*8+(lane>>3),ch=lane&7; const u32x4 v=*(const u32x4*)(stg+row*64+ch*8); ATTN_STORE16(Ow+(long)row*opitch+ch*8,v);}
    } else {
      asm volatile("s_barrier":::"memory");
      if constexpr(MODE==1){ const bf16*stg2=stg+4*2048; const int ch=lane&7; float sb[8];
        #pragma unroll
        for(int e=0;e<8;++e)sb[e]=subln[ch*8+e]*post;
        #pragma unroll
        for(int i=0;i<4;++i){const int row=i*8+(lane>>3); const u32x4 v1=*(const u32x4*)(stg+row*64+ch*8),v2=*(const u32x4*)(stg2+row*64+ch*8);
          float od[8]; float ss=0.f;
          #pragma unroll
          for(int e=0;e<4;++e){ od[2*e]=bflo(v1[e])-lam*bflo(v2[e]); od[2*e+1]=bfhi(v1[e])-lam*bfhi(v2[e]); ss+=od[2*e]*od[2*e]+od[2*e+1]*od[2*e+1]; }
          ss+=__shfl_xor(ss,1); ss+=__shfl_xor(ss,2); ss+=__shfl_xor(ss,4);
          const float rn=__builtin_amdgcn_rsqf(ss*(1.f/64.f)+1e-6f);
          u32x4 w; w[0]=pk2(od[0]*rn*sb[0],od[1]*rn*sb[1]); w[1]=pk2(od[2]*rn*sb[2],od[3]*rn*sb[3]); w[2]=pk2(od[4]*rn*sb[4],od[5]*rn*sb[5]); w[3]=pk2(od[6]*rn*sb[6],od[7]*rn*sb[7]);
          ATTN_STORE16(Ow+(long)row*opitch+ch*8,w);} }
    } }
  asm volatile("s_waitcnt lgkmcnt(0)\n\ts_barrier":::"memory");
  #undef DMA_K
  #undef DMA_V
  #undef CMASK
  #undef START
  #undef RESC
  #undef ROT
}
constexpr int ATTN_LDS_BYTES=LDS_BYTES;
#undef SBAR
#undef WAIT_BAR
}
#else
EMU_ATTN_BODY
#endif
#ifndef EMU
#define XB_TMO      128
#define XB_XCNT(j)  (256  + 64 * (j))
#define XB_XSUB(j)  (1280 + 64 * (j))
#define XB_XGEN(j)  (2304 + 64 * (j))
#define XB_TOP      3328
#define XB_TOPGEN   3392
#define XCD_BAR_WORDS 3456
#define XB_SPIN_CAP (1u << 18)

__device__ __forceinline__ unsigned xb_ld(unsigned* p)              { return __hip_atomic_load(p, __ATOMIC_RELAXED, __HIP_MEMORY_SCOPE_AGENT); }
__device__ __forceinline__ unsigned xb_add(unsigned* p, unsigned v) { return __hip_atomic_fetch_add(p, v, __ATOMIC_RELAXED, __HIP_MEMORY_SCOPE_AGENT); }
__device__ __forceinline__ unsigned xb_xcc_id() { return (unsigned)__builtin_amdgcn_s_getreg((3 << 11) | 20) & 0xFu; }
#define XB_SPIN(cond, bar) do { unsigned _sp = 0; while (cond) { __builtin_amdgcn_s_sleep(1); \
    if ((++_sp & 255u) == 0u) { if (xb_ld(&(bar)[XB_TMO])) break; if (_sp > XB_SPIN_CAP) { atomicAdd(&(bar)[XB_TMO], 1u); break; } } } } while (0)

struct XcdBarrier {
    unsigned* bar; unsigned x;
    volatile LAS unsigned* st;
};

__device__ __forceinline__ XcdBarrier xcd_barrier_post(unsigned* bar, volatile LAS unsigned* st) {
    XcdBarrier b; b.bar = bar; b.x = xb_xcc_id(); b.st = st;
    if (threadIdx.x == 0) (void)xb_add(&bar[XB_XCNT(b.x)], 1u);
    return b;
}
__device__ __forceinline__ void xcd_barrier_complete(unsigned* bar, unsigned x, unsigned& nloc, unsigned& nx) {
    const unsigned G = gridDim.x * gridDim.y * gridDim.z;
    unsigned sum, cnt, mine, sp = 0u;
    for (;;) {
        sum = 0u; cnt = 0u; mine = 0u;
#pragma unroll
        for (unsigned j = 0; j < 16; ++j) { const unsigned c = xb_ld(&bar[XB_XCNT(j)]); sum += c; cnt += (c > 0u) ? 1u : 0u; mine = (j == x) ? c : mine; }
        if (sum == G) break;
        __builtin_amdgcn_s_sleep(1);
        if ((++sp & 255u) == 0u) { if (xb_ld(&bar[XB_TMO])) break; if (sp > XB_SPIN_CAP) { atomicAdd(&bar[XB_TMO], 1u); break; } }
    }
    nloc = mine > 0u ? mine : 1u; nx = cnt > 0u ? cnt : 1u;
}

__device__ __forceinline__ void xcd_barrier(const XcdBarrier& b) {
    asm volatile("s_waitcnt vmcnt(0)" ::: "memory");
    __syncthreads();
    if (threadIdx.x == 0) {
        unsigned* bar = b.bar;
        __builtin_amdgcn_s_waitcnt(0);
        unsigned nloc = b.st[0], nx = b.st[1];
        if (nloc == 0u) { xcd_barrier_complete(bar, b.x, nloc, nx); b.st[0] = nloc; b.st[1] = nx; }
        const unsigned old = xb_add(&bar[XB_XSUB(b.x)], 1u);
        const unsigned gen = old / nloc;
        if (old + 1u == (gen + 1u) * nloc) {
            __builtin_amdgcn_fence(__ATOMIC_RELEASE, "agent");
            asm volatile("s_waitcnt vmcnt(0)" ::: "memory");
            const unsigned og = xb_add(&bar[XB_TOP], 1u);
            const unsigned tg = og / nx;
            if (og + 1u == (tg + 1u) * nx) xb_add(&bar[XB_TOPGEN], 1u);
            else XB_SPIN(xb_ld(&bar[XB_TOPGEN]) == tg, bar);
            __builtin_amdgcn_fence(__ATOMIC_ACQUIRE, "agent");
            xb_add(&bar[XB_XGEN(b.x)], 1u);
            asm volatile("s_waitcnt vmcnt(0)" ::: "memory");
        } else {
            XB_SPIN(xb_ld(&bar[XB_XGEN(b.x)]) == gen, bar);
            __builtin_amdgcn_fence(__ATOMIC_ACQUIRE, "agent");
            asm volatile("s_waitcnt vmcnt(0)" ::: "memory");
        }
    }
    __syncthreads();
}
#endif

constexpr int LDS_BYTES = 147456;
constexpr int MISC_OFF = 139264;
constexpr int PTR_OFF = MISC_OFF + 256;
struct Ctx {
    LAS unsigned char* lds;
    int tid, lane, wave, bid, G;
    float* out; unsigned long long wsi;
};
DEVI const float* inp_ptr(const Ctx& C, int i) {
    const unsigned long long v = ((const LAS unsigned long long*)(C.lds + PTR_OFF))[i];
    const unsigned lo = __builtin_amdgcn_readfirstlane((unsigned)v), hi = __builtin_amdgcn_readfirstlane((unsigned)(v >> 32));
    return (const float*)(const GAS float*)(((unsigned long long)hi << 32) | lo);
}
#define INP(i) inp_ptr(C, i)
#define WSP(T, off) ((T*)(GAS T*)(C.wsi + (unsigned long long)(off)))
DEVI int mod_row(int r) { return r < T_L ? r / SEQ : 8; }
DEVI const float* mod_vec(const Ctx& C, int layer, int mrow, int which) { return WSP(const float, WS_MOD) + ((size_t)(layer * 9 + mrow) * 6 + which) * D; }

DEVI void transpose_item(const float* W, int ldw, int k0, int n0, bf16* WT, int orow0, int Kp, LAS float* scr, int lane) {
    { const int kr = lane >> 3, c4 = (lane & 7) * 4; f32x4 v[8];
#pragma unroll
      for (int i = 0; i < 8; ++i) v[i] = *(const f32x4*)(W + (size_t)(k0 + 8 * i + kr) * ldw + n0 + c4);
#pragma unroll
      for (int i = 0; i < 8; ++i) { LAS float* d = scr + (8 * i + kr) * 33 + c4; d[0] = v[i].x; d[1] = v[i].y; d[2] = v[i].z; d[3] = v[i].w; } }
    LDS_WAIT();
    const int c = lane & 7;
#pragma unroll
    for (int j = 0; j < 4; ++j) { const int n = (lane >> 3) + 8 * j; const LAS float* s = scr + (8 * c) * 33 + n;
        v4u o; o.x = pk2(s[0 * 33], s[1 * 33]); o.y = pk2(s[2 * 33], s[3 * 33]); o.z = pk2(s[4 * 33], s[5 * 33]); o.w = pk2(s[6 * 33], s[7 * 33]);
        *(v4u*)(WT + (size_t)(orow0 + n) * Kp + k0 + 8 * c) = o; }
    LDS_WAIT();
}
DEVI void convert_layer_weights(const Ctx& C, int layer, int part) {
    LAS float* scr = (LAS float*)(C.lds + C.wave * 16384);
    const int gw = C.bid * 8 + C.wave, NGW = C.G * 8;
    constexpr int I_IN = 16 * (N_PROJ / 32), I_OUT = 16 * (D / 32), I_UP = NE * 16 * (2 * DE / 32), I_DN = NE * 16 * (D / 32), I_LAYER = I_IN + I_OUT + I_UP + I_DN;
    const int it_lo = (part == 1) ? I_IN + I_OUT : 0, it_hi = (part == 0) ? I_IN + I_OUT : I_LAYER;
    for (int it = it_lo + gw; it < it_hi; it += NGW) {
        int r = it;
        if (r < I_IN) { const int kb = r / (N_PROJ / 32), nb = r % (N_PROJ / 32);
            transpose_item(INP(8) + (size_t)layer * D * D_IN, D_IN, 64 * kb, 32 * nb, WSP(bf16, WS_WIN) + (size_t)layer * N_PROJ * D, 32 * nb, D, scr, C.lane); continue; }
        r -= I_IN;
        if (r < I_OUT) { const int kb = r / (D / 32), nb = r % (D / 32);
            transpose_item(INP(9) + (size_t)layer * D * D, D, 64 * kb, 32 * nb, WSP(bf16, WS_WOUT) + (size_t)layer * D * D, 32 * nb, D, scr, C.lane); continue; }
        r -= I_OUT;
        if (r < I_UP) { const int e = r / (16 * 64), q = r % (16 * 64), kb = q / 64, nb = q % 64; const int n0 = 32 * nb;
            const int orow = (n0 < DE) ? (n0 / 128) * 256 + (n0 % 128) : ((n0 - DE) / 128) * 256 + 128 + ((n0 - DE) % 128);
            transpose_item(INP(26) + ((size_t)layer * NE + e) * D * 2 * DE, 2 * DE, 64 * kb, n0, WSP(bf16, WS_WUP) + ((size_t)layer * NE + e) * 2 * DE * D, orow, D, scr, C.lane); continue; }
        r -= I_UP;
        { const int e = r / (16 * 32), q = r % (16 * 32), kb = q / 32, nb = q % 32;
            transpose_item(INP(28) + ((size_t)layer * NE + e) * DE * D, D, 64 * kb, 32 * nb, WSP(bf16, WS_WDN) + ((size_t)layer * NE + e) * D * DE, 32 * nb, DE, scr, C.lane); }
    }
}
DEVI void p0_prologue(const Ctx& C) {
    convert_layer_weights(C, 0, 0);
    {
      float* tab = WSP(float, WS_ROPE);
      for (int i = C.bid * 512 + C.tid; i < SEQ * 48; i += C.G * 512) { const int t = i / 48, j = i % 48; const float rp = (float)(t / GRID_W), cp = (float)(t % GRID_W); float c, s;
          if (j < 32) { const float ang = (j < 16 ? rp : cp) * __builtin_amdgcn_exp2f(-(float)(j & 15) * (13.287712379549449f / 16.f)); const float tt = __builtin_amdgcn_fractf(ang * 0.15915494309189535f); c = __builtin_amdgcn_cosf(tt); s = __builtin_amdgcn_sinf(tt);
              tab[(size_t)t * 32 + j] = c; tab[(size_t)SEQ * 32 + (size_t)t * 32 + j] = s; }
          else { const int i2 = j - 32; const float ang = (i2 < 8 ? rp : cp) * __builtin_amdgcn_exp2f(-(float)(i2 & 7) * (13.287712379549449f / 8.f)); const float tt = __builtin_amdgcn_fractf(ang * 0.15915494309189535f); c = __builtin_amdgcn_cosf(tt); s = __builtin_amdgcn_sinf(tt);
              tab[(size_t)SEQ * 64 + (size_t)t * 16 + i2] = c; tab[(size_t)SEQ * 80 + (size_t)t * 16 + i2] = s; } } }
    __syncthreads();
    LAS float* sc = (LAS float*)C.lds;
    LAS float* red = sc + 9 * D;
    for (int i = C.tid; i < 9 * D; i += 512) { const int r = i / D, k = i % D; float v = 0.f; if (r < NB) v = INP(1)[r * D + k]; else if (r == 8) v = INP(3)[k]; sc[i] = siluf_(v); }
    __syncthreads();
    for (int u = C.bid; u < DEPTH * 96; u += C.G) {
        const int layer = u / 96, n0 = (u % 96) * 64, col = C.tid & 63, kg = C.tid >> 6;
        const float* w = INP(4) + (size_t)layer * D * 6 * D + n0 + col;
        float acc[9];
#pragma unroll
        for (int r = 0; r < 9; ++r) acc[r] = 0.f;
#pragma unroll 8
        for (int k = kg * 128; k < kg * 128 + 128; ++k) { const float wv = w[(size_t)k * 6 * D];
#pragma unroll
            for (int r = 0; r < 9; ++r) acc[r] += sc[r * D + k] * wv; }
#pragma unroll
        for (int r = 0; r < 9; ++r) red[(kg * 9 + r) * 64 + col] = acc[r];
        __syncthreads();
        for (int i = C.tid; i < 9 * 64; i += 512) { const int r = i >> 6, c2 = i & 63; float s = 0.f;
#pragma unroll
            for (int g = 0; g < 8; ++g) s += red[(g * 9 + r) * 64 + c2];
            WSP(float, WS_MOD)[((size_t)(layer * 9 + r)) * 6 * D + n0 + c2] = s + INP(5)[(size_t)layer * 6 * D + n0 + c2]; }
        __syncthreads();
    }
}

DEVI void ph_norm_mix(const Ctx& C, int layer) {
    const bool fin = (layer == DEPTH);
    const int nrows = fin ? T_L : T_ALL;
    if (layer == 0) {
        for (int it = C.bid * 8 + C.wave; it < DEPTH * 9 * NE; it += C.G * 8) {
            const int e = it % NE, m = (it / NE) % 9, l = it / (NE * 9);
            const float* gn = INP(7) + (size_t)l * D; const float* sh = mod_vec(C, l, m, 3); const float* scl = mod_vec(C, l, m, 4); const float* rw = INP(24) + (size_t)l * D * NE + e;
            float* dst = WSP(float, WS_RWP) + (size_t)it * D; float bsum = 0.f;
#pragma unroll 4
            for (int j = 0; j < 16; ++j) { const int k = 64 * j + C.lane; const float w = rw[(size_t)k * NE]; dst[k] = gn[k] * (1.f + scl[k]) * w; bsum += sh[k] * w; }
            bsum = wave_sum(bsum); if (C.lane == 0) WSP(float, WS_RBP)[it] = bsum + INP(25)[l * NE + e];
        }
    }
    LAS float* w16 = (LAS float*)C.lds;
    if (!fin) { for (int i = C.tid; i < 16 * D; i += 512) { const int k = i >> 4, j = i & 15; w16[j * D + k] = INP(8)[((size_t)layer * D + k) * D_IN + N_PROJ + j]; } }
    __syncthreads();
    const float* gmain = fin ? INP(30) : INP(6) + (size_t)layer * D;
    const int rstep = C.G * 8;
    int s4[2][4]; float g4[2][4];
#define NM_SLOTS(dst_s, dst_g, rbase) do { _Pragma("unroll") for (int u2 = 0; u2 < 2; ++u2) { const int rr_ = (rbase) + u2 * rstep; const int rc_ = rr_ < nrows ? rr_ : 0; \
        const int* sl_ = WSP(const int, WS_SLOT) + (size_t)rc_ * 4; const float* gl_ = WSP(const float, WS_TOKG) + (size_t)rc_ * 4; \
        _Pragma("unroll") for (int k = 0; k < 4; ++k) { dst_s[u2][k] = sl_[k]; dst_g[u2][k] = gl_[k]; } } } while (0)
    if (layer != 0) NM_SLOTS(s4, g4, C.bid * 8 + C.wave);
#define NMC(j) ((((j) & 2) ? 512 : 0) + 8 * C.lane + 4 * ((j) & 1))
    for (int ra = C.bid * 8 + C.wave; ra < nrows; ra += 2 * rstep) {
        f32x4 v[2][4]; int mrow[2]; bool live[2];
        int s4n[2][4]; float g4n[2][4];
        if (layer != 0) NM_SLOTS(s4n, g4n, ra + 2 * rstep);
#pragma unroll
        for (int u2 = 0; u2 < 2; ++u2) { const int r = ra + u2 * rstep; live[u2] = r < nrows; const int rc = live[u2] ? r : 0; mrow[u2] = mod_row(rc);
            if (layer == 0) { const float* xr = (rc < T_L) ? INP(0) + (size_t)rc * D : INP(2) + (size_t)(rc - T_L) * D;
#pragma unroll
                for (int j = 0; j < 4; ++j) v[u2][j] = *(const f32x4*)(xr + NMC(j));
            } else {
                const bf16* xr = WSP(const bf16, WS_XRES) + (size_t)rc * D; const float* g2 = mod_vec(C, layer - 1, mrow[u2], 5);
                f32x4 xv[4]; { const v4u xa = *(const v4u*)(xr + 8 * C.lane), xb = *(const v4u*)(xr + 512 + 8 * C.lane);
                    xv[0] = (f32x4){bflo(xa.x), bfhi(xa.x), bflo(xa.y), bfhi(xa.y)}; xv[1] = (f32x4){bflo(xa.z), bfhi(xa.z), bflo(xa.w), bfhi(xa.w)};
                    xv[2] = (f32x4){bflo(xb.x), bfhi(xb.x), bflo(xb.y), bfhi(xb.y)}; xv[3] = (f32x4){bflo(xb.z), bfhi(xb.z), bflo(xb.w), bfhi(xb.w)}; }
                f32x4 a[4];
#pragma unroll
                for (int j = 0; j < 4; ++j) a[j] = (f32x4){0.f, 0.f, 0.f, 0.f};
#pragma unroll
                for (int k = 0; k < 4; ++k) { const unsigned char* yr = WSP(const unsigned char, WS_YS) + (size_t)s4[u2][k] * D; const v2u ya = *(const v2u*)(yr + 8 * C.lane), yb = *(const v2u*)(yr + 512 + 8 * C.lane); const float gk = g4[u2][k];
                    const f32x2 p0 = __builtin_amdgcn_cvt_pk_f32_fp8((int)ya.x, false), p1 = __builtin_amdgcn_cvt_pk_f32_fp8((int)ya.x, true), p2 = __builtin_amdgcn_cvt_pk_f32_fp8((int)ya.y, false), p3 = __builtin_amdgcn_cvt_pk_f32_fp8((int)ya.y, true);
                    const f32x2 q0 = __builtin_amdgcn_cvt_pk_f32_fp8((int)yb.x, false), q1 = __builtin_amdgcn_cvt_pk_f32_fp8((int)yb.x, true), q2 = __builtin_amdgcn_cvt_pk_f32_fp8((int)yb.y, false), q3 = __builtin_amdgcn_cvt_pk_f32_fp8((int)yb.y, true);
                    a[0] += (f32x4){p0.x, p0.y, p1.x, p1.y} * gk; a[1] += (f32x4){p2.x, p2.y, p3.x, p3.y} * gk;
                    a[2] += (f32x4){q0.x, q0.y, q1.x, q1.y} * gk; a[3] += (f32x4){q2.x, q2.y, q3.x, q3.y} * gk; }
#pragma unroll
                for (int j = 0; j < 4; ++j) v[u2][j] = xv[j] + *(const f32x4*)(g2 + NMC(j)) * a[j];
            } }
        float rinv[2];
#pragma unroll
        for (int u2 = 0; u2 < 2; ++u2) { float ss = 0.f;
#pragma unroll
            for (int j = 0; j < 4; ++j) ss += (v[u2][j].x * v[u2][j].x + v[u2][j].y * v[u2][j].y) + (v[u2][j].z * v[u2][j].z + v[u2][j].w * v[u2][j].w);
            rinv[u2] = __builtin_amdgcn_rsqf(wave_sum(ss) * (1.f / D) + NORM_EPS); }
#pragma unroll
        for (int u2 = 0; u2 < 2; ++u2) { const int r = ra + u2 * rstep; if (!live[u2]) continue;
            if (fin) {
#pragma unroll
                for (int j = 0; j < 4; ++j) *(f32x4*)(C.out + (size_t)r * D + NMC(j)) = v[u2][j] * rinv[u2] * *(const f32x4*)(gmain + NMC(j));
                continue; }
            if (layer != 0) { bf16* xw = WSP(bf16, WS_XRES) + (size_t)r * D;
                *(v4u*)(xw + 8 * C.lane) = (v4u){pk2(v[u2][0].x, v[u2][0].y), pk2(v[u2][0].z, v[u2][0].w), pk2(v[u2][1].x, v[u2][1].y), pk2(v[u2][1].z, v[u2][1].w)};
                *(v4u*)(xw + 512 + 8 * C.lane) = (v4u){pk2(v[u2][2].x, v[u2][2].y), pk2(v[u2][2].z, v[u2][2].w), pk2(v[u2][3].x, v[u2][3].y), pk2(v[u2][3].z, v[u2][3].w)}; }
            const float* sh = mod_vec(C, layer, mrow[u2], 0); const float* scl = mod_vec(C, layer, mrow[u2], 1);
            f32x4 hv4[4]; float mine = 0.f;
#pragma unroll
            for (int j = 0; j < 4; ++j) hv4[j] = v[u2][j] * rinv[u2] * *(const f32x4*)(gmain + NMC(j)) * (*(const f32x4*)(scl + NMC(j)) + 1.0f) + *(const f32x4*)(sh + NMC(j));
            { bf16* hr = WSP(bf16, WS_H) + (size_t)r * D;
              *(v4u*)(hr + 8 * C.lane) = (v4u){pk2(hv4[0].x, hv4[0].y), pk2(hv4[0].z, hv4[0].w), pk2(hv4[1].x, hv4[1].y), pk2(hv4[1].z, hv4[1].w)};
              *(v4u*)(hr + 512 + 8 * C.lane) = (v4u){pk2(hv4[2].x, hv4[2].y), pk2(hv4[2].z, hv4[2].w), pk2(hv4[3].x, hv4[3].y), pk2(hv4[3].z, hv4[3].w)}; }
#pragma unroll 2
            for (int i = 0; i < 16; ++i) { float pp = 0.f;
#pragma unroll
                for (int j = 0; j < 4; ++j) { const f32x4 w = *(const LAS f32x4*)(w16 + i * D + NMC(j)); pp += (hv4[j].x * w.x + hv4[j].y * w.y) + (hv4[j].z * w.z + hv4[j].w * w.w); }
                pp = wave_sum(pp); if (C.lane == i) mine = pp; }
            if (C.lane < 16) WSP(float, WS_BA)[(size_t)r * 16 + C.lane] = mine; }
        if (layer != 0) {
#pragma unroll
            for (int u2 = 0; u2 < 2; ++u2)
#pragma unroll
                for (int k = 0; k < 4; ++k) { s4[u2][k] = s4n[u2][k]; g4[u2][k] = g4n[u2][k]; } }
    }
#undef NMC
#undef NM_SLOTS
}

DEVI void u8f(const v4u& w, float (&x)[8]) { x[0] = bflo(w.x); x[1] = bfhi(w.x); x[2] = bflo(w.y); x[3] = bfhi(w.y); x[4] = bflo(w.z); x[5] = bfhi(w.z); x[6] = bflo(w.w); x[7] = bfhi(w.w); }
DEVI v4u f8u(const float (&x)[8]) { return (v4u){pk2(x[0], x[1]), pk2(x[2], x[3]), pk2(x[4], x[5]), pk2(x[6], x[7])}; }
DEVI void ph_attn_prep(const Ctx& C, int layer) {
    const bf16* proj = WSP(const bf16, WS_PROJ);
    bf16* QL = WSP(bf16, WS_QL); bf16* QC = WSP(bf16, WS_QC); bf16* KB = WSP(bf16, WS_K); bf16* VB = WSP(bf16, WS_V);
    const float* tab = WSP(const float, WS_ROPE);
    const int lane = C.lane, l7 = lane & 7, d0 = 8 * l7;
    constexpr float C2A = 0.125f * 1.4426950408889634f, C2D = 0.17677669529663687f * 1.4426950408889634f;
    float gA[8];
    { const float* gn = (lane < 32 ? INP(10) : INP(11)) + layer * 64 + d0;
#pragma unroll
      for (int e = 0; e < 8; ++e) gA[e] = gn[e]; }
    const bool lowA = d0 < 32; const int jA = d0 & 31;
    const int i0 = 8 * (lane & 3); const bool lowD = i0 < 16; const int iD = i0 & 15, mp = l7 >> 2;
    constexpr int RU = 2; const int rstep = C.G * 8;
    for (int rbase = C.bid * 8 + C.wave; rbase < T_ALL; rbase += RU * rstep) {
        v4u pa[RU], pc1[RU], pc2[RU]; f32x4 ca[RU][2], sa[RU][2], cd[RU][2], sd[RU][2];
#pragma unroll
        for (int u2 = 0; u2 < RU; ++u2) { const int rr = rbase + u2 * rstep; const int r = rr < T_ALL ? rr : rbase; const bf16* pr = proj + (size_t)r * N_PROJ;
            pa[u2] = *(const v4u*)(pr + 8 * lane); pc1[u2] = *(const v4u*)(pr + C_CQ + 8 * lane); pc2[u2] = *(const v4u*)(pr + C_CV + 8 * (lane & 31));
            const int t = r < T_L ? r % SEQ : 0;
            ca[u2][0] = *(const f32x4*)(tab + (size_t)t * 32 + jA); ca[u2][1] = *(const f32x4*)(tab + (size_t)t * 32 + jA + 4);
            sa[u2][0] = *(const f32x4*)(tab + (size_t)SEQ * 32 + (size_t)t * 32 + jA); sa[u2][1] = *(const f32x4*)(tab + (size_t)SEQ * 32 + (size_t)t * 32 + jA + 4);
            cd[u2][0] = *(const f32x4*)(tab + (size_t)SEQ * 64 + (size_t)t * 16 + iD); cd[u2][1] = *(const f32x4*)(tab + (size_t)SEQ * 64 + (size_t)t * 16 + iD + 4);
            sd[u2][0] = *(const f32x4*)(tab + (size_t)SEQ * 80 + (size_t)t * 16 + iD); sd[u2][1] = *(const f32x4*)(tab + (size_t)SEQ * 80 + (size_t)t * 16 + iD + 4); }
#pragma unroll
        for (int u2 = 0; u2 < RU; ++u2) { const int r = rbase + u2 * rstep; if (r >= T_ALL) continue;
            const bool lat = r < T_L; const int b = lat ? r / SEQ : (r - T_L) / LC; const int t = lat ? r % SEQ : (r - T_L) % LC; const int pos = lat ? t : SEQ + t;
            { float x[8]; u8f(pa[u2], x);
              if (lane < 48) { float ss = 0.f;
#pragma unroll
                  for (int e = 0; e < 8; ++e) ss += x[e] * x[e];
                  const float rinv = __builtin_amdgcn_rsqf(group_sum<8>(ss) * (1.f / 64.f) + NORM_EPS);
#pragma unroll
                  for (int e = 0; e < 8; ++e) x[e] *= rinv * gA[e]; }
              float o[8];
#pragma unroll
              for (int e = 0; e < 8; ++e) { const float pe = __shfl_xor(x[e], 4); const float c = lat ? ca[u2][e >> 2][e & 3] : 1.f, s = lat ? sa[u2][e >> 2][e & 3] : 0.f;
                  o[e] = lowA ? x[e] * c - pe * s : pe * s + x[e] * c; }
              if (lane < 32) { const int hq = lane >> 3;
#pragma unroll
                  for (int e = 0; e < 8; ++e) o[e] *= C2A;
                  bf16* q = lat ? QL + ((size_t)(b * 12 + hq) * SEQ + t) * 64 : QC + ((size_t)(b * 12 + hq) * LC + t) * 64; *(v4u*)(q + d0) = f8u(o); }
              else if (lane < 48) { const int kvh = (lane - 32) >> 3; *(v4u*)(KB + ((size_t)(b * 6 + kvh) * NKEY + pos) * 64 + d0) = f8u(o); }
              else { const int kvh = (lane - 48) >> 3; *(v4u*)(VB + ((size_t)(b * 6 + kvh) * NKEY + pos) * 64 + d0) = pa[u2]; } }
            { float x[8]; u8f(pc1[u2], x); float o[8];
#pragma unroll
              for (int e = 0; e < 8; ++e) { const float pe = __shfl_xor(x[e], 2); const float c = lat ? cd[u2][e >> 2][e & 3] : 1.f, s = lat ? sd[u2][e >> 2][e & 3] : 0.f;
                  o[e] = lowD ? x[e] * c - pe * s : pe * s + x[e] * c; }
              const int hc = (lane & 31) >> 3;
              if (lane < 32) { const int vh = 4 + 2 * hc + mp;
#pragma unroll
                  for (int e = 0; e < 8; ++e) o[e] *= C2D;
                  bf16* q = lat ? QL + ((size_t)(b * 12 + vh) * SEQ + t) * 64 : QC + ((size_t)(b * 12 + vh) * LC + t) * 64;
                  *(v4u*)(q + mp * 32 + i0) = f8u(o); *(v4u*)(q + (1 - mp) * 32 + i0) = (v4u){0u, 0u, 0u, 0u}; }
              else { *(v4u*)(KB + ((size_t)(b * 6 + 2 + hc) * NKEY + pos) * 64 + d0) = f8u(o); } }
            if (lane < 32) { const int hv = lane >> 3; *(v4u*)(VB + ((size_t)(b * 6 + 2 + hv) * NKEY + pos) * 64 + d0) = pc2[u2]; }
        }
    }
}

DEVI void ph_gmlp(const Ctx& C, int layer, int ntok) {
    constexpr int VP = 136, SP = 68;
    LAS bf16* vnT = (LAS bf16*)C.lds;
    LAS float* rinv = (LAS float*)(vnT + 64 * VP);
    LAS float* spT = rinv + 128;
    const bf16* proj = WSP(const bf16, WS_PROJ); bf16* mix = WSP(bf16, WS_MIX);
    const float* gvn = INP(12) + layer * 256;
    const int tid0 = C.tid;
    constexpr int NSCAN = NB * 16; const int total = (ntok / 128) * 4; const bool split = C.G > NSCAN && total > 2 * NSCAN;
    const int ufirst = !split ? C.bid : (C.bid < NSCAN ? C.bid : 2 * NSCAN + (C.bid - NSCAN)), ustride = !split ? C.G : (C.bid < NSCAN ? NSCAN : C.G - NSCAN), uend = (split && C.bid < NSCAN) ? 2 * NSCAN : total;
    for (int u = ufirst; u < uend; u += ustride) {
        int tid = tid0; LAUNDER_V(tid);
        const int chunk = u >> 2, g = u & 3; const int row0 = chunk * 128;
        const int lane = tid & 63, wv = __builtin_amdgcn_readfirstlane(tid >> 6), l15 = lane & 15, q = lane >> 4;
        bf16x8 afr[4];
        { const float* wsr = INP(13) + ((size_t)layer * 4 + g) * 128 * 128 + (size_t)(16 * wv + l15) * 128 + 8 * q;
#pragma unroll
          for (int kk = 0; kk < 4; ++kk) { const f32x4 a0 = *(const f32x4*)(wsr + 32 * kk), a1 = *(const f32x4*)(wsr + 32 * kk + 4);
              const v4u ap = {pk2(a0.x, a0.y), pk2(a0.z, a0.w), pk2(a1.x, a1.y), pk2(a1.z, a1.w)}; afr[kk] = __builtin_bit_cast(bf16x8, ap); } }
        { const int tok = tid >> 2, qd = tid & 3; const bf16* p = proj + (size_t)(row0 + tok) * N_PROJ + C_BV + qd * 64; float ss = 0.f;
#pragma unroll
          for (int c8 = 0; c8 < 8; ++c8) { const v4u w = *(const v4u*)(p + c8 * 8);
              const float a0 = gelu_tanh(bflo(w.x)), a1 = gelu_tanh(bfhi(w.x)), a2 = gelu_tanh(bflo(w.y)), a3 = gelu_tanh(bfhi(w.y)), a4 = gelu_tanh(bflo(w.z)), a5 = gelu_tanh(bfhi(w.z)), a6 = gelu_tanh(bflo(w.w)), a7 = gelu_tanh(bfhi(w.w));
              ss += (a0 * a0 + a1 * a1) + (a2 * a2 + a3 * a3) + (a4 * a4 + a5 * a5) + (a6 * a6 + a7 * a7); }
          ss = group_sum<4>(ss); if (qd == 0) rinv[tok] = __builtin_amdgcn_rsqf(ss * (1.f / 256.f) + NORM_EPS); }
        __syncthreads();
        { const int tok = tid >> 2, c0 = (tid & 3) * 16; const bf16* p = proj + (size_t)(row0 + tok) * N_PROJ + C_BV + g * 64 + c0; const float ri = rinv[tok];
          const v4u w0 = *(const v4u*)p, w1 = *(const v4u*)(p + 8); const unsigned ww[8] = {w0.x, w0.y, w0.z, w0.w, w1.x, w1.y, w1.z, w1.w};
#pragma unroll
          for (int c = 0; c < 16; ++c) { const float x = (c & 1) ? bfhi(ww[c >> 1]) : bflo(ww[c >> 1]); vnT[(c0 + c) * VP + tok] = (bf16)f2bf(gelu_tanh(x) * ri * gvn[g * 64 + c0 + c]); } }
        __syncthreads();
        { f32x4 acc[4];
#pragma unroll
          for (int n = 0; n < 4; ++n) acc[n] = (f32x4){0.f, 0.f, 0.f, 0.f};
#pragma unroll
          for (int kk = 0; kk < 4; ++kk)
#pragma unroll
              for (int n = 0; n < 4; ++n) acc[n] = __builtin_amdgcn_mfma_f32_16x16x32_bf16(afr[kk], *(const LAS bf16x8*)(vnT + (16 * n + l15) * VP + 32 * kk + 8 * q), acc[n], 0, 0, 0);
          const float* bs = INP(14) + ((size_t)layer * 4 + g) * 128;
#pragma unroll
          for (int r = 0; r < 4; ++r) { const int tok = 16 * wv + 4 * q + r; const float bb = bs[tok];
#pragma unroll
              for (int n = 0; n < 4; ++n) spT[tok * SP + 16 * n + l15] = acc[n][r] + bb; } }
        __syncthreads();
        { const int tok = tid >> 2, c0 = (tid & 3) * 16; const size_t rowp = (size_t)(row0 + tok);
          const bf16* pu = proj + rowp * N_PROJ + C_BU + g * 64 + c0; const v4u u0 = *(const v4u*)pu, u1 = *(const v4u*)(pu + 8); const unsigned uw[8] = {u0.x, u0.y, u0.z, u0.w, u1.x, u1.y, u1.z, u1.w};
          float o[16];
#pragma unroll
          for (int c4 = 0; c4 < 4; ++c4) { const f32x4 sp = *(const LAS f32x4*)(spT + tok * SP + c0 + 4 * c4);
              o[4 * c4 + 0] = gelu_tanh(bflo(uw[2 * c4])) * sp.x; o[4 * c4 + 1] = gelu_tanh(bfhi(uw[2 * c4])) * sp.y; o[4 * c4 + 2] = gelu_tanh(bflo(uw[2 * c4 + 1])) * sp.z; o[4 * c4 + 3] = gelu_tanh(bfhi(uw[2 * c4 + 1])) * sp.w; }
          bf16* po = mix + rowp * D + 256 + g * 64 + c0;
          *(v4u*)po = (v4u){pk2(o[0], o[1]), pk2(o[2], o[3]), pk2(o[4], o[5]), pk2(o[6], o[7])}; *(v4u*)(po + 8) = (v4u){pk2(o[8], o[9]), pk2(o[10], o[11]), pk2(o[12], o[13]), pk2(o[14], o[15])}; }
        __syncthreads();
    }
}

DEVI int dn_kmap(int kk, int q, int j) { return 16 * (2 * kk + (j >> 2)) + 4 * q + (j & 3); }
DEVI size_t dn_unit_off(int b, int dir, int h, int sc) { return ((size_t)((b * 2 + dir) * 4 + h) * NCH + sc) * DN_UNIT_BYTES; }
constexpr int DP = 68, XP = 132, HP = 72;
DEVI f32x4 mfma16(bf16x8 a, bf16x8 b, f32x4 c) { return __builtin_amdgcn_mfma_f32_16x16x32_bf16(a, b, c, 0, 0, 0); }
#ifndef D1REP
#define D1REP 0
#endif
#define DN_BAR() asm volatile("s_waitcnt lgkmcnt(0)\n\ts_barrier" ::: "memory")
DEVI void ph_dn_chunk(const Ctx& C, int layer) {
    LAS bf16* kN = (LAS bf16*)C.lds;
    LAS bf16* qN = kN + 64 * HP;
    LAS bf16* kT = qN + 64 * HP;
    LAS bf16* QKd = kT + 64 * HP;
    LAS bf16* RT = QKd + 64 * HP;
    LAS bf16* XT = RT;
    LAS bf16* TiB = RT + 128 * HP;
    LAS float* Am = (LAS float*)(TiB + 64 * HP);
    LAS float* TI = Am + 64 * DP;
    LAS bf16* XdT = (LAS bf16*)Am;
    LAS float* TMP = TI + 64 * DP;
    LAS float* vec = TMP + 1280;
    LAS float* betav = vec; LAS float* cum = vec + 64; LAS float* ecum = vec + 128; LAS float* dvec = vec + 192; LAS float* bec = vec + 256;
    LAS float* cwl = vec + 320;
    LAS float* gpar = cwl + 2304;
    static_assert(128 * HP * 2 <= 2 * 64 * DP * 4 && (4 * 64 * HP + 128 * HP + 64 * HP) * 2 + (2 * 64 * DP + 1280 + 320 + 2304 + 16) * 4 <= MISC_OFF, "D1 LDS");
    const bf16* proj = WSP(const bf16, WS_PROJ); const float* BA = WSP(const float, WS_BA);
    { const float* cwg = INP(20) + (size_t)layer * 3 * 768; for (int i = C.tid; i < 2304; i += 512) cwl[i] = cwg[i];
      if (C.tid < 8) gpar[C.tid] = -fast_exp(INP(21)[layer * 8 + C.tid]); else if (C.tid < 16) gpar[C.tid] = INP(22)[layer * 8 + C.tid - 8]; }
    __syncthreads();
    const LAS float* cw = cwl;
    const int tid0 = C.tid;
#define FRESH_TID() int tid = tid0; LAUNDER_V(tid)
#define DN_DECODE(u_) const int tcx = (u_) % NCH, h = ((u_) / NCH) & 3, dir = ((u_) / (NCH * 4)) & 1, b = (u_) / (NCH * 8); \
        const bool isc = tcx < NCH_C; const int tc = isc ? tcx : tcx - NCH_C; const int nch = isc ? NCH_C : NCH_L; const int len = nch * 64; \
        const int row_seq0 = isc ? T_L + b * LC : b * SEQ
    v4u rw[3][3]; float rb0 = 0.f, rb1 = 0.f, rb2 = 0.f;
#define DN_LOAD(u_) do { if ((u_) < NB * 2 * 4 * NCH) { DN_DECODE(u_); int t_ = tid0; LAUNDER_V(t_); const int c = t_ >> 3, d0 = (t_ & 7) * 8; const int tl = tc * 64 + (dir ? 63 - c : c); const size_t r = (size_t)row_seq0 + tl; \
        const bool hp = tl > 0, hn = tl < len - 1; \
        _Pragma("unroll") for (int w3 = 0; w3 < 3; ++w3) { const bf16* p = proj + r * N_PROJ + C_DQKV + w3 * 256 + h * 64 + d0; \
            rw[w3][1] = *(const v4u*)p; rw[w3][0] = (v4u){0u, 0u, 0u, 0u}; rw[w3][2] = (v4u){0u, 0u, 0u, 0u}; if (hp) rw[w3][0] = *(const v4u*)(p - N_PROJ); if (hn) rw[w3][2] = *(const v4u*)(p + N_PROJ); } \
        rb0 = BA[r * 16 + dir * 4 + h]; \
        if (t_ < 64) { const int tl2 = tc * 64 + (dir ? 63 - t_ : t_); const float* ba = BA + ((size_t)row_seq0 + tl2) * 16; rb1 = ba[dir * 4 + h]; rb2 = ba[8 + dir * 4 + h]; } } } while (0)
    DN_LOAD(C.bid);
    for (int u = C.bid; u < NB * 2 * 4 * NCH; u += C.G) {
        DN_DECODE(u);
        const int sc = (isc ? 0 : NCH_C) + (dir ? nch - 1 - tc : tc);
        { FRESH_TID(); const int c = tid >> 3, part = tid & 7, d0 = part * 8;
          float y[3][8];
#pragma unroll
          for (int w3 = 0; w3 < 3; ++w3) { const int col = w3 * 256 + h * 64 + d0;
              const v4u xc = rw[w3][1], xp = rw[w3][0], xn = rw[w3][2];
              const unsigned xcw[4] = {xc.x, xc.y, xc.z, xc.w}, xpw[4] = {xp.x, xp.y, xp.z, xp.w}, xnw[4] = {xn.x, xn.y, xn.z, xn.w};
#pragma unroll
              for (int e = 0; e < 8; ++e) { const float a = (e & 1) ? bfhi(xpw[e >> 1]) : bflo(xpw[e >> 1]), m = (e & 1) ? bfhi(xcw[e >> 1]) : bflo(xcw[e >> 1]), n = (e & 1) ? bfhi(xnw[e >> 1]) : bflo(xnw[e >> 1]);
                  y[w3][e] = siluf_(cw[col + e] * a + cw[768 + col + e] * m + cw[1536 + col + e] * n); } }
          const float ba_b = rb0, ba_b2 = rb1, ba_a2 = rb2;
          DN_LOAD(u + C.G);
          float sq = 0.f, sk = 0.f;
#pragma unroll
          for (int e = 0; e < 8; ++e) { sq += y[0][e] * y[0][e]; sk += y[1][e] * y[1][e]; }
          sq = group_sum<8>(sq); sk = group_sum<8>(sk);
          const float rq = __builtin_amdgcn_rsqf(sq + NORM_EPS) * 0.125f, rk = __builtin_amdgcn_rsqf(sk + NORM_EPS);
          const float betac = sigmoidf_(ba_b);
#pragma unroll
          for (int e = 0; e < 8; ++e) { y[0][e] *= rq; y[1][e] *= rk; kT[(d0 + e) * HP + c] = (bf16)f2bf(y[1][e]); RT[(d0 + e) * HP + c] = (bf16)f2bf(betac * y[2][e]); }
          *(LAS v4u*)(qN + c * HP + d0) = (v4u){pk2(y[0][0], y[0][1]), pk2(y[0][2], y[0][3]), pk2(y[0][4], y[0][5]), pk2(y[0][6], y[0][7])};
          *(LAS v4u*)(kN + c * HP + d0) = (v4u){pk2(y[1][0], y[1][1]), pk2(y[1][2], y[1][3]), pk2(y[1][4], y[1][5]), pk2(y[1][6], y[1][7])};
          *(LAS v4u*)(QKd + c * HP + d0) = (v4u){0u, 0u, 0u, 0u};
          { LAS f32x4* z = (LAS f32x4*)TI; z[tid] = (f32x4){0.f, 0.f, 0.f, 0.f}; z[tid + 512] = (f32x4){0.f, 0.f, 0.f, 0.f}; if (tid < 64) z[tid + 1024] = (f32x4){0.f, 0.f, 0.f, 0.f}; }
          if (tid < 64) { const int c2 = tid;
              const float bt = sigmoidf_(ba_b2);
              float sg = gpar[dir * 4 + h] * softplusf_(ba_a2 + gpar[8 + dir * 4 + h]);
#pragma unroll
              for (int o = 1; o < 64; o <<= 1) { const float t = __shfl_up(sg, o); if (c2 >= o) sg += t; }
              const float G = __shfl(sg, 63); const float ec = fast_exp(sg);
              betav[c2] = bt; cum[c2] = sg; ecum[c2] = ec; dvec[c2] = fast_exp(G - sg); bec[c2] = bt * ec; } }
        DN_BAR();
        for (int rp_ = 0; rp_ < 1 + (((D1REP) >> 1) & 1); ++rp_) {
        { FRESH_TID(); const int lane = tid & 63, wv = __builtin_amdgcn_readfirstlane(tid >> 6), l15 = lane & 15, q = lane >> 4;
          { const int k = tid >> 3, c0 = (tid & 7) * 8; const v4u kk4 = *(const LAS v4u*)(kT + k * HP + c0); const unsigned kw[4] = {kk4.x, kk4.y, kk4.z, kk4.w}; unsigned ow[4];
#pragma unroll
            for (int e = 0; e < 4; ++e) ow[e] = pk2(bflo(kw[e]) * bec[c0 + 2 * e], bfhi(kw[e]) * bec[c0 + 2 * e + 1]);
            *(LAS v4u*)(RT + (64 + k) * HP + c0) = (v4u){ow[0], ow[1], ow[2], ow[3]}; }
#pragma unroll
          for (int tt = 0; tt < 3; ++tt) { const int t = wv + 8 * tt; if (t >= 20) break;
              const bool isq = t >= 10; const int idx = isq ? t - 10 : t; const int ti = (idx >= 6) ? 3 : (idx >= 3) ? 2 : (idx >= 1) ? 1 : 0; const int tj = idx - ti * (ti + 1) / 2;
              const LAS bf16* asrc = (isq ? qN : kN) + (16 * ti + l15) * HP + 8 * q; const LAS bf16* bsrc = kN + (16 * tj + l15) * HP + 8 * q;
              f32x4 acc = {0.f, 0.f, 0.f, 0.f};
              acc = mfma16(*(const LAS bf16x8*)asrc, *(const LAS bf16x8*)bsrc, acc); acc = mfma16(*(const LAS bf16x8*)(asrc + 32), *(const LAS bf16x8*)(bsrc + 32), acc);
              const int j = 16 * tj + l15; const float cj = cum[j];
#pragma unroll
              for (int r = 0; r < 4; ++r) { const int i = 16 * ti + 4 * q + r; const float dec = fast_exp(cum[i] - cj);
                  if (isq) QKd[i * HP + j] = (bf16)f2bf((i >= j) ? acc[r] * dec : 0.f); else Am[i * DP + j] = (i > j) ? acc[r] * dec * betav[i] : 0.f; } } }
        DN_BAR();
        }
        for (int rp_ = 0; rp_ < 1 + (((D1REP) >> 2) & 1); ++rp_) {
        { FRESH_TID(); if (tid < 64) { const int bb = tid >> 4, col = tid & 15; float x[16];
#pragma unroll
            for (int r = 0; r < 16; ++r) { float s = (r == col) ? 1.f : 0.f;
#pragma unroll
                for (int s2 = 0; s2 < r; ++s2) s -= Am[(16 * bb + r) * DP + 16 * bb + s2] * x[s2];
                x[r] = s; }
#pragma unroll
            for (int r = 0; r < 16; ++r) TI[(16 * bb + r) * DP + 16 * bb + col] = x[r]; } }
        DN_BAR();
        }
        for (int rp_ = 0; rp_ < 1 + (((D1REP) >> 3) & 1); ++rp_) {
        { FRESH_TID(); const int p = tid >> 8, r = (tid >> 4) & 15, c = tid & 15; float e = 0.f;
#pragma unroll
          for (int s2 = 0; s2 < 16; ++s2) e += Am[(32 * p + 16 + r) * DP + 32 * p + s2] * TI[(32 * p + s2) * DP + 32 * p + c];
          TMP[(p * 16 + r) * 17 + c] = e;
          DN_BAR();
          float f = 0.f;
#pragma unroll
          for (int s2 = 0; s2 < 16; ++s2) f -= TI[(32 * p + 16 + r) * DP + 32 * p + 16 + s2] * TMP[(p * 16 + s2) * 17 + c];
          TI[(32 * p + 16 + r) * DP + 32 * p + c] = f; }
        DN_BAR();
        }
        for (int rp_ = 0; rp_ < 1 + (((D1REP) >> 4) & 1); ++rp_) {
        { FRESH_TID(); const int r = tid >> 4, c2 = (tid & 15) * 2; float e0 = 0.f, e1 = 0.f;
#pragma unroll 8
          for (int s2 = 0; s2 < 32; ++s2) { const float a = Am[(32 + r) * DP + s2]; e0 += a * TI[s2 * DP + c2]; e1 += a * TI[s2 * DP + c2 + 1]; }
          TMP[r * 36 + c2] = e0; TMP[r * 36 + c2 + 1] = e1;
          DN_BAR();
          float f0 = 0.f, f1 = 0.f;
#pragma unroll 8
          for (int s2 = 0; s2 < 32; ++s2) { const float a = TI[(32 + r) * DP + 32 + s2]; f0 -= a * TMP[s2 * 36 + c2]; f1 -= a * TMP[s2 * 36 + c2 + 1]; }
          TI[(32 + r) * DP + c2] = f0; TI[(32 + r) * DP + c2 + 1] = f1; }
        DN_BAR();
        }
        for (int rp_ = 0; rp_ < 1 + (((D1REP) >> 5) & 1); ++rp_) {
        { FRESH_TID(); const int c = tid >> 3, c0 = (tid & 7) * 8; float x[8];
#pragma unroll
          for (int e = 0; e < 8; ++e) x[e] = (c0 + e <= c) ? TI[c * DP + c0 + e] : 0.f;
          *(LAS v4u*)(TiB + c * HP + c0) = (v4u){pk2(x[0], x[1]), pk2(x[2], x[3]), pk2(x[4], x[5]), pk2(x[6], x[7])}; }
        DN_BAR();
        }
        { FRESH_TID(); const int lane = tid & 63, wv = __builtin_amdgcn_readfirstlane(tid >> 6), l15 = lane & 15, q = lane >> 4;
          f32x4 xa[4]; const LAS bf16* bsrc = RT + (16 * wv + l15) * HP + 8 * q; const bf16x8 b0 = *(const LAS bf16x8*)bsrc, b1 = *(const LAS bf16x8*)(bsrc + 32);
#pragma unroll
          for (int m = 0; m < 4; ++m) { const LAS bf16* asrc = TiB + (16 * m + l15) * HP + 8 * q; f32x4 a_ = {0.f, 0.f, 0.f, 0.f};
              a_ = mfma16(*(const LAS bf16x8*)asrc, b0, a_); xa[m] = mfma16(*(const LAS bf16x8*)(asrc + 32), b1, a_); }
          DN_BAR();
          const int col = 16 * wv + l15;
#pragma unroll
          for (int m = 0; m < 4; ++m) { const int c0 = 16 * m + 4 * q; const f32x4 x = xa[m];
              *(LAS v2u*)(XT + col * HP + c0) = (v2u){pk2(x.x, x.y), pk2(x.z, x.w)};
              *(LAS v2u*)(XdT + col * HP + c0) = (v2u){pk2(x.x * dvec[c0], x.y * dvec[c0 + 1]), pk2(x.z * dvec[c0 + 2], x.w * dvec[c0 + 3])}; } }
        DN_BAR();
        for (int rp_ = 0; rp_ < 1 + (((D1REP) >> 7) & 1); ++rp_) {
        { FRESH_TID(); const int lane = tid & 63, wv = __builtin_amdgcn_readfirstlane(tid >> 6), l15 = lane & 15, q = lane >> 4;
          unsigned char* ub = WSP(unsigned char, WS_DNF + dn_unit_off(b, dir, h, sc));
          const float eG = ecum[63];
#define DN_MM(dst, Ap, Bp) do { f32x4 a_ = {0.f, 0.f, 0.f, 0.f}; a_ = mfma16(*(const LAS bf16x8*)(Ap), *(const LAS bf16x8*)(Bp), a_); dst = mfma16(*(const LAS bf16x8*)((Ap) + 32), *(const LAS bf16x8*)((Bp) + 32), a_); } while (0)
#pragma unroll
          for (int t2 = 0; t2 < 2; ++t2) { const int t = 2 * wv + t2, m = t >> 2, n = t & 3; f32x4 acc;
              DN_MM(acc, kT + (16 * m + l15) * HP + 8 * q, XdT + (16 * n + l15) * HP + 8 * q);
              *(v2u*)(ub + 16384 + (size_t)((n * 4 + m) * 64 + lane) * 8) = (v2u){pk2(acc.x, acc.y), pk2(acc.z, acc.w)};
              DN_MM(acc, QKd + (16 * m + l15) * HP + 8 * q, XT + (16 * n + l15) * HP + 8 * q);
              *(v2u*)(ub + 24576 + (size_t)((n * 4 + m) * 64 + lane) * 8) = (v2u){pk2(acc.x, acc.y), pk2(acc.z, acc.w)}; }
          { const int n = wv >> 1, kk2 = wv & 1; f32x4 z0, z1, y0, y1;
            DN_MM(z0, XdT + (64 + 16 * (2 * kk2) + l15) * HP + 8 * q, kT + (16 * n + l15) * HP + 8 * q);
            DN_MM(z1, XdT + (64 + 16 * (2 * kk2 + 1) + l15) * HP + 8 * q, kT + (16 * n + l15) * HP + 8 * q);
            DN_MM(y0, XT + (64 + 16 * (2 * kk2) + l15) * HP + 8 * q, QKd + (16 * n + l15) * HP + 8 * q);
            DN_MM(y1, XT + (64 + 16 * (2 * kk2 + 1) + l15) * HP + 8 * q, QKd + (16 * n + l15) * HP + 8 * q);
            const int rowi = 16 * n + l15; float mv[8], qv[8]; const float ec = ecum[rowi];
#pragma unroll
            for (int e = 0; e < 8; ++e) { const int kp = 16 * (2 * kk2 + (e >> 2)) + 4 * q + (e & 3); const float zz = (e < 4) ? z0[e & 3] : z1[e & 3], yy = (e < 4) ? y0[e & 3] : y1[e & 3];
                mv[e] = ((kp == rowi) ? eG : 0.f) - zz; qv[e] = ec * bf2f(qN[rowi * HP + kp]) - yy; }
            *(v4u*)(ub + (size_t)((n * 2 + kk2) * 64 + lane) * 16) = (v4u){pk2(mv[0], mv[1]), pk2(mv[2], mv[3]), pk2(mv[4], mv[5]), pk2(mv[6], mv[7])};
            *(v4u*)(ub + 8192 + (size_t)((n * 2 + kk2) * 64 + lane) * 16) = (v4u){pk2(qv[0], qv[1]), pk2(qv[2], qv[3]), pk2(qv[4], qv[5]), pk2(qv[6], qv[7])}; }
#undef DN_MM
        }
        DN_BAR();
        }
    }
}
#undef FRESH_TID
#undef DN_BAR
#undef DN_LOAD
#undef DN_DECODE
DEVI bf16x8 dn_pack(const f32x4& a, const f32x4& b) { const v4u o = {pk2(a.x, a.y), pk2(a.z, a.w), pk2(b.x, b.y), pk2(b.z, b.w)}; return __builtin_bit_cast(bf16x8, o); }
#define SCAN_BAR() asm volatile("s_waitcnt lgkmcnt(0)\n\ts_barrier" ::: "memory")
DEVI unsigned cvtpk(float lo, float hi) { return pk2(lo, hi); }
DEVI bf16x8 dn_pack_hw(const f32x4& a, const f32x4& b) { const v4u o = {cvtpk(a.x, a.y), cvtpk(a.z, a.w), cvtpk(b.x, b.y), cvtpk(b.z, b.w)}; return __builtin_bit_cast(bf16x8, o); }
DEVI void ph_dn_scan(const Ctx& C, int layer) {
    constexpr int SLOTB = 24576, NS = 4, P = 8, NLD = 384, NPC = 4;
    static_assert(NCH % P == 0 || NCH % P == P / 2, "scan pipeline depth: whole groups of P steps plus at most one half group");
    const int lane = C.lane, q = lane >> 4, v16 = lane & 15;
    bf16* DNO = WSP(bf16, WS_DNO);
    for (int u = C.bid; u < NB * 2 * 4 * 2; u += C.G) {
        const int vp = u & 1, h = (u >> 1) & 3, dir = (u >> 3) & 1, b = u >> 4;
        const unsigned char* base = WSP(const unsigned char, WS_DNF + dn_unit_off(b, dir, h, 0));
        if (C.wave < 2) {
            const int vs = 2 * vp + C.wave;
            bf16x8 sf[2]; { const v4u z = {0u, 0u, 0u, 0u}; sf[0] = __builtin_bit_cast(bf16x8, z); sf[1] = sf[0]; }
            bf16* ob = DNO + (size_t)dir * T_ALL * 256 + h * 64 + vs * 16 + v16;
            SCAN_BAR();
#define SCAN_SEG(SGN, SC0, NCHS, SEQ0, LEN) do { \
            bf16* pm[4]; \
            _Pragma("unroll") for (int m = 0; m < 4; ++m) pm[m] = ob + ((long)(SEQ0) + ((SGN) < 0 ? (LEN) - 1 : 0) + (SGN) * (16 * m + 4 * q)) * 256; \
            _Pragma("unroll 1") for (int s2 = 0; s2 < (NCHS); ++s2) { \
                const LAS unsigned char* sl = C.lds + (((SC0) + s2) % NS) * SLOTB; \
                f32x4 o[4], d[4]; \
                _Pragma("unroll") for (int m = 0; m < 4; ++m) { \
                    const bf16x8 ma0 = *(const LAS bf16x8*)(sl + ((m * 2 + 0) * 64 + lane) * 16), ma1 = *(const LAS bf16x8*)(sl + ((m * 2 + 1) * 64 + lane) * 16); \
                    const bf16x8 qa0 = *(const LAS bf16x8*)(sl + 8192 + ((m * 2 + 0) * 64 + lane) * 16), qa1 = *(const LAS bf16x8*)(sl + 8192 + ((m * 2 + 1) * 64 + lane) * 16); \
                    const v2u ncp = *(const LAS v2u*)(sl + 16384 + ((C.wave * 4 + m) * 64 + lane) * 8), ocp = *(const LAS v2u*)(sl + 20480 + ((C.wave * 4 + m) * 64 + lane) * 8); \
                    const f32x4 nc = {bflo(ncp.x), bfhi(ncp.x), bflo(ncp.y), bfhi(ncp.y)}, oc = {bflo(ocp.x), bfhi(ocp.x), bflo(ocp.y), bfhi(ocp.y)}; \
                    d[m] = __builtin_amdgcn_mfma_f32_16x16x32_bf16(ma0, sf[0], nc, 0, 0, 0); d[m] = __builtin_amdgcn_mfma_f32_16x16x32_bf16(ma1, sf[1], d[m], 0, 0, 0); \
                    o[m] = __builtin_amdgcn_mfma_f32_16x16x32_bf16(qa0, sf[0], oc, 0, 0, 0); o[m] = __builtin_amdgcn_mfma_f32_16x16x32_bf16(qa1, sf[1], o[m], 0, 0, 0); } \
                sf[0] = dn_pack_hw(d[0], d[1]); sf[1] = dn_pack_hw(d[2], d[3]); \
                _Pragma("unroll") for (int m = 0; m < 4; ++m) { \
                    _Pragma("unroll") for (int i = 0; i < 4; ++i) pm[m][(SGN) * i * 256] = (bf16)f2bf(o[m][i]); \
                    pm[m] += (SGN) * 64 * 256; } \
                SCAN_BAR(); } } while (0)
            if (dir == 0) { SCAN_SEG(1, 0, NCH_C, T_L + b * LC, LC); SCAN_SEG(1, NCH_C, NCH_L, b * SEQ, SEQ); }
            else          { SCAN_SEG(-1, 0, NCH_C, T_L + b * LC, LC); SCAN_SEG(-1, NCH_C, NCH_L, b * SEQ, SEQ); }
#undef SCAN_SEG
        } else {
            const int lid = C.tid - 128;
            unsigned so[NPC], dofs[NPC];
#pragma unroll
            for (int i = 0; i < NPC; ++i) { const int pp = lid + NLD * i;
                so[i] = (pp < 1024) ? (unsigned)pp * 16u : (pp < 1280) ? 16384u + (unsigned)(vp * 256 + (pp - 1024)) * 16u : 24576u + (unsigned)(vp * 256 + (pp - 1280)) * 16u; dofs[i] = (unsigned)pp * 16u; }
            v4u buf[P][NPC];
#pragma unroll
            for (int s2 = 0; s2 < P; ++s2)
#pragma unroll
                for (int i = 0; i < NPC; ++i) buf[s2][i] = *(const v4u*)(base + (size_t)s2 * DN_UNIT_BYTES + so[i]);
#pragma unroll
            for (int i = 0; i < NPC; ++i) *(LAS v4u*)(C.lds + dofs[i]) = buf[0][i];
            SCAN_BAR();
#define SCAN_LD_STEP(j) do { const int step = sc + (j); const int nxt = (step + P < NCH) ? step + P : NCH - 1; \
                    _Pragma("unroll") for (int i = 0; i < NPC; ++i) buf[(j)][i] = *(const v4u*)(base + (size_t)nxt * DN_UNIT_BYTES + so[i]); \
                    LAS unsigned char* sl = C.lds + ((step + 1) % NS) * SLOTB; \
                    _Pragma("unroll") for (int i = 0; i < NPC; ++i) *(LAS v4u*)(sl + dofs[i]) = buf[((j) + 1) % P][i]; \
                    SCAN_BAR(); } while (0)
            int sc = 0;
#pragma unroll 1
            for (; sc + P <= NCH; sc += P) {
#pragma unroll
                for (int j = 0; j < P; ++j) SCAN_LD_STEP(j);
            }
            if (NCH % P) {
#pragma unroll
                for (int j = 0; j < P / 2; ++j) SCAN_LD_STEP(j);
            }
#undef SCAN_LD_STEP
        }
    }
}
#undef SCAN_BAR

DEVI void ph_finalize(const Ctx& C, int layer, int ntok) {
    const int lane = C.lane;
    const bf16* DNO = WSP(const bf16, WS_DNO); const bf16* proj = WSP(const bf16, WS_PROJ); bf16* mix = WSP(bf16, WS_MIX);
    const f32x4 ong = *(const f32x4*)(INP(23) + layer * 64 + ((4 * lane) & 63));
    constexpr int RU = 4; const int rstep = C.G * 8;
    for (int r0 = C.bid * 8 + C.wave; r0 < ntok; r0 += RU * rstep) {
        v2u zz[RU], d0[RU], d1[RU];
#pragma unroll
        for (int u2 = 0; u2 < RU; ++u2) { const int rr = r0 + u2 * rstep; const size_t r = rr < ntok ? rr : r0;
            d0[u2] = *(const v2u*)(DNO + r * 256 + 4 * lane); d1[u2] = *(const v2u*)(DNO + ((size_t)T_ALL + r) * 256 + 4 * lane);
            zz[u2] = *(const v2u*)(proj + r * N_PROJ + C_DZ + 4 * lane); }
#pragma unroll
        for (int u2 = 0; u2 < RU; ++u2) { const int rr = r0 + u2 * rstep; if (rr >= ntok) continue; const size_t r = rr;
            const f32x4 od = (f32x4){bflo(d0[u2].x), bfhi(d0[u2].x), bflo(d0[u2].y), bfhi(d0[u2].y)} + (f32x4){bflo(d1[u2].x), bfhi(d1[u2].x), bflo(d1[u2].y), bfhi(d1[u2].y)};
            const float ss = group_sum<16>((od.x * od.x + od.y * od.y) + (od.z * od.z + od.w * od.w));
            const float rinv = __builtin_amdgcn_rsqf(ss * (1.f / 64.f) + NORM_EPS);
            const f32x4 z = (f32x4){siluf_(bflo(zz[u2].x)), siluf_(bfhi(zz[u2].x)), siluf_(bflo(zz[u2].y)), siluf_(bfhi(zz[u2].y))};
            const f32x4 o = od * rinv * ong * z; v2u w; w.x = pk2(o.x, o.y); w.y = pk2(o.z, o.w); *(v2u*)(mix + r * D + 768 + 4 * lane) = w; }
    }
}

DEVI void ph_router(const Ctx& C, int layer, int ntok) {
    LAS float* lgt = (LAS float*)C.lds;
    LAS int* cnt = (LAS int*)(lgt + 8 * 16 * 33);
    if (C.tid < 32) cnt[C.tid] = 0;
    __syncthreads();
    const int nt = ntok / 16; const int t0 = (int)((long)C.bid * nt / C.G), t1 = (int)((long)(C.bid + 1) * nt / C.G);
    const float* gn = INP(7) + (size_t)layer * D;
    const int l15 = C.lane & 15, q = C.lane >> 4; LAS float* lg_w = lgt + C.wave * 16 * 33;
    for (int t = t0 + C.wave; t < t1; t += 8) {
        const int row0 = 16 * t, mrow = mod_row(row0);
        const bf16* xa = WSP(const bf16, WS_XRES) + (size_t)(row0 + l15) * D + 4 * q;
        const float* wb = WSP(const float, WS_RWP) + ((size_t)(layer * 9 + mrow) * NE + l15) * D + 4 * q;
        f32x4 acc0 = {0.f, 0.f, 0.f, 0.f}, acc1 = {0.f, 0.f, 0.f, 0.f}; float ssq = 0.f;
#pragma unroll 8
        for (int kk = 0; kk < 64; ++kk) { const v2u aw = *(const v2u*)(xa + 16 * kk); const f32x4 a = {bflo(aw.x), bfhi(aw.x), bflo(aw.y), bfhi(aw.y)}, b0 = *(const f32x4*)(wb + 16 * kk), b1 = *(const f32x4*)(wb + (size_t)16 * D + 16 * kk);
            ssq += (a.x * a.x + a.y * a.y) + (a.z * a.z + a.w * a.w);
            acc0 = __builtin_amdgcn_mfma_f32_16x16x4f32(a.x, b0.x, acc0, 0, 0, 0); acc1 = __builtin_amdgcn_mfma_f32_16x16x4f32(a.x, b1.x, acc1, 0, 0, 0);
            acc0 = __builtin_amdgcn_mfma_f32_16x16x4f32(a.y, b0.y, acc0, 0, 0, 0); acc1 = __builtin_amdgcn_mfma_f32_16x16x4f32(a.y, b1.y, acc1, 0, 0, 0);
            acc0 = __builtin_amdgcn_mfma_f32_16x16x4f32(a.z, b0.z, acc0, 0, 0, 0); acc1 = __builtin_amdgcn_mfma_f32_16x16x4f32(a.z, b1.z, acc1, 0, 0, 0);
            acc0 = __builtin_amdgcn_mfma_f32_16x16x4f32(a.w, b0.w, acc0, 0, 0, 0); acc1 = __builtin_amdgcn_mfma_f32_16x16x4f32(a.w, b1.w, acc1, 0, 0, 0); }
        ssq += __shfl_xor(ssq, 16); ssq += __shfl_xor(ssq, 32);
        const float rinv = __builtin_amdgcn_rsqf(ssq * (1.f / D) + NORM_EPS);
        const float* rb = WSP(const float, WS_RBP) + (size_t)(layer * 9 + mrow) * NE;
        const float bb0 = rb[l15], bb1 = rb[16 + l15];
#pragma unroll
        for (int r = 0; r < 4; ++r) { const float ri = __shfl(rinv, 4 * q + r); lg_w[(4 * q + r) * 33 + l15] = acc0[r] * ri + bb0; lg_w[(4 * q + r) * 33 + 16 + l15] = acc1[r] * ri + bb1; }
        LDS_WAIT();
        if (C.lane < 16) { const int r = row0 + C.lane; float lg[32];
#pragma unroll
            for (int e = 0; e < 32; ++e) lg[e] = lg_w[C.lane * 33 + e];
            int te[4]; float tv[4];
#pragma unroll
            for (int k = 0; k < 4; ++k) { float best = -INFINITY; int bi = 0;
#pragma unroll
                for (int e = 0; e < 32; ++e) if (lg[e] > best) { best = lg[e]; bi = e; }
#pragma unroll
                for (int e = 0; e < 32; ++e) lg[e] = (e == bi) ? -INFINITY : lg[e];
                te[k] = bi; tv[k] = best; }
            float ex[4], es = 0.f;
#pragma unroll
            for (int k = 0; k < 4; ++k) { ex[k] = fast_exp(tv[k] - tv[0]); es += ex[k]; }
            const float ri = 1.f / es;
#pragma unroll
            for (int k = 0; k < 4; ++k) { const int pos = __hip_atomic_fetch_add(&cnt[te[k]], 1, __ATOMIC_RELAXED, __HIP_MEMORY_SCOPE_WORKGROUP);
                WSP(int, WS_TOKE)[(size_t)r * 4 + k] = te[k]; WSP(float, WS_TOKG)[(size_t)r * 4 + k] = ex[k] * ri; WSP(int, WS_TOKP)[(size_t)r * 4 + k] = pos; } }
        LDS_WAIT();
        { const float* sh = mod_vec(C, layer, mrow, 3); const float* scl = mod_vec(C, layer, mrow, 4);
          f32x4 gm[4], sv[4];
#pragma unroll
          for (int j = 0; j < 4; ++j) { const int col = ((j & 2) ? 512 : 0) + 8 * C.lane + 4 * (j & 1); gm[j] = *(const f32x4*)(gn + col) * (*(const f32x4*)(scl + col) + 1.0f); sv[j] = *(const f32x4*)(sh + col); }
#pragma unroll 1
          for (int rr = 0; rr < 16; rr += 4) { v4u xw[4][2];
#pragma unroll
              for (int u2 = 0; u2 < 4; ++u2) { const bf16* xr = WSP(const bf16, WS_XRES) + (size_t)(row0 + rr + u2) * D; xw[u2][0] = *(const v4u*)(xr + 8 * C.lane); xw[u2][1] = *(const v4u*)(xr + 512 + 8 * C.lane); }
#pragma unroll
              for (int u2 = 0; u2 < 4; ++u2) { const float ri = __shfl(rinv, rr + u2); f32x4 f[4];
                  f[0] = (f32x4){bflo(xw[u2][0].x), bfhi(xw[u2][0].x), bflo(xw[u2][0].y), bfhi(xw[u2][0].y)} * ri * gm[0] + sv[0]; f[1] = (f32x4){bflo(xw[u2][0].z), bfhi(xw[u2][0].z), bflo(xw[u2][0].w), bfhi(xw[u2][0].w)} * ri * gm[1] + sv[1];
                  f[2] = (f32x4){bflo(xw[u2][1].x), bfhi(xw[u2][1].x), bflo(xw[u2][1].y), bfhi(xw[u2][1].y)} * ri * gm[2] + sv[2]; f[3] = (f32x4){bflo(xw[u2][1].z), bfhi(xw[u2][1].z), bflo(xw[u2][1].w), bfhi(xw[u2][1].w)} * ri * gm[3] + sv[3];
                  bf16* fr_ = WSP(bf16, WS_F) + (size_t)(row0 + rr + u2) * D;
                  *(v4u*)(fr_ + 8 * C.lane) = (v4u){pk2(f[0].x, f[0].y), pk2(f[0].z, f[0].w), pk2(f[1].x, f[1].y), pk2(f[1].z, f[1].w)};
                  *(v4u*)(fr_ + 512 + 8 * C.lane) = (v4u){pk2(f[2].x, f[2].y), pk2(f[2].z, f[2].w), pk2(f[3].x, f[3].y), pk2(f[3].z, f[3].w)}; } } }
    }
    __syncthreads();
    if (C.tid < 32) WSP(int, WS_BCNT)[C.bid * 32 + C.tid] = cnt[C.tid];
}

DEVI void ph_slots(const Ctx& C, int layer, int ntok) {
    LAS int* tot = (LAS int*)C.lds; LAS int* myoff = tot + 32; LAS int* base = tot + 64; LAS int* part = tot + 96;
    {
      const int e = C.tid & 31, grp = C.tid >> 5; int t = 0, o = 0; const int* bc = WSP(const int, WS_BCNT) + e;
#pragma unroll 4
      for (int b2 = grp; b2 < C.G; b2 += 16) { const int c = bc[b2 * 32]; t += c; if (b2 < C.bid) o += c; }
      part[grp * 64 + e] = t; part[grp * 64 + 32 + e] = o; }
    __syncthreads();
    if (C.tid < 64) { int a = 0;
#pragma unroll
        for (int g = 0; g < 16; ++g) a += part[g * 64 + C.tid];
        if (C.tid < 32) tot[C.tid] = a; else myoff[C.tid - 32] = a; }
    __syncthreads();
    if (C.tid == 0) { int acc = 0; int* texp = WSP(int, WS_TEXP);
        for (int e = 0; e < 32; ++e) { base[e] = acc; const int nt = (tot[e] + 255) >> 8; if (C.bid == 0) for (int i = 0; i < nt; ++i) texp[1 + (acc >> 8) + i] = e; acc += nt << 8; }
        if (C.bid == 0) texp[0] = acc >> 8; }
    __syncthreads();
    int* rowmap = WSP(int, WS_ROWMAP);
    if (C.bid == 0) {
        for (int e = 0; e < 32; ++e) { const int lo = base[e] + tot[e], hi2 = base[e] + (((tot[e] + 255) >> 8) << 8); for (int i = lo + C.tid; i < hi2; i += 512) rowmap[i] = 0; } }
    const int nt = ntok / 16; const int r0 = 16 * (int)((long)C.bid * nt / C.G), r1 = 16 * (int)((long)(C.bid + 1) * nt / C.G);
    for (int i = r0 * 4 + C.tid; i < r1 * 4; i += 512) { const int e = WSP(const int, WS_TOKE)[i]; const int slot = base[e] + myoff[e] + WSP(const int, WS_TOKP)[i];
        WSP(int, WS_SLOT)[i] = slot; rowmap[slot] = i >> 2; }
}

DEVI void ph_attention(const Ctx& C, bool need_ctx, int layer) {
    const attn_body::bf16* QL = WSP(const attn_body::bf16, WS_QL); const attn_body::bf16* QC = WSP(const attn_body::bf16, WS_QC);
    const attn_body::bf16* KB = WSP(const attn_body::bf16, WS_K); const attn_body::bf16* VB = WSP(const attn_body::bf16, WS_V);
    attn_body::bf16* mix = WSP(attn_body::bf16, WS_MIX);
    constexpr int NQL = SEQ / 128, NQC = LC / 128, UL = NB * 6 * NQL, UC = NB * 6 * NQC;
    const float lam_init = 0.8f - 0.6f * fast_exp(-0.3f * (float)layer); float lam;
    { float p1 = 0.f, p2 = 0.f; if (C.lane < 32) { p1 = INP(15)[layer * 32 + C.lane] * INP(16)[layer * 32 + C.lane]; p2 = INP(17)[layer * 32 + C.lane] * INP(18)[layer * 32 + C.lane]; }
      lam = fast_exp(wave_sum(p1)) - fast_exp(wave_sum(p2)) + lam_init; }
    const float post = 1.f - lam_init; const float* subln = INP(19) + layer * 64;
    const int total = UL + (need_ctx ? UC : 0);
    const int conv_at = (layer + 1 < DEPTH) ? (int)(C.bid % 6) : -1; int ui = 0; bool conv_done = false;
    const int conv0_at = (layer == 0) ? (int)((C.bid + 3) % 6) : -1; bool conv0_done = false;
    for (int u = (C.bid + C.G / 2) % C.G; u < total; u += C.G, ++ui) {
        if (ui == conv_at) { __syncthreads(); convert_layer_weights(C, layer + 1, 2); __syncthreads(); conv_done = true; }
        if (ui == conv0_at) { __syncthreads(); convert_layer_weights(C, 0, 1); __syncthreads(); conv0_done = true; }
        const bool isc = u >= UL; int qb, bp;
        if (!isc && (C.G & 7) == 0 && NQL == 32 && C.G == 256) { const int w = u % C.G, rnd = u / C.G; bp = rnd * 8 + (w & 7); qb = w >> 3; }
        else { const int v = isc ? u - UL : u; const int nq = isc ? NQC : NQL; qb = v % nq; bp = v / nq; }
        const int p = bp % 6, b = bp / 6;
        const int slen = isc ? LC : SEQ; const attn_body::bf16* Qbase = isc ? QC : QL;
        const attn_body::bf16* Qa = Qbase + ((size_t)(b * 12 + 2 * p) * slen + qb * 128) * 64; const attn_body::bf16* Qb = Qa + (size_t)slen * 64;
        const attn_body::bf16* Kh = KB + ((size_t)(b * 6 + p) * NKEY + (isc ? SEQ : 0)) * 64; const attn_body::bf16* Vh = VB + ((size_t)(b * 6 + p) * NKEY + (isc ? SEQ : 0)) * 64;
        const size_t row0 = (size_t)(isc ? T_L + b * LC : b * SEQ) + qb * 128;
        attn_body::bf16 *Oa, *Ob; int opitch;
        if (p < 2) { Oa = mix + row0 * D + (2 * p) * 64; Ob = Oa + 64; opitch = D; }
        else { Oa = mix + row0 * D + 512 + (p - 2) * 64; Ob = Oa; opitch = D; }
        const int ntile = isc ? LC / 64 : NKEY / 64;
        if (p < 2) attn_body::attn_unit<8, 0>(Qa, Qb, Kh, Vh, Oa, Ob, opitch, ntile, (char*)C.lds, lam, post, subln);
        else if (C.wave < 4) attn_body::attn_unit<8, 1>(Qa, Qb, Kh, Vh, Oa, Ob, opitch, ntile, (char*)C.lds, lam, post, subln);
        else attn_body::attn_unit<8, 2>(Qa, Qb, Kh, Vh, Oa, Ob, opitch, ntile, (char*)C.lds, lam, post, subln);
    }
    if (conv_at >= 0 && !conv_done) { __syncthreads(); convert_layer_weights(C, layer + 1, 2); __syncthreads(); }
    if (conv0_at >= 0 && !conv0_done) { __syncthreads(); convert_layer_weights(C, 0, 1); __syncthreads(); }
}

constexpr int PH_PER_LAYER = 10, N_PHASES = 2 + DEPTH * PH_PER_LAYER;
struct Args { const float* in[31]; float* out; unsigned char* ws; int ph_lo, ph_hi; };
template <int MASK> __global__ void __launch_bounds__(512, 2) mk_fwd(Args args) {
    extern __shared__ __attribute__((aligned(16))) unsigned char lds_raw[];
    { LAS unsigned long long* pt = (LAS unsigned long long*)((LAS unsigned char*)lds_raw + PTR_OFF);
      if (threadIdx.x == 0) {
#pragma unroll
          for (int i = 0; i < 31; ++i) pt[i] = (unsigned long long)args.in[i]; } }
    volatile LAS unsigned* MISC = (volatile LAS unsigned*)((LAS unsigned char*)lds_raw + MISC_OFF);
    if (threadIdx.x < 32) MISC[threadIdx.x] = 0u;
    __syncthreads();
#define CTX() Ctx C; { int t_ = threadIdx.x; LAUNDER_V(t_); C.tid = t_; C.lane = t_ & 63; C.wave = __builtin_amdgcn_readfirstlane(t_ >> 6); int b_ = blockIdx.x; LAUNDER_S(b_); C.bid = b_; \
    int g_ = gridDim.x; LAUNDER_S(g_); C.G = g_; unsigned long long w_ = (unsigned long long)args.ws; LAUNDER_S(w_); C.wsi = w_; C.out = (float*)(GAS float*)(unsigned long long)args.out; C.lds = (LAS unsigned char*)lds_raw; }
    const int lo = args.ph_lo, hi = args.ph_hi;
#if MK_N_LAUNCHES == 1
    XcdBarrier bar = xcd_barrier_post((unsigned*)(args.ws + WS_CTL) + CW_BAR, MISC + 8);
#define GRID_BAR() xcd_barrier(bar)
#else
#define GRID_BAR() do {} while (0)
#endif
#define PHON(b) (((MASK) >> (b)) & 1)
#ifndef REP_MASK
#define REP_MASK 0
#endif
#define REP(b) for (int rp_ = 0; rp_ < 1 + (((REP_MASK) >> (b)) & 1); ++rp_)
#define REPX(b, cond) for (int rp_ = 0; rp_ < 1 + ((((REP_MASK) >> (b)) & 1) && (cond)); ++rp_)
#define IN(k) (lo <= (k) && (k) < hi)
#define SEAM(k) do { if (IN(k) && IN((k) + 1)) { GRID_BAR(); if (((REP_MASK) >> 17) & 1) GRID_BAR(); } } while (0)
    if (PHON(0) && IN(0)) REP(0) { CTX(); p0_prologue(C); } SEAM(0);
#define LAYER_BODY(layer) { \
        const int p0 = 1 + layer * PH_PER_LAYER; const bool need_ctx = layer < DEPTH - 1; const int ntok = need_ctx ? T_ALL : T_L; \
        if (PHON(1) && IN(p0 + 0)) REPX(15, layer == 0) { CTX(); ph_norm_mix(C, layer); } SEAM(p0 + 0); \
        if (PHON(2) && IN(p0 + 1)) REP(2) { CTX(); pg8::Gemm g{WSP(const pg8::bf16_t, WS_H), WSP(const pg8::bf16_t, WS_WIN) + (size_t)layer * N_PROJ * D, T_ALL, N_PROJ, D}; \
            pg8::StaticOrder S; S.init(T_ALL, N_PROJ, C.G, C.bid); pg8::EpiBf16<0> E{WSP(pg8::bf16_t, WS_PROJ), N_PROJ, nullptr, 0, 0, 1.f}; \
            pg8::gemm_phase<pg8::EpiBf16<0>, pg8::StaticOrder, true, true>(C.lds, g, S, E); } SEAM(p0 + 1); \
        if (IN(p0 + 2)) { if (PHON(3)) REP(3) { CTX(); ph_attn_prep(C, layer); } if (PHON(5)) REP(5) { CTX(); ph_dn_chunk(C, layer); } } SEAM(p0 + 2); \
        if (IN(p0 + 3)) { if (PHON(6)) REP(6) { CTX(); ph_dn_scan(C, layer); } __syncthreads(); if (PHON(4)) REP(4) { CTX(); ph_gmlp(C, layer, ntok); } __syncthreads(); if (PHON(7)) REP(7) { CTX(); ph_attention(C, need_ctx, layer); } } SEAM(p0 + 3); \
        if (PHON(8) && IN(p0 + 4)) REP(8) { CTX(); ph_finalize(C, layer, ntok); } SEAM(p0 + 4); \
        if (PHON(9) && IN(p0 + 5)) REPX(14, layer == 0) { CTX(); pg8::Gemm g{WSP(const pg8::bf16_t, WS_MIX), WSP(const pg8::bf16_t, WS_WOUT) + (size_t)layer * D * D, ntok, D, D}; \
            pg8::StaticOrder S; S.init(ntok, D, C.G, C.bid); \
            if (layer == 0) { pg8::EpiOutRes<true> E{INP(0), INP(2), WSP(pg8::bf16_t, WS_XRES), WSP(const float, WS_MOD) + (size_t)layer * 9 * 6 * D}; \
                pg8::gemm_phase<pg8::EpiOutRes<true>, pg8::StaticOrder, true, true>(C.lds, g, S, E); } \
            else { pg8::EpiOutRes<false> E{WSP(const pg8::bf16_t, WS_XRES), WSP(const pg8::bf16_t, WS_XRES) + (size_t)T_L * D, WSP(pg8::bf16_t, WS_XRES), WSP(const float, WS_MOD) + (size_t)layer * 9 * 6 * D}; \
                pg8::gemm_phase<pg8::EpiOutRes<false>, pg8::StaticOrder, true, true>(C.lds, g, S, E); } } SEAM(p0 + 5); \
        if (PHON(10) && IN(p0 + 6)) REP(10) { CTX(); ph_router(C, layer, ntok); } SEAM(p0 + 6); \
        if (PHON(11) && IN(p0 + 7)) REP(11) { CTX(); ph_slots(C, layer, ntok); } SEAM(p0 + 7); \
        if (PHON(12) && IN(p0 + 8)) REP(12) { CTX(); pg8::Gemm g{WSP(const pg8::bf16_t, WS_F), WSP(const pg8::bf16_t, WS_WUP) + (size_t)layer * NE * 2 * DE * D, P_ROWS, NE * 2 * DE, D, WSP(const int, WS_ROWMAP)}; \
            pg8::MoeOrder S; S.init(WSP(const int, WS_TEXP), 8, C.G, C.bid); pg8::EpiSwiglu E{WSP(pg8::bf16_t, WS_HID), INP(27) + (size_t)layer * NE * 2 * DE}; \
            pg8::gemm_phase<pg8::EpiSwiglu, pg8::MoeOrder, true, true, true>(C.lds, g, S, E); } SEAM(p0 + 8); \
        if (PHON(13) && IN(p0 + 9)) REP(13) { CTX(); pg8::Gemm g{WSP(const pg8::bf16_t, WS_HID), WSP(const pg8::bf16_t, WS_WDN) + (size_t)layer * NE * D * DE, P_ROWS, NE * D, DE}; \
            pg8::MoeOrder S; S.init(WSP(const int, WS_TEXP), 4, C.G, C.bid); pg8::EpiDown E{WSP(unsigned char, WS_YS), INP(29) + (size_t)layer * NE * D}; \
            pg8::gemm_phase<pg8::EpiDown, pg8::MoeOrder, true, true>(C.lds, g, S, E); } SEAM(p0 + 9); \
    }
    static_assert(DEPTH <= 4, "layer sites");
    if constexpr (DEPTH > 0) LAYER_BODY(0)
    if constexpr (DEPTH > 1) LAYER_BODY(1)
    if constexpr (DEPTH > 2) LAYER_BODY(2)
    if constexpr (DEPTH > 3) LAYER_BODY(3)
#undef LAYER_BODY
    if (PHON(1) && IN(N_PHASES - 1)) REP(16) { CTX(); ph_norm_mix(C, DEPTH); }
#undef IN
#undef SEAM
}

#ifndef EMU
#ifndef FULL_MASK_V
#define FULL_MASK_V 0x3fff
#endif
constexpr int FULL_MASK = FULL_MASK_V;
typedef void (*kern_t)(Args);
static int phase_mask(int p) {
    if (p == 0) return 1; if (p == N_PHASES - 1) return 2;
    const int k = (p - 1) % PH_PER_LAYER; const int m[10] = {2, 4, 8 | 32, 16 | 64 | 128, 256, 512, 1024, 2048, 4096, 8192}; return m[k];
}
static kern_t kern_of_mask(int m) {
    switch (m) {
#if MK_N_LAUNCHES == 1
        case FULL_MASK: return mk_fwd<FULL_MASK>;
#else
        case 1: return mk_fwd<1>; case 2: return mk_fwd<2>; case 4: return mk_fwd<4>; case 8: return mk_fwd<8>; case 16: return mk_fwd<16>; case 32: return mk_fwd<32>; case 192: return mk_fwd<192>; case 256: return mk_fwd<256>;
        case 512: return mk_fwd<512>; case 1024: return mk_fwd<1024>; case 2048: return mk_fwd<2048>; case 4096: return mk_fwd<4096>; case 8192: return mk_fwd<8192>;
#endif
        default: return nullptr;
    }
}
extern "C" void kernel_launch(void* const* d_in, const int* in_sizes, int n_in, void* d_out, int out_size, void* d_ws, size_t ws_size, hipStream_t stream) {
    static int grid = 0;
    if (grid == 0) {
        if (n_in != 31 || in_sizes[0] != T_L * D || out_size != T_L * D || ws_size < WS_END) { fprintf(stderr, "kernel_launch: shape/workspace mismatch (n_in %d, in0 %d, out %d, ws %zu, need %zu)\n", n_in, n_in > 0 ? in_sizes[0] : -1, out_size, ws_size, (size_t)WS_END); grid = -1; return; }
        int dev = 0, cus = 0;
        if (hipGetDevice(&dev) != hipSuccess || hipDeviceGetAttribute(&cus, hipDeviceAttributeMultiprocessorCount, dev) != hipSuccess) { grid = -1; return; }
#if MK_N_LAUNCHES == 1
        const int masks[1] = {FULL_MASK}; const int nm = 1;
#else
        const int masks[13] = {1, 2, 4, 8, 16, 32, 192, 256, 512, 1024, 2048, 4096, 8192}; const int nm = 13;
#endif
        for (int i = 0; i < nm; ++i) {
            if (hipFuncSetAttribute((const void*)kern_of_mask(masks[i]), hipFuncAttributeMaxDynamicSharedMemorySize, LDS_BYTES) != hipSuccess) { fprintf(stderr, "kernel_launch: hipFuncSetAttribute failed\n"); grid = -1; return; }
            int per_cu = 0;
            if (hipOccupancyMaxActiveBlocksPerMultiprocessor(&per_cu, (const void*)kern_of_mask(masks[i]), 512, LDS_BYTES) != hipSuccess || per_cu < 1) fprintf(stderr, "kernel_launch: occupancy query reports %d for mask %d\n", per_cu, masks[i]);
        }
        (void)hipGetLastError();
        grid = cus;
        if (grid > 1024) grid = 1024;
    }
    if (grid < 0) return;
    if (hipMemsetAsync((char*)d_ws + WS_CTL, 0, (CW_BAR + XCD_BAR_WORDS) * sizeof(unsigned), stream) != hipSuccess) return;
    Args a{};
    for (int i = 0; i < 31; ++i) a.in[i] = (const float*)d_in[i];
    a.out = (float*)d_out; a.ws = (unsigned char*)d_ws;
#if MK_N_LAUNCHES == 1
    a.ph_lo = 0; a.ph_hi = N_PHASES;
    hipLaunchKernelGGL(mk_fwd<FULL_MASK>, dim3(grid), dim3(512), LDS_BYTES, stream, a);
#else
    for (int p = 0; p < N_PHASES; ++p) { a.ph_lo = p; a.ph_hi = p + 1; const int pm = phase_mask(p);
        for (int bit = 0; bit < 14; ++bit) { int m = pm & (1 << bit); if (!m) continue; if (m == 64 || m == 128) { if (m == 128) continue; m = 192; } hipLaunchKernelGGL(kern_of_mask(m), dim3(grid), dim3(512), LDS_BYTES, stream, a); } }
#endif
}
#endif
```

```cpp
#ifndef EMU
#include <hip/hip_runtime.h>
#include <cstdio>
#include <cstdint>
#endif

#ifndef MK_N_LAUNCHES
#define MK_N_LAUNCHES 1
#endif

#ifndef CFG_BATCH
#define CFG_BATCH 8
#define CFG_SEQ 4096
#define CFG_CTX 256
#define CFG_DEPTH 4
#endif
constexpr int NB = CFG_BATCH, SEQ = CFG_SEQ, LC = CFG_CTX, DEPTH = CFG_DEPTH, D = 1024;
constexpr int GRID_W = 64;
constexpr int T_L = NB * SEQ, T_C = NB * LC, T_ALL = T_L + T_C;
constexpr int D_IN = 2832, N_PROJ = 2816;
constexpr int NKEY = SEQ + LC;
constexpr int NE = 32, TOPK = 4, DE = 1024;
constexpr int NCH_L = SEQ / 64, NCH_C = LC / 64, NCH = NCH_L + NCH_C;
constexpr int MAX_TILES = (T_ALL * TOPK) / 256 + NE;
constexpr int P_ROWS = MAX_TILES * 256;
constexpr float NORM_EPS = 1e-6f;
static_assert(SEQ % 256 == 0 && LC % 128 == 0 && T_ALL % 256 == 0 && (T_ALL * TOPK) % 256 == 0, "tiling");
constexpr int C_AQ = 0, C_AK = 256, C_AV = 384, C_BU = 512, C_BV = 768, C_CQ = 1024, C_CK = 1280, C_CV = 1536, C_DQKV = 1792, C_DZ = 2560, C_DB = 2816, C_DA = 2824;

#ifndef EMU
#define GAS __attribute__((address_space(1)))
#define LAS __attribute__((address_space(3)))
#define DEVI __device__ __forceinline__
#define LDS_WAIT() asm volatile("s_waitcnt lgkmcnt(0)" ::: "memory")
#define VM_WAIT() asm volatile("s_waitcnt vmcnt(0)" ::: "memory")
#define LAUNDER_V(x) asm volatile("" : "+v"(x))
#define LAUNDER_S(x) asm volatile("" : "+s"(x))
#endif
typedef unsigned short bf16;
typedef unsigned v4u __attribute__((ext_vector_type(4)));
typedef unsigned v2u __attribute__((ext_vector_type(2)));
typedef float f32x4 __attribute__((ext_vector_type(4)));
typedef float f32x2 __attribute__((ext_vector_type(2)));
typedef short bf16x8 __attribute__((ext_vector_type(8)));
typedef GAS unsigned gu32;
#define RLX_AGENT __ATOMIC_RELAXED, __HIP_MEMORY_SCOPE_AGENT
typedef __bf16 hbf2_t __attribute__((ext_vector_type(2)));
DEVI unsigned pk2(float lo, float hi) { const f32x2 v = {lo, hi}; return __builtin_bit_cast(unsigned, __builtin_convertvector(v, hbf2_t)); }
DEVI unsigned f2bf(float f) { return pk2(f, 0.f) & 0xffffu; }
DEVI float bf2f(unsigned h) { return __builtin_bit_cast(float, (h & 0xffffu) << 16); }
DEVI float bflo(unsigned w) { return __builtin_bit_cast(float, w << 16); }
DEVI float bfhi(unsigned w) { return __builtin_bit_cast(float, w & 0xffff0000u); }
DEVI float fast_exp(float x) { return __builtin_amdgcn_exp2f(x * 1.4426950408889634f); }
DEVI float fast_rcp(float x) { return __builtin_amdgcn_rcpf(x); }
DEVI float sigmoidf_(float x) { return fast_rcp(1.f + fast_exp(-x)); }
DEVI float siluf_(float x) { return x * sigmoidf_(x); }
DEVI float tanh_fast(float x) { const float e = fast_exp(-2.f * __builtin_fabsf(x)); const float t = (1.f - e) * fast_rcp(1.f + e); return x < 0.f ? -t : t; }
DEVI float gelu_tanh(float x) { return 0.5f * x * (1.f + tanh_fast(0.7978845608028654f * (x + 0.044715f * x * x * x))); }
DEVI float softplusf_(float x) { return x > 20.f ? x : __builtin_amdgcn_logf(1.f + fast_exp(x)) * 0.6931471805599453f; }
DEVI float wave_sum(float v) {
#pragma unroll
    for (int o = 1; o < 64; o <<= 1) v += __shfl_xor(v, o);
    return v;
}
template <int W> DEVI float group_sum(float v) {
#pragma unroll
    for (int o = 1; o < W; o <<= 1) v += __shfl_xor(v, o);
    return v;
}

constexpr size_t al256(size_t x) { return (x + 255) & ~(size_t)255; }
constexpr size_t WS_CTL = 0, CTL_ZERO_BYTES = 1u << 20;
constexpr size_t WS_MOD   = CTL_ZERO_BYTES;
constexpr size_t WS_WIN   = WS_MOD   + al256((size_t)DEPTH * 9 * 6 * D * 4);
constexpr size_t WS_WOUT  = WS_WIN   + al256((size_t)DEPTH * N_PROJ * D * 2);
constexpr size_t WS_WUP   = WS_WOUT  + al256((size_t)DEPTH * D * D * 2);
constexpr size_t WS_WDN   = WS_WUP   + al256((size_t)DEPTH * NE * 2 * DE * D * 2);
constexpr size_t WS_H     = WS_WDN   + al256((size_t)DEPTH * NE * D * DE * 2);
constexpr size_t WS_F     = WS_H     + al256((size_t)T_ALL * D * 2);
constexpr size_t WS_BA    = WS_F     + al256((size_t)T_ALL * D * 2);
constexpr size_t WS_PROJ  = WS_BA    + al256((size_t)T_ALL * 16 * 4);
constexpr size_t WS_XRES  = WS_PROJ  + al256((size_t)T_ALL * N_PROJ * 2);
constexpr size_t WS_MIX   = WS_XRES  + al256((size_t)T_ALL * D * 4);
constexpr size_t WS_QL    = WS_MIX   + al256((size_t)T_ALL * D * 2);
constexpr size_t WS_QC    = WS_QL    + al256((size_t)NB * 12 * SEQ * 64 * 2);
constexpr size_t WS_K     = WS_QC    + al256((size_t)NB * 12 * LC * 64 * 2);
constexpr size_t WS_V     = WS_K     + al256((size_t)NB * 6 * NKEY * 64 * 2);
constexpr size_t WS_OD    = WS_V     + al256((size_t)NB * 6 * NKEY * 64 * 2);
constexpr size_t WS_DNO   = WS_OD    + al256((size_t)2 * T_ALL * 256 * 2);
constexpr size_t WS_DNF   = WS_DNO   + al256((size_t)2 * T_ALL * 256 * 4);
constexpr size_t DN_UNIT_BYTES = 32768;
constexpr size_t WS_HID   = WS_DNF   + al256((size_t)NB * 2 * 4 * NCH * DN_UNIT_BYTES);
constexpr size_t WS_YS    = WS_HID   + al256((size_t)P_ROWS * DE * 2);
constexpr size_t WS_TOKE  = WS_YS    + al256((size_t)P_ROWS * D * 2);
constexpr size_t WS_TOKG  = WS_TOKE  + al256((size_t)T_ALL * 4 * 4);
constexpr size_t WS_TOKP  = WS_TOKG  + al256((size_t)T_ALL * 4 * 4);
constexpr size_t WS_SLOT  = WS_TOKP  + al256((size_t)T_ALL * 4 * 4);
constexpr size_t WS_BCNT  = WS_SLOT  + al256((size_t)T_ALL * 4 * 4);
constexpr size_t WS_TEXP  = WS_BCNT  + al256((size_t)1024 * 32 * 4);
constexpr size_t WS_RWP   = WS_TEXP  + al256((size_t)(MAX_TILES + 64) * 4);
constexpr size_t WS_RBP   = WS_RWP   + al256((size_t)DEPTH * 9 * NE * D * 4);
constexpr size_t WS_ROWMAP = WS_RBP  + al256((size_t)DEPTH * 9 * NE * 4);
constexpr size_t WS_ROPE  = WS_ROWMAP + al256((size_t)P_ROWS * 4);
constexpr size_t WS_END   = WS_ROPE  + al256((size_t)SEQ * 96 * 4);
constexpr int CW_TMO = 0, CW_CODE = 1, CW_BAR = 4096;
namespace pg8 {
#define PG8_LAS __attribute__((address_space(3)))
typedef unsigned short bf16_t;
typedef short bf16x8 __attribute__((ext_vector_type(8)));
typedef float f32x4 __attribute__((ext_vector_type(4)));
typedef unsigned u32x4 __attribute__((ext_vector_type(4)));
constexpr int BM = 256, BK = 64, HALF = 128, HTB = HALF * BK * 2  , STAGE_BYTES = 8 * HTB, NXCD = 8, WGM = 8;

__host__ __device__ __forceinline__ int lds_byte(int r, int c) { const int st = (r >> 4) * 2 + (c >> 5), rr = r & 15, cc = c & 31, ob = rr * 64 + cc * 2; return st * 1024 + (ob ^ (((ob >> 9) & 1) << 5)); }
__host__ __device__ __forceinline__ void stage_rc(int b, int& R, int& C) { const int st = b / 1024, sb = b % 1024, swz = sb ^ (((sb >> 9) & 1) << 5); R = (st >> 1) * 16 + swz / 64; C = (st & 1) * 32 + (swz % 64) / 2; }
__host__ __device__ __forceinline__ int perm32(int rho) { const int n = rho >> 4, i = rho & 15; return 8 * (i >> 2) + 4 * n + (i & 3); }

struct Unit { int pm, pn; };
struct Gemm { const bf16_t* A; const bf16_t* Bt; int M, N, K; const int* rowmap = nullptr; };

struct StaticOrder {
    int nM, nN, nwg, G, c;
    __host__ __device__ void init(int M, int N, int G_, int c_) { nM = M / BM; nN = N / BM; nwg = nM * nN; G = G_; c = c_; }
    __host__ __device__ bool next(int i, Unit& u) const {
        const long L = (long)i * G + c; if (L >= nwg) return false;
        int wgid = (int)L; { const int q = nwg / NXCD, r = nwg % NXCD, xcd = wgid % NXCD, off = wgid / NXCD; wgid = (xcd < r ? xcd * (q + 1) : r * (q + 1) + (xcd - r) * q) + off; }
        const int nig = WGM * nN, gid = wgid / nig, fm = gid * WGM, gsz = (nM - fm) < WGM ? (nM - fm) : WGM;
        u.pm = fm + ((wgid % nig) % gsz); u.pn = (wgid % nig) / gsz; return true;
    }
    __device__ __forceinline__ void a_ready(const Unit&) const {}
    __device__ __forceinline__ void done(const Unit&) const {}
};

#ifndef EMU
__device__ __forceinline__ unsigned cvt_pk_bf16(float lo, float hi) { unsigned r; asm volatile("v_cvt_pk_bf16_f32 %0, %1, %2" : "=v"(r) : "v"(lo), "v"(hi)); return r; }
#else
__device__ __forceinline__ unsigned cvt_pk_bf16(float lo, float hi) { return pk2(lo, hi); }
#endif
typedef float f32x2 __attribute__((ext_vector_type(2)));
__device__ __forceinline__ f32x2 gelu_pk(f32x2 v) {
    const f32x2 av = __builtin_elementwise_abs(v), d = av * 0.2316418882f + 1.0f;
    f32x2 t; t.x = __builtin_amdgcn_rcpf(d.x); t.y = __builtin_amdgcn_rcpf(d.y);
    f32x2 q = t * 0.5307027145f + (-0.7265760135f); q = q * t + 0.7107068705f; q = q * t + (-0.142248368f); q = q * t + 0.127414796f; q = q * t;
    const f32x2 s = (v * v) * (-0.72134752044f);
    f32x2 e; e.x = __builtin_amdgcn_exp2f(s.x); e.y = __builtin_amdgcn_exp2f(s.y);
    const f32x2 m = v * (q * e), r = v - m;
    f32x2 o; o.x = v.x < 0.f ? m.x : r.x; o.y = v.y < 0.f ? m.y : r.y; return o;
}

template <int ACT  > struct EpiBf16 {
    static constexpr bool PERM = true, AFTER_DRAIN = false; static_assert(ACT == 0 || ACT == 1, "EpiBf16: ACT is 0 (none) or 1 (gelu_pk)");
    bf16_t* O; int ldc; const float* bias; int split_cols; size_t split_stride; float scale0;
    __device__ __forceinline__ void operator()(const f32x4 (&acc)[2][2][4][2], const Unit& u, int wr, int wc, int fr, int fq) const {
        const int row0 = u.pm * BM + wr * 64 + fr; int colt = u.pn * BM; bf16_t* base = O;
        float sc = 1.f; if (split_cols) { const int t = colt / split_cols; base += (size_t)t * split_stride; colt -= t * split_cols; if (t == 0) sc = scale0; }
        const int col0 = colt + wc * 32 + 8 * fq, bcol0 = u.pn * BM + wc * 32 + 8 * fq;
        f32x4 bv[2][2];
#pragma unroll
        for (int bj = 0; bj < 2; ++bj)
#pragma unroll
            for (int n = 0; n < 2; ++n) bv[bj][n] = bias ? *(const f32x4*)(bias + bcol0 + bj * HALF + 4 * n) : (f32x4){0.f, 0.f, 0.f, 0.f};
#pragma unroll
        for (int ai = 0; ai < 2; ++ai)
#pragma unroll
            for (int m = 0; m < 4; ++m) { bf16_t* rowp = base + (size_t)(row0 + ai * HALF + m * 16) * ldc + col0;
#pragma unroll
                for (int bj = 0; bj < 2; ++bj) { f32x4 v0 = acc[ai][bj][m][0] + bv[bj][0], v1 = acc[ai][bj][m][1] + bv[bj][1];
                    if (ACT == 1) { f32x2 a = gelu_pk((f32x2){v0[0], v0[1]}), b = gelu_pk((f32x2){v0[2], v0[3]}), c = gelu_pk((f32x2){v1[0], v1[1]}), d = gelu_pk((f32x2){v1[2], v1[3]});
                        v0 = (f32x4){a.x, a.y, b.x, b.y}; v1 = (f32x4){c.x, c.y, d.x, d.y}; }
                    v0 = v0 * sc; v1 = v1 * sc; u32x4 w; w.x = cvt_pk_bf16(v0[0], v0[1]); w.y = cvt_pk_bf16(v0[2], v0[3]); w.z = cvt_pk_bf16(v1[0], v1[1]); w.w = cvt_pk_bf16(v1[2], v1[3]);
                    *(u32x4*)(rowp + bj * HALF) = w; } }
    }
};

template <bool IN_F32> struct EpiOutRes {
    static constexpr bool PERM = true, AFTER_DRAIN = false;
    const void* xin_l; const void* xin_c;
    bf16_t* xres; const float* mod;
    __device__ __forceinline__ void operator()(const f32x4 (&acc)[2][2][4][2], const Unit& u, int wr, int wc, int fr, int fq) const {
        const int rowt = u.pm * BM; const bool isc = rowt >= T_L; const int mrow = isc ? 8 : rowt / SEQ;
        const float* g = mod + (size_t)(mrow * 6 + 2) * D;
        const size_t inoff = isc ? (size_t)(rowt - T_L) * D : (size_t)rowt * D;
        const float* xf = (const float*)(isc ? xin_c : xin_l) + inoff; const bf16_t* xb = (const bf16_t*)(isc ? xin_c : xin_l) + inoff;
        bf16_t* xo = xres + (size_t)rowt * D;
        const int col0 = u.pn * BM + wc * 32 + 8 * fq;
        f32x4 gv[2][2];
#pragma unroll
        for (int bj = 0; bj < 2; ++bj)
#pragma unroll
            for (int n = 0; n < 2; ++n) gv[bj][n] = *(const f32x4*)(g + col0 + bj * HALF + 4 * n);
#pragma unroll
        for (int ai = 0; ai < 2; ++ai)
#pragma unroll
          for (int mp = 0; mp < 2; ++mp) {
            f32x4 xi[2][2][2];
#pragma unroll
            for (int m2 = 0; m2 < 2; ++m2) { const size_t ro = (size_t)(ai * HALF + wr * 64 + (2 * mp + m2) * 16 + fr) * D + col0;
#pragma unroll
                for (int bj = 0; bj < 2; ++bj) {
                    if constexpr (IN_F32) { xi[m2][bj][0] = *(const f32x4*)(xf + ro + bj * HALF); xi[m2][bj][1] = *(const f32x4*)(xf + ro + bj * HALF + 4); }
                    else { const u32x4 w = *(const u32x4*)(xb + ro + bj * HALF);
                        xi[m2][bj][0] = (f32x4){bflo(w.x), bfhi(w.x), bflo(w.y), bfhi(w.y)}; xi[m2][bj][1] = (f32x4){bflo(w.z), bfhi(w.z), bflo(w.w), bfhi(w.w)}; } } }
#pragma unroll
            for (int m2 = 0; m2 < 2; ++m2) { const int m = 2 * mp + m2; const size_t ro = (size_t)(ai * HALF + wr * 64 + m * 16 + fr) * D + col0;
#pragma unroll
                for (int bj = 0; bj < 2; ++bj) { const f32x4 v0 = xi[m2][bj][0] + gv[bj][0] * acc[ai][bj][m][0], v1 = xi[m2][bj][1] + gv[bj][1] * acc[ai][bj][m][1];
                    u32x4 w; w.x = cvt_pk_bf16(v0[0], v0[1]); w.y = cvt_pk_bf16(v0[2], v0[3]); w.z = cvt_pk_bf16(v1[0], v1[1]); w.w = cvt_pk_bf16(v1[2], v1[3]);
                    *(u32x4*)(xo + ro + bj * HALF) = w; } } }
    }
};
struct EpiSwiglu {
    static constexpr bool PERM = true, AFTER_DRAIN = false;
    bf16_t* hid; const float* bup;
    __device__ __forceinline__ void operator()(const f32x4 (&acc)[2][2][4][2], const Unit& u, int wr, int wc, int fr, int fq) const {
        const int e = u.pn >> 3, j = u.pn & 7; const int h0 = j * HALF + wc * 32 + 8 * fq;
        const float* bg = bup + (size_t)e * 2 * DE + h0; const float* bu = bg + DE;
        f32x4 vg[2], vu[2];
#pragma unroll
        for (int n = 0; n < 2; ++n) { vg[n] = *(const f32x4*)(bg + 4 * n); vu[n] = *(const f32x4*)(bu + 4 * n); }
#pragma unroll
        for (int ai = 0; ai < 2; ++ai)
#pragma unroll
            for (int m = 0; m < 4; ++m) { const size_t row = (size_t)u.pm * BM + ai * HALF + wr * 64 + m * 16 + fr; float o[8];
#pragma unroll
                for (int n = 0; n < 2; ++n) { const f32x4 gt = acc[ai][0][m][n] + vg[n], up = acc[ai][1][m][n] + vu[n];
#pragma unroll
                    for (int i = 0; i < 4; ++i) { const float gg = __builtin_fminf(gt[i], 7.0f); const float uu = __builtin_fminf(__builtin_fmaxf(up[i], -7.0f), 7.0f);
                        o[4 * n + i] = gg * sigmoidf_(1.702f * gg) * (uu + 1.0f); } }
                u32x4 w; w.x = cvt_pk_bf16(o[0], o[1]); w.y = cvt_pk_bf16(o[2], o[3]); w.z = cvt_pk_bf16(o[4], o[5]); w.w = cvt_pk_bf16(o[6], o[7]);
                *(u32x4*)(hid + row * DE + h0) = w; }
    }
};
struct EpiDown {
    static constexpr bool PERM = true, AFTER_DRAIN = false;
    unsigned char* ys; const float* bdn;
    __device__ __forceinline__ void operator()(const f32x4 (&acc)[2][2][4][2], const Unit& u, int wr, int wc, int fr, int fq) const {
        typedef unsigned u32x2v __attribute__((ext_vector_type(2)));
        const int e = u.pn >> 2, j = u.pn & 3; const int col0 = j * BM + wc * 32 + 8 * fq;
        f32x4 bv[2][2];
#pragma unroll
        for (int bj = 0; bj < 2; ++bj)
#pragma unroll
            for (int n = 0; n < 2; ++n) bv[bj][n] = *(const f32x4*)(bdn + (size_t)e * D + col0 + bj * HALF + 4 * n);
#pragma unroll
        for (int ai = 0; ai < 2; ++ai)
#pragma unroll
            for (int m = 0; m < 4; ++m) { const size_t row = (size_t)u.pm * BM + ai * HALF + wr * 64 + m * 16 + fr;
#pragma unroll
                for (int bj = 0; bj < 2; ++bj) { const f32x4 v0 = acc[ai][bj][m][0] + bv[bj][0], v1 = acc[ai][bj][m][1] + bv[bj][1];
                    int w0 = 0, w1 = 0;
                    w0 = __builtin_amdgcn_cvt_pk_fp8_f32(v0[0], v0[1], w0, false); w0 = __builtin_amdgcn_cvt_pk_fp8_f32(v0[2], v0[3], w0, true);
                    w1 = __builtin_amdgcn_cvt_pk_fp8_f32(v1[0], v1[1], w1, false); w1 = __builtin_amdgcn_cvt_pk_fp8_f32(v1[2], v1[3], w1, true);
                    *(u32x2v*)(ys + row * D + col0 + bj * HALF) = (u32x2v){(unsigned)w0, (unsigned)w1}; } }
    }
};
struct MoeOrder {
    const int* texp; int ntiles, nN, nwg, G, c;
    __device__ __forceinline__ void init(const int* texp_, int nN_, int G_, int c_) { texp = texp_; ntiles = texp_[0]; nN = nN_; nwg = ntiles * nN_; G = G_; c = c_; }
    __device__ __forceinline__ bool next(int i, Unit& u) const {
        const long L = (long)i * G + c; if (L >= nwg) return false;
        int wgid = (int)L; { const int q = nwg / NXCD, r = nwg % NXCD, xcd = wgid % NXCD, off = wgid / NXCD; wgid = (xcd < r ? xcd * (q + 1) : r * (q + 1) + (xcd - r) * q) + off; }
        const int nig = WGM * nN, gid = wgid / nig, fm = gid * WGM, gsz = (ntiles - fm) < WGM ? (ntiles - fm) : WGM;
        const int pm = fm + ((wgid % nig) % gsz); u.pm = pm; u.pn = texp[1 + pm] * nN + (wgid % nig) / gsz; return true;
    }
    __device__ __forceinline__ void a_ready(const Unit&) const {}
    __device__ __forceinline__ void done(const Unit&) const {}
};
#ifndef EMU
template <class Epi, class Sched, bool ALIGN_EPI = false, bool SP2 = false, bool GATHER = false>
__device__ __forceinline__ void gemm_phase(PG8_LAS unsigned char* lds, const Gemm g, const Sched& S, const Epi& E) {
    int tid_ = threadIdx.x; asm volatile("" : "+v"(tid_));
    const int tid = tid_, wid = __builtin_amdgcn_readfirstlane(tid >> 6), lane = tid & 63, wr = wid >> 2, wc = wid & 3, fr = lane & 15, fq = lane >> 4;
    const int K = g.K, nt = K / BK;
    unsigned voffA[2], voffB[2]; int gR[2], gC[2];
#pragma unroll
    for (int i = 0; i < 2; ++i) { int R, C; stage_rc(tid * 16 + i * 8192, R, C); const int Rb = Epi::PERM ? ((R & ~31) + perm32(R & 31)) : R;
        voffA[i] = (unsigned)(R * K + C) * 2u; voffB[i] = (unsigned)(Rb * K + C) * 2u; gR[i] = R; gC[i] = C; }
    unsigned voffC[2][2], voffN[2][2];
#define PG8_GOFF(dst, pm_) do { _Pragma("unroll") for (int h_ = 0; h_ < 2; ++h_) _Pragma("unroll") for (int i_ = 0; i_ < 2; ++i_) \
        dst[h_][i_] = (unsigned)(g.rowmap[(size_t)(pm_) * BM + h_ * HALF + gR[i_]] * K + gC[i_]) * 2u; } while (0)
    const size_t kstep = (size_t)(BK * 2);
    const size_t hstep = (size_t)HALF * K * 2;
    const size_t tstep = 2 * hstep;
    const unsigned ldsw = (unsigned)wid * 1024u;
    const int aoff = lds_byte(wr * 64 + fr, fq * 8), boff = lds_byte(wc * 32 + fr, fq * 8);
#define PG8_SA(b, h) (((b) * 2 + (h)) * HTB)
#define PG8_SB(b, h) ((4 + (b) * 2 + (h)) * HTB)
#define PG8_STAGE(bufoff, gbase, voff) do { _Pragma("unroll") for (int _i = 0; _i < 2; ++_i) \
        __builtin_amdgcn_global_load_lds((const unsigned*)((const char*)(gbase) + (voff)[_i]), (PG8_LAS unsigned*)(lds + (bufoff) + ldsw + _i * 8192), 16, 0, 0); } while (0)
#define PG8_LDA(dst, b, h) do { _Pragma("unroll") for (int m = 0; m < 4; ++m) _Pragma("unroll") for (int k = 0; k < 2; ++k) dst[m][k] = *(const PG8_LAS bf16x8*)(lds + PG8_SA(b, h) + aoff + m * 2048 + k * 1024); } while (0)
#define PG8_LDB(dst, b, h) do { _Pragma("unroll") for (int n = 0; n < 2; ++n) _Pragma("unroll") for (int k = 0; k < 2; ++k) dst[n][k] = *(const PG8_LAS bf16x8*)(lds + PG8_SB(b, h) + boff + n * 2048 + k * 1024); } while (0)
#define PG8_MMA(ai, bj, At, Bt) do { __builtin_amdgcn_s_setprio(1); _Pragma("unroll") for (int m = 0; m < 4; ++m) _Pragma("unroll") for (int n = 0; n < 2; ++n) _Pragma("unroll") for (int k = 0; k < 2; ++k) \
        acc[ai][bj][m][n] = __builtin_amdgcn_mfma_f32_16x16x32_bf16(Bt[n][k], At[m][k], acc[ai][bj][m][n], 0, 0, 0); __builtin_amdgcn_s_setprio(0); } while (0)
#define PG8_WAIT_V(n) asm volatile("s_waitcnt vmcnt(" #n ")" ::: "memory")
#define PG8_WAIT_L(n) asm volatile("s_waitcnt lgkmcnt(" #n ")" ::: "memory")
#define PG8_BAR __builtin_amdgcn_s_barrier()
#define PG8_SCHED __builtin_amdgcn_sched_barrier(0)
#define PG8_STAGEA(bufoff, gbase, h, nx) do { if constexpr (GATHER) { _Pragma("unroll") for (int _i = 0; _i < 2; ++_i) { const unsigned o_ = (nx) ? voffN[h][_i] : voffC[h][_i]; \
        __builtin_amdgcn_global_load_lds((const unsigned*)((const char*)(gbase) + o_), (PG8_LAS unsigned*)(lds + (bufoff) + ldsw + _i * 8192), 16, 0, 0); } } \
    else { PG8_STAGE(bufoff, (gbase) + (h) * hstep, voffA); } } while (0)
    Unit cur, nxt; int ui = 0;
    if (!S.next(0, cur)) return;
    f32x4 acc[2][2][4][2];
#pragma unroll
    for (int a = 0; a < 2; ++a)
#pragma unroll
        for (int b = 0; b < 2; ++b)
#pragma unroll
            for (int m = 0; m < 4; ++m)
#pragma unroll
                for (int n = 0; n < 2; ++n) acc[a][b][m][n] = (f32x4){0.f, 0.f, 0.f, 0.f};
    bf16x8 At[4][2], B0[2][2], B1[2][2];
    const char* cA = (const char*)g.A + (GATHER ? (size_t)0 : (size_t)cur.pm * tstep); if constexpr (GATHER) { PG8_GOFF(voffC, cur.pm); }
    const char* cB = (const char*)g.Bt + (size_t)cur.pn * tstep;
    S.a_ready(cur);
    if constexpr (SP2) {
        PG8_STAGE(PG8_SB(0, 0), cB, voffB); PG8_STAGE(PG8_SB(0, 1), cB + hstep, voffB); PG8_STAGEA(PG8_SA(0, 0), cA, 0, false); PG8_STAGEA(PG8_SA(0, 1), cA, 1, false);
        if (wr == 1) PG8_BAR;
        PG8_WAIT_V(2); PG8_BAR;
        PG8_STAGE(PG8_SB(1, 0), cB + kstep, voffB); PG8_STAGEA(PG8_SA(1, 0), cA + kstep, 0, false); PG8_STAGE(PG8_SB(1, 1), cB + hstep + kstep, voffB);
        PG8_WAIT_V(6); PG8_BAR;
    } else {
        PG8_STAGE(PG8_SB(0, 0), cB, voffB); PG8_STAGEA(PG8_SA(0, 0), cA, 0, false); PG8_STAGE(PG8_SB(0, 1), cB + hstep, voffB); PG8_STAGEA(PG8_SA(0, 1), cA, 1, false);
        if (wr == 1) PG8_BAR;
        PG8_WAIT_V(4); PG8_BAR;
        PG8_STAGE(PG8_SB(1, 0), cB + kstep, voffB); PG8_STAGEA(PG8_SA(1, 0), cA + kstep, 0, false); PG8_STAGE(PG8_SB(1, 1), cB + hstep + kstep, voffB);
        PG8_WAIT_V(6); PG8_BAR;
    }
    for (;;) {
        const bool has_next = S.next(ui + 1, nxt);
        if constexpr (GATHER) { if (has_next) { PG8_GOFF(voffN, nxt.pm); } else { _Pragma("unroll") for (int h_ = 0; h_ < 2; ++h_) _Pragma("unroll") for (int i_ = 0; i_ < 2; ++i_) voffN[h_][i_] = voffC[h_][i_]; } }
        const char* nA = (has_next && !GATHER) ? (const char*)g.A + (size_t)nxt.pm * tstep : cA; const char* nB = has_next ? (const char*)g.Bt + (size_t)nxt.pn * tstep : cB;
        for (int t = 0; t < nt; t += 2) {
            const bool last = (t == nt - 2);
            const char* a1 = cA + (size_t)(t + 1) * kstep;
            const char* a2 = last ? nA : cA + (size_t)(t + 2) * kstep; const char* b2 = last ? nB : cB + (size_t)(t + 2) * kstep;
            const char* a3 = a2 + kstep; const char* b3 = b2 + kstep;
            if (last && has_next) S.a_ready(nxt);
            if constexpr (SP2) {
            PG8_LDB(B0, 0, 0); PG8_LDB(B1, 0, 1); PG8_SCHED; PG8_LDA(At, 0, 0); PG8_STAGEA(PG8_SA(1, 1), a1, 1, false);
            PG8_WAIT_V(8); PG8_WAIT_L(0); PG8_BAR; PG8_MMA(0, 0, At, B0); PG8_MMA(0, 1, At, B1); PG8_BAR; PG8_SCHED;
            PG8_LDA(At, 0, 1); PG8_STAGE(PG8_SB(0, 0), b2, voffB); PG8_STAGE(PG8_SB(0, 1), b2 + hstep, voffB); PG8_STAGEA(PG8_SA(0, 0), a2, 0, last);
            PG8_WAIT_V(8); PG8_WAIT_L(0); PG8_BAR; PG8_MMA(1, 0, At, B0); PG8_MMA(1, 1, At, B1); PG8_BAR; PG8_SCHED;
            PG8_LDB(B0, 1, 0); PG8_LDB(B1, 1, 1); PG8_SCHED; PG8_LDA(At, 1, 0); PG8_STAGEA(PG8_SA(0, 1), a2, 1, last);
            PG8_WAIT_V(8); PG8_WAIT_L(0); PG8_BAR; PG8_MMA(0, 0, At, B0); PG8_MMA(0, 1, At, B1); PG8_BAR; PG8_SCHED;
            PG8_LDA(At, 1, 1); PG8_STAGE(PG8_SB(1, 0), b3, voffB); PG8_STAGE(PG8_SB(1, 1), b3 + hstep, voffB); PG8_STAGEA(PG8_SA(1, 0), a3, 0, last);
            PG8_WAIT_V(8); PG8_WAIT_L(0); PG8_BAR; PG8_MMA(1, 0, At, B0); PG8_MMA(1, 1, At, B1); PG8_BAR; PG8_SCHED;
            } else {
            PG8_LDB(B0, 0, 0); PG8_SCHED; PG8_LDA(At, 0, 0); PG8_STAGEA(PG8_SA(1, 1), a1, 1, false);
            PG8_WAIT_L(8); PG8_BAR; PG8_WAIT_L(0); PG8_MMA(0, 0, At, B0); PG8_BAR; PG8_SCHED;
            PG8_LDB(B1, 0, 1); PG8_STAGE(PG8_SB(0, 0), b2, voffB);
            PG8_BAR; PG8_WAIT_L(0); PG8_MMA(0, 1, At, B1); PG8_BAR;
            PG8_LDA(At, 0, 1); PG8_STAGEA(PG8_SA(0, 0), a2, 0, last);
            PG8_BAR; PG8_WAIT_L(0); PG8_MMA(1, 0, At, B0); PG8_BAR; PG8_SCHED;
            PG8_STAGE(PG8_SB(0, 1), b2 + hstep, voffB);
            PG8_WAIT_V(6); PG8_BAR; PG8_MMA(1, 1, At, B1); PG8_BAR;
            PG8_LDB(B0, 1, 0); PG8_SCHED; PG8_LDA(At, 1, 0); PG8_STAGEA(PG8_SA(0, 1), a2, 1, last);
            PG8_WAIT_L(8); PG8_BAR; PG8_WAIT_L(0); PG8_MMA(0, 0, At, B0); PG8_BAR; PG8_SCHED;
            PG8_LDB(B1, 1, 1); PG8_STAGE(PG8_SB(1, 0), b3, voffB);
            PG8_BAR; PG8_WAIT_L(0); PG8_MMA(0, 1, At, B1); PG8_BAR;
            PG8_LDA(At, 1, 1); PG8_STAGEA(PG8_SA(1, 0), a3, 0, last);
            PG8_BAR; PG8_WAIT_L(0); PG8_MMA(1, 0, At, B0); PG8_BAR; PG8_SCHED;
            PG8_STAGE(PG8_SB(1, 1), b3 + hstep, voffB);
            PG8_WAIT_V(6); PG8_BAR; PG8_MMA(1, 1, At, B1); PG8_BAR;
            }
        }
        if constexpr (ALIGN_EPI) { if (wr == 0) PG8_BAR; }
        if constexpr (!Epi::AFTER_DRAIN) { E(acc, cur, wr, wc, fr, fq); S.done(cur); }
        if (!has_next) break;
#pragma unroll
        for (int a = 0; a < 2; ++a)
#pragma unroll
            for (int b = 0; b < 2; ++b)
#pragma unroll
                for (int m = 0; m < 4; ++m)
#pragma unroll
                    for (int n = 0; n < 2; ++n) acc[a][b][m][n] = (f32x4){0.f, 0.f, 0.f, 0.f};
        cur = nxt; cA = nA; cB = nB; ++ui;
        if constexpr (GATHER) { _Pragma("unroll") for (int h_ = 0; h_ < 2; ++h_) _Pragma("unroll") for (int i_ = 0; i_ < 2; ++i_) voffC[h_][i_] = voffN[h_][i_]; }
        if constexpr (ALIGN_EPI) { if (wr == 1) PG8_BAR; }
    }
    PG8_WAIT_V(0);
    if constexpr (!ALIGN_EPI) { if (wr == 0) PG8_BAR; }
    PG8_BAR;
    if constexpr (Epi::AFTER_DRAIN) { E.fused(acc, cur, wr, wc, fr, fq, lds, wid, lane); S.done(cur); }
#undef PG8_SA
#undef PG8_SB
#undef PG8_STAGE
#undef PG8_STAGEA
#undef PG8_GOFF
#undef PG8_LDA
#undef PG8_LDB
#undef PG8_MMA
#undef PG8_WAIT_V
#undef PG8_WAIT_L
#undef PG8_BAR
#undef PG8_SCHED
}
#else
EMU_GEMM_PHASE
#endif
}
#ifndef EMU
namespace attn_body {
using bf16=unsigned short;
using bf16x8=__attribute__((ext_vector_type(8)))short;
using s16x4=__attribute__((ext_vector_type(4)))short;
using f32x16=__attribute__((ext_vector_type(16)))float;
using u32x4=__attribute__((ext_vector_type(4)))unsigned;
constexpr int D=64,DM=64;
constexpr int NW=8,QBLK=32,QB=QBLK*NW,KVBLK=64;
__device__ __forceinline__ int crow(int r,int hi){return (r&3)+8*(r>>2)+4*hi;}
#define SBAR() __builtin_amdgcn_sched_barrier(0)
constexpr int NSLOT=3, SLOTB=8192;
constexpr int LDS_K=0, LDS_V=NSLOT*SLOTB, LDS_WS=2*NSLOT*SLOTB, LDS_OST=LDS_WS+NW*64*4, LDS_BYTES=LDS_OST+NW*4096;
__device__ __forceinline__ void glds16(const void*gsrc,unsigned lds_dst){unsigned keep;
  asm volatile("s_mov_b32 %0, m0\n\ts_mov_b32 m0, %2\n\ts_nop 0\n\tglobal_load_lds_dwordx4 %1, off\n\ts_mov_b32 m0, %0":"=&s"(keep):"v"(gsrc),"s"(lds_dst):"memory");}
__device__ __forceinline__ float max3f(float a,float b,float c){float r;asm("v_max3_f32 %0, %1, %2, %3":"=v"(r):"v"(a),"v"(b),"v"(c));return r;}
__device__ __forceinline__ float max2f(float a,float b){float r;asm("v_max_f32_e32 %0, %1, %2":"=v"(r):"v"(a),"v"(b));return r;}
__device__ __forceinline__ float fadd_s(float a,float b){float r;asm("v_add_f32_e32 %0, %1, %2":"=v"(r):"v"(a),"v"(b));return r;}
__device__ __forceinline__ float fsub_s(float a,float b){float r;asm("v_sub_f32_e32 %0, %1, %2":"=v"(r):"v"(a),"v"(b));return r;}
typedef float f32x2_t __attribute__((ext_vector_type(2))); typedef __bf16 bf16x2_t __attribute__((ext_vector_type(2)));
__device__ __forceinline__ unsigned cvtpk_s(float lo,float hi){f32x2_t v={lo,hi};bf16x2_t b=__builtin_convertvector(v,bf16x2_t);return __builtin_bit_cast(unsigned,b);}
#define WAIT_BAR(N) asm volatile("s_waitcnt vmcnt(" #N ") lgkmcnt(0)\n\ts_barrier":::"memory")

template<int MODE> __device__ __forceinline__ constexpr bool d0_on(int d0){ return MODE==0 || (MODE==1 && d0<2) || (MODE==2 && d0>=2); }
template<int MODE> __device__ __forceinline__ void qkt(f32x16&p0,f32x16&p1,const char*Kslot,const bf16x8*qr,const f32x16&negm,int r32,int hi){
  const char*kb=Kslot+hi*1024+r32*16;
  constexpr int D0A=(MODE==2)?2:0, D0B=(MODE==1)?2:4;
  #pragma unroll
  for(int d0=D0A;d0<D0B;++d0){
    const bf16x8 b0=*reinterpret_cast<const bf16x8*>(kb+d0*2048);
    const bf16x8 b1=*reinterpret_cast<const bf16x8*>(kb+d0*2048+512);
    if(d0==D0A){p0=__builtin_amdgcn_mfma_f32_32x32x16_bf16(b0,qr[d0],negm,0,0,0);p1=__builtin_amdgcn_mfma_f32_32x32x16_bf16(b1,qr[d0],negm,0,0,0);}
    else{p0=__builtin_amdgcn_mfma_f32_32x32x16_bf16(b0,qr[d0],p0,0,0,0);p1=__builtin_amdgcn_mfma_f32_32x32x16_bf16(b1,qr[d0],p1,0,0,0);}}
}
template<int MODE,int IDX> __device__ __forceinline__ void qk_mf(f32x16&Cx,const bf16x8&k,const bf16x8&q,const f32x16&negm){
  if constexpr(d0_on<MODE>(IDX>>1)){ constexpr bool first=((IDX>>1)==((MODE==2)?2:0));
    if constexpr(first) Cx=__builtin_amdgcn_mfma_f32_32x32x16_bf16(k,q,negm,0,0,0); else Cx=__builtin_amdgcn_mfma_f32_32x32x16_bf16(k,q,Cx,0,0,0); }
}
typedef __attribute__((address_space(3))) const char* lds_cptr;
typedef short v4i16_t __attribute__((ext_vector_type(4)));
template<int MODE> __device__ __forceinline__ void kload8(bf16x8*kf,lds_cptr kp){
  #pragma unroll
  for(int j=0;j<4;++j) if(d0_on<MODE>(j)){ kf[2*j]=*(const __attribute__((address_space(3))) bf16x8*)(kp+j*2048); kf[2*j+1]=*(const __attribute__((address_space(3))) bf16x8*)(kp+j*2048+512); }
}
__device__ __forceinline__ void kload2(bf16x8*kf,lds_cptr kp,int j){ kf[2*j]=*(const __attribute__((address_space(3))) bf16x8*)(kp+j*2048); kf[2*j+1]=*(const __attribute__((address_space(3))) bf16x8*)(kp+j*2048+512); }
__device__ __forceinline__ s16x4 vtr(lds_cptr p){ return __builtin_bit_cast(s16x4,__builtin_amdgcn_ds_read_tr16_b64_v4i16((__attribute__((address_space(3))) v4i16_t*)p)); }
__device__ __forceinline__ float rowmax(const f32x16&p0,const f32x16&p1){
  float a=max3f(p0[0],p0[1],p1[0]),b=max3f(p0[2],p0[3],p1[1]);a=max3f(a,p1[2],p1[3]);
  #pragma unroll
  for(int r=4;r<16;r+=4){a=max3f(a,p0[r],p0[r+1]);b=max3f(b,p0[r+2],p0[r+3]);a=max3f(a,p1[r],p1[r+1]);b=max3f(b,p1[r+2],p1[r+3]);}
  const float m=max2f(a,b);
  auto rr=__builtin_amdgcn_permlane32_swap(__float_as_uint(m),__float_as_uint(m),false,false);
  return max2f(__uint_as_float(rr[0]),__uint_as_float(rr[1]));
}
__device__ __forceinline__ void pv(f32x16*o,int vb,bf16x8 pa0,bf16x8 pa1,bf16x8 pa2,bf16x8 pa3){
  #pragma unroll
  for(int d0=0;d0<2;++d0){s16x4 lo[4],hi[4];
    #pragma unroll
    for(int ks=0;ks<4;++ks){
      asm volatile("ds_read_b64_tr_b16 %0,%1 offset:%c2":"=&v"(lo[ks]):"v"(vb),"i"(d0*4096+ks*1024):"memory");
      asm volatile("ds_read_b64_tr_b16 %0,%1 offset:%c2":"=&v"(hi[ks]):"v"(vb),"i"(d0*4096+ks*1024+512):"memory");}
    asm volatile("s_waitcnt lgkmcnt(0)":::"memory");SBAR();
    #define PK(k) (bf16x8){lo[k][0],lo[k][1],lo[k][2],lo[k][3],hi[k][0],hi[k][1],hi[k][2],hi[k][3]}
    o[d0]=__builtin_amdgcn_mfma_f32_32x32x16_bf16(pa0,PK(0),o[d0],0,0,0);
    o[d0]=__builtin_amdgcn_mfma_f32_32x32x16_bf16(pa1,PK(1),o[d0],0,0,0);
    o[d0]=__builtin_amdgcn_mfma_f32_32x32x16_bf16(pa2,PK(2),o[d0],0,0,0);
    o[d0]=__builtin_amdgcn_mfma_f32_32x32x16_bf16(pa3,PK(3),o[d0],0,0,0);
    #undef PK
  }
}

#ifndef ATTN_STORE16
#define ATTN_STORE16(p,v) (*(u32x4*)(p)=(v))
#endif
template<int THRL,int MODE> __device__ __forceinline__ void attn_unit(const bf16*Qa,const bf16*Qb,const bf16*__restrict__ Kh,const bf16*__restrict__ Vh,bf16*Oa,bf16*Ob,int opitch,int NT,char*shm,float lam,float post,const float*subln){
  int tid_=threadIdx.x; asm volatile("":"+v"(tid_)); const int tid=tid_,lane=tid&63,r32=lane&31,hi=lane>>5; const int wid=__builtin_amdgcn_readfirstlane(tid>>6);
  const bf16*Qw=(wid<4?Qa:Qb)+(long)((wid&3)*QBLK)*DM;
  const unsigned lds0=(unsigned)(uintptr_t)shm;
  float*wsf=(float*)(shm+LDS_WS)+wid*64;
  const bf16*ksrc=Kh+(long)lane*DM+wid*8;
  const bf16*vsrc=Vh+(long)(16*(wid&3)+(lane>>2))*DM+(wid>>2)*32+(lane&3)*8;
  const unsigned kdst=lds0+LDS_K+wid*1024, vdst=lds0+LDS_V+wid*1024;
  #define DMA_K(t,slot) glds16(ksrc+(long)(t)*KVBLK*DM,(unsigned)__builtin_amdgcn_readfirstlane(kdst+(slot)))
  #define DMA_V(t,slot) glds16(vsrc+(long)(t)*KVBLK*DM,(unsigned)__builtin_amdgcn_readfirstlane(vdst+(slot)))
  const int vb0=(int)(lds0+LDS_V)+((lane>>4)&1)*32+(lane&3)*8+(4*hi+((lane&15)>>2))*64;
  const char*Kbase=shm+LDS_K; bf16x8 kf[8];
  const lds_cptr shm3=(lds_cptr)shm; const lds_cptr kp0=shm3+LDS_K+hi*1024+r32*16; const lds_cptr vp0=shm3+LDS_V+((lane>>4)&1)*32+(lane&3)*8+(4*hi+((lane&15)>>2))*64;
  DMA_K(0,0);DMA_V(0,0);DMA_K(1,SLOTB);
  bf16x8 qr[4];
  #pragma unroll
  for(int d0=0;d0<4;++d0)qr[d0]=*reinterpret_cast<const bf16x8*>(&Qw[(long)r32*DM+d0*16+hi*8]);
  float mhat=0.f,l_reg=0.f;f32x16 o[2];o[0]=f32x16{};o[1]=f32x16{};f32x16 negm=f32x16{};asm volatile("":"+v"(negm));
  #define CMASK(P0,P1,t) do{}while(0)
  bool resc=false;
  #define START(P0,P1) do{ const float rm=rowmax(P0,P1); resc=false; \
    { const float dl=rm; mhat=fadd_s(mhat,dl); \
      _Pragma("unroll") for(int r=0;r<16;++r){P0[r]=fsub_s(P0[r],dl);P1[r]=fsub_s(P1[r],dl);} \
      _Pragma("unroll") for(int r=0;r<16;++r)negm[r]=-mhat; asm volatile("":"+v"(negm)); } \
    _Pragma("unroll") for(int r=0;r<16;++r)P0[r]=__builtin_amdgcn_exp2f(P0[r]); }while(0)
  #define RESC() do{ if(resc){ asm volatile("s_waitcnt lgkmcnt(0)":::"memory"); \
      _Pragma("unroll") for(int d_=0;d_<2;++d_) _Pragma("unroll") for(int r=0;r<16;++r)o[d_][r]*=wsf[crow(r,hi)]; } }while(0)
  f32x16 pA0,pA1,pB0,pB1;
  int sl_prev=0,sl_cur=0,sl_next=SLOTB;
  #define ROT() do{sl_prev=sl_cur;sl_cur=sl_next;sl_next=(sl_next==(NSLOT-1)*SLOTB)?0:sl_next+SLOTB;}while(0)
  DMA_K(2,2*SLOTB);
  WAIT_BAR(3);
  qkt<MODE>(pA0,pA1,Kbase,qr,negm,r32,hi);asm volatile("s_nop 15\n\ts_nop 7":"+v"(pA0),"+v"(pA1));CMASK(pA0,pA1,0);
  START(pA0,pA1);
  _Pragma("unroll") for(int r=0;r<16;++r)pA1[r]=__builtin_amdgcn_exp2f(pA1[r]);
  WAIT_BAR(0);
  DMA_K(3,0);DMA_V(1,SLOTB);
  ROT();
  kload8<MODE>(kf,kp0+sl_cur);
  WAIT_BAR(2);
  s16x4 vlo[8],vhi[8]; u32x4 pw0,pw1,pw2,pw3;
  #define PKW(P,B) cvtpk_s(P[B],P[B+1])
  #define PAF(k) __builtin_bit_cast(bf16x8,pw##k)
  #define VFR(i) (bf16x8){vlo[i][0],vlo[i][1],vlo[i][2],vlo[i][3],vhi[i][0],vhi[i][1],vhi[i][2],vhi[i][3]}
  #define PIN(x) asm volatile("":"+v"(x))
  #define MX3(a,b,c) __builtin_fmaxf(__builtin_fmaxf((a),(b)),(c))
  #define GAPA(MF,A0,A1,A2,A3,W0,W1,PW) do{ MF; sacc+=A0; sacc+=A1; sacc+=A2; sacc+=A3; PIN(sacc); W0; W1; PIN(PW); SBAR(); }while(0)
  #define EX(v) __builtin_amdgcn_exp2f(v)
  #define GAPB(MF,X,B) do{ MF; X[B]=EX(X[B]); X[B+1]=EX(X[B+1]); X[B+2]=EX(X[B+2]); X[B+3]=EX(X[B+3]); PIN(X); SBAR(); }while(0)
  #define VRD(i) do{ vlo[i]=vtr(vp_+(((i)>>2)*4096+((i)&3)*1024)); vhi[i]=vtr(vp_+(((i)>>2)*4096+((i)&3)*1024+512)); }while(0)
  #define KRD(G,j) do{ if((G)&&d0_on<MODE>(j)){ kload2(kf,kp0+sl_next,j); SBAR(); } }while(0)
  #define STEP(C0,C1,P0,P1,t,GK,GV,GL) do{ SBAR(); \
    const lds_cptr vp_=vp0+sl_prev; \
    VRD(0); SBAR(); float sacc=(P0[0]+P0[1]); \
    GAPA((qk_mf<MODE,0>(C0,kf[0],qr[0],negm)), P0[2],P0[3],P0[4],P0[5],     pw0[0]=PKW(P0,0), pw0[1]=PKW(P0,2), pw0); \
    VRD(4); SBAR(); GAPA((qk_mf<MODE,1>(C1,kf[1],qr[0],negm)), P0[6],P0[7],P0[8],P0[9],     pw0[2]=PKW(P0,4), pw0[3]=PKW(P0,6), pw0); \
    VRD(1); SBAR(); GAPA((qk_mf<MODE,2>(C0,kf[2],qr[1],negm)),   P0[10],P0[11],P0[12],P0[13], pw1[0]=PKW(P0,8), pw1[1]=PKW(P0,10), pw1); \
    VRD(5); SBAR(); GAPA((qk_mf<MODE,3>(C1,kf[3],qr[1],negm)),   P0[14],P0[15],P1[0],P1[1],   pw1[2]=PKW(P0,12),pw1[3]=PKW(P0,14), pw1); \
    VRD(2); SBAR(); GAPA((qk_mf<MODE,4>(C0,kf[4],qr[2],negm)),   P1[2],P1[3],P1[4],P1[5],     pw2[0]=PKW(P1,0), pw2[1]=PKW(P1,2), pw2); \
    VRD(6); SBAR(); GAPA((qk_mf<MODE,5>(C1,kf[5],qr[2],negm)),   P1[6],P1[7],P1[8],P1[9],     pw2[2]=PKW(P1,4), pw2[3]=PKW(P1,6), pw2); \
    VRD(3); SBAR(); GAPA((qk_mf<MODE,6>(C0,kf[6],qr[3],negm)),   P1[10],P1[11],P1[12],P1[13], pw3[0]=PKW(P1,8), pw3[1]=PKW(P1,10), pw3); \
    VRD(7); SBAR(); GAPA((qk_mf<MODE,7>(C1,kf[7],qr[3],negm)),   P1[14],P1[15],0.f,0.f,       pw3[2]=PKW(P1,12),pw3[3]=PKW(P1,14), pw3); \
    l_reg+=sacc; \
    if(GK){DMA_K((t)+3,sl_cur);} if(GV){DMA_V((t)+1,sl_next);} \
    CMASK(C0,C1,t); \
    { float a=MX3(C0[0],C0[1],C1[0]),b=MX3(C0[2],C0[3],C1[1]); a=MX3(a,C1[2],C1[3]); \
      _Pragma("unroll") for(int r=4;r<16;r+=4){a=MX3(a,C0[r],C0[r+1]);b=MX3(b,C0[r+2],C0[r+3]);a=MX3(a,C1[r],C1[r+1]);b=MX3(b,C1[r+2],C1[r+3]);} \
      float rm=__builtin_fmaxf(a,b); { auto rr=__builtin_amdgcn_permlane32_swap(__float_as_uint(rm),__float_as_uint(rm),false,false); rm=__builtin_fmaxf(__uint_as_float(rr[0]),__uint_as_float(rr[1])); } \
      resc=false; \
      if(__builtin_expect(__any(rm>(float)THRL),0)){ const float dl=__builtin_fmaxf(rm,0.f); mhat+=dl; \
        _Pragma("unroll") for(int r=0;r<16;++r){C0[r]-=dl;C1[r]-=dl;} \
        _Pragma("unroll") for(int r=0;r<16;++r)negm[r]=-mhat; asm volatile("":"+v"(negm)); \
        const float f=__builtin_amdgcn_exp2f(-dl); l_reg*=f; if(hi==0)wsf[r32]=f; resc=true; } } \
    SBAR(); \
    GAPB(o[0]=__builtin_amdgcn_mfma_f32_32x32x16_bf16(PAF(0),VFR(0),o[0],0,0,0), C0,0); \
    GAPB(o[1]=__builtin_amdgcn_mfma_f32_32x32x16_bf16(PAF(0),VFR(4),o[1],0,0,0), C0,4); \
    KRD(GL,0); GAPB(o[0]=__builtin_amdgcn_mfma_f32_32x32x16_bf16(PAF(1),VFR(1),o[0],0,0,0), C0,8); \
    KRD(GL,1); GAPB(o[1]=__builtin_amdgcn_mfma_f32_32x32x16_bf16(PAF(1),VFR(5),o[1],0,0,0), C0,12); \
    KRD(GL,2); GAPB(o[0]=__builtin_amdgcn_mfma_f32_32x32x16_bf16(PAF(2),VFR(2),o[0],0,0,0), C1,0); \
    KRD(GL,3); GAPB(o[1]=__builtin_amdgcn_mfma_f32_32x32x16_bf16(PAF(2),VFR(6),o[1],0,0,0), C1,4); \
    GAPB(o[0]=__builtin_amdgcn_mfma_f32_32x32x16_bf16(PAF(3),VFR(3),o[0],0,0,0), C1,8); \
    GAPB(o[1]=__builtin_amdgcn_mfma_f32_32x32x16_bf16(PAF(3),VFR(7),o[1],0,0,0), C1,12); \
    }while(0)
  int t=1;
  for(;t+5<NT;t+=2){
    STEP(pB0,pB1,pA0,pA1,t,true,true,true);     WAIT_BAR(2); RESC(); ROT();
    STEP(pA0,pA1,pB0,pB1,t+1,true,true,true);   WAIT_BAR(2); RESC(); ROT();
  }
  #define ENDW(tt) do{ if((tt)+3<NT){WAIT_BAR(2);} else if((tt)+2<NT){WAIT_BAR(1);} else {WAIT_BAR(0);} }while(0)
  for(;t+1<NT;t+=2){
    STEP(pB0,pB1,pA0,pA1,t,(t+3<NT),(t+1<NT),(t+1<NT));       ENDW(t);   RESC(); ROT();
    STEP(pA0,pA1,pB0,pB1,t+1,(t+4<NT),(t+2<NT),(t+2<NT));     ENDW(t+1); RESC(); ROT();
  }
  STEP(pB0,pB1,pA0,pA1,NT-1,false,false,false); RESC();
  { float sacc=pB0[0]+pB0[1]; _Pragma("unroll") for(int r=2;r<16;++r)sacc+=pB0[r]; _Pragma("unroll") for(int r=0;r<16;++r)sacc+=pB1[r]; l_reg+=sacc;
    pw0=(u32x4){PKW(pB0,0),PKW(pB0,2),PKW(pB0,4),PKW(pB0,6)};pw1=(u32x4){PKW(pB0,8),PKW(pB0,10),PKW(pB0,12),PKW(pB0,14)};pw2=(u32x4){PKW(pB1,0),PKW(pB1,2),PKW(pB1,4),PKW(pB1,6)};pw3=(u32x4){PKW(pB1,8),PKW(pB1,10),PKW(pB1,12),PKW(pB1,14)};
    SBAR(); pv(o,vb0+sl_cur,PAF(0),PAF(1),PAF(2),PAF(3)); }
  #undef PKW
  #undef PAF
  #undef VFR
  #undef PIN
  #undef MX3
  #undef GAPA
  #undef GAPB
  #undef EX
  #undef VRD
  #undef KRD
  #undef STEP
  #undef ENDW
  {auto rr=__builtin_amdgcn_permlane32_swap(__float_as_uint(l_reg),__float_as_uint(l_reg),false,false);l_reg=__uint_as_float(rr[0])+__uint_as_float(rr[1]);}
  if(hi==0)wsf[32+r32]=l_reg;asm volatile("s_waitcnt lgkmcnt(0)":::"memory");
  float rli[16];
  #pragma unroll
  for(int r=0;r<16;++r)rli[r]=__builtin_amdgcn_rcpf(wsf[32+crow(r,hi)]);
  bf16*Ow=(wid<4?Oa:Ob)+(long)((wid&3)*QBLK)*opitch;
  { bf16*stg=(bf16*)(shm+LDS_OST)+wid*2048;
    #pragma unroll
    for(int r=0;r<16;++r){const int orow=crow(r,hi);
      #pragma unroll
      for(int d0=0;d0<2;++d0)stg[orow*64+d0*32+r32]=(bf16)f2bf(o[d0][r]*rli[r]);}
    asm volatile("s_waitcnt lgkmcnt(0)":::"memory");
    if constexpr(MODE==0){
      #pragma unroll
      for(int i=0;i<4;++i){const int row=i*8+(lane>>3),ch=lane&7; const u32x4 v=*(const u32x4*)(stg+row*64+ch*8); ATTN_STORE16(Ow+(long)row*opitch+ch*8,v);}
    } else {
      asm volatile("s_barrier":::"memory");
      if constexpr(MODE==1){ const bf16*stg2=stg+4*2048; const int ch=lane&7; float sb[8];
        #pragma unroll
        for(int e=0;e<8;++e)sb[e]=subln[ch*8+e]*post;
        #pragma unroll
        for(int i=0;i<4;++i){const int row=i*8+(lane>>3); const u32x4 v1=*(const u32x4*)(stg+row*64+ch*8),v2=*(const u32x4*)(stg2+row*64+ch*8);
          float od[8]; float ss=0.f;
          #pragma unroll
          for(int e=0;e<4;++e){ od[2*e]=bflo(v1[e])-lam*bflo(v2[e]); od[2*e+1]=bfhi(v1[e])-lam*bfhi(v2[e]); ss+=od[2*e]*od[2*e]+od[2*e+1]*od[2*e+1]; }
          ss+=__shfl_xor(ss,1); ss+=__shfl_xor(ss,2); ss+=__shfl_xor(ss,4);
          const float rn=__builtin_amdgcn_rsqf(ss*(1.f/64.f)+1e-6f);
          u32x4 w; w[0]=pk2(od[0]*rn*sb[0],od[1]*rn*sb[1]); w[1]=pk2(od[2]*rn*sb[2],od[3]*rn*sb[3]); w[2]=pk2(od[4]*rn*sb[4],od[5]*rn*sb[5]); w[3]=pk2(od[6]*rn*sb[6],od[7]*rn*sb[7]);
          ATTN_STORE16(Ow+(long)row*opitch+ch*8,w);} }
    } }
  asm volatile("s_waitcnt lgkmcnt(0)\n\ts_barrier":::"memory");
  #undef DMA_K
  #undef DMA_V
  #undef CMASK
  #undef START
  #undef RESC
  #undef ROT
}
constexpr int ATTN_LDS_BYTES=LDS_BYTES;
#undef SBAR
#undef WAIT_BAR
}
#else
EMU_ATTN_BODY
#endif
#ifndef EMU
#define XB_TMO      128
#define XB_XCNT(j)  (256  + 64 * (j))
#define XB_XSUB(j)  (1280 + 64 * (j))
#define XB_XGEN(j)  (2304 + 64 * (j))
#define XB_TOP      3328
#define XB_TOPGEN   3392
#define XCD_BAR_WORDS 3456
#define XB_SPIN_CAP (1u << 18)

__device__ __forceinline__ unsigned xb_ld(unsigned* p)              { return __hip_atomic_load(p, __ATOMIC_RELAXED, __HIP_MEMORY_SCOPE_AGENT); }
__device__ __forceinline__ unsigned xb_add(unsigned* p, unsigned v) { return __hip_atomic_fetch_add(p, v, __ATOMIC_RELAXED, __HIP_MEMORY_SCOPE_AGENT); }
__device__ __forceinline__ unsigned xb_xcc_id() { return (unsigned)__builtin_amdgcn_s_getreg((3 << 11) | 20) & 0xFu; }
#define XB_SPIN(cond, bar) do { unsigned _sp = 0; while (cond) { __builtin_amdgcn_s_sleep(1); \
    if ((++_sp & 255u) == 0u) { if (xb_ld(&(bar)[XB_TMO])) break; if (_sp > XB_SPIN_CAP) { atomicAdd(&(bar)[XB_TMO], 1u); break; } } } } while (0)

struct XcdBarrier {
    unsigned* bar; unsigned x;
    volatile LAS unsigned* st;
};

__device__ __forceinline__ XcdBarrier xcd_barrier_post(unsigned* bar, volatile LAS unsigned* st) {
    XcdBarrier b; b.bar = bar; b.x = xb_xcc_id(); b.st = st;
    if (threadIdx.x == 0) (void)xb_add(&bar[XB_XCNT(b.x)], 1u);
    return b;
}
__device__ __forceinline__ void xcd_barrier_complete(unsigned* bar, unsigned x, unsigned& nloc, unsigned& nx) {
    const unsigned G = gridDim.x * gridDim.y * gridDim.z;
    unsigned sum, cnt, mine, sp = 0u;
    for (;;) {
        sum = 0u; cnt = 0u; mine = 0u;
#pragma unroll
        for (unsigned j = 0; j < 16; ++j) { const unsigned c = xb_ld(&bar[XB_XCNT(j)]); sum += c; cnt += (c > 0u) ? 1u : 0u; mine = (j == x) ? c : mine; }
        if (sum == G) break;
        __builtin_amdgcn_s_sleep(1);
        if ((++sp & 255u) == 0u) { if (xb_ld(&bar[XB_TMO])) break; if (sp > XB_SPIN_CAP) { atomicAdd(&bar[XB_TMO], 1u); break; } }
    }
    nloc = mine > 0u ? mine : 1u; nx = cnt > 0u ? cnt : 1u;
}

__device__ __forceinline__ void xcd_barrier(const XcdBarrier& b) {
    asm volatile("s_waitcnt vmcnt(0)" ::: "memory");
    __syncthreads();
    if (threadIdx.x == 0) {
        unsigned* bar = b.bar;
        __builtin_amdgcn_s_waitcnt(0);
        unsigned nloc = b.st[0], nx = b.st[1];
        if (nloc == 0u) { xcd_barrier_complete(bar, b.x, nloc, nx); b.st[0] = nloc; b.st[1] = nx; }
        const unsigned old = xb_add(&bar[XB_XSUB(b.x)], 1u);
        const unsigned gen = old / nloc;
        if (old + 1u == (gen + 1u) * nloc) {
            __builtin_amdgcn_fence(__ATOMIC_RELEASE, "agent");
            asm volatile("s_waitcnt vmcnt(0)" ::: "memory");
            const unsigned og = xb_add(&bar[XB_TOP], 1u);
            const unsigned tg = og / nx;
            if (og + 1u == (tg + 1u) * nx) xb_add(&bar[XB_TOPGEN], 1u);
            else XB_SPIN(xb_ld(&bar[XB_TOPGEN]) == tg, bar);
            __builtin_amdgcn_fence(__ATOMIC_ACQUIRE, "agent");
            xb_add(&bar[XB_XGEN(b.x)], 1u);
            asm volatile("s_waitcnt vmcnt(0)" ::: "memory");
        } else {
            XB_SPIN(xb_ld(&bar[XB_XGEN(b.x)]) == gen, bar);
            __builtin_amdgcn_fence(__ATOMIC_ACQUIRE, "agent");
            asm volatile("s_waitcnt vmcnt(0)" ::: "memory");
        }
    }
    __syncthreads();
}
#endif

constexpr int LDS_BYTES = 147456;
constexpr int MISC_OFF = 139264;
constexpr int PTR_OFF = MISC_OFF + 256;
struct Ctx {
    LAS unsigned char* lds;
    int tid, lane, wave, bid, G;
    float* out; unsigned long long wsi;
};
DEVI const float* inp_ptr(const Ctx& C, int i) {
    const unsigned long long v = ((const LAS unsigned long long*)(C.lds + PTR_OFF))[i];
    const unsigned lo = __builtin_amdgcn_readfirstlane((unsigned)v), hi = __builtin_amdgcn_readfirstlane((unsigned)(v >> 32));
    return (const float*)(const GAS float*)(((unsigned long long)hi << 32) | lo);
}
#define INP(i) inp_ptr(C, i)
#define WSP(T, off) ((T*)(GAS T*)(C.wsi + (unsigned long long)(off)))
DEVI int mod_row(int r) { return r < T_L ? r / SEQ : 8; }
DEVI const float* mod_vec(const Ctx& C, int layer, int mrow, int which) { return WSP(const float, WS_MOD) + ((size_t)(layer * 9 + mrow) * 6 + which) * D; }

DEVI void transpose_item(const float* W, int ldw, int k0, int n0, bf16* WT, int orow0, int Kp, LAS float* scr, int lane) {
    { const int kr = lane >> 3, c4 = (lane & 7) * 4; f32x4 v[8];
#pragma unroll
      for (int i = 0; i < 8; ++i) v[i] = *(const f32x4*)(W + (size_t)(k0 + 8 * i + kr) * ldw + n0 + c4);
#pragma unroll
      for (int i = 0; i < 8; ++i) { LAS float* d = scr + (8 * i + kr) * 33 + c4; d[0] = v[i].x; d[1] = v[i].y; d[2] = v[i].z; d[3] = v[i].w; } }
    LDS_WAIT();
    const int c = lane & 7;
#pragma unroll
    for (int j = 0; j < 4; ++j) { const int n = (lane >> 3) + 8 * j; const LAS float* s = scr + (8 * c) * 33 + n;
        v4u o; o.x = pk2(s[0 * 33], s[1 * 33]); o.y = pk2(s[2 * 33], s[3 * 33]); o.z = pk2(s[4 * 33], s[5 * 33]); o.w = pk2(s[6 * 33], s[7 * 33]);
        *(v4u*)(WT + (size_t)(orow0 + n) * Kp + k0 + 8 * c) = o; }
    LDS_WAIT();
}
DEVI void convert_layer_weights(const Ctx& C, int layer, int part) {
    LAS float* scr = (LAS float*)(C.lds + C.wave * 16384);
    const int gw = C.bid * 8 + C.wave, NGW = C.G * 8;
    constexpr int I_IN = 16 * (N_PROJ / 32), I_OUT = 16 * (D / 32), I_UP = NE * 16 * (2 * DE / 32), I_DN = NE * 16 * (D / 32), I_LAYER = I_IN + I_OUT + I_UP + I_DN;
    const int it_lo = (part == 1) ? I_IN + I_OUT : 0, it_hi = (part == 0) ? I_IN + I_OUT : I_LAYER;
    for (int it = it_lo + gw; it < it_hi; it += NGW) {
        int r = it;
        if (r < I_IN) { const int kb = r / (N_PROJ / 32), nb = r % (N_PROJ / 32);
            transpose_item(INP(8) + (size_t)layer * D * D_IN, D_IN, 64 * kb, 32 * nb, WSP(bf16, WS_WIN) + (size_t)layer * N_PROJ * D, 32 * nb, D, scr, C.lane); continue; }
        r -= I_IN;
        if (r < I_OUT) { const int kb = r / (D / 32), nb = r % (D / 32);
            transpose_item(INP(9) + (size_t)layer * D * D, D, 64 * kb, 32 * nb, WSP(bf16, WS_WOUT) + (size_t)layer * D * D, 32 * nb, D, scr, C.lane); continue; }
        r -= I_OUT;
        if (r < I_UP) { const int e = r / (16 * 64), q = r % (16 * 64), kb = q / 64, nb = q % 64; const int n0 = 32 * nb;
            const int orow = (n0 < DE) ? (n0 / 128) * 256 + (n0 % 128) : ((n0 - DE) / 128) * 256 + 128 + ((n0 - DE) % 128);
            transpose_item(INP(26) + ((size_t)layer * NE + e) * D * 2 * DE, 2 * DE, 64 * kb, n0, WSP(bf16, WS_WUP) + ((size_t)layer * NE + e) * 2 * DE * D, orow, D, scr, C.lane); continue; }
        r -= I_UP;
        { const int e = r / (16 * 32), q = r % (16 * 32), kb = q / 32, nb = q % 32;
            transpose_item(INP(28) + ((size_t)layer * NE + e) * DE * D, D, 64 * kb, 32 * nb, WSP(bf16, WS_WDN) + ((size_t)layer * NE + e) * D * DE, 32 * nb, DE, scr, C.lane); }
    }
}
DEVI void p0_prologue(const Ctx& C) {
    convert_layer_weights(C, 0, 0);
    {
      float* tab = WSP(float, WS_ROPE);
      for (int i = C.bid * 512 + C.tid; i < SEQ * 48; i += C.G * 512) { const int t = i / 48, j = i % 48; const float rp = (float)(t / GRID_W), cp = (float)(t % GRID_W); float c, s;
          if (j < 32) { const float ang = (j < 16 ? rp : cp) * __builtin_amdgcn_exp2f(-(float)(j & 15) * (13.287712379549449f / 16.f)); const float tt = __builtin_amdgcn_fractf(ang * 0.15915494309189535f); c = __builtin_amdgcn_cosf(tt); s = __builtin_amdgcn_sinf(tt);
              tab[(size_t)t * 32 + j] = c; tab[(size_t)SEQ * 32 + (size_t)t * 32 + j] = s; }
          else { const int i2 = j - 32; const float ang = (i2 < 8 ? rp : cp) * __builtin_amdgcn_exp2f(-(float)(i2 & 7) * (13.287712379549449f / 8.f)); const float tt = __builtin_amdgcn_fractf(ang * 0.15915494309189535f); c = __builtin_amdgcn_cosf(tt); s = __builtin_amdgcn_sinf(tt);
              tab[(size_t)SEQ * 64 + (size_t)t * 16 + i2] = c; tab[(size_t)SEQ * 80 + (size_t)t * 16 + i2] = s; } } }
    __syncthreads();
    LAS float* sc = (LAS float*)C.lds;
    LAS float* red = sc + 9 * D;
    for (int i = C.tid; i < 9 * D; i += 512) { const int r = i / D, k = i % D; float v = 0.f; if (r < NB) v = INP(1)[r * D + k]; else if (r == 8) v = INP(3)[k]; sc[i] = siluf_(v); }
    __syncthreads();
    for (int u = C.bid; u < DEPTH * 96; u += C.G) {
        const int layer = u / 96, n0 = (u % 96) * 64, col = C.tid & 63, kg = C.tid >> 6;
        const float* w = INP(4) + (size_t)layer * D * 6 * D + n0 + col;
        float acc[9];
#pragma unroll
        for (int r = 0; r < 9; ++r) acc[r] = 0.f;
#pragma unroll 8
        for (int k = kg * 128; k < kg * 128 + 128; ++k) { const float wv = w[(size_t)k * 6 * D];
#pragma unroll
            for (int r = 0; r < 9; ++r) acc[r] += sc[r * D + k] * wv; }
#pragma unroll
        for (int r = 0; r < 9; ++r) red[(kg * 9 + r) * 64 + col] = acc[r];
        __syncthreads();
        for (int i = C.tid; i < 9 * 64; i += 512) { const int r = i >> 6, c2 = i & 63; float s = 0.f;
#pragma unroll
            for (int g = 0; g < 8; ++g) s += red[(g * 9 + r) * 64 + c2];
            WSP(float, WS_MOD)[((size_t)(layer * 9 + r)) * 6 * D + n0 + c2] = s + INP(5)[(size_t)layer * 6 * D + n0 + c2]; }
        __syncthreads();
    }
}

DEVI void ph_norm_mix(const Ctx& C, int layer) {
    const bool fin = (layer == DEPTH);
    const int nrows = fin ? T_L : T_ALL;
    if (layer == 0) {
        for (int it = C.bid * 8 + C.wave; it < DEPTH * 9 * NE; it += C.G * 8) {
            const int e = it % NE, m = (it / NE) % 9, l = it / (NE * 9);
            const float* gn = INP(7) + (size_t)l * D; const float* sh = mod_vec(C, l, m, 3); const float* scl = mod_vec(C, l, m, 4); const float* rw = INP(24) + (size_t)l * D * NE + e;
            float* dst = WSP(float, WS_RWP) + (size_t)it * D; float bsum = 0.f;
#pragma unroll 4
            for (int j = 0; j < 16; ++j) { const int k = 64 * j + C.lane; const float w = rw[(size_t)k * NE]; dst[k] = gn[k] * (1.f + scl[k]) * w; bsum += sh[k] * w; }
            bsum = wave_sum(bsum); if (C.lane == 0) WSP(float, WS_RBP)[it] = bsum + INP(25)[l * NE + e];
        }
    }
    LAS float* w16 = (LAS float*)C.lds;
    if (!fin) { for (int i = C.tid; i < 16 * D; i += 512) { const int k = i >> 4, j = i & 15; w16[j * D + k] = INP(8)[((size_t)layer * D + k) * D_IN + N_PROJ + j]; } }
    __syncthreads();
    const float* gmain = fin ? INP(30) : INP(6) + (size_t)layer * D;
    const int rstep = C.G * 8;
    int s4[2][4]; float g4[2][4];
#define NM_SLOTS(dst_s, dst_g, rbase) do { _Pragma("unroll") for (int u2 = 0; u2 < 2; ++u2) { const int rr_ = (rbase) + u2 * rstep; const int rc_ = rr_ < nrows ? rr_ : 0; \
        const int* sl_ = WSP(const int, WS_SLOT) + (size_t)rc_ * 4; const float* gl_ = WSP(const float, WS_TOKG) + (size_t)rc_ * 4; \
        _Pragma("unroll") for (int k = 0; k < 4; ++k) { dst_s[u2][k] = sl_[k]; dst_g[u2][k] = gl_[k]; } } } while (0)
    if (layer != 0) NM_SLOTS(s4, g4, C.bid * 8 + C.wave);
#define NMC(j) ((((j) & 2) ? 512 : 0) + 8 * C.lane + 4 * ((j) & 1))
    for (int ra = C.bid * 8 + C.wave; ra < nrows; ra += 2 * rstep) {
        f32x4 v[2][4]; int mrow[2]; bool live[2];
        int s4n[2][4]; float g4n[2][4];
        if (layer != 0) NM_SLOTS(s4n, g4n, ra + 2 * rstep);
#pragma unroll
        for (int u2 = 0; u2 < 2; ++u2) { const int r = ra + u2 * rstep; live[u2] = r < nrows; const int rc = live[u2] ? r : 0; mrow[u2] = mod_row(rc);
            if (layer == 0) { const float* xr = (rc < T_L) ? INP(0) + (size_t)rc * D : INP(2) + (size_t)(rc - T_L) * D;
#pragma unroll
                for (int j = 0; j < 4; ++j) v[u2][j] = *(const f32x4*)(xr + NMC(j));
            } else {
                const bf16* xr = WSP(const bf16, WS_XRES) + (size_t)rc * D; const float* g2 = mod_vec(C, layer - 1, mrow[u2], 5);
                f32x4 xv[4]; { const v4u xa = *(const v4u*)(xr + 8 * C.lane), xb = *(const v4u*)(xr + 512 + 8 * C.lane);
                    xv[0] = (f32x4){bflo(xa.x), bfhi(xa.x), bflo(xa.y), bfhi(xa.y)}; xv[1] = (f32x4){bflo(xa.z), bfhi(xa.z), bflo(xa.w), bfhi(xa.w)};
                    xv[2] = (f32x4){bflo(xb.x), bfhi(xb.x), bflo(xb.y), bfhi(xb.y)}; xv[3] = (f32x4){bflo(xb.z), bfhi(xb.z), bflo(xb.w), bfhi(xb.w)}; }
                f32x4 a[4];
#pragma unroll
                for (int j = 0; j < 4; ++j) a[j] = (f32x4){0.f, 0.f, 0.f, 0.f};
#pragma unroll
                for (int k = 0; k < 4; ++k) { const unsigned char* yr = WSP(const unsigned char, WS_YS) + (size_t)s4[u2][k] * D; const v2u ya = *(const v2u*)(yr + 8 * C.lane), yb = *(const v2u*)(yr + 512 + 8 * C.lane); const float gk = g4[u2][k];
                    const f32x2 p0 = __builtin_amdgcn_cvt_pk_f32_fp8((int)ya.x, false), p1 = __builtin_amdgcn_cvt_pk_f32_fp8((int)ya.x, true), p2 = __builtin_amdgcn_cvt_pk_f32_fp8((int)ya.y, false), p3 = __builtin_amdgcn_cvt_pk_f32_fp8((int)ya.y, true);
                    const f32x2 q0 = __builtin_amdgcn_cvt_pk_f32_fp8((int)yb.x, false), q1 = __builtin_amdgcn_cvt_pk_f32_fp8((int)yb.x, true), q2 = __builtin_amdgcn_cvt_pk_f32_fp8((int)yb.y, false), q3 = __builtin_amdgcn_cvt_pk_f32_fp8((int)yb.y, true);
                    a[0] += (f32x4){p0.x, p0.y, p1.x, p1.y} * gk; a[1] += (f32x4){p2.x, p2.y, p3.x, p3.y} * gk;
                    a[2] += (f32x4){q0.x, q0.y, q1.x, q1.y} * gk; a[3] += (f32x4){q2.x, q2.y, q3.x, q3.y} * gk; }
#pragma unroll
                for (int j = 0; j < 4; ++j) v[u2][j] = xv[j] + *(const f32x4*)(g2 + NMC(j)) * a[j];
            } }
        float rinv[2];
#pragma unroll
        for (int u2 = 0; u2 < 2; ++u2) { float ss = 0.f;
#pragma unroll
            for (int j = 0; j < 4; ++j) ss += (v[u2][j].x * v[u2][j].x + v[u2][j].y * v[u2][j].y) + (v[u2][j].z * v[u2][j].z + v[u2][j].w * v[u2][j].w);
            rinv[u2] = __builtin_amdgcn_rsqf(wave_sum(ss) * (1.f / D) + NORM_EPS); }
#pragma unroll
        for (int u2 = 0; u2 < 2; ++u2) { const int r = ra + u2 * rstep; if (!live[u2]) continue;
            if (fin) {
#pragma unroll
                for (int j = 0; j < 4; ++j) *(f32x4*)(C.out + (size_t)r * D + NMC(j)) = v[u2][j] * rinv[u2] * *(const f32x4*)(gmain + NMC(j));
                continue; }
            if (layer != 0) { bf16* xw = WSP(bf16, WS_XRES) + (size_t)r * D;
                *(v4u*)(xw + 8 * C.lane) = (v4u){pk2(v[u2][0].x, v[u2][0].y), pk2(v[u2][0].z, v[u2][0].w), pk2(v[u2][1].x, v[u2][1].y), pk2(v[u2][1].z, v[u2][1].w)};
                *(v4u*)(xw + 512 + 8 * C.lane) = (v4u){pk2(v[u2][2].x, v[u2][2].y), pk2(v[u2][2].z, v[u2][2].w), pk2(v[u2][3].x, v[u2][3].y), pk2(v[u2][3].z, v[u2][3].w)}; }
            const float* sh = mod_vec(C, layer, mrow[u2], 0); const float* scl = mod_vec(C, layer, mrow[u2], 1);
            f32x4 hv4[4]; float mine = 0.f;
#pragma unroll
            for (int j = 0; j < 4; ++j) hv4[j] = v[u2][j] * rinv[u2] * *(const f32x4*)(gmain + NMC(j)) * (*(const f32x4*)(scl + NMC(j)) + 1.0f) + *(const f32x4*)(sh + NMC(j));
            { bf16* hr = WSP(bf16, WS_H) + (size_t)r * D;
              *(v4u*)(hr + 8 * C.lane) = (v4u){pk2(hv4[0].x, hv4[0].y), pk2(hv4[0].z, hv4[0].w), pk2(hv4[1].x, hv4[1].y), pk2(hv4[1].z, hv4[1].w)};
              *(v4u*)(hr + 512 + 8 * C.lane) = (v4u){pk2(hv4[2].x, hv4[2].y), pk2(hv4[2].z, hv4[2].w), pk2(hv4[3].x, hv4[3].y), pk2(hv4[3].z, hv4[3].w)}; }
#pragma unroll 2
            for (int i = 0; i < 16; ++i) { float pp = 0.f;
#pragma unroll
                for (int j = 0; j < 4; ++j) { const f32x4 w = *(const LAS f32x4*)(w16 + i * D + NMC(j)); pp += (hv4[j].x * w.x + hv4[j].y * w.y) + (hv4[j].z * w.z + hv4[j].w * w.w); }
                pp = wave_sum(pp); if (C.lane == i) mine = pp; }
            if (C.lane < 16) WSP(float, WS_BA)[(size_t)r * 16 + C.lane] = mine; }
        if (layer != 0) {
#pragma unroll
            for (int u2 = 0; u2 < 2; ++u2)
#pragma unroll
                for (int k = 0; k < 4; ++k) { s4[u2][k] = s4n[u2][k]; g4[u2][k] = g4n[u2][k]; } }
    }
#undef NMC
#undef NM_SLOTS
}

DEVI void u8f(const v4u& w, float (&x)[8]) { x[0] = bflo(w.x); x[1] = bfhi(w.x); x[2] = bflo(w.y); x[3] = bfhi(w.y); x[4] = bflo(w.z); x[5] = bfhi(w.z); x[6] = bflo(w.w); x[7] = bfhi(w.w); }
DEVI v4u f8u(const float (&x)[8]) { return (v4u){pk2(x[0], x[1]), pk2(x[2], x[3]), pk2(x[4], x[5]), pk2(x[6], x[7])}; }
DEVI void ph_attn_prep(const Ctx& C, int layer) {
    const bf16* proj = WSP(const bf16, WS_PROJ);
    bf16* QL = WSP(bf16, WS_QL); bf16* QC = WSP(bf16, WS_QC); bf16* KB = WSP(bf16, WS_K); bf16* VB = WSP(bf16, WS_V);
    const float* tab = WSP(const float, WS_ROPE);
    const int lane = C.lane, l7 = lane & 7, d0 = 8 * l7;
    constexpr float C2A = 0.125f * 1.4426950408889634f, C2D = 0.17677669529663687f * 1.4426950408889634f;
    float gA[8];
    { const float* gn = (lane < 32 ? INP(10) : INP(11)) + layer * 64 + d0;
#pragma unroll
      for (int e = 0; e < 8; ++e) gA[e] = gn[e]; }
    const bool lowA = d0 < 32; const int jA = d0 & 31;
    const int i0 = 8 * (lane & 3); const bool lowD = i0 < 16; const int iD = i0 & 15, mp = l7 >> 2;
    constexpr int RU = 2; const int rstep = C.G * 8;
    for (int rbase = C.bid * 8 + C.wave; rbase < T_ALL; rbase += RU * rstep) {
        v4u pa[RU], pc1[RU], pc2[RU]; f32x4 ca[RU][2], sa[RU][2], cd[RU][2], sd[RU][2];
#pragma unroll
        for (int u2 = 0; u2 < RU; ++u2) { const int rr = rbase + u2 * rstep; const int r = rr < T_ALL ? rr : rbase; const bf16* pr = proj + (size_t)r * N_PROJ;
            pa[u2] = *(const v4u*)(pr + 8 * lane); pc1[u2] = *(const v4u*)(pr + C_CQ + 8 * lane); pc2[u2] = *(const v4u*)(pr + C_CV + 8 * (lane & 31));
            const int t = r < T_L ? r % SEQ : 0;
            ca[u2][0] = *(const f32x4*)(tab + (size_t)t * 32 + jA); ca[u2][1] = *(const f32x4*)(tab + (size_t)t * 32 + jA + 4);
            sa[u2][0] = *(const f32x4*)(tab + (size_t)SEQ * 32 + (size_t)t * 32 + jA); sa[u2][1] = *(const f32x4*)(tab + (size_t)SEQ * 32 + (size_t)t * 32 + jA + 4);
            cd[u2][0] = *(const f32x4*)(tab + (size_t)SEQ * 64 + (size_t)t * 16 + iD); cd[u2][1] = *(const f32x4*)(tab + (size_t)SEQ * 64 + (size_t)t * 16 + iD + 4);
            sd[u2][0] = *(const f32x4*)(tab + (size_t)SEQ * 80 + (size_t)t * 16 + iD); sd[u2][1] = *(const f32x4*)(tab + (size_t)SEQ * 80 + (size_t)t * 16 + iD + 4); }
#pragma unroll
        for (int u2 = 0; u2 < RU; ++u2) { const int r = rbase + u2 * rstep; if (r >= T_ALL) continue;
            const bool lat = r < T_L; const int b = lat ? r / SEQ : (r - T_L) / LC; const int t = lat ? r % SEQ : (r - T_L) % LC; const int pos = lat ? t : SEQ + t;
            { float x[8]; u8f(pa[u2], x);
              if (lane < 48) { float ss = 0.f;
#pragma unroll
                  for (int e = 0; e < 8; ++e) ss += x[e] * x[e];
                  const float rinv = __builtin_amdgcn_rsqf(group_sum<8>(ss) * (1.f / 64.f) + NORM_EPS);
#pragma unroll
                  for (int e = 0; e < 8; ++e) x[e] *= rinv * gA[e]; }
              float o[8];
#pragma unroll
              for (int e = 0; e < 8; ++e) { const float pe = __shfl_xor(x[e], 4); const float c = lat ? ca[u2][e >> 2][e & 3] : 1.f, s = lat ? sa[u2][e >> 2][e & 3] : 0.f;
                  o[e] = lowA ? x[e] * c - pe * s : pe * s + x[e] * c; }
              if (lane < 32) { const int hq = lane >> 3;
#pragma unroll
                  for (int e = 0; e < 8; ++e) o[e] *= C2A;
                  bf16* q = lat ? QL + ((size_t)(b * 12 + hq) * SEQ + t) * 64 : QC + ((size_t)(b * 12 + hq) * LC + t) * 64; *(v4u*)(q + d0) = f8u(o); }
              else if (lane < 48) { const int kvh = (lane - 32) >> 3; *(v4u*)(KB + ((size_t)(b * 6 + kvh) * NKEY + pos) * 64 + d0) = f8u(o); }
              else { const int kvh = (lane - 48) >> 3; *(v4u*)(VB + ((size_t)(b * 6 + kvh) * NKEY + pos) * 64 + d0) = pa[u2]; } }
            { float x[8]; u8f(pc1[u2], x); float o[8];
#pragma unroll
              for (int e = 0; e < 8; ++e) { const float pe = __shfl_xor(x[e], 2); const float c = lat ? cd[u2][e >> 2][e & 3] : 1.f, s = lat ? sd[u2][e >> 2][e & 3] : 0.f;
                  o[e] = lowD ? x[e] * c - pe * s : pe * s + x[e] * c; }
              const int hc = (lane & 31) >> 3;
              if (lane < 32) { const int vh = 4 + 2 * hc + mp;
#pragma unroll
                  for (int e = 0; e < 8; ++e) o[e] *= C2D;
                  bf16* q = lat ? QL + ((size_t)(b * 12 + vh) * SEQ + t) * 64 : QC + ((size_t)(b * 12 + vh) * LC + t) * 64;
                  *(v4u*)(q + mp * 32 + i0) = f8u(o); *(v4u*)(q + (1 - mp) * 32 + i0) = (v4u){0u, 0u, 0u, 0u}; }
              else { *(v4u*)(KB + ((size_t)(b * 6 + 2 + hc) * NKEY + pos) * 64 + d0) = f8u(o); } }
            if (lane < 32) { const int hv = lane >> 3; *(v4u*)(VB + ((size_t)(b * 6 + 2 + hv) * NKEY + pos) * 64 + d0) = pc2[u2]; }
        }
    }
}

DEVI void ph_gmlp(const Ctx& C, int layer, int ntok) {
    constexpr int VP = 136, SP = 68;
    LAS bf16* vnT = (LAS bf16*)C.lds;
    LAS float* rinv = (LAS float*)(vnT + 64 * VP);
    LAS float* spT = rinv + 128;
    const bf16* proj = WSP(const bf16, WS_PROJ); bf16* mix = WSP(bf16, WS_MIX);
    const float* gvn = INP(12) + layer * 256;
    const int tid0 = C.tid;
    constexpr int NSCAN = NB * 16; const int total = (ntok / 128) * 4; const bool split = C.G > NSCAN && total > 2 * NSCAN;
    const int ufirst = !split ? C.bid : (C.bid < NSCAN ? C.bid : 2 * NSCAN + (C.bid - NSCAN)), ustride = !split ? C.G : (C.bid < NSCAN ? NSCAN : C.G - NSCAN), uend = (split && C.bid < NSCAN) ? 2 * NSCAN : total;
    for (int u = ufirst; u < uend; u += ustride) {
        int tid = tid0; LAUNDER_V(tid);
        const int chunk = u >> 2, g = u & 3; const int row0 = chunk * 128;
        const int lane = tid & 63, wv = __builtin_amdgcn_readfirstlane(tid >> 6), l15 = lane & 15, q = lane >> 4;
        bf16x8 afr[4];
        { const float* wsr = INP(13) + ((size_t)layer * 4 + g) * 128 * 128 + (size_t)(16 * wv + l15) * 128 + 8 * q;
#pragma unroll
          for (int kk = 0; kk < 4; ++kk) { const f32x4 a0 = *(const f32x4*)(wsr + 32 * kk), a1 = *(const f32x4*)(wsr + 32 * kk + 4);
              const v4u ap = {pk2(a0.x, a0.y), pk2(a0.z, a0.w), pk2(a1.x, a1.y), pk2(a1.z, a1.w)}; afr[kk] = __builtin_bit_cast(bf16x8, ap); } }
        { const int tok = tid >> 2, qd = tid & 3; const bf16* p = proj + (size_t)(row0 + tok) * N_PROJ + C_BV + qd * 64; float ss = 0.f;
#pragma unroll
          for (int c8 = 0; c8 < 8; ++c8) { const v4u w = *(const v4u*)(p + c8 * 8);
              const float a0 = gelu_tanh(bflo(w.x)), a1 = gelu_tanh(bfhi(w.x)), a2 = gelu_tanh(bflo(w.y)), a3 = gelu_tanh(bfhi(w.y)), a4 = gelu_tanh(bflo(w.z)), a5 = gelu_tanh(bfhi(w.z)), a6 = gelu_tanh(bflo(w.w)), a7 = gelu_tanh(bfhi(w.w));
              ss += (a0 * a0 + a1 * a1) + (a2 * a2 + a3 * a3) + (a4 * a4 + a5 * a5) + (a6 * a6 + a7 * a7); }
          ss = group_sum<4>(ss); if (qd == 0) rinv[tok] = __builtin_amdgcn_rsqf(ss * (1.f / 256.f) + NORM_EPS); }
        __syncthreads();
        { const int tok = tid >> 2, c0 = (tid & 3) * 16; const bf16* p = proj + (size_t)(row0 + tok) * N_PROJ + C_BV + g * 64 + c0; const float ri = rinv[tok];
          const v4u w0 = *(const v4u*)p, w1 = *(const v4u*)(p + 8); const unsigned ww[8] = {w0.x, w0.y, w0.z, w0.w, w1.x, w1.y, w1.z, w1.w};
#pragma unroll
          for (int c = 0; c < 16; ++c) { const float x = (c & 1) ? bfhi(ww[c >> 1]) : bflo(ww[c >> 1]); vnT[(c0 + c) * VP + tok] = (bf16)f2bf(gelu_tanh(x) * ri * gvn[g * 64 + c0 + c]); } }
        __syncthreads();
        { f32x4 acc[4];
#pragma unroll
          for (int n = 0; n < 4; ++n) acc[n] = (f32x4){0.f, 0.f, 0.f, 0.f};
#pragma unroll
          for (int kk = 0; kk < 4; ++kk)
#pragma unroll
              for (int n = 0; n < 4; ++n) acc[n] = __builtin_amdgcn_mfma_f32_16x16x32_bf16(afr[kk], *(const LAS bf16x8*)(vnT + (16 * n + l15) * VP + 32 * kk + 8 * q), acc[n], 0, 0, 0);
          const float* bs = INP(14) + ((size_t)layer * 4 + g) * 128;
#pragma unroll
          for (int r = 0; r < 4; ++r) { const int tok = 16 * wv + 4 * q + r; const float bb = bs[tok];
#pragma unroll
              for (int n = 0; n < 4; ++n) spT[tok * SP + 16 * n + l15] = acc[n][r] + bb; } }
        __syncthreads();
        { const int tok = tid >> 2, c0 = (tid & 3) * 16; const size_t rowp = (size_t)(row0 + tok);
          const bf16* pu = proj + rowp * N_PROJ + C_BU + g * 64 + c0; const v4u u0 = *(const v4u*)pu, u1 = *(const v4u*)(pu + 8); const unsigned uw[8] = {u0.x, u0.y, u0.z, u0.w, u1.x, u1.y, u1.z, u1.w};
          float o[16];
#pragma unroll
          for (int c4 = 0; c4 < 4; ++c4) { const f32x4 sp = *(const LAS f32x4*)(spT + tok * SP + c0 + 4 * c4);
              o[4 * c4 + 0] = gelu_tanh(bflo(uw[2 * c4])) * sp.x; o[4 * c4 + 1] = gelu_tanh(bfhi(uw[2 * c4])) * sp.y; o[4 * c4 + 2] = gelu_tanh(bflo(uw[2 * c4 + 1])) * sp.z; o[4 * c4 + 3] = gelu_tanh(bfhi(uw[2 * c4 + 1])) * sp.w; }
          bf16* po = mix + rowp * D + 256 + g * 64 + c0;
          *(v4u*)po = (v4u){pk2(o[0], o[1]), pk2(o[2], o[3]), pk2(o[4], o[5]), pk2(o[6], o[7])}; *(v4u*)(po + 8) = (v4u){pk2(o[8], o[9]), pk2(o[10], o[11]), pk2(o[12], o[13]), pk2(o[14], o[15])}; }
        __syncthreads();
    }
}

DEVI int dn_kmap(int kk, int q, int j) { return 16 * (2 * kk + (j >> 2)) + 4 * q + (j & 3); }
DEVI size_t dn_unit_off(int b, int dir, int h, int sc) { return ((size_t)((b * 2 + dir) * 4 + h) * NCH + sc) * DN_UNIT_BYTES; }
constexpr int DP = 68, XP = 132, HP = 72;
DEVI f32x4 mfma16(bf16x8 a, bf16x8 b, f32x4 c) { return __builtin_amdgcn_mfma_f32_16x16x32_bf16(a, b, c, 0, 0, 0); }
#ifndef D1REP
#define D1REP 0
#endif
#define DN_BAR() asm volatile("s_waitcnt lgkmcnt(0)\n\ts_barrier" ::: "memory")
DEVI void ph_dn_chunk(const Ctx& C, int layer) {
    LAS bf16* kN = (LAS bf16*)C.lds;
    LAS bf16* qN = kN + 64 * HP;
    LAS bf16* kT = qN + 64 * HP;
    LAS bf16* QKd = kT + 64 * HP;
    LAS bf16* RT = QKd + 64 * HP;
    LAS bf16* XT = RT;
    LAS bf16* TiB = RT + 128 * HP;
    LAS float* Am = (LAS float*)(TiB + 64 * HP);
    LAS float* TI = Am + 64 * DP;
    LAS bf16* XdT = (LAS bf16*)Am;
    LAS float* TMP = TI + 64 * DP;
    LAS float* vec = TMP + 1280;
    LAS float* betav = vec; LAS float* cum = vec + 64; LAS float* ecum = vec + 128; LAS float* dvec = vec + 192; LAS float* bec = vec + 256;
    LAS float* cwl = vec + 320;
    LAS float* gpar = cwl + 2304;
    static_assert(128 * HP * 2 <= 2 * 64 * DP * 4 && (4 * 64 * HP + 128 * HP + 64 * HP) * 2 + (2 * 64 * DP + 1280 + 320 + 2304 + 16) * 4 <= MISC_OFF, "D1 LDS");
    const bf16* proj = WSP(const bf16, WS_PROJ); const float* BA = WSP(const float, WS_BA);
    { const float* cwg = INP(20) + (size_t)layer * 3 * 768; for (int i = C.tid; i < 2304; i += 512) cwl[i] = cwg[i];
      if (C.tid < 8) gpar[C.tid] = -fast_exp(INP(21)[layer * 8 + C.tid]); else if (C.tid < 16) gpar[C.tid] = INP(22)[layer * 8 + C.tid - 8]; }
    __syncthreads();
    const LAS float* cw = cwl;
    const int tid0 = C.tid;
#define FRESH_TID() int tid = tid0; LAUNDER_V(tid)
#define DN_DECODE(u_) const int tcx = (u_) % NCH, h = ((u_) / NCH) & 3, dir = ((u_) / (NCH * 4)) & 1, b = (u_) / (NCH * 8); \
        const bool isc = tcx < NCH_C; const int tc = isc ? tcx : tcx - NCH_C; const int nch = isc ? NCH_C : NCH_L; const int len = nch * 64; \
        const int row_seq0 = isc ? T_L + b * LC : b * SEQ
    v4u rw[3][3]; float rb0 = 0.f, rb1 = 0.f, rb2 = 0.f;
#define DN_LOAD(u_) do { if ((u_) < NB * 2 * 4 * NCH) { DN_DECODE(u_); int t_ = tid0; LAUNDER_V(t_); const int c = t_ >> 3, d0 = (t_ & 7) * 8; const int tl = tc * 64 + (dir ? 63 - c : c); const size_t r = (size_t)row_seq0 + tl; \
        const bool hp = tl > 0, hn = tl < len - 1; \
        _Pragma("unroll") for (int w3 = 0; w3 < 3; ++w3) { const bf16* p = proj + r * N_PROJ + C_DQKV + w3 * 256 + h * 64 + d0; \
            rw[w3][1] = *(const v4u*)p; rw[w3][0] = (v4u){0u, 0u, 0u, 0u}; rw[w3][2] = (v4u){0u, 0u, 0u, 0u}; if (hp) rw[w3][0] = *(const v4u*)(p - N_PROJ); if (hn) rw[w3][2] = *(const v4u*)(p + N_PROJ); } \
        rb0 = BA[r * 16 + dir * 4 + h]; \
        if (t_ < 64) { const int tl2 = tc * 64 + (dir ? 63 - t_ : t_); const float* ba = BA + ((size_t)row_seq0 + tl2) * 16; rb1 = ba[dir * 4 + h]; rb2 = ba[8 + dir * 4 + h]; } } } while (0)
    DN_LOAD(C.bid);
    for (int u = C.bid; u < NB * 2 * 4 * NCH; u += C.G) {
        DN_DECODE(u);
        const int sc = (isc ? 0 : NCH_C) + (dir ? nch - 1 - tc : tc);
        { FRESH_TID(); const int c = tid >> 3, part = tid & 7, d0 = part * 8;
          float y[3][8];
#pragma unroll
          for (int w3 = 0; w3 < 3; ++w3) { const int col = w3 * 256 + h * 64 + d0;
              const v4u xc = rw[w3][1], xp = rw[w3][0], xn = rw[w3][2];
              const unsigned xcw[4] = {xc.x, xc.y, xc.z, xc.w}, xpw[4] = {xp.x, xp.y, xp.z, xp.w}, xnw[4] = {xn.x, xn.y, xn.z, xn.w};
#pragma unroll
              for (int e = 0; e < 8; ++e) { const float a = (e & 1) ? bfhi(xpw[e >> 1]) : bflo(xpw[e >> 1]), m = (e & 1) ? bfhi(xcw[e >> 1]) : bflo(xcw[e >> 1]), n = (e & 1) ? bfhi(xnw[e >> 1]) : bflo(xnw[e >> 1]);
                  y[w3][e] = siluf_(cw[col + e] * a + cw[768 + col + e] * m + cw[1536 + col + e] * n); } }
          const float ba_b = rb0, ba_b2 = rb1, ba_a2 = rb2;
          DN_LOAD(u + C.G);
          float sq = 0.f, sk = 0.f;
#pragma unroll
          for (int e = 0; e < 8; ++e) { sq += y[0][e] * y[0][e]; sk += y[1][e] * y[1][e]; }
          sq = group_sum<8>(sq); sk = group_sum<8>(sk);
          const float rq = __builtin_amdgcn_rsqf(sq + NORM_EPS) * 0.125f, rk = __builtin_amdgcn_rsqf(sk + NORM_EPS);
          const float betac = sigmoidf_(ba_b);
#pragma unroll
          for (int e = 0; e < 8; ++e) { y[0][e] *= rq; y[1][e] *= rk; kT[(d0 + e) * HP + c] = (bf16)f2bf(y[1][e]); RT[(d0 + e) * HP + c] = (bf16)f2bf(betac * y[2][e]); }
          *(LAS v4u*)(qN + c * HP + d0) = (v4u){pk2(y[0][0], y[0][1]), pk2(y[0][2], y[0][3]), pk2(y[0][4], y[0][5]), pk2(y[0][6], y[0][7])};
          *(LAS v4u*)(kN + c * HP + d0) = (v4u){pk2(y[1][0], y[1][1]), pk2(y[1][2], y[1][3]), pk2(y[1][4], y[1][5]), pk2(y[1][6], y[1][7])};
          *(LAS v4u*)(QKd + c * HP + d0) = (v4u){0u, 0u, 0u, 0u};
          { LAS f32x4* z = (LAS f32x4*)TI; z[tid] = (f32x4){0.f, 0.f, 0.f, 0.f}; z[tid + 512] = (f32x4){0.f, 0.f, 0.f, 0.f}; if (tid < 64) z[tid + 1024] = (f32x4){0.f, 0.f, 0.f, 0.f}; }
          if (tid < 64) { const int c2 = tid;
              const float bt = sigmoidf_(ba_b2);
              float sg = gpar[dir * 4 + h] * softplusf_(ba_a2 + gpar[8 + dir * 4 + h]);
#pragma unroll
              for (int o = 1; o < 64; o <<= 1) { const float t = __shfl_up(sg, o); if (c2 >= o) sg += t; }
              const float G = __shfl(sg, 63); const float ec = fast_exp(sg);
              betav[c2] = bt; cum[c2] = sg; ecum[c2] = ec; dvec[c2] = fast_exp(G - sg); bec[c2] = bt * ec; } }
        DN_BAR();
        for (int rp_ = 0; rp_ < 1 + (((D1REP) >> 1) & 1); ++rp_) {
        { FRESH_TID(); const int lane = tid & 63, wv = __builtin_amdgcn_readfirstlane(tid >> 6), l15 = lane & 15, q = lane >> 4;
          { const int k = tid >> 3, c0 = (tid & 7) * 8; const v4u kk4 = *(const LAS v4u*)(kT + k * HP + c0); const unsigned kw[4] = {kk4.x, kk4.y, kk4.z, kk4.w}; unsigned ow[4];
#pragma unroll
            for (int e = 0; e < 4; ++e) ow[e] = pk2(bflo(kw[e]) * bec[c0 + 2 * e], bfhi(kw[e]) * bec[c0 + 2 * e + 1]);
            *(LAS v4u*)(RT + (64 + k) * HP + c0) = (v4u){ow[0], ow[1], ow[2], ow[3]}; }
#pragma unroll
          for (int tt = 0; tt < 3; ++tt) { const int t = wv + 8 * tt; if (t >= 20) break;
              const bool isq = t >= 10; const int idx = isq ? t - 10 : t; const int ti = (idx >= 6) ? 3 : (idx >= 3) ? 2 : (idx >= 1) ? 1 : 0; const int tj = idx - ti * (ti + 1) / 2;
              const LAS bf16* asrc = (isq ? qN : kN) + (16 * ti + l15) * HP + 8 * q; const LAS bf16* bsrc = kN + (16 * tj + l15) * HP + 8 * q;
              f32x4 acc = {0.f, 0.f, 0.f, 0.f};
              acc = mfma16(*(const LAS bf16x8*)asrc, *(const LAS bf16x8*)bsrc, acc); acc = mfma16(*(const LAS bf16x8*)(asrc + 32), *(const LAS bf16x8*)(bsrc + 32), acc);
              const int j = 16 * tj + l15; const float cj = cum[j];
#pragma unroll
              for (int r = 0; r < 4; ++r) { const int i = 16 * ti + 4 * q + r; const float dec = fast_exp(cum[i] - cj);
                  if (isq) QKd[i * HP + j] = (bf16)f2bf((i >= j) ? acc[r] * dec : 0.f); else Am[i * DP + j] = (i > j) ? acc[r] * dec * betav[i] : 0.f; } } }
        DN_BAR();
        }
        for (int rp_ = 0; rp_ < 1 + (((D1REP) >> 2) & 1); ++rp_) {
        { FRESH_TID(); if (tid < 64) { const int bb = tid >> 4, col = tid & 15; float x[16];
#pragma unroll
            for (int r = 0; r < 16; ++r) { float s = (r == col) ? 1.f : 0.f;
#pragma unroll
                for (int s2 = 0; s2 < r; ++s2) s -= Am[(16 * bb + r) * DP + 16 * bb + s2] * x[s2];
                x[r] = s; }
#pragma unroll
            for (int r = 0; r < 16; ++r) TI[(16 * bb + r) * DP + 16 * bb + col] = x[r]; } }
        DN_BAR();
        }
        for (int rp_ = 0; rp_ < 1 + (((D1REP) >> 3) & 1); ++rp_) {
        { FRESH_TID(); const int p = tid >> 8, r = (tid >> 4) & 15, c = tid & 15; float e = 0.f;
#pragma unroll
          for (int s2 = 0; s2 < 16; ++s2) e += Am[(32 * p + 16 + r) * DP + 32 * p + s2] * TI[(32 * p + s2) * DP + 32 * p + c];
          TMP[(p * 16 + r) * 17 + c] = e;
          DN_BAR();
          float f = 0.f;
#pragma unroll
          for (int s2 = 0; s2 < 16; ++s2) f -= TI[(32 * p + 16 + r) * DP + 32 * p + 16 + s2] * TMP[(p * 16 + s2) * 17 + c];
          TI[(32 * p + 16 + r) * DP + 32 * p + c] = f; }
        DN_BAR();
        }
        for (int rp_ = 0; rp_ < 1 + (((D1REP) >> 4) & 1); ++rp_) {
        { FRESH_TID(); const int r = tid >> 4, c2 = (tid & 15) * 2; float e0 = 0.f, e1 = 0.f;
#pragma unroll 8
          for (int s2 = 0; s2 < 32; ++s2) { const float a = Am[(32 + r) * DP + s2]; e0 += a * TI[s2 * DP + c2]; e1 += a * TI[s2 * DP + c2 + 1]; }
          TMP[r * 36 + c2] = e0; TMP[r * 36 + c2 + 1] = e1;
          DN_BAR();
          float f0 = 0.f, f1 = 0.f;
#pragma unroll 8
          for (int s2 = 0; s2 < 32; ++s2) { const float a = TI[(32 + r) * DP + 32 + s2]; f0 -= a * TMP[s2 * 36 + c2]; f1 -= a * TMP[s2 * 36 + c2 + 1]; }
          TI[(32 + r) * DP + c2] = f0; TI[(32 + r) * DP + c2 + 1] = f1; }
        DN_BAR();
        }
        for (int rp_ = 0; rp_ < 1 + (((D1REP) >> 5) & 1); ++rp_) {
        { FRESH_TID(); const int c = tid >> 3, c0 = (tid & 7) * 8; float x[8];
#pragma unroll
          for (int e = 0; e < 8; ++e) x[e] = (c0 + e <= c) ? TI[c * DP + c0 + e] : 0.f;
          *(LAS v4u*)(TiB + c * HP + c0) = (v4u){pk2(x[0], x[1]), pk2(x[2], x[3]), pk2(x[4], x[5]), pk2(x[6], x[7])}; }
        DN_BAR();
        }
        { FRESH_TID(); const int lane = tid & 63, wv = __builtin_amdgcn_readfirstlane(tid >> 6), l15 = lane & 15, q = lane >> 4;
          f32x4 xa[4]; const LAS bf16* bsrc = RT + (16 * wv + l15) * HP + 8 * q; const bf16x8 b0 = *(const LAS bf16x8*)bsrc, b1 = *(const LAS bf16x8*)(bsrc + 32);
#pragma unroll
          for (int m = 0; m < 4; ++m) { const LAS bf16* asrc = TiB + (16 * m + l15) * HP + 8 * q; f32x4 a_ = {0.f, 0.f, 0.f, 0.f};
              a_ = mfma16(*(const LAS bf16x8*)asrc, b0, a_); xa[m] = mfma16(*(const LAS bf16x8*)(asrc + 32), b1, a_); }
          DN_BAR();
          const int col = 16 * wv + l15;
#pragma unroll
          for (int m = 0; m < 4; ++m) { const int c0 = 16 * m + 4 * q; const f32x4 x = xa[m];
              *(LAS v2u*)(XT + col * HP + c0) = (v2u){pk2(x.x, x.y), pk2(x.z, x.w)};
              *(LAS v2u*)(XdT + col * HP + c0) = (v2u){pk2(x.x * dvec[c0], x.y * dvec[c0 + 1]), pk2(x.z * dvec[c0 + 2], x.w * dvec[c0 + 3])}; } }
        DN_BAR();
        for (int rp_ = 0; rp_ < 1 + (((D1REP) >> 7) & 1); ++rp_) {
        { FRESH_TID(); const int lane = tid & 63, wv = __builtin_amdgcn_readfirstlane(tid >> 6), l15 = lane & 15, q = lane >> 4;
          unsigned char* ub = WSP(unsigned char, WS_DNF + dn_unit_off(b, dir, h, sc));
          const float eG = ecum[63];
#define DN_MM(dst, Ap, Bp) do { f32x4 a_ = {0.f, 0.f, 0.f, 0.f}; a_ = mfma16(*(const LAS bf16x8*)(Ap), *(const LAS bf16x8*)(Bp), a_); dst = mfma16(*(const LAS bf16x8*)((Ap) + 32), *(const LAS bf16x8*)((Bp) + 32), a_); } while (0)
#pragma unroll
          for (int t2 = 0; t2 < 2; ++t2) { const int t = 2 * wv + t2, m = t >> 2, n = t & 3; f32x4 acc;
              DN_MM(acc, kT + (16 * m + l15) * HP + 8 * q, XdT + (16 * n + l15) * HP + 8 * q);
              *(v2u*)(ub + 16384 + (size_t)((n * 4 + m) * 64 + lane) * 8) = (v2u){pk2(acc.x, acc.y), pk2(acc.z, acc.w)};
              DN_MM(acc, QKd + (16 * m + l15) * HP + 8 * q, XT + (16 * n + l15) * HP + 8 * q);
              *(v2u*)(ub + 24576 + (size_t)((n * 4 + m) * 64 + lane) * 8) = (v2u){pk2(acc.x, acc.y), pk2(acc.z, acc.w)}; }
          { const int n = wv >> 1, kk2 = wv & 1; f32x4 z0, z1, y0, y1;
            DN_MM(z0, XdT + (64 + 16 * (2 * kk2) + l15) * HP + 8 * q, kT + (16 * n + l15) * HP + 8 * q);
            DN_MM(z1, XdT + (64 + 16 * (2 * kk2 + 1) + l15) * HP + 8 * q, kT + (16 * n + l15) * HP + 8 * q);
            DN_MM(y0, XT + (64 + 16 * (2 * kk2) + l15) * HP + 8 * q, QKd + (16 * n + l15) * HP + 8 * q);
            DN_MM(y1, XT + (64 + 16 * (2 * kk2 + 1) + l15) * HP + 8 * q, QKd + (16 * n + l15) * HP + 8 * q);
            const int rowi = 16 * n + l15; float mv[8], qv[8]; const float ec = ecum[rowi];
#pragma unroll
            for (int e = 0; e < 8; ++e) { const int kp = 16 * (2 * kk2 + (e >> 2)) + 4 * q + (e & 3); const float zz = (e < 4) ? z0[e & 3] : z1[e & 3], yy = (e < 4) ? y0[e & 3] : y1[e & 3];
                mv[e] = ((kp == rowi) ? eG : 0.f) - zz; qv[e] = ec * bf2f(qN[rowi * HP + kp]) - yy; }
            *(v4u*)(ub + (size_t)((n * 2 + kk2) * 64 + lane) * 16) = (v4u){pk2(mv[0], mv[1]), pk2(mv[2], mv[3]), pk2(mv[4], mv[5]), pk2(mv[6], mv[7])};
            *(v4u*)(ub + 8192 + (size_t)((n * 2 + kk2) * 64 + lane) * 16) = (v4u){pk2(qv[0], qv[1]), pk2(qv[2], qv[3]), pk2(qv[4], qv[5]), pk2(qv[6], qv[7])}; }
#undef DN_MM
        }
        DN_BAR();
        }
    }
}
#undef FRESH_TID
#undef DN_BAR
#undef DN_LOAD
#undef DN_DECODE
DEVI bf16x8 dn_pack(const f32x4& a, const f32x4& b) { const v4u o = {pk2(a.x, a.y), pk2(a.z, a.w), pk2(b.x, b.y), pk2(b.z, b.w)}; return __builtin_bit_cast(bf16x8, o); }
#define SCAN_BAR() asm volatile("s_waitcnt lgkmcnt(0)\n\ts_barrier" ::: "memory")
DEVI unsigned cvtpk(float lo, float hi) { return pk2(lo, hi); }
DEVI bf16x8 dn_pack_hw(const f32x4& a, const f32x4& b) { const v4u o = {cvtpk(a.x, a.y), cvtpk(a.z, a.w), cvtpk(b.x, b.y), cvtpk(b.z, b.w)}; return __builtin_bit_cast(bf16x8, o); }
DEVI void ph_dn_scan(const Ctx& C, int layer) {
    constexpr int SLOTB = 24576, NS = 4, P = 8, NLD = 384, NPC = 4;
    static_assert(NCH % P == 0 || NCH % P == P / 2, "scan pipeline depth: whole groups of P steps plus at most one half group");
    const int lane = C.lane, q = lane >> 4, v16 = lane & 15;
    bf16* DNO = WSP(bf16, WS_DNO);
    for (int u = C.bid; u < NB * 2 * 4 * 2; u += C.G) {
        const int vp = u & 1, h = (u >> 1) & 3, dir = (u >> 3) & 1, b = u >> 4;
        const unsigned char* base = WSP(const unsigned char, WS_DNF + dn_unit_off(b, dir, h, 0));
        if (C.wave < 2) {
            const int vs = 2 * vp + C.wave;
            bf16x8 sf[2]; { const v4u z = {0u, 0u, 0u, 0u}; sf[0] = __builtin_bit_cast(bf16x8, z); sf[1] = sf[0]; }
            bf16* ob = DNO + (size_t)dir * T_ALL * 256 + h * 64 + vs * 16 + v16;
            SCAN_BAR();
#define SCAN_SEG(SGN, SC0, NCHS, SEQ0, LEN) do { \
            bf16* pm[4]; \
            _Pragma("unroll") for (int m = 0; m < 4; ++m) pm[m] = ob + ((long)(SEQ0) + ((SGN) < 0 ? (LEN) - 1 : 0) + (SGN) * (16 * m + 4 * q)) * 256; \
            _Pragma("unroll 1") for (int s2 = 0; s2 < (NCHS); ++s2) { \
                const LAS unsigned char* sl = C.lds + (((SC0) + s2) % NS) * SLOTB; \
                f32x4 o[4], d[4]; \
                _Pragma("unroll") for (int m = 0; m < 4; ++m) { \
                    const bf16x8 ma0 = *(const LAS bf16x8*)(sl + ((m * 2 + 0) * 64 + lane) * 16), ma1 = *(const LAS bf16x8*)(sl + ((m * 2 + 1) * 64 + lane) * 16); \
                    const bf16x8 qa0 = *(const LAS bf16x8*)(sl + 8192 + ((m * 2 + 0) * 64 + lane) * 16), qa1 = *(const LAS bf16x8*)(sl + 8192 + ((m * 2 + 1) * 64 + lane) * 16); \
                    const v2u ncp = *(const LAS v2u*)(sl + 16384 + ((C.wave * 4 + m) * 64 + lane) * 8), ocp = *(const LAS v2u*)(sl + 20480 + ((C.wave * 4 + m) * 64 + lane) * 8); \
                    const f32x4 nc = {bflo(ncp.x), bfhi(ncp.x), bflo(ncp.y), bfhi(ncp.y)}, oc = {bflo(ocp.x), bfhi(ocp.x), bflo(ocp.y), bfhi(ocp.y)}; \
                    d[m] = __builtin_amdgcn_mfma_f32_16x16x32_bf16(ma0, sf[0], nc, 0, 0, 0); d[m] = __builtin_amdgcn_mfma_f32_16x16x32_bf16(ma1, sf[1], d[m], 0, 0, 0); \
                    o[m] = __builtin_amdgcn_mfma_f32_16x16x32_bf16(qa0, sf[0], oc, 0, 0, 0); o[m] = __builtin_amdgcn_mfma_f32_16x16x32_bf16(qa1, sf[1], o[m], 0, 0, 0); } \
                sf[0] = dn_pack_hw(d[0], d[1]); sf[1] = dn_pack_hw(d[2], d[3]); \
                _Pragma("unroll") for (int m = 0; m < 4; ++m) { \
                    _Pragma("unroll") for (int i = 0; i < 4; ++i) pm[m][(SGN) * i * 256] = (bf16)f2bf(o[m][i]); \
                    pm[m] += (SGN) * 64 * 256; } \
                SCAN_BAR(); } } while (0)
            if (dir == 0) { SCAN_SEG(1, 0, NCH_C, T_L + b * LC, LC); SCAN_SEG(1, NCH_C, NCH_L, b * SEQ, SEQ); }
            else          { SCAN_SEG(-1, 0, NCH_C, T_L + b * LC, LC); SCAN_SEG(-1, NCH_C, NCH_L, b * SEQ, SEQ); }
#undef SCAN_SEG
        } else {
            const int lid = C.tid - 128;
            unsigned so[NPC], dofs[NPC];
#pragma unroll
            for (int i = 0; i < NPC; ++i) { const int pp = lid + NLD * i;
                so[i] = (pp < 1024) ? (unsigned)pp * 16u : (pp < 1280) ? 16384u + (unsigned)(vp * 256 + (pp - 1024)) * 16u : 24576u + (unsigned)(vp * 256 + (pp - 1280)) * 16u; dofs[i] = (unsigned)pp * 16u; }
            v4u buf[P][NPC];
#pragma unroll
            for (int s2 = 0; s2 < P; ++s2)
#pragma unroll
                for (int i = 0; i < NPC; ++i) buf[s2][i] = *(const v4u*)(base + (size_t)s2 * DN_UNIT_BYTES + so[i]);
#pragma unroll
            for (int i = 0; i < NPC; ++i) *(LAS v4u*)(C.lds + dofs[i]) = buf[0][i];
            SCAN_BAR();
#define SCAN_LD_STEP(j) do { const int step = sc + (j); const int nxt = (step + P < NCH) ? step + P : NCH - 1; \
                    _Pragma("unroll") for (int i = 0; i < NPC; ++i) buf[(j)][i] = *(const v4u*)(base + (size_t)nxt * DN_UNIT_BYTES + so[i]); \
                    LAS unsigned char* sl = C.lds + ((step + 1) % NS) * SLOTB; \
                    _Pragma("unroll") for (int i = 0; i < NPC; ++i) *(LAS v4u*)(sl + dofs[i]) = buf[((j) + 1) % P][i]; \
                    SCAN_BAR(); } while (0)
            int sc = 0;
#pragma unroll 1
            for (; sc + P <= NCH; sc += P) {
#pragma unroll
                for (int j = 0; j < P; ++j) SCAN_LD_STEP(j);
            }
            if (NCH % P) {
#pragma unroll
                for (int j = 0; j < P / 2; ++j) SCAN_LD_STEP(j);
            }
#undef SCAN_LD_STEP
        }
    }
}
#undef SCAN_BAR

DEVI void ph_finalize(const Ctx& C, int layer, int ntok) {
    const int lane = C.lane;
    const bf16* DNO = WSP(const bf16, WS_DNO); const bf16* proj = WSP(const bf16, WS_PROJ); bf16* mix = WSP(bf16, WS_MIX);
    const f32x4 ong = *(const f32x4*)(INP(23) + layer * 64 + ((4 * lane) & 63));
    constexpr int RU = 4; const int rstep = C.G * 8;
    for (int r0 = C.bid * 8 + C.wave; r0 < ntok; r0 += RU * rstep) {
        v2u zz[RU], d0[RU], d1[RU];
#pragma unroll
        for (int u2 = 0; u2 < RU; ++u2) { const int rr = r0 + u2 * rstep; const size_t r = rr < ntok ? rr : r0;
            d0[u2] = *(const v2u*)(DNO + r * 256 + 4 * lane); d1[u2] = *(const v2u*)(DNO + ((size_t)T_ALL + r) * 256 + 4 * lane);
            zz[u2] = *(const v2u*)(proj + r * N_PROJ + C_DZ + 4 * lane); }
#pragma unroll
        for (int u2 = 0; u2 < RU; ++u2) { const int rr = r0 + u2 * rstep; if (rr >= ntok) continue; const size_t r = rr;
            const f32x4 od = (f32x4){bflo(d0[u2].x), bfhi(d0[u2].x), bflo(d0[u2].y), bfhi(d0[u2].y)} + (f32x4){bflo(d1[u2].x), bfhi(d1[u2].x), bflo(d1[u2].y), bfhi(d1[u2].y)};
            const float ss = group_sum<16>((od.x * od.x + od.y * od.y) + (od.z * od.z + od.w * od.w));
            const float rinv = __builtin_amdgcn_rsqf(ss * (1.f / 64.f) + NORM_EPS);
            const f32x4 z = (f32x4){siluf_(bflo(zz[u2].x)), siluf_(bfhi(zz[u2].x)), siluf_(bflo(zz[u2].y)), siluf_(bfhi(zz[u2].y))};
            const f32x4 o = od * rinv * ong * z; v2u w; w.x = pk2(o.x, o.y); w.y = pk2(o.z, o.w); *(v2u*)(mix + r * D + 768 + 4 * lane) = w; }
    }
}

DEVI void ph_router(const Ctx& C, int layer, int ntok) {
    LAS float* lgt = (LAS float*)C.lds;
    LAS int* cnt = (LAS int*)(lgt + 8 * 16 * 33);
    if (C.tid < 32) cnt[C.tid] = 0;
    __syncthreads();
    const int nt = ntok / 16; const int t0 = (int)((long)C.bid * nt / C.G), t1 = (int)((long)(C.bid + 1) * nt / C.G);
    const float* gn = INP(7) + (size_t)layer * D;
    const int l15 = C.lane & 15, q = C.lane >> 4; LAS float* lg_w = lgt + C.wave * 16 * 33;
    for (int t = t0 + C.wave; t < t1; t += 8) {
        const int row0 = 16 * t, mrow = mod_row(row0);
        const bf16* xa = WSP(const bf16, WS_XRES) + (size_t)(row0 + l15) * D + 4 * q;
        const float* wb = WSP(const float, WS_RWP) + ((size_t)(layer * 9 + mrow) * NE + l15) * D + 4 * q;
        f32x4 acc0 = {0.f, 0.f, 0.f, 0.f}, acc1 = {0.f, 0.f, 0.f, 0.f}; float ssq = 0.f;
#pragma unroll 4
        for (int kk = 0; kk < 64; ++kk) { const v2u aw = *(const v2u*)(xa + 16 * kk); const f32x4 a = {bflo(aw.x), bfhi(aw.x), bflo(aw.y), bfhi(aw.y)}, b0 = *(const f32x4*)(wb + 16 * kk), b1 = *(const f32x4*)(wb + (size_t)16 * D + 16 * kk);
            ssq += (a.x * a.x + a.y * a.y) + (a.z * a.z + a.w * a.w);
            acc0 = __builtin_amdgcn_mfma_f32_16x16x4f32(a.x, b0.x, acc0, 0, 0, 0); acc1 = __builtin_amdgcn_mfma_f32_16x16x4f32(a.x, b1.x, acc1, 0, 0, 0);
            acc0 = __builtin_amdgcn_mfma_f32_16x16x4f32(a.y, b0.y, acc0, 0, 0, 0); acc1 = __builtin_amdgcn_mfma_f32_16x16x4f32(a.y, b1.y, acc1, 0, 0, 0);
            acc0 = __builtin_amdgcn_mfma_f32_16x16x4f32(a.z, b0.z, acc0, 0, 0, 0); acc1 = __builtin_amdgcn_mfma_f32_16x16x4f32(a.z, b1.z, acc1, 0, 0, 0);
            acc0 = __builtin_amdgcn_mfma_f32_16x16x4f32(a.w, b0.w, acc0, 0, 0, 0); acc1 = __builtin_amdgcn_mfma_f32_16x16x4f32(a.w, b1.w, acc1, 0, 0, 0); }
        ssq += __shfl_xor(ssq, 16); ssq += __shfl_xor(ssq, 32);
        const float rinv = __builtin_amdgcn_rsqf(ssq * (1.f / D) + NORM_EPS);
        const float* rb = WSP(const float, WS_RBP) + (size_t)(layer * 9 + mrow) * NE;
        const float bb0 = rb[l15], bb1 = rb[16 + l15];
#pragma unroll
        for (int r = 0; r < 4; ++r) { const float ri = __shfl(rinv, 4 * q + r); lg_w[(4 * q + r) * 33 + l15] = acc0[r] * ri + bb0; lg_w[(4 * q + r) * 33 + 16 + l15] = acc1[r] * ri + bb1; }
        LDS_WAIT();
        if (C.lane < 16) { const int r = row0 + C.lane; float lg[32];
#pragma unroll
            for (int e = 0; e < 32; ++e) lg[e] = lg_w[C.lane * 33 + e];
            int te[4]; float tv[4];
#pragma unroll
            for (int k = 0; k < 4; ++k) { float best = -INFINITY; int bi = 0;
#pragma unroll
                for (int e = 0; e < 32; ++e) if (lg[e] > best) { best = lg[e]; bi = e; }
#pragma unroll
                for (int e = 0; e < 32; ++e) lg[e] = (e == bi) ? -INFINITY : lg[e];
                te[k] = bi; tv[k] = best; }
            float ex[4], es = 0.f;
#pragma unroll
            for (int k = 0; k < 4; ++k) { ex[k] = fast_exp(tv[k] - tv[0]); es += ex[k]; }
            const float ri = 1.f / es;
#pragma unroll
            for (int k = 0; k < 4; ++k) { const int pos = __hip_atomic_fetch_add(&cnt[te[k]], 1, __ATOMIC_RELAXED, __HIP_MEMORY_SCOPE_WORKGROUP);
                WSP(int, WS_TOKE)[(size_t)r * 4 + k] = te[k]; WSP(float, WS_TOKG)[(size_t)r * 4 + k] = ex[k] * ri; WSP(int, WS_TOKP)[(size_t)r * 4 + k] = pos; } }
        LDS_WAIT();
        { const float* sh = mod_vec(C, layer, mrow, 3); const float* scl = mod_vec(C, layer, mrow, 4);
          f32x4 gm[4], sv[4];
#pragma unroll
          for (int j = 0; j < 4; ++j) { const int col = ((j & 2) ? 512 : 0) + 8 * C.lane + 4 * (j & 1); gm[j] = *(const f32x4*)(gn + col) * (*(const f32x4*)(scl + col) + 1.0f); sv[j] = *(const f32x4*)(sh + col); }
#pragma unroll 1
          for (int rr = 0; rr < 16; rr += 2) { v4u xw[2][2];
#pragma unroll
              for (int u2 = 0; u2 < 2; ++u2) { const bf16* xr = WSP(const bf16, WS_XRES) + (size_t)(row0 + rr + u2) * D; xw[u2][0] = *(const v4u*)(xr + 8 * C.lane); xw[u2][1] = *(const v4u*)(xr + 512 + 8 * C.lane); }
#pragma unroll
              for (int u2 = 0; u2 < 2; ++u2) { const float ri = __shfl(rinv, rr + u2); f32x4 f[4];
                  f[0] = (f32x4){bflo(xw[u2][0].x), bfhi(xw[u2][0].x), bflo(xw[u2][0].y), bfhi(xw[u2][0].y)} * ri * gm[0] + sv[0]; f[1] = (f32x4){bflo(xw[u2][0].z), bfhi(xw[u2][0].z), bflo(xw[u2][0].w), bfhi(xw[u2][0].w)} * ri * gm[1] + sv[1];
                  f[2] = (f32x4){bflo(xw[u2][1].x), bfhi(xw[u2][1].x), bflo(xw[u2][1].y), bfhi(xw[u2][1].y)} * ri * gm[2] + sv[2]; f[3] = (f32x4){bflo(xw[u2][1].z), bfhi(xw[u2][1].z), bflo(xw[u2][1].w), bfhi(xw[u2][1].w)} * ri * gm[3] + sv[3];
                  bf16* fr_ = WSP(bf16, WS_F) + (size_t)(row0 + rr + u2) * D;
                  *(v4u*)(fr_ + 8 * C.lane) = (v4u){pk2(f[0].x, f[0].y), pk2(f[0].z, f[0].w), pk2(f[1].x, f[1].y), pk2(f[1].z, f[1].w)};
                  *(v4u*)(fr_ + 512 + 8 * C.lane) = (v4u){pk2(f[2].x, f[2].y), pk2(f[2].z, f[2].w), pk2(f[3].x, f[3].y), pk2(f[3].z, f[3].w)}; } } }
    }
    __syncthreads();
    if (C.tid < 32) WSP(int, WS_BCNT)[C.bid * 32 + C.tid] = cnt[C.tid];
}

DEVI void ph_slots(const Ctx& C, int layer, int ntok) {
    LAS int* tot = (LAS int*)C.lds; LAS int* myoff = tot + 32; LAS int* base = tot + 64; LAS int* part = tot + 96;
    {
      const int e = C.tid & 31, grp = C.tid >> 5; int t = 0, o = 0; const int* bc = WSP(const int, WS_BCNT) + e;
#pragma unroll 4
      for (int b2 = grp; b2 < C.G; b2 += 16) { const int c = bc[b2 * 32]; t += c; if (b2 < C.bid) o += c; }
      part[grp * 64 + e] = t; part[grp * 64 + 32 + e] = o; }
    __syncthreads();
    if (C.tid < 64) { int a = 0;
#pragma unroll
        for (int g = 0; g < 16; ++g) a += part[g * 64 + C.tid];
        if (C.tid < 32) tot[C.tid] = a; else myoff[C.tid - 32] = a; }
    __syncthreads();
    if (C.tid == 0) { int acc = 0; int* texp = WSP(int, WS_TEXP);
        for (int e = 0; e < 32; ++e) { base[e] = acc; const int nt = (tot[e] + 255) >> 8; if (C.bid == 0) for (int i = 0; i < nt; ++i) texp[1 + (acc >> 8) + i] = e; acc += nt << 8; }
        if (C.bid == 0) texp[0] = acc >> 8; }
    __syncthreads();
    int* rowmap = WSP(int, WS_ROWMAP);
    if (C.bid == 0) {
        for (int e = 0; e < 32; ++e) { const int lo = base[e] + tot[e], hi2 = base[e] + (((tot[e] + 255) >> 8) << 8); for (int i = lo + C.tid; i < hi2; i += 512) rowmap[i] = 0; } }
    const int nt = ntok / 16; const int r0 = 16 * (int)((long)C.bid * nt / C.G), r1 = 16 * (int)((long)(C.bid + 1) * nt / C.G);
    for (int i = r0 * 4 + C.tid; i < r1 * 4; i += 512) { const int e = WSP(const int, WS_TOKE)[i]; const int slot = base[e] + myoff[e] + WSP(const int, WS_TOKP)[i];
        WSP(int, WS_SLOT)[i] = slot; rowmap[slot] = i >> 2; }
}

DEVI void ph_attention(const Ctx& C, bool need_ctx, int layer) {
    const attn_body::bf16* QL = WSP(const attn_body::bf16, WS_QL); const attn_body::bf16* QC = WSP(const attn_body::bf16, WS_QC);
    const attn_body::bf16* KB = WSP(const attn_body::bf16, WS_K); const attn_body::bf16* VB = WSP(const attn_body::bf16, WS_V);
    attn_body::bf16* mix = WSP(attn_body::bf16, WS_MIX);
    constexpr int NQL = SEQ / 128, NQC = LC / 128, UL = NB * 6 * NQL, UC = NB * 6 * NQC;
    const float lam_init = 0.8f - 0.6f * fast_exp(-0.3f * (float)layer); float lam;
    { float p1 = 0.f, p2 = 0.f; if (C.lane < 32) { p1 = INP(15)[layer * 32 + C.lane] * INP(16)[layer * 32 + C.lane]; p2 = INP(17)[layer * 32 + C.lane] * INP(18)[layer * 32 + C.lane]; }
      lam = fast_exp(wave_sum(p1)) - fast_exp(wave_sum(p2)) + lam_init; }
    const float post = 1.f - lam_init; const float* subln = INP(19) + layer * 64;
    const int total = UL + (need_ctx ? UC : 0);
    const int conv_at = (layer + 1 < DEPTH) ? (int)(C.bid % 6) : -1; int ui = 0; bool conv_done = false;
    const int conv0_at = (layer == 0) ? (int)((C.bid + 3) % 6) : -1; bool conv0_done = false;
    for (int u = (C.bid + C.G / 2) % C.G; u < total; u += C.G, ++ui) {
        if (ui == conv_at) { __syncthreads(); convert_layer_weights(C, layer + 1, 2); __syncthreads(); conv_done = true; }
        if (ui == conv0_at) { __syncthreads(); convert_layer_weights(C, 0, 1); __syncthreads(); conv0_done = true; }
        const bool isc = u >= UL; int qb, bp;
        if (!isc && (C.G & 7) == 0 && NQL == 32 && C.G == 256) { const int w = u % C.G, rnd = u / C.G; bp = rnd * 8 + (w & 7); qb = w >> 3; }
        else { const int v = isc ? u - UL : u; const int nq = isc ? NQC : NQL; qb = v % nq; bp = v / nq; }
        const int p = bp % 6, b = bp / 6;
        const int slen = isc ? LC : SEQ; const attn_body::bf16* Qbase = isc ? QC : QL;
        const attn_body::bf16* Qa = Qbase + ((size_t)(b * 12 + 2 * p) * slen + qb * 128) * 64; const attn_body::bf16* Qb = Qa + (size_t)slen * 64;
        const attn_body::bf16* Kh = KB + ((size_t)(b * 6 + p) * NKEY + (isc ? SEQ : 0)) * 64; const attn_body::bf16* Vh = VB + ((size_t)(b * 6 + p) * NKEY + (isc ? SEQ : 0)) * 64;
        const size_t row0 = (size_t)(isc ? T_L + b * LC : b * SEQ) + qb * 128;
        attn_body::bf16 *Oa, *Ob; int opitch;
        if (p < 2) { Oa = mix + row0 * D + (2 * p) * 64; Ob = Oa + 64; opitch = D; }
        else { Oa = mix + row0 * D + 512 + (p - 2) * 64; Ob = Oa; opitch = D; }
        const int ntile = isc ? LC / 64 : NKEY / 64;
        if (p < 2) attn_body::attn_unit<8, 0>(Qa, Qb, Kh, Vh, Oa, Ob, opitch, ntile, (char*)C.lds, lam, post, subln);
        else if (C.wave < 4) attn_body::attn_unit<8, 1>(Qa, Qb, Kh, Vh, Oa, Ob, opitch, ntile, (char*)C.lds, lam, post, subln);
        else attn_body::attn_unit<8, 2>(Qa, Qb, Kh, Vh, Oa, Ob, opitch, ntile, (char*)C.lds, lam, post, subln);
    }
    if (conv_at >= 0 && !conv_done) { __syncthreads(); convert_layer_weights(C, layer + 1, 2); __syncthreads(); }
    if (conv0_at >= 0 && !conv0_done) { __syncthreads(); convert_layer_weights(C, 0, 1); __syncthreads(); }
}

DEVI void ph_outproj_ctx(const Ctx& C, int layer) {
    const int l15 = C.lane & 15, q = C.lane >> 4, rg = C.wave & 3, ch = C.wave >> 2;
    const float* g = mod_vec(C, layer, 8, 2);
    for (int tile = C.bid; tile < (NB * LC / 64) * (D / 128); tile += C.G) {
        const int r0 = (tile >> 3) * 64 + 16 * rg, c0 = (tile & 7) * 128 + 64 * ch;
        const bf16* a = WSP(const bf16, WS_MIX) + (size_t)(T_L + r0 + l15) * D + 8 * q;
        const bf16* b = WSP(const bf16, WS_WOUT) + (size_t)layer * D * D + (size_t)(c0 + l15) * D + 8 * q;
        f32x4 acc[4];
#pragma unroll
        for (int n = 0; n < 4; ++n) acc[n] = (f32x4){0.f, 0.f, 0.f, 0.f};
#pragma unroll 4
        for (int kk = 0; kk < D / 32; ++kk) { const bf16x8 av = *(const bf16x8*)(a + 32 * kk);
#pragma unroll
            for (int n = 0; n < 4; ++n) acc[n] = __builtin_amdgcn_mfma_f32_16x16x32_bf16(*(const bf16x8*)(b + (size_t)16 * n * D + 32 * kk), av, acc[n], 0, 0, 0); }
        const size_t ro = (size_t)(r0 + l15) * D; bf16* xo = WSP(bf16, WS_XRES) + (size_t)T_L * D + ro;
#pragma unroll
        for (int n = 0; n < 4; ++n) { const int cc = c0 + 16 * n + 4 * q; const f32x4 gv = *(const f32x4*)(g + cc); f32x4 xi;
            if (layer == 0) xi = *(const f32x4*)(INP(2) + ro + cc);
            else { const v2u w = *(const v2u*)(xo + cc); xi = (f32x4){bflo(w.x), bfhi(w.x), bflo(w.y), bfhi(w.y)}; }
            const f32x4 v = xi + gv * acc[n];
            *(v2u*)(xo + cc) = (v2u){pk2(v.x, v.y), pk2(v.z, v.w)}; }
    }
}

constexpr int PH_PER_LAYER = 10, N_PHASES = 2 + DEPTH * PH_PER_LAYER;
struct Args { const float* in[31]; float* out; unsigned char* ws; int ph_lo, ph_hi; };
template <int MASK> __global__ void __launch_bounds__(512, 2) mk_fwd(Args args) {
    extern __shared__ __attribute__((aligned(16))) unsigned char lds_raw[];
    { LAS unsigned long long* pt = (LAS unsigned long long*)((LAS unsigned char*)lds_raw + PTR_OFF);
      if (threadIdx.x == 0) {
#pragma unroll
          for (int i = 0; i < 31; ++i) pt[i] = (unsigned long long)args.in[i]; } }
    volatile LAS unsigned* MISC = (volatile LAS unsigned*)((LAS unsigned char*)lds_raw + MISC_OFF);
    if (threadIdx.x < 32) MISC[threadIdx.x] = 0u;
    __syncthreads();
#define CTX() Ctx C; { int t_ = threadIdx.x; LAUNDER_V(t_); C.tid = t_; C.lane = t_ & 63; C.wave = __builtin_amdgcn_readfirstlane(t_ >> 6); int b_ = blockIdx.x; LAUNDER_S(b_); C.bid = b_; \
    int g_ = gridDim.x; LAUNDER_S(g_); C.G = g_; unsigned long long w_ = (unsigned long long)args.ws; LAUNDER_S(w_); C.wsi = w_; C.out = (float*)(GAS float*)(unsigned long long)args.out; C.lds = (LAS unsigned char*)lds_raw; }
    const int lo = args.ph_lo, hi = args.ph_hi;
#if MK_N_LAUNCHES == 1
    XcdBarrier bar = xcd_barrier_post((unsigned*)(args.ws + WS_CTL) + CW_BAR, MISC + 8);
#define GRID_BAR() xcd_barrier(bar)
#else
#define GRID_BAR() do {} while (0)
#endif
#define PHON(b) (((MASK) >> (b)) & 1)
#ifndef REP_MASK
#define REP_MASK 0
#endif
#define REP(b) for (int rp_ = 0; rp_ < 1 + (((REP_MASK) >> (b)) & 1); ++rp_)
#define REPX(b, cond) for (int rp_ = 0; rp_ < 1 + ((((REP_MASK) >> (b)) & 1) && (cond)); ++rp_)
#define IN(k) (lo <= (k) && (k) < hi)
#define SEAM(k) do { if (IN(k) && IN((k) + 1)) { GRID_BAR(); if (((REP_MASK) >> 17) & 1) GRID_BAR(); } } while (0)
    if (PHON(0) && IN(0)) REP(0) { CTX(); p0_prologue(C); } SEAM(0);
#define LAYER_BODY(layer) { \
        const int p0 = 1 + layer * PH_PER_LAYER; const bool need_ctx = layer < DEPTH - 1; const int ntok = need_ctx ? T_ALL : T_L; \
        if (PHON(1) && IN(p0 + 0)) REPX(15, layer == 0) { CTX(); ph_norm_mix(C, layer); } SEAM(p0 + 0); \
        if (PHON(2) && IN(p0 + 1)) REP(2) { CTX(); pg8::Gemm g{WSP(const pg8::bf16_t, WS_H), WSP(const pg8::bf16_t, WS_WIN) + (size_t)layer * N_PROJ * D, T_ALL, N_PROJ, D}; \
            pg8::StaticOrder S; S.init(T_ALL, N_PROJ, C.G, C.bid); pg8::EpiBf16<0> E{WSP(pg8::bf16_t, WS_PROJ), N_PROJ, nullptr, 0, 0, 1.f}; \
            pg8::gemm_phase<pg8::EpiBf16<0>, pg8::StaticOrder, true, true>(C.lds, g, S, E); } SEAM(p0 + 1); \
        if (IN(p0 + 2)) { if (PHON(3)) REP(3) { CTX(); ph_attn_prep(C, layer); } if (PHON(5)) REP(5) { CTX(); ph_dn_chunk(C, layer); } } SEAM(p0 + 2); \
        if (IN(p0 + 3)) { if (PHON(6)) REP(6) { CTX(); ph_dn_scan(C, layer); } __syncthreads(); if (PHON(4)) REP(4) { CTX(); ph_gmlp(C, layer, ntok); } __syncthreads(); if (PHON(7)) REP(7) { CTX(); ph_attention(C, need_ctx, layer); } } SEAM(p0 + 3); \
        if (PHON(8) && IN(p0 + 4)) REP(8) { CTX(); ph_finalize(C, layer, ntok); } SEAM(p0 + 4); \
        if (PHON(9) && IN(p0 + 5)) REPX(14, layer == 0) { CTX(); pg8::Gemm g{WSP(const pg8::bf16_t, WS_MIX), WSP(const pg8::bf16_t, WS_WOUT) + (size_t)layer * D * D, T_L, D, D}; \
            pg8::StaticOrder S; S.init(T_L, D, C.G, C.bid); \
            if (layer == 0) { pg8::EpiOutRes<true> E{INP(0), INP(2), WSP(pg8::bf16_t, WS_XRES), WSP(const float, WS_MOD) + (size_t)layer * 9 * 6 * D}; \
                pg8::gemm_phase<pg8::EpiOutRes<true>, pg8::StaticOrder, true, true>(C.lds, g, S, E); } \
            else { pg8::EpiOutRes<false> E{WSP(const pg8::bf16_t, WS_XRES), WSP(const pg8::bf16_t, WS_XRES) + (size_t)T_L * D, WSP(pg8::bf16_t, WS_XRES), WSP(const float, WS_MOD) + (size_t)layer * 9 * 6 * D}; \
                pg8::gemm_phase<pg8::EpiOutRes<false>, pg8::StaticOrder, true, true>(C.lds, g, S, E); } \
            if (need_ctx) ph_outproj_ctx(C, layer); } SEAM(p0 + 5); \
        if (PHON(10) && IN(p0 + 6)) REP(10) { CTX(); ph_router(C, layer, ntok); } SEAM(p0 + 6); \
        if (PHON(11) && IN(p0 + 7)) REP(11) { CTX(); ph_slots(C, layer, ntok); } SEAM(p0 + 7); \
        if (PHON(12) && IN(p0 + 8)) REP(12) { CTX(); pg8::Gemm g{WSP(const pg8::bf16_t, WS_F), WSP(const pg8::bf16_t, WS_WUP) + (size_t)layer * NE * 2 * DE * D, P_ROWS, NE * 2 * DE, D, WSP(const int, WS_ROWMAP)}; \
            pg8::MoeOrder S; S.init(WSP(const int, WS_TEXP), 8, C.G, C.bid); pg8::EpiSwiglu E{WSP(pg8::bf16_t, WS_HID), INP(27) + (size_t)layer * NE * 2 * DE}; \
            pg8::gemm_phase<pg8::EpiSwiglu, pg8::MoeOrder, true, true, true>(C.lds, g, S, E); } SEAM(p0 + 8); \
        if (PHON(13) && IN(p0 + 9)) REP(13) { CTX(); pg8::Gemm g{WSP(const pg8::bf16_t, WS_HID), WSP(const pg8::bf16_t, WS_WDN) + (size_t)layer * NE * D * DE, P_ROWS, NE * D, DE}; \
            pg8::MoeOrder S; S.init(WSP(const int, WS_TEXP), 4, C.G, C.bid); pg8::EpiDown E{WSP(unsigned char, WS_YS), INP(29) + (size_t)layer * NE * D}; \
            pg8::gemm_phase<pg8::EpiDown, pg8::MoeOrder, true, true>(C.lds, g, S, E); } SEAM(p0 + 9); \
    }
    static_assert(DEPTH <= 4, "layer sites");
    if constexpr (DEPTH > 0) LAYER_BODY(0)
    if constexpr (DEPTH > 1) LAYER_BODY(1)
    if constexpr (DEPTH > 2) LAYER_BODY(2)
    if constexpr (DEPTH > 3) LAYER_BODY(3)
#undef LAYER_BODY
    if (PHON(1) && IN(N_PHASES - 1)) REP(16) { CTX(); ph_norm_mix(C, DEPTH); }
#undef IN
#undef SEAM
}

#ifndef EMU
#ifndef FULL_MASK_V
#define FULL_MASK_V 0x3fff
#endif
constexpr int FULL_MASK = FULL_MASK_V;
typedef void (*kern_t)(Args);
static int phase_mask(int p) {
    if (p == 0) return 1; if (p == N_PHASES - 1) return 2;
    const int k = (p - 1) % PH_PER_LAYER; const int m[10] = {2, 4, 8 | 32, 16 | 64 | 128, 256, 512, 1024, 2048, 4096, 8192}; return m[k];
}
static kern_t kern_of_mask(int m) {
    switch (m) {
#if MK_N_LAUNCHES == 1
        case FULL_MASK: return mk_fwd<FULL_MASK>;
#else
        case 1: return mk_fwd<1>; case 2: return mk_fwd<2>; case 4: return mk_fwd<4>; case 8: return mk_fwd<8>; case 16: return mk_fwd<16>; case 32: return mk_fwd<32>; case 192: return mk_fwd<192>; case 256: return mk_fwd<256>;
        case 512: return mk_fwd<512>; case 1024: return mk_fwd<1024>; case 2048: return mk_fwd<2048>; case 4096: return mk_fwd<4096>; case 8192: return mk_fwd<8192>;
#endif
        default: return nullptr;
    }
}
extern "C" void kernel_launch(void* const* d_in, const int* in_sizes, int n_in, void* d_out, int out_size, void* d_ws, size_t ws_size, hipStream_t stream) {
    static int grid = 0;
    if (grid == 0) {
        if (n_in != 31 || in_sizes[0] != T_L * D || out_size != T_L * D || ws_size < WS_END) { fprintf(stderr, "kernel_launch: shape/workspace mismatch (n_in %d, in0 %d, out %d, ws %zu, need %zu)\n", n_in, n_in > 0 ? in_sizes[0] : -1, out_size, ws_size, (size_t)WS_END); grid = -1; return; }
        int dev = 0, cus = 0;
        if (hipGetDevice(&dev) != hipSuccess || hipDeviceGetAttribute(&cus, hipDeviceAttributeMultiprocessorCount, dev) != hipSuccess) { grid = -1; return; }
#if MK_N_LAUNCHES == 1
        const int masks[1] = {FULL_MASK}; const int nm = 1;
#else
        const int masks[13] = {1, 2, 4, 8, 16, 32, 192, 256, 512, 1024, 2048, 4096, 8192}; const int nm = 13;
#endif
        for (int i = 0; i < nm; ++i) {
            if (hipFuncSetAttribute((const void*)kern_of_mask(masks[i]), hipFuncAttributeMaxDynamicSharedMemorySize, LDS_BYTES) != hipSuccess) { fprintf(stderr, "kernel_launch: hipFuncSetAttribute failed\n"); grid = -1; return; }
            int per_cu = 0;
            if (hipOccupancyMaxActiveBlocksPerMultiprocessor(&per_cu, (const void*)kern_of_mask(masks[i]), 512, LDS_BYTES) != hipSuccess || per_cu < 1) fprintf(stderr, "kernel_launch: occupancy query reports %d for mask %d\n", per_cu, masks[i]);
        }
        (void)hipGetLastError();
        grid = cus;
        if (grid > 1024) grid = 1024;
    }
    if (grid < 0) return;
    if (hipMemsetAsync((char*)d_ws + WS_CTL, 0, (CW_BAR + XCD_BAR_WORDS) * sizeof(unsigned), stream) != hipSuccess) return;
    Args a{};
    for (int i = 0; i < 31; ++i) a.in[i] = (const float*)d_in[i];
    a.out = (float*)d_out; a.ws = (unsigned char*)d_ws;
#if MK_N_LAUNCHES == 1
    a.ph_lo = 0; a.ph_hi = N_PHASES;
    hipLaunchKernelGGL(mk_fwd<FULL_MASK>, dim3(grid), dim3(512), LDS_BYTES, stream, a);
#else
    for (int p = 0; p < N_PHASES; ++p) { a.ph_lo = p; a.ph_hi = p + 1; const int pm = phase_mask(p);
        for (int bit = 0; bit < 14; ++bit) { int m = pm & (1 << bit); if (!m) continue; if (m == 64 || m == 128) { if (m == 128) continue; m = 192; } hipLaunchKernelGGL(kern_of_mask(m), dim3(grid), dim3(512), LDS_BYTES, stream, a); } }
#endif
}
#endif
```

```cpp
#ifndef EMU
#include <hip/hip_runtime.h>
#include <cstdio>
#include <cstdint>
#endif

#ifndef MK_N_LAUNCHES
#define MK_N_LAUNCHES 1
#endif

#ifndef CFG_BATCH
#define CFG_BATCH 8
#define CFG_SEQ 4096
#define CFG_CTX 256
#define CFG_DEPTH 4
#endif
constexpr int NB = CFG_BATCH, SEQ = CFG_SEQ, LC = CFG_CTX, DEPTH = CFG_DEPTH, D = 1024;
constexpr int GRID_W = 64;
constexpr int T_L = NB * SEQ, T_C = NB * LC, T_ALL = T_L + T_C;
constexpr int D_IN = 2832, N_PROJ = 2816;
constexpr int NKEY = SEQ + LC;
constexpr int NE = 32, TOPK = 4, DE = 1024;
constexpr int NCH_L = SEQ / 64, NCH_C = LC / 64, NCH = NCH_L + NCH_C;
constexpr int MAX_TILES = (T_ALL * TOPK) / 256 + NE;
constexpr int P_ROWS = MAX_TILES * 256;
constexpr float NORM_EPS = 1e-6f;
static_assert(SEQ % 256 == 0 && LC % 128 == 0 && T_ALL % 256 == 0 && (T_ALL * TOPK) % 256 == 0, "tiling");
constexpr int C_AQ = 0, C_AK = 256, C_AV = 384, C_BU = 512, C_BV = 768, C_CQ = 1024, C_CK = 1280, C_CV = 1536, C_DQKV = 1792, C_DZ = 2560, C_DB = 2816, C_DA = 2824;

#ifndef EMU
#define GAS __attribute__((address_space(1)))
#define LAS __attribute__((address_space(3)))
#define DEVI __device__ __forceinline__
#define LDS_WAIT() asm volatile("s_waitcnt lgkmcnt(0)" ::: "memory")
#define VM_WAIT() asm volatile("s_waitcnt vmcnt(0)" ::: "memory")
#define LAUNDER_V(x) asm volatile("" : "+v"(x))
#define LAUNDER_S(x) asm volatile("" : "+s"(x))
#endif
typedef unsigned short bf16;
typedef unsigned v4u __attribute__((ext_vector_type(4)));
typedef unsigned v2u __attribute__((ext_vector_type(2)));
typedef float f32x4 __attribute__((ext_vector_type(4)));
typedef float f32x2 __attribute__((ext_vector_type(2)));
typedef short bf16x8 __attribute__((ext_vector_type(8)));
typedef GAS unsigned gu32;
#define RLX_AGENT __ATOMIC_RELAXED, __HIP_MEMORY_SCOPE_AGENT
typedef __bf16 hbf2_t __attribute__((ext_vector_type(2)));
DEVI unsigned pk2(float lo, float hi) { const f32x2 v = {lo, hi}; return __builtin_bit_cast(unsigned, __builtin_convertvector(v, hbf2_t)); }
DEVI unsigned f2bf(float f) { return pk2(f, 0.f) & 0xffffu; }
DEVI float bf2f(unsigned h) { return __builtin_bit_cast(float, (h & 0xffffu) << 16); }
DEVI float bflo(unsigned w) { return __builtin_bit_cast(float, w << 16); }
DEVI float bfhi(unsigned w) { return __builtin_bit_cast(float, w & 0xffff0000u); }
DEVI float fast_exp(float x) { return __builtin_amdgcn_exp2f(x * 1.4426950408889634f); }
DEVI float fast_rcp(float x) { return __builtin_amdgcn_rcpf(x); }
DEVI float sigmoidf_(float x) { return fast_rcp(1.f + fast_exp(-x)); }
DEVI float siluf_(float x) { return x * sigmoidf_(x); }
DEVI float tanh_fast(float x) { const float e = fast_exp(-2.f * __builtin_fabsf(x)); const float t = (1.f - e) * fast_rcp(1.f + e); return x < 0.f ? -t : t; }
DEVI float gelu_tanh(float x) { return 0.5f * x * (1.f + tanh_fast(0.7978845608028654f * (x + 0.044715f * x * x * x))); }
DEVI float softplusf_(float x) { return x > 20.f ? x : __builtin_amdgcn_logf(1.f + fast_exp(x)) * 0.6931471805599453f; }
DEVI float wave_sum(float v) {
#pragma unroll
    for (int o = 1; o < 64; o <<= 1) v += __shfl_xor(v, o);
    return v;
}
template <int W> DEVI float group_sum(float v) {
#pragma unroll
    for (int o = 1; o < W; o <<= 1) v += __shfl_xor(v, o);
    return v;
}

constexpr size_t al256(size_t x) { return (x + 255) & ~(size_t)255; }
constexpr size_t WS_CTL = 0, CTL_ZERO_BYTES = 1u << 20;
constexpr size_t WS_MOD   = CTL_ZERO_BYTES;
constexpr size_t WS_WIN   = WS_MOD   + al256((size_t)DEPTH * 9 * 6 * D * 4);
constexpr size_t WS_WOUT  = WS_WIN   + al256((size_t)DEPTH * N_PROJ * D * 2);
constexpr size_t WS_WUP   = WS_WOUT  + al256((size_t)DEPTH * D * D * 2);
constexpr size_t WS_WDN   = WS_WUP   + al256((size_t)DEPTH * NE * 2 * DE * D * 2);
constexpr size_t WS_H     = WS_WDN   + al256((size_t)DEPTH * NE * D * DE * 2);
constexpr size_t WS_F     = WS_H     + al256((size_t)T_ALL * D * 2);
constexpr size_t WS_BA    = WS_F     + al256((size_t)T_ALL * D * 2);
constexpr size_t WS_PROJ  = WS_BA    + al256((size_t)T_ALL * 16 * 4);
constexpr size_t WS_XRES  = WS_PROJ  + al256((size_t)T_ALL * N_PROJ * 2);
constexpr size_t WS_MIX   = WS_XRES  + al256((size_t)T_ALL * D * 4);
constexpr size_t WS_QL    = WS_MIX   + al256((size_t)T_ALL * D * 2);
constexpr size_t WS_QC    = WS_QL    + al256((size_t)NB * 12 * SEQ * 64 * 2);
constexpr size_t WS_K     = WS_QC    + al256((size_t)NB * 12 * LC * 64 * 2);
constexpr size_t WS_V     = WS_K     + al256((size_t)NB * 6 * NKEY * 64 * 2);
constexpr size_t WS_OD    = WS_V     + al256((size_t)NB * 6 * NKEY * 64 * 2);
constexpr size_t WS_DNO   = WS_OD    + al256((size_t)2 * T_ALL * 256 * 2);
constexpr size_t WS_DNF   = WS_DNO   + al256((size_t)2 * T_ALL * 256 * 4);
constexpr size_t DN_UNIT_BYTES = 32768;
constexpr size_t WS_HID   = WS_DNF   + al256((size_t)NB * 2 * 4 * NCH * DN_UNIT_BYTES);
constexpr size_t WS_YS    = WS_HID   + al256((size_t)P_ROWS * DE * 2);
constexpr size_t WS_TOKE  = WS_YS    + al256((size_t)P_ROWS * D * 2);
constexpr size_t WS_TOKG  = WS_TOKE  + al256((size_t)T_ALL * 4 * 4);
constexpr size_t WS_TOKP  = WS_TOKG  + al256((size_t)T_ALL * 4 * 4);
constexpr size_t WS_SLOT  = WS_TOKP  + al256((size_t)T_ALL * 4 * 4);
constexpr size_t WS_BCNT  = WS_SLOT  + al256((size_t)T_ALL * 4 * 4);
constexpr size_t WS_TEXP  = WS_BCNT  + al256((size_t)1024 * 32 * 4);
constexpr size_t WS_RWP   = WS_TEXP  + al256((size_t)(MAX_TILES + 64) * 4);
constexpr size_t WS_RBP   = WS_RWP   + al256((size_t)DEPTH * 9 * NE * D * 4);
constexpr size_t WS_ROWMAP = WS_RBP  + al256((size_t)DEPTH * 9 * NE * 4);
constexpr size_t WS_ROPE  = WS_ROWMAP + al256((size_t)P_ROWS * 4);
constexpr size_t WS_END   = WS_ROPE  + al256((size_t)SEQ * 96 * 4);
constexpr int CW_TMO = 0, CW_CODE = 1, CW_BAR = 4096;
namespace pg8 {
#define PG8_LAS __attribute__((address_space(3)))
typedef unsigned short bf16_t;
typedef short bf16x8 __attribute__((ext_vector_type(8)));
typedef float f32x4 __attribute__((ext_vector_type(4)));
typedef unsigned u32x4 __attribute__((ext_vector_type(4)));
constexpr int BM = 256, BK = 64, HALF = 128, HTB = HALF * BK * 2  , STAGE_BYTES = 8 * HTB, NXCD = 8, WGM = 8;

__host__ __device__ __forceinline__ int lds_byte(int r, int c) { const int st = (r >> 4) * 2 + (c >> 5), rr = r & 15, cc = c & 31, ob = rr * 64 + cc * 2; return st * 1024 + (ob ^ (((ob >> 9) & 1) << 5)); }
__host__ __device__ __forceinline__ void stage_rc(int b, int& R, int& C) { const int st = b / 1024, sb = b % 1024, swz = sb ^ (((sb >> 9) & 1) << 5); R = (st >> 1) * 16 + swz / 64; C = (st & 1) * 32 + (swz % 64) / 2; }
__host__ __device__ __forceinline__ int perm32(int rho) { const int n = rho >> 4, i = rho & 15; return 8 * (i >> 2) + 4 * n + (i & 3); }

struct Unit { int pm, pn; };
struct Gemm { const bf16_t* A; const bf16_t* Bt; int M, N, K; const int* rowmap = nullptr; };

struct StaticOrder {
    int nM, nN, nwg, G, c;
    __host__ __device__ void init(int M, int N, int G_, int c_) { nM = M / BM; nN = N / BM; nwg = nM * nN; G = G_; c = c_; }
    __host__ __device__ bool next(int i, Unit& u) const {
        const long L = (long)i * G + c; if (L >= nwg) return false;
        int wgid = (int)L; { const int q = nwg / NXCD, r = nwg % NXCD, xcd = wgid % NXCD, off = wgid / NXCD; wgid = (xcd < r ? xcd * (q + 1) : r * (q + 1) + (xcd - r) * q) + off; }
        const int nig = WGM * nN, gid = wgid / nig, fm = gid * WGM, gsz = (nM - fm) < WGM ? (nM - fm) : WGM;
        u.pm = fm + ((wgid % nig) % gsz); u.pn = (wgid % nig) / gsz; return true;
    }
    __device__ __forceinline__ void a_ready(const Unit&) const {}
    __device__ __forceinline__ void done(const Unit&) const {}
};

#ifndef EMU
__device__ __forceinline__ unsigned cvt_pk_bf16(float lo, float hi) { unsigned r; asm volatile("v_cvt_pk_bf16_f32 %0, %1, %2" : "=v"(r) : "v"(lo), "v"(hi)); return r; }
#else
__device__ __forceinline__ unsigned cvt_pk_bf16(float lo, float hi) { return pk2(lo, hi); }
#endif
typedef float f32x2 __attribute__((ext_vector_type(2)));
__device__ __forceinline__ f32x2 gelu_pk(f32x2 v) {
    const f32x2 av = __builtin_elementwise_abs(v), d = av * 0.2316418882f + 1.0f;
    f32x2 t; t.x = __builtin_amdgcn_rcpf(d.x); t.y = __builtin_amdgcn_rcpf(d.y);
    f32x2 q = t * 0.5307027145f + (-0.7265760135f); q = q * t + 0.7107068705f; q = q * t + (-0.142248368f); q = q * t + 0.127414796f; q = q * t;
    const f32x2 s = (v * v) * (-0.72134752044f);
    f32x2 e; e.x = __builtin_amdgcn_exp2f(s.x); e.y = __builtin_amdgcn_exp2f(s.y);
    const f32x2 m = v * (q * e), r = v - m;
    f32x2 o; o.x = v.x < 0.f ? m.x : r.x; o.y = v.y < 0.f ? m.y : r.y; return o;
}

template <int ACT  > struct EpiBf16 {
    static constexpr bool PERM = true, AFTER_DRAIN = false; static_assert(ACT == 0 || ACT == 1, "EpiBf16: ACT is 0 (none) or 1 (gelu_pk)");
    bf16_t* O; int ldc; const float* bias; int split_cols; size_t split_stride; float scale0;
    __device__ __forceinline__ void operator()(const f32x4 (&acc)[2][2][4][2], const Unit& u, int wr, int wc, int fr, int fq) const {
        const int row0 = u.pm * BM + wr * 64 + fr; int colt = u.pn * BM; bf16_t* base = O;
        float sc = 1.f; if (split_cols) { const int t = colt / split_cols; base += (size_t)t * split_stride; colt -= t * split_cols; if (t == 0) sc = scale0; }
        const int col0 = colt + wc * 32 + 8 * fq, bcol0 = u.pn * BM + wc * 32 + 8 * fq;
        f32x4 bv[2][2];
#pragma unroll
        for (int bj = 0; bj < 2; ++bj)
#pragma unroll
            for (int n = 0; n < 2; ++n) bv[bj][n] = bias ? *(const f32x4*)(bias + bcol0 + bj * HALF + 4 * n) : (f32x4){0.f, 0.f, 0.f, 0.f};
#pragma unroll
        for (int ai = 0; ai < 2; ++ai)
#pragma unroll
            for (int m = 0; m < 4; ++m) { bf16_t* rowp = base + (size_t)(row0 + ai * HALF + m * 16) * ldc + col0;
#pragma unroll
                for (int bj = 0; bj < 2; ++bj) { f32x4 v0 = acc[ai][bj][m][0] + bv[bj][0], v1 = acc[ai][bj][m][1] + bv[bj][1];
                    if (ACT == 1) { f32x2 a = gelu_pk((f32x2){v0[0], v0[1]}), b = gelu_pk((f32x2){v0[2], v0[3]}), c = gelu_pk((f32x2){v1[0], v1[1]}), d = gelu_pk((f32x2){v1[2], v1[3]});
                        v0 = (f32x4){a.x, a.y, b.x, b.y}; v1 = (f32x4){c.x, c.y, d.x, d.y}; }
                    v0 = v0 * sc; v1 = v1 * sc; u32x4 w; w.x = cvt_pk_bf16(v0[0], v0[1]); w.y = cvt_pk_bf16(v0[2], v0[3]); w.z = cvt_pk_bf16(v1[0], v1[1]); w.w = cvt_pk_bf16(v1[2], v1[3]);
                    *(u32x4*)(rowp + bj * HALF) = w; } }
    }
};

template <bool IN_F32> struct EpiOutRes {
    static constexpr bool PERM = true, AFTER_DRAIN = false;
    const void* xin_l; const void* xin_c;
    bf16_t* xres; const float* mod;
    __device__ __forceinline__ void operator()(const f32x4 (&acc)[2][2][4][2], const Unit& u, int wr, int wc, int fr, int fq) const {
        const int rowt = u.pm * BM; const bool isc = rowt >= T_L; const int mrow = isc ? 8 : rowt / SEQ;
        const float* g = mod + (size_t)(mrow * 6 + 2) * D;
        const size_t inoff = isc ? (size_t)(rowt - T_L) * D : (size_t)rowt * D;
        const float* xf = (const float*)(isc ? xin_c : xin_l) + inoff; const bf16_t* xb = (const bf16_t*)(isc ? xin_c : xin_l) + inoff;
        bf16_t* xo = xres + (size_t)rowt * D;
        const int col0 = u.pn * BM + wc * 32 + 8 * fq;
        f32x4 gv[2][2];
#pragma unroll
        for (int bj = 0; bj < 2; ++bj)
#pragma unroll
            for (int n = 0; n < 2; ++n) gv[bj][n] = *(const f32x4*)(g + col0 + bj * HALF + 4 * n);
#pragma unroll
        for (int ai = 0; ai < 2; ++ai)
#pragma unroll
          for (int mp = 0; mp < 2; ++mp) {
            f32x4 xi[2][2][2];
#pragma unroll
            for (int m2 = 0; m2 < 2; ++m2) { const size_t ro = (size_t)(ai * HALF + wr * 64 + (2 * mp + m2) * 16 + fr) * D + col0;
#pragma unroll
                for (int bj = 0; bj < 2; ++bj) {
                    if constexpr (IN_F32) { xi[m2][bj][0] = *(const f32x4*)(xf + ro + bj * HALF); xi[m2][bj][1] = *(const f32x4*)(xf + ro + bj * HALF + 4); }
                    else { const u32x4 w = *(const u32x4*)(xb + ro + bj * HALF);
                        xi[m2][bj][0] = (f32x4){bflo(w.x), bfhi(w.x), bflo(w.y), bfhi(w.y)}; xi[m2][bj][1] = (f32x4){bflo(w.z), bfhi(w.z), bflo(w.w), bfhi(w.w)}; } } }
#pragma unroll
            for (int m2 = 0; m2 < 2; ++m2) { const int m = 2 * mp + m2; const size_t ro = (size_t)(ai * HALF + wr * 64 + m * 16 + fr) * D + col0;
#pragma unroll
                for (int bj = 0; bj < 2; ++bj) { const f32x4 v0 = xi[m2][bj][0] + gv[bj][0] * acc[ai][bj][m][0], v1 = xi[m2][bj][1] + gv[bj][1] * acc[ai][bj][m][1];
                    u32x4 w; w.x = cvt_pk_bf16(v0[0], v0[1]); w.y = cvt_pk_bf16(v0[2], v0[3]); w.z = cvt_pk_bf16(v1[0], v1[1]); w.w = cvt_pk_bf16(v1[2], v1[3]);
                    *(u32x4*)(xo + ro + bj * HALF) = w; } } }
    }
};
struct EpiSwiglu {
    static constexpr bool PERM = true, AFTER_DRAIN = false;
    bf16_t* hid; const float* bup;
    __device__ __forceinline__ void operator()(const f32x4 (&acc)[2][2][4][2], const Unit& u, int wr, int wc, int fr, int fq) const {
        const int e = u.pn >> 3, j = u.pn & 7; const int h0 = j * HALF + wc * 32 + 8 * fq;
        const float* bg = bup + (size_t)e * 2 * DE + h0; const float* bu = bg + DE;
        f32x4 vg[2], vu[2];
#pragma unroll
        for (int n = 0; n < 2; ++n) { vg[n] = *(const f32x4*)(bg + 4 * n); vu[n] = *(const f32x4*)(bu + 4 * n); }
#pragma unroll
        for (int ai = 0; ai < 2; ++ai)
#pragma unroll
            for (int m = 0; m < 4; ++m) { const size_t row = (size_t)u.pm * BM + ai * HALF + wr * 64 + m * 16 + fr; float o[8];
#pragma unroll
                for (int n = 0; n < 2; ++n) { const f32x4 gt = acc[ai][0][m][n] + vg[n], up = acc[ai][1][m][n] + vu[n];
#pragma unroll
                    for (int i = 0; i < 4; ++i) { const float gg = __builtin_fminf(gt[i], 7.0f); const float uu = __builtin_fminf(__builtin_fmaxf(up[i], -7.0f), 7.0f);
                        o[4 * n + i] = gg * sigmoidf_(1.702f * gg) * (uu + 1.0f); } }
                u32x4 w; w.x = cvt_pk_bf16(o[0], o[1]); w.y = cvt_pk_bf16(o[2], o[3]); w.z = cvt_pk_bf16(o[4], o[5]); w.w = cvt_pk_bf16(o[6], o[7]);
                *(u32x4*)(hid + row * DE + h0) = w; }
    }
};
struct EpiDown {
    static constexpr bool PERM = true, AFTER_DRAIN = false;
    unsigned char* ys; const float* bdn;
    __device__ __forceinline__ void operator()(const f32x4 (&acc)[2][2][4][2], const Unit& u, int wr, int wc, int fr, int fq) const {
        typedef unsigned u32x2v __attribute__((ext_vector_type(2)));
        const int e = u.pn >> 2, j = u.pn & 3; const int col0 = j * BM + wc * 32 + 8 * fq;
        f32x4 bv[2][2];
#pragma unroll
        for (int bj = 0; bj < 2; ++bj)
#pragma unroll
            for (int n = 0; n < 2; ++n) bv[bj][n] = *(const f32x4*)(bdn + (size_t)e * D + col0 + bj * HALF + 4 * n);
#pragma unroll
        for (int ai = 0; ai < 2; ++ai)
#pragma unroll
            for (int m = 0; m < 4; ++m) { const size_t row = (size_t)u.pm * BM + ai * HALF + wr * 64 + m * 16 + fr;
#pragma unroll
                for (int bj = 0; bj < 2; ++bj) { const f32x4 v0 = acc[ai][bj][m][0] + bv[bj][0], v1 = acc[ai][bj][m][1] + bv[bj][1];
                    int w0 = 0, w1 = 0;
                    w0 = __builtin_amdgcn_cvt_pk_fp8_f32(v0[0], v0[1], w0, false); w0 = __builtin_amdgcn_cvt_pk_fp8_f32(v0[2], v0[3], w0, true);
                    w1 = __builtin_amdgcn_cvt_pk_fp8_f32(v1[0], v1[1], w1, false); w1 = __builtin_amdgcn_cvt_pk_fp8_f32(v1[2], v1[3], w1, true);
                    *(u32x2v*)(ys + row * D + col0 + bj * HALF) = (u32x2v){(unsigned)w0, (unsigned)w1}; } }
    }
};
struct MoeOrder {
    const int* texp; int ntiles, nN, nwg, G, c;
    __device__ __forceinline__ void init(const int* texp_, int nN_, int G_, int c_) { texp = texp_; ntiles = texp_[0]; nN = nN_; nwg = ntiles * nN_; G = G_; c = c_; }
    __device__ __forceinline__ bool next(int i, Unit& u) const {
        const long L = (long)i * G + c; if (L >= nwg) return false;
        int wgid = (int)L; { const int q = nwg / NXCD, r = nwg % NXCD, xcd = wgid % NXCD, off = wgid / NXCD; wgid = (xcd < r ? xcd * (q + 1) : r * (q + 1) + (xcd - r) * q) + off; }
        const int nig = WGM * nN, gid = wgid / nig, fm = gid * WGM, gsz = (ntiles - fm) < WGM ? (ntiles - fm) : WGM;
        const int pm = fm + ((wgid % nig) % gsz); u.pm = pm; u.pn = texp[1 + pm] * nN + (wgid % nig) / gsz; return true;
    }
    __device__ __forceinline__ void a_ready(const Unit&) const {}
    __device__ __forceinline__ void done(const Unit&) const {}
};
#ifndef EMU
template <class Epi, class Sched, bool ALIGN_EPI = false, bool SP2 = false, bool GATHER = false>
__device__ __forceinline__ void gemm_phase(PG8_LAS unsigned char* lds, const Gemm g, const Sched& S, const Epi& E) {
    int tid_ = threadIdx.x; asm volatile("" : "+v"(tid_));
    const int tid = tid_, wid = __builtin_amdgcn_readfirstlane(tid >> 6), lane = tid & 63, wr = wid >> 2, wc = wid & 3, fr = lane & 15, fq = lane >> 4;
    const int K = g.K, nt = K / BK;
    unsigned voffA[2], voffB[2]; int gR[2], gC[2];
#pragma unroll
    for (int i = 0; i < 2; ++i) { int R, C; stage_rc(tid * 16 + i * 8192, R, C); const int Rb = Epi::PERM ? ((R & ~31) + perm32(R & 31)) : R;
        voffA[i] = (unsigned)(R * K + C) * 2u; voffB[i] = (unsigned)(Rb * K + C) * 2u; gR[i] = R; gC[i] = C; }
    unsigned voffC[2][2], voffN[2][2];
#define PG8_GOFF(dst, pm_) do { _Pragma("unroll") for (int h_ = 0; h_ < 2; ++h_) _Pragma("unroll") for (int i_ = 0; i_ < 2; ++i_) \
        dst[h_][i_] = (unsigned)(g.rowmap[(size_t)(pm_) * BM + h_ * HALF + gR[i_]] * K + gC[i_]) * 2u; } while (0)
    const size_t kstep = (size_t)(BK * 2);
    const size_t hstep = (size_t)HALF * K * 2;
    const size_t tstep = 2 * hstep;
    const unsigned ldsw = (unsigned)wid * 1024u;
    const int aoff = lds_byte(wr * 64 + fr, fq * 8), boff = lds_byte(wc * 32 + fr, fq * 8);
#define PG8_SA(b, h) (((b) * 2 + (h)) * HTB)
#define PG8_SB(b, h) ((4 + (b) * 2 + (h)) * HTB)
#define PG8_STAGE(bufoff, gbase, voff) do { _Pragma("unroll") for (int _i = 0; _i < 2; ++_i) \
        __builtin_amdgcn_global_load_lds((const unsigned*)((const char*)(gbase) + (voff)[_i]), (PG8_LAS unsigned*)(lds + (bufoff) + ldsw + _i * 8192), 16, 0, 0); } while (0)
#define PG8_LDA(dst, b, h) do { _Pragma("unroll") for (int m = 0; m < 4; ++m) _Pragma("unroll") for (int k = 0; k < 2; ++k) dst[m][k] = *(const PG8_LAS bf16x8*)(lds + PG8_SA(b, h) + aoff + m * 2048 + k * 1024); } while (0)
#define PG8_LDB(dst, b, h) do { _Pragma("unroll") for (int n = 0; n < 2; ++n) _Pragma("unroll") for (int k = 0; k < 2; ++k) dst[n][k] = *(const PG8_LAS bf16x8*)(lds + PG8_SB(b, h) + boff + n * 2048 + k * 1024); } while (0)
#define PG8_MMA(ai, bj, At, Bt) do { __builtin_amdgcn_s_setprio(1); _Pragma("unroll") for (int m = 0; m < 4; ++m) _Pragma("unroll") for (int n = 0; n < 2; ++n) _Pragma("unroll") for (int k = 0; k < 2; ++k) \
        acc[ai][bj][m][n] = __builtin_amdgcn_mfma_f32_16x16x32_bf16(Bt[n][k], At[m][k], acc[ai][bj][m][n], 0, 0, 0); __builtin_amdgcn_s_setprio(0); } while (0)
#define PG8_WAIT_V(n) asm volatile("s_waitcnt vmcnt(" #n ")" ::: "memory")
#define PG8_WAIT_L(n) asm volatile("s_waitcnt lgkmcnt(" #n ")" ::: "memory")
#define PG8_BAR __builtin_amdgcn_s_barrier()
#define PG8_SCHED __builtin_amdgcn_sched_barrier(0)
#define PG8_STAGEA(bufoff, gbase, h, nx) do { if constexpr (GATHER) { _Pragma("unroll") for (int _i = 0; _i < 2; ++_i) { const unsigned o_ = (nx) ? voffN[h][_i] : voffC[h][_i]; \
        __builtin_amdgcn_global_load_lds((const unsigned*)((const char*)(gbase) + o_), (PG8_LAS unsigned*)(lds + (bufoff) + ldsw + _i * 8192), 16, 0, 0); } } \
    else { PG8_STAGE(bufoff, (gbase) + (h) * hstep, voffA); } } while (0)
    Unit cur, nxt; int ui = 0;
    if (!S.next(0, cur)) return;
    f32x4 acc[2][2][4][2];
#pragma unroll
    for (int a = 0; a < 2; ++a)
#pragma unroll
        for (int b = 0; b < 2; ++b)
#pragma unroll
            for (int m = 0; m < 4; ++m)
#pragma unroll
                for (int n = 0; n < 2; ++n) acc[a][b][m][n] = (f32x4){0.f, 0.f, 0.f, 0.f};
    bf16x8 At[4][2], B0[2][2], B1[2][2];
    const char* cA = (const char*)g.A + (GATHER ? (size_t)0 : (size_t)cur.pm * tstep); if constexpr (GATHER) { PG8_GOFF(voffC, cur.pm); }
    const char* cB = (const char*)g.Bt + (size_t)cur.pn * tstep;
    S.a_ready(cur);
    if constexpr (SP2) {
        PG8_STAGE(PG8_SB(0, 0), cB, voffB); PG8_STAGE(PG8_SB(0, 1), cB + hstep, voffB); PG8_STAGEA(PG8_SA(0, 0), cA, 0, false); PG8_STAGEA(PG8_SA(0, 1), cA, 1, false);
        if (wr == 1) PG8_BAR;
        PG8_WAIT_V(2); PG8_BAR;
        PG8_STAGE(PG8_SB(1, 0), cB + kstep, voffB); PG8_STAGEA(PG8_SA(1, 0), cA + kstep, 0, false); PG8_STAGE(PG8_SB(1, 1), cB + hstep + kstep, voffB);
        PG8_WAIT_V(6); PG8_BAR;
    } else {
        PG8_STAGE(PG8_SB(0, 0), cB, voffB); PG8_STAGEA(PG8_SA(0, 0), cA, 0, false); PG8_STAGE(PG8_SB(0, 1), cB + hstep, voffB); PG8_STAGEA(PG8_SA(0, 1), cA, 1, false);
        if (wr == 1) PG8_BAR;
        PG8_WAIT_V(4); PG8_BAR;
        PG8_STAGE(PG8_SB(1, 0), cB + kstep, voffB); PG8_STAGEA(PG8_SA(1, 0), cA + kstep, 0, false); PG8_STAGE(PG8_SB(1, 1), cB + hstep + kstep, voffB);
        PG8_WAIT_V(6); PG8_BAR;
    }
    for (;;) {
        const bool has_next = S.next(ui + 1, nxt);
        if constexpr (GATHER) { if (has_next) { PG8_GOFF(voffN, nxt.pm); } else { _Pragma("unroll") for (int h_ = 0; h_ < 2; ++h_) _Pragma("unroll") for (int i_ = 0; i_ < 2; ++i_) voffN[h_][i_] = voffC[h_][i_]; } }
        const char* nA = (has_next && !GATHER) ? (const char*)g.A + (size_t)nxt.pm * tstep : cA; const char* nB = has_next ? (const char*)g.Bt + (size_t)nxt.pn * tstep : cB;
        for (int t = 0; t < nt; t += 2) {
            const bool last = (t == nt - 2);
            const char* a1 = cA + (size_t)(t + 1) * kstep;
            const char* a2 = last ? nA : cA + (size_t)(t + 2) * kstep; const char* b2 = last ? nB : cB + (size_t)(t + 2) * kstep;
            const char* a3 = a2 + kstep; const char* b3 = b2 + kstep;
            if (last && has_next) S.a_ready(nxt);
            if constexpr (SP2) {
            PG8_LDB(B0, 0, 0); PG8_LDB(B1, 0, 1); PG8_SCHED; PG8_LDA(At, 0, 0); PG8_STAGEA(PG8_SA(1, 1), a1, 1, false);
            PG8_WAIT_V(8); PG8_WAIT_L(0); PG8_BAR; PG8_MMA(0, 0, At, B0); PG8_MMA(0, 1, At, B1); PG8_BAR; PG8_SCHED;
            PG8_LDA(At, 0, 1); PG8_STAGE(PG8_SB(0, 0), b2, voffB); PG8_STAGE(PG8_SB(0, 1), b2 + hstep, voffB); PG8_STAGEA(PG8_SA(0, 0), a2, 0, last);
            PG8_WAIT_V(8); PG8_WAIT_L(0); PG8_BAR; PG8_MMA(1, 0, At, B0); PG8_MMA(1, 1, At, B1); PG8_BAR; PG8_SCHED;
            PG8_LDB(B0, 1, 0); PG8_LDB(B1, 1, 1); PG8_SCHED; PG8_LDA(At, 1, 0); PG8_STAGEA(PG8_SA(0, 1), a2, 1, last);
            PG8_WAIT_V(8); PG8_WAIT_L(0); PG8_BAR; PG8_MMA(0, 0, At, B0); PG8_MMA(0, 1, At, B1); PG8_BAR; PG8_SCHED;
            PG8_LDA(At, 1, 1); PG8_STAGE(PG8_SB(1, 0), b3, voffB); PG8_STAGE(PG8_SB(1, 1), b3 + hstep, voffB); PG8_STAGEA(PG8_SA(1, 0), a3, 0, last);
            PG8_WAIT_V(8); PG8_WAIT_L(0); PG8_BAR; PG8_MMA(1, 0, At, B0); PG8_MMA(1, 1, At, B1); PG8_BAR; PG8_SCHED;
            } else {
            PG8_LDB(B0, 0, 0); PG8_SCHED; PG8_LDA(At, 0, 0); PG8_STAGEA(PG8_SA(1, 1), a1, 1, false);
            PG8_WAIT_L(8); PG8_BAR; PG8_WAIT_L(0); PG8_MMA(0, 0, At, B0); PG8_BAR; PG8_SCHED;
            PG8_LDB(B1, 0, 1); PG8_STAGE(PG8_SB(0, 0), b2, voffB);
            PG8_BAR; PG8_WAIT_L(0); PG8_MMA(0, 1, At, B1); PG8_BAR;
            PG8_LDA(At, 0, 1); PG8_STAGEA(PG8_SA(0, 0), a2, 0, last);
            PG8_BAR; PG8_WAIT_L(0); PG8_MMA(1, 0, At, B0); PG8_BAR; PG8_SCHED;
            PG8_STAGE(PG8_SB(0, 1), b2 + hstep, voffB);
            PG8_WAIT_V(6); PG8_BAR; PG8_MMA(1, 1, At, B1); PG8_BAR;
            PG8_LDB(B0, 1, 0); PG8_SCHED; PG8_LDA(At, 1, 0); PG8_STAGEA(PG8_SA(0, 1), a2, 1, last);
            PG8_WAIT_L(8); PG8_BAR; PG8_WAIT_L(0); PG8_MMA(0, 0, At, B0); PG8_BAR; PG8_SCHED;
            PG8_LDB(B1, 1, 1); PG8_STAGE(PG8_SB(1, 0), b3, voffB);
            PG8_BAR; PG8_WAIT_L(0); PG8_MMA(0, 1, At, B1); PG8_BAR;
            PG8_LDA(At, 1, 1); PG8_STAGEA(PG8_SA(1, 0), a3, 0, last);
            PG8_BAR; PG8_WAIT_L(0); PG8_MMA(1, 0, At, B0); PG8_BAR; PG8_SCHED;
            PG8_STAGE(PG8_SB(1, 1), b3 + hstep, voffB);
            PG8_WAIT_V(6); PG8_BAR; PG8_MMA(1, 1, At, B1); PG8_BAR;
            }
        }
        if constexpr (ALIGN_EPI) { if (wr == 0) PG8_BAR; }
        if constexpr (!Epi::AFTER_DRAIN) { E(acc, cur, wr, wc, fr, fq); S.done(cur); }
        if (!has_next) break;
#pragma unroll
        for (int a = 0; a < 2; ++a)
#pragma unroll
            for (int b = 0; b < 2; ++b)
#pragma unroll
                for (int m = 0; m < 4; ++m)
#pragma unroll
                    for (int n = 0; n < 2; ++n) acc[a][b][m][n] = (f32x4){0.f, 0.f, 0.f, 0.f};
        cur = nxt; cA = nA; cB = nB; ++ui;
        if constexpr (GATHER) { _Pragma("unroll") for (int h_ = 0; h_ < 2; ++h_) _Pragma("unroll") for (int i_ = 0; i_ < 2; ++i_) voffC[h_][i_] = voffN[h_][i_]; }
        if constexpr (ALIGN_EPI) { if (wr == 1) PG8_BAR; }
    }
    PG8_WAIT_V(0);
    if constexpr (!ALIGN_EPI) { if (wr == 0) PG8_BAR; }
    PG8_BAR;
    if constexpr (Epi::AFTER_DRAIN) { E.fused(acc, cur, wr, wc, fr, fq, lds, wid, lane); S.done(cur); }
#undef PG8_SA
#undef PG8_SB
#undef PG8_STAGE
#undef PG8_STAGEA
#undef PG8_GOFF
#undef PG8_LDA
#undef PG8_LDB
#undef PG8_MMA
#undef PG8_WAIT_V
#undef PG8_WAIT_L
#undef PG8_BAR
#undef PG8_SCHED
}
#else
EMU_GEMM_PHASE
#endif
}
#ifndef EMU
namespace attn_body {
using bf16=unsigned short;
using bf16x8=__attribute__((ext_vector_type(8)))short;
using s16x4=__attribute__((ext_vector_type(4)))short;
using f32x16=__attribute__((ext_vector_type(16)))float;
using u32x4=__attribute__((ext_vector_type(4)))unsigned;
constexpr int D=64,DM=64;
constexpr int NW=8,QBLK=32,QB=QBLK*NW,KVBLK=64;
__device__ __forceinline__ int crow(int r,int hi){return (r&3)+8*(r>>2)+4*hi;}
#define SBAR() __builtin_amdgcn_sched_barrier(0)
constexpr int NSLOT=3, SLOTB=8192;
constexpr int LDS_K=0, LDS_V=NSLOT*SLOTB, LDS_WS=2*NSLOT*SLOTB, LDS_OST=LDS_WS+NW*64*4, LDS_BYTES=LDS_OST+NW*4096;
__device__ __forceinline__ void glds16(const void*gsrc,unsigned lds_dst){unsigned keep;
  asm volatile("s_mov_b32 %0, m0\n\ts_mov_b32 m0, %2\n\ts_nop 0\n\tglobal_load_lds_dwordx4 %1, off\n\ts_mov_b32 m0, %0":"=&s"(keep):"v"(gsrc),"s"(lds_dst):"memory");}
__device__ __forceinline__ float max3f(float a,float b,float c){float r;asm("v_max3_f32 %0, %1, %2, %3":"=v"(r):"v"(a),"v"(b),"v"(c));return r;}
__device__ __forceinline__ float max2f(float a,float b){float r;asm("v_max_f32_e32 %0, %1, %2":"=v"(r):"v"(a),"v"(b));return r;}
__device__ __forceinline__ float fadd_s(float a,float b){float r;asm("v_add_f32_e32 %0, %1, %2":"=v"(r):"v"(a),"v"(b));return r;}
__device__ __forceinline__ float fsub_s(float a,float b){float r;asm("v_sub_f32_e32 %0, %1, %2":"=v"(r):"v"(a),"v"(b));return r;}
typedef float f32x2_t __attribute__((ext_vector_type(2))); typedef __bf16 bf16x2_t __attribute__((ext_vector_type(2)));
__device__ __forceinline__ unsigned cvtpk_s(float lo,float hi){f32x2_t v={lo,hi};bf16x2_t b=__builtin_convertvector(v,bf16x2_t);return __builtin_bit_cast(unsigned,b);}
#define WAIT_BAR(N) asm volatile("s_waitcnt vmcnt(" #N ") lgkmcnt(0)\n\ts_barrier":::"memory")

template<int MODE> __device__ __forceinline__ constexpr bool d0_on(int d0){ return MODE==0 || (MODE==1 && d0<2) || (MODE==2 && d0>=2); }
template<int MODE> __device__ __forceinline__ void qkt(f32x16&p0,f32x16&p1,const char*Kslot,const bf16x8*qr,const f32x16&negm,int r32,int hi){
  const char*kb=Kslot+hi*1024+r32*16;
  constexpr int D0A=(MODE==2)?2:0, D0B=(MODE==1)?2:4;
  #pragma unroll
  for(int d0=D0A;d0<D0B;++d0){
    const bf16x8 b0=*reinterpret_cast<const bf16x8*>(kb+d0*2048);
    const bf16x8 b1=*reinterpret_cast<const bf16x8*>(kb+d0*2048+512);
    if(d0==D0A){p0=__builtin_amdgcn_mfma_f32_32x32x16_bf16(b0,qr[d0],negm,0,0,0);p1=__builtin_amdgcn_mfma_f32_32x32x16_bf16(b1,qr[d0],negm,0,0,0);}
    else{p0=__builtin_amdgcn_mfma_f32_32x32x16_bf16(b0,qr[d0],p0,0,0,0);p1=__builtin_amdgcn_mfma_f32_32x32x16_bf16(b1,qr[d0],p1,0,0,0);}}
}
template<int MODE,int IDX> __device__ __forceinline__ void qk_mf(f32x16&Cx,const bf16x8&k,const bf16x8&q,const f32x16&negm){
  if constexpr(d0_on<MODE>(IDX>>1)){ constexpr bool first=((IDX>>1)==((MODE==2)?2:0));
    if constexpr(first) Cx=__builtin_amdgcn_mfma_f32_32x32x16_bf16(k,q,negm,0,0,0); else Cx=__builtin_amdgcn_mfma_f32_32x32x16_bf16(k,q,Cx,0,0,0); }
}
typedef __attribute__((address_space(3))) const char* lds_cptr;
typedef short v4i16_t __attribute__((ext_vector_type(4)));
template<int MODE> __device__ __forceinline__ void kload8(bf16x8*kf,lds_cptr kp){
  #pragma unroll
  for(int j=0;j<4;++j) if(d0_on<MODE>(j)){ kf[2*j]=*(const __attribute__((address_space(3))) bf16x8*)(kp+j*2048); kf[2*j+1]=*(const __attribute__((address_space(3))) bf16x8*)(kp+j*2048+512); }
}
__device__ __forceinline__ void kload2(bf16x8*kf,lds_cptr kp,int j){ kf[2*j]=*(const __attribute__((address_space(3))) bf16x8*)(kp+j*2048); kf[2*j+1]=*(const __attribute__((address_space(3))) bf16x8*)(kp+j*2048+512); }
__device__ __forceinline__ s16x4 vtr(lds_cptr p){ return __builtin_bit_cast(s16x4,__builtin_amdgcn_ds_read_tr16_b64_v4i16((__attribute__((address_space(3))) v4i16_t*)p)); }
__device__ __forceinline__ float rowmax(const f32x16&p0,const f32x16&p1){
  float a=max3f(p0[0],p0[1],p1[0]),b=max3f(p0[2],p0[3],p1[1]);a=max3f(a,p1[2],p1[3]);
  #pragma unroll
  for(int r=4;r<16;r+=4){a=max3f(a,p0[r],p0[r+1]);b=max3f(b,p0[r+2],p0[r+3]);a=max3f(a,p1[r],p1[r+1]);b=max3f(b,p1[r+2],p1[r+3]);}
  const float m=max2f(a,b);
  auto rr=__builtin_amdgcn_permlane32_swap(__float_as_uint(m),__float_as_uint(m),false,false);
  return max2f(__uint_as_float(rr[0]),__uint_as_float(rr[1]));
}
__device__ __forceinline__ void pv(f32x16*o,int vb,bf16x8 pa0,bf16x8 pa1,bf16x8 pa2,bf16x8 pa3){
  #pragma unroll
  for(int d0=0;d0<2;++d0){s16x4 lo[4],hi[4];
    #pragma unroll
    for(int ks=0;ks<4;++ks){
      asm volatile("ds_read_b64_tr_b16 %0,%1 offset:%c2":"=&v"(lo[ks]):"v"(vb),"i"(d0*4096+ks*1024):"memory");
      asm volatile("ds_read_b64_tr_b16 %0,%1 offset:%c2":"=&v"(hi[ks]):"v"(vb),"i"(d0*4096+ks*1024+512):"memory");}
    asm volatile("s_waitcnt lgkmcnt(0)":::"memory");SBAR();
    #define PK(k) (bf16x8){lo[k][0],lo[k][1],lo[k][2],lo[k][3],hi[k][0],hi[k][1],hi[k][2],hi[k][3]}
    o[d0]=__builtin_amdgcn_mfma_f32_32x32x16_bf16(pa0,PK(0),o[d0],0,0,0);
    o[d0]=__builtin_amdgcn_mfma_f32_32x32x16_bf16(pa1,PK(1),o[d0],0,0,0);
    o[d0]=__builtin_amdgcn_mfma_f32_32x32x16_bf16(pa2,PK(2),o[d0],0,0,0);
    o[d0]=__builtin_amdgcn_mfma_f32_32x32x16_bf16(pa3,PK(3),o[d0],0,0,0);
    #undef PK
  }
}

#ifndef ATTN_STORE16
#define ATTN_STORE16(p,v) (*(u32x4*)(p)=(v))
#endif
template<int THRL,int MODE> __device__ __forceinline__ void attn_unit(const bf16*Qa,const bf16*Qb,const bf16*__restrict__ Kh,const bf16*__restrict__ Vh,bf16*Oa,bf16*Ob,int opitch,int NT,char*shm,float lam,float post,const float*subln){
  int tid_=threadIdx.x; asm volatile("":"+v"(tid_)); const int tid=tid_,lane=tid&63,r32=lane&31,hi=lane>>5; const int wid=__builtin_amdgcn_readfirstlane(tid>>6);
  const bf16*Qw=(wid<4?Qa:Qb)+(long)((wid&3)*QBLK)*DM;
  const unsigned lds0=(unsigned)(uintptr_t)shm;
  float*wsf=(float*)(shm+LDS_WS)+wid*64;
  const bf16*ksrc=Kh+(long)lane*DM+wid*8;
  const bf16*vsrc=Vh+(long)(16*(wid&3)+(lane>>2))*DM+(wid>>2)*32+(lane&3)*8;
  const unsigned kdst=lds0+LDS_K+wid*1024, vdst=lds0+LDS_V+wid*1024;
  #define DMA_K(t,slot) glds16(ksrc+(long)(t)*KVBLK*DM,(unsigned)__builtin_amdgcn_readfirstlane(kdst+(slot)))
  #define DMA_V(t,slot) glds16(vsrc+(long)(t)*KVBLK*DM,(unsigned)__builtin_amdgcn_readfirstlane(vdst+(slot)))
  const int vb0=(int)(lds0+LDS_V)+((lane>>4)&1)*32+(lane&3)*8+(4*hi+((lane&15)>>2))*64;
  const char*Kbase=shm+LDS_K; bf16x8 kf[8];
  const lds_cptr shm3=(lds_cptr)shm; const lds_cptr kp0=shm3+LDS_K+hi*1024+r32*16; const lds_cptr vp0=shm3+LDS_V+((lane>>4)&1)*32+(lane&3)*8+(4*hi+((lane&15)>>2))*64;
  DMA_K(0,0);DMA_V(0,0);DMA_K(1,SLOTB);
  bf16x8 qr[4];
  #pragma unroll
  for(int d0=0;d0<4;++d0)qr[d0]=*reinterpret_cast<const bf16x8*>(&Qw[(long)r32*DM+d0*16+hi*8]);
  float mhat=0.f,l_reg=0.f;f32x16 o[2];o[0]=f32x16{};o[1]=f32x16{};f32x16 negm=f32x16{};asm volatile("":"+v"(negm));
  #define CMASK(P0,P1,t) do{}while(0)
  bool resc=false;
  #define START(P0,P1) do{ const float rm=rowmax(P0,P1); resc=false; \
    { const float dl=rm; mhat=fadd_s(mhat,dl); \
      _Pragma("unroll") for(int r=0;r<16;++r){P0[r]=fsub_s(P0[r],dl);P1[r]=fsub_s(P1[r],dl);} \
      _Pragma("unroll") for(int r=0;r<16;++r)negm[r]=-mhat; asm volatile("":"+v"(negm)); } \
    _Pragma("unroll") for(int r=0;r<16;++r)P0[r]=__builtin_amdgcn_exp2f(P0[r]); }while(0)
  #define RESC() do{ if(resc){ asm volatile("s_waitcnt lgkmcnt(0)":::"memory"); \
      _Pragma("unroll") for(int d_=0;d_<2;++d_) _Pragma("unroll") for(int r=0;r<16;++r)o[d_][r]*=wsf[crow(r,hi)]; } }while(0)
  f32x16 pA0,pA1,pB0,pB1;
  int sl_prev=0,sl_cur=0,sl_next=SLOTB;
  #define ROT() do{sl_prev=sl_cur;sl_cur=sl_next;sl_next=(sl_next==(NSLOT-1)*SLOTB)?0:sl_next+SLOTB;}while(0)
  DMA_K(2,2*SLOTB);
  WAIT_BAR(3);
  qkt<MODE>(pA0,pA1,Kbase,qr,negm,r32,hi);asm volatile("s_nop 15\n\ts_nop 7":"+v"(pA0),"+v"(pA1));CMASK(pA0,pA1,0);
  START(pA0,pA1);
  _Pragma("unroll") for(int r=0;r<16;++r)pA1[r]=__builtin_amdgcn_exp2f(pA1[r]);
  WAIT_BAR(0);
  DMA_K(3,0);DMA_V(1,SLOTB);
  ROT();
  kload8<MODE>(kf,kp0+sl_cur);
  WAIT_BAR(2);
  s16x4 vlo[8],vhi[8]; u32x4 pw0,pw1,pw2,pw3;
  #define PKW(P,B) cvtpk_s(P[B],P[B+1])
  #define PAF(k) __builtin_bit_cast(bf16x8,pw##k)
  #define VFR(i) (bf16x8){vlo[i][0],vlo[i][1],vlo[i][2],vlo[i][3],vhi[i][0],vhi[i][1],vhi[i][2],vhi[i][3]}
  #define PIN(x) asm volatile("":"+v"(x))
  #define MX3(a,b,c) __builtin_fmaxf(__builtin_fmaxf((a),(b)),(c))
  #define GAPA(MF,A0,A1,A2,A3,W0,W1,PW) do{ MF; sacc+=A0; sacc+=A1; sacc+=A2; sacc+=A3; PIN(sacc); W0; W1; PIN(PW); SBAR(); }while(0)
  #define EX(v) __builtin_amdgcn_exp2f(v)
  #define GAPB(MF,X,B) do{ MF; X[B]=EX(X[B]); X[B+1]=EX(X[B+1]); X[B+2]=EX(X[B+2]); X[B+3]=EX(X[B+3]); PIN(X); SBAR(); }while(0)
  #define VRD(i) do{ vlo[i]=vtr(vp_+(((i)>>2)*4096+((i)&3)*1024)); vhi[i]=vtr(vp_+(((i)>>2)*4096+((i)&3)*1024+512)); }while(0)
  #define KRD(G,j) do{ if((G)&&d0_on<MODE>(j)){ kload2(kf,kp0+sl_next,j); SBAR(); } }while(0)
  #define STEP(C0,C1,P0,P1,t,GK,GV,GL) do{ SBAR(); \
    const lds_cptr vp_=vp0+sl_prev; \
    VRD(0); SBAR(); float sacc=(P0[0]+P0[1]); \
    GAPA((qk_mf<MODE,0>(C0,kf[0],qr[0],negm)), P0[2],P0[3],P0[4],P0[5],     pw0[0]=PKW(P0,0), pw0[1]=PKW(P0,2), pw0); \
    VRD(4); SBAR(); GAPA((qk_mf<MODE,1>(C1,kf[1],qr[0],negm)), P0[6],P0[7],P0[8],P0[9],     pw0[2]=PKW(P0,4), pw0[3]=PKW(P0,6), pw0); \
    VRD(1); SBAR(); GAPA((qk_mf<MODE,2>(C0,kf[2],qr[1],negm)),   P0[10],P0[11],P0[12],P0[13], pw1[0]=PKW(P0,8), pw1[1]=PKW(P0,10), pw1); \
    VRD(5); SBAR(); GAPA((qk_mf<MODE,3>(C1,kf[3],qr[1],negm)),   P0[14],P0[15],P1[0],P1[1],   pw1[2]=PKW(P0,12),pw1[3]=PKW(P0,14), pw1); \
    VRD(2); SBAR(); GAPA((qk_mf<MODE,4>(C0,kf[4],qr[2],negm)),   P1[2],P1[3],P1[4],P1[5],     pw2[0]=PKW(P1,0), pw2[1]=PKW(P1,2), pw2); \
    VRD(6); SBAR(); GAPA((qk_mf<MODE,5>(C1,kf[5],qr[2],negm)),   P1[6],P1[7],P1[8],P1[9],     pw2[2]=PKW(P1,4), pw2[3]=PKW(P1,6), pw2); \
    VRD(3); SBAR(); GAPA((qk_mf<MODE,6>(C0,kf[6],qr[3],negm)),   P1[10],P1[11],P1[12],P1[13], pw3[0]=PKW(P1,8), pw3[1]=PKW(P1,10), pw3); \
    VRD(7); SBAR(); GAPA((qk_mf<MODE,7>(C1,kf[7],qr[3],negm)),   P1[14],P1[15],0.f,0.f,       pw3[2]=PKW(P1,12),pw3[3]=PKW(P1,14), pw3); \
    l_reg+=sacc; \
    if(GK){DMA_K((t)+3,sl_cur);} if(GV){DMA_V((t)+1,sl_next);} \
    CMASK(C0,C1,t); \
    { float a=MX3(C0[0],C0[1],C1[0]),b=MX3(C0[2],C0[3],C1[1]); a=MX3(a,C1[2],C1[3]); \
      _Pragma("unroll") for(int r=4;r<16;r+=4){a=MX3(a,C0[r],C0[r+1]);b=MX3(b,C0[r+2],C0[r+3]);a=MX3(a,C1[r],C1[r+1]);b=MX3(b,C1[r+2],C1[r+3]);} \
      float rm=__builtin_fmaxf(a,b); { auto rr=__builtin_amdgcn_permlane32_swap(__float_as_uint(rm),__float_as_uint(rm),false,false); rm=__builtin_fmaxf(__uint_as_float(rr[0]),__uint_as_float(rr[1])); } \
      resc=false; \
      if(__builtin_expect(__any(rm>(float)THRL),0)){ const float dl=__builtin_fmaxf(rm,0.f); mhat+=dl; \
        _Pragma("unroll") for(int r=0;r<16;++r){C0[r]-=dl;C1[r]-=dl;} \
        _Pragma("unroll") for(int r=0;r<16;++r)negm[r]=-mhat; asm volatile("":"+v"(negm)); \
        const float f=__builtin_amdgcn_exp2f(-dl); l_reg*=f; if(hi==0)wsf[r32]=f; resc=true; } } \
    SBAR(); \
    GAPB(o[0]=__builtin_amdgcn_mfma_f32_32x32x16_bf16(PAF(0),VFR(0),o[0],0,0,0), C0,0); \
    GAPB(o[1]=__builtin_amdgcn_mfma_f32_32x32x16_bf16(PAF(0),VFR(4),o[1],0,0,0), C0,4); \
    KRD(GL,0); GAPB(o[0]=__builtin_amdgcn_mfma_f32_32x32x16_bf16(PAF(1),VFR(1),o[0],0,0,0), C0,8); \
    KRD(GL,1); GAPB(o[1]=__builtin_amdgcn_mfma_f32_32x32x16_bf16(PAF(1),VFR(5),o[1],0,0,0), C0,12); \
    KRD(GL,2); GAPB(o[0]=__builtin_amdgcn_mfma_f32_32x32x16_bf16(PAF(2),VFR(2),o[0],0,0,0), C1,0); \
    KRD(GL,3); GAPB(o[1]=__builtin_amdgcn_mfma_f32_32x32x16_bf16(PAF(2),VFR(6),o[1],0,0,0), C1,4); \
    GAPB(o[0]=__builtin_amdgcn_mfma_f32_32x32x16_bf16(PAF(3),VFR(3),o[0],0,0,0), C1,8); \
    GAPB(o[1]=__builtin_amdgcn_mfma_f32_32x32x16_bf16(PAF(3),VFR(7),o[1],0,0,0), C1,12); \
    }while(0)
  int t=1;
  for(;t+5<NT;t+=2){
    STEP(pB0,pB1,pA0,pA1,t,true,true,true);     WAIT_BAR(2); RESC(); ROT();
    STEP(pA0,pA1,pB0,pB1,t+1,true,true,true);   WAIT_BAR(2); RESC(); ROT();
  }
  #define ENDW(tt) do{ if((tt)+3<NT){WAIT_BAR(2);} else if((tt)+2<NT){WAIT_BAR(1);} else {WAIT_BAR(0);} }while(0)
  for(;t+1<NT;t+=2){
    STEP(pB0,pB1,pA0,pA1,t,(t+3<NT),(t+1<NT),(t+1<NT));       ENDW(t);   RESC(); ROT();
    STEP(pA0,pA1,pB0,pB1,t+1,(t+4<NT),(t+2<NT),(t+2<NT));     ENDW(t+1); RESC(); ROT();
  }
  STEP(pB0,pB1,pA0,pA1,NT-1,false,false,false); RESC();
  { float sacc=pB0[0]+pB0[1]; _Pragma("unroll") for(int r=2;r<16;++r)sacc+=pB0[r]; _Pragma("unroll") for(int r=0;r<16;++r)sacc+=pB1[r]; l_reg+=sacc;
    pw0=(u32x4){PKW(pB0,0),PKW(pB0,2),PKW(pB0,4),PKW(pB0,6)};pw1=(u32x4){PKW(pB0,8),PKW(pB0,10),PKW(pB0,12),PKW(pB0,14)};pw2=(u32x4){PKW(pB1,0),PKW(pB1,2),PKW(pB1,4),PKW(pB1,6)};pw3=(u32x4){PKW(pB1,8),PKW(pB1,10),PKW(pB1,12),PKW(pB1,14)};
    SBAR(); pv(o,vb0+sl_cur,PAF(0),PAF(1),PAF(2),PAF(3)); }
  #undef PKW
  #undef PAF
  #undef VFR
  #undef PIN
  #undef MX3
  #undef GAPA
  #undef GAPB
  #undef EX
  #undef VRD
  #undef KRD
  #undef STEP
  #undef ENDW
  {auto rr=__builtin_amdgcn_permlane32_swap(__float_as_uint(l_reg),__float_as_uint(l_reg),false,false);l_reg=__uint_as_float(rr[0])+__uint_as_float(rr[1]);}
  if(hi==0)wsf[32+r32]=l_reg;asm volatile("s_waitcnt lgkmcnt(0)":::"memory");
  float rli[16];
  #pragma unroll
  for(int r=0;r<16;++r)rli[r]=__builtin_amdgcn_rcpf(wsf[32+crow(r,hi)]);
  bf16*Ow=(wid<4?Oa:Ob)+(long)((wid&3)*QBLK)*opitch;
  { bf16*stg=(bf16*)(shm+LDS_OST)+wid*2048;
    #pragma unroll
    for(int r=0;r<16;++r){const int orow=crow(r,hi);
      #pragma unroll
      for(int d0=0;d0<2;++d0)stg[orow*64+d0*32+r32]=(bf16)f2bf(o[d0][r]*rli[r]);}
    asm volatile("s_waitcnt lgkmcnt(0)":::"memory");
    if constexpr(MODE==0){
      #pragma unroll
      for(int i=0;i<4;++i){const int row=i*8+(lane>>3),ch=lane&7; const u32x4 v=*(const u32x4*)(stg+row*64+ch*8); ATTN_STORE16(Ow+(long)row*opitch+ch*8,v);}
    } else {
      asm volatile("s_barrier":::"memory");
      if constexpr(MODE==1){ const bf16*stg2=stg+4*2048; const int ch=lane&7; float sb[8];
        #pragma unroll
        for(int e=0;e<8;++e)sb[e]=subln[ch*8+e]*post;
        #pragma unroll
        for(int i=0;i<4;++i){const int row=i*8+(lane>>3); const u32x4 v1=*(const u32x4*)(stg+row*64+ch*8),v2=*(const u32x4*)(stg2+row*64+ch*8);
          float od[8]; float ss=0.f;
          #pragma unroll
          for(int e=0;e<4;++e){ od[2*e]=bflo(v1[e])-lam*bflo(v2[e]); od[2*e+1]=bfhi(v1[e])-lam*bfhi(v2[e]); ss+=od[2*e]*od[2*e]+od[2*e+1]*od[2*e+1]; }
          ss+=__shfl_xor(ss,1); ss+=__shfl_xor(ss,2); ss+=__shfl_xor(ss,4);
          const float rn=__builtin_amdgcn_rsqf(ss*(1.f/64.f)+1e-6f);
          u32x4 w; w[0]=pk2(od[0]*rn*sb[0],od[1]*rn*sb[1]); w[1]=pk2(od[2]*rn*sb[2],od[3]*rn*sb[3]); w[2]=pk2(od[4]*rn*sb[4],od[5]*rn*sb[5]); w[3]=pk2(od[6]*rn*sb[6],od[7]*rn*sb[7]);
          ATTN_STORE16(Ow+(long)row*opitch+ch*8,w);} }
    } }
  asm volatile("s_waitcnt lgkmcnt(0)\n\ts_barrier":::"memory");
  #undef DMA_K
  #undef DMA_V
  #undef CMASK
  #undef START
  #undef RESC
  #undef ROT
}
constexpr int ATTN_LDS_BYTES=LDS_BYTES;
#undef SBAR
#undef WAIT_BAR
}
#else
EMU_ATTN_BODY
#endif
#ifndef EMU
#define XB_TMO      128
#define XB_XCNT(j)  (256  + 64 * (j))
#define XB_XSUB(j)  (1280 + 64 * (j))
#define XB_XGEN(j)  (2304 + 64 * (j))
#define XB_TOP      3328
#define XB_TOPGEN   3392
#define XCD_BAR_WORDS 3456
#define XB_SPIN_CAP (1u << 18)

__device__ __forceinline__ unsigned xb_ld(unsigned* p)              { return __hip_atomic_load(p, __ATOMIC_RELAXED, __HIP_MEMORY_SCOPE_AGENT); }
__device__ __forceinline__ unsigned xb_add(unsigned* p, unsigned v) { return __hip_atomic_fetch_add(p, v, __ATOMIC_RELAXED, __HIP_MEMORY_SCOPE_AGENT); }
__device__ __forceinline__ unsigned xb_xcc_id() { return (unsigned)__builtin_amdgcn_s_getreg((3 << 11) | 20) & 0xFu; }
#define XB_SPIN(cond, bar) do { unsigned _sp = 0; while (cond) { __builtin_amdgcn_s_sleep(1); \
    if ((++_sp & 255u) == 0u) { if (xb_ld(&(bar)[XB_TMO])) break; if (_sp > XB_SPIN_CAP) { atomicAdd(&(bar)[XB_TMO], 1u); break; } } } } while (0)

struct XcdBarrier {
    unsigned* bar; unsigned x;
    volatile LAS unsigned* st;
};

__device__ __forceinline__ XcdBarrier xcd_barrier_post(unsigned* bar, volatile LAS unsigned* st) {
    XcdBarrier b; b.bar = bar; b.x = xb_xcc_id(); b.st = st;
    if (threadIdx.x == 0) (void)xb_add(&bar[XB_XCNT(b.x)], 1u);
    return b;
}
__device__ __forceinline__ void xcd_barrier_complete(unsigned* bar, unsigned x, unsigned& nloc, unsigned& nx) {
    const unsigned G = gridDim.x * gridDim.y * gridDim.z;
    unsigned sum, cnt, mine, sp = 0u;
    for (;;) {
        sum = 0u; cnt = 0u; mine = 0u;
#pragma unroll
        for (unsigned j = 0; j < 16; ++j) { const unsigned c = xb_ld(&bar[XB_XCNT(j)]); sum += c; cnt += (c > 0u) ? 1u : 0u; mine = (j == x) ? c : mine; }
        if (sum == G) break;
        __builtin_amdgcn_s_sleep(1);
        if ((++sp & 255u) == 0u) { if (xb_ld(&bar[XB_TMO])) break; if (sp > XB_SPIN_CAP) { atomicAdd(&bar[XB_TMO], 1u); break; } }
    }
    nloc = mine > 0u ? mine : 1u; nx = cnt > 0u ? cnt : 1u;
}

__device__ __forceinline__ void xcd_barrier(const XcdBarrier& b) {
    asm volatile("s_waitcnt vmcnt(0)" ::: "memory");
    __syncthreads();
    if (threadIdx.x == 0) {
        unsigned* bar = b.bar;
        __builtin_amdgcn_s_waitcnt(0);
        unsigned nloc = b.st[0], nx = b.st[1];
        if (nloc == 0u) { xcd_barrier_complete(bar, b.x, nloc, nx); b.st[0] = nloc; b.st[1] = nx; }
        const unsigned old = xb_add(&bar[XB_XSUB(b.x)], 1u);
        const unsigned gen = old / nloc;
        if (old + 1u == (gen + 1u) * nloc) {
            __builtin_amdgcn_fence(__ATOMIC_RELEASE, "agent");
            asm volatile("s_waitcnt vmcnt(0)" ::: "memory");
            const unsigned og = xb_add(&bar[XB_TOP], 1u);
            const unsigned tg = og / nx;
            if (og + 1u == (tg + 1u) * nx) xb_add(&bar[XB_TOPGEN], 1u);
            else XB_SPIN(xb_ld(&bar[XB_TOPGEN]) == tg, bar);
            __builtin_amdgcn_fence(__ATOMIC_ACQUIRE, "agent");
            xb_add(&bar[XB_XGEN(b.x)], 1u);
            asm volatile("s_waitcnt vmcnt(0)" ::: "memory");
        } else {
            XB_SPIN(xb_ld(&bar[XB_XGEN(b.x)]) == gen, bar);
            __builtin_amdgcn_fence(__ATOMIC_ACQUIRE, "agent");
            asm volatile("s_waitcnt vmcnt(0)" ::: "memory");
        }
    }
    __syncthreads();
}
#endif

constexpr int LDS_BYTES = 147456;
constexpr int MISC_OFF = 139264;
constexpr int PTR_OFF = MISC_OFF + 256;
struct Ctx {
    LAS unsigned char* lds;
    int tid, lane, wave, bid, G;
    float* out; unsigned long long wsi;
};
DEVI const float* inp_ptr(const Ctx& C, int i) {
    const unsigned long long v = ((const LAS unsigned long long*)(C.lds + PTR_OFF))[i];
    const unsigned lo = __builtin_amdgcn_readfirstlane((unsigned)v), hi = __builtin_amdgcn_readfirstlane((unsigned)(v >> 32));
    return (const float*)(const GAS float*)(((unsigned long long)hi << 32) | lo);
}
#define INP(i) inp_ptr(C, i)
#define WSP(T, off) ((T*)(GAS T*)(C.wsi + (unsigned long long)(off)))
DEVI int mod_row(int r) { return r < T_L ? r / SEQ : 8; }
DEVI const float* mod_vec(const Ctx& C, int layer, int mrow, int which) { return WSP(const float, WS_MOD) + ((size_t)(layer * 9 + mrow) * 6 + which) * D; }

DEVI void transpose_item(const float* W, int ldw, int k0, int n0, bf16* WT, int orow0, int Kp, LAS float* scr, int lane) {
    { const int kr = lane >> 3, c4 = (lane & 7) * 4; f32x4 v[8];
#pragma unroll
      for (int i = 0; i < 8; ++i) v[i] = *(const f32x4*)(W + (size_t)(k0 + 8 * i + kr) * ldw + n0 + c4);
#pragma unroll
      for (int i = 0; i < 8; ++i) { LAS float* d = scr + (8 * i + kr) * 33 + c4; d[0] = v[i].x; d[1] = v[i].y; d[2] = v[i].z; d[3] = v[i].w; } }
    LDS_WAIT();
    const int c = lane & 7;
#pragma unroll
    for (int j = 0; j < 4; ++j) { const int n = (lane >> 3) + 8 * j; const LAS float* s = scr + (8 * c) * 33 + n;
        v4u o; o.x = pk2(s[0 * 33], s[1 * 33]); o.y = pk2(s[2 * 33], s[3 * 33]); o.z = pk2(s[4 * 33], s[5 * 33]); o.w = pk2(s[6 * 33], s[7 * 33]);
        *(v4u*)(WT + (size_t)(orow0 + n) * Kp + k0 + 8 * c) = o; }
    LDS_WAIT();
}
DEVI void convert_layer_weights(const Ctx& C, int layer, int part) {
    LAS float* scr = (LAS float*)(C.lds + C.wave * 16384);
    const int gw = C.bid * 8 + C.wave, NGW = C.G * 8;
    constexpr int I_IN = 16 * (N_PROJ / 32), I_OUT = 16 * (D / 32), I_UP = NE * 16 * (2 * DE / 32), I_DN = NE * 16 * (D / 32), I_LAYER = I_IN + I_OUT + I_UP + I_DN;
    const int it_lo = (part == 1) ? I_IN + I_OUT : 0, it_hi = (part == 0) ? I_IN + I_OUT : I_LAYER;
    for (int it = it_lo + gw; it < it_hi; it += NGW) {
        int r = it;
        if (r < I_IN) { const int kb = r / (N_PROJ / 32), nb = r % (N_PROJ / 32);
            transpose_item(INP(8) + (size_t)layer * D * D_IN, D_IN, 64 * kb, 32 * nb, WSP(bf16, WS_WIN) + (size_t)layer * N_PROJ * D, 32 * nb, D, scr, C.lane); continue; }
        r -= I_IN;
        if (r < I_OUT) { const int kb = r / (D / 32), nb = r % (D / 32);
            transpose_item(INP(9) + (size_t)layer * D * D, D, 64 * kb, 32 * nb, WSP(bf16, WS_WOUT) + (size_t)layer * D * D, 32 * nb, D, scr, C.lane); continue; }
        r -= I_OUT;
        if (r < I_UP) { const int e = r / (16 * 64), q = r % (16 * 64), kb = q / 64, nb = q % 64; const int n0 = 32 * nb;
            const int orow = (n0 < DE) ? (n0 / 128) * 256 + (n0 % 128) : ((n0 - DE) / 128) * 256 + 128 + ((n0 - DE) % 128);
            transpose_item(INP(26) + ((size_t)layer * NE + e) * D * 2 * DE, 2 * DE, 64 * kb, n0, WSP(bf16, WS_WUP) + ((size_t)layer * NE + e) * 2 * DE * D, orow, D, scr, C.lane); continue; }
        r -= I_UP;
        { const int e = r / (16 * 32), q = r % (16 * 32), kb = q / 32, nb = q % 32;
            transpose_item(INP(28) + ((size_t)layer * NE + e) * DE * D, D, 64 * kb, 32 * nb, WSP(bf16, WS_WDN) + ((size_t)layer * NE + e) * D * DE, 32 * nb, DE, scr, C.lane); }
    }
}
DEVI void p0_prologue(const Ctx& C) {
    convert_layer_weights(C, 0, 0);
    {
      float* tab = WSP(float, WS_ROPE);
      for (int i = C.bid * 512 + C.tid; i < SEQ * 48; i += C.G * 512) { const int t = i / 48, j = i % 48; const float rp = (float)(t / GRID_W), cp = (float)(t % GRID_W); float c, s;
          if (j < 32) { const float ang = (j < 16 ? rp : cp) * __builtin_amdgcn_exp2f(-(float)(j & 15) * (13.287712379549449f / 16.f)); const float tt = __builtin_amdgcn_fractf(ang * 0.15915494309189535f); c = __builtin_amdgcn_cosf(tt); s = __builtin_amdgcn_sinf(tt);
              tab[(size_t)t * 32 + j] = c; tab[(size_t)SEQ * 32 + (size_t)t * 32 + j] = s; }
          else { const int i2 = j - 32; const float ang = (i2 < 8 ? rp : cp) * __builtin_amdgcn_exp2f(-(float)(i2 & 7) * (13.287712379549449f / 8.f)); const float tt = __builtin_amdgcn_fractf(ang * 0.15915494309189535f); c = __builtin_amdgcn_cosf(tt); s = __builtin_amdgcn_sinf(tt);
              tab[(size_t)SEQ * 64 + (size_t)t * 16 + i2] = c; tab[(size_t)SEQ * 80 + (size_t)t * 16 + i2] = s; } } }
    __syncthreads();
    LAS float* sc = (LAS float*)C.lds;
    LAS float* red = sc + 9 * D;
    for (int i = C.tid; i < 9 * D; i += 512) { const int r = i / D, k = i % D; float v = 0.f; if (r < NB) v = INP(1)[r * D + k]; else if (r == 8) v = INP(3)[k]; sc[i] = siluf_(v); }
    __syncthreads();
    for (int u = C.bid; u < DEPTH * 96; u += C.G) {
        const int layer = u / 96, n0 = (u % 96) * 64, col = C.tid & 63, kg = C.tid >> 6;
        const float* w = INP(4) + (size_t)layer * D * 6 * D + n0 + col;
        float acc[9];
#pragma unroll
        for (int r = 0; r < 9; ++r) acc[r] = 0.f;
#pragma unroll 8
        for (int k = kg * 128; k < kg * 128 + 128; ++k) { const float wv = w[(size_t)k * 6 * D];
#pragma unroll
            for (int r = 0; r < 9; ++r) acc[r] += sc[r * D + k] * wv; }
#pragma unroll
        for (int r = 0; r < 9; ++r) red[(kg * 9 + r) * 64 + col] = acc[r];
        __syncthreads();
        for (int i = C.tid; i < 9 * 64; i += 512) { const int r = i >> 6, c2 = i & 63; float s = 0.f;
#pragma unroll
            for (int g = 0; g < 8; ++g) s += red[(g * 9 + r) * 64 + c2];
            WSP(float, WS_MOD)[((size_t)(layer * 9 + r)) * 6 * D + n0 + c2] = s + INP(5)[(size_t)layer * 6 * D + n0 + c2]; }
        __syncthreads();
    }
}

DEVI void ph_norm_mix(const Ctx& C, int layer) {
    const bool fin = (layer == DEPTH);
    const int nrows = fin ? T_L : T_ALL;
    if (layer == 0) {
        for (int it = C.bid * 8 + C.wave; it < DEPTH * 9 * NE; it += C.G * 8) {
            const int e = it % NE, m = (it / NE) % 9, l = it / (NE * 9);
            const float* gn = INP(7) + (size_t)l * D; const float* sh = mod_vec(C, l, m, 3); const float* scl = mod_vec(C, l, m, 4); const float* rw = INP(24) + (size_t)l * D * NE + e;
            float* dst = WSP(float, WS_RWP) + (size_t)it * D; float bsum = 0.f;
#pragma unroll 4
            for (int j = 0; j < 16; ++j) { const int k = 64 * j + C.lane; const float w = rw[(size_t)k * NE]; dst[k] = gn[k] * (1.f + scl[k]) * w; bsum += sh[k] * w; }
            bsum = wave_sum(bsum); if (C.lane == 0) WSP(float, WS_RBP)[it] = bsum + INP(25)[l * NE + e];
        }
    }
    LAS float* w16 = (LAS float*)C.lds;
    if (!fin) { for (int i = C.tid; i < 16 * D; i += 512) { const int k = i >> 4, j = i & 15; w16[j * D + k] = INP(8)[((size_t)layer * D + k) * D_IN + N_PROJ + j]; } }
    __syncthreads();
    const float* gmain = fin ? INP(30) : INP(6) + (size_t)layer * D;
    const int rstep = C.G * 8;
    int s4[2][4]; float g4[2][4];
#define NM_SLOTS(dst_s, dst_g, rbase) do { _Pragma("unroll") for (int u2 = 0; u2 < 2; ++u2) { const int rr_ = (rbase) + u2 * rstep; const int rc_ = rr_ < nrows ? rr_ : 0; \
        const int* sl_ = WSP(const int, WS_SLOT) + (size_t)rc_ * 4; const float* gl_ = WSP(const float, WS_TOKG) + (size_t)rc_ * 4; \
        _Pragma("unroll") for (int k = 0; k < 4; ++k) { dst_s[u2][k] = sl_[k]; dst_g[u2][k] = gl_[k]; } } } while (0)
    if (layer != 0) NM_SLOTS(s4, g4, C.bid * 8 + C.wave);
#define NMC(j) ((((j) & 2) ? 512 : 0) + 8 * C.lane + 4 * ((j) & 1))
    for (int ra = C.bid * 8 + C.wave; ra < nrows; ra += 2 * rstep) {
        f32x4 v[2][4]; int mrow[2]; bool live[2];
        int s4n[2][4]; float g4n[2][4];
        if (layer != 0) NM_SLOTS(s4n, g4n, ra + 2 * rstep);
#pragma unroll
        for (int u2 = 0; u2 < 2; ++u2) { const int r = ra + u2 * rstep; live[u2] = r < nrows; const int rc = live[u2] ? r : 0; mrow[u2] = mod_row(rc);
            if (layer == 0) { const float* xr = (rc < T_L) ? INP(0) + (size_t)rc * D : INP(2) + (size_t)(rc - T_L) * D;
#pragma unroll
                for (int j = 0; j < 4; ++j) v[u2][j] = *(const f32x4*)(xr + NMC(j));
            } else {
                const bf16* xr = WSP(const bf16, WS_XRES) + (size_t)rc * D; const float* g2 = mod_vec(C, layer - 1, mrow[u2], 5);
                f32x4 xv[4]; { const v4u xa = *(const v4u*)(xr + 8 * C.lane), xb = *(const v4u*)(xr + 512 + 8 * C.lane);
                    xv[0] = (f32x4){bflo(xa.x), bfhi(xa.x), bflo(xa.y), bfhi(xa.y)}; xv[1] = (f32x4){bflo(xa.z), bfhi(xa.z), bflo(xa.w), bfhi(xa.w)};
                    xv[2] = (f32x4){bflo(xb.x), bfhi(xb.x), bflo(xb.y), bfhi(xb.y)}; xv[3] = (f32x4){bflo(xb.z), bfhi(xb.z), bflo(xb.w), bfhi(xb.w)}; }
                f32x4 a[4];
#pragma unroll
                for (int j = 0; j < 4; ++j) a[j] = (f32x4){0.f, 0.f, 0.f, 0.f};
#pragma unroll
                for (int k = 0; k < 4; ++k) { const unsigned char* yr = WSP(const unsigned char, WS_YS) + (size_t)s4[u2][k] * D; const v2u ya = *(const v2u*)(yr + 8 * C.lane), yb = *(const v2u*)(yr + 512 + 8 * C.lane); const float gk = g4[u2][k];
                    const f32x2 p0 = __builtin_amdgcn_cvt_pk_f32_fp8((int)ya.x, false), p1 = __builtin_amdgcn_cvt_pk_f32_fp8((int)ya.x, true), p2 = __builtin_amdgcn_cvt_pk_f32_fp8((int)ya.y, false), p3 = __builtin_amdgcn_cvt_pk_f32_fp8((int)ya.y, true);
                    const f32x2 q0 = __builtin_amdgcn_cvt_pk_f32_fp8((int)yb.x, false), q1 = __builtin_amdgcn_cvt_pk_f32_fp8((int)yb.x, true), q2 = __builtin_amdgcn_cvt_pk_f32_fp8((int)yb.y, false), q3 = __builtin_amdgcn_cvt_pk_f32_fp8((int)yb.y, true);
                    a[0] += (f32x4){p0.x, p0.y, p1.x, p1.y} * gk; a[1] += (f32x4){p2.x, p2.y, p3.x, p3.y} * gk;
                    a[2] += (f32x4){q0.x, q0.y, q1.x, q1.y} * gk; a[3] += (f32x4){q2.x, q2.y, q3.x, q3.y} * gk; }
#pragma unroll
                for (int j = 0; j < 4; ++j) v[u2][j] = xv[j] + *(const f32x4*)(g2 + NMC(j)) * a[j];
            } }
        float rinv[2];
#pragma unroll
        for (int u2 = 0; u2 < 2; ++u2) { float ss = 0.f;
#pragma unroll
            for (int j = 0; j < 4; ++j) ss += (v[u2][j].x * v[u2][j].x + v[u2][j].y * v[u2][j].y) + (v[u2][j].z * v[u2][j].z + v[u2][j].w * v[u2][j].w);
            rinv[u2] = __builtin_amdgcn_rsqf(wave_sum(ss) * (1.f / D) + NORM_EPS); }
#pragma unroll
        for (int u2 = 0; u2 < 2; ++u2) { const int r = ra + u2 * rstep; if (!live[u2]) continue;
            if (fin) {
#pragma unroll
                for (int j = 0; j < 4; ++j) *(f32x4*)(C.out + (size_t)r * D + NMC(j)) = v[u2][j] * rinv[u2] * *(const f32x4*)(gmain + NMC(j));
                continue; }
            if (layer != 0) { bf16* xw = WSP(bf16, WS_XRES) + (size_t)r * D;
                *(v4u*)(xw + 8 * C.lane) = (v4u){pk2(v[u2][0].x, v[u2][0].y), pk2(v[u2][0].z, v[u2][0].w), pk2(v[u2][1].x, v[u2][1].y), pk2(v[u2][1].z, v[u2][1].w)};
                *(v4u*)(xw + 512 + 8 * C.lane) = (v4u){pk2(v[u2][2].x, v[u2][2].y), pk2(v[u2][2].z, v[u2][2].w), pk2(v[u2][3].x, v[u2][3].y), pk2(v[u2][3].z, v[u2][3].w)}; }
            const float* sh = mod_vec(C, layer, mrow[u2], 0); const float* scl = mod_vec(C, layer, mrow[u2], 1);
            f32x4 hv4[4]; float mine = 0.f;
#pragma unroll
            for (int j = 0; j < 4; ++j) hv4[j] = v[u2][j] * rinv[u2] * *(const f32x4*)(gmain + NMC(j)) * (*(const f32x4*)(scl + NMC(j)) + 1.0f) + *(const f32x4*)(sh + NMC(j));
            { bf16* hr = WSP(bf16, WS_H) + (size_t)r * D;
              *(v4u*)(hr + 8 * C.lane) = (v4u){pk2(hv4[0].x, hv4[0].y), pk2(hv4[0].z, hv4[0].w), pk2(hv4[1].x, hv4[1].y), pk2(hv4[1].z, hv4[1].w)};
              *(v4u*)(hr + 512 + 8 * C.lane) = (v4u){pk2(hv4[2].x, hv4[2].y), pk2(hv4[2].z, hv4[2].w), pk2(hv4[3].x, hv4[3].y), pk2(hv4[3].z, hv4[3].w)}; }
#pragma unroll 2
            for (int i = 0; i < 16; ++i) { float pp = 0.f;
#pragma unroll
                for (int j = 0; j < 4; ++j) { const f32x4 w = *(const LAS f32x4*)(w16 + i * D + NMC(j)); pp += (hv4[j].x * w.x + hv4[j].y * w.y) + (hv4[j].z * w.z + hv4[j].w * w.w); }
                pp = wave_sum(pp); if (C.lane == i) mine = pp; }
            if (C.lane < 16) WSP(float, WS_BA)[(size_t)r * 16 + C.lane] = mine; }
        if (layer != 0) {
#pragma unroll
            for (int u2 = 0; u2 < 2; ++u2)
#pragma unroll
                for (int k = 0; k < 4; ++k) { s4[u2][k] = s4n[u2][k]; g4[u2][k] = g4n[u2][k]; } }
    }
#undef NMC
#undef NM_SLOTS
}

DEVI void u8f(const v4u& w, float (&x)[8]) { x[0] = bflo(w.x); x[1] = bfhi(w.x); x[2] = bflo(w.y); x[3] = bfhi(w.y); x[4] = bflo(w.z); x[5] = bfhi(w.z); x[6] = bflo(w.w); x[7] = bfhi(w.w); }
DEVI v4u f8u(const float (&x)[8]) { return (v4u){pk2(x[0], x[1]), pk2(x[2], x[3]), pk2(x[4], x[5]), pk2(x[6], x[7])}; }
DEVI void ph_attn_prep(const Ctx& C, int layer) {
    const bf16* proj = WSP(const bf16, WS_PROJ);
    bf16* QL = WSP(bf16, WS_QL); bf16* QC = WSP(bf16, WS_QC); bf16* KB = WSP(bf16, WS_K); bf16* VB = WSP(bf16, WS_V);
    const float* tab = WSP(const float, WS_ROPE);
    const int lane = C.lane, l7 = lane & 7, d0 = 8 * l7;
    constexpr float C2A = 0.125f * 1.4426950408889634f, C2D = 0.17677669529663687f * 1.4426950408889634f;
    float gA[8];
    { const float* gn = (lane < 32 ? INP(10) : INP(11)) + layer * 64 + d0;
#pragma unroll
      for (int e = 0; e < 8; ++e) gA[e] = gn[e]; }
    const bool lowA = d0 < 32; const int jA = d0 & 31;
    const int i0 = 8 * (lane & 3); const bool lowD = i0 < 16; const int iD = i0 & 15, mp = l7 >> 2;
    constexpr int RU = 2; const int rstep = C.G * 8;
    for (int rbase = C.bid * 8 + C.wave; rbase < T_ALL; rbase += RU * rstep) {
        v4u pa[RU], pc1[RU], pc2[RU]; f32x4 ca[RU][2], sa[RU][2], cd[RU][2], sd[RU][2];
#pragma unroll
        for (int u2 = 0; u2 < RU; ++u2) { const int rr = rbase + u2 * rstep; const int r = rr < T_ALL ? rr : rbase; const bf16* pr = proj + (size_t)r * N_PROJ;
            pa[u2] = *(const v4u*)(pr + 8 * lane); pc1[u2] = *(const v4u*)(pr + C_CQ + 8 * lane); pc2[u2] = *(const v4u*)(pr + C_CV + 8 * (lane & 31));
            const int t = r < T_L ? r % SEQ : 0;
            ca[u2][0] = *(const f32x4*)(tab + (size_t)t * 32 + jA); ca[u2][1] = *(const f32x4*)(tab + (size_t)t * 32 + jA + 4);
            sa[u2][0] = *(const f32x4*)(tab + (size_t)SEQ * 32 + (size_t)t * 32 + jA); sa[u2][1] = *(const f32x4*)(tab + (size_t)SEQ * 32 + (size_t)t * 32 + jA + 4);
            cd[u2][0] = *(const f32x4*)(tab + (size_t)SEQ * 64 + (size_t)t * 16 + iD); cd[u2][1] = *(const f32x4*)(tab + (size_t)SEQ * 64 + (size_t)t * 16 + iD + 4);
            sd[u2][0] = *(const f32x4*)(tab + (size_t)SEQ * 80 + (size_t)t * 16 + iD); sd[u2][1] = *(const f32x4*)(tab + (size_t)SEQ * 80 + (size_t)t * 16 + iD + 4); }
#pragma unroll
        for (int u2 = 0; u2 < RU; ++u2) { const int r = rbase + u2 * rstep; if (r >= T_ALL) continue;
            const bool lat = r < T_L; const int b = lat ? r / SEQ : (r - T_L) / LC; const int t = lat ? r % SEQ : (r - T_L) % LC; const int pos = lat ? t : SEQ + t;
            { float x[8]; u8f(pa[u2], x);
              if (lane < 48) { float ss = 0.f;
#pragma unroll
                  for (int e = 0; e < 8; ++e) ss += x[e] * x[e];
                  const float rinv = __builtin_amdgcn_rsqf(group_sum<8>(ss) * (1.f / 64.f) + NORM_EPS);
#pragma unroll
                  for (int e = 0; e < 8; ++e) x[e] *= rinv * gA[e]; }
              float o[8];
#pragma unroll
              for (int e = 0; e < 8; ++e) { const float pe = __shfl_xor(x[e], 4); const float c = lat ? ca[u2][e >> 2][e & 3] : 1.f, s = lat ? sa[u2][e >> 2][e & 3] : 0.f;
                  o[e] = lowA ? x[e] * c - pe * s : pe * s + x[e] * c; }
              if (lane < 32) { const int hq = lane >> 3;
#pragma unroll
                  for (int e = 0; e < 8; ++e) o[e] *= C2A;
                  bf16* q = lat ? QL + ((size_t)(b * 12 + hq) * SEQ + t) * 64 : QC + ((size_t)(b * 12 + hq) * LC + t) * 64; *(v4u*)(q + d0) = f8u(o); }
              else if (lane < 48) { const int kvh = (lane - 32) >> 3; *(v4u*)(KB + ((size_t)(b * 6 + kvh) * NKEY + pos) * 64 + d0) = f8u(o); }
              else { const int kvh = (lane - 48) >> 3; *(v4u*)(VB + ((size_t)(b * 6 + kvh) * NKEY + pos) * 64 + d0) = pa[u2]; } }
            { float x[8]; u8f(pc1[u2], x); float o[8];
#pragma unroll
              for (int e = 0; e < 8; ++e) { const float pe = __shfl_xor(x[e], 2); const float c = lat ? cd[u2][e >> 2][e & 3] : 1.f, s = lat ? sd[u2][e >> 2][e & 3] : 0.f;
                  o[e] = lowD ? x[e] * c - pe * s : pe * s + x[e] * c; }
              const int hc = (lane & 31) >> 3;
              if (lane < 32) { const int vh = 4 + 2 * hc + mp;
#pragma unroll
                  for (int e = 0; e < 8; ++e) o[e] *= C2D;
                  bf16* q = lat ? QL + ((size_t)(b * 12 + vh) * SEQ + t) * 64 : QC + ((size_t)(b * 12 + vh) * LC + t) * 64;
                  *(v4u*)(q + mp * 32 + i0) = f8u(o); *(v4u*)(q + (1 - mp) * 32 + i0) = (v4u){0u, 0u, 0u, 0u}; }
              else { *(v4u*)(KB + ((size_t)(b * 6 + 2 + hc) * NKEY + pos) * 64 + d0) = f8u(o); } }
            if (lane < 32) { const int hv = lane >> 3; *(v4u*)(VB + ((size_t)(b * 6 + 2 + hv) * NKEY + pos) * 64 + d0) = pc2[u2]; }
        }
    }
}

DEVI void ph_gmlp(const Ctx& C, int layer, int ntok) {
    constexpr int VP = 136, SP = 68;
    LAS bf16* vnT = (LAS bf16*)C.lds;
    LAS float* rinv = (LAS float*)(vnT + 64 * VP);
    LAS float* spT = rinv + 128;
    const bf16* proj = WSP(const bf16, WS_PROJ); bf16* mix = WSP(bf16, WS_MIX);
    const float* gvn = INP(12) + layer * 256;
    const int tid0 = C.tid;
    constexpr int NSCAN = NB * 16; const int total = (ntok / 128) * 4; const bool split = C.G > NSCAN && total > 2 * NSCAN;
    const int ufirst = !split ? C.bid : (C.bid < NSCAN ? C.bid : 2 * NSCAN + (C.bid - NSCAN)), ustride = !split ? C.G : (C.bid < NSCAN ? NSCAN : C.G - NSCAN), uend = (split && C.bid < NSCAN) ? 2 * NSCAN : total;
    for (int u = ufirst; u < uend; u += ustride) {
        int tid = tid0; LAUNDER_V(tid);
        const int chunk = u >> 2, g = u & 3; const int row0 = chunk * 128;
        const int lane = tid & 63, wv = __builtin_amdgcn_readfirstlane(tid >> 6), l15 = lane & 15, q = lane >> 4;
        bf16x8 afr[4];
        { const float* wsr = INP(13) + ((size_t)layer * 4 + g) * 128 * 128 + (size_t)(16 * wv + l15) * 128 + 8 * q;
#pragma unroll
          for (int kk = 0; kk < 4; ++kk) { const f32x4 a0 = *(const f32x4*)(wsr + 32 * kk), a1 = *(const f32x4*)(wsr + 32 * kk + 4);
              const v4u ap = {pk2(a0.x, a0.y), pk2(a0.z, a0.w), pk2(a1.x, a1.y), pk2(a1.z, a1.w)}; afr[kk] = __builtin_bit_cast(bf16x8, ap); } }
        { const int tok = tid >> 2, qd = tid & 3; const bf16* p = proj + (size_t)(row0 + tok) * N_PROJ + C_BV + qd * 64; float ss = 0.f;
#pragma unroll
          for (int c8 = 0; c8 < 8; ++c8) { const v4u w = *(const v4u*)(p + c8 * 8);
              const float a0 = gelu_tanh(bflo(w.x)), a1 = gelu_tanh(bfhi(w.x)), a2 = gelu_tanh(bflo(w.y)), a3 = gelu_tanh(bfhi(w.y)), a4 = gelu_tanh(bflo(w.z)), a5 = gelu_tanh(bfhi(w.z)), a6 = gelu_tanh(bflo(w.w)), a7 = gelu_tanh(bfhi(w.w));
              ss += (a0 * a0 + a1 * a1) + (a2 * a2 + a3 * a3) + (a4 * a4 + a5 * a5) + (a6 * a6 + a7 * a7); }
          ss = group_sum<4>(ss); if (qd == 0) rinv[tok] = __builtin_amdgcn_rsqf(ss * (1.f / 256.f) + NORM_EPS); }
        __syncthreads();
        { const int tok = tid >> 2, c0 = (tid & 3) * 16; const bf16* p = proj + (size_t)(row0 + tok) * N_PROJ + C_BV + g * 64 + c0; const float ri = rinv[tok];
          const v4u w0 = *(const v4u*)p, w1 = *(const v4u*)(p + 8); const unsigned ww[8] = {w0.x, w0.y, w0.z, w0.w, w1.x, w1.y, w1.z, w1.w};
#pragma unroll
          for (int c = 0; c < 16; ++c) { const float x = (c & 1) ? bfhi(ww[c >> 1]) : bflo(ww[c >> 1]); vnT[(c0 + c) * VP + tok] = (bf16)f2bf(gelu_tanh(x) * ri * gvn[g * 64 + c0 + c]); } }
        __syncthreads();
        { f32x4 acc[4];
#pragma unroll
          for (int n = 0; n < 4; ++n) acc[n] = (f32x4){0.f, 0.f, 0.f, 0.f};
#pragma unroll
          for (int kk = 0; kk < 4; ++kk)
#pragma unroll
              for (int n = 0; n < 4; ++n) acc[n] = __builtin_amdgcn_mfma_f32_16x16x32_bf16(afr[kk], *(const LAS bf16x8*)(vnT + (16 * n + l15) * VP + 32 * kk + 8 * q), acc[n], 0, 0, 0);
          const float* bs = INP(14) + ((size_t)layer * 4 + g) * 128;
#pragma unroll
          for (int r = 0; r < 4; ++r) { const int tok = 16 * wv + 4 * q + r; const float bb = bs[tok];
#pragma unroll
              for (int n = 0; n < 4; ++n) spT[tok * SP + 16 * n + l15] = acc[n][r] + bb; } }
        __syncthreads();
        { const int tok = tid >> 2, c0 = (tid & 3) * 16; const size_t rowp = (size_t)(row0 + tok);
          const bf16* pu = proj + rowp * N_PROJ + C_BU + g * 64 + c0; const v4u u0 = *(const v4u*)pu, u1 = *(const v4u*)(pu + 8); const unsigned uw[8] = {u0.x, u0.y, u0.z, u0.w, u1.x, u1.y, u1.z, u1.w};
          float o[16];
#pragma unroll
          for (int c4 = 0; c4 < 4; ++c4) { const f32x4 sp = *(const LAS f32x4*)(spT + tok * SP + c0 + 4 * c4);
              o[4 * c4 + 0] = gelu_tanh(bflo(uw[2 * c4])) * sp.x; o[4 * c4 + 1] = gelu_tanh(bfhi(uw[2 * c4])) * sp.y; o[4 * c4 + 2] = gelu_tanh(bflo(uw[2 * c4 + 1])) * sp.z; o[4 * c4 + 3] = gelu_tanh(bfhi(uw[2 * c4 + 1])) * sp.w; }
          bf16* po = mix + rowp * D + 256 + g * 64 + c0;
          *(v4u*)po = (v4u){pk2(o[0], o[1]), pk2(o[2], o[3]), pk2(o[4], o[5]), pk2(o[6], o[7])}; *(v4u*)(po + 8) = (v4u){pk2(o[8], o[9]), pk2(o[10], o[11]), pk2(o[12], o[13]), pk2(o[14], o[15])}; }
        __syncthreads();
    }
}

DEVI int dn_kmap(int kk, int q, int j) { return 16 * (2 * kk + (j >> 2)) + 4 * q + (j & 3); }
DEVI size_t dn_unit_off(int b, int dir, int h, int sc) { return ((size_t)((b * 2 + dir) * 4 + h) * NCH + sc) * DN_UNIT_BYTES; }
constexpr int DP = 68, XP = 132, HP = 72;
DEVI f32x4 mfma16(bf16x8 a, bf16x8 b, f32x4 c) { return __builtin_amdgcn_mfma_f32_16x16x32_bf16(a, b, c, 0, 0, 0); }
#ifndef D1REP
#define D1REP 0
#endif
#define DN_BAR() asm volatile("s_waitcnt lgkmcnt(0)\n\ts_barrier" ::: "memory")
DEVI void ph_dn_chunk(const Ctx& C, int layer) {
    LAS bf16* kN = (LAS bf16*)C.lds;
    LAS bf16* qN = kN + 64 * HP;
    LAS bf16* kT = qN + 64 * HP;
    LAS bf16* QKd = kT + 64 * HP;
    LAS bf16* RT = QKd + 64 * HP;
    LAS bf16* XT = RT;
    LAS bf16* TiB = RT + 128 * HP;
    LAS float* Am = (LAS float*)(TiB + 64 * HP);
    LAS float* TI = Am + 64 * DP;
    LAS bf16* XdT = (LAS bf16*)Am;
    LAS float* TMP = TI + 64 * DP;
    LAS float* vec = TMP + 1280;
    LAS float* betav = vec; LAS float* cum = vec + 64; LAS float* ecum = vec + 128; LAS float* dvec = vec + 192; LAS float* bec = vec + 256;
    LAS float* cwl = vec + 320;
    LAS float* gpar = cwl + 2304;
    static_assert(128 * HP * 2 <= 2 * 64 * DP * 4 && (4 * 64 * HP + 128 * HP + 64 * HP) * 2 + (2 * 64 * DP + 1280 + 320 + 2304 + 16) * 4 <= MISC_OFF, "D1 LDS");
    const bf16* proj = WSP(const bf16, WS_PROJ); const float* BA = WSP(const float, WS_BA);
    { const float* cwg = INP(20) + (size_t)layer * 3 * 768; for (int i = C.tid; i < 2304; i += 512) cwl[i] = cwg[i];
      if (C.tid < 8) gpar[C.tid] = -fast_exp(INP(21)[layer * 8 + C.tid]); else if (C.tid < 16) gpar[C.tid] = INP(22)[layer * 8 + C.tid - 8]; }
    __syncthreads();
    const LAS float* cw = cwl;
    const int tid0 = C.tid;
#define FRESH_TID() int tid = tid0; LAUNDER_V(tid)
#define DN_DECODE(u_) const int tcx = (u_) % NCH, h = ((u_) / NCH) & 3, dir = ((u_) / (NCH * 4)) & 1, b = (u_) / (NCH * 8); \
        const bool isc = tcx < NCH_C; const int tc = isc ? tcx : tcx - NCH_C; const int nch = isc ? NCH_C : NCH_L; const int len = nch * 64; \
        const int row_seq0 = isc ? T_L + b * LC : b * SEQ
    v4u rw[3][3]; float rb0 = 0.f, rb1 = 0.f, rb2 = 0.f;
#define DN_LOAD(u_) do { if ((u_) < NB * 2 * 4 * NCH) { DN_DECODE(u_); int t_ = tid0; LAUNDER_V(t_); const int c = t_ >> 3, d0 = (t_ & 7) * 8; const int tl = tc * 64 + (dir ? 63 - c : c); const size_t r = (size_t)row_seq0 + tl; \
        const bool hp = tl > 0, hn = tl < len - 1; \
        _Pragma("unroll") for (int w3 = 0; w3 < 3; ++w3) { const bf16* p = proj + r * N_PROJ + C_DQKV + w3 * 256 + h * 64 + d0; \
            rw[w3][1] = *(const v4u*)p; rw[w3][0] = (v4u){0u, 0u, 0u, 0u}; rw[w3][2] = (v4u){0u, 0u, 0u, 0u}; if (hp) rw[w3][0] = *(const v4u*)(p - N_PROJ); if (hn) rw[w3][2] = *(const v4u*)(p + N_PROJ); } \
        rb0 = BA[r * 16 + dir * 4 + h]; \
        if (t_ < 64) { const int tl2 = tc * 64 + (dir ? 63 - t_ : t_); const float* ba = BA + ((size_t)row_seq0 + tl2) * 16; rb1 = ba[dir * 4 + h]; rb2 = ba[8 + dir * 4 + h]; } } } while (0)
    DN_LOAD(C.bid);
    for (int u = C.bid; u < NB * 2 * 4 * NCH; u += C.G) {
        DN_DECODE(u);
        const int sc = (isc ? 0 : NCH_C) + (dir ? nch - 1 - tc : tc);
        { FRESH_TID(); const int c = tid >> 3, part = tid & 7, d0 = part * 8;
          float y[3][8];
#pragma unroll
          for (int w3 = 0; w3 < 3; ++w3) { const int col = w3 * 256 + h * 64 + d0;
              const v4u xc = rw[w3][1], xp = rw[w3][0], xn = rw[w3][2];
              const unsigned xcw[4] = {xc.x, xc.y, xc.z, xc.w}, xpw[4] = {xp.x, xp.y, xp.z, xp.w}, xnw[4] = {xn.x, xn.y, xn.z, xn.w};
#pragma unroll
              for (int e = 0; e < 8; ++e) { const float a = (e & 1) ? bfhi(xpw[e >> 1]) : bflo(xpw[e >> 1]), m = (e & 1) ? bfhi(xcw[e >> 1]) : bflo(xcw[e >> 1]), n = (e & 1) ? bfhi(xnw[e >> 1]) : bflo(xnw[e >> 1]);
                  y[w3][e] = siluf_(cw[col + e] * a + cw[768 + col + e] * m + cw[1536 + col + e] * n); } }
          const float ba_b = rb0, ba_b2 = rb1, ba_a2 = rb2;
          DN_LOAD(u + C.G);
          float sq = 0.f, sk = 0.f;
#pragma unroll
          for (int e = 0; e < 8; ++e) { sq += y[0][e] * y[0][e]; sk += y[1][e] * y[1][e]; }
          sq = group_sum<8>(sq); sk = group_sum<8>(sk);
          const float rq = __builtin_amdgcn_rsqf(sq + NORM_EPS) * 0.125f, rk = __builtin_amdgcn_rsqf(sk + NORM_EPS);
          const float betac = sigmoidf_(ba_b);
#pragma unroll
          for (int e = 0; e < 8; ++e) { y[0][e] *= rq; y[1][e] *= rk; kT[(d0 + e) * HP + c] = (bf16)f2bf(y[1][e]); RT[(d0 + e) * HP + c] = (bf16)f2bf(betac * y[2][e]); }
          *(LAS v4u*)(qN + c * HP + d0) = (v4u){pk2(y[0][0], y[0][1]), pk2(y[0][2], y[0][3]), pk2(y[0][4], y[0][5]), pk2(y[0][6], y[0][7])};
          *(LAS v4u*)(kN + c * HP + d0) = (v4u){pk2(y[1][0], y[1][1]), pk2(y[1][2], y[1][3]), pk2(y[1][4], y[1][5]), pk2(y[1][6], y[1][7])};
          *(LAS v4u*)(QKd + c * HP + d0) = (v4u){0u, 0u, 0u, 0u};
          { LAS f32x4* z = (LAS f32x4*)TI; z[tid] = (f32x4){0.f, 0.f, 0.f, 0.f}; z[tid + 512] = (f32x4){0.f, 0.f, 0.f, 0.f}; if (tid < 64) z[tid + 1024] = (f32x4){0.f, 0.f, 0.f, 0.f}; }
          if (tid < 64) { const int c2 = tid;
              const float bt = sigmoidf_(ba_b2);
              float sg = gpar[dir * 4 + h] * softplusf_(ba_a2 + gpar[8 + dir * 4 + h]);
#pragma unroll
              for (int o = 1; o < 64; o <<= 1) { const float t = __shfl_up(sg, o); if (c2 >= o) sg += t; }
              const float G = __shfl(sg, 63); const float ec = fast_exp(sg);
              betav[c2] = bt; cum[c2] = sg; ecum[c2] = ec; dvec[c2] = fast_exp(G - sg); bec[c2] = bt * ec; } }
        DN_BAR();
        for (int rp_ = 0; rp_ < 1 + (((D1REP) >> 1) & 1); ++rp_) {
        { FRESH_TID(); const int lane = tid & 63, wv = __builtin_amdgcn_readfirstlane(tid >> 6), l15 = lane & 15, q = lane >> 4;
          { const int k = tid >> 3, c0 = (tid & 7) * 8; const v4u kk4 = *(const LAS v4u*)(kT + k * HP + c0); const unsigned kw[4] = {kk4.x, kk4.y, kk4.z, kk4.w}; unsigned ow[4];
#pragma unroll
            for (int e = 0; e < 4; ++e) ow[e] = pk2(bflo(kw[e]) * bec[c0 + 2 * e], bfhi(kw[e]) * bec[c0 + 2 * e + 1]);
            *(LAS v4u*)(RT + (64 + k) * HP + c0) = (v4u){ow[0], ow[1], ow[2], ow[3]}; }
#pragma unroll
          for (int tt = 0; tt < 3; ++tt) { const int t = wv + 8 * tt; if (t >= 20) break;
              const bool isq = t >= 10; const int idx = isq ? t - 10 : t; const int ti = (idx >= 6) ? 3 : (idx >= 3) ? 2 : (idx >= 1) ? 1 : 0; const int tj = idx - ti * (ti + 1) / 2;
              const LAS bf16* asrc = (isq ? qN : kN) + (16 * ti + l15) * HP + 8 * q; const LAS bf16* bsrc = kN + (16 * tj + l15) * HP + 8 * q;
              f32x4 acc = {0.f, 0.f, 0.f, 0.f};
              acc = mfma16(*(const LAS bf16x8*)asrc, *(const LAS bf16x8*)bsrc, acc); acc = mfma16(*(const LAS bf16x8*)(asrc + 32), *(const LAS bf16x8*)(bsrc + 32), acc);
              const int j = 16 * tj + l15; const float cj = cum[j];
#pragma unroll
              for (int r = 0; r < 4; ++r) { const int i = 16 * ti + 4 * q + r; const float dec = fast_exp(cum[i] - cj);
                  if (isq) QKd[i * HP + j] = (bf16)f2bf((i >= j) ? acc[r] * dec : 0.f); else Am[i * DP + j] = (i > j) ? acc[r] * dec * betav[i] : 0.f; } } }
        DN_BAR();
        }
        for (int rp_ = 0; rp_ < 1 + (((D1REP) >> 2) & 1); ++rp_) {
        { FRESH_TID(); if (tid < 64) { const int bb = tid >> 4, col = tid & 15; float x[16];
#pragma unroll
            for (int r = 0; r < 16; ++r) { float s = (r == col) ? 1.f : 0.f;
#pragma unroll
                for (int s2 = 0; s2 < r; ++s2) s -= Am[(16 * bb + r) * DP + 16 * bb + s2] * x[s2];
                x[r] = s; }
#pragma unroll
            for (int r = 0; r < 16; ++r) TI[(16 * bb + r) * DP + 16 * bb + col] = x[r]; } }
        DN_BAR();
        }
        for (int rp_ = 0; rp_ < 1 + (((D1REP) >> 3) & 1); ++rp_) {
        { FRESH_TID(); const int p = tid >> 8, r = (tid >> 4) & 15, c = tid & 15; float e = 0.f;
#pragma unroll
          for (int s2 = 0; s2 < 16; ++s2) e += Am[(32 * p + 16 + r) * DP + 32 * p + s2] * TI[(32 * p + s2) * DP + 32 * p + c];
          TMP[(p * 16 + r) * 17 + c] = e;
          DN_BAR();
          float f = 0.f;
#pragma unroll
          for (int s2 = 0; s2 < 16; ++s2) f -= TI[(32 * p + 16 + r) * DP + 32 * p + 16 + s2] * TMP[(p * 16 + s2) * 17 + c];
          TI[(32 * p + 16 + r) * DP + 32 * p + c] = f; }
        DN_BAR();
        }
        for (int rp_ = 0; rp_ < 1 + (((D1REP) >> 4) & 1); ++rp_) {
        { FRESH_TID(); const int r = tid >> 4, c2 = (tid & 15) * 2; float e0 = 0.f, e1 = 0.f;
#pragma unroll 8
          for (int s2 = 0; s2 < 32; ++s2) { const float a = Am[(32 + r) * DP + s2]; e0 += a * TI[s2 * DP + c2]; e1 += a * TI[s2 * DP + c2 + 1]; }
          TMP[r * 36 + c2] = e0; TMP[r * 36 + c2 + 1] = e1;
          DN_BAR();
          float f0 = 0.f, f1 = 0.f;
#pragma unroll 8
          for (int s2 = 0; s2 < 32; ++s2) { const float a = TI[(32 + r) * DP + 32 + s2]; f0 -= a * TMP[s2 * 36 + c2]; f1 -= a * TMP[s2 * 36 + c2 + 1]; }
          TI[(32 + r) * DP + c2] = f0; TI[(32 + r) * DP + c2 + 1] = f1; }
        DN_BAR();
        }
        for (int rp_ = 0; rp_ < 1 + (((D1REP) >> 5) & 1); ++rp_) {
        { FRESH_TID(); const int c = tid >> 3, c0 = (tid & 7) * 8; float x[8];
#pragma unroll
          for (int e = 0; e < 8; ++e) x[e] = (c0 + e <= c) ? TI[c * DP + c0 + e] : 0.f;
          *(LAS v4u*)(TiB + c * HP + c0) = (v4u){pk2(x[0], x[1]), pk2(x[2], x[3]), pk2(x[4], x[5]), pk2(x[6], x[7])}; }
        DN_BAR();
        }
        { FRESH_TID(); const int lane = tid & 63, wv = __builtin_amdgcn_readfirstlane(tid >> 6), l15 = lane & 15, q = lane >> 4;
          f32x4 xa[4]; const LAS bf16* bsrc = RT + (16 * wv + l15) * HP + 8 * q; const bf16x8 b0 = *(const LAS bf16x8*)bsrc, b1 = *(const LAS bf16x8*)(bsrc + 32);
#pragma unroll
          for (int m = 0; m < 4; ++m) { const LAS bf16* asrc = TiB + (16 * m + l15) * HP + 8 * q; f32x4 a_ = {0.f, 0.f, 0.f, 0.f};
              a_ = mfma16(*(const LAS bf16x8*)asrc, b0, a_); xa[m] = mfma16(*(const LAS bf16x8*)(asrc + 32), b1, a_); }
          DN_BAR();
          const int col = 16 * wv + l15;
#pragma unroll
          for (int m = 0; m < 4; ++m) { const int c0 = 16 * m + 4 * q; const f32x4 x = xa[m];
              *(LAS v2u*)(XT + col * HP + c0) = (v2u){pk2(x.x, x.y), pk2(x.z, x.w)};
              *(LAS v2u*)(XdT + col * HP + c0) = (v2u){pk2(x.x * dvec[c0], x.y * dvec[c0 + 1]), pk2(x.z * dvec[c0 + 2], x.w * dvec[c0 + 3])}; } }
        DN_BAR();
        for (int rp_ = 0; rp_ < 1 + (((D1REP) >> 7) & 1); ++rp_) {
        { FRESH_TID(); const int lane = tid & 63, wv = __builtin_amdgcn_readfirstlane(tid >> 6), l15 = lane & 15, q = lane >> 4;
          unsigned char* ub = WSP(unsigned char, WS_DNF + dn_unit_off(b, dir, h, sc));
          const float eG = ecum[63];
#define DN_MM(dst, Ap, Bp) do { f32x4 a_ = {0.f, 0.f, 0.f, 0.f}; a_ = mfma16(*(const LAS bf16x8*)(Ap), *(const LAS bf16x8*)(Bp), a_); dst = mfma16(*(const LAS bf16x8*)((Ap) + 32), *(const LAS bf16x8*)((Bp) + 32), a_); } while (0)
#pragma unroll
          for (int t2 = 0; t2 < 2; ++t2) { const int t = 2 * wv + t2, m = t >> 2, n = t & 3; f32x4 acc;
              DN_MM(acc, kT + (16 * m + l15) * HP + 8 * q, XdT + (16 * n + l15) * HP + 8 * q);
              *(v2u*)(ub + 16384 + (size_t)((n * 4 + m) * 64 + lane) * 8) = (v2u){pk2(acc.x, acc.y), pk2(acc.z, acc.w)};
              DN_MM(acc, QKd + (16 * m + l15) * HP + 8 * q, XT + (16 * n + l15) * HP + 8 * q);
              *(v2u*)(ub + 24576 + (size_t)((n * 4 + m) * 64 + lane) * 8) = (v2u){pk2(acc.x, acc.y), pk2(acc.z, acc.w)}; }
          { const int n = wv >> 1, kk2 = wv & 1; f32x4 z0, z1, y0, y1;
            DN_MM(z0, XdT + (64 + 16 * (2 * kk2) + l15) * HP + 8 * q, kT + (16 * n + l15) * HP + 8 * q);
            DN_MM(z1, XdT + (64 + 16 * (2 * kk2 + 1) + l15) * HP + 8 * q, kT + (16 * n + l15) * HP + 8 * q);
            DN_MM(y0, XT + (64 + 16 * (2 * kk2) + l15) * HP + 8 * q, QKd + (16 * n + l15) * HP + 8 * q);
            DN_MM(y1, XT + (64 + 16 * (2 * kk2 + 1) + l15) * HP + 8 * q, QKd + (16 * n + l15) * HP + 8 * q);
            const int rowi = 16 * n + l15; float mv[8], qv[8]; const float ec = ecum[rowi];
#pragma unroll
            for (int e = 0; e < 8; ++e) { const int kp = 16 * (2 * kk2 + (e >> 2)) + 4 * q + (e & 3); const float zz = (e < 4) ? z0[e & 3] : z1[e & 3], yy = (e < 4) ? y0[e & 3] : y1[e & 3];
                mv[e] = ((kp == rowi) ? eG : 0.f) - zz; qv[e] = ec * bf2f(qN[rowi * HP + kp]) - yy; }
            *(v4u*)(ub + (size_t)((n * 2 + kk2) * 64 + lane) * 16) = (v4u){pk2(mv[0], mv[1]), pk2(mv[2], mv[3]), pk2(mv[4], mv[5]), pk2(mv[6], mv[7])};
            *(v4u*)(ub + 8192 + (size_t)((n * 2 + kk2) * 64 + lane) * 16) = (v4u){pk2(qv[0], qv[1]), pk2(qv[2], qv[3]), pk2(qv[4], qv[5]), pk2(qv[6], qv[7])}; }
#undef DN_MM
        }
        DN_BAR();
        }
    }
}
#undef FRESH_TID
#undef DN_BAR
#undef DN_LOAD
#undef DN_DECODE
DEVI bf16x8 dn_pack(const f32x4& a, const f32x4& b) { const v4u o = {pk2(a.x, a.y), pk2(a.z, a.w), pk2(b.x, b.y), pk2(b.z, b.w)}; return __builtin_bit_cast(bf16x8, o); }
#define SCAN_BAR() asm volatile("s_waitcnt lgkmcnt(0)\n\ts_barrier" ::: "memory")
DEVI unsigned cvtpk(float lo, float hi) { return pk2(lo, hi); }
DEVI bf16x8 dn_pack_hw(const f32x4& a, const f32x4& b) { const v4u o = {cvtpk(a.x, a.y), cvtpk(a.z, a.w), cvtpk(b.x, b.y), cvtpk(b.z, b.w)}; return __builtin_bit_cast(bf16x8, o); }
DEVI void ph_dn_scan(const Ctx& C, int layer) {
    constexpr int SLOTB = 24576, NS = 4, P = 8, NLD = 384, NPC = 4;
    static_assert(NCH % P == 0 || NCH % P == P / 2, "scan pipeline depth: whole groups of P steps plus at most one half group");
    const int lane = C.lane, q = lane >> 4, v16 = lane & 15;
    bf16* DNO = WSP(bf16, WS_DNO);
    for (int u = C.bid; u < NB * 2 * 4 * 2; u += C.G) {
        const int vp = u & 1, h = (u >> 1) & 3, dir = (u >> 3) & 1, b = u >> 4;
        const unsigned char* base = WSP(const unsigned char, WS_DNF + dn_unit_off(b, dir, h, 0));
        if (C.wave < 2) {
            const int vs = 2 * vp + C.wave;
            bf16x8 sf[2]; { const v4u z = {0u, 0u, 0u, 0u}; sf[0] = __builtin_bit_cast(bf16x8, z); sf[1] = sf[0]; }
            bf16* ob = DNO + (size_t)dir * T_ALL * 256 + h * 64 + vs * 16 + v16;
            SCAN_BAR();
#define SCAN_SEG(SGN, SC0, NCHS, SEQ0, LEN) do { \
            bf16* pm[4]; \
            _Pragma("unroll") for (int m = 0; m < 4; ++m) pm[m] = ob + ((long)(SEQ0) + ((SGN) < 0 ? (LEN) - 1 : 0) + (SGN) * (16 * m + 4 * q)) * 256; \
            _Pragma("unroll 1") for (int s2 = 0; s2 < (NCHS); ++s2) { \
                const LAS unsigned char* sl = C.lds + (((SC0) + s2) % NS) * SLOTB; \
                f32x4 o[4], d[4]; \
                _Pragma("unroll") for (int m = 0; m < 4; ++m) { \
                    const bf16x8 ma0 = *(const LAS bf16x8*)(sl + ((m * 2 + 0) * 64 + lane) * 16), ma1 = *(const LAS bf16x8*)(sl + ((m * 2 + 1) * 64 + lane) * 16); \
                    const bf16x8 qa0 = *(const LAS bf16x8*)(sl + 8192 + ((m * 2 + 0) * 64 + lane) * 16), qa1 = *(const LAS bf16x8*)(sl + 8192 + ((m * 2 + 1) * 64 + lane) * 16); \
                    const v2u ncp = *(const LAS v2u*)(sl + 16384 + ((C.wave * 4 + m) * 64 + lane) * 8), ocp = *(const LAS v2u*)(sl + 20480 + ((C.wave * 4 + m) * 64 + lane) * 8); \
                    const f32x4 nc = {bflo(ncp.x), bfhi(ncp.x), bflo(ncp.y), bfhi(ncp.y)}, oc = {bflo(ocp.x), bfhi(ocp.x), bflo(ocp.y), bfhi(ocp.y)}; \
                    d[m] = __builtin_amdgcn_mfma_f32_16x16x32_bf16(ma0, sf[0], nc, 0, 0, 0); d[m] = __builtin_amdgcn_mfma_f32_16x16x32_bf16(ma1, sf[1], d[m], 0, 0, 0); \
                    o[m] = __builtin_amdgcn_mfma_f32_16x16x32_bf16(qa0, sf[0], oc, 0, 0, 0); o[m] = __builtin_amdgcn_mfma_f32_16x16x32_bf16(qa1, sf[1], o[m], 0, 0, 0); } \
                sf[0] = dn_pack_hw(d[0], d[1]); sf[1] = dn_pack_hw(d[2], d[3]); \
                _Pragma("unroll") for (int m = 0; m < 4; ++m) { \
                    _Pragma("unroll") for (int i = 0; i < 4; ++i) pm[m][(SGN) * i * 256] = (bf16)f2bf(o[m][i]); \
                    pm[m] += (SGN) * 64 * 256; } \
                SCAN_BAR(); } } while (0)
            if (dir == 0) { SCAN_SEG(1, 0, NCH_C, T_L + b * LC, LC); SCAN_SEG(1, NCH_C, NCH_L, b * SEQ, SEQ); }
            else          { SCAN_SEG(-1, 0, NCH_C, T_L + b * LC, LC); SCAN_SEG(-1, NCH_C, NCH_L, b * SEQ, SEQ); }
#undef SCAN_SEG
        } else {
            const int lid = C.tid - 128;
            unsigned so[NPC], dofs[NPC];
#pragma unroll
            for (int i = 0; i < NPC; ++i) { const int pp = lid + NLD * i;
                so[i] = (pp < 1024) ? (unsigned)pp * 16u : (pp < 1280) ? 16384u + (unsigned)(vp * 256 + (pp - 1024)) * 16u : 24576u + (unsigned)(vp * 256 + (pp - 1280)) * 16u; dofs[i] = (unsigned)pp * 16u; }
            v4u buf[P][NPC];
#pragma unroll
            for (int s2 = 0; s2 < P; ++s2)
#pragma unroll
                for (int i = 0; i < NPC; ++i) buf[s2][i] = *(const v4u*)(base + (size_t)s2 * DN_UNIT_BYTES + so[i]);
#pragma unroll
            for (int i = 0; i < NPC; ++i) *(LAS v4u*)(C.lds + dofs[i]) = buf[0][i];
            SCAN_BAR();
#define SCAN_LD_STEP(j) do { const int step = sc + (j); const int nxt = (step + P < NCH) ? step + P : NCH - 1; \
                    _Pragma("unroll") for (int i = 0; i < NPC; ++i) buf[(j)][i] = *(const v4u*)(base + (size_t)nxt * DN_UNIT_BYTES + so[i]); \
                    LAS unsigned char* sl = C.lds + ((step + 1) % NS) * SLOTB; \
                    _Pragma("unroll") for (int i = 0; i < NPC; ++i) *(LAS v4u*)(sl + dofs[i]) = buf[((j) + 1) % P][i]; \
                    SCAN_BAR(); } while (0)
            int sc = 0;
#pragma unroll 1
            for (; sc + P <= NCH; sc += P) {
#pragma unroll
                for (int j = 0; j < P; ++j) SCAN_LD_STEP(j);
            }
            if (NCH % P) {
#pragma unroll
                for (int j = 0; j < P / 2; ++j) SCAN_LD_STEP(j);
            }
#undef SCAN_LD_STEP
        }
    }
}
#undef SCAN_BAR

DEVI void ph_finalize(const Ctx& C, int layer, int ntok) {
    const int lane = C.lane;
    const bf16* DNO = WSP(const bf16, WS_DNO); const bf16* proj = WSP(const bf16, WS_PROJ); bf16* mix = WSP(bf16, WS_MIX);
    const f32x4 ong = *(const f32x4*)(INP(23) + layer * 64 + ((4 * lane) & 63));
    constexpr int RU = 4; const int rstep = C.G * 8;
    for (int r0 = C.bid * 8 + C.wave; r0 < ntok; r0 += RU * rstep) {
        v2u zz[RU], d0[RU], d1[RU];
#pragma unroll
        for (int u2 = 0; u2 < RU; ++u2) { const int rr = r0 + u2 * rstep; const size_t r = rr < ntok ? rr : r0;
            d0[u2] = *(const v2u*)(DNO + r * 256 + 4 * lane); d1[u2] = *(const v2u*)(DNO + ((size_t)T_ALL + r) * 256 + 4 * lane);
            zz[u2] = *(const v2u*)(proj + r * N_PROJ + C_DZ + 4 * lane); }
#pragma unroll
        for (int u2 = 0; u2 < RU; ++u2) { const int rr = r0 + u2 * rstep; if (rr >= ntok) continue; const size_t r = rr;
            const f32x4 od = (f32x4){bflo(d0[u2].x), bfhi(d0[u2].x), bflo(d0[u2].y), bfhi(d0[u2].y)} + (f32x4){bflo(d1[u2].x), bfhi(d1[u2].x), bflo(d1[u2].y), bfhi(d1[u2].y)};
            const float ss = group_sum<16>((od.x * od.x + od.y * od.y) + (od.z * od.z + od.w * od.w));
            const float rinv = __builtin_amdgcn_rsqf(ss * (1.f / 64.f) + NORM_EPS);
            const f32x4 z = (f32x4){siluf_(bflo(zz[u2].x)), siluf_(bfhi(zz[u2].x)), siluf_(bflo(zz[u2].y)), siluf_(bfhi(zz[u2].y))};
            const f32x4 o = od * rinv * ong * z; v2u w; w.x = pk2(o.x, o.y); w.y = pk2(o.z, o.w); *(v2u*)(mix + r * D + 768 + 4 * lane) = w; }
    }
}

DEVI void ph_router(const Ctx& C, int layer, int ntok) {
    LAS float* lgt = (LAS float*)C.lds;
    LAS int* cnt = (LAS int*)(lgt + 8 * 16 * 33);
    if (C.tid < 32) cnt[C.tid] = 0;
    __syncthreads();
    const int nt = ntok / 16; const int t0 = (int)((long)C.bid * nt / C.G), t1 = (int)((long)(C.bid + 1) * nt / C.G);
    const float* gn = INP(7) + (size_t)layer * D;
    const int l15 = C.lane & 15, q = C.lane >> 4; LAS float* lg_w = lgt + C.wave * 16 * 33;
    for (int t = t0 + C.wave; t < t1; t += 8) {
        const int row0 = 16 * t, mrow = mod_row(row0);
        const bf16* xa = WSP(const bf16, WS_XRES) + (size_t)(row0 + l15) * D + 4 * q;
        const float* wb = WSP(const float, WS_RWP) + ((size_t)(layer * 9 + mrow) * NE + l15) * D + 4 * q;
        f32x4 acc0 = {0.f, 0.f, 0.f, 0.f}, acc1 = {0.f, 0.f, 0.f, 0.f}; float ssq = 0.f;
#pragma unroll 4
        for (int kk = 0; kk < 64; ++kk) { const v2u aw = *(const v2u*)(xa + 16 * kk); const f32x4 a = {bflo(aw.x), bfhi(aw.x), bflo(aw.y), bfhi(aw.y)}, b0 = *(const f32x4*)(wb + 16 * kk), b1 = *(const f32x4*)(wb + (size_t)16 * D + 16 * kk);
            ssq += (a.x * a.x + a.y * a.y) + (a.z * a.z + a.w * a.w);
            acc0 = __builtin_amdgcn_mfma_f32_16x16x4f32(a.x, b0.x, acc0, 0, 0, 0); acc1 = __builtin_amdgcn_mfma_f32_16x16x4f32(a.x, b1.x, acc1, 0, 0, 0);
            acc0 = __builtin_amdgcn_mfma_f32_16x16x4f32(a.y, b0.y, acc0, 0, 0, 0); acc1 = __builtin_amdgcn_mfma_f32_16x16x4f32(a.y, b1.y, acc1, 0, 0, 0);
            acc0 = __builtin_amdgcn_mfma_f32_16x16x4f32(a.z, b0.z, acc0, 0, 0, 0); acc1 = __builtin_amdgcn_mfma_f32_16x16x4f32(a.z, b1.z, acc1, 0, 0, 0);
            acc0 = __builtin_amdgcn_mfma_f32_16x16x4f32(a.w, b0.w, acc0, 0, 0, 0); acc1 = __builtin_amdgcn_mfma_f32_16x16x4f32(a.w, b1.w, acc1, 0, 0, 0); }
        ssq += __shfl_xor(ssq, 16); ssq += __shfl_xor(ssq, 32);
        const float rinv = __builtin_amdgcn_rsqf(ssq * (1.f / D) + NORM_EPS);
        const float* rb = WSP(const float, WS_RBP) + (size_t)(layer * 9 + mrow) * NE;
        const float bb0 = rb[l15], bb1 = rb[16 + l15];
#pragma unroll
        for (int r = 0; r < 4; ++r) { const float ri = __shfl(rinv, 4 * q + r); lg_w[(4 * q + r) * 33 + l15] = acc0[r] * ri + bb0; lg_w[(4 * q + r) * 33 + 16 + l15] = acc1[r] * ri + bb1; }
        LDS_WAIT();
        if (C.lane < 16) { const int r = row0 + C.lane; float lg[32];
#pragma unroll
            for (int e = 0; e < 32; ++e) lg[e] = lg_w[C.lane * 33 + e];
            int te[4]; float tv[4];
#pragma unroll
            for (int k = 0; k < 4; ++k) { float best = -INFINITY; int bi = 0;
#pragma unroll
                for (int e = 0; e < 32; ++e) if (lg[e] > best) { best = lg[e]; bi = e; }
#pragma unroll
                for (int e = 0; e < 32; ++e) lg[e] = (e == bi) ? -INFINITY : lg[e];
                te[k] = bi; tv[k] = best; }
            float ex[4], es = 0.f;
#pragma unroll
            for (int k = 0; k < 4; ++k) { ex[k] = fast_exp(tv[k] - tv[0]); es += ex[k]; }
            const float ri = 1.f / es;
#pragma unroll
            for (int k = 0; k < 4; ++k) { const int pos = __hip_atomic_fetch_add(&cnt[te[k]], 1, __ATOMIC_RELAXED, __HIP_MEMORY_SCOPE_WORKGROUP);
                WSP(int, WS_TOKE)[(size_t)r * 4 + k] = te[k]; WSP(float, WS_TOKG)[(size_t)r * 4 + k] = ex[k] * ri; WSP(int, WS_TOKP)[(size_t)r * 4 + k] = pos; } }
        LDS_WAIT();
        { const float* sh = mod_vec(C, layer, mrow, 3); const float* scl = mod_vec(C, layer, mrow, 4);
          f32x4 gm[4], sv[4];
#pragma unroll
          for (int j = 0; j < 4; ++j) { const int col = ((j & 2) ? 512 : 0) + 8 * C.lane + 4 * (j & 1); gm[j] = *(const f32x4*)(gn + col) * (*(const f32x4*)(scl + col) + 1.0f); sv[j] = *(const f32x4*)(sh + col); }
#pragma unroll 1
          for (int rr = 0; rr < 16; rr += 2) { v4u xw[2][2];
#pragma unroll
              for (int u2 = 0; u2 < 2; ++u2) { const bf16* xr = WSP(const bf16, WS_XRES) + (size_t)(row0 + rr + u2) * D; xw[u2][0] = *(const v4u*)(xr + 8 * C.lane); xw[u2][1] = *(const v4u*)(xr + 512 + 8 * C.lane); }
#pragma unroll
              for (int u2 = 0; u2 < 2; ++u2) { const float ri = __shfl(rinv, rr + u2); f32x4 f[4];
                  f[0] = (f32x4){bflo(xw[u2][0].x), bfhi(xw[u2][0].x), bflo(xw[u2][0].y), bfhi(xw[u2][0].y)} * ri * gm[0] + sv[0]; f[1] = (f32x4){bflo(xw[u2][0].z), bfhi(xw[u2][0].z), bflo(xw[u2][0].w), bfhi(xw[u2][0].w)} * ri * gm[1] + sv[1];
                  f[2] = (f32x4){bflo(xw[u2][1].x), bfhi(xw[u2][1].x), bflo(xw[u2][1].y), bfhi(xw[u2][1].y)} * ri * gm[2] + sv[2]; f[3] = (f32x4){bflo(xw[u2][1].z), bfhi(xw[u2][1].z), bflo(xw[u2][1].w), bfhi(xw[u2][1].w)} * ri * gm[3] + sv[3];
                  bf16* fr_ = WSP(bf16, WS_F) + (size_t)(row0 + rr + u2) * D;
                  *(v4u*)(fr_ + 8 * C.lane) = (v4u){pk2(f[0].x, f[0].y), pk2(f[0].z, f[0].w), pk2(f[1].x, f[1].y), pk2(f[1].z, f[1].w)};
                  *(v4u*)(fr_ + 512 + 8 * C.lane) = (v4u){pk2(f[2].x, f[2].y), pk2(f[2].z, f[2].w), pk2(f[3].x, f[3].y), pk2(f[3].z, f[3].w)}; } } }
    }
    __syncthreads();
    if (C.tid < 32) WSP(int, WS_BCNT)[C.bid * 32 + C.tid] = cnt[C.tid];
}

DEVI void ph_slots(const Ctx& C, int layer, int ntok) {
    LAS int* tot = (LAS int*)C.lds; LAS int* myoff = tot + 32; LAS int* base = tot + 64; LAS int* part = tot + 96;
    {
      const int e = C.tid & 31, grp = C.tid >> 5; int t = 0, o = 0; const int* bc = WSP(const int, WS_BCNT) + e;
#pragma unroll 4
      for (int b2 = grp; b2 < C.G; b2 += 16) { const int c = bc[b2 * 32]; t += c; if (b2 < C.bid) o += c; }
      part[grp * 64 + e] = t; part[grp * 64 + 32 + e] = o; }
    __syncthreads();
    if (C.tid < 64) { int a = 0;
#pragma unroll
        for (int g = 0; g < 16; ++g) a += part[g * 64 + C.tid];
        if (C.tid < 32) tot[C.tid] = a; else myoff[C.tid - 32] = a; }
    __syncthreads();
    if (C.tid == 0) { int acc = 0; int* texp = WSP(int, WS_TEXP);
        for (int e = 0; e < 32; ++e) { base[e] = acc; const int nt = (tot[e] + 255) >> 8; if (C.bid == 0) for (int i = 0; i < nt; ++i) texp[1 + (acc >> 8) + i] = e; acc += nt << 8; }
        if (C.bid == 0) texp[0] = acc >> 8; }
    __syncthreads();
    int* rowmap = WSP(int, WS_ROWMAP);
    if (C.bid == 0) {
        for (int e = 0; e < 32; ++e) { const int lo = base[e] + tot[e], hi2 = base[e] + (((tot[e] + 255) >> 8) << 8); for (int i = lo + C.tid; i < hi2; i += 512) rowmap[i] = 0; } }
    const int nt = ntok / 16; const int r0 = 16 * (int)((long)C.bid * nt / C.G), r1 = 16 * (int)((long)(C.bid + 1) * nt / C.G);
    for (int i = r0 * 4 + C.tid; i < r1 * 4; i += 512) { const int e = WSP(const int, WS_TOKE)[i]; const int slot = base[e] + myoff[e] + WSP(const int, WS_TOKP)[i];
        WSP(int, WS_SLOT)[i] = slot; rowmap[slot] = i >> 2; }
}

DEVI void ph_attention(const Ctx& C, bool need_ctx, int layer) {
    const attn_body::bf16* QL = WSP(const attn_body::bf16, WS_QL); const attn_body::bf16* QC = WSP(const attn_body::bf16, WS_QC);
    const attn_body::bf16* KB = WSP(const attn_body::bf16, WS_K); const attn_body::bf16* VB = WSP(const attn_body::bf16, WS_V);
    attn_body::bf16* mix = WSP(attn_body::bf16, WS_MIX);
    constexpr int NQL = SEQ / 128, NQC = LC / 128, UL = NB * 6 * NQL, UC = NB * 6 * NQC;
    const float lam_init = 0.8f - 0.6f * fast_exp(-0.3f * (float)layer); float lam;
    { float p1 = 0.f, p2 = 0.f; if (C.lane < 32) { p1 = INP(15)[layer * 32 + C.lane] * INP(16)[layer * 32 + C.lane]; p2 = INP(17)[layer * 32 + C.lane] * INP(18)[layer * 32 + C.lane]; }
      lam = fast_exp(wave_sum(p1)) - fast_exp(wave_sum(p2)) + lam_init; }
    const float post = 1.f - lam_init; const float* subln = INP(19) + layer * 64;
    const int total = UL + (need_ctx ? UC : 0);
    const int conv_at = (layer + 1 < DEPTH) ? (int)(C.bid % 6) : -1; int ui = 0; bool conv_done = false;
    const int conv0_at = (layer == 0) ? (int)((C.bid + 3) % 6) : -1; bool conv0_done = false;
    for (int u = (C.bid + C.G / 2) % C.G; u < total; u += C.G, ++ui) {
        if (ui == conv_at) { __syncthreads(); convert_layer_weights(C, layer + 1, 2); __syncthreads(); conv_done = true; }
        if (ui == conv0_at) { __syncthreads(); convert_layer_weights(C, 0, 1); __syncthreads(); conv0_done = true; }
        const bool isc = u >= UL; int qb, bp;
        if (!isc && (C.G & 7) == 0 && NQL == 32 && C.G == 256) { const int w = u % C.G, rnd = u / C.G; bp = rnd * 8 + (w & 7); qb = w >> 3; }
        else { const int v = isc ? u - UL : u; const int nq = isc ? NQC : NQL; qb = v % nq; bp = v / nq; }
        const int p = bp % 6, b = bp / 6;
        const int slen = isc ? LC : SEQ; const attn_body::bf16* Qbase = isc ? QC : QL;
        const attn_body::bf16* Qa = Qbase + ((size_t)(b * 12 + 2 * p) * slen + qb * 128) * 64; const attn_body::bf16* Qb = Qa + (size_t)slen * 64;
        const attn_body::bf16* Kh = KB + ((size_t)(b * 6 + p) * NKEY + (isc ? SEQ : 0)) * 64; const attn_body::bf16* Vh = VB + ((size_t)(b * 6 + p) * NKEY + (isc ? SEQ : 0)) * 64;
        const size_t row0 = (size_t)(isc ? T_L + b * LC : b * SEQ) + qb * 128;
        attn_body::bf16 *Oa, *Ob; int opitch;
        if (p < 2) { Oa = mix + row0 * D + (2 * p) * 64; Ob = Oa + 64; opitch = D; }
        else { Oa = mix + row0 * D + 512 + (p - 2) * 64; Ob = Oa; opitch = D; }
        const int ntile = isc ? LC / 64 : NKEY / 64;
        if (p < 2) attn_body::attn_unit<8, 0>(Qa, Qb, Kh, Vh, Oa, Ob, opitch, ntile, (char*)C.lds, lam, post, subln);
        else if (C.wave < 4) attn_body::attn_unit<8, 1>(Qa, Qb, Kh, Vh, Oa, Ob, opitch, ntile, (char*)C.lds, lam, post, subln);
        else attn_body::attn_unit<8, 2>(Qa, Qb, Kh, Vh, Oa, Ob, opitch, ntile, (char*)C.lds, lam, post, subln);
    }
    if (conv_at >= 0 && !conv_done) { __syncthreads(); convert_layer_weights(C, layer + 1, 2); __syncthreads(); }
    if (conv0_at >= 0 && !conv0_done) { __syncthreads(); convert_layer_weights(C, 0, 1); __syncthreads(); }
}

DEVI void ph_outproj_ctx(const Ctx& C, int layer) {
    const int l15 = C.lane & 15, q = C.lane >> 4, ks = C.wave & 3, ch = C.wave >> 2;
    const float* g = mod_vec(C, layer, 8, 2);
    LAS float* P = (LAS float*)C.lds; constexpr int PP = 132;
    for (int tile = C.bid; tile < (NB * LC / 64) * (D / 128); tile += C.G) {
        const int r0 = (tile >> 3) * 64, c0 = (tile & 7) * 128;
        const bf16* a = WSP(const bf16, WS_MIX) + (size_t)(T_L + r0 + l15) * D + 256 * ks + 8 * q;
        const bf16* b = WSP(const bf16, WS_WOUT) + (size_t)layer * D * D + (size_t)(c0 + 64 * ch + l15) * D + 256 * ks + 8 * q;
        f32x4 acc[4][4];
#pragma unroll
        for (int m = 0; m < 4; ++m)
#pragma unroll
            for (int n = 0; n < 4; ++n) acc[m][n] = (f32x4){0.f, 0.f, 0.f, 0.f};
#pragma unroll 2
        for (int kk = 0; kk < 8; ++kk) { bf16x8 av[4], bv[4];
#pragma unroll
            for (int m = 0; m < 4; ++m) av[m] = *(const bf16x8*)(a + (size_t)16 * m * D + 32 * kk);
#pragma unroll
            for (int n = 0; n < 4; ++n) bv[n] = *(const bf16x8*)(b + (size_t)16 * n * D + 32 * kk);
#pragma unroll
            for (int m = 0; m < 4; ++m)
#pragma unroll
                for (int n = 0; n < 4; ++n) acc[m][n] = __builtin_amdgcn_mfma_f32_16x16x32_bf16(bv[n], av[m], acc[m][n], 0, 0, 0); }
#pragma unroll
        for (int m = 0; m < 4; ++m)
#pragma unroll
            for (int n = 0; n < 4; ++n) *(LAS f32x4*)(P + (size_t)(ks * 64 + 16 * m + l15) * PP + 64 * ch + 16 * n + 4 * q) = acc[m][n];
        __syncthreads();
        { const int row = C.tid >> 3, cg = (C.tid & 7) * 16; f32x4 s[4];
#pragma unroll
          for (int i = 0; i < 4; ++i) { const LAS float* pp = P + (size_t)row * PP + cg + 4 * i;
              s[i] = (*(const LAS f32x4*)pp + *(const LAS f32x4*)(pp + 64 * PP)) + (*(const LAS f32x4*)(pp + 128 * PP) + *(const LAS f32x4*)(pp + 192 * PP)); }
          const size_t ro = (size_t)(r0 + row) * D + c0 + cg; bf16* xo = WSP(bf16, WS_XRES) + (size_t)T_L * D + ro;
          f32x4 xi[4];
          if (layer == 0) {
#pragma unroll
              for (int i = 0; i < 4; ++i) xi[i] = *(const f32x4*)(INP(2) + ro + 4 * i); }
          else { const v4u w0 = *(const v4u*)xo, w1 = *(const v4u*)(xo + 8);
              xi[0] = (f32x4){bflo(w0.x), bfhi(w0.x), bflo(w0.y), bfhi(w0.y)}; xi[1] = (f32x4){bflo(w0.z), bfhi(w0.z), bflo(w0.w), bfhi(w0.w)};
              xi[2] = (f32x4){bflo(w1.x), bfhi(w1.x), bflo(w1.y), bfhi(w1.y)}; xi[3] = (f32x4){bflo(w1.z), bfhi(w1.z), bflo(w1.w), bfhi(w1.w)}; }
          f32x4 v[4];
#pragma unroll
          for (int i = 0; i < 4; ++i) v[i] = xi[i] + *(const f32x4*)(g + c0 + cg + 4 * i) * s[i];
          *(v4u*)xo = (v4u){pk2(v[0].x, v[0].y), pk2(v[0].z, v[0].w), pk2(v[1].x, v[1].y), pk2(v[1].z, v[1].w)};
          *(v4u*)(xo + 8) = (v4u){pk2(v[2].x, v[2].y), pk2(v[2].z, v[2].w), pk2(v[3].x, v[3].y), pk2(v[3].z, v[3].w)}; }
        __syncthreads();
    }
}

constexpr int PH_PER_LAYER = 10, N_PHASES = 2 + DEPTH * PH_PER_LAYER;
struct Args { const float* in[31]; float* out; unsigned char* ws; int ph_lo, ph_hi; };
template <int MASK> __global__ void __launch_bounds__(512, 2) mk_fwd(Args args) {
    extern __shared__ __attribute__((aligned(16))) unsigned char lds_raw[];
    { LAS unsigned long long* pt = (LAS unsigned long long*)((LAS unsigned char*)lds_raw + PTR_OFF);
      if (threadIdx.x == 0) {
#pragma unroll
          for (int i = 0; i < 31; ++i) pt[i] = (unsigned long long)args.in[i]; } }
    volatile LAS unsigned* MISC = (volatile LAS unsigned*)((LAS unsigned char*)lds_raw + MISC_OFF);
    if (threadIdx.x < 32) MISC[threadIdx.x] = 0u;
    __syncthreads();
#define CTX() Ctx C; { int t_ = threadIdx.x; LAUNDER_V(t_); C.tid = t_; C.lane = t_ & 63; C.wave = __builtin_amdgcn_readfirstlane(t_ >> 6); int b_ = blockIdx.x; LAUNDER_S(b_); C.bid = b_; \
    int g_ = gridDim.x; LAUNDER_S(g_); C.G = g_; unsigned long long w_ = (unsigned long long)args.ws; LAUNDER_S(w_); C.wsi = w_; C.out = (float*)(GAS float*)(unsigned long long)args.out; C.lds = (LAS unsigned char*)lds_raw; }
    const int lo = args.ph_lo, hi = args.ph_hi;
#if MK_N_LAUNCHES == 1
    XcdBarrier bar = xcd_barrier_post((unsigned*)(args.ws + WS_CTL) + CW_BAR, MISC + 8);
#define GRID_BAR() xcd_barrier(bar)
#else
#define GRID_BAR() do {} while (0)
#endif
#define PHON(b) (((MASK) >> (b)) & 1)
#ifndef REP_MASK
#define REP_MASK 0
#endif
#define REP(b) for (int rp_ = 0; rp_ < 1 + (((REP_MASK) >> (b)) & 1); ++rp_)
#define REPX(b, cond) for (int rp_ = 0; rp_ < 1 + ((((REP_MASK) >> (b)) & 1) && (cond)); ++rp_)
#define IN(k) (lo <= (k) && (k) < hi)
#define SEAM(k) do { if (IN(k) && IN((k) + 1)) { GRID_BAR(); if (((REP_MASK) >> 17) & 1) GRID_BAR(); } } while (0)
    if (PHON(0) && IN(0)) REP(0) { CTX(); p0_prologue(C); } SEAM(0);
#define LAYER_BODY(layer) { \
        const int p0 = 1 + layer * PH_PER_LAYER; const bool need_ctx = layer < DEPTH - 1; const int ntok = need_ctx ? T_ALL : T_L; \
        if (PHON(1) && IN(p0 + 0)) REPX(15, layer == 0) { CTX(); ph_norm_mix(C, layer); } SEAM(p0 + 0); \
        if (PHON(2) && IN(p0 + 1)) REP(2) { CTX(); pg8::Gemm g{WSP(const pg8::bf16_t, WS_H), WSP(const pg8::bf16_t, WS_WIN) + (size_t)layer * N_PROJ * D, T_ALL, N_PROJ, D}; \
            pg8::StaticOrder S; S.init(T_ALL, N_PROJ, C.G, C.bid); pg8::EpiBf16<0> E{WSP(pg8::bf16_t, WS_PROJ), N_PROJ, nullptr, 0, 0, 1.f}; \
            pg8::gemm_phase<pg8::EpiBf16<0>, pg8::StaticOrder, true, true>(C.lds, g, S, E); } SEAM(p0 + 1); \
        if (IN(p0 + 2)) { if (PHON(3)) REP(3) { CTX(); ph_attn_prep(C, layer); } if (PHON(5)) REP(5) { CTX(); ph_dn_chunk(C, layer); } } SEAM(p0 + 2); \
        if (IN(p0 + 3)) { if (PHON(6)) REP(6) { CTX(); ph_dn_scan(C, layer); } __syncthreads(); if (PHON(4)) REP(4) { CTX(); ph_gmlp(C, layer, ntok); } __syncthreads(); if (PHON(7)) REP(7) { CTX(); ph_attention(C, need_ctx, layer); } } SEAM(p0 + 3); \
        if (PHON(8) && IN(p0 + 4)) REP(8) { CTX(); ph_finalize(C, layer, ntok); } SEAM(p0 + 4); \
        if (PHON(9) && IN(p0 + 5)) REPX(14, layer == 0) { CTX(); pg8::Gemm g{WSP(const pg8::bf16_t, WS_MIX), WSP(const pg8::bf16_t, WS_WOUT) + (size_t)layer * D * D, T_L, D, D}; \
            pg8::StaticOrder S; S.init(T_L, D, C.G, C.bid); \
            if (layer == 0) { pg8::EpiOutRes<true> E{INP(0), INP(2), WSP(pg8::bf16_t, WS_XRES), WSP(const float, WS_MOD) + (size_t)layer * 9 * 6 * D}; \
                pg8::gemm_phase<pg8::EpiOutRes<true>, pg8::StaticOrder, true, true>(C.lds, g, S, E); } \
            else { pg8::EpiOutRes<false> E{WSP(const pg8::bf16_t, WS_XRES), WSP(const pg8::bf16_t, WS_XRES) + (size_t)T_L * D, WSP(pg8::bf16_t, WS_XRES), WSP(const float, WS_MOD) + (size_t)layer * 9 * 6 * D}; \
                pg8::gemm_phase<pg8::EpiOutRes<false>, pg8::StaticOrder, true, true>(C.lds, g, S, E); } \
            if (need_ctx) ph_outproj_ctx(C, layer); } SEAM(p0 + 5); \
        if (PHON(10) && IN(p0 + 6)) REP(10) { CTX(); ph_router(C, layer, ntok); } SEAM(p0 + 6); \
        if (PHON(11) && IN(p0 + 7)) REP(11) { CTX(); ph_slots(C, layer, ntok); } SEAM(p0 + 7); \
        if (PHON(12) && IN(p0 + 8)) REP(12) { CTX(); pg8::Gemm g{WSP(const pg8::bf16_t, WS_F), WSP(const pg8::bf16_t, WS_WUP) + (size_t)layer * NE * 2 * DE * D, P_ROWS, NE * 2 * DE, D, WSP(const int, WS_ROWMAP)}; \
            pg8::MoeOrder S; S.init(WSP(const int, WS_TEXP), 8, C.G, C.bid); pg8::EpiSwiglu E{WSP(pg8::bf16_t, WS_HID), INP(27) + (size_t)layer * NE * 2 * DE}; \
            pg8::gemm_phase<pg8::EpiSwiglu, pg8::MoeOrder, true, true, true>(C.lds, g, S, E); } SEAM(p0 + 8); \
        if (PHON(13) && IN(p0 + 9)) REP(13) { CTX(); pg8::Gemm g{WSP(const pg8::bf16_t, WS_HID), WSP(const pg8::bf16_t, WS_WDN) + (size_t)layer * NE * D * DE, P_ROWS, NE * D, DE}; \
            pg8::MoeOrder S; S.init(WSP(const int, WS_TEXP), 4, C.G, C.bid); pg8::EpiDown E{WSP(unsigned char, WS_YS), INP(29) + (size_t)layer * NE * D}; \
            pg8::gemm_phase<pg8::EpiDown, pg8::MoeOrder, true, true>(C.lds, g, S, E); } SEAM(p0 + 9); \
    }
    static_assert(DEPTH <= 4, "layer sites");
    if constexpr (DEPTH > 0) LAYER_BODY(0)
    if constexpr (DEPTH > 1) LAYER_BODY(1)
    if constexpr (DEPTH > 2) LAYER_BODY(2)
    if constexpr (DEPTH > 3) LAYER_BODY(3)
#undef LAYER_BODY
    if (PHON(1) && IN(N_PHASES - 1)) REP(16) { CTX(); ph_norm_mix(C, DEPTH); }
#undef IN
#undef SEAM
}

#ifndef EMU
#ifndef FULL_MASK_V
#define FULL_MASK_V 0x3fff
#endif
constexpr int FULL_MASK = FULL_MASK_V;
typedef void (*kern_t)(Args);
static int phase_mask(int p) {
    if (p == 0) return 1; if (p == N_PHASES - 1) return 2;
    const int k = (p - 1) % PH_PER_LAYER; const int m[10] = {2, 4, 8 | 32, 16 | 64 | 128, 256, 512, 1024, 2048, 4096, 8192}; return m[k];
}
static kern_t kern_of_mask(int m) {
    switch (m) {
#if MK_N_LAUNCHES == 1
        case FULL_MASK: return mk_fwd<FULL_MASK>;
#else
        case 1: return mk_fwd<1>; case 2: return mk_fwd<2>; case 4: return mk_fwd<4>; case 8: return mk_fwd<8>; case 16: return mk_fwd<16>; case 32: return mk_fwd<32>; case 192: return mk_fwd<192>; case 256: return mk_fwd<256>;
        case 512: return mk_fwd<512>; case 1024: return mk_fwd<1024>; case 2048: return mk_fwd<2048>; case 4096: return mk_fwd<4096>; case 8192: return mk_fwd<8192>;
#endif
        default: return nullptr;
    }
}
extern "C" void kernel_launch(void* const* d_in, const int* in_sizes, int n_in, void* d_out, int out_size, void* d_ws, size_t ws_size, hipStream_t stream) {
    static int grid = 0;
    if (grid == 0) {
        if (n_in != 31 || in_sizes[0] != T_L * D || out_size != T_L * D || ws_size < WS_END) { fprintf(stderr, "kernel_launch: shape/workspace mismatch (n_in %d, in0 %d, out %d, ws %zu, need %zu)\n", n_in, n_in > 0 ? in_sizes[0] : -1, out_size, ws_size, (size_t)WS_END); grid = -1; return; }
        int dev = 0, cus = 0;
        if (hipGetDevice(&dev) != hipSuccess || hipDeviceGetAttribute(&cus, hipDeviceAttributeMultiprocessorCount, dev) != hipSuccess) { grid = -1; return; }
#if MK_N_LAUNCHES == 1
        const int masks[1] = {FULL_MASK}; const int nm = 1;
#else
        const int masks[13] = {1, 2, 4, 8, 16, 32, 192, 256, 512, 1024, 2048, 4096, 8192}; const int nm = 13;
#endif
        for (int i = 0; i < nm; ++i) {
            if (hipFuncSetAttribute((const void*)kern_of_mask(masks[i]), hipFuncAttributeMaxDynamicSharedMemorySize, LDS_BYTES) != hipSuccess) { fprintf(stderr, "kernel_launch: hipFuncSetAttribute failed\n"); grid = -1; return; }
            int per_cu = 0;
            if (hipOccupancyMaxActiveBlocksPerMultiprocessor(&per_cu, (const void*)kern_of_mask(masks[i]), 512, LDS_BYTES) != hipSuccess || per_cu < 1) fprintf(stderr, "kernel_launch: occupancy query reports %d for mask %d\n", per_cu, masks[i]);
        }
        (void)hipGetLastError();
        grid = cus;
        if (grid > 1024) grid = 1024;
    }
    if (grid < 0) return;
    if (hipMemsetAsync((char*)d_ws + WS_CTL, 0, (CW_BAR + XCD_BAR_WORDS) * sizeof(unsigned), stream) != hipSuccess) return;
    Args a{};
    for (int i = 0; i < 31; ++i) a.in[i] = (const float*)d_in[i];
    a.out = (float*)d_out; a.ws = (unsigned char*)d_ws;
#if MK_N_LAUNCHES == 1
    a.ph_lo = 0; a.ph_hi = N_PHASES;
    hipLaunchKernelGGL(mk_fwd<FULL_MASK>, dim3(grid), dim3(512), LDS_BYTES, stream, a);
#else
    for (int p = 0; p < N_PHASES; ++p) { a.ph_lo = p; a.ph_hi = p + 1; const int pm = phase_mask(p);
        for (int bit = 0; bit < 14; ++bit) { int m = pm & (1 << bit); if (!m) continue; if (m == 64 || m == 128) { if (m == 128) continue; m = 192; } hipLaunchKernelGGL(kern_of_mask(m), dim3(grid), dim3(512), LDS_BYTES, stream, a); } }
#endif
}
#endif
```

```cpp
#ifndef EMU
#include <hip/hip_runtime.h>
#include <cstdio>
#include <cstdint>
#endif

#ifndef MK_N_LAUNCHES
#define MK_N_LAUNCHES 1
#endif

#ifndef CFG_BATCH
#define CFG_BATCH 8
#define CFG_SEQ 4096
#define CFG_CTX 256
#define CFG_DEPTH 4
#endif
constexpr int NB = CFG_BATCH, SEQ = CFG_SEQ, LC = CFG_CTX, DEPTH = CFG_DEPTH, D = 1024;
constexpr int GRID_W = 64;
constexpr int T_L = NB * SEQ, T_C = NB * LC, T_ALL = T_L + T_C;
constexpr int D_IN = 2832, N_PROJ = 2816;
constexpr int NKEY = SEQ + LC;
constexpr int NE = 32, TOPK = 4, DE = 1024;
constexpr int NCH_L = SEQ / 64, NCH_C = LC / 64, NCH = NCH_L + NCH_C;
constexpr int MAX_TILES = (T_ALL * TOPK) / 256 + NE;
constexpr int P_ROWS = MAX_TILES * 256;
constexpr float NORM_EPS = 1e-6f;
static_assert(SEQ % 256 == 0 && LC % 128 == 0 && T_ALL % 256 == 0 && (T_ALL * TOPK) % 256 == 0, "tiling");
constexpr int C_AQ = 0, C_AK = 256, C_AV = 384, C_BU = 512, C_BV = 768, C_CQ = 1024, C_CK = 1280, C_CV = 1536, C_DQKV = 1792, C_DZ = 2560, C_DB = 2816, C_DA = 2824;

#ifndef EMU
#define GAS __attribute__((address_space(1)))
#define LAS __attribute__((address_space(3)))
#define DEVI __device__ __forceinline__
#define LDS_WAIT() asm volatile("s_waitcnt lgkmcnt(0)" ::: "memory")
#define VM_WAIT() asm volatile("s_waitcnt vmcnt(0)" ::: "memory")
#define LAUNDER_V(x) asm volatile("" : "+v"(x))
#define LAUNDER_S(x) asm volatile("" : "+s"(x))
#endif
typedef unsigned short bf16;
typedef unsigned v4u __attribute__((ext_vector_type(4)));
typedef unsigned v2u __attribute__((ext_vector_type(2)));
typedef float f32x4 __attribute__((ext_vector_type(4)));
typedef float f32x2 __attribute__((ext_vector_type(2)));
typedef short bf16x8 __attribute__((ext_vector_type(8)));
typedef GAS unsigned gu32;
#define RLX_AGENT __ATOMIC_RELAXED, __HIP_MEMORY_SCOPE_AGENT
typedef __bf16 hbf2_t __attribute__((ext_vector_type(2)));
DEVI unsigned pk2(float lo, float hi) { const f32x2 v = {lo, hi}; return __builtin_bit_cast(unsigned, __builtin_convertvector(v, hbf2_t)); }
DEVI unsigned f2bf(float f) { return pk2(f, 0.f) & 0xffffu; }
DEVI float bf2f(unsigned h) { return __builtin_bit_cast(float, (h & 0xffffu) << 16); }
DEVI float bflo(unsigned w) { return __builtin_bit_cast(float, w << 16); }
DEVI float bfhi(unsigned w) { return __builtin_bit_cast(float, w & 0xffff0000u); }
DEVI float fast_exp(float x) { return __builtin_amdgcn_exp2f(x * 1.4426950408889634f); }
DEVI float fast_rcp(float x) { return __builtin_amdgcn_rcpf(x); }
DEVI float sigmoidf_(float x) { return fast_rcp(1.f + fast_exp(-x)); }
DEVI float siluf_(float x) { return x * sigmoidf_(x); }
DEVI float tanh_fast(float x) { const float e = fast_exp(-2.f * __builtin_fabsf(x)); const float t = (1.f - e) * fast_rcp(1.f + e); return x < 0.f ? -t : t; }
DEVI float gelu_tanh(float x) { return 0.5f * x * (1.f + tanh_fast(0.7978845608028654f * (x + 0.044715f * x * x * x))); }
DEVI float softplusf_(float x) { return x > 20.f ? x : __builtin_amdgcn_logf(1.f + fast_exp(x)) * 0.6931471805599453f; }
DEVI float wave_sum(float v) {
#pragma unroll
    for (int o = 1; o < 64; o <<= 1) v += __shfl_xor(v, o);
    return v;
}
template <int W> DEVI float group_sum(float v) {
#pragma unroll
    for (int o = 1; o < W; o <<= 1) v += __shfl_xor(v, o);
    return v;
}

constexpr size_t al256(size_t x) { return (x + 255) & ~(size_t)255; }
constexpr size_t WS_CTL = 0, CTL_ZERO_BYTES = 1u << 20;
constexpr size_t WS_MOD   = CTL_ZERO_BYTES;
constexpr size_t WS_WIN   = WS_MOD   + al256((size_t)DEPTH * 9 * 6 * D * 4);
constexpr size_t WS_WOUT  = WS_WIN   + al256((size_t)DEPTH * N_PROJ * D * 2);
constexpr size_t WS_WUP   = WS_WOUT  + al256((size_t)DEPTH * D * D * 2);
constexpr size_t WS_WDN   = WS_WUP   + al256((size_t)DEPTH * NE * 2 * DE * D * 2);
constexpr size_t WS_H     = WS_WDN   + al256((size_t)DEPTH * NE * D * DE * 2);
constexpr size_t WS_F     = WS_H     + al256((size_t)T_ALL * D * 2);
constexpr size_t WS_BA    = WS_F     + al256((size_t)T_ALL * D * 2);
constexpr size_t WS_PROJ  = WS_BA    + al256((size_t)T_ALL * 16 * 4);
constexpr size_t WS_XRES  = WS_PROJ  + al256((size_t)T_ALL * N_PROJ * 2);
constexpr size_t WS_MIX   = WS_XRES  + al256((size_t)T_ALL * D * 4);
constexpr size_t WS_QL    = WS_MIX   + al256((size_t)T_ALL * D * 2);
constexpr size_t WS_QC    = WS_QL    + al256((size_t)NB * 12 * SEQ * 64 * 2);
constexpr size_t WS_K     = WS_QC    + al256((size_t)NB * 12 * LC * 64 * 2);
constexpr size_t WS_V     = WS_K     + al256((size_t)NB * 6 * NKEY * 64 * 2);
constexpr size_t WS_OD    = WS_V     + al256((size_t)NB * 6 * NKEY * 64 * 2);
constexpr size_t WS_DNO   = WS_OD    + al256((size_t)2 * T_ALL * 256 * 2);
constexpr size_t WS_DNF   = WS_DNO   + al256((size_t)2 * T_ALL * 256 * 4);
constexpr size_t DN_UNIT_BYTES = 32768;
constexpr size_t WS_HID   = WS_DNF   + al256((size_t)NB * 2 * 4 * NCH * DN_UNIT_BYTES);
constexpr size_t WS_YS    = WS_HID   + al256((size_t)P_ROWS * DE * 2);
constexpr size_t WS_TOKE  = WS_YS    + al256((size_t)P_ROWS * D * 2);
constexpr size_t WS_TOKG  = WS_TOKE  + al256((size_t)T_ALL * 4 * 4);
constexpr size_t WS_TOKP  = WS_TOKG  + al256((size_t)T_ALL * 4 * 4);
constexpr size_t WS_SLOT  = WS_TOKP  + al256((size_t)T_ALL * 4 * 4);
constexpr size_t WS_BCNT  = WS_SLOT  + al256((size_t)T_ALL * 4 * 4);
constexpr size_t WS_TEXP  = WS_BCNT  + al256((size_t)1024 * 32 * 4);
constexpr size_t WS_RWP   = WS_TEXP  + al256((size_t)(MAX_TILES + 64) * 4);
constexpr size_t WS_RBP   = WS_RWP   + al256((size_t)DEPTH * 9 * NE * D * 4);
constexpr size_t WS_ROWMAP = WS_RBP  + al256((size_t)DEPTH * 9 * NE * 4);
constexpr size_t WS_ROPE  = WS_ROWMAP + al256((size_t)P_ROWS * 4);
constexpr size_t WS_END   = WS_ROPE  + al256((size_t)SEQ * 96 * 4);
constexpr int CW_TMO = 0, CW_CODE = 1, CW_BAR = 4096;
namespace pg8 {
#define PG8_LAS __attribute__((address_space(3)))
typedef unsigned short bf16_t;
typedef short bf16x8 __attribute__((ext_vector_type(8)));
typedef float f32x4 __attribute__((ext_vector_type(4)));
typedef unsigned u32x4 __attribute__((ext_vector_type(4)));
constexpr int BM = 256, BK = 64, HALF = 128, HTB = HALF * BK * 2  , STAGE_BYTES = 8 * HTB, NXCD = 8, WGM = 8;

__host__ __device__ __forceinline__ int lds_byte(int r, int c) { const int st = (r >> 4) * 2 + (c >> 5), rr = r & 15, cc = c & 31, ob = rr * 64 + cc * 2; return st * 1024 + (ob ^ (((ob >> 9) & 1) << 5)); }
__host__ __device__ __forceinline__ void stage_rc(int b, int& R, int& C) { const int st = b / 1024, sb = b % 1024, swz = sb ^ (((sb >> 9) & 1) << 5); R = (st >> 1) * 16 + swz / 64; C = (st & 1) * 32 + (swz % 64) / 2; }
__host__ __device__ __forceinline__ int perm32(int rho) { const int n = rho >> 4, i = rho & 15; return 8 * (i >> 2) + 4 * n + (i & 3); }

struct Unit { int pm, pn; };
struct Gemm { const bf16_t* A; const bf16_t* Bt; int M, N, K; const int* rowmap = nullptr; };

struct StaticOrder {
    int nM, nN, nwg, G, c;
    __host__ __device__ void init(int M, int N, int G_, int c_) { nM = M / BM; nN = N / BM; nwg = nM * nN; G = G_; c = c_; }
    __host__ __device__ bool next(int i, Unit& u) const {
        const long L = (long)i * G + c; if (L >= nwg) return false;
        int wgid = (int)L; { const int q = nwg / NXCD, r = nwg % NXCD, xcd = wgid % NXCD, off = wgid / NXCD; wgid = (xcd < r ? xcd * (q + 1) : r * (q + 1) + (xcd - r) * q) + off; }
        const int nig = WGM * nN, gid = wgid / nig, fm = gid * WGM, gsz = (nM - fm) < WGM ? (nM - fm) : WGM;
        u.pm = fm + ((wgid % nig) % gsz); u.pn = (wgid % nig) / gsz; return true;
    }
    __device__ __forceinline__ void a_ready(const Unit&) const {}
    __device__ __forceinline__ void done(const Unit&) const {}
};

#ifndef EMU
__device__ __forceinline__ unsigned cvt_pk_bf16(float lo, float hi) { unsigned r; asm volatile("v_cvt_pk_bf16_f32 %0, %1, %2" : "=v"(r) : "v"(lo), "v"(hi)); return r; }
#else
__device__ __forceinline__ unsigned cvt_pk_bf16(float lo, float hi) { return pk2(lo, hi); }
#endif
typedef float f32x2 __attribute__((ext_vector_type(2)));
__device__ __forceinline__ f32x2 gelu_pk(f32x2 v) {
    const f32x2 av = __builtin_elementwise_abs(v), d = av * 0.2316418882f + 1.0f;
    f32x2 t; t.x = __builtin_amdgcn_rcpf(d.x); t.y = __builtin_amdgcn_rcpf(d.y);
    f32x2 q = t * 0.5307027145f + (-0.7265760135f); q = q * t + 0.7107068705f; q = q * t + (-0.142248368f); q = q * t + 0.127414796f; q = q * t;
    const f32x2 s = (v * v) * (-0.72134752044f);
    f32x2 e; e.x = __builtin_amdgcn_exp2f(s.x); e.y = __builtin_amdgcn_exp2f(s.y);
    const f32x2 m = v * (q * e), r = v - m;
    f32x2 o; o.x = v.x < 0.f ? m.x : r.x; o.y = v.y < 0.f ? m.y : r.y; return o;
}

template <int ACT  > struct EpiBf16 {
    static constexpr bool PERM = true, AFTER_DRAIN = false; static_assert(ACT == 0 || ACT == 1, "EpiBf16: ACT is 0 (none) or 1 (gelu_pk)");
    bf16_t* O; int ldc; const float* bias; int split_cols; size_t split_stride; float scale0;
    __device__ __forceinline__ void operator()(const f32x4 (&acc)[2][2][4][2], const Unit& u, int wr, int wc, int fr, int fq) const {
        const int row0 = u.pm * BM + wr * 64 + fr; int colt = u.pn * BM; bf16_t* base = O;
        float sc = 1.f; if (split_cols) { const int t = colt / split_cols; base += (size_t)t * split_stride; colt -= t * split_cols; if (t == 0) sc = scale0; }
        const int col0 = colt + wc * 32 + 8 * fq, bcol0 = u.pn * BM + wc * 32 + 8 * fq;
        f32x4 bv[2][2];
#pragma unroll
        for (int bj = 0; bj < 2; ++bj)
#pragma unroll
            for (int n = 0; n < 2; ++n) bv[bj][n] = bias ? *(const f32x4*)(bias + bcol0 + bj * HALF + 4 * n) : (f32x4){0.f, 0.f, 0.f, 0.f};
#pragma unroll
        for (int ai = 0; ai < 2; ++ai)
#pragma unroll
            for (int m = 0; m < 4; ++m) { bf16_t* rowp = base + (size_t)(row0 + ai * HALF + m * 16) * ldc + col0;
#pragma unroll
                for (int bj = 0; bj < 2; ++bj) { f32x4 v0 = acc[ai][bj][m][0] + bv[bj][0], v1 = acc[ai][bj][m][1] + bv[bj][1];
                    if (ACT == 1) { f32x2 a = gelu_pk((f32x2){v0[0], v0[1]}), b = gelu_pk((f32x2){v0[2], v0[3]}), c = gelu_pk((f32x2){v1[0], v1[1]}), d = gelu_pk((f32x2){v1[2], v1[3]});
                        v0 = (f32x4){a.x, a.y, b.x, b.y}; v1 = (f32x4){c.x, c.y, d.x, d.y}; }
                    v0 = v0 * sc; v1 = v1 * sc; u32x4 w; w.x = cvt_pk_bf16(v0[0], v0[1]); w.y = cvt_pk_bf16(v0[2], v0[3]); w.z = cvt_pk_bf16(v1[0], v1[1]); w.w = cvt_pk_bf16(v1[2], v1[3]);
                    *(u32x4*)(rowp + bj * HALF) = w; } }
    }
};

template <bool IN_F32> struct EpiOutRes {
    static constexpr bool PERM = true, AFTER_DRAIN = false;
    const void* xin_l; const void* xin_c;
    bf16_t* xres; const float* mod;
    __device__ __forceinline__ void operator()(const f32x4 (&acc)[2][2][4][2], const Unit& u, int wr, int wc, int fr, int fq) const {
        const int rowt = u.pm * BM; const bool isc = rowt >= T_L; const int mrow = isc ? 8 : rowt / SEQ;
        const float* g = mod + (size_t)(mrow * 6 + 2) * D;
        const size_t inoff = isc ? (size_t)(rowt - T_L) * D : (size_t)rowt * D;
        const float* xf = (const float*)(isc ? xin_c : xin_l) + inoff; const bf16_t* xb = (const bf16_t*)(isc ? xin_c : xin_l) + inoff;
        bf16_t* xo = xres + (size_t)rowt * D;
        const int col0 = u.pn * BM + wc * 32 + 8 * fq;
        f32x4 gv[2][2];
#pragma unroll
        for (int bj = 0; bj < 2; ++bj)
#pragma unroll
            for (int n = 0; n < 2; ++n) gv[bj][n] = *(const f32x4*)(g + col0 + bj * HALF + 4 * n);
#pragma unroll
        for (int ai = 0; ai < 2; ++ai)
#pragma unroll
          for (int mp = 0; mp < 2; ++mp) {
            f32x4 xi[2][2][2];
#pragma unroll
            for (int m2 = 0; m2 < 2; ++m2) { const size_t ro = (size_t)(ai * HALF + wr * 64 + (2 * mp + m2) * 16 + fr) * D + col0;
#pragma unroll
                for (int bj = 0; bj < 2; ++bj) {
                    if constexpr (IN_F32) { xi[m2][bj][0] = *(const f32x4*)(xf + ro + bj * HALF); xi[m2][bj][1] = *(const f32x4*)(xf + ro + bj * HALF + 4); }
                    else { const u32x4 w = *(const u32x4*)(xb + ro + bj * HALF);
                        xi[m2][bj][0] = (f32x4){bflo(w.x), bfhi(w.x), bflo(w.y), bfhi(w.y)}; xi[m2][bj][1] = (f32x4){bflo(w.z), bfhi(w.z), bflo(w.w), bfhi(w.w)}; } } }
#pragma unroll
            for (int m2 = 0; m2 < 2; ++m2) { const int m = 2 * mp + m2; const size_t ro = (size_t)(ai * HALF + wr * 64 + m * 16 + fr) * D + col0;
#pragma unroll
                for (int bj = 0; bj < 2; ++bj) { const f32x4 v0 = xi[m2][bj][0] + gv[bj][0] * acc[ai][bj][m][0], v1 = xi[m2][bj][1] + gv[bj][1] * acc[ai][bj][m][1];
                    u32x4 w; w.x = cvt_pk_bf16(v0[0], v0[1]); w.y = cvt_pk_bf16(v0[2], v0[3]); w.z = cvt_pk_bf16(v1[0], v1[1]); w.w = cvt_pk_bf16(v1[2], v1[3]);
                    *(u32x4*)(xo + ro + bj * HALF) = w; } } }
    }
};
struct EpiSwiglu {
    static constexpr bool PERM = true, AFTER_DRAIN = false;
    bf16_t* hid; const float* bup;
    __device__ __forceinline__ void operator()(const f32x4 (&acc)[2][2][4][2], const Unit& u, int wr, int wc, int fr, int fq) const {
        const int e = u.pn >> 3, j = u.pn & 7; const int h0 = j * HALF + wc * 32 + 8 * fq;
        const float* bg = bup + (size_t)e * 2 * DE + h0; const float* bu = bg + DE;
        f32x4 vg[2], vu[2];
#pragma unroll
        for (int n = 0; n < 2; ++n) { vg[n] = *(const f32x4*)(bg + 4 * n); vu[n] = *(const f32x4*)(bu + 4 * n); }
#pragma unroll
        for (int ai = 0; ai < 2; ++ai)
#pragma unroll
            for (int m = 0; m < 4; ++m) { const size_t row = (size_t)u.pm * BM + ai * HALF + wr * 64 + m * 16 + fr; float o[8];
#pragma unroll
                for (int n = 0; n < 2; ++n) { const f32x4 gt = acc[ai][0][m][n] + vg[n], up = acc[ai][1][m][n] + vu[n];
#pragma unroll
                    for (int i = 0; i < 4; ++i) { const float gg = __builtin_fminf(gt[i], 7.0f); const float uu = __builtin_fminf(__builtin_fmaxf(up[i], -7.0f), 7.0f);
                        o[4 * n + i] = gg * sigmoidf_(1.702f * gg) * (uu + 1.0f); } }
                u32x4 w; w.x = cvt_pk_bf16(o[0], o[1]); w.y = cvt_pk_bf16(o[2], o[3]); w.z = cvt_pk_bf16(o[4], o[5]); w.w = cvt_pk_bf16(o[6], o[7]);
                *(u32x4*)(hid + row * DE + h0) = w; }
    }
};
struct EpiDown {
    static constexpr bool PERM = true, AFTER_DRAIN = false;
    unsigned char* ys; const float* bdn;
    __device__ __forceinline__ void operator()(const f32x4 (&acc)[2][2][4][2], const Unit& u, int wr, int wc, int fr, int fq) const {
        typedef unsigned u32x2v __attribute__((ext_vector_type(2)));
        const int e = u.pn >> 2, j = u.pn & 3; const int col0 = j * BM + wc * 32 + 8 * fq;
        f32x4 bv[2][2];
#pragma unroll
        for (int bj = 0; bj < 2; ++bj)
#pragma unroll
            for (int n = 0; n < 2; ++n) bv[bj][n] = *(const f32x4*)(bdn + (size_t)e * D + col0 + bj * HALF + 4 * n);
#pragma unroll
        for (int ai = 0; ai < 2; ++ai)
#pragma unroll
            for (int m = 0; m < 4; ++m) { const size_t row = (size_t)u.pm * BM + ai * HALF + wr * 64 + m * 16 + fr;
#pragma unroll
                for (int bj = 0; bj < 2; ++bj) { const f32x4 v0 = acc[ai][bj][m][0] + bv[bj][0], v1 = acc[ai][bj][m][1] + bv[bj][1];
                    int w0 = 0, w1 = 0;
                    w0 = __builtin_amdgcn_cvt_pk_fp8_f32(v0[0], v0[1], w0, false); w0 = __builtin_amdgcn_cvt_pk_fp8_f32(v0[2], v0[3], w0, true);
                    w1 = __builtin_amdgcn_cvt_pk_fp8_f32(v1[0], v1[1], w1, false); w1 = __builtin_amdgcn_cvt_pk_fp8_f32(v1[2], v1[3], w1, true);
                    *(u32x2v*)(ys + row * D + col0 + bj * HALF) = (u32x2v){(unsigned)w0, (unsigned)w1}; } }
    }
};
struct MoeOrder {
    const int* texp; int ntiles, nN, nwg, G, c;
    __device__ __forceinline__ void init(const int* texp_, int nN_, int G_, int c_) { texp = texp_; ntiles = texp_[0]; nN = nN_; nwg = ntiles * nN_; G = G_; c = c_; }
    __device__ __forceinline__ bool next(int i, Unit& u) const {
        const long L = (long)i * G + c; if (L >= nwg) return false;
        int wgid = (int)L; { const int q = nwg / NXCD, r = nwg % NXCD, xcd = wgid % NXCD, off = wgid / NXCD; wgid = (xcd < r ? xcd * (q + 1) : r * (q + 1) + (xcd - r) * q) + off; }
        const int nig = WGM * nN, gid = wgid / nig, fm = gid * WGM, gsz = (ntiles - fm) < WGM ? (ntiles - fm) : WGM;
        const int pm = fm + ((wgid % nig) % gsz); u.pm = pm; u.pn = texp[1 + pm] * nN + (wgid % nig) / gsz; return true;
    }
    __device__ __forceinline__ void a_ready(const Unit&) const {}
    __device__ __forceinline__ void done(const Unit&) const {}
};
#ifndef EMU
template <class Epi, class Sched, bool ALIGN_EPI = false, bool SP2 = false, bool GATHER = false>
__device__ __forceinline__ void gemm_phase(PG8_LAS unsigned char* lds, const Gemm g, const Sched& S, const Epi& E) {
    int tid_ = threadIdx.x; asm volatile("" : "+v"(tid_));
    const int tid = tid_, wid = __builtin_amdgcn_readfirstlane(tid >> 6), lane = tid & 63, wr = wid >> 2, wc = wid & 3, fr = lane & 15, fq = lane >> 4;
    const int K = g.K, nt = K / BK;
    unsigned voffA[2], voffB[2]; int gR[2], gC[2];
#pragma unroll
    for (int i = 0; i < 2; ++i) { int R, C; stage_rc(tid * 16 + i * 8192, R, C); const int Rb = Epi::PERM ? ((R & ~31) + perm32(R & 31)) : R;
        voffA[i] = (unsigned)(R * K + C) * 2u; voffB[i] = (unsigned)(Rb * K + C) * 2u; gR[i] = R; gC[i] = C; }
    unsigned voffC[2][2], voffN[2][2];
#define PG8_GOFF(dst, pm_) do { _Pragma("unroll") for (int h_ = 0; h_ < 2; ++h_) _Pragma("unroll") for (int i_ = 0; i_ < 2; ++i_) \
        dst[h_][i_] = (unsigned)(g.rowmap[(size_t)(pm_) * BM + h_ * HALF + gR[i_]] * K + gC[i_]) * 2u; } while (0)
    const size_t kstep = (size_t)(BK * 2);
    const size_t hstep = (size_t)HALF * K * 2;
    const size_t tstep = 2 * hstep;
    const unsigned ldsw = (unsigned)wid * 1024u;
    const int aoff = lds_byte(wr * 64 + fr, fq * 8), boff = lds_byte(wc * 32 + fr, fq * 8);
#define PG8_SA(b, h) (((b) * 2 + (h)) * HTB)
#define PG8_SB(b, h) ((4 + (b) * 2 + (h)) * HTB)
#define PG8_STAGE(bufoff, gbase, voff) do { _Pragma("unroll") for (int _i = 0; _i < 2; ++_i) \
        __builtin_amdgcn_global_load_lds((const unsigned*)((const char*)(gbase) + (voff)[_i]), (PG8_LAS unsigned*)(lds + (bufoff) + ldsw + _i * 8192), 16, 0, 0); } while (0)
#define PG8_LDA(dst, b, h) do { _Pragma("unroll") for (int m = 0; m < 4; ++m) _Pragma("unroll") for (int k = 0; k < 2; ++k) dst[m][k] = *(const PG8_LAS bf16x8*)(lds + PG8_SA(b, h) + aoff + m * 2048 + k * 1024); } while (0)
#define PG8_LDB(dst, b, h) do { _Pragma("unroll") for (int n = 0; n < 2; ++n) _Pragma("unroll") for (int k = 0; k < 2; ++k) dst[n][k] = *(const PG8_LAS bf16x8*)(lds + PG8_SB(b, h) + boff + n * 2048 + k * 1024); } while (0)
#define PG8_MMA(ai, bj, At, Bt) do { __builtin_amdgcn_s_setprio(1); _Pragma("unroll") for (int m = 0; m < 4; ++m) _Pragma("unroll") for (int n = 0; n < 2; ++n) _Pragma("unroll") for (int k = 0; k < 2; ++k) \
        acc[ai][bj][m][n] = __builtin_amdgcn_mfma_f32_16x16x32_bf16(Bt[n][k], At[m][k], acc[ai][bj][m][n], 0, 0, 0); __builtin_amdgcn_s_setprio(0); } while (0)
#define PG8_WAIT_V(n) asm volatile("s_waitcnt vmcnt(" #n ")" ::: "memory")
#define PG8_WAIT_L(n) asm volatile("s_waitcnt lgkmcnt(" #n ")" ::: "memory")
#define PG8_BAR __builtin_amdgcn_s_barrier()
#define PG8_SCHED __builtin_amdgcn_sched_barrier(0)
#define PG8_STAGEA(bufoff, gbase, h, nx) do { if constexpr (GATHER) { _Pragma("unroll") for (int _i = 0; _i < 2; ++_i) { const unsigned o_ = (nx) ? voffN[h][_i] : voffC[h][_i]; \
        __builtin_amdgcn_global_load_lds((const unsigned*)((const char*)(gbase) + o_), (PG8_LAS unsigned*)(lds + (bufoff) + ldsw + _i * 8192), 16, 0, 0); } } \
    else { PG8_STAGE(bufoff, (gbase) + (h) * hstep, voffA); } } while (0)
    Unit cur, nxt; int ui = 0;
    if (!S.next(0, cur)) return;
    f32x4 acc[2][2][4][2];
#pragma unroll
    for (int a = 0; a < 2; ++a)
#pragma unroll
        for (int b = 0; b < 2; ++b)
#pragma unroll
            for (int m = 0; m < 4; ++m)
#pragma unroll
                for (int n = 0; n < 2; ++n) acc[a][b][m][n] = (f32x4){0.f, 0.f, 0.f, 0.f};
    bf16x8 At[4][2], B0[2][2], B1[2][2];
    const char* cA = (const char*)g.A + (GATHER ? (size_t)0 : (size_t)cur.pm * tstep); if constexpr (GATHER) { PG8_GOFF(voffC, cur.pm); }
    const char* cB = (const char*)g.Bt + (size_t)cur.pn * tstep;
    S.a_ready(cur);
    if constexpr (SP2) {
        PG8_STAGE(PG8_SB(0, 0), cB, voffB); PG8_STAGE(PG8_SB(0, 1), cB + hstep, voffB); PG8_STAGEA(PG8_SA(0, 0), cA, 0, false); PG8_STAGEA(PG8_SA(0, 1), cA, 1, false);
        if (wr == 1) PG8_BAR;
        PG8_WAIT_V(2); PG8_BAR;
        PG8_STAGE(PG8_SB(1, 0), cB + kstep, voffB); PG8_STAGEA(PG8_SA(1, 0), cA + kstep, 0, false); PG8_STAGE(PG8_SB(1, 1), cB + hstep + kstep, voffB);
        PG8_WAIT_V(6); PG8_BAR;
    } else {
        PG8_STAGE(PG8_SB(0, 0), cB, voffB); PG8_STAGEA(PG8_SA(0, 0), cA, 0, false); PG8_STAGE(PG8_SB(0, 1), cB + hstep, voffB); PG8_STAGEA(PG8_SA(0, 1), cA, 1, false);
        if (wr == 1) PG8_BAR;
        PG8_WAIT_V(4); PG8_BAR;
        PG8_STAGE(PG8_SB(1, 0), cB + kstep, voffB); PG8_STAGEA(PG8_SA(1, 0), cA + kstep, 0, false); PG8_STAGE(PG8_SB(1, 1), cB + hstep + kstep, voffB);
        PG8_WAIT_V(6); PG8_BAR;
    }
    for (;;) {
        const bool has_next = S.next(ui + 1, nxt);
        if constexpr (GATHER) { if (has_next) { PG8_GOFF(voffN, nxt.pm); } else { _Pragma("unroll") for (int h_ = 0; h_ < 2; ++h_) _Pragma("unroll") for (int i_ = 0; i_ < 2; ++i_) voffN[h_][i_] = voffC[h_][i_]; } }
        const char* nA = (has_next && !GATHER) ? (const char*)g.A + (size_t)nxt.pm * tstep : cA; const char* nB = has_next ? (const char*)g.Bt + (size_t)nxt.pn * tstep : cB;
        for (int t = 0; t < nt; t += 2) {
            const bool last = (t == nt - 2);
            const char* a1 = cA + (size_t)(t + 1) * kstep;
            const char* a2 = last ? nA : cA + (size_t)(t + 2) * kstep; const char* b2 = last ? nB : cB + (size_t)(t + 2) * kstep;
            const char* a3 = a2 + kstep; const char* b3 = b2 + kstep;
            if (last && has_next) S.a_ready(nxt);
            if constexpr (SP2) {
            PG8_LDB(B0, 0, 0); PG8_LDB(B1, 0, 1); PG8_SCHED; PG8_LDA(At, 0, 0); PG8_STAGEA(PG8_SA(1, 1), a1, 1, false);
            PG8_WAIT_V(8); PG8_WAIT_L(0); PG8_BAR; PG8_MMA(0, 0, At, B0); PG8_MMA(0, 1, At, B1); PG8_BAR; PG8_SCHED;
            PG8_LDA(At, 0, 1); PG8_STAGE(PG8_SB(0, 0), b2, voffB); PG8_STAGE(PG8_SB(0, 1), b2 + hstep, voffB); PG8_STAGEA(PG8_SA(0, 0), a2, 0, last);
            PG8_WAIT_V(8); PG8_WAIT_L(0); PG8_BAR; PG8_MMA(1, 0, At, B0); PG8_MMA(1, 1, At, B1); PG8_BAR; PG8_SCHED;
            PG8_LDB(B0, 1, 0); PG8_LDB(B1, 1, 1); PG8_SCHED; PG8_LDA(At, 1, 0); PG8_STAGEA(PG8_SA(0, 1), a2, 1, last);
            PG8_WAIT_V(8); PG8_WAIT_L(0); PG8_BAR; PG8_MMA(0, 0, At, B0); PG8_MMA(0, 1, At, B1); PG8_BAR; PG8_SCHED;
            PG8_LDA(At, 1, 1); PG8_STAGE(PG8_SB(1, 0), b3, voffB); PG8_STAGE(PG8_SB(1, 1), b3 + hstep, voffB); PG8_STAGEA(PG8_SA(1, 0), a3, 0, last);
            PG8_WAIT_V(8); PG8_WAIT_L(0); PG8_BAR; PG8_MMA(1, 0, At, B0); PG8_MMA(1, 1, At, B1); PG8_BAR; PG8_SCHED;
            } else {
            PG8_LDB(B0, 0, 0); PG8_SCHED; PG8_LDA(At, 0, 0); PG8_STAGEA(PG8_SA(1, 1), a1, 1, false);
            PG8_WAIT_L(8); PG8_BAR; PG8_WAIT_L(0); PG8_MMA(0, 0, At, B0); PG8_BAR; PG8_SCHED;
            PG8_LDB(B1, 0, 1); PG8_STAGE(PG8_SB(0, 0), b2, voffB);
            PG8_BAR; PG8_WAIT_L(0); PG8_MMA(0, 1, At, B1); PG8_BAR;
            PG8_LDA(At, 0, 1); PG8_STAGEA(PG8_SA(0, 0), a2, 0, last);
            PG8_BAR; PG8_WAIT_L(0); PG8_MMA(1, 0, At, B0); PG8_BAR; PG8_SCHED;
            PG8_STAGE(PG8_SB(0, 1), b2 + hstep, voffB);
            PG8_WAIT_V(6); PG8_BAR; PG8_MMA(1, 1, At, B1); PG8_BAR;
            PG8_LDB(B0, 1, 0); PG8_SCHED; PG8_LDA(At, 1, 0); PG8_STAGEA(PG8_SA(0, 1), a2, 1, last);
            PG8_WAIT_L(8); PG8_BAR; PG8_WAIT_L(0); PG8_MMA(0, 0, At, B0); PG8_BAR; PG8_SCHED;
            PG8_LDB(B1, 1, 1); PG8_STAGE(PG8_SB(1, 0), b3, voffB);
            PG8_BAR; PG8_WAIT_L(0); PG8_MMA(0, 1, At, B1); PG8_BAR;
            PG8_LDA(At, 1, 1); PG8_STAGEA(PG8_SA(1, 0), a3, 0, last);
            PG8_BAR; PG8_WAIT_L(0); PG8_MMA(1, 0, At, B0); PG8_BAR; PG8_SCHED;
            PG8_STAGE(PG8_SB(1, 1), b3 + hstep, voffB);
            PG8_WAIT_V(6); PG8_BAR; PG8_MMA(1, 1, At, B1); PG8_BAR;
            }
        }
        if constexpr (ALIGN_EPI) { if (wr == 0) PG8_BAR; }
        if constexpr (!Epi::AFTER_DRAIN) { E(acc, cur, wr, wc, fr, fq); S.done(cur); }
        if (!has_next) break;
#pragma unroll
        for (int a = 0; a < 2; ++a)
#pragma unroll
            for (int b = 0; b < 2; ++b)
#pragma unroll
                for (int m = 0; m < 4; ++m)
#pragma unroll
                    for (int n = 0; n < 2; ++n) acc[a][b][m][n] = (f32x4){0.f, 0.f, 0.f, 0.f};
        cur = nxt; cA = nA; cB = nB; ++ui;
        if constexpr (GATHER) { _Pragma("unroll") for (int h_ = 0; h_ < 2; ++h_) _Pragma("unroll") for (int i_ = 0; i_ < 2; ++i_) voffC[h_][i_] = voffN[h_][i_]; }
        if constexpr (ALIGN_EPI) { if (wr == 1) PG8_BAR; }
    }
    PG8_WAIT_V(0);
    if constexpr (!ALIGN_EPI) { if (wr == 0) PG8_BAR; }
    PG8_BAR;
    if constexpr (Epi::AFTER_DRAIN) { E.fused(acc, cur, wr, wc, fr, fq, lds, wid, lane); S.done(cur); }
#undef PG8_SA
#undef PG8_SB
#undef PG8_STAGE
#undef PG8_STAGEA
#undef PG8_GOFF
#undef PG8_LDA
#undef PG8_LDB
#undef PG8_MMA
#undef PG8_WAIT_V
#undef PG8_WAIT_L
#undef PG8_BAR
#undef PG8_SCHED
}
#else
EMU_GEMM_PHASE
#endif
}
#ifndef EMU
namespace attn_body {
using bf16=unsigned short;
using bf16x8=__attribute__((ext_vector_type(8)))short;
using s16x4=__attribute__((ext_vector_type(4)))short;
using f32x16=__attribute__((ext_vector_type(16)))float;
using u32x4=__attribute__((ext_vector_type(4)))unsigned;
constexpr int D=64,DM=64;
constexpr int NW=8,QBLK=32,QB=QBLK*NW,KVBLK=64;
__device__ __forceinline__ int crow(int r,int hi){return (r&3)+8*(r>>2)+4*hi;}
#define SBAR() __builtin_amdgcn_sched_barrier(0)
constexpr int NSLOT=3, SLOTB=8192;
constexpr int LDS_K=0, LDS_V=NSLOT*SLOTB, LDS_WS=2*NSLOT*SLOTB, LDS_OST=LDS_WS+NW*64*4, LDS_BYTES=LDS_OST+NW*4096;
__device__ __forceinline__ void glds16(const void*gsrc,unsigned lds_dst){unsigned keep;
  asm volatile("s_mov_b32 %0, m0\n\ts_mov_b32 m0, %2\n\ts_nop 0\n\tglobal_load_lds_dwordx4 %1, off\n\ts_mov_b32 m0, %0":"=&s"(keep):"v"(gsrc),"s"(lds_dst):"memory");}
__device__ __forceinline__ float max3f(float a,float b,float c){float r;asm("v_max3_f32 %0, %1, %2, %3":"=v"(r):"v"(a),"v"(b),"v"(c));return r;}
__device__ __forceinline__ float max2f(float a,float b){float r;asm("v_max_f32_e32 %0, %1, %2":"=v"(r):"v"(a),"v"(b));return r;}
__device__ __forceinline__ float fadd_s(float a,float b){float r;asm("v_add_f32_e32 %0, %1, %2":"=v"(r):"v"(a),"v"(b));return r;}
__device__ __forceinline__ float fsub_s(float a,float b){float r;asm("v_sub_f32_e32 %0, %1, %2":"=v"(r):"v"(a),"v"(b));return r;}
typedef float f32x2_t __attribute__((ext_vector_type(2))); typedef __bf16 bf16x2_t __attribute__((ext_vector_type(2)));
__device__ __forceinline__ unsigned cvtpk_s(float lo,float hi){f32x2_t v={lo,hi};bf16x2_t b=__builtin_convertvector(v,bf16x2_t);return __builtin_bit_cast(unsigned,b);}
#define WAIT_BAR(N) asm volatile("s_waitcnt vmcnt(" #N ") lgkmcnt(0)\n\ts_barrier":::"memory")

template<int MODE> __device__ __forceinline__ constexpr bool d0_on(int d0){ return MODE==0 || (MODE==1 && d0<2) || (MODE==2 && d0>=2); }
template<int MODE> __device__ __forceinline__ void qkt(f32x16&p0,f32x16&p1,const char*Kslot,const bf16x8*qr,const f32x16&negm,int r32,int hi){
  const char*kb=Kslot+hi*1024+r32*16;
  constexpr int D0A=(MODE==2)?2:0, D0B=(MODE==1)?2:4;
  #pragma unroll
  for(int d0=D0A;d0<D0B;++d0){
    const bf16x8 b0=*reinterpret_cast<const bf16x8*>(kb+d0*2048);
    const bf16x8 b1=*reinterpret_cast<const bf16x8*>(kb+d0*2048+512);
    if(d0==D0A){p0=__builtin_amdgcn_mfma_f32_32x32x16_bf16(b0,qr[d0],negm,0,0,0);p1=__builtin_amdgcn_mfma_f32_32x32x16_bf16(b1,qr[d0],negm,0,0,0);}
    else{p0=__builtin_amdgcn_mfma_f32_32x32x16_bf16(b0,qr[d0],p0,0,0,0);p1=__builtin_amdgcn_mfma_f32_32x32x16_bf16(b1,qr[d0],p1,0,0,0);}}
}
template<int MODE,int IDX> __device__ __forceinline__ void qk_mf(f32x16&Cx,const bf16x8&k,const bf16x8&q,const f32x16&negm){
  if constexpr(d0_on<MODE>(IDX>>1)){ constexpr bool first=((IDX>>1)==((MODE==2)?2:0));
    if constexpr(first) Cx=__builtin_amdgcn_mfma_f32_32x32x16_bf16(k,q,negm,0,0,0); else Cx=__builtin_amdgcn_mfma_f32_32x32x16_bf16(k,q,Cx,0,0,0); }
}
typedef __attribute__((address_space(3))) const char* lds_cptr;
typedef short v4i16_t __attribute__((ext_vector_type(4)));
template<int MODE> __device__ __forceinline__ void kload8(bf16x8*kf,lds_cptr kp){
  #pragma unroll
  for(int j=0;j<4;++j) if(d0_on<MODE>(j)){ kf[2*j]=*(const __attribute__((address_space(3))) bf16x8*)(kp+j*2048); kf[2*j+1]=*(const __attribute__((address_space(3))) bf16x8*)(kp+j*2048+512); }
}
__device__ __forceinline__ void kload2(bf16x8*kf,lds_cptr kp,int j){ kf[2*j]=*(const __attribute__((address_space(3))) bf16x8*)(kp+j*2048); kf[2*j+1]=*(const __attribute__((address_space(3))) bf16x8*)(kp+j*2048+512); }
__device__ __forceinline__ s16x4 vtr(lds_cptr p){ return __builtin_bit_cast(s16x4,__builtin_amdgcn_ds_read_tr16_b64_v4i16((__attribute__((address_space(3))) v4i16_t*)p)); }
__device__ __forceinline__ float rowmax(const f32x16&p0,const f32x16&p1){
  float a=max3f(p0[0],p0[1],p1[0]),b=max3f(p0[2],p0[3],p1[1]);a=max3f(a,p1[2],p1[3]);
  #pragma unroll
  for(int r=4;r<16;r+=4){a=max3f(a,p0[r],p0[r+1]);b=max3f(b,p0[r+2],p0[r+3]);a=max3f(a,p1[r],p1[r+1]);b=max3f(b,p1[r+2],p1[r+3]);}
  const float m=max2f(a,b);
  auto rr=__builtin_amdgcn_permlane32_swap(__float_as_uint(m),__float_as_uint(m),false,false);
  return max2f(__uint_as_float(rr[0]),__uint_as_float(rr[1]));
}
__device__ __forceinline__ void pv(f32x16*o,int vb,bf16x8 pa0,bf16x8 pa1,bf16x8 pa2,bf16x8 pa3){
  #pragma unroll
  for(int d0=0;d0<2;++d0){s16x4 lo[4],hi[4];
    #pragma unroll
    for(int ks=0;ks<4;++ks){
      asm volatile("ds_read_b64_tr_b16 %0,%1 offset:%c2":"=&v"(lo[ks]):"v"(vb),"i"(d0*4096+ks*1024):"memory");
      asm volatile("ds_read_b64_tr_b16 %0,%1 offset:%c2":"=&v"(hi[ks]):"v"(vb),"i"(d0*4096+ks*1024+512):"memory");}
    asm volatile("s_waitcnt lgkmcnt(0)":::"memory");SBAR();
    #define PK(k) (bf16x8){lo[k][0],lo[k][1],lo[k][2],lo[k][3],hi[k][0],hi[k][1],hi[k][2],hi[k][3]}
    o[d0]=__builtin_amdgcn_mfma_f32_32x32x16_bf16(pa0,PK(0),o[d0],0,0,0);
    o[d0]=__builtin_amdgcn_mfma_f32_32x32x16_bf16(pa1,PK(1),o[d0],0,0,0);
    o[d0]=__builtin_amdgcn_mfma_f32_32x32x16_bf16(pa2,PK(2),o[d0],0,0,0);
    o[d0]=__builtin_amdgcn_mfma_f32_32x32x16_bf16(pa3,PK(3),o[d0],0,0,0);
    #undef PK
  }
}

#ifndef ATTN_STORE16
#define ATTN_STORE16(p,v) (*(u32x4*)(p)=(v))
#endif
template<int THRL,int MODE> __device__ __forceinline__ void attn_unit(const bf16*Qa,const bf16*Qb,const bf16*__restrict__ Kh,const bf16*__restrict__ Vh,bf16*Oa,bf16*Ob,int opitch,int NT,char*shm,float lam,float post,const float*subln){
  int tid_=threadIdx.x; asm volatile("":"+v"(tid_)); const int tid=tid_,lane=tid&63,r32=lane&31,hi=lane>>5; const int wid=__builtin_amdgcn_readfirstlane(tid>>6);
  const bf16*Qw=(wid<4?Qa:Qb)+(long)((wid&3)*QBLK)*DM;
  const unsigned lds0=(unsigned)(uintptr_t)shm;
  float*wsf=(float*)(shm+LDS_WS)+wid*64;
  const bf16*ksrc=Kh+(long)lane*DM+wid*8;
  const bf16*vsrc=Vh+(long)(16*(wid&3)+(lane>>2))*DM+(wid>>2)*32+(lane&3)*8;
  const unsigned kdst=lds0+LDS_K+wid*1024, vdst=lds0+LDS_V+wid*1024;
  #define DMA_K(t,slot) glds16(ksrc+(long)(t)*KVBLK*DM,(unsigned)__builtin_amdgcn_readfirstlane(kdst+(slot)))
  #define DMA_V(t,slot) glds16(vsrc+(long)(t)*KVBLK*DM,(unsigned)__builtin_amdgcn_readfirstlane(vdst+(slot)))
  const int vb0=(int)(lds0+LDS_V)+((lane>>4)&1)*32+(lane&3)*8+(4*hi+((lane&15)>>2))*64;
  const char*Kbase=shm+LDS_K; bf16x8 kf[8];
  const lds_cptr shm3=(lds_cptr)shm; const lds_cptr kp0=shm3+LDS_K+hi*1024+r32*16; const lds_cptr vp0=shm3+LDS_V+((lane>>4)&1)*32+(lane&3)*8+(4*hi+((lane&15)>>2))*64;
  DMA_K(0,0);DMA_V(0,0);DMA_K(1,SLOTB);
  bf16x8 qr[4];
  #pragma unroll
  for(int d0=0;d0<4;++d0)qr[d0]=*reinterpret_cast<const bf16x8*>(&Qw[(long)r32*DM+d0*16+hi*8]);
  float mhat=0.f,l_reg=0.f;f32x16 o[2];o[0]=f32x16{};o[1]=f32x16{};f32x16 negm=f32x16{};asm volatile("":"+v"(negm));
  #define CMASK(P0,P1,t) do{}while(0)
  bool resc=false;
  #define START(P0,P1) do{ const float rm=rowmax(P0,P1); resc=false; \
    { const float dl=rm; mhat=fadd_s(mhat,dl); \
      _Pragma("unroll") for(int r=0;r<16;++r){P0[r]=fsub_s(P0[r],dl);P1[r]=fsub_s(P1[r],dl);} \
      _Pragma("unroll") for(int r=0;r<16;++r)negm[r]=-mhat; asm volatile("":"+v"(negm)); } \
    _Pragma("unroll") for(int r=0;r<16;++r)P0[r]=__builtin_amdgcn_exp2f(P0[r]); }while(0)
  #define RESC() do{ if(resc){ asm volatile("s_waitcnt lgkmcnt(0)":::"memory"); \
      _Pragma("unroll") for(int d_=0;d_<2;++d_) _Pragma("unroll") for(int r=0;r<16;++r)o[d_][r]*=wsf[crow(r,hi)]; } }while(0)
  f32x16 pA0,pA1,pB0,pB1;
  int sl_prev=0,sl_cur=0,sl_next=SLOTB;
  #define ROT() do{sl_prev=sl_cur;sl_cur=sl_next;sl_next=(sl_next==(NSLOT-1)*SLOTB)?0:sl_next+SLOTB;}while(0)
  DMA_K(2,2*SLOTB);
  WAIT_BAR(3);
  qkt<MODE>(pA0,pA1,Kbase,qr,negm,r32,hi);asm volatile("s_nop 15\n\ts_nop 7":"+v"(pA0),"+v"(pA1));CMASK(pA0,pA1,0);
  START(pA0,pA1);
  _Pragma("unroll") for(int r=0;r<16;++r)pA1[r]=__builtin_amdgcn_exp2f(pA1[r]);
  WAIT_BAR(0);
  DMA_K(3,0);DMA_V(1,SLOTB);
  ROT();
  kload8<MODE>(kf,kp0+sl_cur);
  WAIT_BAR(2);
  s16x4 vlo[8],vhi[8]; u32x4 pw0,pw1,pw2,pw3;
  #define PKW(P,B) cvtpk_s(P[B],P[B+1])
  #define PAF(k) __builtin_bit_cast(bf16x8,pw##k)
  #define VFR(i) (bf16x8){vlo[i][0],vlo[i][1],vlo[i][2],vlo[i][3],vhi[i][0],vhi[i][1],vhi[i][2],vhi[i][3]}
  #define PIN(x) asm volatile("":"+v"(x))
  #define MX3(a,b,c) __builtin_fmaxf(__builtin_fmaxf((a),(b)),(c))
  #define GAPA(MF,A0,A1,A2,A3,W0,W1,PW) do{ MF; sacc+=A0; sacc+=A1; sacc+=A2; sacc+=A3; PIN(sacc); W0; W1; PIN(PW); SBAR(); }while(0)
  #define EX(v) __builtin_amdgcn_exp2f(v)
  #define GAPB(MF,X,B) do{ MF; X[B]=EX(X[B]); X[B+1]=EX(X[B+1]); X[B+2]=EX(X[B+2]); X[B+3]=EX(X[B+3]); PIN(X); SBAR(); }while(0)
  #define VRD(i) do{ vlo[i]=vtr(vp_+(((i)>>2)*4096+((i)&3)*1024)); vhi[i]=vtr(vp_+(((i)>>2)*4096+((i)&3)*1024+512)); }while(0)
  #define KRD(G,j) do{ if((G)&&d0_on<MODE>(j)){ kload2(kf,kp0+sl_next,j); SBAR(); } }while(0)
  #define STEP(C0,C1,P0,P1,t,GK,GV,GL) do{ SBAR(); \
    const lds_cptr vp_=vp0+sl_prev; \
    VRD(0); SBAR(); float sacc=(P0[0]+P0[1]); \
    GAPA((qk_mf<MODE,0>(C0,kf[0],qr[0],negm)), P0[2],P0[3],P0[4],P0[5],     pw0[0]=PKW(P0,0), pw0[1]=PKW(P0,2), pw0); \
    VRD(4); SBAR(); GAPA((qk_mf<MODE,1>(C1,kf[1],qr[0],negm)), P0[6],P0[7],P0[8],P0[9],     pw0[2]=PKW(P0,4), pw0[3]=PKW(P0,6), pw0); \
    VRD(1); SBAR(); GAPA((qk_mf<MODE,2>(C0,kf[2],qr[1],negm)),   P0[10],P0[11],P0[12],P0[13], pw1[0]=PKW(P0,8), pw1[1]=PKW(P0,10), pw1); \
    VRD(5); SBAR(); GAPA((qk_mf<MODE,3>(C1,kf[3],qr[1],negm)),   P0[14],P0[15],P1[0],P1[1],   pw1[2]=PKW(P0,12),pw1[3]=PKW(P0,14), pw1); \
    VRD(2); SBAR(); GAPA((qk_mf<MODE,4>(C0,kf[4],qr[2],negm)),   P1[2],P1[3],P1[4],P1[5],     pw2[0]=PKW(P1,0), pw2[1]=PKW(P1,2), pw2); \
    VRD(6); SBAR(); GAPA((qk_mf<MODE,5>(C1,kf[5],qr[2],negm)),   P1[6],P1[7],P1[8],P1[9],     pw2[2]=PKW(P1,4), pw2[3]=PKW(P1,6), pw2); \
    VRD(3); SBAR(); GAPA((qk_mf<MODE,6>(C0,kf[6],qr[3],negm)),   P1[10],P1[11],P1[12],P1[13], pw3[0]=PKW(P1,8), pw3[1]=PKW(P1,10), pw3); \
    VRD(7); SBAR(); GAPA((qk_mf<MODE,7>(C1,kf[7],qr[3],negm)),   P1[14],P1[15],0.f,0.f,       pw3[2]=PKW(P1,12),pw3[3]=PKW(P1,14), pw3); \
    l_reg+=sacc; \
    if(GK){DMA_K((t)+3,sl_cur);} if(GV){DMA_V((t)+1,sl_next);} \
    CMASK(C0,C1,t); \
    { float a=MX3(C0[0],C0[1],C1[0]),b=MX3(C0[2],C0[3],C1[1]); a=MX3(a,C1[2],C1[3]); \
      _Pragma("unroll") for(int r=4;r<16;r+=4){a=MX3(a,C0[r],C0[r+1]);b=MX3(b,C0[r+2],C0[r+3]);a=MX3(a,C1[r],C1[r+1]);b=MX3(b,C1[r+2],C1[r+3]);} \
      float rm=__builtin_fmaxf(a,b); { auto rr=__builtin_amdgcn_permlane32_swap(__float_as_uint(rm),__float_as_uint(rm),false,false); rm=__builtin_fmaxf(__uint_as_float(rr[0]),__uint_as_float(rr[1])); } \
      resc=false; \
      if(__builtin_expect(__any(rm>(float)THRL),0)){ const float dl=__builtin_fmaxf(rm,0.f); mhat+=dl; \
        _Pragma("unroll") for(int r=0;r<16;++r){C0[r]-=dl;C1[r]-=dl;} \
        _Pragma("unroll") for(int r=0;r<16;++r)negm[r]=-mhat; asm volatile("":"+v"(negm)); \
        const float f=__builtin_amdgcn_exp2f(-dl); l_reg*=f; if(hi==0)wsf[r32]=f; resc=true; } } \
    SBAR(); \
    GAPB(o[0]=__builtin_amdgcn_mfma_f32_32x32x16_bf16(PAF(0),VFR(0),o[0],0,0,0), C0,0); \
    GAPB(o[1]=__builtin_amdgcn_mfma_f32_32x32x16_bf16(PAF(0),VFR(4),o[1],0,0,0), C0,4); \
    KRD(GL,0); GAPB(o[0]=__builtin_amdgcn_mfma_f32_32x32x16_bf16(PAF(1),VFR(1),o[0],0,0,0), C0,8); \
    KRD(GL,1); GAPB(o[1]=__builtin_amdgcn_mfma_f32_32x32x16_bf16(PAF(1),VFR(5),o[1],0,0,0), C0,12); \
    KRD(GL,2); GAPB(o[0]=__builtin_amdgcn_mfma_f32_32x32x16_bf16(PAF(2),VFR(2),o[0],0,0,0), C1,0); \
    KRD(GL,3); GAPB(o[1]=__builtin_amdgcn_mfma_f32_32x32x16_bf16(PAF(2),VFR(6),o[1],0,0,0), C1,4); \
    GAPB(o[0]=__builtin_amdgcn_mfma_f32_32x32x16_bf16(PAF(3),VFR(3),o[0],0,0,0), C1,8); \
    GAPB(o[1]=__builtin_amdgcn_mfma_f32_32x32x16_bf16(PAF(3),VFR(7),o[1],0,0,0), C1,12); \
    }while(0)
  int t=1;
  for(;t+5<NT;t+=2){
    STEP(pB0,pB1,pA0,pA1,t,true,true,true);     WAIT_BAR(2); RESC(); ROT();
    STEP(pA0,pA1,pB0,pB1,t+1,true,true,true);   WAIT_BAR(2); RESC(); ROT();
  }
  #define ENDW(tt) do{ if((tt)+3<NT){WAIT_BAR(2);} else if((tt)+2<NT){WAIT_BAR(1);} else {WAIT_BAR(0);} }while(0)
  for(;t+1<NT;t+=2){
    STEP(pB0,pB1,pA0,pA1,t,(t+3<NT),(t+1<NT),(t+1<NT));       ENDW(t);   RESC(); ROT();
    STEP(pA0,pA1,pB0,pB1,t+1,(t+4<NT),(t+2<NT),(t+2<NT));     ENDW(t+1); RESC(); ROT();
  }
  STEP(pB0,pB1,pA0,pA1,NT-1,false,false,false); RESC();
  { float sacc=pB0[0]+pB0[1]; _Pragma("unroll") for(int r=2;r<16;++r)sacc+=pB0[r]; _Pragma("unroll") for(int r=0;r<16;++r)sacc+=pB1[r]; l_reg+=sacc;
    pw0=(u32x4){PKW(pB0,0),PKW(pB0,2),PKW(pB0,4),PKW(pB0,6)};pw1=(u32x4){PKW(pB0,8),PKW(pB0,10),PKW(pB0,12),PKW(pB0,14)};pw2=(u32x4){PKW(pB1,0),PKW(pB1,2),PKW(pB1,4),PKW(pB1,6)};pw3=(u32x4){PKW(pB1,8),PKW(pB1,10),PKW(pB1,12),PKW(pB1,14)};
    SBAR(); pv(o,vb0+sl_cur,PAF(0),PAF(1),PAF(2),PAF(3)); }
  #undef PKW
  #undef PAF
  #undef VFR
  #undef PIN
  #undef MX3
  #undef GAPA
  #undef GAPB
  #undef EX
  #undef VRD
  #undef KRD
  #undef STEP
  #undef ENDW
  {auto rr=__builtin_amdgcn_permlane32_swap(__float_as_uint(l_reg),__float_as_uint(l_reg),false,false);l_reg=__uint_as_float(rr[0])+__uint_as_float(rr[1]);}
  if(hi==0)wsf[32+r32]=l_reg;asm volatile("s_waitcnt lgkmcnt(0)":::"memory");
  float rli[16];
  #pragma unroll
  for(int r=0;r<16;++r)rli[r]=__builtin_amdgcn_rcpf(wsf[32+crow(r,hi)]);
  bf16*Ow=(wid<4?Oa:Ob)+(long)((wid&3)*QBLK)*opitch;
  { bf16*stg=(bf16*)(shm+LDS_OST)+wid*2048;
    #pragma unroll
    for(int r=0;r<16;++r){const int orow=crow(r,hi);
      #pragma unroll
      for(int d0=0;d0<2;++d0)stg[orow*64+d0*32+r32]=(bf16)f2bf(o[d0][r]*rli[r]);}
    asm volatile("s_waitcnt lgkmcnt(0)":::"memory");
    if constexpr(MODE==0){
      #pragma unroll
      for(int i=0;i<4;++i){const int row=i*8+(lane>>3),ch=lane&7; const u32x4 v=*(const u32x4*)(stg+row*64+ch*8); ATTN_STORE16(Ow+(long)row*opitch+ch*8,v);}
    } else {
      asm volatile("s_barrier":::"memory");
      if constexpr(MODE==1){ const bf16*stg2=stg+4*2048; const int ch=lane&7; float sb[8];
        #pragma unroll
        for(int e=0;e<8;++e)sb[e]=subln[ch*8+e]*post;
        #pragma unroll
        for(int i=0;i<4;++i){const int row=i*8+(lane>>3); const u32x4 v1=*(const u32x4*)(stg+row*64+ch*8),v2=*(const u32x4*)(stg2+row*64+ch*8);
          float od[8]; float ss=0.f;
          #pragma unroll
          for(int e=0;e<4;++e){ od[2*e]=bflo(v1[e])-lam*bflo(v2[e]); od[2*e+1]=bfhi(v1[e])-lam*bfhi(v2[e]); ss+=od[2*e]*od[2*e]+od[2*e+1]*od[2*e+1]; }
          ss+=__shfl_xor(ss,1); ss+=__shfl_xor(ss,2); ss+=__shfl_xor(ss,4);
          const float rn=__builtin_amdgcn_rsqf(ss*(1.f/64.f)+1e-6f);
          u32x4 w; w[0]=pk2(od[0]*rn*sb[0],od[1]*rn*sb[1]); w[1]=pk2(od[2]*rn*sb[2],od[3]*rn*sb[3]); w[2]=pk2(od[4]*rn*sb[4],od[5]*rn*sb[5]); w[3]=pk2(od[6]*rn*sb[6],od[7]*rn*sb[7]);
          ATTN_STORE16(Ow+(long)row*opitch+ch*8,w);} }
    } }
  asm volatile("s_waitcnt lgkmcnt(0)\n\ts_barrier":::"memory");
  #undef DMA_K
  #undef DMA_V
  #undef CMASK
  #undef START
  #undef RESC
  #undef ROT
}
constexpr int ATTN_LDS_BYTES=LDS_BYTES;
#undef SBAR
#undef WAIT_BAR
}
#else
EMU_ATTN_BODY
#endif
#ifndef EMU
#define XB_TMO      128
#define XB_XCNT(j)  (256  + 64 * (j))
#define XB_XSUB(j)  (1280 + 64 * (j))
#define XB_XGEN(j)  (2304 + 64 * (j))
#define XB_TOP      3328
#define XB_TOPGEN   3392
#define XCD_BAR_WORDS 3456
#define XB_SPIN_CAP (1u << 18)

__device__ __forceinline__ unsigned xb_ld(unsigned* p)              { return __hip_atomic_load(p, __ATOMIC_RELAXED, __HIP_MEMORY_SCOPE_AGENT); }
__device__ __forceinline__ unsigned xb_add(unsigned* p, unsigned v) { return __hip_atomic_fetch_add(p, v, __ATOMIC_RELAXED, __HIP_MEMORY_SCOPE_AGENT); }
__device__ __forceinline__ unsigned xb_xcc_id() { return (unsigned)__builtin_amdgcn_s_getreg((3 << 11) | 20) & 0xFu; }
#define XB_SPIN(cond, bar) do { unsigned _sp = 0; while (cond) { __builtin_amdgcn_s_sleep(1); \
    if ((++_sp & 255u) == 0u) { if (xb_ld(&(bar)[XB_TMO])) break; if (_sp > XB_SPIN_CAP) { atomicAdd(&(bar)[XB_TMO], 1u); break; } } } } while (0)

struct XcdBarrier {
    unsigned* bar; unsigned x;
    volatile LAS unsigned* st;
};

__device__ __forceinline__ XcdBarrier xcd_barrier_post(unsigned* bar, volatile LAS unsigned* st) {
    XcdBarrier b; b.bar = bar; b.x = xb_xcc_id(); b.st = st;
    if (threadIdx.x == 0) (void)xb_add(&bar[XB_XCNT(b.x)], 1u);
    return b;
}
__device__ __forceinline__ void xcd_barrier_complete(unsigned* bar, unsigned x, unsigned& nloc, unsigned& nx) {
    const unsigned G = gridDim.x * gridDim.y * gridDim.z;
    unsigned sum, cnt, mine, sp = 0u;
    for (;;) {
        sum = 0u; cnt = 0u; mine = 0u;
#pragma unroll
        for (unsigned j = 0; j < 16; ++j) { const unsigned c = xb_ld(&bar[XB_XCNT(j)]); sum += c; cnt += (c > 0u) ? 1u : 0u; mine = (j == x) ? c : mine; }
        if (sum == G) break;
        __builtin_amdgcn_s_sleep(1);
        if ((++sp & 255u) == 0u) { if (xb_ld(&bar[XB_TMO])) break; if (sp > XB_SPIN_CAP) { atomicAdd(&bar[XB_TMO], 1u); break; } }
    }
    nloc = mine > 0u ? mine : 1u; nx = cnt > 0u ? cnt : 1u;
}

__device__ __forceinline__ void xcd_barrier(const XcdBarrier& b) {
    asm volatile("s_waitcnt vmcnt(0)" ::: "memory");
    __syncthreads();
    if (threadIdx.x == 0) {
        unsigned* bar = b.bar;
        __builtin_amdgcn_s_waitcnt(0);
        unsigned nloc = b.st[0], nx = b.st[1];
        if (nloc == 0u) { xcd_barrier_complete(bar, b.x, nloc, nx); b.st[0] = nloc; b.st[1] = nx; }
        const unsigned old = xb_add(&bar[XB_XSUB(b.x)], 1u);
        const unsigned gen = old / nloc;
        if (old + 1u == (gen + 1u) * nloc) {
            __builtin_amdgcn_fence(__ATOMIC_RELEASE, "agent");
            asm volatile("s_waitcnt vmcnt(0)" ::: "memory");
            const unsigned og = xb_add(&bar[XB_TOP], 1u);
            const unsigned tg = og / nx;
            if (og + 1u == (tg + 1u) * nx) xb_add(&bar[XB_TOPGEN], 1u);
            else XB_SPIN(xb_ld(&bar[XB_TOPGEN]) == tg, bar);
            __builtin_amdgcn_fence(__ATOMIC_ACQUIRE, "agent");
            xb_add(&bar[XB_XGEN(b.x)], 1u);
            asm volatile("s_waitcnt vmcnt(0)" ::: "memory");
        } else {
            XB_SPIN(xb_ld(&bar[XB_XGEN(b.x)]) == gen, bar);
            __builtin_amdgcn_fence(__ATOMIC_ACQUIRE, "agent");
            asm volatile("s_waitcnt vmcnt(0)" ::: "memory");
        }
    }
    __syncthreads();
}
#endif

constexpr int LDS_BYTES = 147456;
constexpr int MISC_OFF = 139264;
constexpr int PTR_OFF = MISC_OFF + 256;
struct Ctx {
    LAS unsigned char* lds;
    int tid, lane, wave, bid, G;
    float* out; unsigned long long wsi;
};
DEVI const float* inp_ptr(const Ctx& C, int i) {
    const unsigned long long v = ((const LAS unsigned long long*)(C.lds + PTR_OFF))[i];
    const unsigned lo = __builtin_amdgcn_readfirstlane((unsigned)v), hi = __builtin_amdgcn_readfirstlane((unsigned)(v >> 32));
    return (const float*)(const GAS float*)(((unsigned long long)hi << 32) | lo);
}
#define INP(i) inp_ptr(C, i)
#define WSP(T, off) ((T*)(GAS T*)(C.wsi + (unsigned long long)(off)))
DEVI int mod_row(int r) { return r < T_L ? r / SEQ : 8; }
DEVI const float* mod_vec(const Ctx& C, int layer, int mrow, int which) { return WSP(const float, WS_MOD) + ((size_t)(layer * 9 + mrow) * 6 + which) * D; }

DEVI void transpose_item(const float* W, int ldw, int k0, int n0, bf16* WT, int orow0, int Kp, LAS float* scr, int lane) {
    { const int kr = lane >> 3, c4 = (lane & 7) * 4; f32x4 v[8];
#pragma unroll
      for (int i = 0; i < 8; ++i) v[i] = *(const f32x4*)(W + (size_t)(k0 + 8 * i + kr) * ldw + n0 + c4);
#pragma unroll
      for (int i = 0; i < 8; ++i) { LAS float* d = scr + (8 * i + kr) * 33 + c4; d[0] = v[i].x; d[1] = v[i].y; d[2] = v[i].z; d[3] = v[i].w; } }
    LDS_WAIT();
    const int c = lane & 7;
#pragma unroll
    for (int j = 0; j < 4; ++j) { const int n = (lane >> 3) + 8 * j; const LAS float* s = scr + (8 * c) * 33 + n;
        v4u o; o.x = pk2(s[0 * 33], s[1 * 33]); o.y = pk2(s[2 * 33], s[3 * 33]); o.z = pk2(s[4 * 33], s[5 * 33]); o.w = pk2(s[6 * 33], s[7 * 33]);
        *(v4u*)(WT + (size_t)(orow0 + n) * Kp + k0 + 8 * c) = o; }
    LDS_WAIT();
}
DEVI void convert_layer_weights(const Ctx& C, int layer, int part) {
    LAS float* scr = (LAS float*)(C.lds + C.wave * 16384);
    const int gw = C.bid * 8 + C.wave, NGW = C.G * 8;
    constexpr int I_IN = 16 * (N_PROJ / 32), I_OUT = 16 * (D / 32), I_UP = NE * 16 * (2 * DE / 32), I_DN = NE * 16 * (D / 32), I_LAYER = I_IN + I_OUT + I_UP + I_DN;
    const int it_lo = (part == 1) ? I_IN + I_OUT : 0, it_hi = (part == 0) ? I_IN + I_OUT : I_LAYER;
    for (int it = it_lo + gw; it < it_hi; it += NGW) {
        int r = it;
        if (r < I_IN) { const int kb = r / (N_PROJ / 32), nb = r % (N_PROJ / 32);
            transpose_item(INP(8) + (size_t)layer * D * D_IN, D_IN, 64 * kb, 32 * nb, WSP(bf16, WS_WIN) + (size_t)layer * N_PROJ * D, 32 * nb, D, scr, C.lane); continue; }
        r -= I_IN;
        if (r < I_OUT) { const int kb = r / (D / 32), nb = r % (D / 32);
            transpose_item(INP(9) + (size_t)layer * D * D, D, 64 * kb, 32 * nb, WSP(bf16, WS_WOUT) + (size_t)layer * D * D, 32 * nb, D, scr, C.lane); continue; }
        r -= I_OUT;
        if (r < I_UP) { const int e = r / (16 * 64), q = r % (16 * 64), kb = q / 64, nb = q % 64; const int n0 = 32 * nb;
            const int orow = (n0 < DE) ? (n0 / 128) * 256 + (n0 % 128) : ((n0 - DE) / 128) * 256 + 128 + ((n0 - DE) % 128);
            transpose_item(INP(26) + ((size_t)layer * NE + e) * D * 2 * DE, 2 * DE, 64 * kb, n0, WSP(bf16, WS_WUP) + ((size_t)layer * NE + e) * 2 * DE * D, orow, D, scr, C.lane); continue; }
        r -= I_UP;
        { const int e = r / (16 * 32), q = r % (16 * 32), kb = q / 32, nb = q % 32;
            transpose_item(INP(28) + ((size_t)layer * NE + e) * DE * D, D, 64 * kb, 32 * nb, WSP(bf16, WS_WDN) + ((size_t)layer * NE + e) * D * DE, 32 * nb, DE, scr, C.lane); }
    }
}
DEVI void p0_prologue(const Ctx& C) {
    convert_layer_weights(C, 0, 0);
    {
      float* tab = WSP(float, WS_ROPE);
      for (int i = C.bid * 512 + C.tid; i < SEQ * 48; i += C.G * 512) { const int t = i / 48, j = i % 48; const float rp = (float)(t / GRID_W), cp = (float)(t % GRID_W); float c, s;
          if (j < 32) { const float ang = (j < 16 ? rp : cp) * __builtin_amdgcn_exp2f(-(float)(j & 15) * (13.287712379549449f / 16.f)); const float tt = __builtin_amdgcn_fractf(ang * 0.15915494309189535f); c = __builtin_amdgcn_cosf(tt); s = __builtin_amdgcn_sinf(tt);
              tab[(size_t)t * 32 + j] = c; tab[(size_t)SEQ * 32 + (size_t)t * 32 + j] = s; }
          else { const int i2 = j - 32; const float ang = (i2 < 8 ? rp : cp) * __builtin_amdgcn_exp2f(-(float)(i2 & 7) * (13.287712379549449f / 8.f)); const float tt = __builtin_amdgcn_fractf(ang * 0.15915494309189535f); c = __builtin_amdgcn_cosf(tt); s = __builtin_amdgcn_sinf(tt);
              tab[(size_t)SEQ * 64 + (size_t)t * 16 + i2] = c; tab[(size_t)SEQ * 80 + (size_t)t * 16 + i2] = s; } } }
    __syncthreads();
    LAS float* sc = (LAS float*)C.lds;
    LAS float* red = sc + 9 * D;
    for (int i = C.tid; i < 9 * D; i += 512) { const int r = i / D, k = i % D; float v = 0.f; if (r < NB) v = INP(1)[r * D + k]; else if (r == 8) v = INP(3)[k]; sc[i] = siluf_(v); }
    __syncthreads();
    for (int u = C.bid; u < DEPTH * 96; u += C.G) {
        const int layer = u / 96, n0 = (u % 96) * 64, col = C.tid & 63, kg = C.tid >> 6;
        const float* w = INP(4) + (size_t)layer * D * 6 * D + n0 + col;
        float acc[9];
#pragma unroll
        for (int r = 0; r < 9; ++r) acc[r] = 0.f;
#pragma unroll 8
        for (int k = kg * 128; k < kg * 128 + 128; ++k) { const float wv = w[(size_t)k * 6 * D];
#pragma unroll
            for (int r = 0; r < 9; ++r) acc[r] += sc[r * D + k] * wv; }
#pragma unroll
        for (int r = 0; r < 9; ++r) red[(kg * 9 + r) * 64 + col] = acc[r];
        __syncthreads();
        for (int i = C.tid; i < 9 * 64; i += 512) { const int r = i >> 6, c2 = i & 63; float s = 0.f;
#pragma unroll
            for (int g = 0; g < 8; ++g) s += red[(g * 9 + r) * 64 + c2];
            WSP(float, WS_MOD)[((size_t)(layer * 9 + r)) * 6 * D + n0 + c2] = s + INP(5)[(size_t)layer * 6 * D + n0 + c2]; }
        __syncthreads();
    }
}

DEVI void ph_norm_mix(const Ctx& C, int layer) {
    const bool fin = (layer == DEPTH);
    const int nrows = fin ? T_L : T_ALL;
    if (layer == 0) {
        for (int it = C.bid * 8 + C.wave; it < DEPTH * 9 * NE; it += C.G * 8) {
            const int e = it % NE, m = (it / NE) % 9, l = it / (NE * 9);
            const float* gn = INP(7) + (size_t)l * D; const float* sh = mod_vec(C, l, m, 3); const float* scl = mod_vec(C, l, m, 4); const float* rw = INP(24) + (size_t)l * D * NE + e;
            float* dst = WSP(float, WS_RWP) + (size_t)it * D; float bsum = 0.f;
#pragma unroll 4
            for (int j = 0; j < 16; ++j) { const int k = 64 * j + C.lane; const float w = rw[(size_t)k * NE]; dst[k] = gn[k] * (1.f + scl[k]) * w; bsum += sh[k] * w; }
            bsum = wave_sum(bsum); if (C.lane == 0) WSP(float, WS_RBP)[it] = bsum + INP(25)[l * NE + e];
        }
    }
    LAS float* w16 = (LAS float*)C.lds;
    if (!fin) { for (int i = C.tid; i < 16 * D; i += 512) { const int k = i >> 4, j = i & 15; w16[j * D + k] = INP(8)[((size_t)layer * D + k) * D_IN + N_PROJ + j]; } }
    __syncthreads();
    const float* gmain = fin ? INP(30) : INP(6) + (size_t)layer * D;
    const int rstep = C.G * 8;
    int s4[2][4]; float g4[2][4];
#define NM_SLOTS(dst_s, dst_g, rbase) do { _Pragma("unroll") for (int u2 = 0; u2 < 2; ++u2) { const int rr_ = (rbase) + u2 * rstep; const int rc_ = rr_ < nrows ? rr_ : 0; \
        const int* sl_ = WSP(const int, WS_SLOT) + (size_t)rc_ * 4; const float* gl_ = WSP(const float, WS_TOKG) + (size_t)rc_ * 4; \
        _Pragma("unroll") for (int k = 0; k < 4; ++k) { dst_s[u2][k] = sl_[k]; dst_g[u2][k] = gl_[k]; } } } while (0)
    if (layer != 0) NM_SLOTS(s4, g4, C.bid * 8 + C.wave);
#define NMC(j) ((((j) & 2) ? 512 : 0) + 8 * C.lane + 4 * ((j) & 1))
    for (int ra = C.bid * 8 + C.wave; ra < nrows; ra += 2 * rstep) {
        f32x4 v[2][4]; int mrow[2]; bool live[2];
        int s4n[2][4]; float g4n[2][4];
        if (layer != 0) NM_SLOTS(s4n, g4n, ra + 2 * rstep);
#pragma unroll
        for (int u2 = 0; u2 < 2; ++u2) { const int r = ra + u2 * rstep; live[u2] = r < nrows; const int rc = live[u2] ? r : 0; mrow[u2] = mod_row(rc);
            if (layer == 0) { const float* xr = (rc < T_L) ? INP(0) + (size_t)rc * D : INP(2) + (size_t)(rc - T_L) * D;
#pragma unroll
                for (int j = 0; j < 4; ++j) v[u2][j] = *(const f32x4*)(xr + NMC(j));
            } else {
                const bf16* xr = WSP(const bf16, WS_XRES) + (size_t)rc * D; const float* g2 = mod_vec(C, layer - 1, mrow[u2], 5);
                f32x4 xv[4]; { const v4u xa = *(const v4u*)(xr + 8 * C.lane), xb = *(const v4u*)(xr + 512 + 8 * C.lane);
                    xv[0] = (f32x4){bflo(xa.x), bfhi(xa.x), bflo(xa.y), bfhi(xa.y)}; xv[1] = (f32x4){bflo(xa.z), bfhi(xa.z), bflo(xa.w), bfhi(xa.w)};
                    xv[2] = (f32x4){bflo(xb.x), bfhi(xb.x), bflo(xb.y), bfhi(xb.y)}; xv[3] = (f32x4){bflo(xb.z), bfhi(xb.z), bflo(xb.w), bfhi(xb.w)}; }
                f32x4 a[4];
#pragma unroll
                for (int j = 0; j < 4; ++j) a[j] = (f32x4){0.f, 0.f, 0.f, 0.f};
#pragma unroll
                for (int k = 0; k < 4; ++k) { const unsigned char* yr = WSP(const unsigned char, WS_YS) + (size_t)s4[u2][k] * D; const v2u ya = *(const v2u*)(yr + 8 * C.lane), yb = *(const v2u*)(yr + 512 + 8 * C.lane); const float gk = g4[u2][k];
                    const f32x2 p0 = __builtin_amdgcn_cvt_pk_f32_fp8((int)ya.x, false), p1 = __builtin_amdgcn_cvt_pk_f32_fp8((int)ya.x, true), p2 = __builtin_amdgcn_cvt_pk_f32_fp8((int)ya.y, false), p3 = __builtin_amdgcn_cvt_pk_f32_fp8((int)ya.y, true);
                    const f32x2 q0 = __builtin_amdgcn_cvt_pk_f32_fp8((int)yb.x, false), q1 = __builtin_amdgcn_cvt_pk_f32_fp8((int)yb.x, true), q2 = __builtin_amdgcn_cvt_pk_f32_fp8((int)yb.y, false), q3 = __builtin_amdgcn_cvt_pk_f32_fp8((int)yb.y, true);
                    a[0] += (f32x4){p0.x, p0.y, p1.x, p1.y} * gk; a[1] += (f32x4){p2.x, p2.y, p3.x, p3.y} * gk;
                    a[2] += (f32x4){q0.x, q0.y, q1.x, q1.y} * gk; a[3] += (f32x4){q2.x, q2.y, q3.x, q3.y} * gk; }
#pragma unroll
                for (int j = 0; j < 4; ++j) v[u2][j] = xv[j] + *(const f32x4*)(g2 + NMC(j)) * a[j];
            } }
        float rinv[2];
#pragma unroll
        for (int u2 = 0; u2 < 2; ++u2) { float ss = 0.f;
#pragma unroll
            for (int j = 0; j < 4; ++j) ss += (v[u2][j].x * v[u2][j].x + v[u2][j].y * v[u2][j].y) + (v[u2][j].z * v[u2][j].z + v[u2][j].w * v[u2][j].w);
            rinv[u2] = __builtin_amdgcn_rsqf(wave_sum(ss) * (1.f / D) + NORM_EPS); }
#pragma unroll
        for (int u2 = 0; u2 < 2; ++u2) { const int r = ra + u2 * rstep; if (!live[u2]) continue;
            if (fin) {
#pragma unroll
                for (int j = 0; j < 4; ++j) *(f32x4*)(C.out + (size_t)r * D + NMC(j)) = v[u2][j] * rinv[u2] * *(const f32x4*)(gmain + NMC(j));
                continue; }
            if (layer != 0) { bf16* xw = WSP(bf16, WS_XRES) + (size_t)r * D;
                *(v4u*)(xw + 8 * C.lane) = (v4u){pk2(v[u2][0].x, v[u2][0].y), pk2(v[u2][0].z, v[u2][0].w), pk2(v[u2][1].x, v[u2][1].y), pk2(v[u2][1].z, v[u2][1].w)};
                *(v4u*)(xw + 512 + 8 * C.lane) = (v4u){pk2(v[u2][2].x, v[u2][2].y), pk2(v[u2][2].z, v[u2][2].w), pk2(v[u2][3].x, v[u2][3].y), pk2(v[u2][3].z, v[u2][3].w)}; }
            const float* sh = mod_vec(C, layer, mrow[u2], 0); const float* scl = mod_vec(C, layer, mrow[u2], 1);
            f32x4 hv4[4]; float mine = 0.f;
#pragma unroll
            for (int j = 0; j < 4; ++j) hv4[j] = v[u2][j] * rinv[u2] * *(const f32x4*)(gmain + NMC(j)) * (*(const f32x4*)(scl + NMC(j)) + 1.0f) + *(const f32x4*)(sh + NMC(j));
            { bf16* hr = WSP(bf16, WS_H) + (size_t)r * D;
              *(v4u*)(hr + 8 * C.lane) = (v4u){pk2(hv4[0].x, hv4[0].y), pk2(hv4[0].z, hv4[0].w), pk2(hv4[1].x, hv4[1].y), pk2(hv4[1].z, hv4[1].w)};
              *(v4u*)(hr + 512 + 8 * C.lane) = (v4u){pk2(hv4[2].x, hv4[2].y), pk2(hv4[2].z, hv4[2].w), pk2(hv4[3].x, hv4[3].y), pk2(hv4[3].z, hv4[3].w)}; }
#pragma unroll 2
            for (int i = 0; i < 16; ++i) { float pp = 0.f;
#pragma unroll
                for (int j = 0; j < 4; ++j) { const f32x4 w = *(const LAS f32x4*)(w16 + i * D + NMC(j)); pp += (hv4[j].x * w.x + hv4[j].y * w.y) + (hv4[j].z * w.z + hv4[j].w * w.w); }
                pp = wave_sum(pp); if (C.lane == i) mine = pp; }
            if (C.lane < 16) WSP(float, WS_BA)[(size_t)r * 16 + C.lane] = mine; }
        if (layer != 0) {
#pragma unroll
            for (int u2 = 0; u2 < 2; ++u2)
#pragma unroll
                for (int k = 0; k < 4; ++k) { s4[u2][k] = s4n[u2][k]; g4[u2][k] = g4n[u2][k]; } }
    }
#undef NMC
#undef NM_SLOTS
}

DEVI void u8f(const v4u& w, float (&x)[8]) { x[0] = bflo(w.x); x[1] = bfhi(w.x); x[2] = bflo(w.y); x[3] = bfhi(w.y); x[4] = bflo(w.z); x[5] = bfhi(w.z); x[6] = bflo(w.w); x[7] = bfhi(w.w); }
DEVI v4u f8u(const float (&x)[8]) { return (v4u){pk2(x[0], x[1]), pk2(x[2], x[3]), pk2(x[4], x[5]), pk2(x[6], x[7])}; }
DEVI void ph_attn_prep(const Ctx& C, int layer) {
    const bf16* proj = WSP(const bf16, WS_PROJ);
    bf16* QL = WSP(bf16, WS_QL); bf16* QC = WSP(bf16, WS_QC); bf16* KB = WSP(bf16, WS_K); bf16* VB = WSP(bf16, WS_V);
    const float* tab = WSP(const float, WS_ROPE);
    const int lane = C.lane, l7 = lane & 7, d0 = 8 * l7;
    constexpr float C2A = 0.125f * 1.4426950408889634f, C2D = 0.17677669529663687f * 1.4426950408889634f;
    float gA[8];
    { const float* gn = (lane < 32 ? INP(10) : INP(11)) + layer * 64 + d0;
#pragma unroll
      for (int e = 0; e < 8; ++e) gA[e] = gn[e]; }
    const bool lowA = d0 < 32; const int jA = d0 & 31;
    const int i0 = 8 * (lane & 3); const bool lowD = i0 < 16; const int iD = i0 & 15, mp = l7 >> 2;
    constexpr int RU = 2; const int rstep = C.G * 8;
    for (int rbase = C.bid * 8 + C.wave; rbase < T_ALL; rbase += RU * rstep) {
        v4u pa[RU], pc1[RU], pc2[RU]; f32x4 ca[RU][2], sa[RU][2], cd[RU][2], sd[RU][2];
#pragma unroll
        for (int u2 = 0; u2 < RU; ++u2) { const int rr = rbase + u2 * rstep; const int r = rr < T_ALL ? rr : rbase; const bf16* pr = proj + (size_t)r * N_PROJ;
            pa[u2] = *(const v4u*)(pr + 8 * lane); pc1[u2] = *(const v4u*)(pr + C_CQ + 8 * lane); pc2[u2] = *(const v4u*)(pr + C_CV + 8 * (lane & 31));
            const int t = r < T_L ? r % SEQ : 0;
            ca[u2][0] = *(const f32x4*)(tab + (size_t)t * 32 + jA); ca[u2][1] = *(const f32x4*)(tab + (size_t)t * 32 + jA + 4);
            sa[u2][0] = *(const f32x4*)(tab + (size_t)SEQ * 32 + (size_t)t * 32 + jA); sa[u2][1] = *(const f32x4*)(tab + (size_t)SEQ * 32 + (size_t)t * 32 + jA + 4);
            cd[u2][0] = *(const f32x4*)(tab + (size_t)SEQ * 64 + (size_t)t * 16 + iD); cd[u2][1] = *(const f32x4*)(tab + (size_t)SEQ * 64 + (size_t)t * 16 + iD + 4);
            sd[u2][0] = *(const f32x4*)(tab + (size_t)SEQ * 80 + (size_t)t * 16 + iD); sd[u2][1] = *(const f32x4*)(tab + (size_t)SEQ * 80 + (size_t)t * 16 + iD + 4); }
#pragma unroll
        for (int u2 = 0; u2 < RU; ++u2) { const int r = rbase + u2 * rstep; if (r >= T_ALL) continue;
            const bool lat = r < T_L; const int b = lat ? r / SEQ : (r - T_L) / LC; const int t = lat ? r % SEQ : (r - T_L) % LC; const int pos = lat ? t : SEQ + t;
            { float x[8]; u8f(pa[u2], x);
              if (lane < 48) { float ss = 0.f;
#pragma unroll
                  for (int e = 0; e < 8; ++e) ss += x[e] * x[e];
                  const float rinv = __builtin_amdgcn_rsqf(group_sum<8>(ss) * (1.f / 64.f) + NORM_EPS);
#pragma unroll
                  for (int e = 0; e < 8; ++e) x[e] *= rinv * gA[e]; }
              float o[8];
#pragma unroll
              for (int e = 0; e < 8; ++e) { const float pe = __shfl_xor(x[e], 4); const float c = lat ? ca[u2][e >> 2][e & 3] : 1.f, s = lat ? sa[u2][e >> 2][e & 3] : 0.f;
                  o[e] = lowA ? x[e] * c - pe * s : pe * s + x[e] * c; }
              if (lane < 32) { const int hq = lane >> 3;
#pragma unroll
                  for (int e = 0; e < 8; ++e) o[e] *= C2A;
                  bf16* q = lat ? QL + ((size_t)(b * 12 + hq) * SEQ + t) * 64 : QC + ((size_t)(b * 12 + hq) * LC + t) * 64; *(v4u*)(q + d0) = f8u(o); }
              else if (lane < 48) { const int kvh = (lane - 32) >> 3; *(v4u*)(KB + ((size_t)(b * 6 + kvh) * NKEY + pos) * 64 + d0) = f8u(o); }
              else { const int kvh = (lane - 48) >> 3; *(v4u*)(VB + ((size_t)(b * 6 + kvh) * NKEY + pos) * 64 + d0) = pa[u2]; } }
            { float x[8]; u8f(pc1[u2], x); float o[8];
#pragma unroll
              for (int e = 0; e < 8; ++e) { const float pe = __shfl_xor(x[e], 2); const float c = lat ? cd[u2][e >> 2][e & 3] : 1.f, s = lat ? sd[u2][e >> 2][e & 3] : 0.f;
                  o[e] = lowD ? x[e] * c - pe * s : pe * s + x[e] * c; }
              const int hc = (lane & 31) >> 3;
              if (lane < 32) { const int vh = 4 + 2 * hc + mp;
#pragma unroll
                  for (int e = 0; e < 8; ++e) o[e] *= C2D;
                  bf16* q = lat ? QL + ((size_t)(b * 12 + vh) * SEQ + t) * 64 : QC + ((size_t)(b * 12 + vh) * LC + t) * 64;
                  *(v4u*)(q + mp * 32 + i0) = f8u(o); *(v4u*)(q + (1 - mp) * 32 + i0) = (v4u){0u, 0u, 0u, 0u}; }
              else { *(v4u*)(KB + ((size_t)(b * 6 + 2 + hc) * NKEY + pos) * 64 + d0) = f8u(o); } }
            if (lane < 32) { const int hv = lane >> 3; *(v4u*)(VB + ((size_t)(b * 6 + 2 + hv) * NKEY + pos) * 64 + d0) = pc2[u2]; }
        }
    }
}

DEVI void ph_gmlp(const Ctx& C, int layer, int ntok) {
    constexpr int VP = 136, SP = 68;
    LAS bf16* vnT = (LAS bf16*)C.lds;
    LAS float* rinv = (LAS float*)(vnT + 64 * VP);
    LAS float* spT = rinv + 128;
    const bf16* proj = WSP(const bf16, WS_PROJ); bf16* mix = WSP(bf16, WS_MIX);
    const float* gvn = INP(12) + layer * 256;
    const int tid0 = C.tid;
    constexpr int NSCAN = NB * 16; const int total = (ntok / 128) * 4; const bool split = C.G > NSCAN && total > 2 * NSCAN;
    const int ufirst = !split ? C.bid : (C.bid < NSCAN ? C.bid : 2 * NSCAN + (C.bid - NSCAN)), ustride = !split ? C.G : (C.bid < NSCAN ? NSCAN : C.G - NSCAN), uend = (split && C.bid < NSCAN) ? 2 * NSCAN : total;
    for (int u = ufirst; u < uend; u += ustride) {
        int tid = tid0; LAUNDER_V(tid);
        const int chunk = u >> 2, g = u & 3; const int row0 = chunk * 128;
        const int lane = tid & 63, wv = __builtin_amdgcn_readfirstlane(tid >> 6), l15 = lane & 15, q = lane >> 4;
        bf16x8 afr[4];
        { const float* wsr = INP(13) + ((size_t)layer * 4 + g) * 128 * 128 + (size_t)(16 * wv + l15) * 128 + 8 * q;
#pragma unroll
          for (int kk = 0; kk < 4; ++kk) { const f32x4 a0 = *(const f32x4*)(wsr + 32 * kk), a1 = *(const f32x4*)(wsr + 32 * kk + 4);
              const v4u ap = {pk2(a0.x, a0.y), pk2(a0.z, a0.w), pk2(a1.x, a1.y), pk2(a1.z, a1.w)}; afr[kk] = __builtin_bit_cast(bf16x8, ap); } }
        { const int tok = tid >> 2, qd = tid & 3; const bf16* p = proj + (size_t)(row0 + tok) * N_PROJ + C_BV + qd * 64; float ss = 0.f;
#pragma unroll
          for (int c8 = 0; c8 < 8; ++c8) { const v4u w = *(const v4u*)(p + c8 * 8);
              const float a0 = gelu_tanh(bflo(w.x)), a1 = gelu_tanh(bfhi(w.x)), a2 = gelu_tanh(bflo(w.y)), a3 = gelu_tanh(bfhi(w.y)), a4 = gelu_tanh(bflo(w.z)), a5 = gelu_tanh(bfhi(w.z)), a6 = gelu_tanh(bflo(w.w)), a7 = gelu_tanh(bfhi(w.w));
              ss += (a0 * a0 + a1 * a1) + (a2 * a2 + a3 * a3) + (a4 * a4 + a5 * a5) + (a6 * a6 + a7 * a7); }
          ss = group_sum<4>(ss); if (qd == 0) rinv[tok] = __builtin_amdgcn_rsqf(ss * (1.f / 256.f) + NORM_EPS); }
        __syncthreads();
        { const int tok = tid >> 2, c0 = (tid & 3) * 16; const bf16* p = proj + (size_t)(row0 + tok) * N_PROJ + C_BV + g * 64 + c0; const float ri = rinv[tok];
          const v4u w0 = *(const v4u*)p, w1 = *(const v4u*)(p + 8); const unsigned ww[8] = {w0.x, w0.y, w0.z, w0.w, w1.x, w1.y, w1.z, w1.w};
#pragma unroll
          for (int c = 0; c < 16; ++c) { const float x = (c & 1) ? bfhi(ww[c >> 1]) : bflo(ww[c >> 1]); vnT[(c0 + c) * VP + tok] = (bf16)f2bf(gelu_tanh(x) * ri * gvn[g * 64 + c0 + c]); } }
        __syncthreads();
        { f32x4 acc[4];
#pragma unroll
          for (int n = 0; n < 4; ++n) acc[n] = (f32x4){0.f, 0.f, 0.f, 0.f};
#pragma unroll
          for (int kk = 0; kk < 4; ++kk)
#pragma unroll
              for (int n = 0; n < 4; ++n) acc[n] = __builtin_amdgcn_mfma_f32_16x16x32_bf16(afr[kk], *(const LAS bf16x8*)(vnT + (16 * n + l15) * VP + 32 * kk + 8 * q), acc[n], 0, 0, 0);
          const float* bs = INP(14) + ((size_t)layer * 4 + g) * 128;
#pragma unroll
          for (int r = 0; r < 4; ++r) { const int tok = 16 * wv + 4 * q + r; const float bb = bs[tok];
#pragma unroll
              for (int n = 0; n < 4; ++n) spT[tok * SP + 16 * n + l15] = acc[n][r] + bb; } }
        __syncthreads();
        { const int tok = tid >> 2, c0 = (tid & 3) * 16; const size_t rowp = (size_t)(row0 + tok);
          const bf16* pu = proj + rowp * N_PROJ + C_BU + g * 64 + c0; const v4u u0 = *(const v4u*)pu, u1 = *(const v4u*)(pu + 8); const unsigned uw[8] = {u0.x, u0.y, u0.z, u0.w, u1.x, u1.y, u1.z, u1.w};
          float o[16];
#pragma unroll
          for (int c4 = 0; c4 < 4; ++c4) { const f32x4 sp = *(const LAS f32x4*)(spT + tok * SP + c0 + 4 * c4);
              o[4 * c4 + 0] = gelu_tanh(bflo(uw[2 * c4])) * sp.x; o[4 * c4 + 1] = gelu_tanh(bfhi(uw[2 * c4])) * sp.y; o[4 * c4 + 2] = gelu_tanh(bflo(uw[2 * c4 + 1])) * sp.z; o[4 * c4 + 3] = gelu_tanh(bfhi(uw[2 * c4 + 1])) * sp.w; }
          bf16* po = mix + rowp * D + 256 + g * 64 + c0;
          *(v4u*)po = (v4u){pk2(o[0], o[1]), pk2(o[2], o[3]), pk2(o[4], o[5]), pk2(o[6], o[7])}; *(v4u*)(po + 8) = (v4u){pk2(o[8], o[9]), pk2(o[10], o[11]), pk2(o[12], o[13]), pk2(o[14], o[15])}; }
        __syncthreads();
    }
}

DEVI int dn_kmap(int kk, int q, int j) { return 16 * (2 * kk + (j >> 2)) + 4 * q + (j & 3); }
DEVI size_t dn_unit_off(int b, int dir, int h, int sc) { return ((size_t)((b * 2 + dir) * 4 + h) * NCH + sc) * DN_UNIT_BYTES; }
constexpr int DP = 68, XP = 132, HP = 72;
DEVI f32x4 mfma16(bf16x8 a, bf16x8 b, f32x4 c) { return __builtin_amdgcn_mfma_f32_16x16x32_bf16(a, b, c, 0, 0, 0); }
#ifndef D1REP
#define D1REP 0
#endif
#define DN_BAR() asm volatile("s_waitcnt lgkmcnt(0)\n\ts_barrier" ::: "memory")
DEVI void ph_dn_chunk(const Ctx& C, int layer) {
    LAS bf16* kN = (LAS bf16*)C.lds;
    LAS bf16* qN = kN + 64 * HP;
    LAS bf16* kT = qN + 64 * HP;
    LAS bf16* QKd = kT + 64 * HP;
    LAS bf16* RT = QKd + 64 * HP;
    LAS bf16* XT = RT;
    LAS bf16* TiB = RT + 128 * HP;
    LAS float* Am = (LAS float*)(TiB + 64 * HP);
    LAS float* TI = Am + 64 * DP;
    LAS bf16* XdT = (LAS bf16*)Am;
    LAS float* TMP = TI + 64 * DP;
    LAS float* vec = TMP + 1280;
    LAS float* betav = vec; LAS float* cum = vec + 64; LAS float* ecum = vec + 128; LAS float* dvec = vec + 192; LAS float* bec = vec + 256;
    LAS float* cwl = vec + 320;
    LAS float* gpar = cwl + 2304;
    static_assert(128 * HP * 2 <= 2 * 64 * DP * 4 && (4 * 64 * HP + 128 * HP + 64 * HP) * 2 + (2 * 64 * DP + 1280 + 320 + 2304 + 16) * 4 <= MISC_OFF, "D1 LDS");
    const bf16* proj = WSP(const bf16, WS_PROJ); const float* BA = WSP(const float, WS_BA);
    { const float* cwg = INP(20) + (size_t)layer * 3 * 768; for (int i = C.tid; i < 2304; i += 512) cwl[i] = cwg[i];
      if (C.tid < 8) gpar[C.tid] = -fast_exp(INP(21)[layer * 8 + C.tid]); else if (C.tid < 16) gpar[C.tid] = INP(22)[layer * 8 + C.tid - 8]; }
    __syncthreads();
    const LAS float* cw = cwl;
    const int tid0 = C.tid;
#define FRESH_TID() int tid = tid0; LAUNDER_V(tid)
#define DN_DECODE(u_) const int tcx = (u_) % NCH, h = ((u_) / NCH) & 3, dir = ((u_) / (NCH * 4)) & 1, b = (u_) / (NCH * 8); \
        const bool isc = tcx < NCH_C; const int tc = isc ? tcx : tcx - NCH_C; const int nch = isc ? NCH_C : NCH_L; const int len = nch * 64; \
        const int row_seq0 = isc ? T_L + b * LC : b * SEQ
    v4u rw[3][3]; float rb0 = 0.f, rb1 = 0.f, rb2 = 0.f;
#define DN_LOAD(u_) do { if ((u_) < NB * 2 * 4 * NCH) { DN_DECODE(u_); int t_ = tid0; LAUNDER_V(t_); const int c = t_ >> 3, d0 = (t_ & 7) * 8; const int tl = tc * 64 + (dir ? 63 - c : c); const size_t r = (size_t)row_seq0 + tl; \
        const bool hp = tl > 0, hn = tl < len - 1; \
        _Pragma("unroll") for (int w3 = 0; w3 < 3; ++w3) { const bf16* p = proj + r * N_PROJ + C_DQKV + w3 * 256 + h * 64 + d0; \
            rw[w3][1] = *(const v4u*)p; rw[w3][0] = (v4u){0u, 0u, 0u, 0u}; rw[w3][2] = (v4u){0u, 0u, 0u, 0u}; if (hp) rw[w3][0] = *(const v4u*)(p - N_PROJ); if (hn) rw[w3][2] = *(const v4u*)(p + N_PROJ); } \
        rb0 = BA[r * 16 + dir * 4 + h]; \
        if (t_ < 64) { const int tl2 = tc * 64 + (dir ? 63 - t_ : t_); const float* ba = BA + ((size_t)row_seq0 + tl2) * 16; rb1 = ba[dir * 4 + h]; rb2 = ba[8 + dir * 4 + h]; } } } while (0)
    DN_LOAD(C.bid);
    for (int u = C.bid; u < NB * 2 * 4 * NCH; u += C.G) {
        DN_DECODE(u);
        const int sc = (isc ? 0 : NCH_C) + (dir ? nch - 1 - tc : tc);
        { FRESH_TID(); const int c = tid >> 3, part = tid & 7, d0 = part * 8;
          float y[3][8];
#pragma unroll
          for (int w3 = 0; w3 < 3; ++w3) { const int col = w3 * 256 + h * 64 + d0;
              const v4u xc = rw[w3][1], xp = rw[w3][0], xn = rw[w3][2];
              const unsigned xcw[4] = {xc.x, xc.y, xc.z, xc.w}, xpw[4] = {xp.x, xp.y, xp.z, xp.w}, xnw[4] = {xn.x, xn.y, xn.z, xn.w};
#pragma unroll
              for (int e = 0; e < 8; ++e) { const float a = (e & 1) ? bfhi(xpw[e >> 1]) : bflo(xpw[e >> 1]), m = (e & 1) ? bfhi(xcw[e >> 1]) : bflo(xcw[e >> 1]), n = (e & 1) ? bfhi(xnw[e >> 1]) : bflo(xnw[e >> 1]);
                  y[w3][e] = siluf_(cw[col + e] * a + cw[768 + col + e] * m + cw[1536 + col + e] * n); } }
          const float ba_b = rb0, ba_b2 = rb1, ba_a2 = rb2;
          DN_LOAD(u + C.G);
          float sq = 0.f, sk = 0.f;
#pragma unroll
          for (int e = 0; e < 8; ++e) { sq += y[0][e] * y[0][e]; sk += y[1][e] * y[1][e]; }
          sq = group_sum<8>(sq); sk = group_sum<8>(sk);
          const float rq = __builtin_amdgcn_rsqf(sq + NORM_EPS) * 0.125f, rk = __builtin_amdgcn_rsqf(sk + NORM_EPS);
          const float betac = sigmoidf_(ba_b);
#pragma unroll
          for (int e = 0; e < 8; ++e) { y[0][e] *= rq; y[1][e] *= rk; kT[(d0 + e) * HP + c] = (bf16)f2bf(y[1][e]); RT[(d0 + e) * HP + c] = (bf16)f2bf(betac * y[2][e]); }
          *(LAS v4u*)(qN + c * HP + d0) = (v4u){pk2(y[0][0], y[0][1]), pk2(y[0][2], y[0][3]), pk2(y[0][4], y[0][5]), pk2(y[0][6], y[0][7])};
          *(LAS v4u*)(kN + c * HP + d0) = (v4u){pk2(y[1][0], y[1][1]), pk2(y[1][2], y[1][3]), pk2(y[1][4], y[1][5]), pk2(y[1][6], y[1][7])};
          *(LAS v4u*)(QKd + c * HP + d0) = (v4u){0u, 0u, 0u, 0u};
          { LAS f32x4* z = (LAS f32x4*)TI; z[tid] = (f32x4){0.f, 0.f, 0.f, 0.f}; z[tid + 512] = (f32x4){0.f, 0.f, 0.f, 0.f}; if (tid < 64) z[tid + 1024] = (f32x4){0.f, 0.f, 0.f, 0.f}; }
          if (tid < 64) { const int c2 = tid;
              const float bt = sigmoidf_(ba_b2);
              float sg = gpar[dir * 4 + h] * softplusf_(ba_a2 + gpar[8 + dir * 4 + h]);
#pragma unroll
              for (int o = 1; o < 64; o <<= 1) { const float t = __shfl_up(sg, o); if (c2 >= o) sg += t; }
              const float G = __shfl(sg, 63); const float ec = fast_exp(sg);
              betav[c2] = bt; cum[c2] = sg; ecum[c2] = ec; dvec[c2] = fast_exp(G - sg); bec[c2] = bt * ec; } }
        DN_BAR();
        for (int rp_ = 0; rp_ < 1 + (((D1REP) >> 1) & 1); ++rp_) {
        { FRESH_TID(); const int lane = tid & 63, wv = __builtin_amdgcn_readfirstlane(tid >> 6), l15 = lane & 15, q = lane >> 4;
          { const int k = tid >> 3, c0 = (tid & 7) * 8; const v4u kk4 = *(const LAS v4u*)(kT + k * HP + c0); const unsigned kw[4] = {kk4.x, kk4.y, kk4.z, kk4.w}; unsigned ow[4];
#pragma unroll
            for (int e = 0; e < 4; ++e) ow[e] = pk2(bflo(kw[e]) * bec[c0 + 2 * e], bfhi(kw[e]) * bec[c0 + 2 * e + 1]);
            *(LAS v4u*)(RT + (64 + k) * HP + c0) = (v4u){ow[0], ow[1], ow[2], ow[3]}; }
#pragma unroll
          for (int tt = 0; tt < 3; ++tt) { const int t = wv + 8 * tt; if (t >= 20) break;
              const bool isq = t >= 10; const int idx = isq ? t - 10 : t; const int ti = (idx >= 6) ? 3 : (idx >= 3) ? 2 : (idx >= 1) ? 1 : 0; const int tj = idx - ti * (ti + 1) / 2;
              const LAS bf16* asrc = (isq ? qN : kN) + (16 * ti + l15) * HP + 8 * q; const LAS bf16* bsrc = kN + (16 * tj + l15) * HP + 8 * q;
              f32x4 acc = {0.f, 0.f, 0.f, 0.f};
              acc = mfma16(*(const LAS bf16x8*)asrc, *(const LAS bf16x8*)bsrc, acc); acc = mfma16(*(const LAS bf16x8*)(asrc + 32), *(const LAS bf16x8*)(bsrc + 32), acc);
              const int j = 16 * tj + l15; const float cj = cum[j];
#pragma unroll
              for (int r = 0; r < 4; ++r) { const int i = 16 * ti + 4 * q + r; const float dec = fast_exp(cum[i] - cj);
                  if (isq) QKd[i * HP + j] = (bf16)f2bf((i >= j) ? acc[r] * dec : 0.f); else Am[i * DP + j] = (i > j) ? acc[r] * dec * betav[i] : 0.f; } } }
        DN_BAR();
        }
        for (int rp_ = 0; rp_ < 1 + (((D1REP) >> 2) & 1); ++rp_) {
        { FRESH_TID(); if (tid < 64) { const int bb = tid >> 4, col = tid & 15; float x[16];
#pragma unroll
            for (int r = 0; r < 16; ++r) { float s = (r == col) ? 1.f : 0.f;
#pragma unroll
                for (int s2 = 0; s2 < r; ++s2) s -= Am[(16 * bb + r) * DP + 16 * bb + s2] * x[s2];
                x[r] = s; }
#pragma unroll
            for (int r = 0; r < 16; ++r) TI[(16 * bb + r) * DP + 16 * bb + col] = x[r]; } }
        DN_BAR();
        }
        for (int rp_ = 0; rp_ < 1 + (((D1REP) >> 3) & 1); ++rp_) {
        { FRESH_TID(); const int p = tid >> 8, r = (tid >> 4) & 15, c = tid & 15; float e = 0.f;
#pragma unroll
          for (int s2 = 0; s2 < 16; ++s2) e += Am[(32 * p + 16 + r) * DP + 32 * p + s2] * TI[(32 * p + s2) * DP + 32 * p + c];
          TMP[(p * 16 + r) * 17 + c] = e;
          DN_BAR();
          float f = 0.f;
#pragma unroll
          for (int s2 = 0; s2 < 16; ++s2) f -= TI[(32 * p + 16 + r) * DP + 32 * p + 16 + s2] * TMP[(p * 16 + s2) * 17 + c];
          TI[(32 * p + 16 + r) * DP + 32 * p + c] = f; }
        DN_BAR();
        }
        for (int rp_ = 0; rp_ < 1 + (((D1REP) >> 4) & 1); ++rp_) {
        { FRESH_TID(); const int r = tid >> 4, c2 = (tid & 15) * 2; float e0 = 0.f, e1 = 0.f;
#pragma unroll 8
          for (int s2 = 0; s2 < 32; ++s2) { const float a = Am[(32 + r) * DP + s2]; e0 += a * TI[s2 * DP + c2]; e1 += a * TI[s2 * DP + c2 + 1]; }
          TMP[r * 36 + c2] = e0; TMP[r * 36 + c2 + 1] = e1;
          DN_BAR();
          float f0 = 0.f, f1 = 0.f;
#pragma unroll 8
          for (int s2 = 0; s2 < 32; ++s2) { const float a = TI[(32 + r) * DP + 32 + s2]; f0 -= a * TMP[s2 * 36 + c2]; f1 -= a * TMP[s2 * 36 + c2 + 1]; }
          TI[(32 + r) * DP + c2] = f0; TI[(32 + r) * DP + c2 + 1] = f1; }
        DN_BAR();
        }
        for (int rp_ = 0; rp_ < 1 + (((D1REP) >> 5) & 1); ++rp_) {
        { FRESH_TID(); const int c = tid >> 3, c0 = (tid & 7) * 8; float x[8];
#pragma unroll
          for (int e = 0; e < 8; ++e) x[e] = (c0 + e <= c) ? TI[c * DP + c0 + e] : 0.f;
          *(LAS v4u*)(TiB + c * HP + c0) = (v4u){pk2(x[0], x[1]), pk2(x[2], x[3]), pk2(x[4], x[5]), pk2(x[6], x[7])}; }
        DN_BAR();
        }
        { FRESH_TID(); const int lane = tid & 63, wv = __builtin_amdgcn_readfirstlane(tid >> 6), l15 = lane & 15, q = lane >> 4;
          f32x4 xa[4]; const LAS bf16* bsrc = RT + (16 * wv + l15) * HP + 8 * q; const bf16x8 b0 = *(const LAS bf16x8*)bsrc, b1 = *(const LAS bf16x8*)(bsrc + 32);
#pragma unroll
          for (int m = 0; m < 4; ++m) { const LAS bf16* asrc = TiB + (16 * m + l15) * HP + 8 * q; f32x4 a_ = {0.f, 0.f, 0.f, 0.f};
              a_ = mfma16(*(const LAS bf16x8*)asrc, b0, a_); xa[m] = mfma16(*(const LAS bf16x8*)(asrc + 32), b1, a_); }
          DN_BAR();
          const int col = 16 * wv + l15;
#pragma unroll
          for (int m = 0; m < 4; ++m) { const int c0 = 16 * m + 4 * q; const f32x4 x = xa[m];
              *(LAS v2u*)(XT + col * HP + c0) = (v2u){pk2(x.x, x.y), pk2(x.z, x.w)};
              *(LAS v2u*)(XdT + col * HP + c0) = (v2u){pk2(x.x * dvec[c0], x.y * dvec[c0 + 1]), pk2(x.z * dvec[c0 + 2], x.w * dvec[c0 + 3])}; } }
        DN_BAR();
        for (int rp_ = 0; rp_ < 1 + (((D1REP) >> 7) & 1); ++rp_) {
        { FRESH_TID(); const int lane = tid & 63, wv = __builtin_amdgcn_readfirstlane(tid >> 6), l15 = lane & 15, q = lane >> 4;
          unsigned char* ub = WSP(unsigned char, WS_DNF + dn_unit_off(b, dir, h, sc));
          const float eG = ecum[63];
#define DN_MM(dst, Ap, Bp) do { f32x4 a_ = {0.f, 0.f, 0.f, 0.f}; a_ = mfma16(*(const LAS bf16x8*)(Ap), *(const LAS bf16x8*)(Bp), a_); dst = mfma16(*(const LAS bf16x8*)((Ap) + 32), *(const LAS bf16x8*)((Bp) + 32), a_); } while (0)
#pragma unroll
          for (int t2 = 0; t2 < 2; ++t2) { const int t = 2 * wv + t2, m = t >> 2, n = t & 3; f32x4 acc;
              DN_MM(acc, kT + (16 * m + l15) * HP + 8 * q, XdT + (16 * n + l15) * HP + 8 * q);
              *(v2u*)(ub + 16384 + (size_t)((n * 4 + m) * 64 + lane) * 8) = (v2u){pk2(acc.x, acc.y), pk2(acc.z, acc.w)};
              DN_MM(acc, QKd + (16 * m + l15) * HP + 8 * q, XT + (16 * n + l15) * HP + 8 * q);
              *(v2u*)(ub + 24576 + (size_t)((n * 4 + m) * 64 + lane) * 8) = (v2u){pk2(acc.x, acc.y), pk2(acc.z, acc.w)}; }
          { const int n = wv >> 1, kk2 = wv & 1; f32x4 z0, z1, y0, y1;
            DN_MM(z0, XdT + (64 + 16 * (2 * kk2) + l15) * HP + 8 * q, kT + (16 * n + l15) * HP + 8 * q);
            DN_MM(z1, XdT + (64 + 16 * (2 * kk2 + 1) + l15) * HP + 8 * q, kT + (16 * n + l15) * HP + 8 * q);
            DN_MM(y0, XT + (64 + 16 * (2 * kk2) + l15) * HP + 8 * q, QKd + (16 * n + l15) * HP + 8 * q);
            DN_MM(y1, XT + (64 + 16 * (2 * kk2 + 1) + l15) * HP + 8 * q, QKd + (16 * n + l15) * HP + 8 * q);
            const int rowi = 16 * n + l15; float mv[8], qv[8]; const float ec = ecum[rowi];
#pragma unroll
            for (int e = 0; e < 8; ++e) { const int kp = 16 * (2 * kk2 + (e >> 2)) + 4 * q + (e & 3); const float zz = (e < 4) ? z0[e & 3] : z1[e & 3], yy = (e < 4) ? y0[e & 3] : y1[e & 3];
                mv[e] = ((kp == rowi) ? eG : 0.f) - zz; qv[e] = ec * bf2f(qN[rowi * HP + kp]) - yy; }
            *(v4u*)(ub + (size_t)((n * 2 + kk2) * 64 + lane) * 16) = (v4u){pk2(mv[0], mv[1]), pk2(mv[2], mv[3]), pk2(mv[4], mv[5]), pk2(mv[6], mv[7])};
            *(v4u*)(ub + 8192 + (size_t)((n * 2 + kk2) * 64 + lane) * 16) = (v4u){pk2(qv[0], qv[1]), pk2(qv[2], qv[3]), pk2(qv[4], qv[5]), pk2(qv[6], qv[7])}; }
#undef DN_MM
        }
        DN_BAR();
        }
    }
}
#undef FRESH_TID
#undef DN_BAR
#undef DN_LOAD
#undef DN_DECODE
DEVI bf16x8 dn_pack(const f32x4& a, const f32x4& b) { const v4u o = {pk2(a.x, a.y), pk2(a.z, a.w), pk2(b.x, b.y), pk2(b.z, b.w)}; return __builtin_bit_cast(bf16x8, o); }
#define SCAN_BAR() asm volatile("s_waitcnt lgkmcnt(0)\n\ts_barrier" ::: "memory")
DEVI unsigned cvtpk(float lo, float hi) { return pk2(lo, hi); }
DEVI bf16x8 dn_pack_hw(const f32x4& a, const f32x4& b) { const v4u o = {cvtpk(a.x, a.y), cvtpk(a.z, a.w), cvtpk(b.x, b.y), cvtpk(b.z, b.w)}; return __builtin_bit_cast(bf16x8, o); }
DEVI void ph_dn_scan(const Ctx& C, int layer) {
    constexpr int SLOTB = 24576, NS = 4, P = 8, NLD = 384, NPC = 4;
    static_assert(NCH % P == 0 || NCH % P == P / 2, "scan pipeline depth: whole groups of P steps plus at most one half group");
    const int lane = C.lane, q = lane >> 4, v16 = lane & 15;
    bf16* DNO = WSP(bf16, WS_DNO);
    for (int u = C.bid; u < NB * 2 * 4 * 2; u += C.G) {
        const int vp = u & 1, h = (u >> 1) & 3, dir = (u >> 3) & 1, b = u >> 4;
        const unsigned char* base = WSP(const unsigned char, WS_DNF + dn_unit_off(b, dir, h, 0));
        if (C.wave < 2) {
            const int vs = 2 * vp + C.wave;
            bf16x8 sf[2]; { const v4u z = {0u, 0u, 0u, 0u}; sf[0] = __builtin_bit_cast(bf16x8, z); sf[1] = sf[0]; }
            bf16* ob = DNO + (size_t)dir * T_ALL * 256 + h * 64 + vs * 16 + v16;
            SCAN_BAR();
#define SCAN_SEG(SGN, SC0, NCHS, SEQ0, LEN) do { \
            bf16* pm[4]; \
            _Pragma("unroll") for (int m = 0; m < 4; ++m) pm[m] = ob + ((long)(SEQ0) + ((SGN) < 0 ? (LEN) - 1 : 0) + (SGN) * (16 * m + 4 * q)) * 256; \
            _Pragma("unroll 1") for (int s2 = 0; s2 < (NCHS); ++s2) { \
                const LAS unsigned char* sl = C.lds + (((SC0) + s2) % NS) * SLOTB; \
                f32x4 o[4], d[4]; \
                _Pragma("unroll") for (int m = 0; m < 4; ++m) { \
                    const bf16x8 ma0 = *(const LAS bf16x8*)(sl + ((m * 2 + 0) * 64 + lane) * 16), ma1 = *(const LAS bf16x8*)(sl + ((m * 2 + 1) * 64 + lane) * 16); \
                    const bf16x8 qa0 = *(const LAS bf16x8*)(sl + 8192 + ((m * 2 + 0) * 64 + lane) * 16), qa1 = *(const LAS bf16x8*)(sl + 8192 + ((m * 2 + 1) * 64 + lane) * 16); \
                    const v2u ncp = *(const LAS v2u*)(sl + 16384 + ((C.wave * 4 + m) * 64 + lane) * 8), ocp = *(const LAS v2u*)(sl + 20480 + ((C.wave * 4 + m) * 64 + lane) * 8); \
                    const f32x4 nc = {bflo(ncp.x), bfhi(ncp.x), bflo(ncp.y), bfhi(ncp.y)}, oc = {bflo(ocp.x), bfhi(ocp.x), bflo(ocp.y), bfhi(ocp.y)}; \
                    d[m] = __builtin_amdgcn_mfma_f32_16x16x32_bf16(ma0, sf[0], nc, 0, 0, 0); d[m] = __builtin_amdgcn_mfma_f32_16x16x32_bf16(ma1, sf[1], d[m], 0, 0, 0); \
                    o[m] = __builtin_amdgcn_mfma_f32_16x16x32_bf16(qa0, sf[0], oc, 0, 0, 0); o[m] = __builtin_amdgcn_mfma_f32_16x16x32_bf16(qa1, sf[1], o[m], 0, 0, 0); } \
                sf[0] = dn_pack_hw(d[0], d[1]); sf[1] = dn_pack_hw(d[2], d[3]); \
                _Pragma("unroll") for (int m = 0; m < 4; ++m) { \
                    _Pragma("unroll") for (int i = 0; i < 4; ++i) pm[m][(SGN) * i * 256] = (bf16)f2bf(o[m][i]); \
                    pm[m] += (SGN) * 64 * 256; } \
                SCAN_BAR(); } } while (0)
            if (dir == 0) { SCAN_SEG(1, 0, NCH_C, T_L + b * LC, LC); SCAN_SEG(1, NCH_C, NCH_L, b * SEQ, SEQ); }
            else          { SCAN_SEG(-1, 0, NCH_C, T_L + b * LC, LC); SCAN_SEG(-1, NCH_C, NCH_L, b * SEQ, SEQ); }
#undef SCAN_SEG
        } else {
            const int lid = C.tid - 128;
            unsigned so[NPC], dofs[NPC];
#pragma unroll
            for (int i = 0; i < NPC; ++i) { const int pp = lid + NLD * i;
                so[i] = (pp < 1024) ? (unsigned)pp * 16u : (pp < 1280) ? 16384u + (unsigned)(vp * 256 + (pp - 1024)) * 16u : 24576u + (unsigned)(vp * 256 + (pp - 1280)) * 16u; dofs[i] = (unsigned)pp * 16u; }
            v4u buf[P][NPC];
#pragma unroll
            for (int s2 = 0; s2 < P; ++s2)
#pragma unroll
                for (int i = 0; i < NPC; ++i) buf[s2][i] = *(const v4u*)(base + (size_t)s2 * DN_UNIT_BYTES + so[i]);
#pragma unroll
            for (int i = 0; i < NPC; ++i) *(LAS v4u*)(C.lds + dofs[i]) = buf[0][i];
            SCAN_BAR();
#define SCAN_LD_STEP(j) do { const int step = sc + (j); const int nxt = (step + P < NCH) ? step + P : NCH - 1; \
                    _Pragma("unroll") for (int i = 0; i < NPC; ++i) buf[(j)][i] = *(const v4u*)(base + (size_t)nxt * DN_UNIT_BYTES + so[i]); \
                    LAS unsigned char* sl = C.lds + ((step + 1) % NS) * SLOTB; \
                    _Pragma("unroll") for (int i = 0; i < NPC; ++i) *(LAS v4u*)(sl + dofs[i]) = buf[((j) + 1) % P][i]; \
                    SCAN_BAR(); } while (0)
            int sc = 0;
#pragma unroll 1
            for (; sc + P <= NCH; sc += P) {
#pragma unroll
                for (int j = 0; j < P; ++j) SCAN_LD_STEP(j);
            }
            if (NCH % P) {
#pragma unroll
                for (int j = 0; j < P / 2; ++j) SCAN_LD_STEP(j);
            }
#undef SCAN_LD_STEP
        }
    }
}
#undef SCAN_BAR

DEVI void ph_finalize(const Ctx& C, int layer, int ntok) {
    const int lane = C.lane;
    const bf16* DNO = WSP(const bf16, WS_DNO); const bf16* proj = WSP(const bf16, WS_PROJ); bf16* mix = WSP(bf16, WS_MIX);
    const f32x4 ong = *(const f32x4*)(INP(23) + layer * 64 + ((4 * lane) & 63));
    constexpr int RU = 4; const int rstep = C.G * 8;
    for (int r0 = C.bid * 8 + C.wave; r0 < ntok; r0 += RU * rstep) {
        v2u zz[RU], d0[RU], d1[RU];
#pragma unroll
        for (int u2 = 0; u2 < RU; ++u2) { const int rr = r0 + u2 * rstep; const size_t r = rr < ntok ? rr : r0;
            d0[u2] = *(const v2u*)(DNO + r * 256 + 4 * lane); d1[u2] = *(const v2u*)(DNO + ((size_t)T_ALL + r) * 256 + 4 * lane);
            zz[u2] = *(const v2u*)(proj + r * N_PROJ + C_DZ + 4 * lane); }
#pragma unroll
        for (int u2 = 0; u2 < RU; ++u2) { const int rr = r0 + u2 * rstep; if (rr >= ntok) continue; const size_t r = rr;
            const f32x4 od = (f32x4){bflo(d0[u2].x), bfhi(d0[u2].x), bflo(d0[u2].y), bfhi(d0[u2].y)} + (f32x4){bflo(d1[u2].x), bfhi(d1[u2].x), bflo(d1[u2].y), bfhi(d1[u2].y)};
            const float ss = group_sum<16>((od.x * od.x + od.y * od.y) + (od.z * od.z + od.w * od.w));
            const float rinv = __builtin_amdgcn_rsqf(ss * (1.f / 64.f) + NORM_EPS);
            const f32x4 z = (f32x4){siluf_(bflo(zz[u2].x)), siluf_(bfhi(zz[u2].x)), siluf_(bflo(zz[u2].y)), siluf_(bfhi(zz[u2].y))};
            const f32x4 o = od * rinv * ong * z; v2u w; w.x = pk2(o.x, o.y); w.y = pk2(o.z, o.w); *(v2u*)(mix + r * D + 768 + 4 * lane) = w; }
    }
}

DEVI void ph_router(const Ctx& C, int layer, int ntok) {
    LAS float* lgt = (LAS float*)C.lds;
    LAS int* cnt = (LAS int*)(lgt + 8 * 16 * 33);
    if (C.tid < 32) cnt[C.tid] = 0;
    __syncthreads();
    const int nt = ntok / 16; const int t0 = (int)((long)C.bid * nt / C.G), t1 = (int)((long)(C.bid + 1) * nt / C.G);
    const float* gn = INP(7) + (size_t)layer * D;
    const int l15 = C.lane & 15, q = C.lane >> 4; LAS float* lg_w = lgt + C.wave * 16 * 33;
    for (int t = t0 + C.wave; t < t1; t += 8) {
        const int row0 = 16 * t, mrow = mod_row(row0);
        const bf16* xa = WSP(const bf16, WS_XRES) + (size_t)(row0 + l15) * D + 4 * q;
        const float* wb = WSP(const float, WS_RWP) + ((size_t)(layer * 9 + mrow) * NE + l15) * D + 4 * q;
        f32x4 acc0 = {0.f, 0.f, 0.f, 0.f}, acc1 = {0.f, 0.f, 0.f, 0.f}; float ssq = 0.f;
#pragma unroll 4
        for (int kk = 0; kk < 64; ++kk) { const v2u aw = *(const v2u*)(xa + 16 * kk); const f32x4 a = {bflo(aw.x), bfhi(aw.x), bflo(aw.y), bfhi(aw.y)}, b0 = *(const f32x4*)(wb + 16 * kk), b1 = *(const f32x4*)(wb + (size_t)16 * D + 16 * kk);
            ssq += (a.x * a.x + a.y * a.y) + (a.z * a.z + a.w * a.w);
            acc0 = __builtin_amdgcn_mfma_f32_16x16x4f32(a.x, b0.x, acc0, 0, 0, 0); acc1 = __builtin_amdgcn_mfma_f32_16x16x4f32(a.x, b1.x, acc1, 0, 0, 0);
            acc0 = __builtin_amdgcn_mfma_f32_16x16x4f32(a.y, b0.y, acc0, 0, 0, 0); acc1 = __builtin_amdgcn_mfma_f32_16x16x4f32(a.y, b1.y, acc1, 0, 0, 0);
            acc0 = __builtin_amdgcn_mfma_f32_16x16x4f32(a.z, b0.z, acc0, 0, 0, 0); acc1 = __builtin_amdgcn_mfma_f32_16x16x4f32(a.z, b1.z, acc1, 0, 0, 0);
            acc0 = __builtin_amdgcn_mfma_f32_16x16x4f32(a.w, b0.w, acc0, 0, 0, 0); acc1 = __builtin_amdgcn_mfma_f32_16x16x4f32(a.w, b1.w, acc1, 0, 0, 0); }
        ssq += __shfl_xor(ssq, 16); ssq += __shfl_xor(ssq, 32);
        const float rinv = __builtin_amdgcn_rsqf(ssq * (1.f / D) + NORM_EPS);
        const float* rb = WSP(const float, WS_RBP) + (size_t)(layer * 9 + mrow) * NE;
        const float bb0 = rb[l15], bb1 = rb[16 + l15];
#pragma unroll
        for (int r = 0; r < 4; ++r) { const float ri = __shfl(rinv, 4 * q + r); lg_w[(4 * q + r) * 33 + l15] = acc0[r] * ri + bb0; lg_w[(4 * q + r) * 33 + 16 + l15] = acc1[r] * ri + bb1; }
        LDS_WAIT();
        if (C.lane < 16) { const int r = row0 + C.lane; float lg[32];
#pragma unroll
            for (int e = 0; e < 32; ++e) lg[e] = lg_w[C.lane * 33 + e];
            int te[4]; float tv[4];
#pragma unroll
            for (int k = 0; k < 4; ++k) { float best = -INFINITY; int bi = 0;
#pragma unroll
                for (int e = 0; e < 32; ++e) if (lg[e] > best) { best = lg[e]; bi = e; }
#pragma unroll
                for (int e = 0; e < 32; ++e) lg[e] = (e == bi) ? -INFINITY : lg[e];
                te[k] = bi; tv[k] = best; }
            float ex[4], es = 0.f;
#pragma unroll
            for (int k = 0; k < 4; ++k) { ex[k] = fast_exp(tv[k] - tv[0]); es += ex[k]; }
            const float ri = 1.f / es;
#pragma unroll
            for (int k = 0; k < 4; ++k) { const int pos = __hip_atomic_fetch_add(&cnt[te[k]], 1, __ATOMIC_RELAXED, __HIP_MEMORY_SCOPE_WORKGROUP);
                WSP(int, WS_TOKE)[(size_t)r * 4 + k] = te[k]; WSP(float, WS_TOKG)[(size_t)r * 4 + k] = ex[k] * ri; WSP(int, WS_TOKP)[(size_t)r * 4 + k] = pos; } }
        LDS_WAIT();
        { const float* sh = mod_vec(C, layer, mrow, 3); const float* scl = mod_vec(C, layer, mrow, 4);
          f32x4 gm[4], sv[4];
#pragma unroll
          for (int j = 0; j < 4; ++j) { const int col = ((j & 2) ? 512 : 0) + 8 * C.lane + 4 * (j & 1); gm[j] = *(const f32x4*)(gn + col) * (*(const f32x4*)(scl + col) + 1.0f); sv[j] = *(const f32x4*)(sh + col); }
#pragma unroll 1
          for (int rr = 0; rr < 16; rr += 2) { v4u xw[2][2];
#pragma unroll
              for (int u2 = 0; u2 < 2; ++u2) { const bf16* xr = WSP(const bf16, WS_XRES) + (size_t)(row0 + rr + u2) * D; xw[u2][0] = *(const v4u*)(xr + 8 * C.lane); xw[u2][1] = *(const v4u*)(xr + 512 + 8 * C.lane); }
#pragma unroll
              for (int u2 = 0; u2 < 2; ++u2) { const float ri = __shfl(rinv, rr + u2); f32x4 f[4];
                  f[0] = (f32x4){bflo(xw[u2][0].x), bfhi(xw[u2][0].x), bflo(xw[u2][0].y), bfhi(xw[u2][0].y)} * ri * gm[0] + sv[0]; f[1] = (f32x4){bflo(xw[u2][0].z), bfhi(xw[u2][0].z), bflo(xw[u2][0].w), bfhi(xw[u2][0].w)} * ri * gm[1] + sv[1];
                  f[2] = (f32x4){bflo(xw[u2][1].x), bfhi(xw[u2][1].x), bflo(xw[u2][1].y), bfhi(xw[u2][1].y)} * ri * gm[2] + sv[2]; f[3] = (f32x4){bflo(xw[u2][1].z), bfhi(xw[u2][1].z), bflo(xw[u2][1].w), bfhi(xw[u2][1].w)} * ri * gm[3] + sv[3];
                  bf16* fr_ = WSP(bf16, WS_F) + (size_t)(row0 + rr + u2) * D;
                  *(v4u*)(fr_ + 8 * C.lane) = (v4u){pk2(f[0].x, f[0].y), pk2(f[0].z, f[0].w), pk2(f[1].x, f[1].y), pk2(f[1].z, f[1].w)};
                  *(v4u*)(fr_ + 512 + 8 * C.lane) = (v4u){pk2(f[2].x, f[2].y), pk2(f[2].z, f[2].w), pk2(f[3].x, f[3].y), pk2(f[3].z, f[3].w)}; } } }
    }
    __syncthreads();
    if (C.tid < 32) WSP(int, WS_BCNT)[C.bid * 32 + C.tid] = cnt[C.tid];
}

DEVI void ph_slots(const Ctx& C, int layer, int ntok) {
    LAS int* tot = (LAS int*)C.lds; LAS int* myoff = tot + 32; LAS int* base = tot + 64; LAS int* part = tot + 96;
    {
      const int e = C.tid & 31, grp = C.tid >> 5; int t = 0, o = 0; const int* bc = WSP(const int, WS_BCNT) + e;
#pragma unroll 4
      for (int b2 = grp; b2 < C.G; b2 += 16) { const int c = bc[b2 * 32]; t += c; if (b2 < C.bid) o += c; }
      part[grp * 64 + e] = t; part[grp * 64 + 32 + e] = o; }
    __syncthreads();
    if (C.tid < 64) { int a = 0;
#pragma unroll
        for (int g = 0; g < 16; ++g) a += part[g * 64 + C.tid];
        if (C.tid < 32) tot[C.tid] = a; else myoff[C.tid - 32] = a; }
    __syncthreads();
    if (C.tid == 0) { int acc = 0; int* texp = WSP(int, WS_TEXP);
        for (int e = 0; e < 32; ++e) { base[e] = acc; const int nt = (tot[e] + 255) >> 8; if (C.bid == 0) for (int i = 0; i < nt; ++i) texp[1 + (acc >> 8) + i] = e; acc += nt << 8; }
        if (C.bid == 0) texp[0] = acc >> 8; }
    __syncthreads();
    int* rowmap = WSP(int, WS_ROWMAP);
    if (C.bid == 0) {
        for (int e = 0; e < 32; ++e) { const int lo = base[e] + tot[e], hi2 = base[e] + (((tot[e] + 255) >> 8) << 8); for (int i = lo + C.tid; i < hi2; i += 512) rowmap[i] = 0; } }
    const int nt = ntok / 16; const int r0 = 16 * (int)((long)C.bid * nt / C.G), r1 = 16 * (int)((long)(C.bid + 1) * nt / C.G);
    for (int i = r0 * 4 + C.tid; i < r1 * 4; i += 512) { const int e = WSP(const int, WS_TOKE)[i]; const int slot = base[e] + myoff[e] + WSP(const int, WS_TOKP)[i];
        WSP(int, WS_SLOT)[i] = slot; rowmap[slot] = i >> 2; }
}

DEVI void ph_attention(const Ctx& C, bool need_ctx, int layer) {
    const attn_body::bf16* QL = WSP(const attn_body::bf16, WS_QL); const attn_body::bf16* QC = WSP(const attn_body::bf16, WS_QC);
    const attn_body::bf16* KB = WSP(const attn_body::bf16, WS_K); const attn_body::bf16* VB = WSP(const attn_body::bf16, WS_V);
    attn_body::bf16* mix = WSP(attn_body::bf16, WS_MIX);
    constexpr int NQL = SEQ / 128, NQC = LC / 128, UL = NB * 6 * NQL, UC = NB * 6 * NQC;
    const float lam_init = 0.8f - 0.6f * fast_exp(-0.3f * (float)layer); float lam;
    { float p1 = 0.f, p2 = 0.f; if (C.lane < 32) { p1 = INP(15)[layer * 32 + C.lane] * INP(16)[layer * 32 + C.lane]; p2 = INP(17)[layer * 32 + C.lane] * INP(18)[layer * 32 + C.lane]; }
      lam = fast_exp(wave_sum(p1)) - fast_exp(wave_sum(p2)) + lam_init; }
    const float post = 1.f - lam_init; const float* subln = INP(19) + layer * 64;
    const int total = UL + (need_ctx ? UC : 0);
    const int conv_at = (layer + 1 < DEPTH) ? (int)(C.bid % 6) : -1; int ui = 0; bool conv_done = false;
    const int conv0_at = (layer == 0) ? (int)((C.bid + 3) % 6) : -1; bool conv0_done = false;
    for (int u = (C.bid + C.G / 2) % C.G; u < total; u += C.G, ++ui) {
        if (ui == conv_at) { __syncthreads(); convert_layer_weights(C, layer + 1, 2); __syncthreads(); conv_done = true; }
        if (ui == conv0_at) { __syncthreads(); convert_layer_weights(C, 0, 1); __syncthreads(); conv0_done = true; }
        const bool isc = u >= UL; int qb, bp;
        if (!isc && (C.G & 7) == 0 && NQL == 32 && C.G == 256) { const int w = u % C.G, rnd = u / C.G; bp = rnd * 8 + (w & 7); qb = w >> 3; }
        else { const int v = isc ? u - UL : u; const int nq = isc ? NQC : NQL; qb = v % nq; bp = v / nq; }
        const int p = bp % 6, b = bp / 6;
        const int slen = isc ? LC : SEQ; const attn_body::bf16* Qbase = isc ? QC : QL;
        const attn_body::bf16* Qa = Qbase + ((size_t)(b * 12 + 2 * p) * slen + qb * 128) * 64; const attn_body::bf16* Qb = Qa + (size_t)slen * 64;
        const attn_body::bf16* Kh = KB + ((size_t)(b * 6 + p) * NKEY + (isc ? SEQ : 0)) * 64; const attn_body::bf16* Vh = VB + ((size_t)(b * 6 + p) * NKEY + (isc ? SEQ : 0)) * 64;
        const size_t row0 = (size_t)(isc ? T_L + b * LC : b * SEQ) + qb * 128;
        attn_body::bf16 *Oa, *Ob; int opitch;
        if (p < 2) { Oa = mix + row0 * D + (2 * p) * 64; Ob = Oa + 64; opitch = D; }
        else { Oa = mix + row0 * D + 512 + (p - 2) * 64; Ob = Oa; opitch = D; }
        const int ntile = isc ? LC / 64 : NKEY / 64;
        if (p < 2) attn_body::attn_unit<8, 0>(Qa, Qb, Kh, Vh, Oa, Ob, opitch, ntile, (char*)C.lds, lam, post, subln);
        else if (C.wave < 4) attn_body::attn_unit<8, 1>(Qa, Qb, Kh, Vh, Oa, Ob, opitch, ntile, (char*)C.lds, lam, post, subln);
        else attn_body::attn_unit<8, 2>(Qa, Qb, Kh, Vh, Oa, Ob, opitch, ntile, (char*)C.lds, lam, post, subln);
    }
    if (conv_at >= 0 && !conv_done) { __syncthreads(); convert_layer_weights(C, layer + 1, 2); __syncthreads(); }
    if (conv0_at >= 0 && !conv0_done) { __syncthreads(); convert_layer_weights(C, 0, 1); __syncthreads(); }
}

DEVI void ph_outproj_ctx(const Ctx& C, int layer) {
    const int l15 = C.lane & 15, q = C.lane >> 4, ks = C.wave & 3, ch = C.wave >> 2;
    const float* g = mod_vec(C, layer, 8, 2);
    LAS float* P = (LAS float*)C.lds; constexpr int PP = 132;
    for (int tile = C.bid; tile < (NB * LC / 64) * (D / 128); tile += C.G) {
        const int r0 = (tile >> 3) * 64, c0 = (tile & 7) * 128;
        const bf16* a = WSP(const bf16, WS_MIX) + (size_t)(T_L + r0 + l15) * D + 256 * ks + 8 * q;
        const bf16* b = WSP(const bf16, WS_WOUT) + (size_t)layer * D * D + (size_t)(c0 + 64 * ch + l15) * D + 256 * ks + 8 * q;
        f32x4 acc[4][4];
#pragma unroll
        for (int m = 0; m < 4; ++m)
#pragma unroll
            for (int n = 0; n < 4; ++n) acc[m][n] = (f32x4){0.f, 0.f, 0.f, 0.f};
#pragma unroll 4
        for (int kk = 0; kk < 8; ++kk) { bf16x8 av[4], bv[4];
#pragma unroll
            for (int m = 0; m < 4; ++m) av[m] = *(const bf16x8*)(a + (size_t)16 * m * D + 32 * kk);
#pragma unroll
            for (int n = 0; n < 4; ++n) bv[n] = *(const bf16x8*)(b + (size_t)16 * n * D + 32 * kk);
#pragma unroll
            for (int m = 0; m < 4; ++m)
#pragma unroll
                for (int n = 0; n < 4; ++n) acc[m][n] = __builtin_amdgcn_mfma_f32_16x16x32_bf16(bv[n], av[m], acc[m][n], 0, 0, 0); }
#pragma unroll
        for (int m = 0; m < 4; ++m)
#pragma unroll
            for (int n = 0; n < 4; ++n) *(LAS f32x4*)(P + (size_t)(ks * 64 + 16 * m + l15) * PP + 64 * ch + 16 * n + 4 * q) = acc[m][n];
        __syncthreads();
        { const int row = C.tid >> 3, cg = (C.tid & 7) * 16; f32x4 s[4];
#pragma unroll
          for (int i = 0; i < 4; ++i) { const LAS float* pp = P + (size_t)row * PP + cg + 4 * i;
              s[i] = (*(const LAS f32x4*)pp + *(const LAS f32x4*)(pp + 64 * PP)) + (*(const LAS f32x4*)(pp + 128 * PP) + *(const LAS f32x4*)(pp + 192 * PP)); }
          const size_t ro = (size_t)(r0 + row) * D + c0 + cg; bf16* xo = WSP(bf16, WS_XRES) + (size_t)T_L * D + ro;
          f32x4 xi[4];
          if (layer == 0) {
#pragma unroll
              for (int i = 0; i < 4; ++i) xi[i] = *(const f32x4*)(INP(2) + ro + 4 * i); }
          else { const v4u w0 = *(const v4u*)xo, w1 = *(const v4u*)(xo + 8);
              xi[0] = (f32x4){bflo(w0.x), bfhi(w0.x), bflo(w0.y), bfhi(w0.y)}; xi[1] = (f32x4){bflo(w0.z), bfhi(w0.z), bflo(w0.w), bfhi(w0.w)};
              xi[2] = (f32x4){bflo(w1.x), bfhi(w1.x), bflo(w1.y), bfhi(w1.y)}; xi[3] = (f32x4){bflo(w1.z), bfhi(w1.z), bflo(w1.w), bfhi(w1.w)}; }
          f32x4 v[4];
#pragma unroll
          for (int i = 0; i < 4; ++i) v[i] = xi[i] + *(const f32x4*)(g + c0 + cg + 4 * i) * s[i];
          *(v4u*)xo = (v4u){pk2(v[0].x, v[0].y), pk2(v[0].z, v[0].w), pk2(v[1].x, v[1].y), pk2(v[1].z, v[1].w)};
          *(v4u*)(xo + 8) = (v4u){pk2(v[2].x, v[2].y), pk2(v[2].z, v[2].w), pk2(v[3].x, v[3].y), pk2(v[3].z, v[3].w)}; }
        __syncthreads();
    }
}

constexpr int PH_PER_LAYER = 10, N_PHASES = 2 + DEPTH * PH_PER_LAYER;
struct Args { const float* in[31]; float* out; unsigned char* ws; int ph_lo, ph_hi; };
template <int MASK> __global__ void __launch_bounds__(512, 2) mk_fwd(Args args) {
    extern __shared__ __attribute__((aligned(16))) unsigned char lds_raw[];
    { LAS unsigned long long* pt = (LAS unsigned long long*)((LAS unsigned char*)lds_raw + PTR_OFF);
      if (threadIdx.x == 0) {
#pragma unroll
          for (int i = 0; i < 31; ++i) pt[i] = (unsigned long long)args.in[i]; } }
    volatile LAS unsigned* MISC = (volatile LAS unsigned*)((LAS unsigned char*)lds_raw + MISC_OFF);
    if (threadIdx.x < 32) MISC[threadIdx.x] = 0u;
    __syncthreads();
#define CTX() Ctx C; { int t_ = threadIdx.x; LAUNDER_V(t_); C.tid = t_; C.lane = t_ & 63; C.wave = __builtin_amdgcn_readfirstlane(t_ >> 6); int b_ = blockIdx.x; LAUNDER_S(b_); C.bid = b_; \
    int g_ = gridDim.x; LAUNDER_S(g_); C.G = g_; unsigned long long w_ = (unsigned long long)args.ws; LAUNDER_S(w_); C.wsi = w_; C.out = (float*)(GAS float*)(unsigned long long)args.out; C.lds = (LAS unsigned char*)lds_raw; }
    const int lo = args.ph_lo, hi = args.ph_hi;
#if MK_N_LAUNCHES == 1
    XcdBarrier bar = xcd_barrier_post((unsigned*)(args.ws + WS_CTL) + CW_BAR, MISC + 8);
#define GRID_BAR() xcd_barrier(bar)
#else
#define GRID_BAR() do {} while (0)
#endif
#define PHON(b) (((MASK) >> (b)) & 1)
#ifndef REP_MASK
#define REP_MASK 0
#endif
#define REP(b) for (int rp_ = 0; rp_ < 1 + (((REP_MASK) >> (b)) & 1); ++rp_)
#define REPX(b, cond) for (int rp_ = 0; rp_ < 1 + ((((REP_MASK) >> (b)) & 1) && (cond)); ++rp_)
#define IN(k) (lo <= (k) && (k) < hi)
#define SEAM(k) do { if (IN(k) && IN((k) + 1)) { GRID_BAR(); if (((REP_MASK) >> 17) & 1) GRID_BAR(); } } while (0)
    if (PHON(0) && IN(0)) REP(0) { CTX(); p0_prologue(C); } SEAM(0);
#define LAYER_BODY(layer) { \
        const int p0 = 1 + layer * PH_PER_LAYER; const bool need_ctx = layer < DEPTH - 1; const int ntok = need_ctx ? T_ALL : T_L; \
        if (PHON(1) && IN(p0 + 0)) REPX(15, layer == 0) { CTX(); ph_norm_mix(C, layer); } SEAM(p0 + 0); \
        if (PHON(2) && IN(p0 + 1)) REP(2) { CTX(); pg8::Gemm g{WSP(const pg8::bf16_t, WS_H), WSP(const pg8::bf16_t, WS_WIN) + (size_t)layer * N_PROJ * D, T_ALL, N_PROJ, D}; \
            pg8::StaticOrder S; S.init(T_ALL, N_PROJ, C.G, C.bid); pg8::EpiBf16<0> E{WSP(pg8::bf16_t, WS_PROJ), N_PROJ, nullptr, 0, 0, 1.f}; \
            pg8::gemm_phase<pg8::EpiBf16<0>, pg8::StaticOrder, true, true>(C.lds, g, S, E); } SEAM(p0 + 1); \
        if (IN(p0 + 2)) { if (PHON(3)) REP(3) { CTX(); ph_attn_prep(C, layer); } if (PHON(5)) REP(5) { CTX(); ph_dn_chunk(C, layer); } } SEAM(p0 + 2); \
        if (IN(p0 + 3)) { if (PHON(6)) REP(6) { CTX(); ph_dn_scan(C, layer); } __syncthreads(); if (PHON(4)) REP(4) { CTX(); ph_gmlp(C, layer, ntok); } __syncthreads(); if (PHON(7)) REP(7) { CTX(); ph_attention(C, need_ctx, layer); } } SEAM(p0 + 3); \
        if (PHON(8) && IN(p0 + 4)) REP(8) { CTX(); ph_finalize(C, layer, ntok); } SEAM(p0 + 4); \
        if (PHON(9) && IN(p0 + 5)) REPX(14, layer == 0) { CTX(); pg8::Gemm g{WSP(const pg8::bf16_t, WS_MIX), WSP(const pg8::bf16_t, WS_WOUT) + (size_t)layer * D * D, T_L, D, D}; \
            pg8::StaticOrder S; S.init(T_L, D, C.G, C.bid); \
            if (layer == 0) { pg8::EpiOutRes<true> E{INP(0), INP(2), WSP(pg8::bf16_t, WS_XRES), WSP(const float, WS_MOD) + (size_t)layer * 9 * 6 * D}; \
                pg8::gemm_phase<pg8::EpiOutRes<true>, pg8::StaticOrder, true, true>(C.lds, g, S, E); } \
            else { pg8::EpiOutRes<false> E{WSP(const pg8::bf16_t, WS_XRES), WSP(const pg8::bf16_t, WS_XRES) + (size_t)T_L * D, WSP(pg8::bf16_t, WS_XRES), WSP(const float, WS_MOD) + (size_t)layer * 9 * 6 * D}; \
                pg8::gemm_phase<pg8::EpiOutRes<false>, pg8::StaticOrder, true, true>(C.lds, g, S, E); } \
            if (need_ctx) ph_outproj_ctx(C, layer); } SEAM(p0 + 5); \
        if (PHON(10) && IN(p0 + 6)) REP(10) { CTX(); ph_router(C, layer, ntok); } SEAM(p0 + 6); \
        if (PHON(11) && IN(p0 + 7)) REP(11) { CTX(); ph_slots(C, layer, ntok); } SEAM(p0 + 7); \
        if (PHON(12) && IN(p0 + 8)) REP(12) { CTX(); pg8::Gemm g{WSP(const pg8::bf16_t, WS_F), WSP(const pg8::bf16_t, WS_WUP) + (size_t)layer * NE * 2 * DE * D, P_ROWS, NE * 2 * DE, D, WSP(const int, WS_ROWMAP)}; \
            pg8::MoeOrder S; S.init(WSP(const int, WS_TEXP), 8, C.G, C.bid); pg8::EpiSwiglu E{WSP(pg8::bf16_t, WS_HID), INP(27) + (size_t)layer * NE * 2 * DE}; \
            pg8::gemm_phase<pg8::EpiSwiglu, pg8::MoeOrder, true, true, true>(C.lds, g, S, E); } SEAM(p0 + 8); \
        if (PHON(13) && IN(p0 + 9)) REP(13) { CTX(); pg8::Gemm g{WSP(const pg8::bf16_t, WS_HID), WSP(const pg8::bf16_t, WS_WDN) + (size_t)layer * NE * D * DE, P_ROWS, NE * D, DE}; \
            pg8::MoeOrder S; S.init(WSP(const int, WS_TEXP), 4, C.G, C.bid); pg8::EpiDown E{WSP(unsigned char, WS_YS), INP(29) + (size_t)layer * NE * D}; \
            pg8::gemm_phase<pg8::EpiDown, pg8::MoeOrder, true, true>(C.lds, g, S, E); } SEAM(p0 + 9); \
    }
    static_assert(DEPTH <= 4, "layer sites");
    if constexpr (DEPTH > 0) LAYER_BODY(0)
    if constexpr (DEPTH > 1) LAYER_BODY(1)
    if constexpr (DEPTH > 2) LAYER_BODY(2)
    if constexpr (DEPTH > 3) LAYER_BODY(3)
#undef LAYER_BODY
    if (PHON(1) && IN(N_PHASES - 1)) REP(16) { CTX(); ph_norm_mix(C, DEPTH); }
#undef IN
#undef SEAM
}

#ifndef EMU
#ifndef FULL_MASK_V
#define FULL_MASK_V 0x3fff
#endif
constexpr int FULL_MASK = FULL_MASK_V;
typedef void (*kern_t)(Args);
static int phase_mask(int p) {
    if (p == 0) return 1; if (p == N_PHASES - 1) return 2;
    const int k = (p - 1) % PH_PER_LAYER; const int m[10] = {2, 4, 8 | 32, 16 | 64 | 128, 256, 512, 1024, 2048, 4096, 8192}; return m[k];
}
static kern_t kern_of_mask(int m) {
    switch (m) {
#if MK_N_LAUNCHES == 1
        case FULL_MASK: return mk_fwd<FULL_MASK>;
#else
        case 1: return mk_fwd<1>; case 2: return mk_fwd<2>; case 4: return mk_fwd<4>; case 8: return mk_fwd<8>; case 16: return mk_fwd<16>; case 32: return mk_fwd<32>; case 192: return mk_fwd<192>; case 256: return mk_fwd<256>;
        case 512: return mk_fwd<512>; case 1024: return mk_fwd<1024>; case 2048: return mk_fwd<2048>; case 4096: return mk_fwd<4096>; case 8192: return mk_fwd<8192>;
#endif
        default: return nullptr;
    }
}
extern "C" void kernel_launch(void* const* d_in, const int* in_sizes, int n_in, void* d_out, int out_size, void* d_ws, size_t ws_size, hipStream_t stream) {
    static int grid = 0;
    if (grid == 0) {
        if (n_in != 31 || in_sizes[0] != T_L * D || out_size != T_L * D || ws_size < WS_END) { fprintf(stderr, "kernel_launch: shape/workspace mismatch (n_in %d, in0 %d, out %d, ws %zu, need %zu)\n", n_in, n_in > 0 ? in_sizes[0] : -1, out_size, ws_size, (size_t)WS_END); grid = -1; return; }
        int dev = 0, cus = 0;
        if (hipGetDevice(&dev) != hipSuccess || hipDeviceGetAttribute(&cus, hipDeviceAttributeMultiprocessorCount, dev) != hipSuccess) { grid = -1; return; }
#if MK_N_LAUNCHES == 1
        const int masks[1] = {FULL_MASK}; const int nm = 1;
#else
        const int masks[13] = {1, 2, 4, 8, 16, 32, 192, 256, 512, 1024, 2048, 4096, 8192}; const int nm = 13;
#endif
        for (int i = 0; i < nm; ++i) {
            if (hipFuncSetAttribute((const void*)kern_of_mask(masks[i]), hipFuncAttributeMaxDynamicSharedMemorySize, LDS_BYTES) != hipSuccess) { fprintf(stderr, "kernel_launch: hipFuncSetAttribute failed\n"); grid = -1; return; }
            int per_cu = 0;
            if (hipOccupancyMaxActiveBlocksPerMultiprocessor(&per_cu, (const void*)kern_of_mask(masks[i]), 512, LDS_BYTES) != hipSuccess || per_cu < 1) fprintf(stderr, "kernel_launch: occupancy query reports %d for mask %d\n", per_cu, masks[i]);
        }
        (void)hipGetLastError();
        grid = cus;
        if (grid > 1024) grid = 1024;
    }
    if (grid < 0) return;
    if (hipMemsetAsync((char*)d_ws + WS_CTL, 0, (CW_BAR + XCD_BAR_WORDS) * sizeof(unsigned), stream) != hipSuccess) return;
    Args a{};
    for (int i = 0; i < 31; ++i) a.in[i] = (const float*)d_in[i];
    a.out = (float*)d_out; a.ws = (unsigned char*)d_ws;
#if MK_N_LAUNCHES == 1
    a.ph_lo = 0; a.ph_hi = N_PHASES;
    hipLaunchKernelGGL(mk_fwd<FULL_MASK>, dim3(grid), dim3(512), LDS_BYTES, stream, a);
#else
    for (int p = 0; p < N_PHASES; ++p) { a.ph_lo = p; a.ph_hi = p + 1; const int pm = phase_mask(p);
        for (int bit = 0; bit < 14; ++bit) { int m = pm & (1 << bit); if (!m) continue; if (m == 64 || m == 128) { if (m == 128) continue; m = 192; } hipLaunchKernelGGL(kern_of_mask(m), dim3(grid), dim3(512), LDS_BYTES, stream, a); } }
#endif
}
#endif
```

```cpp
#ifndef EMU
#include <hip/hip_runtime.h>
#include <cstdio>
#include <cstdint>
#endif

#ifndef MK_N_LAUNCHES
#define MK_N_LAUNCHES 1
#endif

#ifndef CFG_BATCH
#define CFG_BATCH 8
#define CFG_SEQ 4096
#define CFG_CTX 256
#define CFG_DEPTH 4
#endif
constexpr int NB = CFG_BATCH, SEQ = CFG_SEQ, LC = CFG_CTX, DEPTH = CFG_DEPTH, D = 1024;
constexpr int GRID_W = 64;
constexpr int T_L = NB * SEQ, T_C = NB * LC, T_ALL = T_L + T_C;
constexpr int D_IN = 2832, N_PROJ = 2816;
constexpr int NKEY = SEQ + LC;
constexpr int NE = 32, TOPK = 4, DE = 1024;
constexpr int NCH_L = SEQ / 64, NCH_C = LC / 64, NCH = NCH_L + NCH_C;
constexpr int MAX_TILES = (T_ALL * TOPK) / 256 + NE;
constexpr int P_ROWS = MAX_TILES * 256;
constexpr float NORM_EPS = 1e-6f;
static_assert(SEQ % 256 == 0 && LC % 128 == 0 && T_ALL % 256 == 0 && (T_ALL * TOPK) % 256 == 0, "tiling");
constexpr int C_AQ = 0, C_AK = 256, C_AV = 384, C_BU = 512, C_BV = 768, C_CQ = 1024, C_CK = 1280, C_CV = 1536, C_DQKV = 1792, C_DZ = 2560, C_DB = 2816, C_DA = 2824;

#ifndef EMU
#define GAS __attribute__((address_space(1)))
#define LAS __attribute__((address_space(3)))
#define DEVI __device__ __forceinline__
#define LDS_WAIT() asm volatile("s_waitcnt lgkmcnt(0)" ::: "memory")
#define VM_WAIT() asm volatile("s_waitcnt vmcnt(0)" ::: "memory")
#define LAUNDER_V(x) asm volatile("" : "+v"(x))
#define LAUNDER_S(x) asm volatile("" : "+s"(x))
#endif
typedef unsigned short bf16;
typedef unsigned v4u __attribute__((ext_vector_type(4)));
typedef unsigned v2u __attribute__((ext_vector_type(2)));
typedef float f32x4 __attribute__((ext_vector_type(4)));
typedef float f32x2 __attribute__((ext_vector_type(2)));
typedef short bf16x8 __attribute__((ext_vector_type(8)));
typedef GAS unsigned gu32;
#define RLX_AGENT __ATOMIC_RELAXED, __HIP_MEMORY_SCOPE_AGENT
typedef __bf16 hbf2_t __attribute__((ext_vector_type(2)));
DEVI unsigned pk2(float lo, float hi) { const f32x2 v = {lo, hi}; return __builtin_bit_cast(unsigned, __builtin_convertvector(v, hbf2_t)); }
DEVI unsigned f2bf(float f) { return pk2(f, 0.f) & 0xffffu; }
DEVI float bf2f(unsigned h) { return __builtin_bit_cast(float, (h & 0xffffu) << 16); }
DEVI float bflo(unsigned w) { return __builtin_bit_cast(float, w << 16); }
DEVI float bfhi(unsigned w) { return __builtin_bit_cast(float, w & 0xffff0000u); }
DEVI float fast_exp(float x) { return __builtin_amdgcn_exp2f(x * 1.4426950408889634f); }
DEVI float fast_rcp(float x) { return __builtin_amdgcn_rcpf(x); }
DEVI float sigmoidf_(float x) { return fast_rcp(1.f + fast_exp(-x)); }
DEVI float siluf_(float x) { return x * sigmoidf_(x); }
DEVI float tanh_fast(float x) { const float e = fast_exp(-2.f * __builtin_fabsf(x)); const float t = (1.f - e) * fast_rcp(1.f + e); return x < 0.f ? -t : t; }
DEVI float gelu_tanh(float x) { return 0.5f * x * (1.f + tanh_fast(0.7978845608028654f * (x + 0.044715f * x * x * x))); }
DEVI float softplusf_(float x) { return x > 20.f ? x : __builtin_amdgcn_logf(1.f + fast_exp(x)) * 0.6931471805599453f; }
DEVI float wave_sum(float v) {
#pragma unroll
    for (int o = 1; o < 64; o <<= 1) v += __shfl_xor(v, o);
    return v;
}
template <int W> DEVI float group_sum(float v) {
#pragma unroll
    for (int o = 1; o < W; o <<= 1) v += __shfl_xor(v, o);
    return v;
}

constexpr size_t al256(size_t x) { return (x + 255) & ~(size_t)255; }
constexpr size_t WS_CTL = 0, CTL_ZERO_BYTES = 1u << 20;
constexpr size_t WS_MOD   = CTL_ZERO_BYTES;
constexpr size_t WS_WIN   = WS_MOD   + al256((size_t)DEPTH * 9 * 6 * D * 4);
constexpr size_t WS_WOUT  = WS_WIN   + al256((size_t)DEPTH * N_PROJ * D * 2);
constexpr size_t WS_WUP   = WS_WOUT  + al256((size_t)DEPTH * D * D * 2);
constexpr size_t WS_WDN   = WS_WUP   + al256((size_t)DEPTH * NE * 2 * DE * D * 2);
constexpr size_t WS_H     = WS_WDN   + al256((size_t)DEPTH * NE * D * DE * 2);
constexpr size_t WS_F     = WS_H     + al256((size_t)T_ALL * D * 2);
constexpr size_t WS_BA    = WS_F     + al256((size_t)T_ALL * D * 2);
constexpr size_t WS_PROJ  = WS_BA    + al256((size_t)T_ALL * 16 * 4);
constexpr size_t WS_XRES  = WS_PROJ  + al256((size_t)T_ALL * N_PROJ * 2);
constexpr size_t WS_MIX   = WS_XRES  + al256((size_t)T_ALL * D * 4);
constexpr size_t WS_QL    = WS_MIX   + al256((size_t)T_ALL * D * 2);
constexpr size_t WS_QC    = WS_QL    + al256((size_t)NB * 12 * SEQ * 64 * 2);
constexpr size_t WS_K     = WS_QC    + al256((size_t)NB * 12 * LC * 64 * 2);
constexpr size_t WS_V     = WS_K     + al256((size_t)NB * 6 * NKEY * 64 * 2);
constexpr size_t WS_OD    = WS_V     + al256((size_t)NB * 6 * NKEY * 64 * 2);
constexpr size_t WS_DNO   = WS_OD    + al256((size_t)2 * T_ALL * 256 * 2);
constexpr size_t WS_DNF   = WS_DNO   + al256((size_t)2 * T_ALL * 256 * 4);
constexpr size_t DN_UNIT_BYTES = 32768;
constexpr size_t WS_HID   = WS_DNF   + al256((size_t)NB * 2 * 4 * NCH * DN_UNIT_BYTES);
constexpr size_t WS_YS    = WS_HID   + al256((size_t)P_ROWS * DE * 2);
constexpr size_t WS_TOKE  = WS_YS    + al256((size_t)P_ROWS * D * 2);
constexpr size_t WS_TOKG  = WS_TOKE  + al256((size_t)T_ALL * 4 * 4);
constexpr size_t WS_TOKP  = WS_TOKG  + al256((size_t)T_ALL * 4 * 4);
constexpr size_t WS_SLOT  = WS_TOKP  + al256((size_t)T_ALL * 4 * 4);
constexpr size_t WS_BCNT  = WS_SLOT  + al256((size_t)T_ALL * 4 * 4);
constexpr size_t WS_TEXP  = WS_BCNT  + al256((size_t)1024 * 32 * 4);
constexpr size_t WS_RWP   = WS_TEXP  + al256((size_t)(MAX_TILES + 64) * 4);
constexpr size_t WS_RBP   = WS_RWP   + al256((size_t)DEPTH * 9 * NE * D * 4);
constexpr size_t WS_ROWMAP = WS_RBP  + al256((size_t)DEPTH * 9 * NE * 4);
constexpr size_t WS_ROPE  = WS_ROWMAP + al256((size_t)P_ROWS * 4);
constexpr size_t WS_END   = WS_ROPE  + al256((size_t)SEQ * 96 * 4);
constexpr int CW_TMO = 0, CW_CODE = 1, CW_BAR = 4096;
namespace pg8 {
#define PG8_LAS __attribute__((address_space(3)))
typedef unsigned short bf16_t;
typedef short bf16x8 __attribute__((ext_vector_type(8)));
typedef float f32x4 __attribute__((ext_vector_type(4)));
typedef unsigned u32x4 __attribute__((ext_vector_type(4)));
constexpr int BM = 256, BK = 64, HALF = 128, HTB = HALF * BK * 2  , STAGE_BYTES = 8 * HTB, NXCD = 8, WGM = 8;

__host__ __device__ __forceinline__ int lds_byte(int r, int c) { const int st = (r >> 4) * 2 + (c >> 5), rr = r & 15, cc = c & 31, ob = rr * 64 + cc * 2; return st * 1024 + (ob ^ (((ob >> 9) & 1) << 5)); }
__host__ __device__ __forceinline__ void stage_rc(int b, int& R, int& C) { const int st = b / 1024, sb = b % 1024, swz = sb ^ (((sb >> 9) & 1) << 5); R = (st >> 1) * 16 + swz / 64; C = (st & 1) * 32 + (swz % 64) / 2; }
__host__ __device__ __forceinline__ int perm32(int rho) { const int n = rho >> 4, i = rho & 15; return 8 * (i >> 2) + 4 * n + (i & 3); }

struct Unit { int pm, pn; };
struct Gemm { const bf16_t* A; const bf16_t* Bt; int M, N, K; const int* rowmap = nullptr; };

struct StaticOrder {
    int nM, nN, nwg, G, c;
    __host__ __device__ void init(int M, int N, int G_, int c_) { nM = M / BM; nN = N / BM; nwg = nM * nN; G = G_; c = c_; }
    __host__ __device__ bool next(int i, Unit& u) const {
        const long L = (long)i * G + c; if (L >= nwg) return false;
        int wgid = (int)L; { const int q = nwg / NXCD, r = nwg % NXCD, xcd = wgid % NXCD, off = wgid / NXCD; wgid = (xcd < r ? xcd * (q + 1) : r * (q + 1) + (xcd - r) * q) + off; }
        const int nig = WGM * nN, gid = wgid / nig, fm = gid * WGM, gsz = (nM - fm) < WGM ? (nM - fm) : WGM;
        u.pm = fm + ((wgid % nig) % gsz); u.pn = (wgid % nig) / gsz; return true;
    }
    __device__ __forceinline__ void a_ready(const Unit&) const {}
    __device__ __forceinline__ void done(const Unit&) const {}
};

#ifndef EMU
__device__ __forceinline__ unsigned cvt_pk_bf16(float lo, float hi) { unsigned r; asm volatile("v_cvt_pk_bf16_f32 %0, %1, %2" : "=v"(r) : "v"(lo), "v"(hi)); return r; }
#else
__device__ __forceinline__ unsigned cvt_pk_bf16(float lo, float hi) { return pk2(lo, hi); }
#endif
typedef float f32x2 __attribute__((ext_vector_type(2)));
__device__ __forceinline__ f32x2 gelu_pk(f32x2 v) {
    const f32x2 av = __builtin_elementwise_abs(v), d = av * 0.2316418882f + 1.0f;
    f32x2 t; t.x = __builtin_amdgcn_rcpf(d.x); t.y = __builtin_amdgcn_rcpf(d.y);
    f32x2 q = t * 0.5307027145f + (-0.7265760135f); q = q * t + 0.7107068705f; q = q * t + (-0.142248368f); q = q * t + 0.127414796f; q = q * t;
    const f32x2 s = (v * v) * (-0.72134752044f);
    f32x2 e; e.x = __builtin_amdgcn_exp2f(s.x); e.y = __builtin_amdgcn_exp2f(s.y);
    const f32x2 m = v * (q * e), r = v - m;
    f32x2 o; o.x = v.x < 0.f ? m.x : r.x; o.y = v.y < 0.f ? m.y : r.y; return o;
}

template <int ACT  > struct EpiBf16 {
    static constexpr bool PERM = true, AFTER_DRAIN = false; static_assert(ACT == 0 || ACT == 1, "EpiBf16: ACT is 0 (none) or 1 (gelu_pk)");
    bf16_t* O; int ldc; const float* bias; int split_cols; size_t split_stride; float scale0;
    __device__ __forceinline__ void operator()(const f32x4 (&acc)[2][2][4][2], const Unit& u, int wr, int wc, int fr, int fq) const {
        const int row0 = u.pm * BM + wr * 64 + fr; int colt = u.pn * BM; bf16_t* base = O;
        float sc = 1.f; if (split_cols) { const int t = colt / split_cols; base += (size_t)t * split_stride; colt -= t * split_cols; if (t == 0) sc = scale0; }
        const int col0 = colt + wc * 32 + 8 * fq, bcol0 = u.pn * BM + wc * 32 + 8 * fq;
        f32x4 bv[2][2];
#pragma unroll
        for (int bj = 0; bj < 2; ++bj)
#pragma unroll
            for (int n = 0; n < 2; ++n) bv[bj][n] = bias ? *(const f32x4*)(bias + bcol0 + bj * HALF + 4 * n) : (f32x4){0.f, 0.f, 0.f, 0.f};
#pragma unroll
        for (int ai = 0; ai < 2; ++ai)
#pragma unroll
            for (int m = 0; m < 4; ++m) { bf16_t* rowp = base + (size_t)(row0 + ai * HALF + m * 16) * ldc + col0;
#pragma unroll
                for (int bj = 0; bj < 2; ++bj) { f32x4 v0 = acc[ai][bj][m][0] + bv[bj][0], v1 = acc[ai][bj][m][1] + bv[bj][1];
                    if (ACT == 1) { f32x2 a = gelu_pk((f32x2){v0[0], v0[1]}), b = gelu_pk((f32x2){v0[2], v0[3]}), c = gelu_pk((f32x2){v1[0], v1[1]}), d = gelu_pk((f32x2){v1[2], v1[3]});
                        v0 = (f32x4){a.x, a.y, b.x, b.y}; v1 = (f32x4){c.x, c.y, d.x, d.y}; }
                    v0 = v0 * sc; v1 = v1 * sc; u32x4 w; w.x = cvt_pk_bf16(v0[0], v0[1]); w.y = cvt_pk_bf16(v0[2], v0[3]); w.z = cvt_pk_bf16(v1[0], v1[1]); w.w = cvt_pk_bf16(v1[2], v1[3]);
                    *(u32x4*)(rowp + bj * HALF) = w; } }
    }
};

template <bool IN_F32> struct EpiOutRes {
    static constexpr bool PERM = true, AFTER_DRAIN = false;
    const void* xin_l; const void* xin_c;
    bf16_t* xres; const float* mod;
    __device__ __forceinline__ void operator()(const f32x4 (&acc)[2][2][4][2], const Unit& u, int wr, int wc, int fr, int fq) const {
        const int rowt = u.pm * BM; const bool isc = rowt >= T_L; const int mrow = isc ? 8 : rowt / SEQ;
        const float* g = mod + (size_t)(mrow * 6 + 2) * D;
        const size_t inoff = isc ? (size_t)(rowt - T_L) * D : (size_t)rowt * D;
        const float* xf = (const float*)(isc ? xin_c : xin_l) + inoff; const bf16_t* xb = (const bf16_t*)(isc ? xin_c : xin_l) + inoff;
        bf16_t* xo = xres + (size_t)rowt * D;
        const int col0 = u.pn * BM + wc * 32 + 8 * fq;
        f32x4 gv[2][2];
#pragma unroll
        for (int bj = 0; bj < 2; ++bj)
#pragma unroll
            for (int n = 0; n < 2; ++n) gv[bj][n] = *(const f32x4*)(g + col0 + bj * HALF + 4 * n);
#pragma unroll
        for (int ai = 0; ai < 2; ++ai)
#pragma unroll
          for (int mp = 0; mp < 2; ++mp) {
            f32x4 xi[2][2][2];
#pragma unroll
            for (int m2 = 0; m2 < 2; ++m2) { const size_t ro = (size_t)(ai * HALF + wr * 64 + (2 * mp + m2) * 16 + fr) * D + col0;
#pragma unroll
                for (int bj = 0; bj < 2; ++bj) {
                    if constexpr (IN_F32) { xi[m2][bj][0] = *(const f32x4*)(xf + ro + bj * HALF); xi[m2][bj][1] = *(const f32x4*)(xf + ro + bj * HALF + 4); }
                    else { const u32x4 w = *(const u32x4*)(xb + ro + bj * HALF);
                        xi[m2][bj][0] = (f32x4){bflo(w.x), bfhi(w.x), bflo(w.y), bfhi(w.y)}; xi[m2][bj][1] = (f32x4){bflo(w.z), bfhi(w.z), bflo(w.w), bfhi(w.w)}; } } }
#pragma unroll
            for (int m2 = 0; m2 < 2; ++m2) { const int m = 2 * mp + m2; const size_t ro = (size_t)(ai * HALF + wr * 64 + m * 16 + fr) * D + col0;
#pragma unroll
                for (int bj = 0; bj < 2; ++bj) { const f32x4 v0 = xi[m2][bj][0] + gv[bj][0] * acc[ai][bj][m][0], v1 = xi[m2][bj][1] + gv[bj][1] * acc[ai][bj][m][1];
                    u32x4 w; w.x = cvt_pk_bf16(v0[0], v0[1]); w.y = cvt_pk_bf16(v0[2], v0[3]); w.z = cvt_pk_bf16(v1[0], v1[1]); w.w = cvt_pk_bf16(v1[2], v1[3]);
                    *(u32x4*)(xo + ro + bj * HALF) = w; } } }
    }
};
struct EpiSwiglu {
    static constexpr bool PERM = true, AFTER_DRAIN = false;
    bf16_t* hid; const float* bup;
    __device__ __forceinline__ void operator()(const f32x4 (&acc)[2][2][4][2], const Unit& u, int wr, int wc, int fr, int fq) const {
        const int e = u.pn >> 3, j = u.pn & 7; const int h0 = j * HALF + wc * 32 + 8 * fq;
        const float* bg = bup + (size_t)e * 2 * DE + h0; const float* bu = bg + DE;
        f32x4 vg[2], vu[2];
#pragma unroll
        for (int n = 0; n < 2; ++n) { vg[n] = *(const f32x4*)(bg + 4 * n); vu[n] = *(const f32x4*)(bu + 4 * n); }
#pragma unroll
        for (int ai = 0; ai < 2; ++ai)
#pragma unroll
            for (int m = 0; m < 4; ++m) { const size_t row = (size_t)u.pm * BM + ai * HALF + wr * 64 + m * 16 + fr; float o[8];
#pragma unroll
                for (int n = 0; n < 2; ++n) { const f32x4 gt = acc[ai][0][m][n] + vg[n], up = acc[ai][1][m][n] + vu[n];
#pragma unroll
                    for (int i = 0; i < 4; ++i) { const float gg = __builtin_fminf(gt[i], 7.0f); const float uu = __builtin_fminf(__builtin_fmaxf(up[i], -7.0f), 7.0f);
                        o[4 * n + i] = gg * sigmoidf_(1.702f * gg) * (uu + 1.0f); } }
                u32x4 w; w.x = cvt_pk_bf16(o[0], o[1]); w.y = cvt_pk_bf16(o[2], o[3]); w.z = cvt_pk_bf16(o[4], o[5]); w.w = cvt_pk_bf16(o[6], o[7]);
                *(u32x4*)(hid + row * DE + h0) = w; }
    }
};
struct EpiDown {
    static constexpr bool PERM = true, AFTER_DRAIN = false;
    unsigned char* ys; const float* bdn;
    __device__ __forceinline__ void operator()(const f32x4 (&acc)[2][2][4][2], const Unit& u, int wr, int wc, int fr, int fq) const {
        typedef unsigned u32x2v __attribute__((ext_vector_type(2)));
        const int e = u.pn >> 2, j = u.pn & 3; const int col0 = j * BM + wc * 32 + 8 * fq;
        f32x4 bv[2][2];
#pragma unroll
        for (int bj = 0; bj < 2; ++bj)
#pragma unroll
            for (int n = 0; n < 2; ++n) bv[bj][n] = *(const f32x4*)(bdn + (size_t)e * D + col0 + bj * HALF + 4 * n);
#pragma unroll
        for (int ai = 0; ai < 2; ++ai)
#pragma unroll
            for (int m = 0; m < 4; ++m) { const size_t row = (size_t)u.pm * BM + ai * HALF + wr * 64 + m * 16 + fr;
#pragma unroll
                for (int bj = 0; bj < 2; ++bj) { const f32x4 v0 = acc[ai][bj][m][0] + bv[bj][0], v1 = acc[ai][bj][m][1] + bv[bj][1];
                    int w0 = 0, w1 = 0;
                    w0 = __builtin_amdgcn_cvt_pk_fp8_f32(v0[0], v0[1], w0, false); w0 = __builtin_amdgcn_cvt_pk_fp8_f32(v0[2], v0[3], w0, true);
                    w1 = __builtin_amdgcn_cvt_pk_fp8_f32(v1[0], v1[1], w1, false); w1 = __builtin_amdgcn_cvt_pk_fp8_f32(v1[2], v1[3], w1, true);
                    *(u32x2v*)(ys + row * D + col0 + bj * HALF) = (u32x2v){(unsigned)w0, (unsigned)w1}; } }
    }
};
struct MoeOrder {
    const int* texp; int ntiles, nN, nwg, G, c;
    __device__ __forceinline__ void init(const int* texp_, int nN_, int G_, int c_) { texp = texp_; ntiles = texp_[0]; nN = nN_; nwg = ntiles * nN_; G = G_; c = c_; }
    __device__ __forceinline__ bool next(int i, Unit& u) const {
        const long L = (long)i * G + c; if (L >= nwg) return false;
        int wgid = (int)L; { const int q = nwg / NXCD, r = nwg % NXCD, xcd = wgid % NXCD, off = wgid / NXCD; wgid = (xcd < r ? xcd * (q + 1) : r * (q + 1) + (xcd - r) * q) + off; }
        const int nig = WGM * nN, gid = wgid / nig, fm = gid * WGM, gsz = (ntiles - fm) < WGM ? (ntiles - fm) : WGM;
        const int pm = fm + ((wgid % nig) % gsz); u.pm = pm; u.pn = texp[1 + pm] * nN + (wgid % nig) / gsz; return true;
    }
    __device__ __forceinline__ void a_ready(const Unit&) const {}
    __device__ __forceinline__ void done(const Unit&) const {}
};
#ifndef EMU
template <class Epi, class Sched, bool ALIGN_EPI = false, bool SP2 = false, bool GATHER = false>
__device__ __forceinline__ void gemm_phase(PG8_LAS unsigned char* lds, const Gemm g, const Sched& S, const Epi& E) {
    int tid_ = threadIdx.x; asm volatile("" : "+v"(tid_));
    const int tid = tid_, wid = __builtin_amdgcn_readfirstlane(tid >> 6), lane = tid & 63, wr = wid >> 2, wc = wid & 3, fr = lane & 15, fq = lane >> 4;
    const int K = g.K, nt = K / BK;
    unsigned voffA[2], voffB[2]; int gR[2], gC[2];
#pragma unroll
    for (int i = 0; i < 2; ++i) { int R, C; stage_rc(tid * 16 + i * 8192, R, C); const int Rb = Epi::PERM ? ((R & ~31) + perm32(R & 31)) : R;
        voffA[i] = (unsigned)(R * K + C) * 2u; voffB[i] = (unsigned)(Rb * K + C) * 2u; gR[i] = R; gC[i] = C; }
    unsigned voffC[2][2], voffN[2][2];
#define PG8_GOFF(dst, pm_) do { _Pragma("unroll") for (int h_ = 0; h_ < 2; ++h_) _Pragma("unroll") for (int i_ = 0; i_ < 2; ++i_) \
        dst[h_][i_] = (unsigned)(g.rowmap[(size_t)(pm_) * BM + h_ * HALF + gR[i_]] * K + gC[i_]) * 2u; } while (0)
    const size_t kstep = (size_t)(BK * 2);
    const size_t hstep = (size_t)HALF * K * 2;
    const size_t tstep = 2 * hstep;
    const unsigned ldsw = (unsigned)wid * 1024u;
    const int aoff = lds_byte(wr * 64 + fr, fq * 8), boff = lds_byte(wc * 32 + fr, fq * 8);
#define PG8_SA(b, h) (((b) * 2 + (h)) * HTB)
#define PG8_SB(b, h) ((4 + (b) * 2 + (h)) * HTB)
#define PG8_STAGE(bufoff, gbase, voff) do { _Pragma("unroll") for (int _i = 0; _i < 2; ++_i) \
        __builtin_amdgcn_global_load_lds((const unsigned*)((const char*)(gbase) + (voff)[_i]), (PG8_LAS unsigned*)(lds + (bufoff) + ldsw + _i * 8192), 16, 0, 0); } while (0)
#define PG8_LDA(dst, b, h) do { _Pragma("unroll") for (int m = 0; m < 4; ++m) _Pragma("unroll") for (int k = 0; k < 2; ++k) dst[m][k] = *(const PG8_LAS bf16x8*)(lds + PG8_SA(b, h) + aoff + m * 2048 + k * 1024); } while (0)
#define PG8_LDB(dst, b, h) do { _Pragma("unroll") for (int n = 0; n < 2; ++n) _Pragma("unroll") for (int k = 0; k < 2; ++k) dst[n][k] = *(const PG8_LAS bf16x8*)(lds + PG8_SB(b, h) + boff + n * 2048 + k * 1024); } while (0)
#define PG8_MMA(ai, bj, At, Bt) do { __builtin_amdgcn_s_setprio(1); _Pragma("unroll") for (int m = 0; m < 4; ++m) _Pragma("unroll") for (int n = 0; n < 2; ++n) _Pragma("unroll") for (int k = 0; k < 2; ++k) \
        acc[ai][bj][m][n] = __builtin_amdgcn_mfma_f32_16x16x32_bf16(Bt[n][k], At[m][k], acc[ai][bj][m][n], 0, 0, 0); __builtin_amdgcn_s_setprio(0); } while (0)
#define PG8_WAIT_V(n) asm volatile("s_waitcnt vmcnt(" #n ")" ::: "memory")
#define PG8_WAIT_L(n) asm volatile("s_waitcnt lgkmcnt(" #n ")" ::: "memory")
#define PG8_BAR __builtin_amdgcn_s_barrier()
#define PG8_SCHED __builtin_amdgcn_sched_barrier(0)
#define PG8_STAGEA(bufoff, gbase, h, nx) do { if constexpr (GATHER) { _Pragma("unroll") for (int _i = 0; _i < 2; ++_i) { const unsigned o_ = (nx) ? voffN[h][_i] : voffC[h][_i]; \
        __builtin_amdgcn_global_load_lds((const unsigned*)((const char*)(gbase) + o_), (PG8_LAS unsigned*)(lds + (bufoff) + ldsw + _i * 8192), 16, 0, 0); } } \
    else { PG8_STAGE(bufoff, (gbase) + (h) * hstep, voffA); } } while (0)
    Unit cur, nxt; int ui = 0;
    if (!S.next(0, cur)) return;
    f32x4 acc[2][2][4][2];
#pragma unroll
    for (int a = 0; a < 2; ++a)
#pragma unroll
        for (int b = 0; b < 2; ++b)
#pragma unroll
            for (int m = 0; m < 4; ++m)
#pragma unroll
                for (int n = 0; n < 2; ++n) acc[a][b][m][n] = (f32x4){0.f, 0.f, 0.f, 0.f};
    bf16x8 At[4][2], B0[2][2], B1[2][2];
    const char* cA = (const char*)g.A + (GATHER ? (size_t)0 : (size_t)cur.pm * tstep); if constexpr (GATHER) { PG8_GOFF(voffC, cur.pm); }
    const char* cB = (const char*)g.Bt + (size_t)cur.pn * tstep;
    S.a_ready(cur);
    if constexpr (SP2) {
        PG8_STAGE(PG8_SB(0, 0), cB, voffB); PG8_STAGE(PG8_SB(0, 1), cB + hstep, voffB); PG8_STAGEA(PG8_SA(0, 0), cA, 0, false); PG8_STAGEA(PG8_SA(0, 1), cA, 1, false);
        if (wr == 1) PG8_BAR;
        PG8_WAIT_V(2); PG8_BAR;
        PG8_STAGE(PG8_SB(1, 0), cB + kstep, voffB); PG8_STAGEA(PG8_SA(1, 0), cA + kstep, 0, false); PG8_STAGE(PG8_SB(1, 1), cB + hstep + kstep, voffB);
        PG8_WAIT_V(6); PG8_BAR;
    } else {
        PG8_STAGE(PG8_SB(0, 0), cB, voffB); PG8_STAGEA(PG8_SA(0, 0), cA, 0, false); PG8_STAGE(PG8_SB(0, 1), cB + hstep, voffB); PG8_STAGEA(PG8_SA(0, 1), cA, 1, false);
        if (wr == 1) PG8_BAR;
        PG8_WAIT_V(4); PG8_BAR;
        PG8_STAGE(PG8_SB(1, 0), cB + kstep, voffB); PG8_STAGEA(PG8_SA(1, 0), cA + kstep, 0, false); PG8_STAGE(PG8_SB(1, 1), cB + hstep + kstep, voffB);
        PG8_WAIT_V(6); PG8_BAR;
    }
    for (;;) {
        const bool has_next = S.next(ui + 1, nxt);
        if constexpr (GATHER) { if (has_next) { PG8_GOFF(voffN, nxt.pm); } else { _Pragma("unroll") for (int h_ = 0; h_ < 2; ++h_) _Pragma("unroll") for (int i_ = 0; i_ < 2; ++i_) voffN[h_][i_] = voffC[h_][i_]; } }
        const char* nA = (has_next && !GATHER) ? (const char*)g.A + (size_t)nxt.pm * tstep : cA; const char* nB = has_next ? (const char*)g.Bt + (size_t)nxt.pn * tstep : cB;
        for (int t = 0; t < nt; t += 2) {
            const bool last = (t == nt - 2);
            const char* a1 = cA + (size_t)(t + 1) * kstep;
            const char* a2 = last ? nA : cA + (size_t)(t + 2) * kstep; const char* b2 = last ? nB : cB + (size_t)(t + 2) * kstep;
            const char* a3 = a2 + kstep; const char* b3 = b2 + kstep;
            if (last && has_next) S.a_ready(nxt);
            if constexpr (SP2) {
            PG8_LDB(B0, 0, 0); PG8_LDB(B1, 0, 1); PG8_SCHED; PG8_LDA(At, 0, 0); PG8_STAGEA(PG8_SA(1, 1), a1, 1, false);
            PG8_WAIT_V(8); PG8_WAIT_L(0); PG8_BAR; PG8_MMA(0, 0, At, B0); PG8_MMA(0, 1, At, B1); PG8_BAR; PG8_SCHED;
            PG8_LDA(At, 0, 1); PG8_STAGE(PG8_SB(0, 0), b2, voffB); PG8_STAGE(PG8_SB(0, 1), b2 + hstep, voffB); PG8_STAGEA(PG8_SA(0, 0), a2, 0, last);
            PG8_WAIT_V(8); PG8_WAIT_L(0); PG8_BAR; PG8_MMA(1, 0, At, B0); PG8_MMA(1, 1, At, B1); PG8_BAR; PG8_SCHED;
            PG8_LDB(B0, 1, 0); PG8_LDB(B1, 1, 1); PG8_SCHED; PG8_LDA(At, 1, 0); PG8_STAGEA(PG8_SA(0, 1), a2, 1, last);
            PG8_WAIT_V(8); PG8_WAIT_L(0); PG8_BAR; PG8_MMA(0, 0, At, B0); PG8_MMA(0, 1, At, B1); PG8_BAR; PG8_SCHED;
            PG8_LDA(At, 1, 1); PG8_STAGE(PG8_SB(1, 0), b3, voffB); PG8_STAGE(PG8_SB(1, 1), b3 + hstep, voffB); PG8_STAGEA(PG8_SA(1, 0), a3, 0, last);
            PG8_WAIT_V(8); PG8_WAIT_L(0); PG8_BAR; PG8_MMA(1, 0, At, B0); PG8_MMA(1, 1, At, B1); PG8_BAR; PG8_SCHED;
            } else {
            PG8_LDB(B0, 0, 0); PG8_SCHED; PG8_LDA(At, 0, 0); PG8_STAGEA(PG8_SA(1, 1), a1, 1, false);
            PG8_WAIT_L(8); PG8_BAR; PG8_WAIT_L(0); PG8_MMA(0, 0, At, B0); PG8_BAR; PG8_SCHED;
            PG8_LDB(B1, 0, 1); PG8_STAGE(PG8_SB(0, 0), b2, voffB);
            PG8_BAR; PG8_WAIT_L(0); PG8_MMA(0, 1, At, B1); PG8_BAR;
            PG8_LDA(At, 0, 1); PG8_STAGEA(PG8_SA(0, 0), a2, 0, last);
            PG8_BAR; PG8_WAIT_L(0); PG8_MMA(1, 0, At, B0); PG8_BAR; PG8_SCHED;
            PG8_STAGE(PG8_SB(0, 1), b2 + hstep, voffB);
            PG8_WAIT_V(6); PG8_BAR; PG8_MMA(1, 1, At, B1); PG8_BAR;
            PG8_LDB(B0, 1, 0); PG8_SCHED; PG8_LDA(At, 1, 0); PG8_STAGEA(PG8_SA(0, 1), a2, 1, last);
            PG8_WAIT_L(8); PG8_BAR; PG8_WAIT_L(0); PG8_MMA(0, 0, At, B0); PG8_BAR; PG8_SCHED;
            PG8_LDB(B1, 1, 1); PG8_STAGE(PG8_SB(1, 0), b3, voffB);
            PG8_BAR; PG8_WAIT_L(0); PG8_MMA(0, 1, At, B1); PG8_BAR;
            PG8_LDA(At, 1, 1); PG8_STAGEA(PG8_SA(1, 0), a3, 0, last);
            PG8_BAR; PG8_WAIT_L(0); PG8_MMA(1, 0, At, B0); PG8_BAR; PG8_SCHED;
            PG8_STAGE(PG8_SB(1, 1), b3 + hstep, voffB);
            PG8_WAIT_V(6); PG8_BAR; PG8_MMA(1, 1, At, B1); PG8_BAR;
            }
        }
        if constexpr (ALIGN_EPI) { if (wr == 0) PG8_BAR; }
        if constexpr (!Epi::AFTER_DRAIN) { E(acc, cur, wr, wc, fr, fq); S.done(cur); }
        if (!has_next) break;
#pragma unroll
        for (int a = 0; a < 2; ++a)
#pragma unroll
            for (int b = 0; b < 2; ++b)
#pragma unroll
                for (int m = 0; m < 4; ++m)
#pragma unroll
                    for (int n = 0; n < 2; ++n) acc[a][b][m][n] = (f32x4){0.f, 0.f, 0.f, 0.f};
        cur = nxt; cA = nA; cB = nB; ++ui;
        if constexpr (GATHER) { _Pragma("unroll") for (int h_ = 0; h_ < 2; ++h_) _Pragma("unroll") for (int i_ = 0; i_ < 2; ++i_) voffC[h_][i_] = voffN[h_][i_]; }
        if constexpr (ALIGN_EPI) { if (wr == 1) PG8_BAR; }
    }
    PG8_WAIT_V(0);
    if constexpr (!ALIGN_EPI) { if (wr == 0) PG8_BAR; }
    PG8_BAR;
    if constexpr (Epi::AFTER_DRAIN) { E.fused(acc, cur, wr, wc, fr, fq, lds, wid, lane); S.done(cur); }
#undef PG8_SA
#undef PG8_SB
#undef PG8_STAGE
#undef PG8_STAGEA
#undef PG8_GOFF
#undef PG8_LDA
#undef PG8_LDB
#undef PG8_MMA
#undef PG8_WAIT_V
#undef PG8_WAIT_L
#undef PG8_BAR
#undef PG8_SCHED
}
#else
EMU_GEMM_PHASE
#endif
}
#ifndef EMU
namespace attn_body {
using bf16=unsigned short;
using bf16x8=__attribute__((ext_vector_type(8)))short;
using s16x4=__attribute__((ext_vector_type(4)))short;
using f32x16=__attribute__((ext_vector_type(16)))float;
using u32x4=__attribute__((ext_vector_type(4)))unsigned;
constexpr int D=64,DM=64;
constexpr int NW=8,QBLK=32,QB=QBLK*NW,KVBLK=64;
__device__ __forceinline__ int crow(int r,int hi){return (r&3)+8*(r>>2)+4*hi;}
#define SBAR() __builtin_amdgcn_sched_barrier(0)
constexpr int NSLOT=3, SLOTB=8192;
constexpr int LDS_K=0, LDS_V=NSLOT*SLOTB, LDS_WS=2*NSLOT*SLOTB, LDS_OST=LDS_WS+NW*64*4, LDS_BYTES=LDS_OST+NW*4096;
__device__ __forceinline__ void glds16(const void*gsrc,unsigned lds_dst){unsigned keep;
  asm volatile("s_mov_b32 %0, m0\n\ts_mov_b32 m0, %2\n\ts_nop 0\n\tglobal_load_lds_dwordx4 %1, off\n\ts_mov_b32 m0, %0":"=&s"(keep):"v"(gsrc),"s"(lds_dst):"memory");}
__device__ __forceinline__ float max3f(float a,float b,float c){float r;asm("v_max3_f32 %0, %1, %2, %3":"=v"(r):"v"(a),"v"(b),"v"(c));return r;}
__device__ __forceinline__ float max2f(float a,float b){float r;asm("v_max_f32_e32 %0, %1, %2":"=v"(r):"v"(a),"v"(b));return r;}
__device__ __forceinline__ float fadd_s(float a,float b){float r;asm("v_add_f32_e32 %0, %1, %2":"=v"(r):"v"(a),"v"(b));return r;}
__device__ __forceinline__ float fsub_s(float a,float b){float r;asm("v_sub_f32_e32 %0, %1, %2":"=v"(r):"v"(a),"v"(b));return r;}
typedef float f32x2_t __attribute__((ext_vector_type(2))); typedef __bf16 bf16x2_t __attribute__((ext_vector_type(2)));
__device__ __forceinline__ unsigned cvtpk_s(float lo,float hi){f32x2_t v={lo,hi};bf16x2_t b=__builtin_convertvector(v,bf16x2_t);return __builtin_bit_cast(unsigned,b);}
#define WAIT_BAR(N) asm volatile("s_waitcnt vmcnt(" #N ") lgkmcnt(0)\n\ts_barrier":::"memory")

template<int MODE> __device__ __forceinline__ constexpr bool d0_on(int d0){ return MODE==0 || (MODE==1 && d0<2) || (MODE==2 && d0>=2); }
template<int MODE> __device__ __forceinline__ void qkt(f32x16&p0,f32x16&p1,const char*Kslot,const bf16x8*qr,const f32x16&negm,int r32,int hi){
  const char*kb=Kslot+hi*1024+r32*16;
  constexpr int D0A=(MODE==2)?2:0, D0B=(MODE==1)?2:4;
  #pragma unroll
  for(int d0=D0A;d0<D0B;++d0){
    const bf16x8 b0=*reinterpret_cast<const bf16x8*>(kb+d0*2048);
    const bf16x8 b1=*reinterpret_cast<const bf16x8*>(kb+d0*2048+512);
    if(d0==D0A){p0=__builtin_amdgcn_mfma_f32_32x32x16_bf16(b0,qr[d0],negm,0,0,0);p1=__builtin_amdgcn_mfma_f32_32x32x16_bf16(b1,qr[d0],negm,0,0,0);}
    else{p0=__builtin_amdgcn_mfma_f32_32x32x16_bf16(b0,qr[d0],p0,0,0,0);p1=__builtin_amdgcn_mfma_f32_32x32x16_bf16(b1,qr[d0],p1,0,0,0);}}
}
template<int MODE,int IDX> __device__ __forceinline__ void qk_mf(f32x16&Cx,const bf16x8&k,const bf16x8&q,const f32x16&negm){
  if constexpr(d0_on<MODE>(IDX>>1)){ constexpr bool first=((IDX>>1)==((MODE==2)?2:0));
    if constexpr(first) Cx=__builtin_amdgcn_mfma_f32_32x32x16_bf16(k,q,negm,0,0,0); else Cx=__builtin_amdgcn_mfma_f32_32x32x16_bf16(k,q,Cx,0,0,0); }
}
typedef __attribute__((address_space(3))) const char* lds_cptr;
typedef short v4i16_t __attribute__((ext_vector_type(4)));
template<int MODE> __device__ __forceinline__ void kload8(bf16x8*kf,lds_cptr kp){
  #pragma unroll
  for(int j=0;j<4;++j) if(d0_on<MODE>(j)){ kf[2*j]=*(const __attribute__((address_space(3))) bf16x8*)(kp+j*2048); kf[2*j+1]=*(const __attribute__((address_space(3))) bf16x8*)(kp+j*2048+512); }
}
__device__ __forceinline__ void kload2(bf16x8*kf,lds_cptr kp,int j){ kf[2*j]=*(const __attribute__((address_space(3))) bf16x8*)(kp+j*2048); kf[2*j+1]=*(const __attribute__((address_space(3))) bf16x8*)(kp+j*2048+512); }
__device__ __forceinline__ s16x4 vtr(lds_cptr p){ return __builtin_bit_cast(s16x4,__builtin_amdgcn_ds_read_tr16_b64_v4i16((__attribute__((address_space(3))) v4i16_t*)p)); }
__device__ __forceinline__ float rowmax(const f32x16&p0,const f32x16&p1){
  float a=max3f(p0[0],p0[1],p1[0]),b=max3f(p0[2],p0[3],p1[1]);a=max3f(a,p1[2],p1[3]);
  #pragma unroll
  for(int r=4;r<16;r+=4){a=max3f(a,p0[r],p0[r+1]);b=max3f(b,p0[r+2],p0[r+3]);a=max3f(a,p1[r],p1[r+1]);b=max3f(b,p1[r+2],p1[r+3]);}
  const float m=max2f(a,b);
  auto rr=__builtin_amdgcn_permlane32_swap(__float_as_uint(m),__float_as_uint(m),false,false);
  return max2f(__uint_as_float(rr[0]),__uint_as_float(rr[1]));
}
__device__ __forceinline__ void pv(f32x16*o,int vb,bf16x8 pa0,bf16x8 pa1,bf16x8 pa2,bf16x8 pa3){
  #pragma unroll
  for(int d0=0;d0<2;++d0){s16x4 lo[4],hi[4];
    #pragma unroll
    for(int ks=0;ks<4;++ks){
      asm volatile("ds_read_b64_tr_b16 %0,%1 offset:%c2":"=&v"(lo[ks]):"v"(vb),"i"(d0*4096+ks*1024):"memory");
      asm volatile("ds_read_b64_tr_b16 %0,%1 offset:%c2":"=&v"(hi[ks]):"v"(vb),"i"(d0*4096+ks*1024+512):"memory");}
    asm volatile("s_waitcnt lgkmcnt(0)":::"memory");SBAR();
    #define PK(k) (bf16x8){lo[k][0],lo[k][1],lo[k][2],lo[k][3],hi[k][0],hi[k][1],hi[k][2],hi[k][3]}
    o[d0]=__builtin_amdgcn_mfma_f32_32x32x16_bf16(pa0,PK(0),o[d0],0,0,0);
    o[d0]=__builtin_amdgcn_mfma_f32_32x32x16_bf16(pa1,PK(1),o[d0],0,0,0);
    o[d0]=__builtin_amdgcn_mfma_f32_32x32x16_bf16(pa2,PK(2),o[d0],0,0,0);
    o[d0]=__builtin_amdgcn_mfma_f32_32x32x16_bf16(pa3,PK(3),o[d0],0,0,0);
    #undef PK
  }
}

#ifndef ATTN_STORE16
#define ATTN_STORE16(p,v) (*(u32x4*)(p)=(v))
#endif
template<int THRL,int MODE> __device__ __forceinline__ void attn_unit(const bf16*Qa,const bf16*Qb,const bf16*__restrict__ Kh,const bf16*__restrict__ Vh,bf16*Oa,bf16*Ob,int opitch,int NT,char*shm,float lam,float post,const float*subln){
  int tid_=threadIdx.x; asm volatile("":"+v"(tid_)); const int tid=tid_,lane=tid&63,r32=lane&31,hi=lane>>5; const int wid=__builtin_amdgcn_readfirstlane(tid>>6);
  const bf16*Qw=(wid<4?Qa:Qb)+(long)((wid&3)*QBLK)*DM;
  const unsigned lds0=(unsigned)(uintptr_t)shm;
  float*wsf=(float*)(shm+LDS_WS)+wid*64;
  const bf16*ksrc=Kh+(long)lane*DM+wid*8;
  const bf16*vsrc=Vh+(long)(16*(wid&3)+(lane>>2))*DM+(wid>>2)*32+(lane&3)*8;
  const unsigned kdst=lds0+LDS_K+wid*1024, vdst=lds0+LDS_V+wid*1024;
  #define DMA_K(t,slot) glds16(ksrc+(long)(t)*KVBLK*DM,(unsigned)__builtin_amdgcn_readfirstlane(kdst+(slot)))
  #define DMA_V(t,slot) glds16(vsrc+(long)(t)*KVBLK*DM,(unsigned)__builtin_amdgcn_readfirstlane(vdst+(slot)))
  const int vb0=(int)(lds0+LDS_V)+((lane>>4)&1)*32+(lane&3)*8+(4*hi+((lane&15)>>2))*64;
  const char*Kbase=shm+LDS_K; bf16x8 kf[8];
  const lds_cptr shm3=(lds_cptr)shm; const lds_cptr kp0=shm3+LDS_K+hi*1024+r32*16; const lds_cptr vp0=shm3+LDS_V+((lane>>4)&1)*32+(lane&3)*8+(4*hi+((lane&15)>>2))*64;
  DMA_K(0,0);DMA_V(0,0);DMA_K(1,SLOTB);
  bf16x8 qr[4];
  #pragma unroll
  for(int d0=0;d0<4;++d0)qr[d0]=*reinterpret_cast<const bf16x8*>(&Qw[(long)r32*DM+d0*16+hi*8]);
  float mhat=0.f,l_reg=0.f;f32x16 o[2];o[0]=f32x16{};o[1]=f32x16{};f32x16 negm=f32x16{};asm volatile("":"+v"(negm));
  #define CMASK(P0,P1,t) do{}while(0)
  bool resc=false;
  #define START(P0,P1) do{ const float rm=rowmax(P0,P1); resc=false; \
    { const float dl=rm; mhat=fadd_s(mhat,dl); \
      _Pragma("unroll") for(int r=0;r<16;++r){P0[r]=fsub_s(P0[r],dl);P1[r]=fsub_s(P1[r],dl);} \
      _Pragma("unroll") for(int r=0;r<16;++r)negm[r]=-mhat; asm volatile("":"+v"(negm)); } \
    _Pragma("unroll") for(int r=0;r<16;++r)P0[r]=__builtin_amdgcn_exp2f(P0[r]); }while(0)
  #define RESC() do{ if(resc){ asm volatile("s_waitcnt lgkmcnt(0)":::"memory"); \
      _Pragma("unroll") for(int d_=0;d_<2;++d_) _Pragma("unroll") for(int r=0;r<16;++r)o[d_][r]*=wsf[crow(r,hi)]; } }while(0)
  f32x16 pA0,pA1,pB0,pB1;
  int sl_prev=0,sl_cur=0,sl_next=SLOTB;
  #define ROT() do{sl_prev=sl_cur;sl_cur=sl_next;sl_next=(sl_next==(NSLOT-1)*SLOTB)?0:sl_next+SLOTB;}while(0)
  DMA_K(2,2*SLOTB);
  WAIT_BAR(3);
  qkt<MODE>(pA0,pA1,Kbase,qr,negm,r32,hi);asm volatile("s_nop 15\n\ts_nop 7":"+v"(pA0),"+v"(pA1));CMASK(pA0,pA1,0);
  START(pA0,pA1);
  _Pragma("unroll") for(int r=0;r<16;++r)pA1[r]=__builtin_amdgcn_exp2f(pA1[r]);
  WAIT_BAR(0);
  DMA_K(3,0);DMA_V(1,SLOTB);
  ROT();
  kload8<MODE>(kf,kp0+sl_cur);
  WAIT_BAR(2);
  s16x4 vlo[8],vhi[8]; u32x4 pw0,pw1,pw2,pw3;
  #define PKW(P,B) cvtpk_s(P[B],P[B+1])
  #define PAF(k) __builtin_bit_cast(bf16x8,pw##k)
  #define VFR(i) (bf16x8){vlo[i][0],vlo[i][1],vlo[i][2],vlo[i][3],vhi[i][0],vhi[i][1],vhi[i][2],vhi[i][3]}
  #define PIN(x) asm volatile("":"+v"(x))
  #define MX3(a,b,c) __builtin_fmaxf(__builtin_fmaxf((a),(b)),(c))
  #define GAPA(MF,A0,A1,A2,A3,W0,W1,PW) do{ MF; sacc+=A0; sacc+=A1; sacc+=A2; sacc+=A3; PIN(sacc); W0; W1; PIN(PW); SBAR(); }while(0)
  #define EX(v) __builtin_amdgcn_exp2f(v)
  #define GAPB(MF,X,B) do{ MF; X[B]=EX(X[B]); X[B+1]=EX(X[B+1]); X[B+2]=EX(X[B+2]); X[B+3]=EX(X[B+3]); PIN(X); SBAR(); }while(0)
  #define VRD(i) do{ vlo[i]=vtr(vp_+(((i)>>2)*4096+((i)&3)*1024)); vhi[i]=vtr(vp_+(((i)>>2)*4096+((i)&3)*1024+512)); }while(0)
  #define KRD(G,j) do{ if((G)&&d0_on<MODE>(j)){ kload2(kf,kp0+sl_next,j); SBAR(); } }while(0)
  #define STEP(C0,C1,P0,P1,t,GK,GV,GL) do{ SBAR(); \
    const lds_cptr vp_=vp0+sl_prev; \
    VRD(0); SBAR(); float sacc=(P0[0]+P0[1]); \
    GAPA((qk_mf<MODE,0>(C0,kf[0],qr[0],negm)), P0[2],P0[3],P0[4],P0[5],     pw0[0]=PKW(P0,0), pw0[1]=PKW(P0,2), pw0); \
    VRD(4); SBAR(); GAPA((qk_mf<MODE,1>(C1,kf[1],qr[0],negm)), P0[6],P0[7],P0[8],P0[9],     pw0[2]=PKW(P0,4), pw0[3]=PKW(P0,6), pw0); \
    VRD(1); SBAR(); GAPA((qk_mf<MODE,2>(C0,kf[2],qr[1],negm)),   P0[10],P0[11],P0[12],P0[13], pw1[0]=PKW(P0,8), pw1[1]=PKW(P0,10), pw1); \
    VRD(5); SBAR(); GAPA((qk_mf<MODE,3>(C1,kf[3],qr[1],negm)),   P0[14],P0[15],P1[0],P1[1],   pw1[2]=PKW(P0,12),pw1[3]=PKW(P0,14), pw1); \
    VRD(2); SBAR(); GAPA((qk_mf<MODE,4>(C0,kf[4],qr[2],negm)),   P1[2],P1[3],P1[4],P1[5],     pw2[0]=PKW(P1,0), pw2[1]=PKW(P1,2), pw2); \
    VRD(6); SBAR(); GAPA((qk_mf<MODE,5>(C1,kf[5],qr[2],negm)),   P1[6],P1[7],P1[8],P1[9],     pw2[2]=PKW(P1,4), pw2[3]=PKW(P1,6), pw2); \
    VRD(3); SBAR(); GAPA((qk_mf<MODE,6>(C0,kf[6],qr[3],negm)),   P1[10],P1[11],P1[12],P1[13], pw3[0]=PKW(P1,8), pw3[1]=PKW(P1,10), pw3); \
    VRD(7); SBAR(); GAPA((qk_mf<MODE,7>(C1,kf[7],qr[3],negm)),   P1[14],P1[15],0.f,0.f,       pw3[2]=PKW(P1,12),pw3[3]=PKW(P1,14), pw3); \
    l_reg+=sacc; \
    if(GK){DMA_K((t)+3,sl_cur);} if(GV){DMA_V((t)+1,sl_next);} \
    CMASK(C0,C1,t); \
    { float a=MX3(C0[0],C0[1],C1[0]),b=MX3(C0[2],C0[3],C1[1]); a=MX3(a,C1[2],C1[3]); \
      _Pragma("unroll") for(int r=4;r<16;r+=4){a=MX3(a,C0[r],C0[r+1]);b=MX3(b,C0[r+2],C0[r+3]);a=MX3(a,C1[r],C1[r+1]);b=MX3(b,C1[r+2],C1[r+3]);} \
      float rm=__builtin_fmaxf(a,b); { auto rr=__builtin_amdgcn_permlane32_swap(__float_as_uint(rm),__float_as_uint(rm),false,false); rm=__builtin_fmaxf(__uint_as_float(rr[0]),__uint_as_float(rr[1])); } \
      resc=false; \
      if(__builtin_expect(__any(rm>(float)THRL),0)){ const float dl=__builtin_fmaxf(rm,0.f); mhat+=dl; \
        _Pragma("unroll") for(int r=0;r<16;++r){C0[r]-=dl;C1[r]-=dl;} \
        _Pragma("unroll") for(int r=0;r<16;++r)negm[r]=-mhat; asm volatile("":"+v"(negm)); \
        const float f=__builtin_amdgcn_exp2f(-dl); l_reg*=f; if(hi==0)wsf[r32]=f; resc=true; } } \
    SBAR(); \
    GAPB(o[0]=__builtin_amdgcn_mfma_f32_32x32x16_bf16(PAF(0),VFR(0),o[0],0,0,0), C0,0); \
    GAPB(o[1]=__builtin_amdgcn_mfma_f32_32x32x16_bf16(PAF(0),VFR(4),o[1],0,0,0), C0,4); \
    KRD(GL,0); GAPB(o[0]=__builtin_amdgcn_mfma_f32_32x32x16_bf16(PAF(1),VFR(1),o[0],0,0,0), C0,8); \
    KRD(GL,1); GAPB(o[1]=__builtin_amdgcn_mfma_f32_32x32x16_bf16(PAF(1),VFR(5),o[1],0,0,0), C0,12); \
    KRD(GL,2); GAPB(o[0]=__builtin_amdgcn_mfma_f32_32x32x16_bf16(PAF(2),VFR(2),o[0],0,0,0), C1,0); \
    KRD(GL,3); GAPB(o[1]=__builtin_amdgcn_mfma_f32_32x32x16_bf16(PAF(2),VFR(6),o[1],0,0,0), C1,4); \
    GAPB(o[0]=__builtin_amdgcn_mfma_f32_32x32x16_bf16(PAF(3),VFR(3),o[0],0,0,0), C1,8); \
    GAPB(o[1]=__builtin_amdgcn_mfma_f32_32x32x16_bf16(PAF(3),VFR(7),o[1],0,0,0), C1,12); \
    }while(0)
  int t=1;
  for(;t+5<NT;t+=2){
    STEP(pB0,pB1,pA0,pA1,t,true,true,true);     WAIT_BAR(2); RESC(); ROT();
    STEP(pA0,pA1,pB0,pB1,t+1,true,true,true);   WAIT_BAR(2); RESC(); ROT();
  }
  #define ENDW(tt) do{ if((tt)+3<NT){WAIT_BAR(2);} else if((tt)+2<NT){WAIT_BAR(1);} else {WAIT_BAR(0);} }while(0)
  for(;t+1<NT;t+=2){
    STEP(pB0,pB1,pA0,pA1,t,(t+3<NT),(t+1<NT),(t+1<NT));       ENDW(t);   RESC(); ROT();
    STEP(pA0,pA1,pB0,pB1,t+1,(t+4<NT),(t+2<NT),(t+2<NT));     ENDW(t+1); RESC(); ROT();
  }
  STEP(pB0,pB1,pA0,pA1,NT-1,false,false,false); RESC();
  { float sacc=pB0[0]+pB0[1]; _Pragma("unroll") for(int r=2;r<16;++r)sacc+=pB0[r]; _Pragma("unroll") for(int r=0;r<16;++r)sacc+=pB1[r]; l_reg+=sacc;
    pw0=(u32x4){PKW(pB0,0),PKW(pB0,2),PKW(pB0,4),PKW(pB0,6)};pw1=(u32x4){PKW(pB0,8),PKW(pB0,10),PKW(pB0,12),PKW(pB0,14)};pw2=(u32x4){PKW(pB1,0),PKW(pB1,2),PKW(pB1,4),PKW(pB1,6)};pw3=(u32x4){PKW(pB1,8),PKW(pB1,10),PKW(pB1,12),PKW(pB1,14)};
    SBAR(); pv(o,vb0+sl_cur,PAF(0),PAF(1),PAF(2),PAF(3)); }
  #undef PKW
  #undef PAF
  #undef VFR
  #undef PIN
  #undef MX3
  #undef GAPA
  #undef GAPB
  #undef EX
  #undef VRD
  #undef KRD
  #undef STEP
  #undef ENDW
  {auto rr=__builtin_amdgcn_permlane32_swap(__float_as_uint(l_reg),__float_as_uint(l_reg),false,false);l_reg=__uint_as_float(rr[0])+__uint_as_float(rr[1]);}
  if(hi==0)wsf[32+r32]=l_reg;asm volatile("s_waitcnt lgkmcnt(0)":::"memory");
  float rli[16];
  #pragma unroll
  for(int r=0;r<16;++r)rli[r]=__builtin_amdgcn_rcpf(wsf[32+crow(r,hi)]);
  bf16*Ow=(wid<4?Oa:Ob)+(long)((wid&3)*QBLK)*opitch;
  { bf16*stg=(bf16*)(shm+LDS_OST)+wid*2048;
    #pragma unroll
    for(int r=0;r<16;++r){const int orow=crow(r,hi);
      #pragma unroll
      for(int d0=0;d0<2;++d0)stg[orow*64+d0*32+r32]=(bf16)f2bf(o[d0][r]*rli[r]);}
    asm volatile("s_waitcnt lgkmcnt(0)":::"memory");
    if constexpr(MODE==0){
      #pragma unroll
      for(int i=0;i<4;++i){const int row=i*8+(lane>>3),ch=lane&7; const u32x4 v=*(const u32x4*)(stg+row*64+ch*8); ATTN_STORE16(Ow+(long)row*opitch+ch*8,v);}
    } else {
      asm volatile("s_barrier":::"memory");
      if constexpr(MODE==1){ const bf16*stg2=stg+4*2048; const int ch=lane&7; float sb[8];
        #pragma unroll
        for(int e=0;e<8;++e)sb[e]=subln[ch*8+e]*post;
        #pragma unroll
        for(int i=0;i<4;++i){const int row=i*8+(lane>>3); const u32x4 v1=*(const u32x4*)(stg+row*64+ch*8),v2=*(const u32x4*)(stg2+row*64+ch*8);
          float od[8]; float ss=0.f;
          #pragma unroll
          for(int e=0;e<4;++e){ od[2*e]=bflo(v1[e])-lam*bflo(v2[e]); od[2*e+1]=bfhi(v1[e])-lam*bfhi(v2[e]); ss+=od[2*e]*od[2*e]+od[2*e+1]*od[2*e+1]; }
          ss+=__shfl_xor(ss,1); ss+=__shfl_xor(ss,2); ss+=__shfl_xor(ss,4);
          const float rn=__builtin_amdgcn_rsqf(ss*(1.f/64.f)+1e-6f);
          u32x4 w; w[0]=pk2(od[0]*rn*sb[0],od[1]*rn*sb[1]); w[1]=pk2(od[2]*rn*sb[2],od[3]*rn*sb[3]); w[2]=pk2(od[4]*rn*sb[4],od[5]*rn*sb[5]); w[3]=pk2(od[6]*rn*sb[6],od[7]*rn*sb[7]);
          ATTN_STORE16(Ow+(long)row*opitch+ch*8,w);} }
    } }
  asm volatile("s_waitcnt lgkmcnt(0)\n\ts_barrier":::"memory");
  #undef DMA_K
  #undef DMA_V
  #undef CMASK
  #undef START
  #undef RESC
  #undef ROT
}
constexpr int ATTN_LDS_BYTES=LDS_BYTES;
#undef SBAR
#undef WAIT_BAR
}
#else
EMU_ATTN_BODY
#endif
#ifndef EMU
#define XB_TMO      128
#define XB_XCNT(j)  (256  + 64 * (j))
#define XB_XSUB(j)  (1280 + 64 * (j))
#define XB_XGEN(j)  (2304 + 64 * (j))
#define XB_TOP      3328
#define XB_TOPGEN   3392
#define XCD_BAR_WORDS 3456
#define XB_SPIN_CAP (1u << 18)

__device__ __forceinline__ unsigned xb_ld(unsigned* p)              { return __hip_atomic_load(p, __ATOMIC_RELAXED, __HIP_MEMORY_SCOPE_AGENT); }
__device__ __forceinline__ unsigned xb_add(unsigned* p, unsigned v) { return __hip_atomic_fetch_add(p, v, __ATOMIC_RELAXED, __HIP_MEMORY_SCOPE_AGENT); }
__device__ __forceinline__ unsigned xb_xcc_id() { return (unsigned)__builtin_amdgcn_s_getreg((3 << 11) | 20) & 0xFu; }
#define XB_SPIN(cond, bar) do { unsigned _sp = 0; while (cond) { __builtin_amdgcn_s_sleep(1); \
    if ((++_sp & 255u) == 0u) { if (xb_ld(&(bar)[XB_TMO])) break; if (_sp > XB_SPIN_CAP) { atomicAdd(&(bar)[XB_TMO], 1u); break; } } } } while (0)

struct XcdBarrier {
    unsigned* bar; unsigned x;
    volatile LAS unsigned* st;
};

__device__ __forceinline__ XcdBarrier xcd_barrier_post(unsigned* bar, volatile LAS unsigned* st) {
    XcdBarrier b; b.bar = bar; b.x = xb_xcc_id(); b.st = st;
    if (threadIdx.x == 0) (void)xb_add(&bar[XB_XCNT(b.x)], 1u);
    return b;
}
__device__ __forceinline__ void xcd_barrier_complete(unsigned* bar, unsigned x, unsigned& nloc, unsigned& nx) {
    const unsigned G = gridDim.x * gridDim.y * gridDim.z;
    unsigned sum, cnt, mine, sp = 0u;
    for (;;) {
        sum = 0u; cnt = 0u; mine = 0u;
#pragma unroll
        for (unsigned j = 0; j < 16; ++j) { const unsigned c = xb_ld(&bar[XB_XCNT(j)]); sum += c; cnt += (c > 0u) ? 1u : 0u; mine = (j == x) ? c : mine; }
        if (sum == G) break;
        __builtin_amdgcn_s_sleep(1);
        if ((++sp & 255u) == 0u) { if (xb_ld(&bar[XB_TMO])) break; if (sp > XB_SPIN_CAP) { atomicAdd(&bar[XB_TMO], 1u); break; } }
    }
    nloc = mine > 0u ? mine : 1u; nx = cnt > 0u ? cnt : 1u;
}

__device__ __forceinline__ void xcd_barrier(const XcdBarrier& b) {
    asm volatile("s_waitcnt vmcnt(0)" ::: "memory");
    __syncthreads();
    if (threadIdx.x == 0) {
        unsigned* bar = b.bar;
        __builtin_amdgcn_s_waitcnt(0);
        unsigned nloc = b.st[0], nx = b.st[1];
        if (nloc == 0u) { xcd_barrier_complete(bar, b.x, nloc, nx); b.st[0] = nloc; b.st[1] = nx; }
        const unsigned old = xb_add(&bar[XB_XSUB(b.x)], 1u);
        const unsigned gen = old / nloc;
        if (old + 1u == (gen + 1u) * nloc) {
            __builtin_amdgcn_fence(__ATOMIC_RELEASE, "agent");
            asm volatile("s_waitcnt vmcnt(0)" ::: "memory");
            const unsigned og = xb_add(&bar[XB_TOP], 1u);
            const unsigned tg = og / nx;
            if (og + 1u == (tg + 1u) * nx) xb_add(&bar[XB_TOPGEN], 1u);
            else XB_SPIN(xb_ld(&bar[XB_TOPGEN]) == tg, bar);
            __builtin_amdgcn_fence(__ATOMIC_ACQUIRE, "agent");
            xb_add(&bar[XB_XGEN(b.x)], 1u);
            asm volatile("s_waitcnt vmcnt(0)" ::: "memory");
        } else {
            XB_SPIN(xb_ld(&bar[XB_XGEN(b.x)]) == gen, bar);
            __builtin_amdgcn_fence(__ATOMIC_ACQUIRE, "agent");
            asm volatile("s_waitcnt vmcnt(0)" ::: "memory");
        }
    }
    __syncthreads();
}
#endif

constexpr int LDS_BYTES = 147456;
constexpr int MISC_OFF = 139264;
constexpr int PTR_OFF = MISC_OFF + 256;
struct Ctx {
    LAS unsigned char* lds;
    int tid, lane, wave, bid, G;
    float* out; unsigned long long wsi;
};
DEVI const float* inp_ptr(const Ctx& C, int i) {
    const unsigned long long v = ((const LAS unsigned long long*)(C.lds + PTR_OFF))[i];
    const unsigned lo = __builtin_amdgcn_readfirstlane((unsigned)v), hi = __builtin_amdgcn_readfirstlane((unsigned)(v >> 32));
    return (const float*)(const GAS float*)(((unsigned long long)hi << 32) | lo);
}
#define INP(i) inp_ptr(C, i)
#define WSP(T, off) ((T*)(GAS T*)(C.wsi + (unsigned long long)(off)))
DEVI int mod_row(int r) { return r < T_L ? r / SEQ : 8; }
DEVI const float* mod_vec(const Ctx& C, int layer, int mrow, int which) { return WSP(const float, WS_MOD) + ((size_t)(layer * 9 + mrow) * 6 + which) * D; }

DEVI void transpose_item(const float* W, int ldw, int k0, int n0, bf16* WT, int orow0, int Kp, LAS float* scr, int lane) {
    { const int kr = lane >> 3, c4 = (lane & 7) * 4; f32x4 v[8];
#pragma unroll
      for (int i = 0; i < 8; ++i) v[i] = *(const f32x4*)(W + (size_t)(k0 + 8 * i + kr) * ldw + n0 + c4);
#pragma unroll
      for (int i = 0; i < 8; ++i) { LAS float* d = scr + (8 * i + kr) * 33 + c4; d[0] = v[i].x; d[1] = v[i].y; d[2] = v[i].z; d[3] = v[i].w; } }
    LDS_WAIT();
    const int c = lane & 7;
#pragma unroll
    for (int j = 0; j < 4; ++j) { const int n = (lane >> 3) + 8 * j; const LAS float* s = scr + (8 * c) * 33 + n;
        v4u o; o.x = pk2(s[0 * 33], s[1 * 33]); o.y = pk2(s[2 * 33], s[3 * 33]); o.z = pk2(s[4 * 33], s[5 * 33]); o.w = pk2(s[6 * 33], s[7 * 33]);
        *(v4u*)(WT + (size_t)(orow0 + n) * Kp + k0 + 8 * c) = o; }
    LDS_WAIT();
}
DEVI void convert_layer_weights(const Ctx& C, int layer, int part) {
    LAS float* scr = (LAS float*)(C.lds + C.wave * 16384);
    const int gw = C.bid * 8 + C.wave, NGW = C.G * 8;
    constexpr int I_IN = 16 * (N_PROJ / 32), I_OUT = 16 * (D / 32), I_UP = NE * 16 * (2 * DE / 32), I_DN = NE * 16 * (D / 32), I_LAYER = I_IN + I_OUT + I_UP + I_DN;
    const int it_lo = (part == 1) ? I_IN + I_OUT : 0, it_hi = (part == 0) ? I_IN + I_OUT : I_LAYER;
    for (int it = it_lo + gw; it < it_hi; it += NGW) {
        int r = it;
        if (r < I_IN) { const int kb = r / (N_PROJ / 32), nb = r % (N_PROJ / 32);
            transpose_item(INP(8) + (size_t)layer * D * D_IN, D_IN, 64 * kb, 32 * nb, WSP(bf16, WS_WIN) + (size_t)layer * N_PROJ * D, 32 * nb, D, scr, C.lane); continue; }
        r -= I_IN;
        if (r < I_OUT) { const int kb = r / (D / 32), nb = r % (D / 32);
            transpose_item(INP(9) + (size_t)layer * D * D, D, 64 * kb, 32 * nb, WSP(bf16, WS_WOUT) + (size_t)layer * D * D, 32 * nb, D, scr, C.lane); continue; }
        r -= I_OUT;
        if (r < I_UP) { const int e = r / (16 * 64), q = r % (16 * 64), kb = q / 64, nb = q % 64; const int n0 = 32 * nb;
            const int orow = (n0 < DE) ? (n0 / 128) * 256 + (n0 % 128) : ((n0 - DE) / 128) * 256 + 128 + ((n0 - DE) % 128);
            transpose_item(INP(26) + ((size_t)layer * NE + e) * D * 2 * DE, 2 * DE, 64 * kb, n0, WSP(bf16, WS_WUP) + ((size_t)layer * NE + e) * 2 * DE * D, orow, D, scr, C.lane); continue; }
        r -= I_UP;
        { const int e = r / (16 * 32), q = r % (16 * 32), kb = q / 32, nb = q % 32;
            transpose_item(INP(28) + ((size_t)layer * NE + e) * DE * D, D, 64 * kb, 32 * nb, WSP(bf16, WS_WDN) + ((size_t)layer * NE + e) * D * DE, 32 * nb, DE, scr, C.lane); }
    }
}
DEVI void p0_prologue(const Ctx& C) {
    convert_layer_weights(C, 0, 0);
    {
      float* tab = WSP(float, WS_ROPE);
      for (int i = C.bid * 512 + C.tid; i < SEQ * 48; i += C.G * 512) { const int t = i / 48, j = i % 48; const float rp = (float)(t / GRID_W), cp = (float)(t % GRID_W); float c, s;
          if (j < 32) { const float ang = (j < 16 ? rp : cp) * __builtin_amdgcn_exp2f(-(float)(j & 15) * (13.287712379549449f / 16.f)); const float tt = __builtin_amdgcn_fractf(ang * 0.15915494309189535f); c = __builtin_amdgcn_cosf(tt); s = __builtin_amdgcn_sinf(tt);
              tab[(size_t)t * 32 + j] = c; tab[(size_t)SEQ * 32 + (size_t)t * 32 + j] = s; }
          else { const int i2 = j - 32; const float ang = (i2 < 8 ? rp : cp) * __builtin_amdgcn_exp2f(-(float)(i2 & 7) * (13.287712379549449f / 8.f)); const float tt = __builtin_amdgcn_fractf(ang * 0.15915494309189535f); c = __builtin_amdgcn_cosf(tt); s = __builtin_amdgcn_sinf(tt);
              tab[(size_t)SEQ * 64 + (size_t)t * 16 + i2] = c; tab[(size_t)SEQ * 80 + (size_t)t * 16 + i2] = s; } } }
    __syncthreads();
    LAS float* sc = (LAS float*)C.lds;
    LAS float* red = sc + 9 * D;
    for (int i = C.tid; i < 9 * D; i += 512) { const int r = i / D, k = i % D; float v = 0.f; if (r < NB) v = INP(1)[r * D + k]; else if (r == 8) v = INP(3)[k]; sc[i] = siluf_(v); }
    __syncthreads();
    for (int u = C.bid; u < DEPTH * 96; u += C.G) {
        const int layer = u / 96, n0 = (u % 96) * 64, col = C.tid & 63, kg = C.tid >> 6;
        const float* w = INP(4) + (size_t)layer * D * 6 * D + n0 + col;
        float acc[9];
#pragma unroll
        for (int r = 0; r < 9; ++r) acc[r] = 0.f;
#pragma unroll 8
        for (int k = kg * 128; k < kg * 128 + 128; ++k) { const float wv = w[(size_t)k * 6 * D];
#pragma unroll
            for (int r = 0; r < 9; ++r) acc[r] += sc[r * D + k] * wv; }
#pragma unroll
        for (int r = 0; r < 9; ++r) red[(kg * 9 + r) * 64 + col] = acc[r];
        __syncthreads();
        for (int i = C.tid; i < 9 * 64; i += 512) { const int r = i >> 6, c2 = i & 63; float s = 0.f;
#pragma unroll
            for (int g = 0; g < 8; ++g) s += red[(g * 9 + r) * 64 + c2];
            WSP(float, WS_MOD)[((size_t)(layer * 9 + r)) * 6 * D + n0 + c2] = s + INP(5)[(size_t)layer * 6 * D + n0 + c2]; }
        __syncthreads();
    }
}

DEVI void ph_norm_mix(const Ctx& C, int layer) {
    const bool fin = (layer == DEPTH);
    const int nrows = fin ? T_L : T_ALL;
    if (layer == 0) {
        for (int it = C.bid * 8 + C.wave; it < DEPTH * 9 * NE; it += C.G * 8) {
            const int e = it % NE, m = (it / NE) % 9, l = it / (NE * 9);
            const float* gn = INP(7) + (size_t)l * D; const float* sh = mod_vec(C, l, m, 3); const float* scl = mod_vec(C, l, m, 4); const float* rw = INP(24) + (size_t)l * D * NE + e;
            float* dst = WSP(float, WS_RWP) + (size_t)it * D; float bsum = 0.f;
#pragma unroll 4
            for (int j = 0; j < 16; ++j) { const int k = 64 * j + C.lane; const float w = rw[(size_t)k * NE]; dst[k] = gn[k] * (1.f + scl[k]) * w; bsum += sh[k] * w; }
            bsum = wave_sum(bsum); if (C.lane == 0) WSP(float, WS_RBP)[it] = bsum + INP(25)[l * NE + e];
        }
    }
    LAS float* w16 = (LAS float*)C.lds;
    if (!fin) { for (int i = C.tid; i < 16 * D; i += 512) { const int k = i >> 4, j = i & 15; w16[j * D + k] = INP(8)[((size_t)layer * D + k) * D_IN + N_PROJ + j]; } }
    __syncthreads();
    const float* gmain = fin ? INP(30) : INP(6) + (size_t)layer * D;
    const int rstep = C.G * 8;
    int s4[2][4]; float g4[2][4];
#define NM_SLOTS(dst_s, dst_g, rbase) do { _Pragma("unroll") for (int u2 = 0; u2 < 2; ++u2) { const int rr_ = (rbase) + u2 * rstep; const int rc_ = rr_ < nrows ? rr_ : 0; \
        const int* sl_ = WSP(const int, WS_SLOT) + (size_t)rc_ * 4; const float* gl_ = WSP(const float, WS_TOKG) + (size_t)rc_ * 4; \
        _Pragma("unroll") for (int k = 0; k < 4; ++k) { dst_s[u2][k] = sl_[k]; dst_g[u2][k] = gl_[k]; } } } while (0)
    if (layer != 0) NM_SLOTS(s4, g4, C.bid * 8 + C.wave);
#define NMC(j) ((((j) & 2) ? 512 : 0) + 8 * C.lane + 4 * ((j) & 1))
    for (int ra = C.bid * 8 + C.wave; ra < nrows; ra += 2 * rstep) {
        f32x4 v[2][4]; int mrow[2]; bool live[2];
        int s4n[2][4]; float g4n[2][4];
        if (layer != 0) NM_SLOTS(s4n, g4n, ra + 2 * rstep);
#pragma unroll
        for (int u2 = 0; u2 < 2; ++u2) { const int r = ra + u2 * rstep; live[u2] = r < nrows; const int rc = live[u2] ? r : 0; mrow[u2] = mod_row(rc);
            if (layer == 0) { const float* xr = (rc < T_L) ? INP(0) + (size_t)rc * D : INP(2) + (size_t)(rc - T_L) * D;
#pragma unroll
                for (int j = 0; j < 4; ++j) v[u2][j] = *(const f32x4*)(xr + NMC(j));
            } else {
                const bf16* xr = WSP(const bf16, WS_XRES) + (size_t)rc * D; const float* g2 = mod_vec(C, layer - 1, mrow[u2], 5);
                f32x4 xv[4]; { const v4u xa = *(const v4u*)(xr + 8 * C.lane), xb = *(const v4u*)(xr + 512 + 8 * C.lane);
                    xv[0] = (f32x4){bflo(xa.x), bfhi(xa.x), bflo(xa.y), bfhi(xa.y)}; xv[1] = (f32x4){bflo(xa.z), bfhi(xa.z), bflo(xa.w), bfhi(xa.w)};
                    xv[2] = (f32x4){bflo(xb.x), bfhi(xb.x), bflo(xb.y), bfhi(xb.y)}; xv[3] = (f32x4){bflo(xb.z), bfhi(xb.z), bflo(xb.w), bfhi(xb.w)}; }
                f32x4 a[4];
#pragma unroll
                for (int j = 0; j < 4; ++j) a[j] = (f32x4){0.f, 0.f, 0.f, 0.f};
#pragma unroll
                for (int k = 0; k < 4; ++k) { const unsigned char* yr = WSP(const unsigned char, WS_YS) + (size_t)s4[u2][k] * D; const v2u ya = *(const v2u*)(yr + 8 * C.lane), yb = *(const v2u*)(yr + 512 + 8 * C.lane); const float gk = g4[u2][k];
                    const f32x2 p0 = __builtin_amdgcn_cvt_pk_f32_fp8((int)ya.x, false), p1 = __builtin_amdgcn_cvt_pk_f32_fp8((int)ya.x, true), p2 = __builtin_amdgcn_cvt_pk_f32_fp8((int)ya.y, false), p3 = __builtin_amdgcn_cvt_pk_f32_fp8((int)ya.y, true);
                    const f32x2 q0 = __builtin_amdgcn_cvt_pk_f32_fp8((int)yb.x, false), q1 = __builtin_amdgcn_cvt_pk_f32_fp8((int)yb.x, true), q2 = __builtin_amdgcn_cvt_pk_f32_fp8((int)yb.y, false), q3 = __builtin_amdgcn_cvt_pk_f32_fp8((int)yb.y, true);
                    a[0] += (f32x4){p0.x, p0.y, p1.x, p1.y} * gk; a[1] += (f32x4){p2.x, p2.y, p3.x, p3.y} * gk;
                    a[2] += (f32x4){q0.x, q0.y, q1.x, q1.y} * gk; a[3] += (f32x4){q2.x, q2.y, q3.x, q3.y} * gk; }
#pragma unroll
                for (int j = 0; j < 4; ++j) v[u2][j] = xv[j] + *(const f32x4*)(g2 + NMC(j)) * a[j];
            } }
        float rinv[2];
#pragma unroll
        for (int u2 = 0; u2 < 2; ++u2) { float ss = 0.f;
#pragma unroll
            for (int j = 0; j < 4; ++j) ss += (v[u2][j].x * v[u2][j].x + v[u2][j].y * v[u2][j].y) + (v[u2][j].z * v[u2][j].z + v[u2][j].w * v[u2][j].w);
            rinv[u2] = __builtin_amdgcn_rsqf(wave_sum(ss) * (1.f / D) + NORM_EPS); }
#pragma unroll
        for (int u2 = 0; u2 < 2; ++u2) { const int r = ra + u2 * rstep; if (!live[u2]) continue;
            if (fin) {
#pragma unroll
                for (int j = 0; j < 4; ++j) *(f32x4*)(C.out + (size_t)r * D + NMC(j)) = v[u2][j] * rinv[u2] * *(const f32x4*)(gmain + NMC(j));
                continue; }
            if (layer != 0) { bf16* xw = WSP(bf16, WS_XRES) + (size_t)r * D;
                *(v4u*)(xw + 8 * C.lane) = (v4u){pk2(v[u2][0].x, v[u2][0].y), pk2(v[u2][0].z, v[u2][0].w), pk2(v[u2][1].x, v[u2][1].y), pk2(v[u2][1].z, v[u2][1].w)};
                *(v4u*)(xw + 512 + 8 * C.lane) = (v4u){pk2(v[u2][2].x, v[u2][2].y), pk2(v[u2][2].z, v[u2][2].w), pk2(v[u2][3].x, v[u2][3].y), pk2(v[u2][3].z, v[u2][3].w)}; }
            const float* sh = mod_vec(C, layer, mrow[u2], 0); const float* scl = mod_vec(C, layer, mrow[u2], 1);
            f32x4 hv4[4]; float mine = 0.f;
#pragma unroll
            for (int j = 0; j < 4; ++j) hv4[j] = v[u2][j] * rinv[u2] * *(const f32x4*)(gmain + NMC(j)) * (*(const f32x4*)(scl + NMC(j)) + 1.0f) + *(const f32x4*)(sh + NMC(j));
            { bf16* hr = WSP(bf16, WS_H) + (size_t)r * D;
              *(v4u*)(hr + 8 * C.lane) = (v4u){pk2(hv4[0].x, hv4[0].y), pk2(hv4[0].z, hv4[0].w), pk2(hv4[1].x, hv4[1].y), pk2(hv4[1].z, hv4[1].w)};
              *(v4u*)(hr + 512 + 8 * C.lane) = (v4u){pk2(hv4[2].x, hv4[2].y), pk2(hv4[2].z, hv4[2].w), pk2(hv4[3].x, hv4[3].y), pk2(hv4[3].z, hv4[3].w)}; }
#pragma unroll 2
            for (int i = 0; i < 16; ++i) { float pp = 0.f;
#pragma unroll
                for (int j = 0; j < 4; ++j) { const f32x4 w = *(const LAS f32x4*)(w16 + i * D + NMC(j)); pp += (hv4[j].x * w.x + hv4[j].y * w.y) + (hv4[j].z * w.z + hv4[j].w * w.w); }
                pp = wave_sum(pp); if (C.lane == i) mine = pp; }
            if (C.lane < 16) WSP(float, WS_BA)[(size_t)r * 16 + C.lane] = mine; }
        if (layer != 0) {
#pragma unroll
            for (int u2 = 0; u2 < 2; ++u2)
#pragma unroll
                for (int k = 0; k < 4; ++k) { s4[u2][k] = s4n[u2][k]; g4[u2][k] = g4n[u2][k]; } }
    }
#undef NMC
#undef NM_SLOTS
}

DEVI void u8f(const v4u& w, float (&x)[8]) { x[0] = bflo(w.x); x[1] = bfhi(w.x); x[2] = bflo(w.y); x[3] = bfhi(w.y); x[4] = bflo(w.z); x[5] = bfhi(w.z); x[6] = bflo(w.w); x[7] = bfhi(w.w); }
DEVI v4u f8u(const float (&x)[8]) { return (v4u){pk2(x[0], x[1]), pk2(x[2], x[3]), pk2(x[4], x[5]), pk2(x[6], x[7])}; }
DEVI void ph_attn_prep(const Ctx& C, int layer) {
    const bf16* proj = WSP(const bf16, WS_PROJ);
    bf16* QL = WSP(bf16, WS_QL); bf16* QC = WSP(bf16, WS_QC); bf16* KB = WSP(bf16, WS_K); bf16* VB = WSP(bf16, WS_V);
    const float* tab = WSP(const float, WS_ROPE);
    const int lane = C.lane, l7 = lane & 7, d0 = 8 * l7;
    constexpr float C2A = 0.125f * 1.4426950408889634f, C2D = 0.17677669529663687f * 1.4426950408889634f;
    float gA[8];
    { const float* gn = (lane < 32 ? INP(10) : INP(11)) + layer * 64 + d0;
#pragma unroll
      for (int e = 0; e < 8; ++e) gA[e] = gn[e]; }
    const bool lowA = d0 < 32; const int jA = d0 & 31;
    const int i0 = 8 * (lane & 3); const bool lowD = i0 < 16; const int iD = i0 & 15, mp = l7 >> 2;
    constexpr int RU = 2; const int rstep = C.G * 8;
    for (int rbase = C.bid * 8 + C.wave; rbase < T_ALL; rbase += RU * rstep) {
        v4u pa[RU], pc1[RU], pc2[RU]; f32x4 ca[RU][2], sa[RU][2], cd[RU][2], sd[RU][2];
#pragma unroll
        for (int u2 = 0; u2 < RU; ++u2) { const int rr = rbase + u2 * rstep; const int r = rr < T_ALL ? rr : rbase; const bf16* pr = proj + (size_t)r * N_PROJ;
            pa[u2] = *(const v4u*)(pr + 8 * lane); pc1[u2] = *(const v4u*)(pr + C_CQ + 8 * lane); pc2[u2] = *(const v4u*)(pr + C_CV + 8 * (lane & 31));
            const int t = r < T_L ? r % SEQ : 0;
            ca[u2][0] = *(const f32x4*)(tab + (size_t)t * 32 + jA); ca[u2][1] = *(const f32x4*)(tab + (size_t)t * 32 + jA + 4);
            sa[u2][0] = *(const f32x4*)(tab + (size_t)SEQ * 32 + (size_t)t * 32 + jA); sa[u2][1] = *(const f32x4*)(tab + (size_t)SEQ * 32 + (size_t)t * 32 + jA + 4);
            cd[u2][0] = *(const f32x4*)(tab + (size_t)SEQ * 64 + (size_t)t * 16 + iD); cd[u2][1] = *(const f32x4*)(tab + (size_t)SEQ * 64 + (size_t)t * 16 + iD + 4);
            sd[u2][0] = *(const f32x4*)(tab + (size_t)SEQ * 80 + (size_t)t * 16 + iD); sd[u2][1] = *(const f32x4*)(tab + (size_t)SEQ * 80 + (size_t)t * 16 + iD + 4); }
#pragma unroll
        for (int u2 = 0; u2 < RU; ++u2) { const int r = rbase + u2 * rstep; if (r >= T_ALL) continue;
            const bool lat = r < T_L; const int b = lat ? r / SEQ : (r - T_L) / LC; const int t = lat ? r % SEQ : (r - T_L) % LC; const int pos = lat ? t : SEQ + t;
            { float x[8]; u8f(pa[u2], x);
              if (lane < 48) { float ss = 0.f;
#pragma unroll
                  for (int e = 0; e < 8; ++e) ss += x[e] * x[e];
                  const float rinv = __builtin_amdgcn_rsqf(group_sum<8>(ss) * (1.f / 64.f) + NORM_EPS);
#pragma unroll
                  for (int e = 0; e < 8; ++e) x[e] *= rinv * gA[e]; }
              float o[8];
#pragma unroll
              for (int e = 0; e < 8; ++e) { const float pe = __shfl_xor(x[e], 4); const float c = lat ? ca[u2][e >> 2][e & 3] : 1.f, s = lat ? sa[u2][e >> 2][e & 3] : 0.f;
                  o[e] = lowA ? x[e] * c - pe * s : pe * s + x[e] * c; }
              if (lane < 32) { const int hq = lane >> 3;
#pragma unroll
                  for (int e = 0; e < 8; ++e) o[e] *= C2A;
                  bf16* q = lat ? QL + ((size_t)(b * 12 + hq) * SEQ + t) * 64 : QC + ((size_t)(b * 12 + hq) * LC + t) * 64; *(v4u*)(q + d0) = f8u(o); }
              else if (lane < 48) { const int kvh = (lane - 32) >> 3; *(v4u*)(KB + ((size_t)(b * 6 + kvh) * NKEY + pos) * 64 + d0) = f8u(o); }
              else { const int kvh = (lane - 48) >> 3; *(v4u*)(VB + ((size_t)(b * 6 + kvh) * NKEY + pos) * 64 + d0) = pa[u2]; } }
            { float x[8]; u8f(pc1[u2], x); float o[8];
#pragma unroll
              for (int e = 0; e < 8; ++e) { const float pe = __shfl_xor(x[e], 2); const float c = lat ? cd[u2][e >> 2][e & 3] : 1.f, s = lat ? sd[u2][e >> 2][e & 3] : 0.f;
                  o[e] = lowD ? x[e] * c - pe * s : pe * s + x[e] * c; }
              const int hc = (lane & 31) >> 3;
              if (lane < 32) { const int vh = 4 + 2 * hc + mp;
#pragma unroll
                  for (int e = 0; e < 8; ++e) o[e] *= C2D;
                  bf16* q = lat ? QL + ((size_t)(b * 12 + vh) * SEQ + t) * 64 : QC + ((size_t)(b * 12 + vh) * LC + t) * 64;
                  *(v4u*)(q + mp * 32 + i0) = f8u(o); *(v4u*)(q + (1 - mp) * 32 + i0) = (v4u){0u, 0u, 0u, 0u}; }
              else { *(v4u*)(KB + ((size_t)(b * 6 + 2 + hc) * NKEY + pos) * 64 + d0) = f8u(o); } }
            if (lane < 32) { const int hv = lane >> 3; *(v4u*)(VB + ((size_t)(b * 6 + 2 + hv) * NKEY + pos) * 64 + d0) = pc2[u2]; }
        }
    }
}

DEVI void ph_gmlp(const Ctx& C, int layer, int ntok) {
    constexpr int VP = 136, SP = 68;
    LAS bf16* vnT = (LAS bf16*)C.lds;
    LAS float* rinv = (LAS float*)(vnT + 64 * VP);
    LAS float* spT = rinv + 128;
    const bf16* proj = WSP(const bf16, WS_PROJ); bf16* mix = WSP(bf16, WS_MIX);
    const float* gvn = INP(12) + layer * 256;
    const int tid0 = C.tid;
    constexpr int NSCAN = NB * 16; const int total = (ntok / 128) * 4; const bool split = C.G > NSCAN && total > 2 * NSCAN;
    const int ufirst = !split ? C.bid : (C.bid < NSCAN ? C.bid : 2 * NSCAN + (C.bid - NSCAN)), ustride = !split ? C.G : (C.bid < NSCAN ? NSCAN : C.G - NSCAN), uend = (split && C.bid < NSCAN) ? 2 * NSCAN : total;
    for (int u = ufirst; u < uend; u += ustride) {
        int tid = tid0; LAUNDER_V(tid);
        const int chunk = u >> 2, g = u & 3; const int row0 = chunk * 128;
        const int lane = tid & 63, wv = __builtin_amdgcn_readfirstlane(tid >> 6), l15 = lane & 15, q = lane >> 4;
        bf16x8 afr[4];
        { const float* wsr = INP(13) + ((size_t)layer * 4 + g) * 128 * 128 + (size_t)(16 * wv + l15) * 128 + 8 * q;
#pragma unroll
          for (int kk = 0; kk < 4; ++kk) { const f32x4 a0 = *(const f32x4*)(wsr + 32 * kk), a1 = *(const f32x4*)(wsr + 32 * kk + 4);
              const v4u ap = {pk2(a0.x, a0.y), pk2(a0.z, a0.w), pk2(a1.x, a1.y), pk2(a1.z, a1.w)}; afr[kk] = __builtin_bit_cast(bf16x8, ap); } }
        { const int tok = tid >> 2, qd = tid & 3; const bf16* p = proj + (size_t)(row0 + tok) * N_PROJ + C_BV + qd * 64; float ss = 0.f;
#pragma unroll
          for (int c8 = 0; c8 < 8; ++c8) { const v4u w = *(const v4u*)(p + c8 * 8);
              const float a0 = gelu_tanh(bflo(w.x)), a1 = gelu_tanh(bfhi(w.x)), a2 = gelu_tanh(bflo(w.y)), a3 = gelu_tanh(bfhi(w.y)), a4 = gelu_tanh(bflo(w.z)), a5 = gelu_tanh(bfhi(w.z)), a6 = gelu_tanh(bflo(w.w)), a7 = gelu_tanh(bfhi(w.w));
              ss += (a0 * a0 + a1 * a1) + (a2 * a2 + a3 * a3) + (a4 * a4 + a5 * a5) + (a6 * a6 + a7 * a7); }
          ss = group_sum<4>(ss); if (qd == 0) rinv[tok] = __builtin_amdgcn_rsqf(ss * (1.f / 256.f) + NORM_EPS); }
        __syncthreads();
        { const int tok = tid >> 2, c0 = (tid & 3) * 16; const bf16* p = proj + (size_t)(row0 + tok) * N_PROJ + C_BV + g * 64 + c0; const float ri = rinv[tok];
          const v4u w0 = *(const v4u*)p, w1 = *(const v4u*)(p + 8); const unsigned ww[8] = {w0.x, w0.y, w0.z, w0.w, w1.x, w1.y, w1.z, w1.w};
#pragma unroll
          for (int c = 0; c < 16; ++c) { const float x = (c & 1) ? bfhi(ww[c >> 1]) : bflo(ww[c >> 1]); vnT[(c0 + c) * VP + tok] = (bf16)f2bf(gelu_tanh(x) * ri * gvn[g * 64 + c0 + c]); } }
        __syncthreads();
        { f32x4 acc[4];
#pragma unroll
          for (int n = 0; n < 4; ++n) acc[n] = (f32x4){0.f, 0.f, 0.f, 0.f};
#pragma unroll
          for (int kk = 0; kk < 4; ++kk)
#pragma unroll
              for (int n = 0; n < 4; ++n) acc[n] = __builtin_amdgcn_mfma_f32_16x16x32_bf16(afr[kk], *(const LAS bf16x8*)(vnT + (16 * n + l15) * VP + 32 * kk + 8 * q), acc[n], 0, 0, 0);
          const float* bs = INP(14) + ((size_t)layer * 4 + g) * 128;
#pragma unroll
          for (int r = 0; r < 4; ++r) { const int tok = 16 * wv + 4 * q + r; const float bb = bs[tok];
#pragma unroll
              for (int n = 0; n < 4; ++n) spT[tok * SP + 16 * n + l15] = acc[n][r] + bb; } }
        __syncthreads();
        { const int tok = tid >> 2, c0 = (tid & 3) * 16; const size_t rowp = (size_t)(row0 + tok);
          const bf16* pu = proj + rowp * N_PROJ + C_BU + g * 64 + c0; const v4u u0 = *(const v4u*)pu, u1 = *(const v4u*)(pu + 8); const unsigned uw[8] = {u0.x, u0.y, u0.z, u0.w, u1.x, u1.y, u1.z, u1.w};
          float o[16];
#pragma unroll
          for (int c4 = 0; c4 < 4; ++c4) { const f32x4 sp = *(const LAS f32x4*)(spT + tok * SP + c0 + 4 * c4);
              o[4 * c4 + 0] = gelu_tanh(bflo(uw[2 * c4])) * sp.x; o[4 * c4 + 1] = gelu_tanh(bfhi(uw[2 * c4])) * sp.y; o[4 * c4 + 2] = gelu_tanh(bflo(uw[2 * c4 + 1])) * sp.z; o[4 * c4 + 3] = gelu_tanh(bfhi(uw[2 * c4 + 1])) * sp.w; }
          bf16* po = mix + rowp * D + 256 + g * 64 + c0;
          *(v4u*)po = (v4u){pk2(o[0], o[1]), pk2(o[2], o[3]), pk2(o[4], o[5]), pk2(o[6], o[7])}; *(v4u*)(po + 8) = (v4u){pk2(o[8], o[9]), pk2(o[10], o[11]), pk2(o[12], o[13]), pk2(o[14], o[15])}; }
        __syncthreads();
    }
}

DEVI int dn_kmap(int kk, int q, int j) { return 16 * (2 * kk + (j >> 2)) + 4 * q + (j & 3); }
DEVI size_t dn_unit_off(int b, int dir, int h, int sc) { return ((size_t)((b * 2 + dir) * 4 + h) * NCH + sc) * DN_UNIT_BYTES; }
constexpr int DP = 68, XP = 132, HP = 72;
DEVI f32x4 mfma16(bf16x8 a, bf16x8 b, f32x4 c) { return __builtin_amdgcn_mfma_f32_16x16x32_bf16(a, b, c, 0, 0, 0); }
#ifndef D1REP
#define D1REP 0
#endif
#define DN_BAR() asm volatile("s_waitcnt lgkmcnt(0)\n\ts_barrier" ::: "memory")
DEVI void ph_dn_chunk(const Ctx& C, int layer) {
    LAS bf16* kN = (LAS bf16*)C.lds;
    LAS bf16* qN = kN + 64 * HP;
    LAS bf16* kT = qN + 64 * HP;
    LAS bf16* QKd = kT + 64 * HP;
    LAS bf16* RT = QKd + 64 * HP;
    LAS bf16* XT = RT;
    LAS bf16* TiB = RT + 128 * HP;
    LAS float* Am = (LAS float*)(TiB + 64 * HP);
    LAS float* TI = Am + 64 * DP;
    LAS bf16* XdT = (LAS bf16*)Am;
    LAS float* TMP = TI + 64 * DP;
    LAS float* vec = TMP + 1280;
    LAS float* betav = vec; LAS float* cum = vec + 64; LAS float* ecum = vec + 128; LAS float* dvec = vec + 192; LAS float* bec = vec + 256;
    LAS float* cwl = vec + 320;
    LAS float* gpar = cwl + 2304;
    static_assert(128 * HP * 2 <= 2 * 64 * DP * 4 && (4 * 64 * HP + 128 * HP + 64 * HP) * 2 + (2 * 64 * DP + 1280 + 320 + 2304 + 16) * 4 <= MISC_OFF, "D1 LDS");
    const bf16* proj = WSP(const bf16, WS_PROJ); const float* BA = WSP(const float, WS_BA);
    { const float* cwg = INP(20) + (size_t)layer * 3 * 768; for (int i = C.tid; i < 2304; i += 512) cwl[i] = cwg[i];
      if (C.tid < 8) gpar[C.tid] = -fast_exp(INP(21)[layer * 8 + C.tid]); else if (C.tid < 16) gpar[C.tid] = INP(22)[layer * 8 + C.tid - 8]; }
    __syncthreads();
    const LAS float* cw = cwl;
    const int tid0 = C.tid;
#define FRESH_TID() int tid = tid0; LAUNDER_V(tid)
#define DN_DECODE(u_) const int tcx = (u_) % NCH, h = ((u_) / NCH) & 3, dir = ((u_) / (NCH * 4)) & 1, b = (u_) / (NCH * 8); \
        const bool isc = tcx < NCH_C; const int tc = isc ? tcx : tcx - NCH_C; const int nch = isc ? NCH_C : NCH_L; const int len = nch * 64; \
        const int row_seq0 = isc ? T_L + b * LC : b * SEQ
    v4u rw[3][3]; float rb0 = 0.f, rb1 = 0.f, rb2 = 0.f;
#define DN_LOAD(u_) do { if ((u_) < NB * 2 * 4 * NCH) { DN_DECODE(u_); int t_ = tid0; LAUNDER_V(t_); const int c = t_ >> 3, d0 = (t_ & 7) * 8; const int tl = tc * 64 + (dir ? 63 - c : c); const size_t r = (size_t)row_seq0 + tl; \
        const bool hp = tl > 0, hn = tl < len - 1; \
        _Pragma("unroll") for (int w3 = 0; w3 < 3; ++w3) { const bf16* p = proj + r * N_PROJ + C_DQKV + w3 * 256 + h * 64 + d0; \
            rw[w3][1] = *(const v4u*)p; rw[w3][0] = (v4u){0u, 0u, 0u, 0u}; rw[w3][2] = (v4u){0u, 0u, 0u, 0u}; if (hp) rw[w3][0] = *(const v4u*)(p - N_PROJ); if (hn) rw[w3][2] = *(const v4u*)(p + N_PROJ); } \
        rb0 = BA[r * 16 + dir * 4 + h]; \
        if (t_ < 64) { const int tl2 = tc * 64 + (dir ? 63 - t_ : t_); const float* ba = BA + ((size_t)row_seq0 + tl2) * 16; rb1 = ba[dir * 4 + h]; rb2 = ba[8 + dir * 4 + h]; } } } while (0)
    DN_LOAD(C.bid);
    for (int u = C.bid; u < NB * 2 * 4 * NCH; u += C.G) {
        DN_DECODE(u);
        const int sc = (isc ? 0 : NCH_C) + (dir ? nch - 1 - tc : tc);
        { FRESH_TID(); const int c = tid >> 3, part = tid & 7, d0 = part * 8;
          float y[3][8];
#pragma unroll
          for (int w3 = 0; w3 < 3; ++w3) { const int col = w3 * 256 + h * 64 + d0;
              const v4u xc = rw[w3][1], xp = rw[w3][0], xn = rw[w3][2];
              const unsigned xcw[4] = {xc.x, xc.y, xc.z, xc.w}, xpw[4] = {xp.x, xp.y, xp.z, xp.w}, xnw[4] = {xn.x, xn.y, xn.z, xn.w};
#pragma unroll
              for (int e = 0; e < 8; ++e) { const float a = (e & 1) ? bfhi(xpw[e >> 1]) : bflo(xpw[e >> 1]), m = (e & 1) ? bfhi(xcw[e >> 1]) : bflo(xcw[e >> 1]), n = (e & 1) ? bfhi(xnw[e >> 1]) : bflo(xnw[e >> 1]);
                  y[w3][e] = siluf_(cw[col + e] * a + cw[768 + col + e] * m + cw[1536 + col + e] * n); } }
          const float ba_b = rb0, ba_b2 = rb1, ba_a2 = rb2;
          DN_LOAD(u + C.G);
          float sq = 0.f, sk = 0.f;
#pragma unroll
          for (int e = 0; e < 8; ++e) { sq += y[0][e] * y[0][e]; sk += y[1][e] * y[1][e]; }
          sq = group_sum<8>(sq); sk = group_sum<8>(sk);
          const float rq = __builtin_amdgcn_rsqf(sq + NORM_EPS) * 0.125f, rk = __builtin_amdgcn_rsqf(sk + NORM_EPS);
          const float betac = sigmoidf_(ba_b);
#pragma unroll
          for (int e = 0; e < 8; ++e) { y[0][e] *= rq; y[1][e] *= rk; kT[(d0 + e) * HP + c] = (bf16)f2bf(y[1][e]); RT[(d0 + e) * HP + c] = (bf16)f2bf(betac * y[2][e]); }
          *(LAS v4u*)(qN + c * HP + d0) = (v4u){pk2(y[0][0], y[0][1]), pk2(y[0][2], y[0][3]), pk2(y[0][4], y[0][5]), pk2(y[0][6], y[0][7])};
          *(LAS v4u*)(kN + c * HP + d0) = (v4u){pk2(y[1][0], y[1][1]), pk2(y[1][2], y[1][3]), pk2(y[1][4], y[1][5]), pk2(y[1][6], y[1][7])};
          *(LAS v4u*)(QKd + c * HP + d0) = (v4u){0u, 0u, 0u, 0u};
          { LAS f32x4* z = (LAS f32x4*)TI; z[tid] = (f32x4){0.f, 0.f, 0.f, 0.f}; z[tid + 512] = (f32x4){0.f, 0.f, 0.f, 0.f}; if (tid < 64) z[tid + 1024] = (f32x4){0.f, 0.f, 0.f, 0.f}; }
          if (tid < 64) { const int c2 = tid;
              const float bt = sigmoidf_(ba_b2);
              float sg = gpar[dir * 4 + h] * softplusf_(ba_a2 + gpar[8 + dir * 4 + h]);
#pragma unroll
              for (int o = 1; o < 64; o <<= 1) { const float t = __shfl_up(sg, o); if (c2 >= o) sg += t; }
              const float G = __shfl(sg, 63); const float ec = fast_exp(sg);
              betav[c2] = bt; cum[c2] = sg; ecum[c2] = ec; dvec[c2] = fast_exp(G - sg); bec[c2] = bt * ec; } }
        DN_BAR();
        for (int rp_ = 0; rp_ < 1 + (((D1REP) >> 1) & 1); ++rp_) {
        { FRESH_TID(); const int lane = tid & 63, wv = __builtin_amdgcn_readfirstlane(tid >> 6), l15 = lane & 15, q = lane >> 4;
          { const int k = tid >> 3, c0 = (tid & 7) * 8; const v4u kk4 = *(const LAS v4u*)(kT + k * HP + c0); const unsigned kw[4] = {kk4.x, kk4.y, kk4.z, kk4.w}; unsigned ow[4];
#pragma unroll
            for (int e = 0; e < 4; ++e) ow[e] = pk2(bflo(kw[e]) * bec[c0 + 2 * e], bfhi(kw[e]) * bec[c0 + 2 * e + 1]);
            *(LAS v4u*)(RT + (64 + k) * HP + c0) = (v4u){ow[0], ow[1], ow[2], ow[3]}; }
#pragma unroll
          for (int tt = 0; tt < 3; ++tt) { const int t = wv + 8 * tt; if (t >= 20) break;
              const bool isq = t >= 10; const int idx = isq ? t - 10 : t; const int ti = (idx >= 6) ? 3 : (idx >= 3) ? 2 : (idx >= 1) ? 1 : 0; const int tj = idx - ti * (ti + 1) / 2;
              const LAS bf16* asrc = (isq ? qN : kN) + (16 * ti + l15) * HP + 8 * q; const LAS bf16* bsrc = kN + (16 * tj + l15) * HP + 8 * q;
              f32x4 acc = {0.f, 0.f, 0.f, 0.f};
              acc = mfma16(*(const LAS bf16x8*)asrc, *(const LAS bf16x8*)bsrc, acc); acc = mfma16(*(const LAS bf16x8*)(asrc + 32), *(const LAS bf16x8*)(bsrc + 32), acc);
              const int j = 16 * tj + l15; const float cj = cum[j];
#pragma unroll
              for (int r = 0; r < 4; ++r) { const int i = 16 * ti + 4 * q + r; const float dec = fast_exp(cum[i] - cj);
                  if (isq) QKd[i * HP + j] = (bf16)f2bf((i >= j) ? acc[r] * dec : 0.f); else Am[i * DP + j] = (i > j) ? acc[r] * dec * betav[i] : 0.f; } } }
        DN_BAR();
        }
        for (int rp_ = 0; rp_ < 1 + (((D1REP) >> 2) & 1); ++rp_) {
        { FRESH_TID(); if (tid < 64) { const int bb = tid >> 4, col = tid & 15; float x[16];
#pragma unroll
            for (int r = 0; r < 16; ++r) { float s = (r == col) ? 1.f : 0.f;
#pragma unroll
                for (int s2 = 0; s2 < r; ++s2) s -= Am[(16 * bb + r) * DP + 16 * bb + s2] * x[s2];
                x[r] = s; }
#pragma unroll
            for (int r = 0; r < 16; ++r) TI[(16 * bb + r) * DP + 16 * bb + col] = x[r]; } }
        DN_BAR();
        }
        for (int rp_ = 0; rp_ < 1 + (((D1REP) >> 3) & 1); ++rp_) {
        { FRESH_TID(); const int p = tid >> 8, r = (tid >> 4) & 15, c = tid & 15; float e = 0.f;
#pragma unroll
          for (int s2 = 0; s2 < 16; ++s2) e += Am[(32 * p + 16 + r) * DP + 32 * p + s2] * TI[(32 * p + s2) * DP + 32 * p + c];
          TMP[(p * 16 + r) * 17 + c] = e;
          DN_BAR();
          float f = 0.f;
#pragma unroll
          for (int s2 = 0; s2 < 16; ++s2) f -= TI[(32 * p + 16 + r) * DP + 32 * p + 16 + s2] * TMP[(p * 16 + s2) * 17 + c];
          TI[(32 * p + 16 + r) * DP + 32 * p + c] = f; }
        DN_BAR();
        }
        for (int rp_ = 0; rp_ < 1 + (((D1REP) >> 4) & 1); ++rp_) {
        { FRESH_TID(); const int r = tid >> 4, c2 = (tid & 15) * 2; float e0 = 0.f, e1 = 0.f;
#pragma unroll 8
          for (int s2 = 0; s2 < 32; ++s2) { const float a = Am[(32 + r) * DP + s2]; e0 += a * TI[s2 * DP + c2]; e1 += a * TI[s2 * DP + c2 + 1]; }
          TMP[r * 36 + c2] = e0; TMP[r * 36 + c2 + 1] = e1;
          DN_BAR();
          float f0 = 0.f, f1 = 0.f;
#pragma unroll 8
          for (int s2 = 0; s2 < 32; ++s2) { const float a = TI[(32 + r) * DP + 32 + s2]; f0 -= a * TMP[s2 * 36 + c2]; f1 -= a * TMP[s2 * 36 + c2 + 1]; }
          TI[(32 + r) * DP + c2] = f0; TI[(32 + r) * DP + c2 + 1] = f1; }
        DN_BAR();
        }
        for (int rp_ = 0; rp_ < 1 + (((D1REP) >> 5) & 1); ++rp_) {
        { FRESH_TID(); const int c = tid >> 3, c0 = (tid & 7) * 8; float x[8];
#pragma unroll
          for (int e = 0; e < 8; ++e) x[e] = (c0 + e <= c) ? TI[c * DP + c0 + e] : 0.f;
          *(LAS v4u*)(TiB + c * HP + c0) = (v4u){pk2(x[0], x[1]), pk2(x[2], x[3]), pk2(x[4], x[5]), pk2(x[6], x[7])}; }
        DN_BAR();
        }
        { FRESH_TID(); const int lane = tid & 63, wv = __builtin_amdgcn_readfirstlane(tid >> 6), l15 = lane & 15, q = lane >> 4;
          f32x4 xa[4]; const LAS bf16* bsrc = RT + (16 * wv + l15) * HP + 8 * q; const bf16x8 b0 = *(const LAS bf16x8*)bsrc, b1 = *(const LAS bf16x8*)(bsrc + 32);
#pragma unroll
          for (int m = 0; m < 4; ++m) { const LAS bf16* asrc = TiB + (16 * m + l15) * HP + 8 * q; f32x4 a_ = {0.f, 0.f, 0.f, 0.f};
              a_ = mfma16(*(const LAS bf16x8*)asrc, b0, a_); xa[m] = mfma16(*(const LAS bf16x8*)(asrc + 32), b1, a_); }
          DN_BAR();
          const int col = 16 * wv + l15;
#pragma unroll
          for (int m = 0; m < 4; ++m) { const int c0 = 16 * m + 4 * q; const f32x4 x = xa[m];
              *(LAS v2u*)(XT + col * HP + c0) = (v2u){pk2(x.x, x.y), pk2(x.z, x.w)};
              *(LAS v2u*)(XdT + col * HP + c0) = (v2u){pk2(x.x * dvec[c0], x.y * dvec[c0 + 1]), pk2(x.z * dvec[c0 + 2], x.w * dvec[c0 + 3])}; } }
        DN_BAR();
        for (int rp_ = 0; rp_ < 1 + (((D1REP) >> 7) & 1); ++rp_) {
        { FRESH_TID(); const int lane = tid & 63, wv = __builtin_amdgcn_readfirstlane(tid >> 6), l15 = lane & 15, q = lane >> 4;
          unsigned char* ub = WSP(unsigned char, WS_DNF + dn_unit_off(b, dir, h, sc));
          const float eG = ecum[63];
#define DN_MM(dst, Ap, Bp) do { f32x4 a_ = {0.f, 0.f, 0.f, 0.f}; a_ = mfma16(*(const LAS bf16x8*)(Ap), *(const LAS bf16x8*)(Bp), a_); dst = mfma16(*(const LAS bf16x8*)((Ap) + 32), *(const LAS bf16x8*)((Bp) + 32), a_); } while (0)
#pragma unroll
          for (int t2 = 0; t2 < 2; ++t2) { const int t = 2 * wv + t2, m = t >> 2, n = t & 3; f32x4 acc;
              DN_MM(acc, kT + (16 * m + l15) * HP + 8 * q, XdT + (16 * n + l15) * HP + 8 * q);
              *(v2u*)(ub + 16384 + (size_t)((n * 4 + m) * 64 + lane) * 8) = (v2u){pk2(acc.x, acc.y), pk2(acc.z, acc.w)};
              DN_MM(acc, QKd + (16 * m + l15) * HP + 8 * q, XT + (16 * n + l15) * HP + 8 * q);
              *(v2u*)(ub + 24576 + (size_t)((n * 4 + m) * 64 + lane) * 8) = (v2u){pk2(acc.x, acc.y), pk2(acc.z, acc.w)}; }
          { const int n = wv >> 1, kk2 = wv & 1; f32x4 z0, z1, y0, y1;
            DN_MM(z0, XdT + (64 + 16 * (2 * kk2) + l15) * HP + 8 * q, kT + (16 * n + l15) * HP + 8 * q);
            DN_MM(z1, XdT + (64 + 16 * (2 * kk2 + 1) + l15) * HP + 8 * q, kT + (16 * n + l15) * HP + 8 * q);
            DN_MM(y0, XT + (64 + 16 * (2 * kk2) + l15) * HP + 8 * q, QKd + (16 * n + l15) * HP + 8 * q);
            DN_MM(y1, XT + (64 + 16 * (2 * kk2 + 1) + l15) * HP + 8 * q, QKd + (16 * n + l15) * HP + 8 * q);
            const int rowi = 16 * n + l15; float mv[8], qv[8]; const float ec = ecum[rowi];
#pragma unroll
            for (int e = 0; e < 8; ++e) { const int kp = 16 * (2 * kk2 + (e >> 2)) + 4 * q + (e & 3); const float zz = (e < 4) ? z0[e & 3] : z1[e & 3], yy = (e < 4) ? y0[e & 3] : y1[e & 3];
                mv[e] = ((kp == rowi) ? eG : 0.f) - zz; qv[e] = ec * bf2f(qN[rowi * HP + kp]) - yy; }
            *(v4u*)(ub + (size_t)((n * 2 + kk2) * 64 + lane) * 16) = (v4u){pk2(mv[0], mv[1]), pk2(mv[2], mv[3]), pk2(mv[4], mv[5]), pk2(mv[6], mv[7])};
            *(v4u*)(ub + 8192 + (size_t)((n * 2 + kk2) * 64 + lane) * 16) = (v4u){pk2(qv[0], qv[1]), pk2(qv[2], qv[3]), pk2(qv[4], qv[5]), pk2(qv[6], qv[7])}; }
#undef DN_MM
        }
        DN_BAR();
        }
    }
}
#undef FRESH_TID
#undef DN_BAR
#undef DN_LOAD
#undef DN_DECODE
DEVI bf16x8 dn_pack(const f32x4& a, const f32x4& b) { const v4u o = {pk2(a.x, a.y), pk2(a.z, a.w), pk2(b.x, b.y), pk2(b.z, b.w)}; return __builtin_bit_cast(bf16x8, o); }
#define SCAN_BAR() asm volatile("s_waitcnt lgkmcnt(0)\n\ts_barrier" ::: "memory")
DEVI unsigned cvtpk(float lo, float hi) { return pk2(lo, hi); }
DEVI bf16x8 dn_pack_hw(const f32x4& a, const f32x4& b) { const v4u o = {cvtpk(a.x, a.y), cvtpk(a.z, a.w), cvtpk(b.x, b.y), cvtpk(b.z, b.w)}; return __builtin_bit_cast(bf16x8, o); }
DEVI void ph_dn_scan(const Ctx& C, int layer) {
    constexpr int SLOTB = 24576, NS = 4, P = 8, NLD = 384, NPC = 4;
    static_assert(NCH % P == 0 || NCH % P == P / 2, "scan pipeline depth: whole groups of P steps plus at most one half group");
    const int lane = C.lane, q = lane >> 4, v16 = lane & 15;
    bf16* DNO = WSP(bf16, WS_DNO);
    for (int u = C.bid; u < NB * 2 * 4 * 2; u += C.G) {
        const int vp = u & 1, h = (u >> 1) & 3, dir = (u >> 3) & 1, b = u >> 4;
        const unsigned char* base = WSP(const unsigned char, WS_DNF + dn_unit_off(b, dir, h, 0));
        if (C.wave < 2) {
            const int vs = 2 * vp + C.wave;
            bf16x8 sf[2]; { const v4u z = {0u, 0u, 0u, 0u}; sf[0] = __builtin_bit_cast(bf16x8, z); sf[1] = sf[0]; }
            bf16* ob = DNO + (size_t)dir * T_ALL * 256 + h * 64 + vs * 16 + v16;
            SCAN_BAR();
#define SCAN_SEG(SGN, SC0, NCHS, SEQ0, LEN) do { \
            bf16* pm[4]; \
            _Pragma("unroll") for (int m = 0; m < 4; ++m) pm[m] = ob + ((long)(SEQ0) + ((SGN) < 0 ? (LEN) - 1 : 0) + (SGN) * (16 * m + 4 * q)) * 256; \
            _Pragma("unroll 1") for (int s2 = 0; s2 < (NCHS); ++s2) { \
                const LAS unsigned char* sl = C.lds + (((SC0) + s2) % NS) * SLOTB; \
                f32x4 o[4], d[4]; \
                _Pragma("unroll") for (int m = 0; m < 4; ++m) { \
                    const bf16x8 ma0 = *(const LAS bf16x8*)(sl + ((m * 2 + 0) * 64 + lane) * 16), ma1 = *(const LAS bf16x8*)(sl + ((m * 2 + 1) * 64 + lane) * 16); \
                    const bf16x8 qa0 = *(const LAS bf16x8*)(sl + 8192 + ((m * 2 + 0) * 64 + lane) * 16), qa1 = *(const LAS bf16x8*)(sl + 8192 + ((m * 2 + 1) * 64 + lane) * 16); \
                    const v2u ncp = *(const LAS v2u*)(sl + 16384 + ((C.wave * 4 + m) * 64 + lane) * 8), ocp = *(const LAS v2u*)(sl + 20480 + ((C.wave * 4 + m) * 64 + lane) * 8); \
                    const f32x4 nc = {bflo(ncp.x), bfhi(ncp.x), bflo(ncp.y), bfhi(ncp.y)}, oc = {bflo(ocp.x), bfhi(ocp.x), bflo(ocp.y), bfhi(ocp.y)}; \
                    d[m] = __builtin_amdgcn_mfma_f32_16x16x32_bf16(ma0, sf[0], nc, 0, 0, 0); d[m] = __builtin_amdgcn_mfma_f32_16x16x32_bf16(ma1, sf[1], d[m], 0, 0, 0); \
                    o[m] = __builtin_amdgcn_mfma_f32_16x16x32_bf16(qa0, sf[0], oc, 0, 0, 0); o[m] = __builtin_amdgcn_mfma_f32_16x16x32_bf16(qa1, sf[1], o[m], 0, 0, 0); } \
                sf[0] = dn_pack_hw(d[0], d[1]); sf[1] = dn_pack_hw(d[2], d[3]); \
                _Pragma("unroll") for (int m = 0; m < 4; ++m) { \
                    _Pragma("unroll") for (int i = 0; i < 4; ++i) pm[m][(SGN) * i * 256] = (bf16)f2bf(o[m][i]); \
                    pm[m] += (SGN) * 64 * 256; } \
                SCAN_BAR(); } } while (0)
            if (dir == 0) { SCAN_SEG(1, 0, NCH_C, T_L + b * LC, LC); SCAN_SEG(1, NCH_C, NCH_L, b * SEQ, SEQ); }
            else          { SCAN_SEG(-1, 0, NCH_C, T_L + b * LC, LC); SCAN_SEG(-1, NCH_C, NCH_L, b * SEQ, SEQ); }
#undef SCAN_SEG
        } else {
            const int lid = C.tid - 128;
            unsigned so[NPC], dofs[NPC];
#pragma unroll
            for (int i = 0; i < NPC; ++i) { const int pp = lid + NLD * i;
                so[i] = (pp < 1024) ? (unsigned)pp * 16u : (pp < 1280) ? 16384u + (unsigned)(vp * 256 + (pp - 1024)) * 16u : 24576u + (unsigned)(vp * 256 + (pp - 1280)) * 16u; dofs[i] = (unsigned)pp * 16u; }
            v4u buf[P][NPC];
#pragma unroll
            for (int s2 = 0; s2 < P; ++s2)
#pragma unroll
                for (int i = 0; i < NPC; ++i) buf[s2][i] = *(const v4u*)(base + (size_t)s2 * DN_UNIT_BYTES + so[i]);
#pragma unroll
            for (int i = 0; i < NPC; ++i) *(LAS v4u*)(C.lds + dofs[i]) = buf[0][i];
            SCAN_BAR();
#define SCAN_LD_STEP(j) do { const int step = sc + (j); const int nxt = (step + P < NCH) ? step + P : NCH - 1; \
                    _Pragma("unroll") for (int i = 0; i < NPC; ++i) buf[(j)][i] = *(const v4u*)(base + (size_t)nxt * DN_UNIT_BYTES + so[i]); \
                    LAS unsigned char* sl = C.lds + ((step + 1) % NS) * SLOTB; \
                    _Pragma("unroll") for (int i = 0; i < NPC; ++i) *(LAS v4u*)(sl + dofs[i]) = buf[((j) + 1) % P][i]; \
                    SCAN_BAR(); } while (0)
            int sc = 0;
#pragma unroll 1
            for (; sc + P <= NCH; sc += P) {
#pragma unroll
                for (int j = 0; j < P; ++j) SCAN_LD_STEP(j);
            }
            if (NCH % P) {
#pragma unroll
                for (int j = 0; j < P / 2; ++j) SCAN_LD_STEP(j);
            }
#undef SCAN_LD_STEP
        }
    }
}
#undef SCAN_BAR

DEVI void ph_finalize(const Ctx& C, int layer, int ntok) {
    const int lane = C.lane;
    const bf16* DNO = WSP(const bf16, WS_DNO); const bf16* proj = WSP(const bf16, WS_PROJ); bf16* mix = WSP(bf16, WS_MIX);
    const f32x4 ong = *(const f32x4*)(INP(23) + layer * 64 + ((4 * lane) & 63));
    constexpr int RU = 4; const int rstep = C.G * 8;
    for (int r0 = C.bid * 8 + C.wave; r0 < ntok; r0 += RU * rstep) {
        v2u zz[RU], d0[RU], d1[RU];
#pragma unroll
        for (int u2 = 0; u2 < RU; ++u2) { const int rr = r0 + u2 * rstep; const size_t r = rr < ntok ? rr : r0;
            d0[u2] = *(const v2u*)(DNO + r * 256 + 4 * lane); d1[u2] = *(const v2u*)(DNO + ((size_t)T_ALL + r) * 256 + 4 * lane);
            zz[u2] = *(const v2u*)(proj + r * N_PROJ + C_DZ + 4 * lane); }
#pragma unroll
        for (int u2 = 0; u2 < RU; ++u2) { const int rr = r0 + u2 * rstep; if (rr >= ntok) continue; const size_t r = rr;
            const f32x4 od = (f32x4){bflo(d0[u2].x), bfhi(d0[u2].x), bflo(d0[u2].y), bfhi(d0[u2].y)} + (f32x4){bflo(d1[u2].x), bfhi(d1[u2].x), bflo(d1[u2].y), bfhi(d1[u2].y)};
            const float ss = group_sum<16>((od.x * od.x + od.y * od.y) + (od.z * od.z + od.w * od.w));
            const float rinv = __builtin_amdgcn_rsqf(ss * (1.f / 64.f) + NORM_EPS);
            const f32x4 z = (f32x4){siluf_(bflo(zz[u2].x)), siluf_(bfhi(zz[u2].x)), siluf_(bflo(zz[u2].y)), siluf_(bfhi(zz[u2].y))};
            const f32x4 o = od * rinv * ong * z; v2u w; w.x = pk2(o.x, o.y); w.y = pk2(o.z, o.w); *(v2u*)(mix + r * D + 768 + 4 * lane) = w; }
    }
}

DEVI void ph_router(const Ctx& C, int layer, int ntok) {
    LAS float* lgt = (LAS float*)C.lds;
    LAS int* cnt = (LAS int*)(lgt + 8 * 16 * 33);
    if (C.tid < 32) cnt[C.tid] = 0;
    __syncthreads();
    const int nt = ntok / 16; const int t0 = (int)((long)C.bid * nt / C.G), t1 = (int)((long)(C.bid + 1) * nt / C.G);
    const float* gn = INP(7) + (size_t)layer * D;
    const int l15 = C.lane & 15, q = C.lane >> 4; LAS float* lg_w = lgt + C.wave * 16 * 33;
    const int nrem = (t1 - t0) & 7; const int t1w = nrem <= 2 ? t1 - nrem : t1;
    for (int t = t0 + C.wave; t < t1w; t += 8) {
        const int row0 = 16 * t, mrow = mod_row(row0);
        const bf16* xa = WSP(const bf16, WS_XRES) + (size_t)(row0 + l15) * D + 4 * q;
        const float* wb = WSP(const float, WS_RWP) + ((size_t)(layer * 9 + mrow) * NE + l15) * D + 4 * q;
        f32x4 acc0 = {0.f, 0.f, 0.f, 0.f}, acc1 = {0.f, 0.f, 0.f, 0.f}; float ssq = 0.f;
#pragma unroll 4
        for (int kk = 0; kk < 64; ++kk) { const v2u aw = *(const v2u*)(xa + 16 * kk); const f32x4 a = {bflo(aw.x), bfhi(aw.x), bflo(aw.y), bfhi(aw.y)}, b0 = *(const f32x4*)(wb + 16 * kk), b1 = *(const f32x4*)(wb + (size_t)16 * D + 16 * kk);
            ssq += (a.x * a.x + a.y * a.y) + (a.z * a.z + a.w * a.w);
            acc0 = __builtin_amdgcn_mfma_f32_16x16x4f32(a.x, b0.x, acc0, 0, 0, 0); acc1 = __builtin_amdgcn_mfma_f32_16x16x4f32(a.x, b1.x, acc1, 0, 0, 0);
            acc0 = __builtin_amdgcn_mfma_f32_16x16x4f32(a.y, b0.y, acc0, 0, 0, 0); acc1 = __builtin_amdgcn_mfma_f32_16x16x4f32(a.y, b1.y, acc1, 0, 0, 0);
            acc0 = __builtin_amdgcn_mfma_f32_16x16x4f32(a.z, b0.z, acc0, 0, 0, 0); acc1 = __builtin_amdgcn_mfma_f32_16x16x4f32(a.z, b1.z, acc1, 0, 0, 0);
            acc0 = __builtin_amdgcn_mfma_f32_16x16x4f32(a.w, b0.w, acc0, 0, 0, 0); acc1 = __builtin_amdgcn_mfma_f32_16x16x4f32(a.w, b1.w, acc1, 0, 0, 0); }
        ssq += __shfl_xor(ssq, 16); ssq += __shfl_xor(ssq, 32);
        const float rinv = __builtin_amdgcn_rsqf(ssq * (1.f / D) + NORM_EPS);
        const float* rb = WSP(const float, WS_RBP) + (size_t)(layer * 9 + mrow) * NE;
        const float bb0 = rb[l15], bb1 = rb[16 + l15];
#pragma unroll
        for (int r = 0; r < 4; ++r) { const float ri = __shfl(rinv, 4 * q + r); lg_w[(4 * q + r) * 33 + l15] = acc0[r] * ri + bb0; lg_w[(4 * q + r) * 33 + 16 + l15] = acc1[r] * ri + bb1; }
        LDS_WAIT();
        if (C.lane < 16) { const int r = row0 + C.lane; float lg[32];
#pragma unroll
            for (int e = 0; e < 32; ++e) lg[e] = lg_w[C.lane * 33 + e];
            int te[4]; float tv[4];
#pragma unroll
            for (int k = 0; k < 4; ++k) { float best = -INFINITY; int bi = 0;
#pragma unroll
                for (int e = 0; e < 32; ++e) if (lg[e] > best) { best = lg[e]; bi = e; }
#pragma unroll
                for (int e = 0; e < 32; ++e) lg[e] = (e == bi) ? -INFINITY : lg[e];
                te[k] = bi; tv[k] = best; }
            float ex[4], es = 0.f;
#pragma unroll
            for (int k = 0; k < 4; ++k) { ex[k] = fast_exp(tv[k] - tv[0]); es += ex[k]; }
            const float ri = 1.f / es;
#pragma unroll
            for (int k = 0; k < 4; ++k) { const int pos = __hip_atomic_fetch_add(&cnt[te[k]], 1, __ATOMIC_RELAXED, __HIP_MEMORY_SCOPE_WORKGROUP);
                WSP(int, WS_TOKE)[(size_t)r * 4 + k] = te[k]; WSP(float, WS_TOKG)[(size_t)r * 4 + k] = ex[k] * ri; WSP(int, WS_TOKP)[(size_t)r * 4 + k] = pos; } }
        LDS_WAIT();
        { const float* sh = mod_vec(C, layer, mrow, 3); const float* scl = mod_vec(C, layer, mrow, 4);
          f32x4 gm[4], sv[4];
#pragma unroll
          for (int j = 0; j < 4; ++j) { const int col = ((j & 2) ? 512 : 0) + 8 * C.lane + 4 * (j & 1); gm[j] = *(const f32x4*)(gn + col) * (*(const f32x4*)(scl + col) + 1.0f); sv[j] = *(const f32x4*)(sh + col); }
#pragma unroll 1
          for (int rr = 0; rr < 16; rr += 2) { v4u xw[2][2];
#pragma unroll
              for (int u2 = 0; u2 < 2; ++u2) { const bf16* xr = WSP(const bf16, WS_XRES) + (size_t)(row0 + rr + u2) * D; xw[u2][0] = *(const v4u*)(xr + 8 * C.lane); xw[u2][1] = *(const v4u*)(xr + 512 + 8 * C.lane); }
#pragma unroll
              for (int u2 = 0; u2 < 2; ++u2) { const float ri = __shfl(rinv, rr + u2); f32x4 f[4];
                  f[0] = (f32x4){bflo(xw[u2][0].x), bfhi(xw[u2][0].x), bflo(xw[u2][0].y), bfhi(xw[u2][0].y)} * ri * gm[0] + sv[0]; f[1] = (f32x4){bflo(xw[u2][0].z), bfhi(xw[u2][0].z), bflo(xw[u2][0].w), bfhi(xw[u2][0].w)} * ri * gm[1] + sv[1];
                  f[2] = (f32x4){bflo(xw[u2][1].x), bfhi(xw[u2][1].x), bflo(xw[u2][1].y), bfhi(xw[u2][1].y)} * ri * gm[2] + sv[2]; f[3] = (f32x4){bflo(xw[u2][1].z), bfhi(xw[u2][1].z), bflo(xw[u2][1].w), bfhi(xw[u2][1].w)} * ri * gm[3] + sv[3];
                  bf16* fr_ = WSP(bf16, WS_F) + (size_t)(row0 + rr + u2) * D;
                  *(v4u*)(fr_ + 8 * C.lane) = (v4u){pk2(f[0].x, f[0].y), pk2(f[0].z, f[0].w), pk2(f[1].x, f[1].y), pk2(f[1].z, f[1].w)};
                  *(v4u*)(fr_ + 512 + 8 * C.lane) = (v4u){pk2(f[2].x, f[2].y), pk2(f[2].z, f[2].w), pk2(f[3].x, f[3].y), pk2(f[3].z, f[3].w)}; } } }
    }
    LAS float* ssqp = (LAS float*)(cnt + 32); LAS float* rinvs = ssqp + 128;
    for (int t = t1w; t < t1; ++t) {
        const int row0 = 16 * t, mrow = mod_row(row0);
        { const bf16* xa = WSP(const bf16, WS_XRES) + (size_t)(row0 + l15) * D + 4 * q + 128 * C.wave;
          const float* wb = WSP(const float, WS_RWP) + ((size_t)(layer * 9 + mrow) * NE + l15) * D + 4 * q + 128 * C.wave;
          f32x4 acc0 = {0.f, 0.f, 0.f, 0.f}, acc1 = {0.f, 0.f, 0.f, 0.f}; float ssq = 0.f;
#pragma unroll
          for (int kk = 0; kk < 8; ++kk) { const v2u aw = *(const v2u*)(xa + 16 * kk); const f32x4 a = {bflo(aw.x), bfhi(aw.x), bflo(aw.y), bfhi(aw.y)}, b0 = *(const f32x4*)(wb + 16 * kk), b1 = *(const f32x4*)(wb + (size_t)16 * D + 16 * kk);
              ssq += (a.x * a.x + a.y * a.y) + (a.z * a.z + a.w * a.w);
              acc0 = __builtin_amdgcn_mfma_f32_16x16x4f32(a.x, b0.x, acc0, 0, 0, 0); acc1 = __builtin_amdgcn_mfma_f32_16x16x4f32(a.x, b1.x, acc1, 0, 0, 0);
              acc0 = __builtin_amdgcn_mfma_f32_16x16x4f32(a.y, b0.y, acc0, 0, 0, 0); acc1 = __builtin_amdgcn_mfma_f32_16x16x4f32(a.y, b1.y, acc1, 0, 0, 0);
              acc0 = __builtin_amdgcn_mfma_f32_16x16x4f32(a.z, b0.z, acc0, 0, 0, 0); acc1 = __builtin_amdgcn_mfma_f32_16x16x4f32(a.z, b1.z, acc1, 0, 0, 0);
              acc0 = __builtin_amdgcn_mfma_f32_16x16x4f32(a.w, b0.w, acc0, 0, 0, 0); acc1 = __builtin_amdgcn_mfma_f32_16x16x4f32(a.w, b1.w, acc1, 0, 0, 0); }
          ssq += __shfl_xor(ssq, 16); ssq += __shfl_xor(ssq, 32);
          if (q == 0) ssqp[C.wave * 16 + l15] = ssq;
#pragma unroll
          for (int r = 0; r < 4; ++r) { lg_w[(4 * q + r) * 33 + l15] = acc0[r]; lg_w[(4 * q + r) * 33 + 16 + l15] = acc1[r]; } }
        __syncthreads();
        if (C.wave == 0) {
            float s = 0.f;
#pragma unroll
            for (int w = 0; w < 8; ++w) s += ssqp[w * 16 + l15];
            const float rinv = __builtin_amdgcn_rsqf(s * (1.f / D) + NORM_EPS);
            if (q == 0) rinvs[l15] = rinv;
            const float* rb = WSP(const float, WS_RBP) + (size_t)(layer * 9 + mrow) * NE;
            const float bb0 = rb[l15], bb1 = rb[16 + l15];
            float a0[4], a1[4];
#pragma unroll
            for (int r = 0; r < 4; ++r) { a0[r] = 0.f; a1[r] = 0.f;
#pragma unroll
                for (int w = 0; w < 8; ++w) { a0[r] += lgt[w * 16 * 33 + (4 * q + r) * 33 + l15]; a1[r] += lgt[w * 16 * 33 + (4 * q + r) * 33 + 16 + l15]; } }
#pragma unroll
            for (int r = 0; r < 4; ++r) { const float ri = __shfl(rinv, 4 * q + r); lgt[(4 * q + r) * 33 + l15] = a0[r] * ri + bb0; lgt[(4 * q + r) * 33 + 16 + l15] = a1[r] * ri + bb1; }
            LDS_WAIT();
            if (C.lane < 16) { const int r = row0 + C.lane; float lg[32];
#pragma unroll
                for (int e = 0; e < 32; ++e) lg[e] = lgt[C.lane * 33 + e];
                int te[4]; float tv[4];
#pragma unroll
                for (int k = 0; k < 4; ++k) { float best = -INFINITY; int bi = 0;
#pragma unroll
                    for (int e = 0; e < 32; ++e) if (lg[e] > best) { best = lg[e]; bi = e; }
#pragma unroll
                    for (int e = 0; e < 32; ++e) lg[e] = (e == bi) ? -INFINITY : lg[e];
                    te[k] = bi; tv[k] = best; }
                float ex[4], es = 0.f;
#pragma unroll
                for (int k = 0; k < 4; ++k) { ex[k] = fast_exp(tv[k] - tv[0]); es += ex[k]; }
                const float ri = 1.f / es;
#pragma unroll
                for (int k = 0; k < 4; ++k) { const int pos = __hip_atomic_fetch_add(&cnt[te[k]], 1, __ATOMIC_RELAXED, __HIP_MEMORY_SCOPE_WORKGROUP);
                    WSP(int, WS_TOKE)[(size_t)r * 4 + k] = te[k]; WSP(float, WS_TOKG)[(size_t)r * 4 + k] = ex[k] * ri; WSP(int, WS_TOKP)[(size_t)r * 4 + k] = pos; } }
        }
        __syncthreads();
        { const float* sh = mod_vec(C, layer, mrow, 3); const float* scl = mod_vec(C, layer, mrow, 4);
          v4u xw[2][2];
#pragma unroll
          for (int u2 = 0; u2 < 2; ++u2) { const bf16* xr = WSP(const bf16, WS_XRES) + (size_t)(row0 + 2 * C.wave + u2) * D; xw[u2][0] = *(const v4u*)(xr + 8 * C.lane); xw[u2][1] = *(const v4u*)(xr + 512 + 8 * C.lane); }
          f32x4 gm[4], sv[4];
#pragma unroll
          for (int j = 0; j < 4; ++j) { const int col = ((j & 2) ? 512 : 0) + 8 * C.lane + 4 * (j & 1); gm[j] = *(const f32x4*)(gn + col) * (*(const f32x4*)(scl + col) + 1.0f); sv[j] = *(const f32x4*)(sh + col); }
#pragma unroll
          for (int u2 = 0; u2 < 2; ++u2) { const float ri = rinvs[2 * C.wave + u2]; f32x4 f[4];
              f[0] = (f32x4){bflo(xw[u2][0].x), bfhi(xw[u2][0].x), bflo(xw[u2][0].y), bfhi(xw[u2][0].y)} * ri * gm[0] + sv[0]; f[1] = (f32x4){bflo(xw[u2][0].z), bfhi(xw[u2][0].z), bflo(xw[u2][0].w), bfhi(xw[u2][0].w)} * ri * gm[1] + sv[1];
              f[2] = (f32x4){bflo(xw[u2][1].x), bfhi(xw[u2][1].x), bflo(xw[u2][1].y), bfhi(xw[u2][1].y)} * ri * gm[2] + sv[2]; f[3] = (f32x4){bflo(xw[u2][1].z), bfhi(xw[u2][1].z), bflo(xw[u2][1].w), bfhi(xw[u2][1].w)} * ri * gm[3] + sv[3];
              bf16* fr_ = WSP(bf16, WS_F) + (size_t)(row0 + 2 * C.wave + u2) * D;
              *(v4u*)(fr_ + 8 * C.lane) = (v4u){pk2(f[0].x, f[0].y), pk2(f[0].z, f[0].w), pk2(f[1].x, f[1].y), pk2(f[1].z, f[1].w)};
              *(v4u*)(fr_ + 512 + 8 * C.lane) = (v4u){pk2(f[2].x, f[2].y), pk2(f[2].z, f[2].w), pk2(f[3].x, f[3].y), pk2(f[3].z, f[3].w)}; } }
        __syncthreads();
    }
    __syncthreads();
    if (C.tid < 32) WSP(int, WS_BCNT)[C.bid * 32 + C.tid] = cnt[C.tid];
}

DEVI void ph_slots(const Ctx& C, int layer, int ntok) {
    LAS int* tot = (LAS int*)C.lds; LAS int* myoff = tot + 32; LAS int* base = tot + 64; LAS int* part = tot + 96;
    {
      const int e = C.tid & 31, grp = C.tid >> 5; int t = 0, o = 0; const int* bc = WSP(const int, WS_BCNT) + e;
#pragma unroll 4
      for (int b2 = grp; b2 < C.G; b2 += 16) { const int c = bc[b2 * 32]; t += c; if (b2 < C.bid) o += c; }
      part[grp * 64 + e] = t; part[grp * 64 + 32 + e] = o; }
    __syncthreads();
    if (C.tid < 64) { int a = 0;
#pragma unroll
        for (int g = 0; g < 16; ++g) a += part[g * 64 + C.tid];
        if (C.tid < 32) tot[C.tid] = a; else myoff[C.tid - 32] = a; }
    __syncthreads();
    if (C.tid == 0) { int acc = 0; int* texp = WSP(int, WS_TEXP);
        for (int e = 0; e < 32; ++e) { base[e] = acc; const int nt = (tot[e] + 255) >> 8; if (C.bid == 0) for (int i = 0; i < nt; ++i) texp[1 + (acc >> 8) + i] = e; acc += nt << 8; }
        if (C.bid == 0) texp[0] = acc >> 8; }
    __syncthreads();
    int* rowmap = WSP(int, WS_ROWMAP);
    if (C.bid == 0) {
        for (int e = 0; e < 32; ++e) { const int lo = base[e] + tot[e], hi2 = base[e] + (((tot[e] + 255) >> 8) << 8); for (int i = lo + C.tid; i < hi2; i += 512) rowmap[i] = 0; } }
    const int nt = ntok / 16; const int r0 = 16 * (int)((long)C.bid * nt / C.G), r1 = 16 * (int)((long)(C.bid + 1) * nt / C.G);
    for (int i = r0 * 4 + C.tid; i < r1 * 4; i += 512) { const int e = WSP(const int, WS_TOKE)[i]; const int slot = base[e] + myoff[e] + WSP(const int, WS_TOKP)[i];
        WSP(int, WS_SLOT)[i] = slot; rowmap[slot] = i >> 2; }
}

DEVI void ph_attention(const Ctx& C, bool need_ctx, int layer) {
    const attn_body::bf16* QL = WSP(const attn_body::bf16, WS_QL); const attn_body::bf16* QC = WSP(const attn_body::bf16, WS_QC);
    const attn_body::bf16* KB = WSP(const attn_body::bf16, WS_K); const attn_body::bf16* VB = WSP(const attn_body::bf16, WS_V);
    attn_body::bf16* mix = WSP(attn_body::bf16, WS_MIX);
    constexpr int NQL = SEQ / 128, NQC = LC / 128, UL = NB * 6 * NQL, UC = NB * 6 * NQC;
    const float lam_init = 0.8f - 0.6f * fast_exp(-0.3f * (float)layer); float lam;
    { float p1 = 0.f, p2 = 0.f; if (C.lane < 32) { p1 = INP(15)[layer * 32 + C.lane] * INP(16)[layer * 32 + C.lane]; p2 = INP(17)[layer * 32 + C.lane] * INP(18)[layer * 32 + C.lane]; }
      lam = fast_exp(wave_sum(p1)) - fast_exp(wave_sum(p2)) + lam_init; }
    const float post = 1.f - lam_init; const float* subln = INP(19) + layer * 64;
    const int total = UL + (need_ctx ? UC : 0);
    const int conv_at = (layer + 1 < DEPTH) ? (int)(C.bid % 6) : -1; int ui = 0; bool conv_done = false;
    const int conv0_at = (layer == 0) ? (int)((C.bid + 3) % 6) : -1; bool conv0_done = false;
    for (int u = (C.bid + C.G / 2) % C.G; u < total; u += C.G, ++ui) {
        if (ui == conv_at) { __syncthreads(); convert_layer_weights(C, layer + 1, 2); __syncthreads(); conv_done = true; }
        if (ui == conv0_at) { __syncthreads(); convert_layer_weights(C, 0, 1); __syncthreads(); conv0_done = true; }
        const bool isc = u >= UL; int qb, bp;
        if (!isc && (C.G & 7) == 0 && NQL == 32 && C.G == 256) { const int w = u % C.G, rnd = u / C.G; bp = rnd * 8 + (w & 7); qb = w >> 3; }
        else { const int v = isc ? u - UL : u; const int nq = isc ? NQC : NQL; qb = v % nq; bp = v / nq; }
        const int p = bp % 6, b = bp / 6;
        const int slen = isc ? LC : SEQ; const attn_body::bf16* Qbase = isc ? QC : QL;
        const attn_body::bf16* Qa = Qbase + ((size_t)(b * 12 + 2 * p) * slen + qb * 128) * 64; const attn_body::bf16* Qb = Qa + (size_t)slen * 64;
        const attn_body::bf16* Kh = KB + ((size_t)(b * 6 + p) * NKEY + (isc ? SEQ : 0)) * 64; const attn_body::bf16* Vh = VB + ((size_t)(b * 6 + p) * NKEY + (isc ? SEQ : 0)) * 64;
        const size_t row0 = (size_t)(isc ? T_L + b * LC : b * SEQ) + qb * 128;
        attn_body::bf16 *Oa, *Ob; int opitch;
        if (p < 2) { Oa = mix + row0 * D + (2 * p) * 64; Ob = Oa + 64; opitch = D; }
        else { Oa = mix + row0 * D + 512 + (p - 2) * 64; Ob = Oa; opitch = D; }
        const int ntile = isc ? LC / 64 : NKEY / 64;
        if (p < 2) attn_body::attn_unit<8, 0>(Qa, Qb, Kh, Vh, Oa, Ob, opitch, ntile, (char*)C.lds, lam, post, subln);
        else if (C.wave < 4) attn_body::attn_unit<8, 1>(Qa, Qb, Kh, Vh, Oa, Ob, opitch, ntile, (char*)C.lds, lam, post, subln);
        else attn_body::attn_unit<8, 2>(Qa, Qb, Kh, Vh, Oa, Ob, opitch, ntile, (char*)C.lds, lam, post, subln);
    }
    if (conv_at >= 0 && !conv_done) { __syncthreads(); convert_layer_weights(C, layer + 1, 2); __syncthreads(); }
    if (conv0_at >= 0 && !conv0_done) { __syncthreads(); convert_layer_weights(C, 0, 1); __syncthreads(); }
}

DEVI void ph_outproj_ctx(const Ctx& C, int layer) {
    const int l15 = C.lane & 15, q = C.lane >> 4, ks = C.wave & 3, ch = C.wave >> 2;
    const float* g = mod_vec(C, layer, 8, 2);
    LAS float* P = (LAS float*)C.lds; constexpr int PP = 132;
    for (int tile = C.bid; tile < (NB * LC / 64) * (D / 128); tile += C.G) {
        const int r0 = (tile >> 3) * 64, c0 = (tile & 7) * 128;
        const bf16* a = WSP(const bf16, WS_MIX) + (size_t)(T_L + r0 + l15) * D + 256 * ks + 8 * q;
        const bf16* b = WSP(const bf16, WS_WOUT) + (size_t)layer * D * D + (size_t)(c0 + 64 * ch + l15) * D + 256 * ks + 8 * q;
        f32x4 acc[4][4];
#pragma unroll
        for (int m = 0; m < 4; ++m)
#pragma unroll
            for (int n = 0; n < 4; ++n) acc[m][n] = (f32x4){0.f, 0.f, 0.f, 0.f};
#pragma unroll 4
        for (int kk = 0; kk < 8; ++kk) { bf16x8 av[4], bv[4];
#pragma unroll
            for (int m = 0; m < 4; ++m) av[m] = *(const bf16x8*)(a + (size_t)16 * m * D + 32 * kk);
#pragma unroll
            for (int n = 0; n < 4; ++n) bv[n] = *(const bf16x8*)(b + (size_t)16 * n * D + 32 * kk);
#pragma unroll
            for (int m = 0; m < 4; ++m)
#pragma unroll
                for (int n = 0; n < 4; ++n) acc[m][n] = __builtin_amdgcn_mfma_f32_16x16x32_bf16(bv[n], av[m], acc[m][n], 0, 0, 0); }
#pragma unroll
        for (int m = 0; m < 4; ++m)
#pragma unroll
            for (int n = 0; n < 4; ++n) *(LAS f32x4*)(P + (size_t)(ks * 64 + 16 * m + l15) * PP + 64 * ch + 16 * n + 4 * q) = acc[m][n];
        __syncthreads();
        { const int row = C.tid >> 3, cg = (C.tid & 7) * 16; f32x4 s[4];
#pragma unroll
          for (int i = 0; i < 4; ++i) { const LAS float* pp = P + (size_t)row * PP + cg + 4 * i;
              s[i] = (*(const LAS f32x4*)pp + *(const LAS f32x4*)(pp + 64 * PP)) + (*(const LAS f32x4*)(pp + 128 * PP) + *(const LAS f32x4*)(pp + 192 * PP)); }
          const size_t ro = (size_t)(r0 + row) * D + c0 + cg; bf16* xo = WSP(bf16, WS_XRES) + (size_t)T_L * D + ro;
          f32x4 xi[4];
          if (layer == 0) {
#pragma unroll
              for (int i = 0; i < 4; ++i) xi[i] = *(const f32x4*)(INP(2) + ro + 4 * i); }
          else { const v4u w0 = *(const v4u*)xo, w1 = *(const v4u*)(xo + 8);
              xi[0] = (f32x4){bflo(w0.x), bfhi(w0.x), bflo(w0.y), bfhi(w0.y)}; xi[1] = (f32x4){bflo(w0.z), bfhi(w0.z), bflo(w0.w), bfhi(w0.w)};
              xi[2] = (f32x4){bflo(w1.x), bfhi(w1.x), bflo(w1.y), bfhi(w1.y)}; xi[3] = (f32x4){bflo(w1.z), bfhi(w1.z), bflo(w1.w), bfhi(w1.w)}; }
          f32x4 v[4];
#pragma unroll
          for (int i = 0; i < 4; ++i) v[i] = xi[i] + *(const f32x4*)(g + c0 + cg + 4 * i) * s[i];
          *(v4u*)xo = (v4u){pk2(v[0].x, v[0].y), pk2(v[0].z, v[0].w), pk2(v[1].x, v[1].y), pk2(v[1].z, v[1].w)};
          *(v4u*)(xo + 8) = (v4u){pk2(v[2].x, v[2].y), pk2(v[2].z, v[2].w), pk2(v[3].x, v[3].y), pk2(v[3].z, v[3].w)}; }
        __syncthreads();
    }
}

constexpr int PH_PER_LAYER = 10, N_PHASES = 2 + DEPTH * PH_PER_LAYER;
struct Args { const float* in[31]; float* out; unsigned char* ws; int ph_lo, ph_hi; };
template <int MASK> __global__ void __launch_bounds__(512, 2) mk_fwd(Args args) {
    extern __shared__ __attribute__((aligned(16))) unsigned char lds_raw[];
    { LAS unsigned long long* pt = (LAS unsigned long long*)((LAS unsigned char*)lds_raw + PTR_OFF);
      if (threadIdx.x == 0) {
#pragma unroll
          for (int i = 0; i < 31; ++i) pt[i] = (unsigned long long)args.in[i]; } }
    volatile LAS unsigned* MISC = (volatile LAS unsigned*)((LAS unsigned char*)lds_raw + MISC_OFF);
    if (threadIdx.x < 32) MISC[threadIdx.x] = 0u;
    __syncthreads();
#define CTX() Ctx C; { int t_ = threadIdx.x; LAUNDER_V(t_); C.tid = t_; C.lane = t_ & 63; C.wave = __builtin_amdgcn_readfirstlane(t_ >> 6); int b_ = blockIdx.x; LAUNDER_S(b_); C.bid = b_; \
    int g_ = gridDim.x; LAUNDER_S(g_); C.G = g_; unsigned long long w_ = (unsigned long long)args.ws; LAUNDER_S(w_); C.wsi = w_; C.out = (float*)(GAS float*)(unsigned long long)args.out; C.lds = (LAS unsigned char*)lds_raw; }
    const int lo = args.ph_lo, hi = args.ph_hi;
#if MK_N_LAUNCHES == 1
    XcdBarrier bar = xcd_barrier_post((unsigned*)(args.ws + WS_CTL) + CW_BAR, MISC + 8);
#define GRID_BAR() xcd_barrier(bar)
#else
#define GRID_BAR() do {} while (0)
#endif
#define PHON(b) (((MASK) >> (b)) & 1)
#ifndef REP_MASK
#define REP_MASK 0
#endif
#define REP(b) for (int rp_ = 0; rp_ < 1 + (((REP_MASK) >> (b)) & 1); ++rp_)
#define REPX(b, cond) for (int rp_ = 0; rp_ < 1 + ((((REP_MASK) >> (b)) & 1) && (cond)); ++rp_)
#define IN(k) (lo <= (k) && (k) < hi)
#define SEAM(k) do { if (IN(k) && IN((k) + 1)) { GRID_BAR(); if (((REP_MASK) >> 17) & 1) GRID_BAR(); } } while (0)
    if (PHON(0) && IN(0)) REP(0) { CTX(); p0_prologue(C); } SEAM(0);
#define LAYER_BODY(layer) { \
        const int p0 = 1 + layer * PH_PER_LAYER; const bool need_ctx = layer < DEPTH - 1; const int ntok = need_ctx ? T_ALL : T_L; \
        if (PHON(1) && IN(p0 + 0)) REPX(15, layer == 0) { CTX(); ph_norm_mix(C, layer); } SEAM(p0 + 0); \
        if (PHON(2) && IN(p0 + 1)) REP(2) { CTX(); pg8::Gemm g{WSP(const pg8::bf16_t, WS_H), WSP(const pg8::bf16_t, WS_WIN) + (size_t)layer * N_PROJ * D, T_ALL, N_PROJ, D}; \
            pg8::StaticOrder S; S.init(T_ALL, N_PROJ, C.G, C.bid); pg8::EpiBf16<0> E{WSP(pg8::bf16_t, WS_PROJ), N_PROJ, nullptr, 0, 0, 1.f}; \
            pg8::gemm_phase<pg8::EpiBf16<0>, pg8::StaticOrder, true, true>(C.lds, g, S, E); } SEAM(p0 + 1); \
        if (IN(p0 + 2)) { if (PHON(3)) REP(3) { CTX(); ph_attn_prep(C, layer); } if (PHON(5)) REP(5) { CTX(); ph_dn_chunk(C, layer); } } SEAM(p0 + 2); \
        if (IN(p0 + 3)) { if (PHON(6)) REP(6) { CTX(); ph_dn_scan(C, layer); } __syncthreads(); if (PHON(4)) REP(4) { CTX(); ph_gmlp(C, layer, ntok); } __syncthreads(); if (PHON(7)) REP(7) { CTX(); ph_attention(C, need_ctx, layer); } } SEAM(p0 + 3); \
        if (PHON(8) && IN(p0 + 4)) REP(8) { CTX(); ph_finalize(C, layer, ntok); } SEAM(p0 + 4); \
        if (PHON(9) && IN(p0 + 5)) REPX(14, layer == 0) { CTX(); pg8::Gemm g{WSP(const pg8::bf16_t, WS_MIX), WSP(const pg8::bf16_t, WS_WOUT) + (size_t)layer * D * D, T_L, D, D}; \
            pg8::StaticOrder S; S.init(T_L, D, C.G, C.bid); \
            if (layer == 0) { pg8::EpiOutRes<true> E{INP(0), INP(2), WSP(pg8::bf16_t, WS_XRES), WSP(const float, WS_MOD) + (size_t)layer * 9 * 6 * D}; \
                pg8::gemm_phase<pg8::EpiOutRes<true>, pg8::StaticOrder, true, true>(C.lds, g, S, E); } \
            else { pg8::EpiOutRes<false> E{WSP(const pg8::bf16_t, WS_XRES), WSP(const pg8::bf16_t, WS_XRES) + (size_t)T_L * D, WSP(pg8::bf16_t, WS_XRES), WSP(const float, WS_MOD) + (size_t)layer * 9 * 6 * D}; \
                pg8::gemm_phase<pg8::EpiOutRes<false>, pg8::StaticOrder, true, true>(C.lds, g, S, E); } \
            if (need_ctx) ph_outproj_ctx(C, layer); } SEAM(p0 + 5); \
        if (PHON(10) && IN(p0 + 6)) REP(10) { CTX(); ph_router(C, layer, ntok); } SEAM(p0 + 6); \
        if (PHON(11) && IN(p0 + 7)) REP(11) { CTX(); ph_slots(C, layer, ntok); } SEAM(p0 + 7); \
        if (PHON(12) && IN(p0 + 8)) REP(12) { CTX(); pg8::Gemm g{WSP(const pg8::bf16_t, WS_F), WSP(const pg8::bf16_t, WS_WUP) + (size_t)layer * NE * 2 * DE * D, P_ROWS, NE * 2 * DE, D, WSP(const int, WS_ROWMAP)}; \
            pg8::MoeOrder S; S.init(WSP(const int, WS_TEXP), 8, C.G, C.bid); pg8::EpiSwiglu E{WSP(pg8::bf16_t, WS_HID), INP(27) + (size_t)layer * NE * 2 * DE}; \
            pg8::gemm_phase<pg8::EpiSwiglu, pg8::MoeOrder, true, true, true>(C.lds, g, S, E); } SEAM(p0 + 8); \
        if (PHON(13) && IN(p0 + 9)) REP(13) { CTX(); pg8::Gemm g{WSP(const pg8::bf16_t, WS_HID), WSP(const pg8::bf16_t, WS_WDN) + (size_t)layer * NE * D * DE, P_ROWS, NE * D, DE}; \
            pg8::MoeOrder S; S.init(WSP(const int, WS_TEXP), 4, C.G, C.bid); pg8::EpiDown E{WSP(unsigned char, WS_YS), INP(29) + (size_t)layer * NE * D}; \
            pg8::gemm_phase<pg8::EpiDown, pg8::MoeOrder, true, true>(C.lds, g, S, E); } SEAM(p0 + 9); \
    }
    static_assert(DEPTH <= 4, "layer sites");
    if constexpr (DEPTH > 0) LAYER_BODY(0)
    if constexpr (DEPTH > 1) LAYER_BODY(1)
    if constexpr (DEPTH > 2) LAYER_BODY(2)
    if constexpr (DEPTH > 3) LAYER_BODY(3)
#undef LAYER_BODY
    if (PHON(1) && IN(N_PHASES - 1)) REP(16) { CTX(); ph_norm_mix(C, DEPTH); }
#undef IN
#undef SEAM
}

#ifndef EMU
#ifndef FULL_MASK_V
#define FULL_MASK_V 0x3fff
#endif
constexpr int FULL_MASK = FULL_MASK_V;
typedef void (*kern_t)(Args);
static int phase_mask(int p) {
    if (p == 0) return 1; if (p == N_PHASES - 1) return 2;
    const int k = (p - 1) % PH_PER_LAYER; const int m[10] = {2, 4, 8 | 32, 16 | 64 | 128, 256, 512, 1024, 2048, 4096, 8192}; return m[k];
}
static kern_t kern_of_mask(int m) {
    switch (m) {
#if MK_N_LAUNCHES == 1
        case FULL_MASK: return mk_fwd<FULL_MASK>;
#else
        case 1: return mk_fwd<1>; case 2: return mk_fwd<2>; case 4: return mk_fwd<4>; case 8: return mk_fwd<8>; case 16: return mk_fwd<16>; case 32: return mk_fwd<32>; case 192: return mk_fwd<192>; case 256: return mk_fwd<256>;
        case 512: return mk_fwd<512>; case 1024: return mk_fwd<1024>; case 2048: return mk_fwd<2048>; case 4096: return mk_fwd<4096>; case 8192: return mk_fwd<8192>;
#endif
        default: return nullptr;
    }
}
extern "C" void kernel_launch(void* const* d_in, const int* in_sizes, int n_in, void* d_out, int out_size, void* d_ws, size_t ws_size, hipStream_t stream) {
    static int grid = 0;
    if (grid == 0) {
        if (n_in != 31 || in_sizes[0] != T_L * D || out_size != T_L * D || ws_size < WS_END) { fprintf(stderr, "kernel_launch: shape/workspace mismatch (n_in %d, in0 %d, out %d, ws %zu, need %zu)\n", n_in, n_in > 0 ? in_sizes[0] : -1, out_size, ws_size, (size_t)WS_END); grid = -1; return; }
        int dev = 0, cus = 0;
        if (hipGetDevice(&dev) != hipSuccess || hipDeviceGetAttribute(&cus, hipDeviceAttributeMultiprocessorCount, dev) != hipSuccess) { grid = -1; return; }
#if MK_N_LAUNCHES == 1
        const int masks[1] = {FULL_MASK}; const int nm = 1;
#else
        const int masks[13] = {1, 2, 4, 8, 16, 32, 192, 256, 512, 1024, 2048, 4096, 8192}; const int nm = 13;
#endif
        for (int i = 0; i < nm; ++i) {
            if (hipFuncSetAttribute((const void*)kern_of_mask(masks[i]), hipFuncAttributeMaxDynamicSharedMemorySize, LDS_BYTES) != hipSuccess) { fprintf(stderr, "kernel_launch: hipFuncSetAttribute failed\n"); grid = -1; return; }
            int per_cu = 0;
            if (hipOccupancyMaxActiveBlocksPerMultiprocessor(&per_cu, (const void*)kern_of_mask(masks[i]), 512, LDS_BYTES) != hipSuccess || per_cu < 1) fprintf(stderr, "kernel_launch: occupancy query reports %d for mask %d\n", per_cu, masks[i]);
        }
        (void)hipGetLastError();
        grid = cus;
        if (grid > 1024) grid = 1024;
    }
    if (grid < 0) return;
    if (hipMemsetAsync((char*)d_ws + WS_CTL, 0, (CW_BAR + XCD_BAR_WORDS) * sizeof(unsigned), stream) != hipSuccess) return;
    Args a{};
    for (int i = 0; i < 31; ++i) a.in[i] = (const float*)d_in[i];
    a.out = (float*)d_out; a.ws = (unsigned char*)d_ws;
#if MK_N_LAUNCHES == 1
    a.ph_lo = 0; a.ph_hi = N_PHASES;
    hipLaunchKernelGGL(mk_fwd<FULL_MASK>, dim3(grid), dim3(512), LDS_BYTES, stream, a);
#else
    for (int p = 0; p < N_PHASES; ++p) { a.ph_lo = p; a.ph_hi = p + 1; const int pm = phase_mask(p);
        for (int bit = 0; bit < 14; ++bit) { int m = pm & (1 << bit); if (!m) continue; if (m == 64 || m == 128) { if (m == 128) continue; m = 192; } hipLaunchKernelGGL(kern_of_mask(m), dim3(grid), dim3(512), LDS_BYTES, stream, a); } }
#endif
}
#endif
```

```cpp
#ifndef EMU
#include <hip/hip_runtime.h>
#include <cstdio>
#include <cstdint>
#endif

#ifndef MK_N_LAUNCHES
#define MK_N_LAUNCHES 1
#endif

#ifndef CFG_BATCH
#define CFG_BATCH 8
#define CFG_SEQ 4096
#define CFG_CTX 256
#define CFG_DEPTH 4
#endif
constexpr int NB = CFG_BATCH, SEQ = CFG_SEQ, LC = CFG_CTX, DEPTH = CFG_DEPTH, D = 1024;
constexpr int GRID_W = 64;
constexpr int T_L = NB * SEQ, T_C = NB * LC, T_ALL = T_L + T_C;
constexpr int D_IN = 2832, N_PROJ = 2816;
constexpr int NKEY = SEQ + LC;
constexpr int NE = 32, TOPK = 4, DE = 1024;
constexpr int NCH_L = SEQ / 64, NCH_C = LC / 64, NCH = NCH_L + NCH_C;
constexpr int MAX_TILES = (T_ALL * TOPK) / 256 + NE;
constexpr int P_ROWS = MAX_TILES * 256;
constexpr float NORM_EPS = 1e-6f;
static_assert(SEQ % 256 == 0 && LC % 128 == 0 && T_ALL % 256 == 0 && (T_ALL * TOPK) % 256 == 0, "tiling");
constexpr int C_AQ = 0, C_AK = 256, C_AV = 384, C_BU = 512, C_BV = 768, C_CQ = 1024, C_CK = 1280, C_CV = 1536, C_DQKV = 1792, C_DZ = 2560, C_DB = 2816, C_DA = 2824;

#ifndef EMU
#define GAS __attribute__((address_space(1)))
#define LAS __attribute__((address_space(3)))
#define DEVI __device__ __forceinline__
#define LDS_WAIT() asm volatile("s_waitcnt lgkmcnt(0)" ::: "memory")
#define VM_WAIT() asm volatile("s_waitcnt vmcnt(0)" ::: "memory")
#define LAUNDER_V(x) asm volatile("" : "+v"(x))
#define LAUNDER_S(x) asm volatile("" : "+s"(x))
#endif
typedef unsigned short bf16;
typedef unsigned v4u __attribute__((ext_vector_type(4)));
typedef unsigned v2u __attribute__((ext_vector_type(2)));
typedef float f32x4 __attribute__((ext_vector_type(4)));
typedef float f32x2 __attribute__((ext_vector_type(2)));
typedef short bf16x8 __attribute__((ext_vector_type(8)));
typedef GAS unsigned gu32;
#define RLX_AGENT __ATOMIC_RELAXED, __HIP_MEMORY_SCOPE_AGENT
typedef __bf16 hbf2_t __attribute__((ext_vector_type(2)));
DEVI unsigned pk2(float lo, float hi) { const f32x2 v = {lo, hi}; return __builtin_bit_cast(unsigned, __builtin_convertvector(v, hbf2_t)); }
DEVI unsigned f2bf(float f) { return pk2(f, 0.f) & 0xffffu; }
DEVI float bf2f(unsigned h) { return __builtin_bit_cast(float, (h & 0xffffu) << 16); }
DEVI float bflo(unsigned w) { return __builtin_bit_cast(float, w << 16); }
DEVI float bfhi(unsigned w) { return __builtin_bit_cast(float, w & 0xffff0000u); }
DEVI float fast_exp(float x) { return __builtin_amdgcn_exp2f(x * 1.4426950408889634f); }
DEVI float fast_rcp(float x) { return __builtin_amdgcn_rcpf(x); }
DEVI float sigmoidf_(float x) { return fast_rcp(1.f + fast_exp(-x)); }
DEVI float siluf_(float x) { return x * sigmoidf_(x); }
DEVI float tanh_fast(float x) { const float e = fast_exp(-2.f * __builtin_fabsf(x)); const float t = (1.f - e) * fast_rcp(1.f + e); return x < 0.f ? -t : t; }
DEVI float gelu_tanh(float x) { return 0.5f * x * (1.f + tanh_fast(0.7978845608028654f * (x + 0.044715f * x * x * x))); }
DEVI float softplusf_(float x) { return x > 20.f ? x : __builtin_amdgcn_logf(1.f + fast_exp(x)) * 0.6931471805599453f; }
DEVI float wave_sum(float v) {
#pragma unroll
    for (int o = 1; o < 64; o <<= 1) v += __shfl_xor(v, o);
    return v;
}
template <int W> DEVI float group_sum(float v) {
#pragma unroll
    for (int o = 1; o < W; o <<= 1) v += __shfl_xor(v, o);
    return v;
}

constexpr size_t al256(size_t x) { return (x + 255) & ~(size_t)255; }
constexpr size_t WS_CTL = 0, CTL_ZERO_BYTES = 1u << 20;
constexpr size_t WS_MOD   = CTL_ZERO_BYTES;
constexpr size_t WS_WIN   = WS_MOD   + al256((size_t)DEPTH * 9 * 6 * D * 4);
constexpr size_t WS_WOUT  = WS_WIN   + al256((size_t)DEPTH * N_PROJ * D * 2);
constexpr size_t WS_WUP   = WS_WOUT  + al256((size_t)DEPTH * D * D * 2);
constexpr size_t WS_WDN   = WS_WUP   + al256((size_t)DEPTH * NE * 2 * DE * D * 2);
constexpr size_t WS_H     = WS_WDN   + al256((size_t)DEPTH * NE * D * DE * 2);
constexpr size_t WS_F     = WS_H     + al256((size_t)T_ALL * D * 2);
constexpr size_t WS_BA    = WS_F     + al256((size_t)T_ALL * D * 2);
constexpr size_t WS_PROJ  = WS_BA    + al256((size_t)T_ALL * 16 * 4);
constexpr size_t WS_XRES  = WS_PROJ  + al256((size_t)T_ALL * N_PROJ * 2);
constexpr size_t WS_MIX   = WS_XRES  + al256((size_t)T_ALL * D * 4);
constexpr size_t WS_QL    = WS_MIX   + al256((size_t)T_ALL * D * 2);
constexpr size_t WS_QC    = WS_QL    + al256((size_t)NB * 12 * SEQ * 64 * 2);
constexpr size_t WS_K     = WS_QC    + al256((size_t)NB * 12 * LC * 64 * 2);
constexpr size_t WS_V     = WS_K     + al256((size_t)NB * 6 * NKEY * 64 * 2);
constexpr size_t WS_OD    = WS_V     + al256((size_t)NB * 6 * NKEY * 64 * 2);
constexpr size_t WS_DNO   = WS_OD    + al256((size_t)2 * T_ALL * 256 * 2);
constexpr size_t WS_DNF   = WS_DNO   + al256((size_t)2 * T_ALL * 256 * 4);
constexpr size_t DN_UNIT_BYTES = 32768;
constexpr size_t WS_HID   = WS_DNF   + al256((size_t)NB * 2 * 4 * NCH * DN_UNIT_BYTES);
constexpr size_t WS_YS    = WS_HID   + al256((size_t)P_ROWS * DE * 2);
constexpr size_t WS_TOKE  = WS_YS    + al256((size_t)P_ROWS * D * 2);
constexpr size_t WS_TOKG  = WS_TOKE  + al256((size_t)T_ALL * 4 * 4);
constexpr size_t WS_TOKP  = WS_TOKG  + al256((size_t)T_ALL * 4 * 4);
constexpr size_t WS_SLOT  = WS_TOKP  + al256((size_t)T_ALL * 4 * 4);
constexpr size_t WS_BCNT  = WS_SLOT  + al256((size_t)T_ALL * 4 * 4);
constexpr size_t WS_TEXP  = WS_BCNT  + al256((size_t)1024 * 32 * 4);
constexpr size_t WS_RWP   = WS_TEXP  + al256((size_t)(MAX_TILES + 64) * 4);
constexpr size_t WS_RBP   = WS_RWP   + al256((size_t)DEPTH * 9 * NE * D * 4);
constexpr size_t WS_ROWMAP = WS_RBP  + al256((size_t)DEPTH * 9 * NE * 4);
constexpr size_t WS_ROPE  = WS_ROWMAP + al256((size_t)P_ROWS * 4);
constexpr size_t WS_END   = WS_ROPE  + al256((size_t)SEQ * 96 * 4);
constexpr int CW_TMO = 0, CW_CODE = 1, CW_BAR = 4096;
namespace pg8 {
#define PG8_LAS __attribute__((address_space(3)))
typedef unsigned short bf16_t;
typedef short bf16x8 __attribute__((ext_vector_type(8)));
typedef float f32x4 __attribute__((ext_vector_type(4)));
typedef unsigned u32x4 __attribute__((ext_vector_type(4)));
constexpr int BM = 256, BK = 64, HALF = 128, HTB = HALF * BK * 2  , STAGE_BYTES = 8 * HTB, NXCD = 8, WGM = 8;

__host__ __device__ __forceinline__ int lds_byte(int r, int c) { const int st = (r >> 4) * 2 + (c >> 5), rr = r & 15, cc = c & 31, ob = rr * 64 + cc * 2; return st * 1024 + (ob ^ (((ob >> 9) & 1) << 5)); }
__host__ __device__ __forceinline__ void stage_rc(int b, int& R, int& C) { const int st = b / 1024, sb = b % 1024, swz = sb ^ (((sb >> 9) & 1) << 5); R = (st >> 1) * 16 + swz / 64; C = (st & 1) * 32 + (swz % 64) / 2; }
__host__ __device__ __forceinline__ int perm32(int rho) { const int n = rho >> 4, i = rho & 15; return 8 * (i >> 2) + 4 * n + (i & 3); }

struct Unit { int pm, pn; };
struct Gemm { const bf16_t* A; const bf16_t* Bt; int M, N, K; const int* rowmap = nullptr; };

struct StaticOrder {
    int nM, nN, nwg, G, c;
    __host__ __device__ void init(int M, int N, int G_, int c_) { nM = M / BM; nN = N / BM; nwg = nM * nN; G = G_; c = c_; }
    __host__ __device__ bool next(int i, Unit& u) const {
        const long L = (long)i * G + c; if (L >= nwg) return false;
        int wgid = (int)L; { const int q = nwg / NXCD, r = nwg % NXCD, xcd = wgid % NXCD, off = wgid / NXCD; wgid = (xcd < r ? xcd * (q + 1) : r * (q + 1) + (xcd - r) * q) + off; }
        const int nig = WGM * nN, gid = wgid / nig, fm = gid * WGM, gsz = (nM - fm) < WGM ? (nM - fm) : WGM;
        u.pm = fm + ((wgid % nig) % gsz); u.pn = (wgid % nig) / gsz; return true;
    }
    __device__ __forceinline__ void a_ready(const Unit&) const {}
    __device__ __forceinline__ void done(const Unit&) const {}
};

#ifndef EMU
__device__ __forceinline__ unsigned cvt_pk_bf16(float lo, float hi) { unsigned r; asm volatile("v_cvt_pk_bf16_f32 %0, %1, %2" : "=v"(r) : "v"(lo), "v"(hi)); return r; }
#else
__device__ __forceinline__ unsigned cvt_pk_bf16(float lo, float hi) { return pk2(lo, hi); }
#endif
typedef float f32x2 __attribute__((ext_vector_type(2)));
__device__ __forceinline__ f32x2 gelu_pk(f32x2 v) {
    const f32x2 av = __builtin_elementwise_abs(v), d = av * 0.2316418882f + 1.0f;
    f32x2 t; t.x = __builtin_amdgcn_rcpf(d.x); t.y = __builtin_amdgcn_rcpf(d.y);
    f32x2 q = t * 0.5307027145f + (-0.7265760135f); q = q * t + 0.7107068705f; q = q * t + (-0.142248368f); q = q * t + 0.127414796f; q = q * t;
    const f32x2 s = (v * v) * (-0.72134752044f);
    f32x2 e; e.x = __builtin_amdgcn_exp2f(s.x); e.y = __builtin_amdgcn_exp2f(s.y);
    const f32x2 m = v * (q * e), r = v - m;
    f32x2 o; o.x = v.x < 0.f ? m.x : r.x; o.y = v.y < 0.f ? m.y : r.y; return o;
}

template <int ACT  > struct EpiBf16 {
    static constexpr bool PERM = true, AFTER_DRAIN = false; static_assert(ACT == 0 || ACT == 1, "EpiBf16: ACT is 0 (none) or 1 (gelu_pk)");
    bf16_t* O; int ldc; const float* bias; int split_cols; size_t split_stride; float scale0;
    __device__ __forceinline__ void operator()(const f32x4 (&acc)[2][2][4][2], const Unit& u, int wr, int wc, int fr, int fq) const {
        const int row0 = u.pm * BM + wr * 64 + fr; int colt = u.pn * BM; bf16_t* base = O;
        float sc = 1.f; if (split_cols) { const int t = colt / split_cols; base += (size_t)t * split_stride; colt -= t * split_cols; if (t == 0) sc = scale0; }
        const int col0 = colt + wc * 32 + 8 * fq, bcol0 = u.pn * BM + wc * 32 + 8 * fq;
        f32x4 bv[2][2];
#pragma unroll
        for (int bj = 0; bj < 2; ++bj)
#pragma unroll
            for (int n = 0; n < 2; ++n) bv[bj][n] = bias ? *(const f32x4*)(bias + bcol0 + bj * HALF + 4 * n) : (f32x4){0.f, 0.f, 0.f, 0.f};
#pragma unroll
        for (int ai = 0; ai < 2; ++ai)
#pragma unroll
            for (int m = 0; m < 4; ++m) { bf16_t* rowp = base + (size_t)(row0 + ai * HALF + m * 16) * ldc + col0;
#pragma unroll
                for (int bj = 0; bj < 2; ++bj) { f32x4 v0 = acc[ai][bj][m][0] + bv[bj][0], v1 = acc[ai][bj][m][1] + bv[bj][1];
                    if (ACT == 1) { f32x2 a = gelu_pk((f32x2){v0[0], v0[1]}), b = gelu_pk((f32x2){v0[2], v0[3]}), c = gelu_pk((f32x2){v1[0], v1[1]}), d = gelu_pk((f32x2){v1[2], v1[3]});
                        v0 = (f32x4){a.x, a.y, b.x, b.y}; v1 = (f32x4){c.x, c.y, d.x, d.y}; }
                    v0 = v0 * sc; v1 = v1 * sc; u32x4 w; w.x = cvt_pk_bf16(v0[0], v0[1]); w.y = cvt_pk_bf16(v0[2], v0[3]); w.z = cvt_pk_bf16(v1[0], v1[1]); w.w = cvt_pk_bf16(v1[2], v1[3]);
                    *(u32x4*)(rowp + bj * HALF) = w; } }
    }
};

template <bool IN_F32> struct EpiOutRes {
    static constexpr bool PERM = true, AFTER_DRAIN = false;
    const void* xin_l; const void* xin_c;
    bf16_t* xres; const float* mod;
    __device__ __forceinline__ void operator()(const f32x4 (&acc)[2][2][4][2], const Unit& u, int wr, int wc, int fr, int fq) const {
        const int rowt = u.pm * BM; const bool isc = rowt >= T_L; const int mrow = isc ? 8 : rowt / SEQ;
        const float* g = mod + (size_t)(mrow * 6 + 2) * D;
        const size_t inoff = isc ? (size_t)(rowt - T_L) * D : (size_t)rowt * D;
        const float* xf = (const float*)(isc ? xin_c : xin_l) + inoff; const bf16_t* xb = (const bf16_t*)(isc ? xin_c : xin_l) + inoff;
        bf16_t* xo = xres + (size_t)rowt * D;
        const int col0 = u.pn * BM + wc * 32 + 8 * fq;
        f32x4 gv[2][2];
#pragma unroll
        for (int bj = 0; bj < 2; ++bj)
#pragma unroll
            for (int n = 0; n < 2; ++n) gv[bj][n] = *(const f32x4*)(g + col0 + bj * HALF + 4 * n);
#pragma unroll
        for (int ai = 0; ai < 2; ++ai)
#pragma unroll
          for (int mp = 0; mp < 2; ++mp) {
            f32x4 xi[2][2][2];
#pragma unroll
            for (int m2 = 0; m2 < 2; ++m2) { const size_t ro = (size_t)(ai * HALF + wr * 64 + (2 * mp + m2) * 16 + fr) * D + col0;
#pragma unroll
                for (int bj = 0; bj < 2; ++bj) {
                    if constexpr (IN_F32) { xi[m2][bj][0] = *(const f32x4*)(xf + ro + bj * HALF); xi[m2][bj][1] = *(const f32x4*)(xf + ro + bj * HALF + 4); }
                    else { const u32x4 w = *(const u32x4*)(xb + ro + bj * HALF);
                        xi[m2][bj][0] = (f32x4){bflo(w.x), bfhi(w.x), bflo(w.y), bfhi(w.y)}; xi[m2][bj][1] = (f32x4){bflo(w.z), bfhi(w.z), bflo(w.w), bfhi(w.w)}; } } }
#pragma unroll
            for (int m2 = 0; m2 < 2; ++m2) { const int m = 2 * mp + m2; const size_t ro = (size_t)(ai * HALF + wr * 64 + m * 16 + fr) * D + col0;
#pragma unroll
                for (int bj = 0; bj < 2; ++bj) { const f32x4 v0 = xi[m2][bj][0] + gv[bj][0] * acc[ai][bj][m][0], v1 = xi[m2][bj][1] + gv[bj][1] * acc[ai][bj][m][1];
                    u32x4 w; w.x = cvt_pk_bf16(v0[0], v0[1]); w.y = cvt_pk_bf16(v0[2], v0[3]); w.z = cvt_pk_bf16(v1[0], v1[1]); w.w = cvt_pk_bf16(v1[2], v1[3]);
                    *(u32x4*)(xo + ro + bj * HALF) = w; } } }
    }
};
struct EpiSwiglu {
    static constexpr bool PERM = true, AFTER_DRAIN = false;
    bf16_t* hid; const float* bup;
    __device__ __forceinline__ void operator()(const f32x4 (&acc)[2][2][4][2], const Unit& u, int wr, int wc, int fr, int fq) const {
        const int e = u.pn >> 3, j = u.pn & 7; const int h0 = j * HALF + wc * 32 + 8 * fq;
        const float* bg = bup + (size_t)e * 2 * DE + h0; const float* bu = bg + DE;
        f32x4 vg[2], vu[2];
#pragma unroll
        for (int n = 0; n < 2; ++n) { vg[n] = *(const f32x4*)(bg + 4 * n); vu[n] = *(const f32x4*)(bu + 4 * n); }
#pragma unroll
        for (int ai = 0; ai < 2; ++ai)
#pragma unroll
            for (int m = 0; m < 4; ++m) { const size_t row = (size_t)u.pm * BM + ai * HALF + wr * 64 + m * 16 + fr; float o[8];
#pragma unroll
                for (int n = 0; n < 2; ++n) { const f32x4 gt = acc[ai][0][m][n] + vg[n], up = acc[ai][1][m][n] + vu[n];
#pragma unroll
                    for (int i = 0; i < 4; ++i) { const float gg = __builtin_fminf(gt[i], 7.0f); const float uu = __builtin_fminf(__builtin_fmaxf(up[i], -7.0f), 7.0f);
                        o[4 * n + i] = gg * sigmoidf_(1.702f * gg) * (uu + 1.0f); } }
                u32x4 w; w.x = cvt_pk_bf16(o[0], o[1]); w.y = cvt_pk_bf16(o[2], o[3]); w.z = cvt_pk_bf16(o[4], o[5]); w.w = cvt_pk_bf16(o[6], o[7]);
                *(u32x4*)(hid + row * DE + h0) = w; }
    }
};
struct EpiDown {
    static constexpr bool PERM = true, AFTER_DRAIN = false;
    unsigned char* ys; const float* bdn;
    __device__ __forceinline__ void operator()(const f32x4 (&acc)[2][2][4][2], const Unit& u, int wr, int wc, int fr, int fq) const {
        typedef unsigned u32x2v __attribute__((ext_vector_type(2)));
        const int e = u.pn >> 2, j = u.pn & 3; const int col0 = j * BM + wc * 32 + 8 * fq;
        f32x4 bv[2][2];
#pragma unroll
        for (int bj = 0; bj < 2; ++bj)
#pragma unroll
            for (int n = 0; n < 2; ++n) bv[bj][n] = *(const f32x4*)(bdn + (size_t)e * D + col0 + bj * HALF + 4 * n);
#pragma unroll
        for (int ai = 0; ai < 2; ++ai)
#pragma unroll
            for (int m = 0; m < 4; ++m) { const size_t row = (size_t)u.pm * BM + ai * HALF + wr * 64 + m * 16 + fr;
#pragma unroll
                for (int bj = 0; bj < 2; ++bj) { const f32x4 v0 = acc[ai][bj][m][0] + bv[bj][0], v1 = acc[ai][bj][m][1] + bv[bj][1];
                    int w0 = 0, w1 = 0;
                    w0 = __builtin_amdgcn_cvt_pk_fp8_f32(v0[0], v0[1], w0, false); w0 = __builtin_amdgcn_cvt_pk_fp8_f32(v0[2], v0[3], w0, true);
                    w1 = __builtin_amdgcn_cvt_pk_fp8_f32(v1[0], v1[1], w1, false); w1 = __builtin_amdgcn_cvt_pk_fp8_f32(v1[2], v1[3], w1, true);
                    *(u32x2v*)(ys + row * D + col0 + bj * HALF) = (u32x2v){(unsigned)w0, (unsigned)w1}; } }
    }
};
struct MoeOrder {
    const int* texp; int ntiles, nN, nwg, G, c;
    __device__ __forceinline__ void init(const int* texp_, int nN_, int G_, int c_) { texp = texp_; ntiles = texp_[0]; nN = nN_; nwg = ntiles * nN_; G = G_; c = c_; }
    __device__ __forceinline__ bool next(int i, Unit& u) const {
        const long L = (long)i * G + c; if (L >= nwg) return false;
        int wgid = (int)L; { const int q = nwg / NXCD, r = nwg % NXCD, xcd = wgid % NXCD, off = wgid / NXCD; wgid = (xcd < r ? xcd * (q + 1) : r * (q + 1) + (xcd - r) * q) + off; }
        const int nig = WGM * nN, gid = wgid / nig, fm = gid * WGM, gsz = (ntiles - fm) < WGM ? (ntiles - fm) : WGM;
        const int pm = fm + ((wgid % nig) % gsz); u.pm = pm; u.pn = texp[1 + pm] * nN + (wgid % nig) / gsz; return true;
    }
    __device__ __forceinline__ void a_ready(const Unit&) const {}
    __device__ __forceinline__ void done(const Unit&) const {}
};
#ifndef EMU
template <class Epi, class Sched, bool ALIGN_EPI = false, bool SP2 = false, bool GATHER = false>
__device__ __forceinline__ void gemm_phase(PG8_LAS unsigned char* lds, const Gemm g, const Sched& S, const Epi& E) {
    int tid_ = threadIdx.x; asm volatile("" : "+v"(tid_));
    const int tid = tid_, wid = __builtin_amdgcn_readfirstlane(tid >> 6), lane = tid & 63, wr = wid >> 2, wc = wid & 3, fr = lane & 15, fq = lane >> 4;
    const int K = g.K, nt = K / BK;
    unsigned voffA[2], voffB[2]; int gR[2], gC[2];
#pragma unroll
    for (int i = 0; i < 2; ++i) { int R, C; stage_rc(tid * 16 + i * 8192, R, C); const int Rb = Epi::PERM ? ((R & ~31) + perm32(R & 31)) : R;
        voffA[i] = (unsigned)(R * K + C) * 2u; voffB[i] = (unsigned)(Rb * K + C) * 2u; gR[i] = R; gC[i] = C; }
    unsigned voffC[2][2], voffN[2][2];
#define PG8_GOFF(dst, pm_) do { _Pragma("unroll") for (int h_ = 0; h_ < 2; ++h_) _Pragma("unroll") for (int i_ = 0; i_ < 2; ++i_) \
        dst[h_][i_] = (unsigned)(g.rowmap[(size_t)(pm_) * BM + h_ * HALF + gR[i_]] * K + gC[i_]) * 2u; } while (0)
    const size_t kstep = (size_t)(BK * 2);
    const size_t hstep = (size_t)HALF * K * 2;
    const size_t tstep = 2 * hstep;
    const unsigned ldsw = (unsigned)wid * 1024u;
    const int aoff = lds_byte(wr * 64 + fr, fq * 8), boff = lds_byte(wc * 32 + fr, fq * 8);
#define PG8_SA(b, h) (((b) * 2 + (h)) * HTB)
#define PG8_SB(b, h) ((4 + (b) * 2 + (h)) * HTB)
#define PG8_STAGE(bufoff, gbase, voff) do { _Pragma("unroll") for (int _i = 0; _i < 2; ++_i) \
        __builtin_amdgcn_global_load_lds((const unsigned*)((const char*)(gbase) + (voff)[_i]), (PG8_LAS unsigned*)(lds + (bufoff) + ldsw + _i * 8192), 16, 0, 0); } while (0)
#define PG8_LDA(dst, b, h) do { _Pragma("unroll") for (int m = 0; m < 4; ++m) _Pragma("unroll") for (int k = 0; k < 2; ++k) dst[m][k] = *(const PG8_LAS bf16x8*)(lds + PG8_SA(b, h) + aoff + m * 2048 + k * 1024); } while (0)
#define PG8_LDB(dst, b, h) do { _Pragma("unroll") for (int n = 0; n < 2; ++n) _Pragma("unroll") for (int k = 0; k < 2; ++k) dst[n][k] = *(const PG8_LAS bf16x8*)(lds + PG8_SB(b, h) + boff + n * 2048 + k * 1024); } while (0)
#define PG8_MMA(ai, bj, At, Bt) do { __builtin_amdgcn_s_setprio(1); _Pragma("unroll") for (int m = 0; m < 4; ++m) _Pragma("unroll") for (int n = 0; n < 2; ++n) _Pragma("unroll") for (int k = 0; k < 2; ++k) \
        acc[ai][bj][m][n] = __builtin_amdgcn_mfma_f32_16x16x32_bf16(Bt[n][k], At[m][k], acc[ai][bj][m][n], 0, 0, 0); __builtin_amdgcn_s_setprio(0); } while (0)
#define PG8_WAIT_V(n) asm volatile("s_waitcnt vmcnt(" #n ")" ::: "memory")
#define PG8_WAIT_L(n) asm volatile("s_waitcnt lgkmcnt(" #n ")" ::: "memory")
#define PG8_BAR __builtin_amdgcn_s_barrier()
#define PG8_SCHED __builtin_amdgcn_sched_barrier(0)
#define PG8_STAGEA(bufoff, gbase, h, nx) do { if constexpr (GATHER) { _Pragma("unroll") for (int _i = 0; _i < 2; ++_i) { const unsigned o_ = (nx) ? voffN[h][_i] : voffC[h][_i]; \
        __builtin_amdgcn_global_load_lds((const unsigned*)((const char*)(gbase) + o_), (PG8_LAS unsigned*)(lds + (bufoff) + ldsw + _i * 8192), 16, 0, 0); } } \
    else { PG8_STAGE(bufoff, (gbase) + (h) * hstep, voffA); } } while (0)
    Unit cur, nxt; int ui = 0;
    if (!S.next(0, cur)) return;
    f32x4 acc[2][2][4][2];
#pragma unroll
    for (int a = 0; a < 2; ++a)
#pragma unroll
        for (int b = 0; b < 2; ++b)
#pragma unroll
            for (int m = 0; m < 4; ++m)
#pragma unroll
                for (int n = 0; n < 2; ++n) acc[a][b][m][n] = (f32x4){0.f, 0.f, 0.f, 0.f};
    bf16x8 At[4][2], B0[2][2], B1[2][2];
    const char* cA = (const char*)g.A + (GATHER ? (size_t)0 : (size_t)cur.pm * tstep); if constexpr (GATHER) { PG8_GOFF(voffC, cur.pm); }
    const char* cB = (const char*)g.Bt + (size_t)cur.pn * tstep;
    S.a_ready(cur);
    if constexpr (SP2) {
        PG8_STAGE(PG8_SB(0, 0), cB, voffB); PG8_STAGE(PG8_SB(0, 1), cB + hstep, voffB); PG8_STAGEA(PG8_SA(0, 0), cA, 0, false); PG8_STAGEA(PG8_SA(0, 1), cA, 1, false);
        if (wr == 1) PG8_BAR;
        PG8_WAIT_V(2); PG8_BAR;
        PG8_STAGE(PG8_SB(1, 0), cB + kstep, voffB); PG8_STAGEA(PG8_SA(1, 0), cA + kstep, 0, false); PG8_STAGE(PG8_SB(1, 1), cB + hstep + kstep, voffB);
        PG8_WAIT_V(6); PG8_BAR;
    } else {
        PG8_STAGE(PG8_SB(0, 0), cB, voffB); PG8_STAGEA(PG8_SA(0, 0), cA, 0, false); PG8_STAGE(PG8_SB(0, 1), cB + hstep, voffB); PG8_STAGEA(PG8_SA(0, 1), cA, 1, false);
        if (wr == 1) PG8_BAR;
        PG8_WAIT_V(4); PG8_BAR;
        PG8_STAGE(PG8_SB(1, 0), cB + kstep, voffB); PG8_STAGEA(PG8_SA(1, 0), cA + kstep, 0, false); PG8_STAGE(PG8_SB(1, 1), cB + hstep + kstep, voffB);
        PG8_WAIT_V(6); PG8_BAR;
    }
    for (;;) {
        const bool has_next = S.next(ui + 1, nxt);
        if constexpr (GATHER) { if (has_next) { PG8_GOFF(voffN, nxt.pm); } else { _Pragma("unroll") for (int h_ = 0; h_ < 2; ++h_) _Pragma("unroll") for (int i_ = 0; i_ < 2; ++i_) voffN[h_][i_] = voffC[h_][i_]; } }
        const char* nA = (has_next && !GATHER) ? (const char*)g.A + (size_t)nxt.pm * tstep : cA; const char* nB = has_next ? (const char*)g.Bt + (size_t)nxt.pn * tstep : cB;
        for (int t = 0; t < nt; t += 2) {
            const bool last = (t == nt - 2);
            const char* a1 = cA + (size_t)(t + 1) * kstep;
            const char* a2 = last ? nA : cA + (size_t)(t + 2) * kstep; const char* b2 = last ? nB : cB + (size_t)(t + 2) * kstep;
            const char* a3 = a2 + kstep; const char* b3 = b2 + kstep;
            if (last && has_next) S.a_ready(nxt);
            if constexpr (SP2) {
            PG8_LDB(B0, 0, 0); PG8_LDB(B1, 0, 1); PG8_SCHED; PG8_LDA(At, 0, 0); PG8_STAGEA(PG8_SA(1, 1), a1, 1, false);
            PG8_WAIT_V(8); PG8_WAIT_L(0); PG8_BAR; PG8_MMA(0, 0, At, B0); PG8_MMA(0, 1, At, B1); PG8_BAR; PG8_SCHED;
            PG8_LDA(At, 0, 1); PG8_STAGE(PG8_SB(0, 0), b2, voffB); PG8_STAGE(PG8_SB(0, 1), b2 + hstep, voffB); PG8_STAGEA(PG8_SA(0, 0), a2, 0, last);
            PG8_WAIT_V(8); PG8_WAIT_L(0); PG8_BAR; PG8_MMA(1, 0, At, B0); PG8_MMA(1, 1, At, B1); PG8_BAR; PG8_SCHED;
            PG8_LDB(B0, 1, 0); PG8_LDB(B1, 1, 1); PG8_SCHED; PG8_LDA(At, 1, 0); PG8_STAGEA(PG8_SA(0, 1), a2, 1, last);
            PG8_WAIT_V(8); PG8_WAIT_L(0); PG8_BAR; PG8_MMA(0, 0, At, B0); PG8_MMA(0, 1, At, B1); PG8_BAR; PG8_SCHED;
            PG8_LDA(At, 1, 1); PG8_STAGE(PG8_SB(1, 0), b3, voffB); PG8_STAGE(PG8_SB(1, 1), b3 + hstep, voffB); PG8_STAGEA(PG8_SA(1, 0), a3, 0, last);
            PG8_WAIT_V(8); PG8_WAIT_L(0); PG8_BAR; PG8_MMA(1, 0, At, B0); PG8_MMA(1, 1, At, B1); PG8_BAR; PG8_SCHED;
            } else {
            PG8_LDB(B0, 0, 0); PG8_SCHED; PG8_LDA(At, 0, 0); PG8_STAGEA(PG8_SA(1, 1), a1, 1, false);
            PG8_WAIT_L(8); PG8_BAR; PG8_WAIT_L(0); PG8_MMA(0, 0, At, B0); PG8_BAR; PG8_SCHED;
            PG8_LDB(B1, 0, 1); PG8_STAGE(PG8_SB(0, 0), b2, voffB);
            PG8_BAR; PG8_WAIT_L(0); PG8_MMA(0, 1, At, B1); PG8_BAR;
            PG8_LDA(At, 0, 1); PG8_STAGEA(PG8_SA(0, 0), a2, 0, last);
            PG8_BAR; PG8_WAIT_L(0); PG8_MMA(1, 0, At, B0); PG8_BAR; PG8_SCHED;
            PG8_STAGE(PG8_SB(0, 1), b2 + hstep, voffB);
            PG8_WAIT_V(6); PG8_BAR; PG8_MMA(1, 1, At, B1); PG8_BAR;
            PG8_LDB(B0, 1, 0); PG8_SCHED; PG8_LDA(At, 1, 0); PG8_STAGEA(PG8_SA(0, 1), a2, 1, last);
            PG8_WAIT_L(8); PG8_BAR; PG8_WAIT_L(0); PG8_MMA(0, 0, At, B0); PG8_BAR; PG8_SCHED;
            PG8_LDB(B1, 1, 1); PG8_STAGE(PG8_SB(1, 0), b3, voffB);
            PG8_BAR; PG8_WAIT_L(0); PG8_MMA(0, 1, At, B1); PG8_BAR;
            PG8_LDA(At, 1, 1); PG8_STAGEA(PG8_SA(1, 0), a3, 0, last);
            PG8_BAR; PG8_WAIT_L(0); PG8_MMA(1, 0, At, B0); PG8_BAR; PG8_SCHED;
            PG8_STAGE(PG8_SB(1, 1), b3 + hstep, voffB);
            PG8_WAIT_V(6); PG8_BAR; PG8_MMA(1, 1, At, B1); PG8_BAR;
            }
        }
        if constexpr (ALIGN_EPI) { if (wr == 0) PG8_BAR; }
        if constexpr (!Epi::AFTER_DRAIN) { E(acc, cur, wr, wc, fr, fq); S.done(cur); }
        if (!has_next) break;
#pragma unroll
        for (int a = 0; a < 2; ++a)
#pragma unroll
            for (int b = 0; b < 2; ++b)
#pragma unroll
                for (int m = 0; m < 4; ++m)
#pragma unroll
                    for (int n = 0; n < 2; ++n) acc[a][b][m][n] = (f32x4){0.f, 0.f, 0.f, 0.f};
        cur = nxt; cA = nA; cB = nB; ++ui;
        if constexpr (GATHER) { _Pragma("unroll") for (int h_ = 0; h_ < 2; ++h_) _Pragma("unroll") for (int i_ = 0; i_ < 2; ++i_) voffC[h_][i_] = voffN[h_][i_]; }
        if constexpr (ALIGN_EPI) { if (wr == 1) PG8_BAR; }
    }
    PG8_WAIT_V(0);
    if constexpr (!ALIGN_EPI) { if (wr == 0) PG8_BAR; }
    PG8_BAR;
    if constexpr (Epi::AFTER_DRAIN) { E.fused(acc, cur, wr, wc, fr, fq, lds, wid, lane); S.done(cur); }
#undef PG8_SA
#undef PG8_SB
#undef PG8_STAGE
#undef PG8_STAGEA
#undef PG8_GOFF
#undef PG8_LDA
#undef PG8_LDB
#undef PG8_MMA
#undef PG8_WAIT_V
#undef PG8_WAIT_L
#undef PG8_BAR
#undef PG8_SCHED
}
#else
EMU_GEMM_PHASE
#endif
}
#ifndef EMU
namespace attn_body {
using bf16=unsigned short;
using bf16x8=__attribute__((ext_vector_type(8)))short;
using s16x4=__attribute__((ext_vector_type(4)))short;
using f32x16=__attribute__((ext_vector_type(16)))float;
using u32x4=__attribute__((ext_vector_type(4)))unsigned;
constexpr int D=64,DM=64;
constexpr int NW=8,QBLK=32,QB=QBLK*NW,KVBLK=64;
__device__ __forceinline__ int crow(int r,int hi){return (r&3)+8*(r>>2)+4*hi;}
#define SBAR() __builtin_amdgcn_sched_barrier(0)
constexpr int NSLOT=3, SLOTB=8192;
constexpr int LDS_K=0, LDS_V=NSLOT*SLOTB, LDS_WS=2*NSLOT*SLOTB, LDS_OST=LDS_WS+NW*64*4, LDS_BYTES=LDS_OST+NW*4096;
__device__ __forceinline__ void glds16(const void*gsrc,unsigned lds_dst){unsigned keep;
  asm volatile("s_mov_b32 %0, m0\n\ts_mov_b32 m0, %2\n\ts_nop 0\n\tglobal_load_lds_dwordx4 %1, off\n\ts_mov_b32 m0, %0":"=&s"(keep):"v"(gsrc),"s"(lds_dst):"memory");}
__device__ __forceinline__ float max3f(float a,float b,float c){float r;asm("v_max3_f32 %0, %1, %2, %3":"=v"(r):"v"(a),"v"(b),"v"(c));return r;}
__device__ __forceinline__ float max2f(float a,float b){float r;asm("v_max_f32_e32 %0, %1, %2":"=v"(r):"v"(a),"v"(b));return r;}
__device__ __forceinline__ float fadd_s(float a,float b){float r;asm("v_add_f32_e32 %0, %1, %2":"=v"(r):"v"(a),"v"(b));return r;}
__device__ __forceinline__ float fsub_s(float a,float b){float r;asm("v_sub_f32_e32 %0, %1, %2":"=v"(r):"v"(a),"v"(b));return r;}
typedef float f32x2_t __attribute__((ext_vector_type(2))); typedef __bf16 bf16x2_t __attribute__((ext_vector_type(2)));
__device__ __forceinline__ unsigned cvtpk_s(float lo,float hi){f32x2_t v={lo,hi};bf16x2_t b=__builtin_convertvector(v,bf16x2_t);return __builtin_bit_cast(unsigned,b);}
#define WAIT_BAR(N) asm volatile("s_waitcnt vmcnt(" #N ") lgkmcnt(0)\n\ts_barrier":::"memory")

template<int MODE> __device__ __forceinline__ constexpr bool d0_on(int d0){ return MODE==0 || (MODE==1 && d0<2) || (MODE==2 && d0>=2); }
template<int MODE> __device__ __forceinline__ void qkt(f32x16&p0,f32x16&p1,const char*Kslot,const bf16x8*qr,const f32x16&negm,int r32,int hi){
  const char*kb=Kslot+hi*1024+r32*16;
  constexpr int D0A=(MODE==2)?2:0, D0B=(MODE==1)?2:4;
  #pragma unroll
  for(int d0=D0A;d0<D0B;++d0){
    const bf16x8 b0=*reinterpret_cast<const bf16x8*>(kb+d0*2048);
    const bf16x8 b1=*reinterpret_cast<const bf16x8*>(kb+d0*2048+512);
    if(d0==D0A){p0=__builtin_amdgcn_mfma_f32_32x32x16_bf16(b0,qr[d0],negm,0,0,0);p1=__builtin_amdgcn_mfma_f32_32x32x16_bf16(b1,qr[d0],negm,0,0,0);}
    else{p0=__builtin_amdgcn_mfma_f32_32x32x16_bf16(b0,qr[d0],p0,0,0,0);p1=__builtin_amdgcn_mfma_f32_32x32x16_bf16(b1,qr[d0],p1,0,0,0);}}
}
template<int MODE,int IDX> __device__ __forceinline__ void qk_mf(f32x16&Cx,const bf16x8&k,const bf16x8&q,const f32x16&negm){
  if constexpr(d0_on<MODE>(IDX>>1)){ constexpr bool first=((IDX>>1)==((MODE==2)?2:0));
    if constexpr(first) Cx=__builtin_amdgcn_mfma_f32_32x32x16_bf16(k,q,negm,0,0,0); else Cx=__builtin_amdgcn_mfma_f32_32x32x16_bf16(k,q,Cx,0,0,0); }
}
typedef __attribute__((address_space(3))) const char* lds_cptr;
typedef short v4i16_t __attribute__((ext_vector_type(4)));
template<int MODE> __device__ __forceinline__ void kload8(bf16x8*kf,lds_cptr kp){
  #pragma unroll
  for(int j=0;j<4;++j) if(d0_on<MODE>(j)){ kf[2*j]=*(const __attribute__((address_space(3))) bf16x8*)(kp+j*2048); kf[2*j+1]=*(const __attribute__((address_space(3))) bf16x8*)(kp+j*2048+512); }
}
__device__ __forceinline__ void kload2(bf16x8*kf,lds_cptr kp,int j){ kf[2*j]=*(const __attribute__((address_space(3))) bf16x8*)(kp+j*2048); kf[2*j+1]=*(const __attribute__((address_space(3))) bf16x8*)(kp+j*2048+512); }
__device__ __forceinline__ s16x4 vtr(lds_cptr p){ return __builtin_bit_cast(s16x4,__builtin_amdgcn_ds_read_tr16_b64_v4i16((__attribute__((address_space(3))) v4i16_t*)p)); }
__device__ __forceinline__ float rowmax(const f32x16&p0,const f32x16&p1){
  float a=max3f(p0[0],p0[1],p1[0]),b=max3f(p0[2],p0[3],p1[1]);a=max3f(a,p1[2],p1[3]);
  #pragma unroll
  for(int r=4;r<16;r+=4){a=max3f(a,p0[r],p0[r+1]);b=max3f(b,p0[r+2],p0[r+3]);a=max3f(a,p1[r],p1[r+1]);b=max3f(b,p1[r+2],p1[r+3]);}
  const float m=max2f(a,b);
  auto rr=__builtin_amdgcn_permlane32_swap(__float_as_uint(m),__float_as_uint(m),false,false);
  return max2f(__uint_as_float(rr[0]),__uint_as_float(rr[1]));
}
__device__ __forceinline__ void pv(f32x16*o,int vb,bf16x8 pa0,bf16x8 pa1,bf16x8 pa2,bf16x8 pa3){
  #pragma unroll
  for(int d0=0;d0<2;++d0){s16x4 lo[4],hi[4];
    #pragma unroll
    for(int ks=0;ks<4;++ks){
      asm volatile("ds_read_b64_tr_b16 %0,%1 offset:%c2":"=&v"(lo[ks]):"v"(vb),"i"(d0*4096+ks*1024):"memory");
      asm volatile("ds_read_b64_tr_b16 %0,%1 offset:%c2":"=&v"(hi[ks]):"v"(vb),"i"(d0*4096+ks*1024+512):"memory");}
    asm volatile("s_waitcnt lgkmcnt(0)":::"memory");SBAR();
    #define PK(k) (bf16x8){lo[k][0],lo[k][1],lo[k][2],lo[k][3],hi[k][0],hi[k][1],hi[k][2],hi[k][3]}
    o[d0]=__builtin_amdgcn_mfma_f32_32x32x16_bf16(pa0,PK(0),o[d0],0,0,0);
    o[d0]=__builtin_amdgcn_mfma_f32_32x32x16_bf16(pa1,PK(1),o[d0],0,0,0);
    o[d0]=__builtin_amdgcn_mfma_f32_32x32x16_bf16(pa2,PK(2),o[d0],0,0,0);
    o[d0]=__builtin_amdgcn_mfma_f32_32x32x16_bf16(pa3,PK(3),o[d0],0,0,0);
    #undef PK
  }
}

#ifndef ATTN_STORE16
#define ATTN_STORE16(p,v) (*(u32x4*)(p)=(v))
#endif
template<int THRL,int MODE> __device__ __forceinline__ void attn_unit(const bf16*Qa,const bf16*Qb,const bf16*__restrict__ Kh,const bf16*__restrict__ Vh,bf16*Oa,bf16*Ob,int opitch,int NT,char*shm,float lam,float post,const float*subln){
  int tid_=threadIdx.x; asm volatile("":"+v"(tid_)); const int tid=tid_,lane=tid&63,r32=lane&31,hi=lane>>5; const int wid=__builtin_amdgcn_readfirstlane(tid>>6);
  const bf16*Qw=(wid<4?Qa:Qb)+(long)((wid&3)*QBLK)*DM;
  const unsigned lds0=(unsigned)(uintptr_t)shm;
  float*wsf=(float*)(shm+LDS_WS)+wid*64;
  const bf16*ksrc=Kh+(long)lane*DM+wid*8;
  const bf16*vsrc=Vh+(long)(16*(wid&3)+(lane>>2))*DM+(wid>>2)*32+(lane&3)*8;
  const unsigned kdst=lds0+LDS_K+wid*1024, vdst=lds0+LDS_V+wid*1024;
  #define DMA_K(t,slot) glds16(ksrc+(long)(t)*KVBLK*DM,(unsigned)__builtin_amdgcn_readfirstlane(kdst+(slot)))
  #define DMA_V(t,slot) glds16(vsrc+(long)(t)*KVBLK*DM,(unsigned)__builtin_amdgcn_readfirstlane(vdst+(slot)))
  const int vb0=(int)(lds0+LDS_V)+((lane>>4)&1)*32+(lane&3)*8+(4*hi+((lane&15)>>2))*64;
  const char*Kbase=shm+LDS_K; bf16x8 kf[8];
  const lds_cptr shm3=(lds_cptr)shm; const lds_cptr kp0=shm3+LDS_K+hi*1024+r32*16; const lds_cptr vp0=shm3+LDS_V+((lane>>4)&1)*32+(lane&3)*8+(4*hi+((lane&15)>>2))*64;
  DMA_K(0,0);DMA_V(0,0);DMA_K(1,SLOTB);
  bf16x8 qr[4];
  #pragma unroll
  for(int d0=0;d0<4;++d0)qr[d0]=*reinterpret_cast<const bf16x8*>(&Qw[(long)r32*DM+d0*16+hi*8]);
  float mhat=0.f,l_reg=0.f;f32x16 o[2];o[0]=f32x16{};o[1]=f32x16{};f32x16 negm=f32x16{};asm volatile("":"+v"(negm));
  #define CMASK(P0,P1,t) do{}while(0)
  bool resc=false;
  #define START(P0,P1) do{ const float rm=rowmax(P0,P1); resc=false; \
    { const float dl=rm; mhat=fadd_s(mhat,dl); \
      _Pragma("unroll") for(int r=0;r<16;++r){P0[r]=fsub_s(P0[r],dl);P1[r]=fsub_s(P1[r],dl);} \
      _Pragma("unroll") for(int r=0;r<16;++r)negm[r]=-mhat; asm volatile("":"+v"(negm)); } \
    _Pragma("unroll") for(int r=0;r<16;++r)P0[r]=__builtin_amdgcn_exp2f(P0[r]); }while(0)
  #define RESC() do{ if(resc){ asm volatile("s_waitcnt lgkmcnt(0)":::"memory"); \
      _Pragma("unroll") for(int d_=0;d_<2;++d_) _Pragma("unroll") for(int r=0;r<16;++r)o[d_][r]*=wsf[crow(r,hi)]; } }while(0)
  f32x16 pA0,pA1,pB0,pB1;
  int sl_prev=0,sl_cur=0,sl_next=SLOTB;
  #define ROT() do{sl_prev=sl_cur;sl_cur=sl_next;sl_next=(sl_next==(NSLOT-1)*SLOTB)?0:sl_next+SLOTB;}while(0)
  DMA_K(2,2*SLOTB);
  WAIT_BAR(3);
  qkt<MODE>(pA0,pA1,Kbase,qr,negm,r32,hi);asm volatile("s_nop 15\n\ts_nop 7":"+v"(pA0),"+v"(pA1));CMASK(pA0,pA1,0);
  START(pA0,pA1);
  _Pragma("unroll") for(int r=0;r<16;++r)pA1[r]=__builtin_amdgcn_exp2f(pA1[r]);
  WAIT_BAR(0);
  DMA_K(3,0);DMA_V(1,SLOTB);
  ROT();
  kload8<MODE>(kf,kp0+sl_cur);
  WAIT_BAR(2);
  s16x4 vlo[8],vhi[8]; u32x4 pw0,pw1,pw2,pw3;
  #define PKW(P,B) cvtpk_s(P[B],P[B+1])
  #define PAF(k) __builtin_bit_cast(bf16x8,pw##k)
  #define VFR(i) (bf16x8){vlo[i][0],vlo[i][1],vlo[i][2],vlo[i][3],vhi[i][0],vhi[i][1],vhi[i][2],vhi[i][3]}
  #define PIN(x) asm volatile("":"+v"(x))
  #define MX3(a,b,c) __builtin_fmaxf(__builtin_fmaxf((a),(b)),(c))
  #define GAPA(MF,A0,A1,A2,A3,W0,W1,PW) do{ MF; sacc+=A0; sacc+=A1; sacc+=A2; sacc+=A3; PIN(sacc); W0; W1; PIN(PW); SBAR(); }while(0)
  #define EX(v) __builtin_amdgcn_exp2f(v)
  #define GAPB(MF,X,B) do{ MF; X[B]=EX(X[B]); X[B+1]=EX(X[B+1]); X[B+2]=EX(X[B+2]); X[B+3]=EX(X[B+3]); PIN(X); SBAR(); }while(0)
  #define VRD(i) do{ vlo[i]=vtr(vp_+(((i)>>2)*4096+((i)&3)*1024)); vhi[i]=vtr(vp_+(((i)>>2)*4096+((i)&3)*1024+512)); }while(0)
  #define KRD(G,j) do{ if((G)&&d0_on<MODE>(j)){ kload2(kf,kp0+sl_next,j); SBAR(); } }while(0)
  #define STEP(C0,C1,P0,P1,t,GK,GV,GL) do{ SBAR(); \
    const lds_cptr vp_=vp0+sl_prev; \
    VRD(0); SBAR(); float sacc=(P0[0]+P0[1]); \
    GAPA((qk_mf<MODE,0>(C0,kf[0],qr[0],negm)), P0[2],P0[3],P0[4],P0[5],     pw0[0]=PKW(P0,0), pw0[1]=PKW(P0,2), pw0); \
    VRD(4); SBAR(); GAPA((qk_mf<MODE,1>(C1,kf[1],qr[0],negm)), P0[6],P0[7],P0[8],P0[9],     pw0[2]=PKW(P0,4), pw0[3]=PKW(P0,6), pw0); \
    VRD(1); SBAR(); GAPA((qk_mf<MODE,2>(C0,kf[2],qr[1],negm)),   P0[10],P0[11],P0[12],P0[13], pw1[0]=PKW(P0,8), pw1[1]=PKW(P0,10), pw1); \
    VRD(5); SBAR(); GAPA((qk_mf<MODE,3>(C1,kf[3],qr[1],negm)),   P0[14],P0[15],P1[0],P1[1],   pw1[2]=PKW(P0,12),pw1[3]=PKW(P0,14), pw1); \
    VRD(2); SBAR(); GAPA((qk_mf<MODE,4>(C0,kf[4],qr[2],negm)),   P1[2],P1[3],P1[4],P1[5],     pw2[0]=PKW(P1,0), pw2[1]=PKW(P1,2), pw2); \
    VRD(6); SBAR(); GAPA((qk_mf<MODE,5>(C1,kf[5],qr[2],negm)),   P1[6],P1[7],P1[8],P1[9],     pw2[2]=PKW(P1,4), pw2[3]=PKW(P1,6), pw2); \
    VRD(3); SBAR(); GAPA((qk_mf<MODE,6>(C0,kf[6],qr[3],negm)),   P1[10],P1[11],P1[12],P1[13], pw3[0]=PKW(P1,8), pw3[1]=PKW(P1,10), pw3); \
    VRD(7); SBAR(); GAPA((qk_mf<MODE,7>(C1,kf[7],qr[3],negm)),   P1[14],P1[15],0.f,0.f,       pw3[2]=PKW(P1,12),pw3[3]=PKW(P1,14), pw3); \
    l_reg+=sacc; \
    if(GK){DMA_K((t)+3,sl_cur);} if(GV){DMA_V((t)+1,sl_next);} \
    CMASK(C0,C1,t); \
    { float a=MX3(C0[0],C0[1],C1[0]),b=MX3(C0[2],C0[3],C1[1]); a=MX3(a,C1[2],C1[3]); \
      _Pragma("unroll") for(int r=4;r<16;r+=4){a=MX3(a,C0[r],C0[r+1]);b=MX3(b,C0[r+2],C0[r+3]);a=MX3(a,C1[r],C1[r+1]);b=MX3(b,C1[r+2],C1[r+3]);} \
      float rm=__builtin_fmaxf(a,b); { auto rr=__builtin_amdgcn_permlane32_swap(__float_as_uint(rm),__float_as_uint(rm),false,false); rm=__builtin_fmaxf(__uint_as_float(rr[0]),__uint_as_float(rr[1])); } \
      resc=false; \
      if(__builtin_expect(__any(rm>(float)THRL),0)){ const float dl=__builtin_fmaxf(rm,0.f); mhat+=dl; \
        _Pragma("unroll") for(int r=0;r<16;++r){C0[r]-=dl;C1[r]-=dl;} \
        _Pragma("unroll") for(int r=0;r<16;++r)negm[r]=-mhat; asm volatile("":"+v"(negm)); \
        const float f=__builtin_amdgcn_exp2f(-dl); l_reg*=f; if(hi==0)wsf[r32]=f; resc=true; } } \
    SBAR(); \
    GAPB(o[0]=__builtin_amdgcn_mfma_f32_32x32x16_bf16(PAF(0),VFR(0),o[0],0,0,0), C0,0); \
    GAPB(o[1]=__builtin_amdgcn_mfma_f32_32x32x16_bf16(PAF(0),VFR(4),o[1],0,0,0), C0,4); \
    KRD(GL,0); GAPB(o[0]=__builtin_amdgcn_mfma_f32_32x32x16_bf16(PAF(1),VFR(1),o[0],0,0,0), C0,8); \
    KRD(GL,1); GAPB(o[1]=__builtin_amdgcn_mfma_f32_32x32x16_bf16(PAF(1),VFR(5),o[1],0,0,0), C0,12); \
    KRD(GL,2); GAPB(o[0]=__builtin_amdgcn_mfma_f32_32x32x16_bf16(PAF(2),VFR(2),o[0],0,0,0), C1,0); \
    KRD(GL,3); GAPB(o[1]=__builtin_amdgcn_mfma_f32_32x32x16_bf16(PAF(2),VFR(6),o[1],0,0,0), C1,4); \
    GAPB(o[0]=__builtin_amdgcn_mfma_f32_32x32x16_bf16(PAF(3),VFR(3),o[0],0,0,0), C1,8); \
    GAPB(o[1]=__builtin_amdgcn_mfma_f32_32x32x16_bf16(PAF(3),VFR(7),o[1],0,0,0), C1,12); \
    }while(0)
  int t=1;
  for(;t+5<NT;t+=2){
    STEP(pB0,pB1,pA0,pA1,t,true,true,true);     WAIT_BAR(2); RESC(); ROT();
    STEP(pA0,pA1,pB0,pB1,t+1,true,true,true);   WAIT_BAR(2); RESC(); ROT();
  }
  #define ENDW(tt) do{ if((tt)+3<NT){WAIT_BAR(2);} else if((tt)+2<NT){WAIT_BAR(1);} else {WAIT_BAR(0);} }while(0)
  for(;t+1<NT;t+=2){
    STEP(pB0,pB1,pA0,pA1,t,(t+3<NT),(t+1<NT),(t+1<NT));       ENDW(t);   RESC(); ROT();
    STEP(pA0,pA1,pB0,pB1,t+1,(t+4<NT),(t+2<NT),(t+2<NT));     ENDW(t+1); RESC(); ROT();
  }
  STEP(pB0,pB1,pA0,pA1,NT-1,false,false,false); RESC();
  { float sacc=pB0[0]+pB0[1]; _Pragma("unroll") for(int r=2;r<16;++r)sacc+=pB0[r]; _Pragma("unroll") for(int r=0;r<16;++r)sacc+=pB1[r]; l_reg+=sacc;
    pw0=(u32x4){PKW(pB0,0),PKW(pB0,2),PKW(pB0,4),PKW(pB0,6)};pw1=(u32x4){PKW(pB0,8),PKW(pB0,10),PKW(pB0,12),PKW(pB0,14)};pw2=(u32x4){PKW(pB1,0),PKW(pB1,2),PKW(pB1,4),PKW(pB1,6)};pw3=(u32x4){PKW(pB1,8),PKW(pB1,10),PKW(pB1,12),PKW(pB1,14)};
    SBAR(); pv(o,vb0+sl_cur,PAF(0),PAF(1),PAF(2),PAF(3)); }
  #undef PKW
  #undef PAF
  #undef VFR
  #undef PIN
  #undef MX3
  #undef GAPA
  #undef GAPB
  #undef EX
  #undef VRD
  #undef KRD
  #undef STEP
  #undef ENDW
  {auto rr=__builtin_amdgcn_permlane32_swap(__float_as_uint(l_reg),__float_as_uint(l_reg),false,false);l_reg=__uint_as_float(rr[0])+__uint_as_float(rr[1]);}
  if(hi==0)wsf[32+r32]=l_reg;asm volatile("s_waitcnt lgkmcnt(0)":::"memory");
  float rli[16];
  #pragma unroll
  for(int r=0;r<16;++r)rli[r]=__builtin_amdgcn_rcpf(wsf[32+crow(r,hi)]);
  bf16*Ow=(wid<4?Oa:Ob)+(long)((wid&3)*QBLK)*opitch;
  { bf16*stg=(bf16*)(shm+LDS_OST)+wid*2048;
    #pragma unroll
    for(int r=0;r<16;++r){const int orow=crow(r,hi);
      #pragma unroll
      for(int d0=0;d0<2;++d0)stg[orow*64+d0*32+r32]=(bf16)f2bf(o[d0][r]*rli[r]);}
    asm volatile("s_waitcnt lgkmcnt(0)":::"memory");
    if constexpr(MODE==0){
      #pragma unroll
      for(int i=0;i<4;++i){const int row=i*8+(lane>>3),ch=lane&7; const u32x4 v=*(const u32x4*)(stg+row*64+ch*8); ATTN_STORE16(Ow+(long)row*opitch+ch*8,v);}
    } else {
      asm volatile("s_barrier":::"memory");
      if constexpr(MODE==1){ const bf16*stg2=stg+4*2048; const int ch=lane&7; float sb[8];
        #pragma unroll
        for(int e=0;e<8;++e)sb[e]=subln[ch*8+e]*post;
        #pragma unroll
        for(int i=0;i<4;++i){const int row=i*8+(lane>>3); const u32x4 v1=*(const u32x4*)(stg+row*64+ch*8),v2=*(const u32x4*)(stg2+row*64+ch*8);
          float od[8]; float ss=0.f;
          #pragma unroll
          for(int e=0;e<4;++e){ od[2*e]=bflo(v1[e])-lam*bflo(v2[e]); od[2*e+1]=bfhi(v1[e])-lam*bfhi(v2[e]); ss+=od[2*e]*od[2*e]+od[2*e+1]*od[2*e+1]; }
          ss+=__shfl_xor(ss,1); ss+=__shfl_xor(ss,2); ss+=__shfl_xor(ss,4);
          const float rn=__builtin_amdgcn_rsqf(ss*(1.f/64.f)+1e-6f);
          u32x4 w; w[0]=pk2(od[0]*rn*sb[0],od[1]*rn*sb[1]); w[1]=pk2(od[2]*rn*sb[2],od[3]*rn*sb[3]); w[2]=pk2(od[4]*rn*sb[4],od[5]*rn*sb[5]); w[3]=pk2(od[6]*rn*sb[6],od[7]*rn*sb[7]);
          ATTN_STORE16(Ow+(long)row*opitch+ch*8,w);} }
    } }
  asm volatile("s_waitcnt lgkmcnt(0)\n\ts_barrier":::"memory");
  #undef DMA_K
  #undef DMA_V
  #undef CMASK
  #undef START
  #undef RESC
  #undef ROT
}
constexpr int ATTN_LDS_BYTES=LDS_BYTES;
#undef SBAR
#undef WAIT_BAR
}
#else
EMU_ATTN_BODY
#endif
#ifndef EMU
#define XB_TMO      128
#define XB_XCNT(j)  (256  + 64 * (j))
#define XB_XSUB(j)  (1280 + 64 * (j))
#define XB_XGEN(j)  (2304 + 64 * (j))
#define XB_TOP      3328
#define XB_TOPGEN   3392
#define XCD_BAR_WORDS 3456
#define XB_SPIN_CAP (1u << 18)

__device__ __forceinline__ unsigned xb_ld(unsigned* p)              { return __hip_atomic_load(p, __ATOMIC_RELAXED, __HIP_MEMORY_SCOPE_AGENT); }
__device__ __forceinline__ unsigned xb_add(unsigned* p, unsigned v) { return __hip_atomic_fetch_add(p, v, __ATOMIC_RELAXED, __HIP_MEMORY_SCOPE_AGENT); }
__device__ __forceinline__ unsigned xb_xcc_id() { return (unsigned)__builtin_amdgcn_s_getreg((3 << 11) | 20) & 0xFu; }
#define XB_SPIN(cond, bar) do { unsigned _sp = 0; while (cond) { __builtin_amdgcn_s_sleep(1); \
    if ((++_sp & 255u) == 0u) { if (xb_ld(&(bar)[XB_TMO])) break; if (_sp > XB_SPIN_CAP) { atomicAdd(&(bar)[XB_TMO], 1u); break; } } } } while (0)

struct XcdBarrier {
    unsigned* bar; unsigned x;
    volatile LAS unsigned* st;
};

__device__ __forceinline__ XcdBarrier xcd_barrier_post(unsigned* bar, volatile LAS unsigned* st) {
    XcdBarrier b; b.bar = bar; b.x = xb_xcc_id(); b.st = st;
    if (threadIdx.x == 0) (void)xb_add(&bar[XB_XCNT(b.x)], 1u);
    return b;
}
__device__ __forceinline__ void xcd_barrier_complete(unsigned* bar, unsigned x, unsigned& nloc, unsigned& nx) {
    const unsigned G = gridDim.x * gridDim.y * gridDim.z;
    unsigned sum, cnt, mine, sp = 0u;
    for (;;) {
        sum = 0u; cnt = 0u; mine = 0u;
#pragma unroll
        for (unsigned j = 0; j < 16; ++j) { const unsigned c = xb_ld(&bar[XB_XCNT(j)]); sum += c; cnt += (c > 0u) ? 1u : 0u; mine = (j == x) ? c : mine; }
        if (sum == G) break;
        __builtin_amdgcn_s_sleep(1);
        if ((++sp & 255u) == 0u) { if (xb_ld(&bar[XB_TMO])) break; if (sp > XB_SPIN_CAP) { atomicAdd(&bar[XB_TMO], 1u); break; } }
    }
    nloc = mine > 0u ? mine : 1u; nx = cnt > 0u ? cnt : 1u;
}

__device__ __forceinline__ void xcd_barrier(const XcdBarrier& b) {
    asm volatile("s_waitcnt vmcnt(0)" ::: "memory");
    __syncthreads();
    if (threadIdx.x == 0) {
        unsigned* bar = b.bar;
        __builtin_amdgcn_s_waitcnt(0);
        unsigned nloc = b.st[0], nx = b.st[1];
        if (nloc == 0u) { xcd_barrier_complete(bar, b.x, nloc, nx); b.st[0] = nloc; b.st[1] = nx; }
        const unsigned old = xb_add(&bar[XB_XSUB(b.x)], 1u);
        const unsigned gen = old / nloc;
        if (old + 1u == (gen + 1u) * nloc) {
            __builtin_amdgcn_fence(__ATOMIC_RELEASE, "agent");
            asm volatile("s_waitcnt vmcnt(0)" ::: "memory");
            const unsigned og = xb_add(&bar[XB_TOP], 1u);
            const unsigned tg = og / nx;
            if (og + 1u == (tg + 1u) * nx) xb_add(&bar[XB_TOPGEN], 1u);
            else XB_SPIN(xb_ld(&bar[XB_TOPGEN]) == tg, bar);
            __builtin_amdgcn_fence(__ATOMIC_ACQUIRE, "agent");
            xb_add(&bar[XB_XGEN(b.x)], 1u);
            asm volatile("s_waitcnt vmcnt(0)" ::: "memory");
        } else {
            XB_SPIN(xb_ld(&bar[XB_XGEN(b.x)]) == gen, bar);
            __builtin_amdgcn_fence(__ATOMIC_ACQUIRE, "agent");
            asm volatile("s_waitcnt vmcnt(0)" ::: "memory");
        }
    }
    __syncthreads();
}
#endif

constexpr int LDS_BYTES = 147456;
constexpr int MISC_OFF = 139264;
constexpr int PTR_OFF = MISC_OFF + 256;
struct Ctx {
    LAS unsigned char* lds;
    int tid, lane, wave, bid, G;
    float* out; unsigned long long wsi;
};
DEVI const float* inp_ptr(const Ctx& C, int i) {
    const unsigned long long v = ((const LAS unsigned long long*)(C.lds + PTR_OFF))[i];
    const unsigned lo = __builtin_amdgcn_readfirstlane((unsigned)v), hi = __builtin_amdgcn_readfirstlane((unsigned)(v >> 32));
    return (const float*)(const GAS float*)(((unsigned long long)hi << 32) | lo);
}
#define INP(i) inp_ptr(C, i)
#define WSP(T, off) ((T*)(GAS T*)(C.wsi + (unsigned long long)(off)))
DEVI int mod_row(int r) { return r < T_L ? r / SEQ : 8; }
DEVI const float* mod_vec(const Ctx& C, int layer, int mrow, int which) { return WSP(const float, WS_MOD) + ((size_t)(layer * 9 + mrow) * 6 + which) * D; }

DEVI void transpose_item(const float* W, int ldw, int k0, int n0, bf16* WT, int orow0, int Kp, LAS float* scr, int lane) {
    { const int kr = lane >> 3, c4 = (lane & 7) * 4; f32x4 v[8];
#pragma unroll
      for (int i = 0; i < 8; ++i) v[i] = *(const f32x4*)(W + (size_t)(k0 + 8 * i + kr) * ldw + n0 + c4);
#pragma unroll
      for (int i = 0; i < 8; ++i) { LAS float* d = scr + (8 * i + kr) * 33 + c4; d[0] = v[i].x; d[1] = v[i].y; d[2] = v[i].z; d[3] = v[i].w; } }
    LDS_WAIT();
    const int c = lane & 7;
#pragma unroll
    for (int j = 0; j < 4; ++j) { const int n = (lane >> 3) + 8 * j; const LAS float* s = scr + (8 * c) * 33 + n;
        v4u o; o.x = pk2(s[0 * 33], s[1 * 33]); o.y = pk2(s[2 * 33], s[3 * 33]); o.z = pk2(s[4 * 33], s[5 * 33]); o.w = pk2(s[6 * 33], s[7 * 33]);
        *(v4u*)(WT + (size_t)(orow0 + n) * Kp + k0 + 8 * c) = o; }
    LDS_WAIT();
}
DEVI void convert_layer_weights(const Ctx& C, int layer, int part) {
    LAS float* scr = (LAS float*)(C.lds + C.wave * 16384);
    const int gw = C.bid * 8 + C.wave, NGW = C.G * 8;
    constexpr int I_IN = 16 * (N_PROJ / 32), I_OUT = 16 * (D / 32), I_UP = NE * 16 * (2 * DE / 32), I_DN = NE * 16 * (D / 32), I_LAYER = I_IN + I_OUT + I_UP + I_DN;
    const int it_lo = (part == 1) ? I_IN + I_OUT : 0, it_hi = (part == 0) ? I_IN + I_OUT : I_LAYER;
    for (int it = it_lo + gw; it < it_hi; it += NGW) {
        int r = it;
        if (r < I_IN) { const int kb = r / (N_PROJ / 32), nb = r % (N_PROJ / 32);
            transpose_item(INP(8) + (size_t)layer * D * D_IN, D_IN, 64 * kb, 32 * nb, WSP(bf16, WS_WIN) + (size_t)layer * N_PROJ * D, 32 * nb, D, scr, C.lane); continue; }
        r -= I_IN;
        if (r < I_OUT) { const int kb = r / (D / 32), nb = r % (D / 32);
            transpose_item(INP(9) + (size_t)layer * D * D, D, 64 * kb, 32 * nb, WSP(bf16, WS_WOUT) + (size_t)layer * D * D, 32 * nb, D, scr, C.lane); continue; }
        r -= I_OUT;
        if (r < I_UP) { const int e = r / (16 * 64), q = r % (16 * 64), kb = q / 64, nb = q % 64; const int n0 = 32 * nb;
            const int orow = (n0 < DE) ? (n0 / 128) * 256 + (n0 % 128) : ((n0 - DE) / 128) * 256 + 128 + ((n0 - DE) % 128);
            transpose_item(INP(26) + ((size_t)layer * NE + e) * D * 2 * DE, 2 * DE, 64 * kb, n0, WSP(bf16, WS_WUP) + ((size_t)layer * NE + e) * 2 * DE * D, orow, D, scr, C.lane); continue; }
        r -= I_UP;
        { const int e = r / (16 * 32), q = r % (16 * 32), kb = q / 32, nb = q % 32;
            transpose_item(INP(28) + ((size_t)layer * NE + e) * DE * D, D, 64 * kb, 32 * nb, WSP(bf16, WS_WDN) + ((size_t)layer * NE + e) * D * DE, 32 * nb, DE, scr, C.lane); }
    }
}
DEVI void p0_prologue(const Ctx& C) {
    convert_layer_weights(C, 0, 0);
    {
      float* tab = WSP(float, WS_ROPE);
      for (int i = C.bid * 512 + C.tid; i < SEQ * 48; i += C.G * 512) { const int t = i / 48, j = i % 48; const float rp = (float)(t / GRID_W), cp = (float)(t % GRID_W); float c, s;
          if (j < 32) { const float ang = (j < 16 ? rp : cp) * __builtin_amdgcn_exp2f(-(float)(j & 15) * (13.287712379549449f / 16.f)); const float tt = __builtin_amdgcn_fractf(ang * 0.15915494309189535f); c = __builtin_amdgcn_cosf(tt); s = __builtin_amdgcn_sinf(tt);
              tab[(size_t)t * 32 + j] = c; tab[(size_t)SEQ * 32 + (size_t)t * 32 + j] = s; }
          else { const int i2 = j - 32; const float ang = (i2 < 8 ? rp : cp) * __builtin_amdgcn_exp2f(-(float)(i2 & 7) * (13.287712379549449f / 8.f)); const float tt = __builtin_amdgcn_fractf(ang * 0.15915494309189535f); c = __builtin_amdgcn_cosf(tt); s = __builtin_amdgcn_sinf(tt);
              tab[(size_t)SEQ * 64 + (size_t)t * 16 + i2] = c; tab[(size_t)SEQ * 80 + (size_t)t * 16 + i2] = s; } } }
    __syncthreads();
    LAS float* sc = (LAS float*)C.lds;
    LAS float* red = sc + 9 * D;
    for (int i = C.tid; i < 9 * D; i += 512) { const int r = i / D, k = i % D; float v = 0.f; if (r < NB) v = INP(1)[r * D + k]; else if (r == 8) v = INP(3)[k]; sc[i] = siluf_(v); }
    __syncthreads();
    for (int u = C.bid; u < DEPTH * 96; u += C.G) {
        const int layer = u / 96, n0 = (u % 96) * 64, col = C.tid & 63, kg = C.tid >> 6;
        const float* w = INP(4) + (size_t)layer * D * 6 * D + n0 + col;
        float acc[9];
#pragma unroll
        for (int r = 0; r < 9; ++r) acc[r] = 0.f;
#pragma unroll 8
        for (int k = kg * 128; k < kg * 128 + 128; ++k) { const float wv = w[(size_t)k * 6 * D];
#pragma unroll
            for (int r = 0; r < 9; ++r) acc[r] += sc[r * D + k] * wv; }
#pragma unroll
        for (int r = 0; r < 9; ++r) red[(kg * 9 + r) * 64 + col] = acc[r];
        __syncthreads();
        for (int i = C.tid; i < 9 * 64; i += 512) { const int r = i >> 6, c2 = i & 63; float s = 0.f;
#pragma unroll
            for (int g = 0; g < 8; ++g) s += red[(g * 9 + r) * 64 + c2];
            WSP(float, WS_MOD)[((size_t)(layer * 9 + r)) * 6 * D + n0 + c2] = s + INP(5)[(size_t)layer * 6 * D + n0 + c2]; }
        __syncthreads();
    }
}

DEVI void ph_norm_mix(const Ctx& C, int layer) {
    const bool fin = (layer == DEPTH);
    const int nrows = fin ? T_L : T_ALL;
    if (layer == 0) {
        for (int it = C.bid * 8 + C.wave; it < DEPTH * 9 * NE; it += C.G * 8) {
            const int e = it % NE, m = (it / NE) % 9, l = it / (NE * 9);
            const float* gn = INP(7) + (size_t)l * D; const float* sh = mod_vec(C, l, m, 3); const float* scl = mod_vec(C, l, m, 4); const float* rw = INP(24) + (size_t)l * D * NE + e;
            float* dst = WSP(float, WS_RWP) + (size_t)it * D; float bsum = 0.f;
#pragma unroll 4
            for (int j = 0; j < 16; ++j) { const int k = 64 * j + C.lane; const float w = rw[(size_t)k * NE]; const float tv = gn[k] * (1.f + scl[k]) * w; const unsigned hb = f2bf(tv);
                ((unsigned short*)dst)[k] = (unsigned short)hb; ((unsigned short*)dst)[D + k] = (unsigned short)f2bf(tv - bflo(hb)); bsum += sh[k] * w; }
            bsum = wave_sum(bsum); if (C.lane == 0) WSP(float, WS_RBP)[it] = bsum + INP(25)[l * NE + e];
        }
    }
    LAS float* w16 = (LAS float*)C.lds;
    if (!fin) { for (int i = C.tid; i < 16 * D; i += 512) { const int k = i >> 4, j = i & 15; w16[j * D + k] = INP(8)[((size_t)layer * D + k) * D_IN + N_PROJ + j]; } }
    __syncthreads();
    const float* gmain = fin ? INP(30) : INP(6) + (size_t)layer * D;
    const int rstep = C.G * 8;
    int s4[2][4]; float g4[2][4];
#define NM_SLOTS(dst_s, dst_g, rbase) do { _Pragma("unroll") for (int u2 = 0; u2 < 2; ++u2) { const int rr_ = (rbase) + u2 * rstep; const int rc_ = rr_ < nrows ? rr_ : 0; \
        const int* sl_ = WSP(const int, WS_SLOT) + (size_t)rc_ * 4; const float* gl_ = WSP(const float, WS_TOKG) + (size_t)rc_ * 4; \
        _Pragma("unroll") for (int k = 0; k < 4; ++k) { dst_s[u2][k] = sl_[k]; dst_g[u2][k] = gl_[k]; } } } while (0)
    if (layer != 0) NM_SLOTS(s4, g4, C.bid * 8 + C.wave);
#define NMC(j) ((((j) & 2) ? 512 : 0) + 8 * C.lane + 4 * ((j) & 1))
    for (int ra = C.bid * 8 + C.wave; ra < nrows; ra += 2 * rstep) {
        f32x4 v[2][4]; int mrow[2]; bool live[2];
        int s4n[2][4]; float g4n[2][4];
        if (layer != 0) NM_SLOTS(s4n, g4n, ra + 2 * rstep);
#pragma unroll
        for (int u2 = 0; u2 < 2; ++u2) { const int r = ra + u2 * rstep; live[u2] = r < nrows; const int rc = live[u2] ? r : 0; mrow[u2] = mod_row(rc);
            if (layer == 0) { const float* xr = (rc < T_L) ? INP(0) + (size_t)rc * D : INP(2) + (size_t)(rc - T_L) * D;
#pragma unroll
                for (int j = 0; j < 4; ++j) v[u2][j] = *(const f32x4*)(xr + NMC(j));
            } else {
                const bf16* xr = WSP(const bf16, WS_XRES) + (size_t)rc * D; const float* g2 = mod_vec(C, layer - 1, mrow[u2], 5);
                f32x4 xv[4]; { const v4u xa = *(const v4u*)(xr + 8 * C.lane), xb = *(const v4u*)(xr + 512 + 8 * C.lane);
                    xv[0] = (f32x4){bflo(xa.x), bfhi(xa.x), bflo(xa.y), bfhi(xa.y)}; xv[1] = (f32x4){bflo(xa.z), bfhi(xa.z), bflo(xa.w), bfhi(xa.w)};
                    xv[2] = (f32x4){bflo(xb.x), bfhi(xb.x), bflo(xb.y), bfhi(xb.y)}; xv[3] = (f32x4){bflo(xb.z), bfhi(xb.z), bflo(xb.w), bfhi(xb.w)}; }
                f32x4 a[4];
#pragma unroll
                for (int j = 0; j < 4; ++j) a[j] = (f32x4){0.f, 0.f, 0.f, 0.f};
#pragma unroll
                for (int k = 0; k < 4; ++k) { const unsigned char* yr = WSP(const unsigned char, WS_YS) + (size_t)s4[u2][k] * D; const v2u ya = *(const v2u*)(yr + 8 * C.lane), yb = *(const v2u*)(yr + 512 + 8 * C.lane); const float gk = g4[u2][k];
                    const f32x2 p0 = __builtin_amdgcn_cvt_pk_f32_fp8((int)ya.x, false), p1 = __builtin_amdgcn_cvt_pk_f32_fp8((int)ya.x, true), p2 = __builtin_amdgcn_cvt_pk_f32_fp8((int)ya.y, false), p3 = __builtin_amdgcn_cvt_pk_f32_fp8((int)ya.y, true);
                    const f32x2 q0 = __builtin_amdgcn_cvt_pk_f32_fp8((int)yb.x, false), q1 = __builtin_amdgcn_cvt_pk_f32_fp8((int)yb.x, true), q2 = __builtin_amdgcn_cvt_pk_f32_fp8((int)yb.y, false), q3 = __builtin_amdgcn_cvt_pk_f32_fp8((int)yb.y, true);
                    a[0] += (f32x4){p0.x, p0.y, p1.x, p1.y} * gk; a[1] += (f32x4){p2.x, p2.y, p3.x, p3.y} * gk;
                    a[2] += (f32x4){q0.x, q0.y, q1.x, q1.y} * gk; a[3] += (f32x4){q2.x, q2.y, q3.x, q3.y} * gk; }
#pragma unroll
                for (int j = 0; j < 4; ++j) v[u2][j] = xv[j] + *(const f32x4*)(g2 + NMC(j)) * a[j];
            } }
        float rinv[2];
#pragma unroll
        for (int u2 = 0; u2 < 2; ++u2) { float ss = 0.f;
#pragma unroll
            for (int j = 0; j < 4; ++j) ss += (v[u2][j].x * v[u2][j].x + v[u2][j].y * v[u2][j].y) + (v[u2][j].z * v[u2][j].z + v[u2][j].w * v[u2][j].w);
            rinv[u2] = __builtin_amdgcn_rsqf(wave_sum(ss) * (1.f / D) + NORM_EPS); }
#pragma unroll
        for (int u2 = 0; u2 < 2; ++u2) { const int r = ra + u2 * rstep; if (!live[u2]) continue;
            if (fin) {
#pragma unroll
                for (int j = 0; j < 4; ++j) *(f32x4*)(C.out + (size_t)r * D + NMC(j)) = v[u2][j] * rinv[u2] * *(const f32x4*)(gmain + NMC(j));
                continue; }
            if (layer != 0) { bf16* xw = WSP(bf16, WS_XRES) + (size_t)r * D;
                *(v4u*)(xw + 8 * C.lane) = (v4u){pk2(v[u2][0].x, v[u2][0].y), pk2(v[u2][0].z, v[u2][0].w), pk2(v[u2][1].x, v[u2][1].y), pk2(v[u2][1].z, v[u2][1].w)};
                *(v4u*)(xw + 512 + 8 * C.lane) = (v4u){pk2(v[u2][2].x, v[u2][2].y), pk2(v[u2][2].z, v[u2][2].w), pk2(v[u2][3].x, v[u2][3].y), pk2(v[u2][3].z, v[u2][3].w)}; }
            const float* sh = mod_vec(C, layer, mrow[u2], 0); const float* scl = mod_vec(C, layer, mrow[u2], 1);
            f32x4 hv4[4]; float mine = 0.f;
#pragma unroll
            for (int j = 0; j < 4; ++j) hv4[j] = v[u2][j] * rinv[u2] * *(const f32x4*)(gmain + NMC(j)) * (*(const f32x4*)(scl + NMC(j)) + 1.0f) + *(const f32x4*)(sh + NMC(j));
            { bf16* hr = WSP(bf16, WS_H) + (size_t)r * D;
              *(v4u*)(hr + 8 * C.lane) = (v4u){pk2(hv4[0].x, hv4[0].y), pk2(hv4[0].z, hv4[0].w), pk2(hv4[1].x, hv4[1].y), pk2(hv4[1].z, hv4[1].w)};
              *(v4u*)(hr + 512 + 8 * C.lane) = (v4u){pk2(hv4[2].x, hv4[2].y), pk2(hv4[2].z, hv4[2].w), pk2(hv4[3].x, hv4[3].y), pk2(hv4[3].z, hv4[3].w)}; }
#pragma unroll 2
            for (int i = 0; i < 16; ++i) { float pp = 0.f;
#pragma unroll
                for (int j = 0; j < 4; ++j) { const f32x4 w = *(const LAS f32x4*)(w16 + i * D + NMC(j)); pp += (hv4[j].x * w.x + hv4[j].y * w.y) + (hv4[j].z * w.z + hv4[j].w * w.w); }
                pp = wave_sum(pp); if (C.lane == i) mine = pp; }
            if (C.lane < 16) WSP(float, WS_BA)[(size_t)r * 16 + C.lane] = mine; }
        if (layer != 0) {
#pragma unroll
            for (int u2 = 0; u2 < 2; ++u2)
#pragma unroll
                for (int k = 0; k < 4; ++k) { s4[u2][k] = s4n[u2][k]; g4[u2][k] = g4n[u2][k]; } }
    }
#undef NMC
#undef NM_SLOTS
}

DEVI void u8f(const v4u& w, float (&x)[8]) { x[0] = bflo(w.x); x[1] = bfhi(w.x); x[2] = bflo(w.y); x[3] = bfhi(w.y); x[4] = bflo(w.z); x[5] = bfhi(w.z); x[6] = bflo(w.w); x[7] = bfhi(w.w); }
DEVI v4u f8u(const float (&x)[8]) { return (v4u){pk2(x[0], x[1]), pk2(x[2], x[3]), pk2(x[4], x[5]), pk2(x[6], x[7])}; }
DEVI void ph_attn_prep(const Ctx& C, int layer) {
    const bf16* proj = WSP(const bf16, WS_PROJ);
    bf16* QL = WSP(bf16, WS_QL); bf16* QC = WSP(bf16, WS_QC); bf16* KB = WSP(bf16, WS_K); bf16* VB = WSP(bf16, WS_V);
    const float* tab = WSP(const float, WS_ROPE);
    const int lane = C.lane, l7 = lane & 7, d0 = 8 * l7;
    constexpr float C2A = 0.125f * 1.4426950408889634f, C2D = 0.17677669529663687f * 1.4426950408889634f;
    float gA[8];
    { const float* gn = (lane < 32 ? INP(10) : INP(11)) + layer * 64 + d0;
#pragma unroll
      for (int e = 0; e < 8; ++e) gA[e] = gn[e]; }
    const bool lowA = d0 < 32; const int jA = d0 & 31;
    const int i0 = 8 * (lane & 3); const bool lowD = i0 < 16; const int iD = i0 & 15, mp = l7 >> 2;
    constexpr int RU = 2; const int rstep = C.G * 8;
    for (int rbase = C.bid * 8 + C.wave; rbase < T_ALL; rbase += RU * rstep) {
        v4u pa[RU], pc1[RU], pc2[RU]; f32x4 ca[RU][2], sa[RU][2], cd[RU][2], sd[RU][2];
#pragma unroll
        for (int u2 = 0; u2 < RU; ++u2) { const int rr = rbase + u2 * rstep; const int r = rr < T_ALL ? rr : rbase; const bf16* pr = proj + (size_t)r * N_PROJ;
            pa[u2] = *(const v4u*)(pr + 8 * lane); pc1[u2] = *(const v4u*)(pr + C_CQ + 8 * lane); pc2[u2] = *(const v4u*)(pr + C_CV + 8 * (lane & 31));
            const int t = r < T_L ? r % SEQ : 0;
            ca[u2][0] = *(const f32x4*)(tab + (size_t)t * 32 + jA); ca[u2][1] = *(const f32x4*)(tab + (size_t)t * 32 + jA + 4);
            sa[u2][0] = *(const f32x4*)(tab + (size_t)SEQ * 32 + (size_t)t * 32 + jA); sa[u2][1] = *(const f32x4*)(tab + (size_t)SEQ * 32 + (size_t)t * 32 + jA + 4);
            cd[u2][0] = *(const f32x4*)(tab + (size_t)SEQ * 64 + (size_t)t * 16 + iD); cd[u2][1] = *(const f32x4*)(tab + (size_t)SEQ * 64 + (size_t)t * 16 + iD + 4);
            sd[u2][0] = *(const f32x4*)(tab + (size_t)SEQ * 80 + (size_t)t * 16 + iD); sd[u2][1] = *(const f32x4*)(tab + (size_t)SEQ * 80 + (size_t)t * 16 + iD + 4); }
#pragma unroll
        for (int u2 = 0; u2 < RU; ++u2) { const int r = rbase + u2 * rstep; if (r >= T_ALL) continue;
            const bool lat = r < T_L; const int b = lat ? r / SEQ : (r - T_L) / LC; const int t = lat ? r % SEQ : (r - T_L) % LC; const int pos = lat ? t : SEQ + t;
            { float x[8]; u8f(pa[u2], x);
              if (lane < 48) { float ss = 0.f;
#pragma unroll
                  for (int e = 0; e < 8; ++e) ss += x[e] * x[e];
                  const float rinv = __builtin_amdgcn_rsqf(group_sum<8>(ss) * (1.f / 64.f) + NORM_EPS);
#pragma unroll
                  for (int e = 0; e < 8; ++e) x[e] *= rinv * gA[e]; }
              float o[8];
#pragma unroll
              for (int e = 0; e < 8; ++e) { const float pe = __shfl_xor(x[e], 4); const float c = lat ? ca[u2][e >> 2][e & 3] : 1.f, s = lat ? sa[u2][e >> 2][e & 3] : 0.f;
                  o[e] = lowA ? x[e] * c - pe * s : pe * s + x[e] * c; }
              if (lane < 32) { const int hq = lane >> 3;
#pragma unroll
                  for (int e = 0; e < 8; ++e) o[e] *= C2A;
                  bf16* q = lat ? QL + ((size_t)(b * 12 + hq) * SEQ + t) * 64 : QC + ((size_t)(b * 12 + hq) * LC + t) * 64; *(v4u*)(q + d0) = f8u(o); }
              else if (lane < 48) { const int kvh = (lane - 32) >> 3; *(v4u*)(KB + ((size_t)(b * 6 + kvh) * NKEY + pos) * 64 + d0) = f8u(o); }
              else { const int kvh = (lane - 48) >> 3; *(v4u*)(VB + ((size_t)(b * 6 + kvh) * NKEY + pos) * 64 + d0) = pa[u2]; } }
            { float x[8]; u8f(pc1[u2], x); float o[8];
#pragma unroll
              for (int e = 0; e < 8; ++e) { const float pe = __shfl_xor(x[e], 2); const float c = lat ? cd[u2][e >> 2][e & 3] : 1.f, s = lat ? sd[u2][e >> 2][e & 3] : 0.f;
                  o[e] = lowD ? x[e] * c - pe * s : pe * s + x[e] * c; }
              const int hc = (lane & 31) >> 3;
              if (lane < 32) { const int vh = 4 + 2 * hc + mp;
#pragma unroll
                  for (int e = 0; e < 8; ++e) o[e] *= C2D;
                  bf16* q = lat ? QL + ((size_t)(b * 12 + vh) * SEQ + t) * 64 : QC + ((size_t)(b * 12 + vh) * LC + t) * 64;
                  *(v4u*)(q + mp * 32 + i0) = f8u(o); *(v4u*)(q + (1 - mp) * 32 + i0) = (v4u){0u, 0u, 0u, 0u}; }
              else { *(v4u*)(KB + ((size_t)(b * 6 + 2 + hc) * NKEY + pos) * 64 + d0) = f8u(o); } }
            if (lane < 32) { const int hv = lane >> 3; *(v4u*)(VB + ((size_t)(b * 6 + 2 + hv) * NKEY + pos) * 64 + d0) = pc2[u2]; }
        }
    }
}

DEVI void ph_gmlp(const Ctx& C, int layer, int ntok) {
    constexpr int VP = 136, SP = 68;
    LAS bf16* vnT = (LAS bf16*)C.lds;
    LAS float* rinv = (LAS float*)(vnT + 64 * VP);
    LAS float* spT = rinv + 128;
    const bf16* proj = WSP(const bf16, WS_PROJ); bf16* mix = WSP(bf16, WS_MIX);
    const float* gvn = INP(12) + layer * 256;
    const int tid0 = C.tid;
    constexpr int NSCAN = NB * 16; const int total = (ntok / 128) * 4; const bool split = C.G > NSCAN && total > 2 * NSCAN;
    const int ufirst = !split ? C.bid : (C.bid < NSCAN ? C.bid : 2 * NSCAN + (C.bid - NSCAN)), ustride = !split ? C.G : (C.bid < NSCAN ? NSCAN : C.G - NSCAN), uend = (split && C.bid < NSCAN) ? 2 * NSCAN : total;
    for (int u = ufirst; u < uend; u += ustride) {
        int tid = tid0; LAUNDER_V(tid);
        const int chunk = u >> 2, g = u & 3; const int row0 = chunk * 128;
        const int lane = tid & 63, wv = __builtin_amdgcn_readfirstlane(tid >> 6), l15 = lane & 15, q = lane >> 4;
        bf16x8 afr[4];
        { const float* wsr = INP(13) + ((size_t)layer * 4 + g) * 128 * 128 + (size_t)(16 * wv + l15) * 128 + 8 * q;
#pragma unroll
          for (int kk = 0; kk < 4; ++kk) { const f32x4 a0 = *(const f32x4*)(wsr + 32 * kk), a1 = *(const f32x4*)(wsr + 32 * kk + 4);
              const v4u ap = {pk2(a0.x, a0.y), pk2(a0.z, a0.w), pk2(a1.x, a1.y), pk2(a1.z, a1.w)}; afr[kk] = __builtin_bit_cast(bf16x8, ap); } }
        { const int tok = tid >> 2, qd = tid & 3; const bf16* p = proj + (size_t)(row0 + tok) * N_PROJ + C_BV + qd * 64; float ss = 0.f;
#pragma unroll
          for (int c8 = 0; c8 < 8; ++c8) { const v4u w = *(const v4u*)(p + c8 * 8);
              const float a0 = gelu_tanh(bflo(w.x)), a1 = gelu_tanh(bfhi(w.x)), a2 = gelu_tanh(bflo(w.y)), a3 = gelu_tanh(bfhi(w.y)), a4 = gelu_tanh(bflo(w.z)), a5 = gelu_tanh(bfhi(w.z)), a6 = gelu_tanh(bflo(w.w)), a7 = gelu_tanh(bfhi(w.w));
              ss += (a0 * a0 + a1 * a1) + (a2 * a2 + a3 * a3) + (a4 * a4 + a5 * a5) + (a6 * a6 + a7 * a7); }
          ss = group_sum<4>(ss); if (qd == 0) rinv[tok] = __builtin_amdgcn_rsqf(ss * (1.f / 256.f) + NORM_EPS); }
        __syncthreads();
        { const int tok = tid >> 2, c0 = (tid & 3) * 16; const bf16* p = proj + (size_t)(row0 + tok) * N_PROJ + C_BV + g * 64 + c0; const float ri = rinv[tok];
          const v4u w0 = *(const v4u*)p, w1 = *(const v4u*)(p + 8); const unsigned ww[8] = {w0.x, w0.y, w0.z, w0.w, w1.x, w1.y, w1.z, w1.w};
#pragma unroll
          for (int c = 0; c < 16; ++c) { const float x = (c & 1) ? bfhi(ww[c >> 1]) : bflo(ww[c >> 1]); vnT[(c0 + c) * VP + tok] = (bf16)f2bf(gelu_tanh(x) * ri * gvn[g * 64 + c0 + c]); } }
        __syncthreads();
        { f32x4 acc[4];
#pragma unroll
          for (int n = 0; n < 4; ++n) acc[n] = (f32x4){0.f, 0.f, 0.f, 0.f};
#pragma unroll
          for (int kk = 0; kk < 4; ++kk)
#pragma unroll
              for (int n = 0; n < 4; ++n) acc[n] = __builtin_amdgcn_mfma_f32_16x16x32_bf16(afr[kk], *(const LAS bf16x8*)(vnT + (16 * n + l15) * VP + 32 * kk + 8 * q), acc[n], 0, 0, 0);
          const float* bs = INP(14) + ((size_t)layer * 4 + g) * 128;
#pragma unroll
          for (int r = 0; r < 4; ++r) { const int tok = 16 * wv + 4 * q + r; const float bb = bs[tok];
#pragma unroll
              for (int n = 0; n < 4; ++n) spT[tok * SP + 16 * n + l15] = acc[n][r] + bb; } }
        __syncthreads();
        { const int tok = tid >> 2, c0 = (tid & 3) * 16; const size_t rowp = (size_t)(row0 + tok);
          const bf16* pu = proj + rowp * N_PROJ + C_BU + g * 64 + c0; const v4u u0 = *(const v4u*)pu, u1 = *(const v4u*)(pu + 8); const unsigned uw[8] = {u0.x, u0.y, u0.z, u0.w, u1.x, u1.y, u1.z, u1.w};
          float o[16];
#pragma unroll
          for (int c4 = 0; c4 < 4; ++c4) { const f32x4 sp = *(const LAS f32x4*)(spT + tok * SP + c0 + 4 * c4);
              o[4 * c4 + 0] = gelu_tanh(bflo(uw[2 * c4])) * sp.x; o[4 * c4 + 1] = gelu_tanh(bfhi(uw[2 * c4])) * sp.y; o[4 * c4 + 2] = gelu_tanh(bflo(uw[2 * c4 + 1])) * sp.z; o[4 * c4 + 3] = gelu_tanh(bfhi(uw[2 * c4 + 1])) * sp.w; }
          bf16* po = mix + rowp * D + 256 + g * 64 + c0;
          *(v4u*)po = (v4u){pk2(o[0], o[1]), pk2(o[2], o[3]), pk2(o[4], o[5]), pk2(o[6], o[7])}; *(v4u*)(po + 8) = (v4u){pk2(o[8], o[9]), pk2(o[10], o[11]), pk2(o[12], o[13]), pk2(o[14], o[15])}; }
        __syncthreads();
    }
}

DEVI int dn_kmap(int kk, int q, int j) { return 16 * (2 * kk + (j >> 2)) + 4 * q + (j & 3); }
DEVI size_t dn_unit_off(int b, int dir, int h, int sc) { return ((size_t)((b * 2 + dir) * 4 + h) * NCH + sc) * DN_UNIT_BYTES; }
constexpr int DP = 68, XP = 132, HP = 72;
DEVI f32x4 mfma16(bf16x8 a, bf16x8 b, f32x4 c) { return __builtin_amdgcn_mfma_f32_16x16x32_bf16(a, b, c, 0, 0, 0); }
#ifndef D1REP
#define D1REP 0
#endif
#define DN_BAR() asm volatile("s_waitcnt lgkmcnt(0)\n\ts_barrier" ::: "memory")
DEVI void ph_dn_chunk(const Ctx& C, int layer) {
    LAS bf16* kN = (LAS bf16*)C.lds;
    LAS bf16* qN = kN + 64 * HP;
    LAS bf16* kT = qN + 64 * HP;
    LAS bf16* QKd = kT + 64 * HP;
    LAS bf16* RT = QKd + 64 * HP;
    LAS bf16* XT = RT;
    LAS bf16* TiB = RT + 128 * HP;
    LAS float* Am = (LAS float*)(TiB + 64 * HP);
    LAS float* TI = Am + 64 * DP;
    LAS bf16* XdT = (LAS bf16*)Am;
    LAS float* TMP = TI + 64 * DP;
    LAS float* vec = TMP + 1280;
    LAS float* betav = vec; LAS float* cum = vec + 64; LAS float* ecum = vec + 128; LAS float* dvec = vec + 192; LAS float* bec = vec + 256;
    LAS float* cwl = vec + 320;
    LAS float* gpar = cwl + 2304;
    static_assert(128 * HP * 2 <= 2 * 64 * DP * 4 && (4 * 64 * HP + 128 * HP + 64 * HP) * 2 + (2 * 64 * DP + 1280 + 320 + 2304 + 16) * 4 <= MISC_OFF, "D1 LDS");
    const bf16* proj = WSP(const bf16, WS_PROJ); const float* BA = WSP(const float, WS_BA);
    { const float* cwg = INP(20) + (size_t)layer * 3 * 768; for (int i = C.tid; i < 2304; i += 512) cwl[i] = cwg[i];
      if (C.tid < 8) gpar[C.tid] = -fast_exp(INP(21)[layer * 8 + C.tid]); else if (C.tid < 16) gpar[C.tid] = INP(22)[layer * 8 + C.tid - 8]; }
    __syncthreads();
    const LAS float* cw = cwl;
    const int tid0 = C.tid;
#define FRESH_TID() int tid = tid0; LAUNDER_V(tid)
#define DN_DECODE(u_) const int tcx = (u_) % NCH, h = ((u_) / NCH) & 3, dir = ((u_) / (NCH * 4)) & 1, b = (u_) / (NCH * 8); \
        const bool isc = tcx < NCH_C; const int tc = isc ? tcx : tcx - NCH_C; const int nch = isc ? NCH_C : NCH_L; const int len = nch * 64; \
        const int row_seq0 = isc ? T_L + b * LC : b * SEQ
    v4u rw[3][3]; float rb0 = 0.f, rb1 = 0.f, rb2 = 0.f;
#define DN_LOAD(u_) do { if ((u_) < NB * 2 * 4 * NCH) { DN_DECODE(u_); int t_ = tid0; LAUNDER_V(t_); const int c = t_ >> 3, d0 = (t_ & 7) * 8; const int tl = tc * 64 + (dir ? 63 - c : c); const size_t r = (size_t)row_seq0 + tl; \
        const bool hp = tl > 0, hn = tl < len - 1; \
        _Pragma("unroll") for (int w3 = 0; w3 < 3; ++w3) { const bf16* p = proj + r * N_PROJ + C_DQKV + w3 * 256 + h * 64 + d0; \
            rw[w3][1] = *(const v4u*)p; rw[w3][0] = (v4u){0u, 0u, 0u, 0u}; rw[w3][2] = (v4u){0u, 0u, 0u, 0u}; if (hp) rw[w3][0] = *(const v4u*)(p - N_PROJ); if (hn) rw[w3][2] = *(const v4u*)(p + N_PROJ); } \
        rb0 = BA[r * 16 + dir * 4 + h]; \
        if (t_ < 64) { const int tl2 = tc * 64 + (dir ? 63 - t_ : t_); const float* ba = BA + ((size_t)row_seq0 + tl2) * 16; rb1 = ba[dir * 4 + h]; rb2 = ba[8 + dir * 4 + h]; } } } while (0)
    DN_LOAD(C.bid);
    for (int u = C.bid; u < NB * 2 * 4 * NCH; u += C.G) {
        DN_DECODE(u);
        const int sc = (isc ? 0 : NCH_C) + (dir ? nch - 1 - tc : tc);
        { FRESH_TID(); const int c = tid >> 3, part = tid & 7, d0 = part * 8;
          float y[3][8];
#pragma unroll
          for (int w3 = 0; w3 < 3; ++w3) { const int col = w3 * 256 + h * 64 + d0;
              const v4u xc = rw[w3][1], xp = rw[w3][0], xn = rw[w3][2];
              const unsigned xcw[4] = {xc.x, xc.y, xc.z, xc.w}, xpw[4] = {xp.x, xp.y, xp.z, xp.w}, xnw[4] = {xn.x, xn.y, xn.z, xn.w};
#pragma unroll
              for (int e = 0; e < 8; ++e) { const float a = (e & 1) ? bfhi(xpw[e >> 1]) : bflo(xpw[e >> 1]), m = (e & 1) ? bfhi(xcw[e >> 1]) : bflo(xcw[e >> 1]), n = (e & 1) ? bfhi(xnw[e >> 1]) : bflo(xnw[e >> 1]);
                  y[w3][e] = siluf_(cw[col + e] * a + cw[768 + col + e] * m + cw[1536 + col + e] * n); } }
          const float ba_b = rb0, ba_b2 = rb1, ba_a2 = rb2;
          DN_LOAD(u + C.G);
          float sq = 0.f, sk = 0.f;
#pragma unroll
          for (int e = 0; e < 8; ++e) { sq += y[0][e] * y[0][e]; sk += y[1][e] * y[1][e]; }
          sq = group_sum<8>(sq); sk = group_sum<8>(sk);
          const float rq = __builtin_amdgcn_rsqf(sq + NORM_EPS) * 0.125f, rk = __builtin_amdgcn_rsqf(sk + NORM_EPS);
          const float betac = sigmoidf_(ba_b);
#pragma unroll
          for (int e = 0; e < 8; ++e) { y[0][e] *= rq; y[1][e] *= rk; kT[(d0 + e) * HP + c] = (bf16)f2bf(y[1][e]); RT[(d0 + e) * HP + c] = (bf16)f2bf(betac * y[2][e]); }
          *(LAS v4u*)(qN + c * HP + d0) = (v4u){pk2(y[0][0], y[0][1]), pk2(y[0][2], y[0][3]), pk2(y[0][4], y[0][5]), pk2(y[0][6], y[0][7])};
          *(LAS v4u*)(kN + c * HP + d0) = (v4u){pk2(y[1][0], y[1][1]), pk2(y[1][2], y[1][3]), pk2(y[1][4], y[1][5]), pk2(y[1][6], y[1][7])};
          *(LAS v4u*)(QKd + c * HP + d0) = (v4u){0u, 0u, 0u, 0u};
          { LAS f32x4* z = (LAS f32x4*)TI; z[tid] = (f32x4){0.f, 0.f, 0.f, 0.f}; z[tid + 512] = (f32x4){0.f, 0.f, 0.f, 0.f}; if (tid < 64) z[tid + 1024] = (f32x4){0.f, 0.f, 0.f, 0.f}; }
          if (tid < 64) { const int c2 = tid;
              const float bt = sigmoidf_(ba_b2);
              float sg = gpar[dir * 4 + h] * softplusf_(ba_a2 + gpar[8 + dir * 4 + h]);
#pragma unroll
              for (int o = 1; o < 64; o <<= 1) { const float t = __shfl_up(sg, o); if (c2 >= o) sg += t; }
              const float G = __shfl(sg, 63); const float ec = fast_exp(sg);
              betav[c2] = bt; cum[c2] = sg; ecum[c2] = ec; dvec[c2] = fast_exp(G - sg); bec[c2] = bt * ec; } }
        DN_BAR();
        for (int rp_ = 0; rp_ < 1 + (((D1REP) >> 1) & 1); ++rp_) {
        { FRESH_TID(); const int lane = tid & 63, wv = __builtin_amdgcn_readfirstlane(tid >> 6), l15 = lane & 15, q = lane >> 4;
          { const int k = tid >> 3, c0 = (tid & 7) * 8; const v4u kk4 = *(const LAS v4u*)(kT + k * HP + c0); const unsigned kw[4] = {kk4.x, kk4.y, kk4.z, kk4.w}; unsigned ow[4];
#pragma unroll
            for (int e = 0; e < 4; ++e) ow[e] = pk2(bflo(kw[e]) * bec[c0 + 2 * e], bfhi(kw[e]) * bec[c0 + 2 * e + 1]);
            *(LAS v4u*)(RT + (64 + k) * HP + c0) = (v4u){ow[0], ow[1], ow[2], ow[3]}; }
#pragma unroll
          for (int tt = 0; tt < 3; ++tt) { const int t = wv + 8 * tt; if (t >= 20) break;
              const bool isq = t >= 10; const int idx = isq ? t - 10 : t; const int ti = (idx >= 6) ? 3 : (idx >= 3) ? 2 : (idx >= 1) ? 1 : 0; const int tj = idx - ti * (ti + 1) / 2;
              const LAS bf16* asrc = (isq ? qN : kN) + (16 * ti + l15) * HP + 8 * q; const LAS bf16* bsrc = kN + (16 * tj + l15) * HP + 8 * q;
              f32x4 acc = {0.f, 0.f, 0.f, 0.f};
              acc = mfma16(*(const LAS bf16x8*)asrc, *(const LAS bf16x8*)bsrc, acc); acc = mfma16(*(const LAS bf16x8*)(asrc + 32), *(const LAS bf16x8*)(bsrc + 32), acc);
              const int j = 16 * tj + l15; const float cj = cum[j];
#pragma unroll
              for (int r = 0; r < 4; ++r) { const int i = 16 * ti + 4 * q + r; const float dec = fast_exp(cum[i] - cj);
                  if (isq) QKd[i * HP + j] = (bf16)f2bf((i >= j) ? acc[r] * dec : 0.f); else Am[i * DP + j] = (i > j) ? acc[r] * dec * betav[i] : 0.f; } } }
        DN_BAR();
        }
        for (int rp_ = 0; rp_ < 1 + (((D1REP) >> 2) & 1); ++rp_) {
        { FRESH_TID(); if (tid < 64) { const int bb = tid >> 4, col = tid & 15; float x[16];
#pragma unroll
            for (int r = 0; r < 16; ++r) { float s = (r == col) ? 1.f : 0.f;
#pragma unroll
                for (int s2 = 0; s2 < r; ++s2) s -= Am[(16 * bb + r) * DP + 16 * bb + s2] * x[s2];
                x[r] = s; }
#pragma unroll
            for (int r = 0; r < 16; ++r) TI[(16 * bb + r) * DP + 16 * bb + col] = x[r]; } }
        DN_BAR();
        }
        for (int rp_ = 0; rp_ < 1 + (((D1REP) >> 3) & 1); ++rp_) {
        { FRESH_TID(); const int p = tid >> 8, r = (tid >> 4) & 15, c = tid & 15; float e = 0.f;
#pragma unroll
          for (int s2 = 0; s2 < 16; ++s2) e += Am[(32 * p + 16 + r) * DP + 32 * p + s2] * TI[(32 * p + s2) * DP + 32 * p + c];
          TMP[(p * 16 + r) * 17 + c] = e;
          DN_BAR();
          float f = 0.f;
#pragma unroll
          for (int s2 = 0; s2 < 16; ++s2) f -= TI[(32 * p + 16 + r) * DP + 32 * p + 16 + s2] * TMP[(p * 16 + s2) * 17 + c];
          TI[(32 * p + 16 + r) * DP + 32 * p + c] = f; }
        DN_BAR();
        }
        for (int rp_ = 0; rp_ < 1 + (((D1REP) >> 4) & 1); ++rp_) {
        { FRESH_TID(); const int r = tid >> 4, c2 = (tid & 15) * 2; float e0 = 0.f, e1 = 0.f;
#pragma unroll 8
          for (int s2 = 0; s2 < 32; ++s2) { const float a = Am[(32 + r) * DP + s2]; e0 += a * TI[s2 * DP + c2]; e1 += a * TI[s2 * DP + c2 + 1]; }
          TMP[r * 36 + c2] = e0; TMP[r * 36 + c2 + 1] = e1;
          DN_BAR();
          float f0 = 0.f, f1 = 0.f;
#pragma unroll 8
          for (int s2 = 0; s2 < 32; ++s2) { const float a = TI[(32 + r) * DP + 32 + s2]; f0 -= a * TMP[s2 * 36 + c2]; f1 -= a * TMP[s2 * 36 + c2 + 1]; }
          TI[(32 + r) * DP + c2] = f0; TI[(32 + r) * DP + c2 + 1] = f1; }
        DN_BAR();
        }
        for (int rp_ = 0; rp_ < 1 + (((D1REP) >> 5) & 1); ++rp_) {
        { FRESH_TID(); const int c = tid >> 3, c0 = (tid & 7) * 8; float x[8];
#pragma unroll
          for (int e = 0; e < 8; ++e) x[e] = (c0 + e <= c) ? TI[c * DP + c0 + e] : 0.f;
          *(LAS v4u*)(TiB + c * HP + c0) = (v4u){pk2(x[0], x[1]), pk2(x[2], x[3]), pk2(x[4], x[5]), pk2(x[6], x[7])}; }
        DN_BAR();
        }
        { FRESH_TID(); const int lane = tid & 63, wv = __builtin_amdgcn_readfirstlane(tid >> 6), l15 = lane & 15, q = lane >> 4;
          f32x4 xa[4]; const LAS bf16* bsrc = RT + (16 * wv + l15) * HP + 8 * q; const bf16x8 b0 = *(const LAS bf16x8*)bsrc, b1 = *(const LAS bf16x8*)(bsrc + 32);
#pragma unroll
          for (int m = 0; m < 4; ++m) { const LAS bf16* asrc = TiB + (16 * m + l15) * HP + 8 * q; f32x4 a_ = {0.f, 0.f, 0.f, 0.f};
              a_ = mfma16(*(const LAS bf16x8*)asrc, b0, a_); xa[m] = mfma16(*(const LAS bf16x8*)(asrc + 32), b1, a_); }
          DN_BAR();
          const int col = 16 * wv + l15;
#pragma unroll
          for (int m = 0; m < 4; ++m) { const int c0 = 16 * m + 4 * q; const f32x4 x = xa[m];
              *(LAS v2u*)(XT + col * HP + c0) = (v2u){pk2(x.x, x.y), pk2(x.z, x.w)};
              *(LAS v2u*)(XdT + col * HP + c0) = (v2u){pk2(x.x * dvec[c0], x.y * dvec[c0 + 1]), pk2(x.z * dvec[c0 + 2], x.w * dvec[c0 + 3])}; } }
        DN_BAR();
        for (int rp_ = 0; rp_ < 1 + (((D1REP) >> 7) & 1); ++rp_) {
        { FRESH_TID(); const int lane = tid & 63, wv = __builtin_amdgcn_readfirstlane(tid >> 6), l15 = lane & 15, q = lane >> 4;
          unsigned char* ub = WSP(unsigned char, WS_DNF + dn_unit_off(b, dir, h, sc));
          const float eG = ecum[63];
#define DN_MM(dst, Ap, Bp) do { f32x4 a_ = {0.f, 0.f, 0.f, 0.f}; a_ = mfma16(*(const LAS bf16x8*)(Ap), *(const LAS bf16x8*)(Bp), a_); dst = mfma16(*(const LAS bf16x8*)((Ap) + 32), *(const LAS bf16x8*)((Bp) + 32), a_); } while (0)
#pragma unroll
          for (int t2 = 0; t2 < 2; ++t2) { const int t = 2 * wv + t2, m = t >> 2, n = t & 3; f32x4 acc;
              DN_MM(acc, kT + (16 * m + l15) * HP + 8 * q, XdT + (16 * n + l15) * HP + 8 * q);
              *(v2u*)(ub + 16384 + (size_t)((n * 4 + m) * 64 + lane) * 8) = (v2u){pk2(acc.x, acc.y), pk2(acc.z, acc.w)};
              DN_MM(acc, QKd + (16 * m + l15) * HP + 8 * q, XT + (16 * n + l15) * HP + 8 * q);
              *(v2u*)(ub + 24576 + (size_t)((n * 4 + m) * 64 + lane) * 8) = (v2u){pk2(acc.x, acc.y), pk2(acc.z, acc.w)}; }
          { const int n = wv >> 1, kk2 = wv & 1; f32x4 z0, z1, y0, y1;
            DN_MM(z0, XdT + (64 + 16 * (2 * kk2) + l15) * HP + 8 * q, kT + (16 * n + l15) * HP + 8 * q);
            DN_MM(z1, XdT + (64 + 16 * (2 * kk2 + 1) + l15) * HP + 8 * q, kT + (16 * n + l15) * HP + 8 * q);
            DN_MM(y0, XT + (64 + 16 * (2 * kk2) + l15) * HP + 8 * q, QKd + (16 * n + l15) * HP + 8 * q);
            DN_MM(y1, XT + (64 + 16 * (2 * kk2 + 1) + l15) * HP + 8 * q, QKd + (16 * n + l15) * HP + 8 * q);
            const int rowi = 16 * n + l15; float mv[8], qv[8]; const float ec = ecum[rowi];
#pragma unroll
            for (int e = 0; e < 8; ++e) { const int kp = 16 * (2 * kk2 + (e >> 2)) + 4 * q + (e & 3); const float zz = (e < 4) ? z0[e & 3] : z1[e & 3], yy = (e < 4) ? y0[e & 3] : y1[e & 3];
                mv[e] = ((kp == rowi) ? eG : 0.f) - zz; qv[e] = ec * bf2f(qN[rowi * HP + kp]) - yy; }
            *(v4u*)(ub + (size_t)((n * 2 + kk2) * 64 + lane) * 16) = (v4u){pk2(mv[0], mv[1]), pk2(mv[2], mv[3]), pk2(mv[4], mv[5]), pk2(mv[6], mv[7])};
            *(v4u*)(ub + 8192 + (size_t)((n * 2 + kk2) * 64 + lane) * 16) = (v4u){pk2(qv[0], qv[1]), pk2(qv[2], qv[3]), pk2(qv[4], qv[5]), pk2(qv[6], qv[7])}; }
#undef DN_MM
        }
        DN_BAR();
        }
    }
}
#undef FRESH_TID
#undef DN_BAR
#undef DN_LOAD
#undef DN_DECODE
DEVI bf16x8 dn_pack(const f32x4& a, const f32x4& b) { const v4u o = {pk2(a.x, a.y), pk2(a.z, a.w), pk2(b.x, b.y), pk2(b.z, b.w)}; return __builtin_bit_cast(bf16x8, o); }
#define SCAN_BAR() asm volatile("s_waitcnt lgkmcnt(0)\n\ts_barrier" ::: "memory")
DEVI unsigned cvtpk(float lo, float hi) { return pk2(lo, hi); }
DEVI bf16x8 dn_pack_hw(const f32x4& a, const f32x4& b) { const v4u o = {cvtpk(a.x, a.y), cvtpk(a.z, a.w), cvtpk(b.x, b.y), cvtpk(b.z, b.w)}; return __builtin_bit_cast(bf16x8, o); }
DEVI void ph_dn_scan(const Ctx& C, int layer) {
    constexpr int SLOTB = 24576, NS = 4, P = 8, NLD = 384, NPC = 4;
    static_assert(NCH % P == 0 || NCH % P == P / 2, "scan pipeline depth: whole groups of P steps plus at most one half group");
    const int lane = C.lane, q = lane >> 4, v16 = lane & 15;
    bf16* DNO = WSP(bf16, WS_DNO);
    for (int u = C.bid; u < NB * 2 * 4 * 2; u += C.G) {
        const int vp = u & 1, h = (u >> 1) & 3, dir = (u >> 3) & 1, b = u >> 4;
        const unsigned char* base = WSP(const unsigned char, WS_DNF + dn_unit_off(b, dir, h, 0));
        if (C.wave < 2) {
            const int vs = 2 * vp + C.wave;
            bf16x8 sf[2]; { const v4u z = {0u, 0u, 0u, 0u}; sf[0] = __builtin_bit_cast(bf16x8, z); sf[1] = sf[0]; }
            bf16* ob = DNO + (size_t)dir * T_ALL * 256 + h * 64 + vs * 16 + v16;
            SCAN_BAR();
#define SCAN_SEG(SGN, SC0, NCHS, SEQ0, LEN) do { \
            bf16* pm[4]; \
            _Pragma("unroll") for (int m = 0; m < 4; ++m) pm[m] = ob + ((long)(SEQ0) + ((SGN) < 0 ? (LEN) - 1 : 0) + (SGN) * (16 * m + 4 * q)) * 256; \
            _Pragma("unroll 1") for (int s2 = 0; s2 < (NCHS); ++s2) { \
                const LAS unsigned char* sl = C.lds + (((SC0) + s2) % NS) * SLOTB; \
                f32x4 o[4], d[4]; \
                _Pragma("unroll") for (int m = 0; m < 4; ++m) { \
                    const bf16x8 ma0 = *(const LAS bf16x8*)(sl + ((m * 2 + 0) * 64 + lane) * 16), ma1 = *(const LAS bf16x8*)(sl + ((m * 2 + 1) * 64 + lane) * 16); \
                    const bf16x8 qa0 = *(const LAS bf16x8*)(sl + 8192 + ((m * 2 + 0) * 64 + lane) * 16), qa1 = *(const LAS bf16x8*)(sl + 8192 + ((m * 2 + 1) * 64 + lane) * 16); \
                    const v2u ncp = *(const LAS v2u*)(sl + 16384 + ((C.wave * 4 + m) * 64 + lane) * 8), ocp = *(const LAS v2u*)(sl + 20480 + ((C.wave * 4 + m) * 64 + lane) * 8); \
                    const f32x4 nc = {bflo(ncp.x), bfhi(ncp.x), bflo(ncp.y), bfhi(ncp.y)}, oc = {bflo(ocp.x), bfhi(ocp.x), bflo(ocp.y), bfhi(ocp.y)}; \
                    d[m] = __builtin_amdgcn_mfma_f32_16x16x32_bf16(ma0, sf[0], nc, 0, 0, 0); d[m] = __builtin_amdgcn_mfma_f32_16x16x32_bf16(ma1, sf[1], d[m], 0, 0, 0); \
                    o[m] = __builtin_amdgcn_mfma_f32_16x16x32_bf16(qa0, sf[0], oc, 0, 0, 0); o[m] = __builtin_amdgcn_mfma_f32_16x16x32_bf16(qa1, sf[1], o[m], 0, 0, 0); } \
                sf[0] = dn_pack_hw(d[0], d[1]); sf[1] = dn_pack_hw(d[2], d[3]); \
                _Pragma("unroll") for (int m = 0; m < 4; ++m) { \
                    _Pragma("unroll") for (int i = 0; i < 4; ++i) pm[m][(SGN) * i * 256] = (bf16)f2bf(o[m][i]); \
                    pm[m] += (SGN) * 64 * 256; } \
                SCAN_BAR(); } } while (0)
            if (dir == 0) { SCAN_SEG(1, 0, NCH_C, T_L + b * LC, LC); SCAN_SEG(1, NCH_C, NCH_L, b * SEQ, SEQ); }
            else          { SCAN_SEG(-1, 0, NCH_C, T_L + b * LC, LC); SCAN_SEG(-1, NCH_C, NCH_L, b * SEQ, SEQ); }
#undef SCAN_SEG
        } else {
            const int lid = C.tid - 128;
            unsigned so[NPC], dofs[NPC];
#pragma unroll
            for (int i = 0; i < NPC; ++i) { const int pp = lid + NLD * i;
                so[i] = (pp < 1024) ? (unsigned)pp * 16u : (pp < 1280) ? 16384u + (unsigned)(vp * 256 + (pp - 1024)) * 16u : 24576u + (unsigned)(vp * 256 + (pp - 1280)) * 16u; dofs[i] = (unsigned)pp * 16u; }
            v4u buf[P][NPC];
#pragma unroll
            for (int s2 = 0; s2 < P; ++s2)
#pragma unroll
                for (int i = 0; i < NPC; ++i) buf[s2][i] = *(const v4u*)(base + (size_t)s2 * DN_UNIT_BYTES + so[i]);
#pragma unroll
            for (int i = 0; i < NPC; ++i) *(LAS v4u*)(C.lds + dofs[i]) = buf[0][i];
            SCAN_BAR();
#define SCAN_LD_STEP(j) do { const int step = sc + (j); const int nxt = (step + P < NCH) ? step + P : NCH - 1; \
                    _Pragma("unroll") for (int i = 0; i < NPC; ++i) buf[(j)][i] = *(const v4u*)(base + (size_t)nxt * DN_UNIT_BYTES + so[i]); \
                    LAS unsigned char* sl = C.lds + ((step + 1) % NS) * SLOTB; \
                    _Pragma("unroll") for (int i = 0; i < NPC; ++i) *(LAS v4u*)(sl + dofs[i]) = buf[((j) + 1) % P][i]; \
                    SCAN_BAR(); } while (0)
            int sc = 0;
#pragma unroll 1
            for (; sc + P <= NCH; sc += P) {
#pragma unroll
                for (int j = 0; j < P; ++j) SCAN_LD_STEP(j);
            }
            if (NCH % P) {
#pragma unroll
                for (int j = 0; j < P / 2; ++j) SCAN_LD_STEP(j);
            }
#undef SCAN_LD_STEP
        }
    }
}
#undef SCAN_BAR

DEVI void ph_finalize(const Ctx& C, int layer, int ntok) {
    const int lane = C.lane;
    const bf16* DNO = WSP(const bf16, WS_DNO); const bf16* proj = WSP(const bf16, WS_PROJ); bf16* mix = WSP(bf16, WS_MIX);
    const f32x4 ong = *(const f32x4*)(INP(23) + layer * 64 + ((4 * lane) & 63));
    constexpr int RU = 4; const int rstep = C.G * 8;
    for (int r0 = C.bid * 8 + C.wave; r0 < ntok; r0 += RU * rstep) {
        v2u zz[RU], d0[RU], d1[RU];
#pragma unroll
        for (int u2 = 0; u2 < RU; ++u2) { const int rr = r0 + u2 * rstep; const size_t r = rr < ntok ? rr : r0;
            d0[u2] = *(const v2u*)(DNO + r * 256 + 4 * lane); d1[u2] = *(const v2u*)(DNO + ((size_t)T_ALL + r) * 256 + 4 * lane);
            zz[u2] = *(const v2u*)(proj + r * N_PROJ + C_DZ + 4 * lane); }
#pragma unroll
        for (int u2 = 0; u2 < RU; ++u2) { const int rr = r0 + u2 * rstep; if (rr >= ntok) continue; const size_t r = rr;
            const f32x4 od = (f32x4){bflo(d0[u2].x), bfhi(d0[u2].x), bflo(d0[u2].y), bfhi(d0[u2].y)} + (f32x4){bflo(d1[u2].x), bfhi(d1[u2].x), bflo(d1[u2].y), bfhi(d1[u2].y)};
            const float ss = group_sum<16>((od.x * od.x + od.y * od.y) + (od.z * od.z + od.w * od.w));
            const float rinv = __builtin_amdgcn_rsqf(ss * (1.f / 64.f) + NORM_EPS);
            const f32x4 z = (f32x4){siluf_(bflo(zz[u2].x)), siluf_(bfhi(zz[u2].x)), siluf_(bflo(zz[u2].y)), siluf_(bfhi(zz[u2].y))};
            const f32x4 o = od * rinv * ong * z; v2u w; w.x = pk2(o.x, o.y); w.y = pk2(o.z, o.w); *(v2u*)(mix + r * D + 768 + 4 * lane) = w; }
    }
}

DEVI void ph_router(const Ctx& C, int layer, int ntok) {
    LAS float* lgt = (LAS float*)C.lds;
    LAS int* cnt = (LAS int*)(lgt + 8 * 16 * 33);
    if (C.tid < 32) cnt[C.tid] = 0;
    __syncthreads();
    const int nt = ntok / 16; const int t0 = (int)((long)C.bid * nt / C.G), t1 = (int)((long)(C.bid + 1) * nt / C.G);
    const float* gn = INP(7) + (size_t)layer * D;
    const int l15 = C.lane & 15, q = C.lane >> 4; LAS float* lg_w = lgt + C.wave * 16 * 33;
    const int nrem = (t1 - t0) & 7; const int t1w = nrem <= 2 ? t1 - nrem : t1;
    for (int t = t0 + C.wave; t < t1w; t += 8) {
        const int row0 = 16 * t, mrow = mod_row(row0);
        const bf16* xa = WSP(const bf16, WS_XRES) + (size_t)(row0 + l15) * D + 8 * q;
        const bf16* wb = (const bf16*)(WSP(const float, WS_RWP) + ((size_t)(layer * 9 + mrow) * NE + l15) * D) + 8 * q;
        f32x4 acc0 = {0.f, 0.f, 0.f, 0.f}, acc1 = {0.f, 0.f, 0.f, 0.f}; float ssq = 0.f;
#pragma unroll 4
        for (int kk = 0; kk < 32; ++kk) { const v4u aw = *(const v4u*)(xa + 32 * kk); const bf16x8 av = __builtin_bit_cast(bf16x8, aw);
            const bf16x8 h0 = *(const bf16x8*)(wb + 32 * kk), l0 = *(const bf16x8*)(wb + D + 32 * kk), h1 = *(const bf16x8*)(wb + (size_t)32 * D + 32 * kk), l1 = *(const bf16x8*)(wb + (size_t)33 * D + 32 * kk);
            ssq += ((bflo(aw.x) * bflo(aw.x) + bfhi(aw.x) * bfhi(aw.x)) + (bflo(aw.y) * bflo(aw.y) + bfhi(aw.y) * bfhi(aw.y))) + ((bflo(aw.z) * bflo(aw.z) + bfhi(aw.z) * bfhi(aw.z)) + (bflo(aw.w) * bflo(aw.w) + bfhi(aw.w) * bfhi(aw.w)));
            acc0 = __builtin_amdgcn_mfma_f32_16x16x32_bf16(av, h0, acc0, 0, 0, 0); acc1 = __builtin_amdgcn_mfma_f32_16x16x32_bf16(av, h1, acc1, 0, 0, 0);
            acc0 = __builtin_amdgcn_mfma_f32_16x16x32_bf16(av, l0, acc0, 0, 0, 0); acc1 = __builtin_amdgcn_mfma_f32_16x16x32_bf16(av, l1, acc1, 0, 0, 0); }
        ssq += __shfl_xor(ssq, 16); ssq += __shfl_xor(ssq, 32);
        const float rinv = __builtin_amdgcn_rsqf(ssq * (1.f / D) + NORM_EPS);
        const float* rb = WSP(const float, WS_RBP) + (size_t)(layer * 9 + mrow) * NE;
        const float bb0 = rb[l15], bb1 = rb[16 + l15];
#pragma unroll
        for (int r = 0; r < 4; ++r) { const float ri = __shfl(rinv, 4 * q + r); lg_w[(4 * q + r) * 33 + l15] = acc0[r] * ri + bb0; lg_w[(4 * q + r) * 33 + 16 + l15] = acc1[r] * ri + bb1; }
        LDS_WAIT();
        if (C.lane < 16) { const int r = row0 + C.lane; float lg[32];
#pragma unroll
            for (int e = 0; e < 32; ++e) lg[e] = lg_w[C.lane * 33 + e];
            int te[4]; float tv[4];
#pragma unroll
            for (int k = 0; k < 4; ++k) { float best = -INFINITY; int bi = 0;
#pragma unroll
                for (int e = 0; e < 32; ++e) if (lg[e] > best) { best = lg[e]; bi = e; }
#pragma unroll
                for (int e = 0; e < 32; ++e) lg[e] = (e == bi) ? -INFINITY : lg[e];
                te[k] = bi; tv[k] = best; }
            float ex[4], es = 0.f;
#pragma unroll
            for (int k = 0; k < 4; ++k) { ex[k] = fast_exp(tv[k] - tv[0]); es += ex[k]; }
            const float ri = 1.f / es;
#pragma unroll
            for (int k = 0; k < 4; ++k) { const int pos = __hip_atomic_fetch_add(&cnt[te[k]], 1, __ATOMIC_RELAXED, __HIP_MEMORY_SCOPE_WORKGROUP);
                WSP(int, WS_TOKE)[(size_t)r * 4 + k] = te[k]; WSP(float, WS_TOKG)[(size_t)r * 4 + k] = ex[k] * ri; WSP(int, WS_TOKP)[(size_t)r * 4 + k] = pos; } }
        LDS_WAIT();
        { const float* sh = mod_vec(C, layer, mrow, 3); const float* scl = mod_vec(C, layer, mrow, 4);
          f32x4 gm[4], sv[4];
#pragma unroll
          for (int j = 0; j < 4; ++j) { const int col = ((j & 2) ? 512 : 0) + 8 * C.lane + 4 * (j & 1); gm[j] = *(const f32x4*)(gn + col) * (*(const f32x4*)(scl + col) + 1.0f); sv[j] = *(const f32x4*)(sh + col); }
#pragma unroll 1
          for (int rr = 0; rr < 16; rr += 2) { v4u xw[2][2];
#pragma unroll
              for (int u2 = 0; u2 < 2; ++u2) { const bf16* xr = WSP(const bf16, WS_XRES) + (size_t)(row0 + rr + u2) * D; xw[u2][0] = *(const v4u*)(xr + 8 * C.lane); xw[u2][1] = *(const v4u*)(xr + 512 + 8 * C.lane); }
#pragma unroll
              for (int u2 = 0; u2 < 2; ++u2) { const float ri = __shfl(rinv, rr + u2); f32x4 f[4];
                  f[0] = (f32x4){bflo(xw[u2][0].x), bfhi(xw[u2][0].x), bflo(xw[u2][0].y), bfhi(xw[u2][0].y)} * ri * gm[0] + sv[0]; f[1] = (f32x4){bflo(xw[u2][0].z), bfhi(xw[u2][0].z), bflo(xw[u2][0].w), bfhi(xw[u2][0].w)} * ri * gm[1] + sv[1];
                  f[2] = (f32x4){bflo(xw[u2][1].x), bfhi(xw[u2][1].x), bflo(xw[u2][1].y), bfhi(xw[u2][1].y)} * ri * gm[2] + sv[2]; f[3] = (f32x4){bflo(xw[u2][1].z), bfhi(xw[u2][1].z), bflo(xw[u2][1].w), bfhi(xw[u2][1].w)} * ri * gm[3] + sv[3];
                  bf16* fr_ = WSP(bf16, WS_F) + (size_t)(row0 + rr + u2) * D;
                  *(v4u*)(fr_ + 8 * C.lane) = (v4u){pk2(f[0].x, f[0].y), pk2(f[0].z, f[0].w), pk2(f[1].x, f[1].y), pk2(f[1].z, f[1].w)};
                  *(v4u*)(fr_ + 512 + 8 * C.lane) = (v4u){pk2(f[2].x, f[2].y), pk2(f[2].z, f[2].w), pk2(f[3].x, f[3].y), pk2(f[3].z, f[3].w)}; } } }
    }
    LAS float* ssqp = (LAS float*)(cnt + 32); LAS float* rinvs = ssqp + 128;
    for (int t = t1w; t < t1; ++t) {
        const int row0 = 16 * t, mrow = mod_row(row0);
        { const bf16* xa = WSP(const bf16, WS_XRES) + (size_t)(row0 + l15) * D + 8 * q + 128 * C.wave;
          const bf16* wb = (const bf16*)(WSP(const float, WS_RWP) + ((size_t)(layer * 9 + mrow) * NE + l15) * D) + 8 * q + 128 * C.wave;
          f32x4 acc0 = {0.f, 0.f, 0.f, 0.f}, acc1 = {0.f, 0.f, 0.f, 0.f}; float ssq = 0.f;
#pragma unroll
          for (int kk = 0; kk < 4; ++kk) { const v4u aw = *(const v4u*)(xa + 32 * kk); const bf16x8 av = __builtin_bit_cast(bf16x8, aw);
              const bf16x8 h0 = *(const bf16x8*)(wb + 32 * kk), l0 = *(const bf16x8*)(wb + D + 32 * kk), h1 = *(const bf16x8*)(wb + (size_t)32 * D + 32 * kk), l1 = *(const bf16x8*)(wb + (size_t)33 * D + 32 * kk);
              ssq += ((bflo(aw.x) * bflo(aw.x) + bfhi(aw.x) * bfhi(aw.x)) + (bflo(aw.y) * bflo(aw.y) + bfhi(aw.y) * bfhi(aw.y))) + ((bflo(aw.z) * bflo(aw.z) + bfhi(aw.z) * bfhi(aw.z)) + (bflo(aw.w) * bflo(aw.w) + bfhi(aw.w) * bfhi(aw.w)));
              acc0 = __builtin_amdgcn_mfma_f32_16x16x32_bf16(av, h0, acc0, 0, 0, 0); acc1 = __builtin_amdgcn_mfma_f32_16x16x32_bf16(av, h1, acc1, 0, 0, 0);
              acc0 = __builtin_amdgcn_mfma_f32_16x16x32_bf16(av, l0, acc0, 0, 0, 0); acc1 = __builtin_amdgcn_mfma_f32_16x16x32_bf16(av, l1, acc1, 0, 0, 0); }
          ssq += __shfl_xor(ssq, 16); ssq += __shfl_xor(ssq, 32);
          if (q == 0) ssqp[C.wave * 16 + l15] = ssq;
#pragma unroll
          for (int r = 0; r < 4; ++r) { lg_w[(4 * q + r) * 33 + l15] = acc0[r]; lg_w[(4 * q + r) * 33 + 16 + l15] = acc1[r]; } }
        __syncthreads();
        if (C.wave == 0) {
            float s = 0.f;
#pragma unroll
            for (int w = 0; w < 8; ++w) s += ssqp[w * 16 + l15];
            const float rinv = __builtin_amdgcn_rsqf(s * (1.f / D) + NORM_EPS);
            if (q == 0) rinvs[l15] = rinv;
            const float* rb = WSP(const float, WS_RBP) + (size_t)(layer * 9 + mrow) * NE;
            const float bb0 = rb[l15], bb1 = rb[16 + l15];
            float a0[4], a1[4];
#pragma unroll
            for (int r = 0; r < 4; ++r) { a0[r] = 0.f; a1[r] = 0.f;
#pragma unroll
                for (int w = 0; w < 8; ++w) { a0[r] += lgt[w * 16 * 33 + (4 * q + r) * 33 + l15]; a1[r] += lgt[w * 16 * 33 + (4 * q + r) * 33 + 16 + l15]; } }
#pragma unroll
            for (int r = 0; r < 4; ++r) { const float ri = __shfl(rinv, 4 * q + r); lgt[(4 * q + r) * 33 + l15] = a0[r] * ri + bb0; lgt[(4 * q + r) * 33 + 16 + l15] = a1[r] * ri + bb1; }
            LDS_WAIT();
            if (C.lane < 16) { const int r = row0 + C.lane; float lg[32];
#pragma unroll
                for (int e = 0; e < 32; ++e) lg[e] = lgt[C.lane * 33 + e];
                int te[4]; float tv[4];
#pragma unroll
                for (int k = 0; k < 4; ++k) { float best = -INFINITY; int bi = 0;
#pragma unroll
                    for (int e = 0; e < 32; ++e) if (lg[e] > best) { best = lg[e]; bi = e; }
#pragma unroll
                    for (int e = 0; e < 32; ++e) lg[e] = (e == bi) ? -INFINITY : lg[e];
                    te[k] = bi; tv[k] = best; }
                float ex[4], es = 0.f;
#pragma unroll
                for (int k = 0; k < 4; ++k) { ex[k] = fast_exp(tv[k] - tv[0]); es += ex[k]; }
                const float ri = 1.f / es;
#pragma unroll
                for (int k = 0; k < 4; ++k) { const int pos = __hip_atomic_fetch_add(&cnt[te[k]], 1, __ATOMIC_RELAXED, __HIP_MEMORY_SCOPE_WORKGROUP);
                    WSP(int, WS_TOKE)[(size_t)r * 4 + k] = te[k]; WSP(float, WS_TOKG)[(size_t)r * 4 + k] = ex[k] * ri; WSP(int, WS_TOKP)[(size_t)r * 4 + k] = pos; } }
        }
        __syncthreads();
        { const float* sh = mod_vec(C, layer, mrow, 3); const float* scl = mod_vec(C, layer, mrow, 4);
          v4u xw[2][2];
#pragma unroll
          for (int u2 = 0; u2 < 2; ++u2) { const bf16* xr = WSP(const bf16, WS_XRES) + (size_t)(row0 + 2 * C.wave + u2) * D; xw[u2][0] = *(const v4u*)(xr + 8 * C.lane); xw[u2][1] = *(const v4u*)(xr + 512 + 8 * C.lane); }
          f32x4 gm[4], sv[4];
#pragma unroll
          for (int j = 0; j < 4; ++j) { const int col = ((j & 2) ? 512 : 0) + 8 * C.lane + 4 * (j & 1); gm[j] = *(const f32x4*)(gn + col) * (*(const f32x4*)(scl + col) + 1.0f); sv[j] = *(const f32x4*)(sh + col); }
#pragma unroll
          for (int u2 = 0; u2 < 2; ++u2) { const float ri = rinvs[2 * C.wave + u2]; f32x4 f[4];
              f[0] = (f32x4){bflo(xw[u2][0].x), bfhi(xw[u2][0].x), bflo(xw[u2][0].y), bfhi(xw[u2][0].y)} * ri * gm[0] + sv[0]; f[1] = (f32x4){bflo(xw[u2][0].z), bfhi(xw[u2][0].z), bflo(xw[u2][0].w), bfhi(xw[u2][0].w)} * ri * gm[1] + sv[1];
              f[2] = (f32x4){bflo(xw[u2][1].x), bfhi(xw[u2][1].x), bflo(xw[u2][1].y), bfhi(xw[u2][1].y)} * ri * gm[2] + sv[2]; f[3] = (f32x4){bflo(xw[u2][1].z), bfhi(xw[u2][1].z), bflo(xw[u2][1].w), bfhi(xw[u2][1].w)} * ri * gm[3] + sv[3];
              bf16* fr_ = WSP(bf16, WS_F) + (size_t)(row0 + 2 * C.wave + u2) * D;
              *(v4u*)(fr_ + 8 * C.lane) = (v4u){pk2(f[0].x, f[0].y), pk2(f[0].z, f[0].w), pk2(f[1].x, f[1].y), pk2(f[1].z, f[1].w)};
              *(v4u*)(fr_ + 512 + 8 * C.lane) = (v4u){pk2(f[2].x, f[2].y), pk2(f[2].z, f[2].w), pk2(f[3].x, f[3].y), pk2(f[3].z, f[3].w)}; } }
        __syncthreads();
    }
    __syncthreads();
    if (C.tid < 32) WSP(int, WS_BCNT)[C.bid * 32 + C.tid] = cnt[C.tid];
}

DEVI void ph_slots(const Ctx& C, int layer, int ntok) {
    LAS int* tot = (LAS int*)C.lds; LAS int* myoff = tot + 32; LAS int* base = tot + 64; LAS int* part = tot + 96;
    {
      const int e = C.tid & 31, grp = C.tid >> 5; int t = 0, o = 0; const int* bc = WSP(const int, WS_BCNT) + e;
#pragma unroll 4
      for (int b2 = grp; b2 < C.G; b2 += 16) { const int c = bc[b2 * 32]; t += c; if (b2 < C.bid) o += c; }
      part[grp * 64 + e] = t; part[grp * 64 + 32 + e] = o; }
    __syncthreads();
    if (C.tid < 64) { int a = 0;
#pragma unroll
        for (int g = 0; g < 16; ++g) a += part[g * 64 + C.tid];
        if (C.tid < 32) tot[C.tid] = a; else myoff[C.tid - 32] = a; }
    __syncthreads();
    if (C.tid == 0) { int acc = 0; int* texp = WSP(int, WS_TEXP);
        for (int e = 0; e < 32; ++e) { base[e] = acc; const int nt = (tot[e] + 255) >> 8; if (C.bid == 0) for (int i = 0; i < nt; ++i) texp[1 + (acc >> 8) + i] = e; acc += nt << 8; }
        if (C.bid == 0) texp[0] = acc >> 8; }
    __syncthreads();
    int* rowmap = WSP(int, WS_ROWMAP);
    if (C.bid == 0) {
        for (int e = 0; e < 32; ++e) { const int lo = base[e] + tot[e], hi2 = base[e] + (((tot[e] + 255) >> 8) << 8); for (int i = lo + C.tid; i < hi2; i += 512) rowmap[i] = 0; } }
    const int nt = ntok / 16; const int r0 = 16 * (int)((long)C.bid * nt / C.G), r1 = 16 * (int)((long)(C.bid + 1) * nt / C.G);
    for (int i = r0 * 4 + C.tid; i < r1 * 4; i += 512) { const int e = WSP(const int, WS_TOKE)[i]; const int slot = base[e] + myoff[e] + WSP(const int, WS_TOKP)[i];
        WSP(int, WS_SLOT)[i] = slot; rowmap[slot] = i >> 2; }
}

DEVI void ph_attention(const Ctx& C, bool need_ctx, int layer) {
    const attn_body::bf16* QL = WSP(const attn_body::bf16, WS_QL); const attn_body::bf16* QC = WSP(const attn_body::bf16, WS_QC);
    const attn_body::bf16* KB = WSP(const attn_body::bf16, WS_K); const attn_body::bf16* VB = WSP(const attn_body::bf16, WS_V);
    attn_body::bf16* mix = WSP(attn_body::bf16, WS_MIX);
    constexpr int NQL = SEQ / 128, NQC = LC / 128, UL = NB * 6 * NQL, UC = NB * 6 * NQC;
    const float lam_init = 0.8f - 0.6f * fast_exp(-0.3f * (float)layer); float lam;
    { float p1 = 0.f, p2 = 0.f; if (C.lane < 32) { p1 = INP(15)[layer * 32 + C.lane] * INP(16)[layer * 32 + C.lane]; p2 = INP(17)[layer * 32 + C.lane] * INP(18)[layer * 32 + C.lane]; }
      lam = fast_exp(wave_sum(p1)) - fast_exp(wave_sum(p2)) + lam_init; }
    const float post = 1.f - lam_init; const float* subln = INP(19) + layer * 64;
    const int total = UL + (need_ctx ? UC : 0);
    const int conv_at = (layer + 1 < DEPTH) ? (int)(C.bid % 6) : -1; int ui = 0; bool conv_done = false;
    const int conv0_at = (layer == 0) ? (int)((C.bid + 3) % 6) : -1; bool conv0_done = false;
    for (int u = (C.bid + C.G / 2) % C.G; u < total; u += C.G, ++ui) {
        if (ui == conv_at) { __syncthreads(); convert_layer_weights(C, layer + 1, 2); __syncthreads(); conv_done = true; }
        if (ui == conv0_at) { __syncthreads(); convert_layer_weights(C, 0, 1); __syncthreads(); conv0_done = true; }
        const bool isc = u >= UL; int qb, bp;
        if (!isc && (C.G & 7) == 0 && NQL == 32 && C.G == 256) { const int w = u % C.G, rnd = u / C.G; bp = rnd * 8 + (w & 7); qb = w >> 3; }
        else { const int v = isc ? u - UL : u; const int nq = isc ? NQC : NQL; qb = v % nq; bp = v / nq; }
        const int p = bp % 6, b = bp / 6;
        const int slen = isc ? LC : SEQ; const attn_body::bf16* Qbase = isc ? QC : QL;
        const attn_body::bf16* Qa = Qbase + ((size_t)(b * 12 + 2 * p) * slen + qb * 128) * 64; const attn_body::bf16* Qb = Qa + (size_t)slen * 64;
        const attn_body::bf16* Kh = KB + ((size_t)(b * 6 + p) * NKEY + (isc ? SEQ : 0)) * 64; const attn_body::bf16* Vh = VB + ((size_t)(b * 6 + p) * NKEY + (isc ? SEQ : 0)) * 64;
        const size_t row0 = (size_t)(isc ? T_L + b * LC : b * SEQ) + qb * 128;
        attn_body::bf16 *Oa, *Ob; int opitch;
        if (p < 2) { Oa = mix + row0 * D + (2 * p) * 64; Ob = Oa + 64; opitch = D; }
        else { Oa = mix + row0 * D + 512 + (p - 2) * 64; Ob = Oa; opitch = D; }
        const int ntile = isc ? LC / 64 : NKEY / 64;
        if (p < 2) attn_body::attn_unit<8, 0>(Qa, Qb, Kh, Vh, Oa, Ob, opitch, ntile, (char*)C.lds, lam, post, subln);
        else if (C.wave < 4) attn_body::attn_unit<8, 1>(Qa, Qb, Kh, Vh, Oa, Ob, opitch, ntile, (char*)C.lds, lam, post, subln);
        else attn_body::attn_unit<8, 2>(Qa, Qb, Kh, Vh, Oa, Ob, opitch, ntile, (char*)C.lds, lam, post, subln);
    }
    if (conv_at >= 0 && !conv_done) { __syncthreads(); convert_layer_weights(C, layer + 1, 2); __syncthreads(); }
    if (conv0_at >= 0 && !conv0_done) { __syncthreads(); convert_layer_weights(C, 0, 1); __syncthreads(); }
}

DEVI void ph_outproj_ctx(const Ctx& C, int layer) {
    const int l15 = C.lane & 15, q = C.lane >> 4, ks = C.wave & 3, ch = C.wave >> 2;
    const float* g = mod_vec(C, layer, 8, 2);
    LAS float* P = (LAS float*)C.lds; constexpr int PP = 132;
    for (int tile = C.bid; tile < (NB * LC / 64) * (D / 128); tile += C.G) {
        const int r0 = (tile >> 3) * 64, c0 = (tile & 7) * 128;
        const bf16* a = WSP(const bf16, WS_MIX) + (size_t)(T_L + r0 + l15) * D + 256 * ks + 8 * q;
        const bf16* b = WSP(const bf16, WS_WOUT) + (size_t)layer * D * D + (size_t)(c0 + 64 * ch + l15) * D + 256 * ks + 8 * q;
        f32x4 acc[4][4];
#pragma unroll
        for (int m = 0; m < 4; ++m)
#pragma unroll
            for (int n = 0; n < 4; ++n) acc[m][n] = (f32x4){0.f, 0.f, 0.f, 0.f};
#pragma unroll 4
        for (int kk = 0; kk < 8; ++kk) { bf16x8 av[4], bv[4];
#pragma unroll
            for (int m = 0; m < 4; ++m) av[m] = *(const bf16x8*)(a + (size_t)16 * m * D + 32 * kk);
#pragma unroll
            for (int n = 0; n < 4; ++n) bv[n] = *(const bf16x8*)(b + (size_t)16 * n * D + 32 * kk);
#pragma unroll
            for (int m = 0; m < 4; ++m)
#pragma unroll
                for (int n = 0; n < 4; ++n) acc[m][n] = __builtin_amdgcn_mfma_f32_16x16x32_bf16(bv[n], av[m], acc[m][n], 0, 0, 0); }
#pragma unroll
        for (int m = 0; m < 4; ++m)
#pragma unroll
            for (int n = 0; n < 4; ++n) *(LAS f32x4*)(P + (size_t)(ks * 64 + 16 * m + l15) * PP + 64 * ch + 16 * n + 4 * q) = acc[m][n];
        __syncthreads();
        { const int row = C.tid >> 3, cg = (C.tid & 7) * 16; f32x4 s[4];
#pragma unroll
          for (int i = 0; i < 4; ++i) { const LAS float* pp = P + (size_t)row * PP + cg + 4 * i;
              s[i] = (*(const LAS f32x4*)pp + *(const LAS f32x4*)(pp + 64 * PP)) + (*(const LAS f32x4*)(pp + 128 * PP) + *(const LAS f32x4*)(pp + 192 * PP)); }
          const size_t ro = (size_t)(r0 + row) * D + c0 + cg; bf16* xo = WSP(bf16, WS_XRES) + (size_t)T_L * D + ro;
          f32x4 xi[4];
          if (layer == 0) {
#pragma unroll
              for (int i = 0; i < 4; ++i) xi[i] = *(const f32x4*)(INP(2) + ro + 4 * i); }
          else { const v4u w0 = *(const v4u*)xo, w1 = *(const v4u*)(xo + 8);
              xi[0] = (f32x4){bflo(w0.x), bfhi(w0.x), bflo(w0.y), bfhi(w0.y)}; xi[1] = (f32x4){bflo(w0.z), bfhi(w0.z), bflo(w0.w), bfhi(w0.w)};
              xi[2] = (f32x4){bflo(w1.x), bfhi(w1.x), bflo(w1.y), bfhi(w1.y)}; xi[3] = (f32x4){bflo(w1.z), bfhi(w1.z), bflo(w1.w), bfhi(w1.w)}; }
          f32x4 v[4];
#pragma unroll
          for (int i = 0; i < 4; ++i) v[i] = xi[i] + *(const f32x4*)(g + c0 + cg + 4 * i) * s[i];
          *(v4u*)xo = (v4u){pk2(v[0].x, v[0].y), pk2(v[0].z, v[0].w), pk2(v[1].x, v[1].y), pk2(v[1].z, v[1].w)};
          *(v4u*)(xo + 8) = (v4u){pk2(v[2].x, v[2].y), pk2(v[2].z, v[2].w), pk2(v[3].x, v[3].y), pk2(v[3].z, v[3].w)}; }
        __syncthreads();
    }
}

constexpr int PH_PER_LAYER = 10, N_PHASES = 2 + DEPTH * PH_PER_LAYER;
struct Args { const float* in[31]; float* out; unsigned char* ws; int ph_lo, ph_hi; };
template <int MASK> __global__ void __launch_bounds__(512, 2) mk_fwd(Args args) {
    extern __shared__ __attribute__((aligned(16))) unsigned char lds_raw[];
    { LAS unsigned long long* pt = (LAS unsigned long long*)((LAS unsigned char*)lds_raw + PTR_OFF);
      if (threadIdx.x == 0) {
#pragma unroll
          for (int i = 0; i < 31; ++i) pt[i] = (unsigned long long)args.in[i]; } }
    volatile LAS unsigned* MISC = (volatile LAS unsigned*)((LAS unsigned char*)lds_raw + MISC_OFF);
    if (threadIdx.x < 32) MISC[threadIdx.x] = 0u;
    __syncthreads();
#define CTX() Ctx C; { int t_ = threadIdx.x; LAUNDER_V(t_); C.tid = t_; C.lane = t_ & 63; C.wave = __builtin_amdgcn_readfirstlane(t_ >> 6); int b_ = blockIdx.x; LAUNDER_S(b_); C.bid = b_; \
    int g_ = gridDim.x; LAUNDER_S(g_); C.G = g_; unsigned long long w_ = (unsigned long long)args.ws; LAUNDER_S(w_); C.wsi = w_; C.out = (float*)(GAS float*)(unsigned long long)args.out; C.lds = (LAS unsigned char*)lds_raw; }
    const int lo = args.ph_lo, hi = args.ph_hi;
#if MK_N_LAUNCHES == 1
    XcdBarrier bar = xcd_barrier_post((unsigned*)(args.ws + WS_CTL) + CW_BAR, MISC + 8);
#define GRID_BAR() xcd_barrier(bar)
#else
#define GRID_BAR() do {} while (0)
#endif
#define PHON(b) (((MASK) >> (b)) & 1)
#ifndef REP_MASK
#define REP_MASK 0
#endif
#define REP(b) for (int rp_ = 0; rp_ < 1 + (((REP_MASK) >> (b)) & 1); ++rp_)
#define REPX(b, cond) for (int rp_ = 0; rp_ < 1 + ((((REP_MASK) >> (b)) & 1) && (cond)); ++rp_)
#define IN(k) (lo <= (k) && (k) < hi)
#define SEAM(k) do { if (IN(k) && IN((k) + 1)) { GRID_BAR(); if (((REP_MASK) >> 17) & 1) GRID_BAR(); } } while (0)
    if (PHON(0) && IN(0)) REP(0) { CTX(); p0_prologue(C); } SEAM(0);
#define LAYER_BODY(layer) { \
        const int p0 = 1 + layer * PH_PER_LAYER; const bool need_ctx = layer < DEPTH - 1; const int ntok = need_ctx ? T_ALL : T_L; \
        if (PHON(1) && IN(p0 + 0)) REPX(15, layer == 0) { CTX(); ph_norm_mix(C, layer); } SEAM(p0 + 0); \
        if (PHON(2) && IN(p0 + 1)) REP(2) { CTX(); pg8::Gemm g{WSP(const pg8::bf16_t, WS_H), WSP(const pg8::bf16_t, WS_WIN) + (size_t)layer * N_PROJ * D, T_ALL, N_PROJ, D}; \
            pg8::StaticOrder S; S.init(T_ALL, N_PROJ, C.G, C.bid); pg8::EpiBf16<0> E{WSP(pg8::bf16_t, WS_PROJ), N_PROJ, nullptr, 0, 0, 1.f}; \
            pg8::gemm_phase<pg8::EpiBf16<0>, pg8::StaticOrder, true, true>(C.lds, g, S, E); } SEAM(p0 + 1); \
        if (IN(p0 + 2)) { if (PHON(3)) REP(3) { CTX(); ph_attn_prep(C, layer); } if (PHON(5)) REP(5) { CTX(); ph_dn_chunk(C, layer); } } SEAM(p0 + 2); \
        if (IN(p0 + 3)) { if (PHON(6)) REP(6) { CTX(); ph_dn_scan(C, layer); } __syncthreads(); if (PHON(4)) REP(4) { CTX(); ph_gmlp(C, layer, ntok); } __syncthreads(); if (PHON(7)) REP(7) { CTX(); ph_attention(C, need_ctx, layer); } } SEAM(p0 + 3); \
        if (PHON(8) && IN(p0 + 4)) REP(8) { CTX(); ph_finalize(C, layer, ntok); } SEAM(p0 + 4); \
        if (PHON(9) && IN(p0 + 5)) REPX(14, layer == 0) { CTX(); pg8::Gemm g{WSP(const pg8::bf16_t, WS_MIX), WSP(const pg8::bf16_t, WS_WOUT) + (size_t)layer * D * D, T_L, D, D}; \
            pg8::StaticOrder S; S.init(T_L, D, C.G, C.bid); \
            if (layer == 0) { pg8::EpiOutRes<true> E{INP(0), INP(2), WSP(pg8::bf16_t, WS_XRES), WSP(const float, WS_MOD) + (size_t)layer * 9 * 6 * D}; \
                pg8::gemm_phase<pg8::EpiOutRes<true>, pg8::StaticOrder, true, true>(C.lds, g, S, E); } \
            else { pg8::EpiOutRes<false> E{WSP(const pg8::bf16_t, WS_XRES), WSP(const pg8::bf16_t, WS_XRES) + (size_t)T_L * D, WSP(pg8::bf16_t, WS_XRES), WSP(const float, WS_MOD) + (size_t)layer * 9 * 6 * D}; \
                pg8::gemm_phase<pg8::EpiOutRes<false>, pg8::StaticOrder, true, true>(C.lds, g, S, E); } \
            if (need_ctx) ph_outproj_ctx(C, layer); } SEAM(p0 + 5); \
        if (PHON(10) && IN(p0 + 6)) REP(10) { CTX(); ph_router(C, layer, ntok); } SEAM(p0 + 6); \
        if (PHON(11) && IN(p0 + 7)) REP(11) { CTX(); ph_slots(C, layer, ntok); } SEAM(p0 + 7); \
        if (PHON(12) && IN(p0 + 8)) REP(12) { CTX(); pg8::Gemm g{WSP(const pg8::bf16_t, WS_F), WSP(const pg8::bf16_t, WS_WUP) + (size_t)layer * NE * 2 * DE * D, P_ROWS, NE * 2 * DE, D, WSP(const int, WS_ROWMAP)}; \
            pg8::MoeOrder S; S.init(WSP(const int, WS_TEXP), 8, C.G, C.bid); pg8::EpiSwiglu E{WSP(pg8::bf16_t, WS_HID), INP(27) + (size_t)layer * NE * 2 * DE}; \
            pg8::gemm_phase<pg8::EpiSwiglu, pg8::MoeOrder, true, true, true>(C.lds, g, S, E); } SEAM(p0 + 8); \
        if (PHON(13) && IN(p0 + 9)) REP(13) { CTX(); pg8::Gemm g{WSP(const pg8::bf16_t, WS_HID), WSP(const pg8::bf16_t, WS_WDN) + (size_t)layer * NE * D * DE, P_ROWS, NE * D, DE}; \
            pg8::MoeOrder S; S.init(WSP(const int, WS_TEXP), 4, C.G, C.bid); pg8::EpiDown E{WSP(unsigned char, WS_YS), INP(29) + (size_t)layer * NE * D}; \
            pg8::gemm_phase<pg8::EpiDown, pg8::MoeOrder, true, true>(C.lds, g, S, E); } SEAM(p0 + 9); \
    }
    static_assert(DEPTH <= 4, "layer sites");
    if constexpr (DEPTH > 0) LAYER_BODY(0)
    if constexpr (DEPTH > 1) LAYER_BODY(1)
    if constexpr (DEPTH > 2) LAYER_BODY(2)
    if constexpr (DEPTH > 3) LAYER_BODY(3)
#undef LAYER_BODY
    if (PHON(1) && IN(N_PHASES - 1)) REP(16) { CTX(); ph_norm_mix(C, DEPTH); }
#undef IN
#undef SEAM
}

#ifndef EMU
#ifndef FULL_MASK_V
#define FULL_MASK_V 0x3fff
#endif
constexpr int FULL_MASK = FULL_MASK_V;
typedef void (*kern_t)(Args);
static int phase_mask(int p) {
    if (p == 0) return 1; if (p == N_PHASES - 1) return 2;
    const int k = (p - 1) % PH_PER_LAYER; const int m[10] = {2, 4, 8 | 32, 16 | 64 | 128, 256, 512, 1024, 2048, 4096, 8192}; return m[k];
}
static kern_t kern_of_mask(int m) {
    switch (m) {
#if MK_N_LAUNCHES == 1
        case FULL_MASK: return mk_fwd<FULL_MASK>;
#else
        case 1: return mk_fwd<1>; case 2: return mk_fwd<2>; case 4: return mk_fwd<4>; case 8: return mk_fwd<8>; case 16: return mk_fwd<16>; case 32: return mk_fwd<32>; case 192: return mk_fwd<192>; case 256: return mk_fwd<256>;
        case 512: return mk_fwd<512>; case 1024: return mk_fwd<1024>; case 2048: return mk_fwd<2048>; case 4096: return mk_fwd<4096>; case 8192: return mk_fwd<8192>;
#endif
        default: return nullptr;
    }
}
extern "C" void kernel_launch(void* const* d_in, const int* in_sizes, int n_in, void* d_out, int out_size, void* d_ws, size_t ws_size, hipStream_t stream) {
    static int grid = 0;
    if (grid == 0) {
        if (n_in != 31 || in_sizes[0] != T_L * D || out_size != T_L * D || ws_size < WS_END) { fprintf(stderr, "kernel_launch: shape/workspace mismatch (n_in %d, in0 %d, out %d, ws %zu, need %zu)\n", n_in, n_in > 0 ? in_sizes[0] : -1, out_size, ws_size, (size_t)WS_END); grid = -1; return; }
        int dev = 0, cus = 0;
        if (hipGetDevice(&dev) != hipSuccess || hipDeviceGetAttribute(&cus, hipDeviceAttributeMultiprocessorCount, dev) != hipSuccess) { grid = -1; return; }
#if MK_N_LAUNCHES == 1
        const int masks[1] = {FULL_MASK}; const int nm = 1;
#else
        const int masks[13] = {1, 2, 4, 8, 16, 32, 192, 256, 512, 1024, 2048, 4096, 8192}; const int nm = 13;
#endif
        for (int i = 0; i < nm; ++i) {
            if (hipFuncSetAttribute((const void*)kern_of_mask(masks[i]), hipFuncAttributeMaxDynamicSharedMemorySize, LDS_BYTES) != hipSuccess) { fprintf(stderr, "kernel_launch: hipFuncSetAttribute failed\n"); grid = -1; return; }
            int per_cu = 0;
            if (hipOccupancyMaxActiveBlocksPerMultiprocessor(&per_cu, (const void*)kern_of_mask(masks[i]), 512, LDS_BYTES) != hipSuccess || per_cu < 1) fprintf(stderr, "kernel_launch: occupancy query reports %d for mask %d\n", per_cu, masks[i]);
        }
        (void)hipGetLastError();
        grid = cus;
        if (grid > 1024) grid = 1024;
    }
    if (grid < 0) return;
    if (hipMemsetAsync((char*)d_ws + WS_CTL, 0, (CW_BAR + XCD_BAR_WORDS) * sizeof(unsigned), stream) != hipSuccess) return;
    Args a{};
    for (int i = 0; i < 31; ++i) a.in[i] = (const float*)d_in[i];
    a.out = (float*)d_out; a.ws = (unsigned char*)d_ws;
#if MK_N_LAUNCHES == 1
    a.ph_lo = 0; a.ph_hi = N_PHASES;
    hipLaunchKernelGGL(mk_fwd<FULL_MASK>, dim3(grid), dim3(512), LDS_BYTES, stream, a);
#else
    for (int p = 0; p < N_PHASES; ++p) { a.ph_lo = p; a.ph_hi = p + 1; const int pm = phase_mask(p);
        for (int bit = 0; bit < 14; ++bit) { int m = pm & (1 << bit); if (!m) continue; if (m == 64 || m == 128) { if (m == 128) continue; m = 192; } hipLaunchKernelGGL(kern_of_mask(m), dim3(grid), dim3(512), LDS_BYTES, stream, a); } }
#endif
}
#endif
```

```cpp
#ifndef EMU
#include <hip/hip_runtime.h>
#include <cstdio>
#include <cstdint>
#endif

#ifndef MK_N_LAUNCHES
#define MK_N_LAUNCHES 1
#endif

#ifndef CFG_BATCH
#define CFG_BATCH 8
#define CFG_SEQ 4096
#define CFG_CTX 256
#define CFG_DEPTH 4
#endif
constexpr int NB = CFG_BATCH, SEQ = CFG_SEQ, LC = CFG_CTX, DEPTH = CFG_DEPTH, D = 1024;
constexpr int GRID_W = 64;
constexpr int T_L = NB * SEQ, T_C = NB * LC, T_ALL = T_L + T_C;
constexpr int D_IN = 2832, N_PROJ = 2816;
constexpr int NKEY = SEQ + LC;
constexpr int NE = 32, TOPK = 4, DE = 1024;
constexpr int NCH_L = SEQ / 64, NCH_C = LC / 64, NCH = NCH_L + NCH_C;
constexpr int MAX_TILES = (T_ALL * TOPK) / 256 + NE;
constexpr int P_ROWS = MAX_TILES * 256;
constexpr float NORM_EPS = 1e-6f;
static_assert(SEQ % 256 == 0 && LC % 128 == 0 && T_ALL % 256 == 0 && (T_ALL * TOPK) % 256 == 0, "tiling");
constexpr int C_AQ = 0, C_AK = 256, C_AV = 384, C_BU = 512, C_BV = 768, C_CQ = 1024, C_CK = 1280, C_CV = 1536, C_DQKV = 1792, C_DZ = 2560, C_DB = 2816, C_DA = 2824;

#ifndef EMU
#define GAS __attribute__((address_space(1)))
#define LAS __attribute__((address_space(3)))
#define DEVI __device__ __forceinline__
#define LDS_WAIT() asm volatile("s_waitcnt lgkmcnt(0)" ::: "memory")
#define VM_WAIT() asm volatile("s_waitcnt vmcnt(0)" ::: "memory")
#define LAUNDER_V(x) asm volatile("" : "+v"(x))
#define LAUNDER_S(x) asm volatile("" : "+s"(x))
#endif
typedef unsigned short bf16;
typedef unsigned v4u __attribute__((ext_vector_type(4)));
typedef unsigned v2u __attribute__((ext_vector_type(2)));
typedef float f32x4 __attribute__((ext_vector_type(4)));
typedef float f32x2 __attribute__((ext_vector_type(2)));
typedef short bf16x8 __attribute__((ext_vector_type(8)));
typedef GAS unsigned gu32;
#define RLX_AGENT __ATOMIC_RELAXED, __HIP_MEMORY_SCOPE_AGENT
typedef __bf16 hbf2_t __attribute__((ext_vector_type(2)));
DEVI unsigned pk2(float lo, float hi) { const f32x2 v = {lo, hi}; return __builtin_bit_cast(unsigned, __builtin_convertvector(v, hbf2_t)); }
DEVI unsigned f2bf(float f) { return pk2(f, 0.f) & 0xffffu; }
DEVI float bf2f(unsigned h) { return __builtin_bit_cast(float, (h & 0xffffu) << 16); }
DEVI float bflo(unsigned w) { return __builtin_bit_cast(float, w << 16); }
DEVI float bfhi(unsigned w) { return __builtin_bit_cast(float, w & 0xffff0000u); }
DEVI float fast_exp(float x) { return __builtin_amdgcn_exp2f(x * 1.4426950408889634f); }
DEVI float fast_rcp(float x) { return __builtin_amdgcn_rcpf(x); }
DEVI float sigmoidf_(float x) { return fast_rcp(1.f + fast_exp(-x)); }
DEVI float siluf_(float x) { return x * sigmoidf_(x); }
DEVI float tanh_fast(float x) { const float e = fast_exp(-2.f * __builtin_fabsf(x)); const float t = (1.f - e) * fast_rcp(1.f + e); return x < 0.f ? -t : t; }
DEVI float gelu_tanh(float x) { return 0.5f * x * (1.f + tanh_fast(0.7978845608028654f * (x + 0.044715f * x * x * x))); }
DEVI float softplusf_(float x) { return x > 20.f ? x : __builtin_amdgcn_logf(1.f + fast_exp(x)) * 0.6931471805599453f; }
DEVI float wave_sum(float v) {
#pragma unroll
    for (int o = 1; o < 64; o <<= 1) v += __shfl_xor(v, o);
    return v;
}
template <int W> DEVI float group_sum(float v) {
#pragma unroll
    for (int o = 1; o < W; o <<= 1) v += __shfl_xor(v, o);
    return v;
}

constexpr size_t al256(size_t x) { return (x + 255) & ~(size_t)255; }
constexpr size_t WS_CTL = 0, CTL_ZERO_BYTES = 1u << 20;
constexpr size_t WS_MOD   = CTL_ZERO_BYTES;
constexpr size_t WS_WIN   = WS_MOD   + al256((size_t)DEPTH * 9 * 6 * D * 4);
constexpr size_t WS_WOUT  = WS_WIN   + al256((size_t)DEPTH * N_PROJ * D * 2);
constexpr size_t WS_WUP   = WS_WOUT  + al256((size_t)DEPTH * D * D * 2);
constexpr size_t WS_WDN   = WS_WUP   + al256((size_t)DEPTH * NE * 2 * DE * D * 2);
constexpr size_t WS_H     = WS_WDN   + al256((size_t)DEPTH * NE * D * DE * 2);
constexpr size_t WS_F     = WS_H     + al256((size_t)T_ALL * D * 2);
constexpr size_t WS_BA    = WS_F     + al256((size_t)T_ALL * D * 2);
constexpr size_t WS_PROJ  = WS_BA    + al256((size_t)T_ALL * 16 * 4);
constexpr size_t WS_XRES  = WS_PROJ  + al256((size_t)T_ALL * N_PROJ * 2);
constexpr size_t WS_MIX   = WS_XRES  + al256((size_t)T_ALL * D * 4);
constexpr size_t WS_QL    = WS_MIX   + al256((size_t)T_ALL * D * 2);
constexpr size_t WS_QC    = WS_QL    + al256((size_t)NB * 12 * SEQ * 64 * 2);
constexpr size_t WS_K     = WS_QC    + al256((size_t)NB * 12 * LC * 64 * 2);
constexpr size_t WS_V     = WS_K     + al256((size_t)NB * 6 * NKEY * 64 * 2);
constexpr size_t WS_OD    = WS_V     + al256((size_t)NB * 6 * NKEY * 64 * 2);
constexpr size_t WS_DNO   = WS_OD    + al256((size_t)2 * T_ALL * 256 * 2);
constexpr size_t WS_DNF   = WS_DNO   + al256((size_t)2 * T_ALL * 256 * 4);
constexpr size_t DN_UNIT_BYTES = 32768;
constexpr size_t WS_HID   = WS_DNF   + al256((size_t)NB * 2 * 4 * NCH * DN_UNIT_BYTES);
constexpr size_t WS_YS    = WS_HID   + al256((size_t)P_ROWS * DE * 2);
constexpr size_t WS_TOKE  = WS_YS    + al256((size_t)P_ROWS * D * 2);
constexpr size_t WS_TOKG  = WS_TOKE  + al256((size_t)T_ALL * 4 * 4);
constexpr size_t WS_TOKP  = WS_TOKG  + al256((size_t)T_ALL * 4 * 4);
constexpr size_t WS_SLOT  = WS_TOKP  + al256((size_t)T_ALL * 4 * 4);
constexpr size_t WS_BCNT  = WS_SLOT  + al256((size_t)T_ALL * 4 * 4);
constexpr size_t WS_TEXP  = WS_BCNT  + al256((size_t)1024 * 32 * 4);
constexpr size_t WS_RWP   = WS_TEXP  + al256((size_t)(MAX_TILES + 64) * 4);
constexpr size_t WS_RBP   = WS_RWP   + al256((size_t)DEPTH * 9 * NE * D * 4);
constexpr size_t WS_ROWMAP = WS_RBP  + al256((size_t)DEPTH * 9 * NE * 4);
constexpr size_t WS_ROPE  = WS_ROWMAP + al256((size_t)P_ROWS * 4);
constexpr size_t WS_END   = WS_ROPE  + al256((size_t)SEQ * 96 * 4);
constexpr int CW_TMO = 0, CW_CODE = 1, CW_BAR = 4096;
namespace pg8 {
#define PG8_LAS __attribute__((address_space(3)))
typedef unsigned short bf16_t;
typedef short bf16x8 __attribute__((ext_vector_type(8)));
typedef float f32x4 __attribute__((ext_vector_type(4)));
typedef unsigned u32x4 __attribute__((ext_vector_type(4)));
constexpr int BM = 256, BK = 64, HALF = 128, HTB = HALF * BK * 2  , STAGE_BYTES = 8 * HTB, NXCD = 8, WGM = 8;

__host__ __device__ __forceinline__ int lds_byte(int r, int c) { const int st = (r >> 4) * 2 + (c >> 5), rr = r & 15, cc = c & 31, ob = rr * 64 + cc * 2; return st * 1024 + (ob ^ (((ob >> 9) & 1) << 5)); }
__host__ __device__ __forceinline__ void stage_rc(int b, int& R, int& C) { const int st = b / 1024, sb = b % 1024, swz = sb ^ (((sb >> 9) & 1) << 5); R = (st >> 1) * 16 + swz / 64; C = (st & 1) * 32 + (swz % 64) / 2; }
__host__ __device__ __forceinline__ int perm32(int rho) { const int n = rho >> 4, i = rho & 15; return 8 * (i >> 2) + 4 * n + (i & 3); }

struct Unit { int pm, pn; };
struct Gemm { const bf16_t* A; const bf16_t* Bt; int M, N, K; const int* rowmap = nullptr; };

struct StaticOrder {
    int nM, nN, nwg, G, c;
    __host__ __device__ void init(int M, int N, int G_, int c_) { nM = M / BM; nN = N / BM; nwg = nM * nN; G = G_; c = c_; }
    __host__ __device__ bool next(int i, Unit& u) const {
        const long L = (long)i * G + c; if (L >= nwg) return false;
        int wgid = (int)L; { const int q = nwg / NXCD, r = nwg % NXCD, xcd = wgid % NXCD, off = wgid / NXCD; wgid = (xcd < r ? xcd * (q + 1) : r * (q + 1) + (xcd - r) * q) + off; }
        const int nig = WGM * nN, gid = wgid / nig, fm = gid * WGM, gsz = (nM - fm) < WGM ? (nM - fm) : WGM;
        u.pm = fm + ((wgid % nig) % gsz); u.pn = (wgid % nig) / gsz; return true;
    }
    __device__ __forceinline__ void a_ready(const Unit&) const {}
    __device__ __forceinline__ void done(const Unit&) const {}
};

#ifndef EMU
__device__ __forceinline__ unsigned cvt_pk_bf16(float lo, float hi) { unsigned r; asm volatile("v_cvt_pk_bf16_f32 %0, %1, %2" : "=v"(r) : "v"(lo), "v"(hi)); return r; }
#else
__device__ __forceinline__ unsigned cvt_pk_bf16(float lo, float hi) { return pk2(lo, hi); }
#endif
typedef float f32x2 __attribute__((ext_vector_type(2)));
__device__ __forceinline__ f32x2 gelu_pk(f32x2 v) {
    const f32x2 av = __builtin_elementwise_abs(v), d = av * 0.2316418882f + 1.0f;
    f32x2 t; t.x = __builtin_amdgcn_rcpf(d.x); t.y = __builtin_amdgcn_rcpf(d.y);
    f32x2 q = t * 0.5307027145f + (-0.7265760135f); q = q * t + 0.7107068705f; q = q * t + (-0.142248368f); q = q * t + 0.127414796f; q = q * t;
    const f32x2 s = (v * v) * (-0.72134752044f);
    f32x2 e; e.x = __builtin_amdgcn_exp2f(s.x); e.y = __builtin_amdgcn_exp2f(s.y);
    const f32x2 m = v * (q * e), r = v - m;
    f32x2 o; o.x = v.x < 0.f ? m.x : r.x; o.y = v.y < 0.f ? m.y : r.y; return o;
}

template <int ACT  > struct EpiBf16 {
    static constexpr bool PERM = true, AFTER_DRAIN = false; static_assert(ACT == 0 || ACT == 1, "EpiBf16: ACT is 0 (none) or 1 (gelu_pk)");
    bf16_t* O; int ldc; const float* bias; int split_cols; size_t split_stride; float scale0;
    __device__ __forceinline__ void operator()(const f32x4 (&acc)[2][2][4][2], const Unit& u, int wr, int wc, int fr, int fq) const {
        const int row0 = u.pm * BM + wr * 64 + fr; int colt = u.pn * BM; bf16_t* base = O;
        float sc = 1.f; if (split_cols) { const int t = colt / split_cols; base += (size_t)t * split_stride; colt -= t * split_cols; if (t == 0) sc = scale0; }
        const int col0 = colt + wc * 32 + 8 * fq, bcol0 = u.pn * BM + wc * 32 + 8 * fq;
        f32x4 bv[2][2];
#pragma unroll
        for (int bj = 0; bj < 2; ++bj)
#pragma unroll
            for (int n = 0; n < 2; ++n) bv[bj][n] = bias ? *(const f32x4*)(bias + bcol0 + bj * HALF + 4 * n) : (f32x4){0.f, 0.f, 0.f, 0.f};
#pragma unroll
        for (int ai = 0; ai < 2; ++ai)
#pragma unroll
            for (int m = 0; m < 4; ++m) { bf16_t* rowp = base + (size_t)(row0 + ai * HALF + m * 16) * ldc + col0;
#pragma unroll
                for (int bj = 0; bj < 2; ++bj) { f32x4 v0 = acc[ai][bj][m][0] + bv[bj][0], v1 = acc[ai][bj][m][1] + bv[bj][1];
                    if (ACT == 1) { f32x2 a = gelu_pk((f32x2){v0[0], v0[1]}), b = gelu_pk((f32x2){v0[2], v0[3]}), c = gelu_pk((f32x2){v1[0], v1[1]}), d = gelu_pk((f32x2){v1[2], v1[3]});
                        v0 = (f32x4){a.x, a.y, b.x, b.y}; v1 = (f32x4){c.x, c.y, d.x, d.y}; }
                    v0 = v0 * sc; v1 = v1 * sc; u32x4 w; w.x = cvt_pk_bf16(v0[0], v0[1]); w.y = cvt_pk_bf16(v0[2], v0[3]); w.z = cvt_pk_bf16(v1[0], v1[1]); w.w = cvt_pk_bf16(v1[2], v1[3]);
                    *(u32x4*)(rowp + bj * HALF) = w; } }
    }
};

template <bool IN_F32> struct EpiOutRes {
    static constexpr bool PERM = true, AFTER_DRAIN = false;
    const void* xin_l; const void* xin_c;
    bf16_t* xres; const float* mod;
    __device__ __forceinline__ void operator()(const f32x4 (&acc)[2][2][4][2], const Unit& u, int wr, int wc, int fr, int fq) const {
        const int rowt = u.pm * BM; const bool isc = rowt >= T_L; const int mrow = isc ? 8 : rowt / SEQ;
        const float* g = mod + (size_t)(mrow * 6 + 2) * D;
        const size_t inoff = isc ? (size_t)(rowt - T_L) * D : (size_t)rowt * D;
        const float* xf = (const float*)(isc ? xin_c : xin_l) + inoff; const bf16_t* xb = (const bf16_t*)(isc ? xin_c : xin_l) + inoff;
        bf16_t* xo = xres + (size_t)rowt * D;
        const int col0 = u.pn * BM + wc * 32 + 8 * fq;
        f32x4 gv[2][2];
#pragma unroll
        for (int bj = 0; bj < 2; ++bj)
#pragma unroll
            for (int n = 0; n < 2; ++n) gv[bj][n] = *(const f32x4*)(g + col0 + bj * HALF + 4 * n);
#pragma unroll
        for (int ai = 0; ai < 2; ++ai)
#pragma unroll
          for (int mp = 0; mp < 2; ++mp) {
            f32x4 xi[2][2][2];
#pragma unroll
            for (int m2 = 0; m2 < 2; ++m2) { const size_t ro = (size_t)(ai * HALF + wr * 64 + (2 * mp + m2) * 16 + fr) * D + col0;
#pragma unroll
                for (int bj = 0; bj < 2; ++bj) {
                    if constexpr (IN_F32) { xi[m2][bj][0] = *(const f32x4*)(xf + ro + bj * HALF); xi[m2][bj][1] = *(const f32x4*)(xf + ro + bj * HALF + 4); }
                    else { const u32x4 w = *(const u32x4*)(xb + ro + bj * HALF);
                        xi[m2][bj][0] = (f32x4){bflo(w.x), bfhi(w.x), bflo(w.y), bfhi(w.y)}; xi[m2][bj][1] = (f32x4){bflo(w.z), bfhi(w.z), bflo(w.w), bfhi(w.w)}; } } }
#pragma unroll
            for (int m2 = 0; m2 < 2; ++m2) { const int m = 2 * mp + m2; const size_t ro = (size_t)(ai * HALF + wr * 64 + m * 16 + fr) * D + col0;
#pragma unroll
                for (int bj = 0; bj < 2; ++bj) { const f32x4 v0 = xi[m2][bj][0] + gv[bj][0] * acc[ai][bj][m][0], v1 = xi[m2][bj][1] + gv[bj][1] * acc[ai][bj][m][1];
                    u32x4 w; w.x = cvt_pk_bf16(v0[0], v0[1]); w.y = cvt_pk_bf16(v0[2], v0[3]); w.z = cvt_pk_bf16(v1[0], v1[1]); w.w = cvt_pk_bf16(v1[2], v1[3]);
                    *(u32x4*)(xo + ro + bj * HALF) = w; } } }
    }
};
struct EpiSwiglu {
    static constexpr bool PERM = true, AFTER_DRAIN = false;
    bf16_t* hid; const float* bup;
    __device__ __forceinline__ void operator()(const f32x4 (&acc)[2][2][4][2], const Unit& u, int wr, int wc, int fr, int fq) const {
        const int e = u.pn >> 3, j = u.pn & 7; const int h0 = j * HALF + wc * 32 + 8 * fq;
        const float* bg = bup + (size_t)e * 2 * DE + h0; const float* bu = bg + DE;
        f32x4 vg[2], vu[2];
#pragma unroll
        for (int n = 0; n < 2; ++n) { vg[n] = *(const f32x4*)(bg + 4 * n); vu[n] = *(const f32x4*)(bu + 4 * n); }
#pragma unroll
        for (int ai = 0; ai < 2; ++ai)
#pragma unroll
            for (int m = 0; m < 4; ++m) { const size_t row = (size_t)u.pm * BM + ai * HALF + wr * 64 + m * 16 + fr; float o[8];
#pragma unroll
                for (int n = 0; n < 2; ++n) { const f32x4 gt = acc[ai][0][m][n] + vg[n], up = acc[ai][1][m][n] + vu[n];
#pragma unroll
                    for (int i = 0; i < 4; ++i) { const float gg = __builtin_fminf(gt[i], 7.0f); const float uu = __builtin_fminf(__builtin_fmaxf(up[i], -7.0f), 7.0f);
                        o[4 * n + i] = gg * sigmoidf_(1.702f * gg) * (uu + 1.0f); } }
                u32x4 w; w.x = cvt_pk_bf16(o[0], o[1]); w.y = cvt_pk_bf16(o[2], o[3]); w.z = cvt_pk_bf16(o[4], o[5]); w.w = cvt_pk_bf16(o[6], o[7]);
                *(u32x4*)(hid + row * DE + h0) = w; }
    }
};
struct EpiDown {
    static constexpr bool PERM = true, AFTER_DRAIN = false;
    unsigned char* ys; const float* bdn;
    __device__ __forceinline__ void operator()(const f32x4 (&acc)[2][2][4][2], const Unit& u, int wr, int wc, int fr, int fq) const {
        typedef unsigned u32x2v __attribute__((ext_vector_type(2)));
        const int e = u.pn >> 2, j = u.pn & 3; const int col0 = j * BM + wc * 32 + 8 * fq;
        f32x4 bv[2][2];
#pragma unroll
        for (int bj = 0; bj < 2; ++bj)
#pragma unroll
            for (int n = 0; n < 2; ++n) bv[bj][n] = *(const f32x4*)(bdn + (size_t)e * D + col0 + bj * HALF + 4 * n);
#pragma unroll
        for (int ai = 0; ai < 2; ++ai)
#pragma unroll
            for (int m = 0; m < 4; ++m) { const size_t row = (size_t)u.pm * BM + ai * HALF + wr * 64 + m * 16 + fr;
#pragma unroll
                for (int bj = 0; bj < 2; ++bj) { const f32x4 v0 = acc[ai][bj][m][0] + bv[bj][0], v1 = acc[ai][bj][m][1] + bv[bj][1];
                    int w0 = 0, w1 = 0;
                    w0 = __builtin_amdgcn_cvt_pk_fp8_f32(v0[0], v0[1], w0, false); w0 = __builtin_amdgcn_cvt_pk_fp8_f32(v0[2], v0[3], w0, true);
                    w1 = __builtin_amdgcn_cvt_pk_fp8_f32(v1[0], v1[1], w1, false); w1 = __builtin_amdgcn_cvt_pk_fp8_f32(v1[2], v1[3], w1, true);
                    *(u32x2v*)(ys + row * D + col0 + bj * HALF) = (u32x2v){(unsigned)w0, (unsigned)w1}; } }
    }
};
struct MoeOrder {
    const int* texp; int ntiles, nN, nwg, G, c;
    __device__ __forceinline__ void init(const int* texp_, int nN_, int G_, int c_) { texp = texp_; ntiles = texp_[0]; nN = nN_; nwg = ntiles * nN_; G = G_; c = c_; }
    __device__ __forceinline__ bool next(int i, Unit& u) const {
        const long L = (long)i * G + c; if (L >= nwg) return false;
        int wgid = (int)L; { const int q = nwg / NXCD, r = nwg % NXCD, xcd = wgid % NXCD, off = wgid / NXCD; wgid = (xcd < r ? xcd * (q + 1) : r * (q + 1) + (xcd - r) * q) + off; }
        const int nig = WGM * nN, gid = wgid / nig, fm = gid * WGM, gsz = (ntiles - fm) < WGM ? (ntiles - fm) : WGM;
        const int pm = fm + ((wgid % nig) % gsz); u.pm = pm; u.pn = texp[1 + pm] * nN + (wgid % nig) / gsz; return true;
    }
    __device__ __forceinline__ void a_ready(const Unit&) const {}
    __device__ __forceinline__ void done(const Unit&) const {}
};
#ifndef EMU
template <class Epi, class Sched, bool ALIGN_EPI = false, bool SP2 = false, bool GATHER = false>
__device__ __forceinline__ void gemm_phase(PG8_LAS unsigned char* lds, const Gemm g, const Sched& S, const Epi& E) {
    int tid_ = threadIdx.x; asm volatile("" : "+v"(tid_));
    const int tid = tid_, wid = __builtin_amdgcn_readfirstlane(tid >> 6), lane = tid & 63, wr = wid >> 2, wc = wid & 3, fr = lane & 15, fq = lane >> 4;
    const int K = g.K, nt = K / BK;
    unsigned voffA[2], voffB[2]; int gR[2], gC[2];
#pragma unroll
    for (int i = 0; i < 2; ++i) { int R, C; stage_rc(tid * 16 + i * 8192, R, C); const int Rb = Epi::PERM ? ((R & ~31) + perm32(R & 31)) : R;
        voffA[i] = (unsigned)(R * K + C) * 2u; voffB[i] = (unsigned)(Rb * K + C) * 2u; gR[i] = R; gC[i] = C; }
    unsigned voffC[2][2], voffN[2][2];
#define PG8_GOFF(dst, pm_) do { _Pragma("unroll") for (int h_ = 0; h_ < 2; ++h_) _Pragma("unroll") for (int i_ = 0; i_ < 2; ++i_) \
        dst[h_][i_] = (unsigned)(g.rowmap[(size_t)(pm_) * BM + h_ * HALF + gR[i_]] * K + gC[i_]) * 2u; } while (0)
    const size_t kstep = (size_t)(BK * 2);
    const size_t hstep = (size_t)HALF * K * 2;
    const size_t tstep = 2 * hstep;
    const unsigned ldsw = (unsigned)wid * 1024u;
    const int aoff = lds_byte(wr * 64 + fr, fq * 8), boff = lds_byte(wc * 32 + fr, fq * 8);
#define PG8_SA(b, h) (((b) * 2 + (h)) * HTB)
#define PG8_SB(b, h) ((4 + (b) * 2 + (h)) * HTB)
#define PG8_STAGE(bufoff, gbase, voff) do { _Pragma("unroll") for (int _i = 0; _i < 2; ++_i) \
        __builtin_amdgcn_global_load_lds((const unsigned*)((const char*)(gbase) + (voff)[_i]), (PG8_LAS unsigned*)(lds + (bufoff) + ldsw + _i * 8192), 16, 0, 0); } while (0)
#define PG8_LDA(dst, b, h) do { _Pragma("unroll") for (int m = 0; m < 4; ++m) _Pragma("unroll") for (int k = 0; k < 2; ++k) dst[m][k] = *(const PG8_LAS bf16x8*)(lds + PG8_SA(b, h) + aoff + m * 2048 + k * 1024); } while (0)
#define PG8_LDB(dst, b, h) do { _Pragma("unroll") for (int n = 0; n < 2; ++n) _Pragma("unroll") for (int k = 0; k < 2; ++k) dst[n][k] = *(const PG8_LAS bf16x8*)(lds + PG8_SB(b, h) + boff + n * 2048 + k * 1024); } while (0)
#define PG8_MMA(ai, bj, At, Bt) do { __builtin_amdgcn_s_setprio(1); _Pragma("unroll") for (int m = 0; m < 4; ++m) _Pragma("unroll") for (int n = 0; n < 2; ++n) _Pragma("unroll") for (int k = 0; k < 2; ++k) \
        acc[ai][bj][m][n] = __builtin_amdgcn_mfma_f32_16x16x32_bf16(Bt[n][k], At[m][k], acc[ai][bj][m][n], 0, 0, 0); __builtin_amdgcn_s_setprio(0); } while (0)
#define PG8_WAIT_V(n) asm volatile("s_waitcnt vmcnt(" #n ")" ::: "memory")
#define PG8_WAIT_L(n) asm volatile("s_waitcnt lgkmcnt(" #n ")" ::: "memory")
#define PG8_BAR __builtin_amdgcn_s_barrier()
#define PG8_SCHED __builtin_amdgcn_sched_barrier(0)
#define PG8_STAGEA(bufoff, gbase, h, nx) do { if constexpr (GATHER) { _Pragma("unroll") for (int _i = 0; _i < 2; ++_i) { const unsigned o_ = (nx) ? voffN[h][_i] : voffC[h][_i]; \
        __builtin_amdgcn_global_load_lds((const unsigned*)((const char*)(gbase) + o_), (PG8_LAS unsigned*)(lds + (bufoff) + ldsw + _i * 8192), 16, 0, 0); } } \
    else { PG8_STAGE(bufoff, (gbase) + (h) * hstep, voffA); } } while (0)
    Unit cur, nxt; int ui = 0;
    if (!S.next(0, cur)) return;
    f32x4 acc[2][2][4][2];
#pragma unroll
    for (int a = 0; a < 2; ++a)
#pragma unroll
        for (int b = 0; b < 2; ++b)
#pragma unroll
            for (int m = 0; m < 4; ++m)
#pragma unroll
                for (int n = 0; n < 2; ++n) acc[a][b][m][n] = (f32x4){0.f, 0.f, 0.f, 0.f};
    bf16x8 At[4][2], B0[2][2], B1[2][2];
    const char* cA = (const char*)g.A + (GATHER ? (size_t)0 : (size_t)cur.pm * tstep); if constexpr (GATHER) { PG8_GOFF(voffC, cur.pm); }
    const char* cB = (const char*)g.Bt + (size_t)cur.pn * tstep;
    S.a_ready(cur);
    if constexpr (SP2) {
        PG8_STAGE(PG8_SB(0, 0), cB, voffB); PG8_STAGE(PG8_SB(0, 1), cB + hstep, voffB); PG8_STAGEA(PG8_SA(0, 0), cA, 0, false); PG8_STAGEA(PG8_SA(0, 1), cA, 1, false);
        if (wr == 1) PG8_BAR;
        PG8_WAIT_V(2); PG8_BAR;
        PG8_STAGE(PG8_SB(1, 0), cB + kstep, voffB); PG8_STAGEA(PG8_SA(1, 0), cA + kstep, 0, false); PG8_STAGE(PG8_SB(1, 1), cB + hstep + kstep, voffB);
        PG8_WAIT_V(6); PG8_BAR;
    } else {
        PG8_STAGE(PG8_SB(0, 0), cB, voffB); PG8_STAGEA(PG8_SA(0, 0), cA, 0, false); PG8_STAGE(PG8_SB(0, 1), cB + hstep, voffB); PG8_STAGEA(PG8_SA(0, 1), cA, 1, false);
        if (wr == 1) PG8_BAR;
        PG8_WAIT_V(4); PG8_BAR;
        PG8_STAGE(PG8_SB(1, 0), cB + kstep, voffB); PG8_STAGEA(PG8_SA(1, 0), cA + kstep, 0, false); PG8_STAGE(PG8_SB(1, 1), cB + hstep + kstep, voffB);
        PG8_WAIT_V(6); PG8_BAR;
    }
    for (;;) {
        const bool has_next = S.next(ui + 1, nxt);
        if constexpr (GATHER) { if (has_next) { PG8_GOFF(voffN, nxt.pm); } else { _Pragma("unroll") for (int h_ = 0; h_ < 2; ++h_) _Pragma("unroll") for (int i_ = 0; i_ < 2; ++i_) voffN[h_][i_] = voffC[h_][i_]; } }
        const char* nA = (has_next && !GATHER) ? (const char*)g.A + (size_t)nxt.pm * tstep : cA; const char* nB = has_next ? (const char*)g.Bt + (size_t)nxt.pn * tstep : cB;
        for (int t = 0; t < nt; t += 2) {
            const bool last = (t == nt - 2);
            const char* a1 = cA + (size_t)(t + 1) * kstep;
            const char* a2 = last ? nA : cA + (size_t)(t + 2) * kstep; const char* b2 = last ? nB : cB + (size_t)(t + 2) * kstep;
            const char* a3 = a2 + kstep; const char* b3 = b2 + kstep;
            if (last && has_next) S.a_ready(nxt);
            if constexpr (SP2) {
            PG8_LDB(B0, 0, 0); PG8_LDB(B1, 0, 1); PG8_SCHED; PG8_LDA(At, 0, 0); PG8_STAGEA(PG8_SA(1, 1), a1, 1, false);
            PG8_WAIT_V(8); PG8_WAIT_L(0); PG8_BAR; PG8_MMA(0, 0, At, B0); PG8_MMA(0, 1, At, B1); PG8_BAR; PG8_SCHED;
            PG8_LDA(At, 0, 1); PG8_STAGE(PG8_SB(0, 0), b2, voffB); PG8_STAGE(PG8_SB(0, 1), b2 + hstep, voffB); PG8_STAGEA(PG8_SA(0, 0), a2, 0, last);
            PG8_WAIT_V(8); PG8_WAIT_L(0); PG8_BAR; PG8_MMA(1, 0, At, B0); PG8_MMA(1, 1, At, B1); PG8_BAR; PG8_SCHED;
            PG8_LDB(B0, 1, 0); PG8_LDB(B1, 1, 1); PG8_SCHED; PG8_LDA(At, 1, 0); PG8_STAGEA(PG8_SA(0, 1), a2, 1, last);
            PG8_WAIT_V(8); PG8_WAIT_L(0); PG8_BAR; PG8_MMA(0, 0, At, B0); PG8_MMA(0, 1, At, B1); PG8_BAR; PG8_SCHED;
            PG8_LDA(At, 1, 1); PG8_STAGE(PG8_SB(1, 0), b3, voffB); PG8_STAGE(PG8_SB(1, 1), b3 + hstep, voffB); PG8_STAGEA(PG8_SA(1, 0), a3, 0, last);
            PG8_WAIT_V(8); PG8_WAIT_L(0); PG8_BAR; PG8_MMA(1, 0, At, B0); PG8_MMA(1, 1, At, B1); PG8_BAR; PG8_SCHED;
            } else {
            PG8_LDB(B0, 0, 0); PG8_SCHED; PG8_LDA(At, 0, 0); PG8_STAGEA(PG8_SA(1, 1), a1, 1, false);
            PG8_WAIT_L(8); PG8_BAR; PG8_WAIT_L(0); PG8_MMA(0, 0, At, B0); PG8_BAR; PG8_SCHED;
            PG8_LDB(B1, 0, 1); PG8_STAGE(PG8_SB(0, 0), b2, voffB);
            PG8_BAR; PG8_WAIT_L(0); PG8_MMA(0, 1, At, B1); PG8_BAR;
            PG8_LDA(At, 0, 1); PG8_STAGEA(PG8_SA(0, 0), a2, 0, last);
            PG8_BAR; PG8_WAIT_L(0); PG8_MMA(1, 0, At, B0); PG8_BAR; PG8_SCHED;
            PG8_STAGE(PG8_SB(0, 1), b2 + hstep, voffB);
            PG8_WAIT_V(6); PG8_BAR; PG8_MMA(1, 1, At, B1); PG8_BAR;
            PG8_LDB(B0, 1, 0); PG8_SCHED; PG8_LDA(At, 1, 0); PG8_STAGEA(PG8_SA(0, 1), a2, 1, last);
            PG8_WAIT_L(8); PG8_BAR; PG8_WAIT_L(0); PG8_MMA(0, 0, At, B0); PG8_BAR; PG8_SCHED;
            PG8_LDB(B1, 1, 1); PG8_STAGE(PG8_SB(1, 0), b3, voffB);
            PG8_BAR; PG8_WAIT_L(0); PG8_MMA(0, 1, At, B1); PG8_BAR;
            PG8_LDA(At, 1, 1); PG8_STAGEA(PG8_SA(1, 0), a3, 0, last);
            PG8_BAR; PG8_WAIT_L(0); PG8_MMA(1, 0, At, B0); PG8_BAR; PG8_SCHED;
            PG8_STAGE(PG8_SB(1, 1), b3 + hstep, voffB);
            PG8_WAIT_V(6); PG8_BAR; PG8_MMA(1, 1, At, B1); PG8_BAR;
            }
        }
        if constexpr (ALIGN_EPI) { if (wr == 0) PG8_BAR; }
        if constexpr (!Epi::AFTER_DRAIN) { E(acc, cur, wr, wc, fr, fq); S.done(cur); }
        if (!has_next) break;
#pragma unroll
        for (int a = 0; a < 2; ++a)
#pragma unroll
            for (int b = 0; b < 2; ++b)
#pragma unroll
                for (int m = 0; m < 4; ++m)
#pragma unroll
                    for (int n = 0; n < 2; ++n) acc[a][b][m][n] = (f32x4){0.f, 0.f, 0.f, 0.f};
        cur = nxt; cA = nA; cB = nB; ++ui;
        if constexpr (GATHER) { _Pragma("unroll") for (int h_ = 0; h_ < 2; ++h_) _Pragma("unroll") for (int i_ = 0; i_ < 2; ++i_) voffC[h_][i_] = voffN[h_][i_]; }
        if constexpr (ALIGN_EPI) { if (wr == 1) PG8_BAR; }
    }
    PG8_WAIT_V(0);
    if constexpr (!ALIGN_EPI) { if (wr == 0) PG8_BAR; }
    PG8_BAR;
    if constexpr (Epi::AFTER_DRAIN) { E.fused(acc, cur, wr, wc, fr, fq, lds, wid, lane); S.done(cur); }
#undef PG8_SA
#undef PG8_SB
#undef PG8_STAGE
#undef PG8_STAGEA
#undef PG8_GOFF
#undef PG8_LDA
#undef PG8_LDB
#undef PG8_MMA
#undef PG8_WAIT_V
#undef PG8_WAIT_L
#undef PG8_BAR
#undef PG8_SCHED
}
#else
EMU_GEMM_PHASE
#endif
}
#ifndef EMU
namespace attn_body {
using bf16=unsigned short;
using bf16x8=__attribute__((ext_vector_type(8)))short;
using s16x4=__attribute__((ext_vector_type(4)))short;
using f32x16=__attribute__((ext_vector_type(16)))float;
using u32x4=__attribute__((ext_vector_type(4)))unsigned;
constexpr int D=64,DM=64;
constexpr int NW=8,QBLK=32,QB=QBLK*NW,KVBLK=64;
__device__ __forceinline__ int crow(int r,int hi){return (r&3)+8*(r>>2)+4*hi;}
#define SBAR() __builtin_amdgcn_sched_barrier(0)
constexpr int NSLOT=3, SLOTB=8192;
constexpr int LDS_K=0, LDS_V=NSLOT*SLOTB, LDS_WS=2*NSLOT*SLOTB, LDS_OST=LDS_WS+NW*64*4, LDS_BYTES=LDS_OST+NW*4096;
__device__ __forceinline__ void glds16(const void*gsrc,unsigned lds_dst){unsigned keep;
  asm volatile("s_mov_b32 %0, m0\n\ts_mov_b32 m0, %2\n\ts_nop 0\n\tglobal_load_lds_dwordx4 %1, off\n\ts_mov_b32 m0, %0":"=&s"(keep):"v"(gsrc),"s"(lds_dst):"memory");}
__device__ __forceinline__ float max3f(float a,float b,float c){float r;asm("v_max3_f32 %0, %1, %2, %3":"=v"(r):"v"(a),"v"(b),"v"(c));return r;}
__device__ __forceinline__ float max2f(float a,float b){float r;asm("v_max_f32_e32 %0, %1, %2":"=v"(r):"v"(a),"v"(b));return r;}
__device__ __forceinline__ float fadd_s(float a,float b){float r;asm("v_add_f32_e32 %0, %1, %2":"=v"(r):"v"(a),"v"(b));return r;}
__device__ __forceinline__ float fsub_s(float a,float b){float r;asm("v_sub_f32_e32 %0, %1, %2":"=v"(r):"v"(a),"v"(b));return r;}
typedef float f32x2_t __attribute__((ext_vector_type(2))); typedef __bf16 bf16x2_t __attribute__((ext_vector_type(2)));
__device__ __forceinline__ unsigned cvtpk_s(float lo,float hi){f32x2_t v={lo,hi};bf16x2_t b=__builtin_convertvector(v,bf16x2_t);return __builtin_bit_cast(unsigned,b);}
#define WAIT_BAR(N) asm volatile("s_waitcnt vmcnt(" #N ") lgkmcnt(0)\n\ts_barrier":::"memory")

template<int MODE> __device__ __forceinline__ constexpr bool d0_on(int d0){ return MODE==0 || (MODE==1 && d0<2) || (MODE==2 && d0>=2); }
template<int MODE> __device__ __forceinline__ void qkt(f32x16&p0,f32x16&p1,const char*Kslot,const bf16x8*qr,const f32x16&negm,int r32,int hi){
  const char*kb=Kslot+hi*1024+r32*16;
  constexpr int D0A=(MODE==2)?2:0, D0B=(MODE==1)?2:4;
  #pragma unroll
  for(int d0=D0A;d0<D0B;++d0){
    const bf16x8 b0=*reinterpret_cast<const bf16x8*>(kb+d0*2048);
    const bf16x8 b1=*reinterpret_cast<const bf16x8*>(kb+d0*2048+512);
    if(d0==D0A){p0=__builtin_amdgcn_mfma_f32_32x32x16_bf16(b0,qr[d0],negm,0,0,0);p1=__builtin_amdgcn_mfma_f32_32x32x16_bf16(b1,qr[d0],negm,0,0,0);}
    else{p0=__builtin_amdgcn_mfma_f32_32x32x16_bf16(b0,qr[d0],p0,0,0,0);p1=__builtin_amdgcn_mfma_f32_32x32x16_bf16(b1,qr[d0],p1,0,0,0);}}
}
template<int MODE,int IDX> __device__ __forceinline__ void qk_mf(f32x16&Cx,const bf16x8&k,const bf16x8&q,const f32x16&negm){
  if constexpr(d0_on<MODE>(IDX>>1)){ constexpr bool first=((IDX>>1)==((MODE==2)?2:0));
    if constexpr(first) Cx=__builtin_amdgcn_mfma_f32_32x32x16_bf16(k,q,negm,0,0,0); else Cx=__builtin_amdgcn_mfma_f32_32x32x16_bf16(k,q,Cx,0,0,0); }
}
typedef __attribute__((address_space(3))) const char* lds_cptr;
typedef short v4i16_t __attribute__((ext_vector_type(4)));
template<int MODE> __device__ __forceinline__ void kload8(bf16x8*kf,lds_cptr kp){
  #pragma unroll
  for(int j=0;j<4;++j) if(d0_on<MODE>(j)){ kf[2*j]=*(const __attribute__((address_space(3))) bf16x8*)(kp+j*2048); kf[2*j+1]=*(const __attribute__((address_space(3))) bf16x8*)(kp+j*2048+512); }
}
__device__ __forceinline__ void kload2(bf16x8*kf,lds_cptr kp,int j){ kf[2*j]=*(const __attribute__((address_space(3))) bf16x8*)(kp+j*2048); kf[2*j+1]=*(const __attribute__((address_space(3))) bf16x8*)(kp+j*2048+512); }
__device__ __forceinline__ s16x4 vtr(lds_cptr p){ return __builtin_bit_cast(s16x4,__builtin_amdgcn_ds_read_tr16_b64_v4i16((__attribute__((address_space(3))) v4i16_t*)p)); }
__device__ __forceinline__ float rowmax(const f32x16&p0,const f32x16&p1){
  float a=max3f(p0[0],p0[1],p1[0]),b=max3f(p0[2],p0[3],p1[1]);a=max3f(a,p1[2],p1[3]);
  #pragma unroll
  for(int r=4;r<16;r+=4){a=max3f(a,p0[r],p0[r+1]);b=max3f(b,p0[r+2],p0[r+3]);a=max3f(a,p1[r],p1[r+1]);b=max3f(b,p1[r+2],p1[r+3]);}
  const float m=max2f(a,b);
  auto rr=__builtin_amdgcn_permlane32_swap(__float_as_uint(m),__float_as_uint(m),false,false);
  return max2f(__uint_as_float(rr[0]),__uint_as_float(rr[1]));
}
__device__ __forceinline__ void pv(f32x16*o,int vb,bf16x8 pa0,bf16x8 pa1,bf16x8 pa2,bf16x8 pa3){
  #pragma unroll
  for(int d0=0;d0<2;++d0){s16x4 lo[4],hi[4];
    #pragma unroll
    for(int ks=0;ks<4;++ks){
      asm volatile("ds_read_b64_tr_b16 %0,%1 offset:%c2":"=&v"(lo[ks]):"v"(vb),"i"(d0*4096+ks*1024):"memory");
      asm volatile("ds_read_b64_tr_b16 %0,%1 offset:%c2":"=&v"(hi[ks]):"v"(vb),"i"(d0*4096+ks*1024+512):"memory");}
    asm volatile("s_waitcnt lgkmcnt(0)":::"memory");SBAR();
    #define PK(k) (bf16x8){lo[k][0],lo[k][1],lo[k][2],lo[k][3],hi[k][0],hi[k][1],hi[k][2],hi[k][3]}
    o[d0]=__builtin_amdgcn_mfma_f32_32x32x16_bf16(pa0,PK(0),o[d0],0,0,0);
    o[d0]=__builtin_amdgcn_mfma_f32_32x32x16_bf16(pa1,PK(1),o[d0],0,0,0);
    o[d0]=__builtin_amdgcn_mfma_f32_32x32x16_bf16(pa2,PK(2),o[d0],0,0,0);
    o[d0]=__builtin_amdgcn_mfma_f32_32x32x16_bf16(pa3,PK(3),o[d0],0,0,0);
    #undef PK
  }
}

#ifndef ATTN_STORE16
#define ATTN_STORE16(p,v) (*(u32x4*)(p)=(v))
#endif
template<int THRL,int MODE> __device__ __forceinline__ void attn_unit(const bf16*Qa,const bf16*Qb,const bf16*__restrict__ Kh,const bf16*__restrict__ Vh,bf16*Oa,bf16*Ob,int opitch,int NT,char*shm,float lam,float post,const float*subln){
  int tid_=threadIdx.x; asm volatile("":"+v"(tid_)); const int tid=tid_,lane=tid&63,r32=lane&31,hi=lane>>5; const int wid=__builtin_amdgcn_readfirstlane(tid>>6);
  const bf16*Qw=(wid<4?Qa:Qb)+(long)((wid&3)*QBLK)*DM;
  const unsigned lds0=(unsigned)(uintptr_t)shm;
  float*wsf=(float*)(shm+LDS_WS)+wid*64;
  const bf16*ksrc=Kh+(long)lane*DM+wid*8;
  const bf16*vsrc=Vh+(long)(16*(wid&3)+(lane>>2))*DM+(wid>>2)*32+(lane&3)*8;
  const unsigned kdst=lds0+LDS_K+wid*1024, vdst=lds0+LDS_V+wid*1024;
  #define DMA_K(t,slot) glds16(ksrc+(long)(t)*KVBLK*DM,(unsigned)__builtin_amdgcn_readfirstlane(kdst+(slot)))
  #define DMA_V(t,slot) glds16(vsrc+(long)(t)*KVBLK*DM,(unsigned)__builtin_amdgcn_readfirstlane(vdst+(slot)))
  const int vb0=(int)(lds0+LDS_V)+((lane>>4)&1)*32+(lane&3)*8+(4*hi+((lane&15)>>2))*64;
  const char*Kbase=shm+LDS_K; bf16x8 kf[8];
  const lds_cptr shm3=(lds_cptr)shm; const lds_cptr kp0=shm3+LDS_K+hi*1024+r32*16; const lds_cptr vp0=shm3+LDS_V+((lane>>4)&1)*32+(lane&3)*8+(4*hi+((lane&15)>>2))*64;
  DMA_K(0,0);DMA_V(0,0);DMA_K(1,SLOTB);
  bf16x8 qr[4];
  #pragma unroll
  for(int d0=0;d0<4;++d0)qr[d0]=*reinterpret_cast<const bf16x8*>(&Qw[(long)r32*DM+d0*16+hi*8]);
  float mhat=0.f,l_reg=0.f;f32x16 o[2];o[0]=f32x16{};o[1]=f32x16{};f32x16 negm=f32x16{};asm volatile("":"+v"(negm));
  #define CMASK(P0,P1,t) do{}while(0)
  bool resc=false;
  #define START(P0,P1) do{ const float rm=rowmax(P0,P1); resc=false; \
    { const float dl=rm; mhat=fadd_s(mhat,dl); \
      _Pragma("unroll") for(int r=0;r<16;++r){P0[r]=fsub_s(P0[r],dl);P1[r]=fsub_s(P1[r],dl);} \
      _Pragma("unroll") for(int r=0;r<16;++r)negm[r]=-mhat; asm volatile("":"+v"(negm)); } \
    _Pragma("unroll") for(int r=0;r<16;++r)P0[r]=__builtin_amdgcn_exp2f(P0[r]); }while(0)
  #define RESC() do{ if(resc){ asm volatile("s_waitcnt lgkmcnt(0)":::"memory"); \
      _Pragma("unroll") for(int d_=0;d_<2;++d_) _Pragma("unroll") for(int r=0;r<16;++r)o[d_][r]*=wsf[crow(r,hi)]; } }while(0)
  f32x16 pA0,pA1,pB0,pB1;
  int sl_prev=0,sl_cur=0,sl_next=SLOTB;
  #define ROT() do{sl_prev=sl_cur;sl_cur=sl_next;sl_next=(sl_next==(NSLOT-1)*SLOTB)?0:sl_next+SLOTB;}while(0)
  DMA_K(2,2*SLOTB);
  WAIT_BAR(3);
  qkt<MODE>(pA0,pA1,Kbase,qr,negm,r32,hi);asm volatile("s_nop 15\n\ts_nop 7":"+v"(pA0),"+v"(pA1));CMASK(pA0,pA1,0);
  START(pA0,pA1);
  _Pragma("unroll") for(int r=0;r<16;++r)pA1[r]=__builtin_amdgcn_exp2f(pA1[r]);
  WAIT_BAR(0);
  DMA_K(3,0);DMA_V(1,SLOTB);
  ROT();
  kload8<MODE>(kf,kp0+sl_cur);
  WAIT_BAR(2);
  s16x4 vlo[8],vhi[8]; u32x4 pw0,pw1,pw2,pw3;
  #define PKW(P,B) cvtpk_s(P[B],P[B+1])
  #define PAF(k) __builtin_bit_cast(bf16x8,pw##k)
  #define VFR(i) (bf16x8){vlo[i][0],vlo[i][1],vlo[i][2],vlo[i][3],vhi[i][0],vhi[i][1],vhi[i][2],vhi[i][3]}
  #define PIN(x) asm volatile("":"+v"(x))
  #define MX3(a,b,c) __builtin_fmaxf(__builtin_fmaxf((a),(b)),(c))
  #define GAPA(MF,A0,A1,A2,A3,W0,W1,PW) do{ MF; sacc+=A0; sacc+=A1; sacc+=A2; sacc+=A3; PIN(sacc); W0; W1; PIN(PW); SBAR(); }while(0)
  #define EX(v) __builtin_amdgcn_exp2f(v)
  #define GAPB(MF,X,B) do{ MF; X[B]=EX(X[B]); X[B+1]=EX(X[B+1]); X[B+2]=EX(X[B+2]); X[B+3]=EX(X[B+3]); PIN(X); SBAR(); }while(0)
  #define VRD(i) do{ vlo[i]=vtr(vp_+(((i)>>2)*4096+((i)&3)*1024)); vhi[i]=vtr(vp_+(((i)>>2)*4096+((i)&3)*1024+512)); }while(0)
  #define KRD(G,j) do{ if((G)&&d0_on<MODE>(j)){ kload2(kf,kp0+sl_next,j); SBAR(); } }while(0)
  #define STEP(C0,C1,P0,P1,t,GK,GV,GL) do{ SBAR(); \
    const lds_cptr vp_=vp0+sl_prev; \
    VRD(0); SBAR(); float sacc=(P0[0]+P0[1]); \
    GAPA((qk_mf<MODE,0>(C0,kf[0],qr[0],negm)), P0[2],P0[3],P0[4],P0[5],     pw0[0]=PKW(P0,0), pw0[1]=PKW(P0,2), pw0); \
    VRD(4); SBAR(); GAPA((qk_mf<MODE,1>(C1,kf[1],qr[0],negm)), P0[6],P0[7],P0[8],P0[9],     pw0[2]=PKW(P0,4), pw0[3]=PKW(P0,6), pw0); \
    VRD(1); SBAR(); GAPA((qk_mf<MODE,2>(C0,kf[2],qr[1],negm)),   P0[10],P0[11],P0[12],P0[13], pw1[0]=PKW(P0,8), pw1[1]=PKW(P0,10), pw1); \
    VRD(5); SBAR(); GAPA((qk_mf<MODE,3>(C1,kf[3],qr[1],negm)),   P0[14],P0[15],P1[0],P1[1],   pw1[2]=PKW(P0,12),pw1[3]=PKW(P0,14), pw1); \
    VRD(2); SBAR(); GAPA((qk_mf<MODE,4>(C0,kf[4],qr[2],negm)),   P1[2],P1[3],P1[4],P1[5],     pw2[0]=PKW(P1,0), pw2[1]=PKW(P1,2), pw2); \
    VRD(6); SBAR(); GAPA((qk_mf<MODE,5>(C1,kf[5],qr[2],negm)),   P1[6],P1[7],P1[8],P1[9],     pw2[2]=PKW(P1,4), pw2[3]=PKW(P1,6), pw2); \
    VRD(3); SBAR(); GAPA((qk_mf<MODE,6>(C0,kf[6],qr[3],negm)),   P1[10],P1[11],P1[12],P1[13], pw3[0]=PKW(P1,8), pw3[1]=PKW(P1,10), pw3); \
    VRD(7); SBAR(); GAPA((qk_mf<MODE,7>(C1,kf[7],qr[3],negm)),   P1[14],P1[15],0.f,0.f,       pw3[2]=PKW(P1,12),pw3[3]=PKW(P1,14), pw3); \
    l_reg+=sacc; \
    if(GK){DMA_K((t)+3,sl_cur);} if(GV){DMA_V((t)+1,sl_next);} \
    CMASK(C0,C1,t); \
    { float a=MX3(C0[0],C0[1],C1[0]),b=MX3(C0[2],C0[3],C1[1]); a=MX3(a,C1[2],C1[3]); \
      _Pragma("unroll") for(int r=4;r<16;r+=4){a=MX3(a,C0[r],C0[r+1]);b=MX3(b,C0[r+2],C0[r+3]);a=MX3(a,C1[r],C1[r+1]);b=MX3(b,C1[r+2],C1[r+3]);} \
      float rm=__builtin_fmaxf(a,b); { auto rr=__builtin_amdgcn_permlane32_swap(__float_as_uint(rm),__float_as_uint(rm),false,false); rm=__builtin_fmaxf(__uint_as_float(rr[0]),__uint_as_float(rr[1])); } \
      resc=false; \
      if(__builtin_expect(__any(rm>(float)THRL),0)){ const float dl=__builtin_fmaxf(rm,0.f); mhat+=dl; \
        _Pragma("unroll") for(int r=0;r<16;++r){C0[r]-=dl;C1[r]-=dl;} \
        _Pragma("unroll") for(int r=0;r<16;++r)negm[r]=-mhat; asm volatile("":"+v"(negm)); \
        const float f=__builtin_amdgcn_exp2f(-dl); l_reg*=f; if(hi==0)wsf[r32]=f; resc=true; } } \
    SBAR(); \
    GAPB(o[0]=__builtin_amdgcn_mfma_f32_32x32x16_bf16(PAF(0),VFR(0),o[0],0,0,0), C0,0); \
    GAPB(o[1]=__builtin_amdgcn_mfma_f32_32x32x16_bf16(PAF(0),VFR(4),o[1],0,0,0), C0,4); \
    KRD(GL,0); GAPB(o[0]=__builtin_amdgcn_mfma_f32_32x32x16_bf16(PAF(1),VFR(1),o[0],0,0,0), C0,8); \
    KRD(GL,1); GAPB(o[1]=__builtin_amdgcn_mfma_f32_32x32x16_bf16(PAF(1),VFR(5),o[1],0,0,0), C0,12); \
    KRD(GL,2); GAPB(o[0]=__builtin_amdgcn_mfma_f32_32x32x16_bf16(PAF(2),VFR(2),o[0],0,0,0), C1,0); \
    KRD(GL,3); GAPB(o[1]=__builtin_amdgcn_mfma_f32_32x32x16_bf16(PAF(2),VFR(6),o[1],0,0,0), C1,4); \
    GAPB(o[0]=__builtin_amdgcn_mfma_f32_32x32x16_bf16(PAF(3),VFR(3),o[0],0,0,0), C1,8); \
    GAPB(o[1]=__builtin_amdgcn_mfma_f32_32x32x16_bf16(PAF(3),VFR(7),o[1],0,0,0), C1,12); \
    }while(0)
  int t=1;
  for(;t+5<NT;t+=2){
    STEP(pB0,pB1,pA0,pA1,t,true,true,true);     WAIT_BAR(2); RESC(); ROT();
    STEP(pA0,pA1,pB0,pB1,t+1,true,true,true);   WAIT_BAR(2); RESC(); ROT();
  }
  #define ENDW(tt) do{ if((tt)+3<NT){WAIT_BAR(2);} else if((tt)+2<NT){WAIT_BAR(1);} else {WAIT_BAR(0);} }while(0)
  for(;t+1<NT;t+=2){
    STEP(pB0,pB1,pA0,pA1,t,(t+3<NT),(t+1<NT),(t+1<NT));       ENDW(t);   RESC(); ROT();
    STEP(pA0,pA1,pB0,pB1,t+1,(t+4<NT),(t+2<NT),(t+2<NT));     ENDW(t+1); RESC(); ROT();
  }
  STEP(pB0,pB1,pA0,pA1,NT-1,false,false,false); RESC();
  { float sacc=pB0[0]+pB0[1]; _Pragma("unroll") for(int r=2;r<16;++r)sacc+=pB0[r]; _Pragma("unroll") for(int r=0;r<16;++r)sacc+=pB1[r]; l_reg+=sacc;
    pw0=(u32x4){PKW(pB0,0),PKW(pB0,2),PKW(pB0,4),PKW(pB0,6)};pw1=(u32x4){PKW(pB0,8),PKW(pB0,10),PKW(pB0,12),PKW(pB0,14)};pw2=(u32x4){PKW(pB1,0),PKW(pB1,2),PKW(pB1,4),PKW(pB1,6)};pw3=(u32x4){PKW(pB1,8),PKW(pB1,10),PKW(pB1,12),PKW(pB1,14)};
    SBAR(); pv(o,vb0+sl_cur,PAF(0),PAF(1),PAF(2),PAF(3)); }
  #undef PKW
  #undef PAF
  #undef VFR
  #undef PIN
  #undef MX3
  #undef GAPA
  #undef GAPB
  #undef EX
  #undef VRD
  #undef KRD
  #undef STEP
  #undef ENDW
  {auto rr=__builtin_amdgcn_permlane32_swap(__float_as_uint(l_reg),__float_as_uint(l_reg),false,false);l_reg=__uint_as_float(rr[0])+__uint_as_float(rr[1]);}
  if(hi==0)wsf[32+r32]=l_reg;asm volatile("s_waitcnt lgkmcnt(0)":::"memory");
  float rli[16];
  #pragma unroll
  for(int r=0;r<16;++r)rli[r]=__builtin_amdgcn_rcpf(wsf[32+crow(r,hi)]);
  bf16*Ow=(wid<4?Oa:Ob)+(long)((wid&3)*QBLK)*opitch;
  { bf16*stg=(bf16*)(shm+LDS_OST)+wid*2048;
    #pragma unroll
    for(int r=0;r<16;++r){const int orow=crow(r,hi);
      #pragma unroll
      for(int d0=0;d0<2;++d0)stg[orow*64+d0*32+r32]=(bf16)f2bf(o[d0][r]*rli[r]);}
    asm volatile("s_waitcnt lgkmcnt(0)":::"memory");
    if constexpr(MODE==0){
      #pragma unroll
      for(int i=0;i<4;++i){const int row=i*8+(lane>>3),ch=lane&7; const u32x4 v=*(const u32x4*)(stg+row*64+ch*8); ATTN_STORE16(Ow+(long)row*opitch+ch*8,v);}
    } else {
      asm volatile("s_barrier":::"memory");
      if constexpr(MODE==1){ const bf16*stg2=stg+4*2048; const int ch=lane&7; float sb[8];
        #pragma unroll
        for(int e=0;e<8;++e)sb[e]=subln[ch*8+e]*post;
        #pragma unroll
        for(int i=0;i<4;++i){const int row=i*8+(lane>>3); const u32x4 v1=*(const u32x4*)(stg+row*64+ch*8),v2=*(const u32x4*)(stg2+row*64+ch*8);
          float od[8]; float ss=0.f;
          #pragma unroll
          for(int e=0;e<4;++e){ od[2*e]=bflo(v1[e])-lam*bflo(v2[e]); od[2*e+1]=bfhi(v1[e])-lam*bfhi(v2[e]); ss+=od[2*e]*od[2*e]+od[2*e+1]*od[2*e+1]; }
          ss+=__shfl_xor(ss,1); ss+=__shfl_xor(ss,2); ss+=__shfl_xor(ss,4);
          const float rn=__builtin_amdgcn_rsqf(ss*(1.f/64.f)+1e-6f);
          u32x4 w; w[0]=pk2(od[0]*rn*sb[0],od[1]*rn*sb[1]); w[1]=pk2(od[2]*rn*sb[2],od[3]*rn*sb[3]); w[2]=pk2(od[4]*rn*sb[4],od[5]*rn*sb[5]); w[3]=pk2(od[6]*rn*sb[6],od[7]*rn*sb[7]);
          ATTN_STORE16(Ow+(long)row*opitch+ch*8,w);} }
    } }
  asm volatile("s_waitcnt lgkmcnt(0)\n\ts_barrier":::"memory");
  #undef DMA_K
  #undef DMA_V
  #undef CMASK
  #undef START
  #undef RESC
  #undef ROT
}
constexpr int ATTN_LDS_BYTES=LDS_BYTES;
#undef SBAR
#undef WAIT_BAR
}
#else
EMU_ATTN_BODY
#endif
#ifndef EMU
#define XB_TMO      128
#define XB_XCNT(j)  (256  + 64 * (j))
#define XB_XSUB(j)  (1280 + 64 * (j))
#define XB_XGEN(j)  (2304 + 64 * (j))
#define XB_TOP      3328
#define XB_TOPGEN   3392
#define XCD_BAR_WORDS 3456
#define XB_SPIN_CAP (1u << 18)

__device__ __forceinline__ unsigned xb_ld(unsigned* p)              { return __hip_atomic_load(p, __ATOMIC_RELAXED, __HIP_MEMORY_SCOPE_AGENT); }
__device__ __forceinline__ unsigned xb_add(unsigned* p, unsigned v) { return __hip_atomic_fetch_add(p, v, __ATOMIC_RELAXED, __HIP_MEMORY_SCOPE_AGENT); }
__device__ __forceinline__ unsigned xb_xcc_id() { return (unsigned)__builtin_amdgcn_s_getreg((3 << 11) | 20) & 0xFu; }
#define XB_SPIN(cond, bar) do { unsigned _sp = 0; while (cond) { __builtin_amdgcn_s_sleep(1); \
    if ((++_sp & 255u) == 0u) { if (xb_ld(&(bar)[XB_TMO])) break; if (_sp > XB_SPIN_CAP) { atomicAdd(&(bar)[XB_TMO], 1u); break; } } } } while (0)

struct XcdBarrier {
    unsigned* bar; unsigned x;
    volatile LAS unsigned* st;
};

__device__ __forceinline__ XcdBarrier xcd_barrier_post(unsigned* bar, volatile LAS unsigned* st) {
    XcdBarrier b; b.bar = bar; b.x = xb_xcc_id(); b.st = st;
    if (threadIdx.x == 0) (void)xb_add(&bar[XB_XCNT(b.x)], 1u);
    return b;
}
__device__ __forceinline__ void xcd_barrier_complete(unsigned* bar, unsigned x, unsigned& nloc, unsigned& nx) {
    const unsigned G = gridDim.x * gridDim.y * gridDim.z;
    unsigned sum, cnt, mine, sp = 0u;
    for (;;) {
        sum = 0u; cnt = 0u; mine = 0u;
#pragma unroll
        for (unsigned j = 0; j < 16; ++j) { const unsigned c = xb_ld(&bar[XB_XCNT(j)]); sum += c; cnt += (c > 0u) ? 1u : 0u; mine = (j == x) ? c : mine; }
        if (sum == G) break;
        __builtin_amdgcn_s_sleep(1);
        if ((++sp & 255u) == 0u) { if (xb_ld(&bar[XB_TMO])) break; if (sp > XB_SPIN_CAP) { atomicAdd(&bar[XB_TMO], 1u); break; } }
    }
    nloc = mine > 0u ? mine : 1u; nx = cnt > 0u ? cnt : 1u;
}

__device__ __forceinline__ void xcd_barrier(const XcdBarrier& b) {
    asm volatile("s_waitcnt vmcnt(0)" ::: "memory");
    __syncthreads();
    if (threadIdx.x == 0) {
        unsigned* bar = b.bar;
        __builtin_amdgcn_s_waitcnt(0);
        unsigned nloc = b.st[0], nx = b.st[1];
        if (nloc == 0u) { xcd_barrier_complete(bar, b.x, nloc, nx); b.st[0] = nloc; b.st[1] = nx; }
        const unsigned old = xb_add(&bar[XB_XSUB(b.x)], 1u);
        const unsigned gen = old / nloc;
        if (old + 1u == (gen + 1u) * nloc) {
            __builtin_amdgcn_fence(__ATOMIC_RELEASE, "agent");
            asm volatile("s_waitcnt vmcnt(0)" ::: "memory");
            const unsigned og = xb_add(&bar[XB_TOP], 1u);
            const unsigned tg = og / nx;
            if (og + 1u == (tg + 1u) * nx) xb_add(&bar[XB_TOPGEN], 1u);
            else XB_SPIN(xb_ld(&bar[XB_TOPGEN]) == tg, bar);
            __builtin_amdgcn_fence(__ATOMIC_ACQUIRE, "agent");
            xb_add(&bar[XB_XGEN(b.x)], 1u);
            asm volatile("s_waitcnt vmcnt(0)" ::: "memory");
        } else {
            XB_SPIN(xb_ld(&bar[XB_XGEN(b.x)]) == gen, bar);
            __builtin_amdgcn_fence(__ATOMIC_ACQUIRE, "agent");
            asm volatile("s_waitcnt vmcnt(0)" ::: "memory");
        }
    }
    __syncthreads();
}
#endif

constexpr int LDS_BYTES = 147456;
constexpr int MISC_OFF = 139264;
constexpr int PTR_OFF = MISC_OFF + 256;
struct Ctx {
    LAS unsigned char* lds;
    int tid, lane, wave, bid, G;
    float* out; unsigned long long wsi;
};
DEVI const float* inp_ptr(const Ctx& C, int i) {
    const unsigned long long v = ((const LAS unsigned long long*)(C.lds + PTR_OFF))[i];
    const unsigned lo = __builtin_amdgcn_readfirstlane((unsigned)v), hi = __builtin_amdgcn_readfirstlane((unsigned)(v >> 32));
    return (const float*)(const GAS float*)(((unsigned long long)hi << 32) | lo);
}
#define INP(i) inp_ptr(C, i)
#define WSP(T, off) ((T*)(GAS T*)(C.wsi + (unsigned long long)(off)))
DEVI int mod_row(int r) { return r < T_L ? r / SEQ : 8; }
DEVI const float* mod_vec(const Ctx& C, int layer, int mrow, int which) { return WSP(const float, WS_MOD) + ((size_t)(layer * 9 + mrow) * 6 + which) * D; }

DEVI void transpose_item(const float* W, int ldw, int k0, int n0, bf16* WT, int orow0, int Kp, LAS float* scr, int lane) {
    { const int kr = lane >> 3, c4 = (lane & 7) * 4; f32x4 v[8];
#pragma unroll
      for (int i = 0; i < 8; ++i) v[i] = *(const f32x4*)(W + (size_t)(k0 + 8 * i + kr) * ldw + n0 + c4);
#pragma unroll
      for (int i = 0; i < 8; ++i) { LAS float* d = scr + (8 * i + kr) * 33 + c4; d[0] = v[i].x; d[1] = v[i].y; d[2] = v[i].z; d[3] = v[i].w; } }
    LDS_WAIT();
    const int c = lane & 7;
#pragma unroll
    for (int j = 0; j < 4; ++j) { const int n = (lane >> 3) + 8 * j; const LAS float* s = scr + (8 * c) * 33 + n;
        v4u o; o.x = pk2(s[0 * 33], s[1 * 33]); o.y = pk2(s[2 * 33], s[3 * 33]); o.z = pk2(s[4 * 33], s[5 * 33]); o.w = pk2(s[6 * 33], s[7 * 33]);
        *(v4u*)(WT + (size_t)(orow0 + n) * Kp + k0 + 8 * c) = o; }
    LDS_WAIT();
}
DEVI void convert_layer_weights(const Ctx& C, int layer, int part) {
    LAS float* scr = (LAS float*)(C.lds + C.wave * 16384);
    const int gw = C.bid * 8 + C.wave, NGW = C.G * 8;
    constexpr int I_IN = 16 * (N_PROJ / 32), I_OUT = 16 * (D / 32), I_UP = NE * 16 * (2 * DE / 32), I_DN = NE * 16 * (D / 32), I_LAYER = I_IN + I_OUT + I_UP + I_DN;
    const int it_lo = (part == 1) ? I_IN + I_OUT : 0, it_hi = (part == 0) ? I_IN + I_OUT : I_LAYER;
    for (int it = it_lo + gw; it < it_hi; it += NGW) {
        int r = it;
        if (r < I_IN) { const int kb = r / (N_PROJ / 32), nb = r % (N_PROJ / 32);
            transpose_item(INP(8) + (size_t)layer * D * D_IN, D_IN, 64 * kb, 32 * nb, WSP(bf16, WS_WIN) + (size_t)layer * N_PROJ * D, 32 * nb, D, scr, C.lane); continue; }
        r -= I_IN;
        if (r < I_OUT) { const int kb = r / (D / 32), nb = r % (D / 32);
            transpose_item(INP(9) + (size_t)layer * D * D, D, 64 * kb, 32 * nb, WSP(bf16, WS_WOUT) + (size_t)layer * D * D, 32 * nb, D, scr, C.lane); continue; }
        r -= I_OUT;
        if (r < I_UP) { const int e = r / (16 * 64), q = r % (16 * 64), kb = q / 64, nb = q % 64; const int n0 = 32 * nb;
            const int orow = (n0 < DE) ? (n0 / 128) * 256 + (n0 % 128) : ((n0 - DE) / 128) * 256 + 128 + ((n0 - DE) % 128);
            transpose_item(INP(26) + ((size_t)layer * NE + e) * D * 2 * DE, 2 * DE, 64 * kb, n0, WSP(bf16, WS_WUP) + ((size_t)layer * NE + e) * 2 * DE * D, orow, D, scr, C.lane); continue; }
        r -= I_UP;
        { const int e = r / (16 * 32), q = r % (16 * 32), kb = q / 32, nb = q % 32;
            transpose_item(INP(28) + ((size_t)layer * NE + e) * DE * D, D, 64 * kb, 32 * nb, WSP(bf16, WS_WDN) + ((size_t)layer * NE + e) * D * DE, 32 * nb, DE, scr, C.lane); }
    }
}
DEVI void p0_prologue(const Ctx& C) {
    convert_layer_weights(C, 0, 0);
    {
      float* tab = WSP(float, WS_ROPE);
      for (int i = C.bid * 512 + C.tid; i < SEQ * 48; i += C.G * 512) { const int t = i / 48, j = i % 48; const float rp = (float)(t / GRID_W), cp = (float)(t % GRID_W); float c, s;
          if (j < 32) { const float ang = (j < 16 ? rp : cp) * __builtin_amdgcn_exp2f(-(float)(j & 15) * (13.287712379549449f / 16.f)); const float tt = __builtin_amdgcn_fractf(ang * 0.15915494309189535f); c = __builtin_amdgcn_cosf(tt); s = __builtin_amdgcn_sinf(tt);
              tab[(size_t)t * 32 + j] = c; tab[(size_t)SEQ * 32 + (size_t)t * 32 + j] = s; }
          else { const int i2 = j - 32; const float ang = (i2 < 8 ? rp : cp) * __builtin_amdgcn_exp2f(-(float)(i2 & 7) * (13.287712379549449f / 8.f)); const float tt = __builtin_amdgcn_fractf(ang * 0.15915494309189535f); c = __builtin_amdgcn_cosf(tt); s = __builtin_amdgcn_sinf(tt);
              tab[(size_t)SEQ * 64 + (size_t)t * 16 + i2] = c; tab[(size_t)SEQ * 80 + (size_t)t * 16 + i2] = s; } } }
    __syncthreads();
    LAS float* sc = (LAS float*)C.lds;
    LAS float* red = sc + 9 * D;
    for (int i = C.tid; i < 9 * D; i += 512) { const int r = i / D, k = i % D; float v = 0.f; if (r < NB) v = INP(1)[r * D + k]; else if (r == 8) v = INP(3)[k]; sc[i] = siluf_(v); }
    __syncthreads();
    for (int u = C.bid; u < DEPTH * 96; u += C.G) {
        const int layer = u / 96, n0 = (u % 96) * 64, col = C.tid & 63, kg = C.tid >> 6;
        const float* w = INP(4) + (size_t)layer * D * 6 * D + n0 + col;
        float acc[9];
#pragma unroll
        for (int r = 0; r < 9; ++r) acc[r] = 0.f;
#pragma unroll 8
        for (int k = kg * 128; k < kg * 128 + 128; ++k) { const float wv = w[(size_t)k * 6 * D];
#pragma unroll
            for (int r = 0; r < 9; ++r) acc[r] += sc[r * D + k] * wv; }
#pragma unroll
        for (int r = 0; r < 9; ++r) red[(kg * 9 + r) * 64 + col] = acc[r];
        __syncthreads();
        for (int i = C.tid; i < 9 * 64; i += 512) { const int r = i >> 6, c2 = i & 63; float s = 0.f;
#pragma unroll
            for (int g = 0; g < 8; ++g) s += red[(g * 9 + r) * 64 + c2];
            WSP(float, WS_MOD)[((size_t)(layer * 9 + r)) * 6 * D + n0 + c2] = s + INP(5)[(size_t)layer * 6 * D + n0 + c2]; }
        __syncthreads();
    }
}

DEVI void ph_norm_mix(const Ctx& C, int layer) {
    const bool fin = (layer == DEPTH);
    const int nrows = fin ? T_L : T_ALL;
    if (layer == 0) {
        for (int it = C.bid * 8 + C.wave; it < DEPTH * 9 * NE; it += C.G * 8) {
            const int e = it % NE, m = (it / NE) % 9, l = it / (NE * 9);
            const float* gn = INP(7) + (size_t)l * D; const float* sh = mod_vec(C, l, m, 3); const float* scl = mod_vec(C, l, m, 4); const float* rw = INP(24) + (size_t)l * D * NE + e;
            float* dst = WSP(float, WS_RWP) + (size_t)it * D; float bsum = 0.f;
#pragma unroll 4
            for (int j = 0; j < 16; ++j) { const int k = 64 * j + C.lane; const float w = rw[(size_t)k * NE]; const float tv = gn[k] * (1.f + scl[k]) * w; const unsigned hb = f2bf(tv);
                ((unsigned short*)dst)[k] = (unsigned short)hb; ((unsigned short*)dst)[D + k] = (unsigned short)f2bf(tv - bflo(hb)); bsum += sh[k] * w; }
            bsum = wave_sum(bsum); if (C.lane == 0) WSP(float, WS_RBP)[it] = bsum + INP(25)[l * NE + e];
        }
    }
    LAS float* w16 = (LAS float*)C.lds;
    if (!fin) { for (int i = C.tid; i < 16 * D; i += 512) { const int k = i >> 4, j = i & 15; w16[j * D + k] = INP(8)[((size_t)layer * D + k) * D_IN + N_PROJ + j]; } }
    __syncthreads();
    const float* gmain = fin ? INP(30) : INP(6) + (size_t)layer * D;
    const int rstep = C.G * 8;
    int s4[2][4]; float g4[2][4];
#define NM_SLOTS(dst_s, dst_g, rbase) do { _Pragma("unroll") for (int u2 = 0; u2 < 2; ++u2) { const int rr_ = (rbase) + u2 * rstep; const int rc_ = rr_ < nrows ? rr_ : 0; \
        const int* sl_ = WSP(const int, WS_SLOT) + (size_t)rc_ * 4; const float* gl_ = WSP(const float, WS_TOKG) + (size_t)rc_ * 4; \
        _Pragma("unroll") for (int k = 0; k < 4; ++k) { dst_s[u2][k] = sl_[k]; dst_g[u2][k] = gl_[k]; } } } while (0)
    if (layer != 0) NM_SLOTS(s4, g4, C.bid * 8 + C.wave);
#define NMC(j) ((((j) & 2) ? 512 : 0) + 8 * C.lane + 4 * ((j) & 1))
    for (int ra = C.bid * 8 + C.wave; ra < nrows; ra += 2 * rstep) {
        f32x4 v[2][4]; int mrow[2]; bool live[2];
        int s4n[2][4]; float g4n[2][4];
        if (layer != 0) NM_SLOTS(s4n, g4n, ra + 2 * rstep);
#pragma unroll
        for (int u2 = 0; u2 < 2; ++u2) { const int r = ra + u2 * rstep; live[u2] = r < nrows; const int rc = live[u2] ? r : 0; mrow[u2] = mod_row(rc);
            if (layer == 0) { const float* xr = (rc < T_L) ? INP(0) + (size_t)rc * D : INP(2) + (size_t)(rc - T_L) * D;
#pragma unroll
                for (int j = 0; j < 4; ++j) v[u2][j] = *(const f32x4*)(xr + NMC(j));
            } else {
                const bf16* xr = WSP(const bf16, WS_XRES) + (size_t)rc * D; const float* g2 = mod_vec(C, layer - 1, mrow[u2], 5);
                f32x4 xv[4]; { const v4u xa = *(const v4u*)(xr + 8 * C.lane), xb = *(const v4u*)(xr + 512 + 8 * C.lane);
                    xv[0] = (f32x4){bflo(xa.x), bfhi(xa.x), bflo(xa.y), bfhi(xa.y)}; xv[1] = (f32x4){bflo(xa.z), bfhi(xa.z), bflo(xa.w), bfhi(xa.w)};
                    xv[2] = (f32x4){bflo(xb.x), bfhi(xb.x), bflo(xb.y), bfhi(xb.y)}; xv[3] = (f32x4){bflo(xb.z), bfhi(xb.z), bflo(xb.w), bfhi(xb.w)}; }
                f32x4 a[4];
#pragma unroll
                for (int j = 0; j < 4; ++j) a[j] = (f32x4){0.f, 0.f, 0.f, 0.f};
#pragma unroll
                for (int k = 0; k < 4; ++k) { const unsigned char* yr = WSP(const unsigned char, WS_YS) + (size_t)s4[u2][k] * D; const v2u ya = *(const v2u*)(yr + 8 * C.lane), yb = *(const v2u*)(yr + 512 + 8 * C.lane); const float gk = g4[u2][k];
                    const f32x2 p0 = __builtin_amdgcn_cvt_pk_f32_fp8((int)ya.x, false), p1 = __builtin_amdgcn_cvt_pk_f32_fp8((int)ya.x, true), p2 = __builtin_amdgcn_cvt_pk_f32_fp8((int)ya.y, false), p3 = __builtin_amdgcn_cvt_pk_f32_fp8((int)ya.y, true);
                    const f32x2 q0 = __builtin_amdgcn_cvt_pk_f32_fp8((int)yb.x, false), q1 = __builtin_amdgcn_cvt_pk_f32_fp8((int)yb.x, true), q2 = __builtin_amdgcn_cvt_pk_f32_fp8((int)yb.y, false), q3 = __builtin_amdgcn_cvt_pk_f32_fp8((int)yb.y, true);
                    a[0] += (f32x4){p0.x, p0.y, p1.x, p1.y} * gk; a[1] += (f32x4){p2.x, p2.y, p3.x, p3.y} * gk;
                    a[2] += (f32x4){q0.x, q0.y, q1.x, q1.y} * gk; a[3] += (f32x4){q2.x, q2.y, q3.x, q3.y} * gk; }
#pragma unroll
                for (int j = 0; j < 4; ++j) v[u2][j] = xv[j] + *(const f32x4*)(g2 + NMC(j)) * a[j];
            } }
        float rinv[2];
#pragma unroll
        for (int u2 = 0; u2 < 2; ++u2) { float ss = 0.f;
#pragma unroll
            for (int j = 0; j < 4; ++j) ss += (v[u2][j].x * v[u2][j].x + v[u2][j].y * v[u2][j].y) + (v[u2][j].z * v[u2][j].z + v[u2][j].w * v[u2][j].w);
            rinv[u2] = __builtin_amdgcn_rsqf(wave_sum(ss) * (1.f / D) + NORM_EPS); }
#pragma unroll
        for (int u2 = 0; u2 < 2; ++u2) { const int r = ra + u2 * rstep; if (!live[u2]) continue;
            if (fin) {
#pragma unroll
                for (int j = 0; j < 4; ++j) *(f32x4*)(C.out + (size_t)r * D + NMC(j)) = v[u2][j] * rinv[u2] * *(const f32x4*)(gmain + NMC(j));
                continue; }
            if (layer != 0) { bf16* xw = WSP(bf16, WS_XRES) + (size_t)r * D;
                *(v4u*)(xw + 8 * C.lane) = (v4u){pk2(v[u2][0].x, v[u2][0].y), pk2(v[u2][0].z, v[u2][0].w), pk2(v[u2][1].x, v[u2][1].y), pk2(v[u2][1].z, v[u2][1].w)};
                *(v4u*)(xw + 512 + 8 * C.lane) = (v4u){pk2(v[u2][2].x, v[u2][2].y), pk2(v[u2][2].z, v[u2][2].w), pk2(v[u2][3].x, v[u2][3].y), pk2(v[u2][3].z, v[u2][3].w)}; }
            const float* sh = mod_vec(C, layer, mrow[u2], 0); const float* scl = mod_vec(C, layer, mrow[u2], 1);
            f32x4 hv4[4]; float mine = 0.f;
#pragma unroll
            for (int j = 0; j < 4; ++j) hv4[j] = v[u2][j] * rinv[u2] * *(const f32x4*)(gmain + NMC(j)) * (*(const f32x4*)(scl + NMC(j)) + 1.0f) + *(const f32x4*)(sh + NMC(j));
            { bf16* hr = WSP(bf16, WS_H) + (size_t)r * D;
              *(v4u*)(hr + 8 * C.lane) = (v4u){pk2(hv4[0].x, hv4[0].y), pk2(hv4[0].z, hv4[0].w), pk2(hv4[1].x, hv4[1].y), pk2(hv4[1].z, hv4[1].w)};
              *(v4u*)(hr + 512 + 8 * C.lane) = (v4u){pk2(hv4[2].x, hv4[2].y), pk2(hv4[2].z, hv4[2].w), pk2(hv4[3].x, hv4[3].y), pk2(hv4[3].z, hv4[3].w)}; }
#pragma unroll 2
            for (int i = 0; i < 16; ++i) { float pp = 0.f;
#pragma unroll
                for (int j = 0; j < 4; ++j) { const f32x4 w = *(const LAS f32x4*)(w16 + i * D + NMC(j)); pp += (hv4[j].x * w.x + hv4[j].y * w.y) + (hv4[j].z * w.z + hv4[j].w * w.w); }
                pp = wave_sum(pp); if (C.lane == i) mine = pp; }
            if (C.lane < 16) WSP(float, WS_BA)[(size_t)r * 16 + C.lane] = mine; }
        if (layer != 0) {
#pragma unroll
            for (int u2 = 0; u2 < 2; ++u2)
#pragma unroll
                for (int k = 0; k < 4; ++k) { s4[u2][k] = s4n[u2][k]; g4[u2][k] = g4n[u2][k]; } }
    }
#undef NMC
#undef NM_SLOTS
}

DEVI void u8f(const v4u& w, float (&x)[8]) { x[0] = bflo(w.x); x[1] = bfhi(w.x); x[2] = bflo(w.y); x[3] = bfhi(w.y); x[4] = bflo(w.z); x[5] = bfhi(w.z); x[6] = bflo(w.w); x[7] = bfhi(w.w); }
DEVI v4u f8u(const float (&x)[8]) { return (v4u){pk2(x[0], x[1]), pk2(x[2], x[3]), pk2(x[4], x[5]), pk2(x[6], x[7])}; }
DEVI void ph_attn_prep(const Ctx& C, int layer) {
    const bf16* proj = WSP(const bf16, WS_PROJ);
    bf16* QL = WSP(bf16, WS_QL); bf16* QC = WSP(bf16, WS_QC); bf16* KB = WSP(bf16, WS_K); bf16* VB = WSP(bf16, WS_V);
    const float* tab = WSP(const float, WS_ROPE);
    const int lane = C.lane, l7 = lane & 7, d0 = 8 * l7;
    constexpr float C2A = 0.125f * 1.4426950408889634f, C2D = 0.17677669529663687f * 1.4426950408889634f;
    float gA[8];
    { const float* gn = (lane < 32 ? INP(10) : INP(11)) + layer * 64 + d0;
#pragma unroll
      for (int e = 0; e < 8; ++e) gA[e] = gn[e]; }
    const bool lowA = d0 < 32; const int jA = d0 & 31;
    const int i0 = 8 * (lane & 3); const bool lowD = i0 < 16; const int iD = i0 & 15, mp = l7 >> 2;
    constexpr int RU = 2; const int rstep = C.G * 8;
    for (int rbase = C.bid * 8 + C.wave; rbase < T_ALL; rbase += RU * rstep) {
        v4u pa[RU], pc1[RU], pc2[RU]; f32x4 ca[RU][2], sa[RU][2], cd[RU][2], sd[RU][2];
#pragma unroll
        for (int u2 = 0; u2 < RU; ++u2) { const int rr = rbase + u2 * rstep; const int r = rr < T_ALL ? rr : rbase; const bf16* pr = proj + (size_t)r * N_PROJ;
            pa[u2] = *(const v4u*)(pr + 8 * lane); pc1[u2] = *(const v4u*)(pr + C_CQ + 8 * lane); pc2[u2] = *(const v4u*)(pr + C_CV + 8 * (lane & 31));
            const int t = r < T_L ? r % SEQ : 0;
            ca[u2][0] = *(const f32x4*)(tab + (size_t)t * 32 + jA); ca[u2][1] = *(const f32x4*)(tab + (size_t)t * 32 + jA + 4);
            sa[u2][0] = *(const f32x4*)(tab + (size_t)SEQ * 32 + (size_t)t * 32 + jA); sa[u2][1] = *(const f32x4*)(tab + (size_t)SEQ * 32 + (size_t)t * 32 + jA + 4);
            cd[u2][0] = *(const f32x4*)(tab + (size_t)SEQ * 64 + (size_t)t * 16 + iD); cd[u2][1] = *(const f32x4*)(tab + (size_t)SEQ * 64 + (size_t)t * 16 + iD + 4);
            sd[u2][0] = *(const f32x4*)(tab + (size_t)SEQ * 80 + (size_t)t * 16 + iD); sd[u2][1] = *(const f32x4*)(tab + (size_t)SEQ * 80 + (size_t)t * 16 + iD + 4); }
#pragma unroll
        for (int u2 = 0; u2 < RU; ++u2) { const int r = rbase + u2 * rstep; if (r >= T_ALL) continue;
            const bool lat = r < T_L; const int b = lat ? r / SEQ : (r - T_L) / LC; const int t = lat ? r % SEQ : (r - T_L) % LC; const int pos = lat ? t : SEQ + t;
            { float x[8]; u8f(pa[u2], x);
              if (lane < 48) { float ss = 0.f;
#pragma unroll
                  for (int e = 0; e < 8; ++e) ss += x[e] * x[e];
                  const float rinv = __builtin_amdgcn_rsqf(group_sum<8>(ss) * (1.f / 64.f) + NORM_EPS);
#pragma unroll
                  for (int e = 0; e < 8; ++e) x[e] *= rinv * gA[e]; }
              float o[8];
#pragma unroll
              for (int e = 0; e < 8; ++e) { const float pe = __shfl_xor(x[e], 4); const float c = lat ? ca[u2][e >> 2][e & 3] : 1.f, s = lat ? sa[u2][e >> 2][e & 3] : 0.f;
                  o[e] = lowA ? x[e] * c - pe * s : pe * s + x[e] * c; }
              if (lane < 32) { const int hq = lane >> 3;
#pragma unroll
                  for (int e = 0; e < 8; ++e) o[e] *= C2A;
                  bf16* q = lat ? QL + ((size_t)(b * 12 + hq) * SEQ + t) * 64 : QC + ((size_t)(b * 12 + hq) * LC + t) * 64; *(v4u*)(q + d0) = f8u(o); }
              else if (lane < 48) { const int kvh = (lane - 32) >> 3; *(v4u*)(KB + ((size_t)(b * 6 + kvh) * NKEY + pos) * 64 + d0) = f8u(o); }
              else { const int kvh = (lane - 48) >> 3; *(v4u*)(VB + ((size_t)(b * 6 + kvh) * NKEY + pos) * 64 + d0) = pa[u2]; } }
            { float x[8]; u8f(pc1[u2], x); float o[8];
#pragma unroll
              for (int e = 0; e < 8; ++e) { const float pe = __shfl_xor(x[e], 2); const float c = lat ? cd[u2][e >> 2][e & 3] : 1.f, s = lat ? sd[u2][e >> 2][e & 3] : 0.f;
                  o[e] = lowD ? x[e] * c - pe * s : pe * s + x[e] * c; }
              const int hc = (lane & 31) >> 3;
              if (lane < 32) { const int vh = 4 + 2 * hc + mp;
#pragma unroll
                  for (int e = 0; e < 8; ++e) o[e] *= C2D;
                  bf16* q = lat ? QL + ((size_t)(b * 12 + vh) * SEQ + t) * 64 : QC + ((size_t)(b * 12 + vh) * LC + t) * 64;
                  *(v4u*)(q + mp * 32 + i0) = f8u(o); *(v4u*)(q + (1 - mp) * 32 + i0) = (v4u){0u, 0u, 0u, 0u}; }
              else { *(v4u*)(KB + ((size_t)(b * 6 + 2 + hc) * NKEY + pos) * 64 + d0) = f8u(o); } }
            if (lane < 32) { const int hv = lane >> 3; *(v4u*)(VB + ((size_t)(b * 6 + 2 + hv) * NKEY + pos) * 64 + d0) = pc2[u2]; }
        }
    }
}

DEVI void ph_gmlp(const Ctx& C, int layer, int ntok) {
    constexpr int VP = 136, SP = 68;
    LAS bf16* vnT = (LAS bf16*)C.lds;
    LAS float* rinv = (LAS float*)(vnT + 64 * VP);
    LAS float* spT = rinv + 128;
    const bf16* proj = WSP(const bf16, WS_PROJ); bf16* mix = WSP(bf16, WS_MIX);
    const float* gvn = INP(12) + layer * 256;
    const int tid0 = C.tid;
    constexpr int NSCAN = NB * 16; const int total = (ntok / 128) * 4; const bool split = C.G > NSCAN && total > 2 * NSCAN;
    const int ufirst = !split ? C.bid : (C.bid < NSCAN ? C.bid : 2 * NSCAN + (C.bid - NSCAN)), ustride = !split ? C.G : (C.bid < NSCAN ? NSCAN : C.G - NSCAN), uend = (split && C.bid < NSCAN) ? 2 * NSCAN : total;
    for (int u = ufirst; u < uend; u += ustride) {
        int tid = tid0; LAUNDER_V(tid);
        const int chunk = u >> 2, g = u & 3; const int row0 = chunk * 128;
        const int lane = tid & 63, wv = __builtin_amdgcn_readfirstlane(tid >> 6), l15 = lane & 15, q = lane >> 4;
        bf16x8 afr[4];
        { const float* wsr = INP(13) + ((size_t)layer * 4 + g) * 128 * 128 + (size_t)(16 * wv + l15) * 128 + 8 * q;
#pragma unroll
          for (int kk = 0; kk < 4; ++kk) { const f32x4 a0 = *(const f32x4*)(wsr + 32 * kk), a1 = *(const f32x4*)(wsr + 32 * kk + 4);
              const v4u ap = {pk2(a0.x, a0.y), pk2(a0.z, a0.w), pk2(a1.x, a1.y), pk2(a1.z, a1.w)}; afr[kk] = __builtin_bit_cast(bf16x8, ap); } }
        { const int tok = tid >> 2, qd = tid & 3; const bf16* p = proj + (size_t)(row0 + tok) * N_PROJ + C_BV + qd * 64; float ss = 0.f;
#pragma unroll
          for (int c8 = 0; c8 < 8; ++c8) { const v4u w = *(const v4u*)(p + c8 * 8);
              const float a0 = gelu_tanh(bflo(w.x)), a1 = gelu_tanh(bfhi(w.x)), a2 = gelu_tanh(bflo(w.y)), a3 = gelu_tanh(bfhi(w.y)), a4 = gelu_tanh(bflo(w.z)), a5 = gelu_tanh(bfhi(w.z)), a6 = gelu_tanh(bflo(w.w)), a7 = gelu_tanh(bfhi(w.w));
              ss += (a0 * a0 + a1 * a1) + (a2 * a2 + a3 * a3) + (a4 * a4 + a5 * a5) + (a6 * a6 + a7 * a7); }
          ss = group_sum<4>(ss); if (qd == 0) rinv[tok] = __builtin_amdgcn_rsqf(ss * (1.f / 256.f) + NORM_EPS); }
        __syncthreads();
        { const int tok = tid >> 2, c0 = (tid & 3) * 16; const bf16* p = proj + (size_t)(row0 + tok) * N_PROJ + C_BV + g * 64 + c0; const float ri = rinv[tok];
          const v4u w0 = *(const v4u*)p, w1 = *(const v4u*)(p + 8); const unsigned ww[8] = {w0.x, w0.y, w0.z, w0.w, w1.x, w1.y, w1.z, w1.w};
#pragma unroll
          for (int c = 0; c < 16; ++c) { const float x = (c & 1) ? bfhi(ww[c >> 1]) : bflo(ww[c >> 1]); vnT[(c0 + c) * VP + tok] = (bf16)f2bf(gelu_tanh(x) * ri * gvn[g * 64 + c0 + c]); } }
        __syncthreads();
        { f32x4 acc[4];
#pragma unroll
          for (int n = 0; n < 4; ++n) acc[n] = (f32x4){0.f, 0.f, 0.f, 0.f};
#pragma unroll
          for (int kk = 0; kk < 4; ++kk)
#pragma unroll
              for (int n = 0; n < 4; ++n) acc[n] = __builtin_amdgcn_mfma_f32_16x16x32_bf16(afr[kk], *(const LAS bf16x8*)(vnT + (16 * n + l15) * VP + 32 * kk + 8 * q), acc[n], 0, 0, 0);
          const float* bs = INP(14) + ((size_t)layer * 4 + g) * 128;
#pragma unroll
          for (int r = 0; r < 4; ++r) { const int tok = 16 * wv + 4 * q + r; const float bb = bs[tok];
#pragma unroll
              for (int n = 0; n < 4; ++n) spT[tok * SP + 16 * n + l15] = acc[n][r] + bb; } }
        __syncthreads();
        { const int tok = tid >> 2, c0 = (tid & 3) * 16; const size_t rowp = (size_t)(row0 + tok);
          const bf16* pu = proj + rowp * N_PROJ + C_BU + g * 64 + c0; const v4u u0 = *(const v4u*)pu, u1 = *(const v4u*)(pu + 8); const unsigned uw[8] = {u0.x, u0.y, u0.z, u0.w, u1.x, u1.y, u1.z, u1.w};
          float o[16];
#pragma unroll
          for (int c4 = 0; c4 < 4; ++c4) { const f32x4 sp = *(const LAS f32x4*)(spT + tok * SP + c0 + 4 * c4);
              o[4 * c4 + 0] = gelu_tanh(bflo(uw[2 * c4])) * sp.x; o[4 * c4 + 1] = gelu_tanh(bfhi(uw[2 * c4])) * sp.y; o[4 * c4 + 2] = gelu_tanh(bflo(uw[2 * c4 + 1])) * sp.z; o[4 * c4 + 3] = gelu_tanh(bfhi(uw[2 * c4 + 1])) * sp.w; }
          bf16* po = mix + rowp * D + 256 + g * 64 + c0;
          *(v4u*)po = (v4u){pk2(o[0], o[1]), pk2(o[2], o[3]), pk2(o[4], o[5]), pk2(o[6], o[7])}; *(v4u*)(po + 8) = (v4u){pk2(o[8], o[9]), pk2(o[10], o[11]), pk2(o[12], o[13]), pk2(o[14], o[15])}; }
        __syncthreads();
    }
}

DEVI int dn_kmap(int kk, int q, int j) { return 16 * (2 * kk + (j >> 2)) + 4 * q + (j & 3); }
DEVI size_t dn_unit_off(int b, int dir, int h, int sc) { return ((size_t)((b * 2 + dir) * 4 + h) * NCH + sc) * DN_UNIT_BYTES; }
constexpr int DP = 68, XP = 132, HP = 72;
DEVI f32x4 mfma16(bf16x8 a, bf16x8 b, f32x4 c) { return __builtin_amdgcn_mfma_f32_16x16x32_bf16(a, b, c, 0, 0, 0); }
#ifndef D1REP
#define D1REP 0
#endif
#define DN_BAR() asm volatile("s_waitcnt lgkmcnt(0)\n\ts_barrier" ::: "memory")
DEVI void ph_dn_chunk(const Ctx& C, int layer) {
    LAS bf16* kN = (LAS bf16*)C.lds;
    LAS bf16* qN = kN + 64 * HP;
    LAS bf16* kT = qN + 64 * HP;
    LAS bf16* QKd = kT + 64 * HP;
    LAS bf16* RT = QKd + 64 * HP;
    LAS bf16* XT = RT;
    LAS bf16* TiB = RT + 128 * HP;
    LAS float* Am = (LAS float*)(TiB + 64 * HP);
    LAS float* TI = Am + 64 * DP;
    LAS bf16* XdT = (LAS bf16*)Am;
    LAS float* TMP = TI + 64 * DP;
    LAS float* vec = TMP + 1280;
    LAS float* betav = vec; LAS float* cum = vec + 64; LAS float* ecum = vec + 128; LAS float* dvec = vec + 192; LAS float* bec = vec + 256;
    LAS float* cwl = vec + 320;
    LAS float* gpar = cwl + 2304;
    static_assert(128 * HP * 2 <= 2 * 64 * DP * 4 && (4 * 64 * HP + 128 * HP + 64 * HP) * 2 + (2 * 64 * DP + 1280 + 320 + 2304 + 16) * 4 <= MISC_OFF, "D1 LDS");
    const bf16* proj = WSP(const bf16, WS_PROJ); const float* BA = WSP(const float, WS_BA);
    { const float* cwg = INP(20) + (size_t)layer * 3 * 768; for (int i = C.tid; i < 2304; i += 512) cwl[i] = cwg[i];
      if (C.tid < 8) gpar[C.tid] = -fast_exp(INP(21)[layer * 8 + C.tid]); else if (C.tid < 16) gpar[C.tid] = INP(22)[layer * 8 + C.tid - 8]; }
    __syncthreads();
    const LAS float* cw = cwl;
    const int tid0 = C.tid;
#define FRESH_TID() int tid = tid0; LAUNDER_V(tid)
#define DN_DECODE(u_) const int tcx = (u_) % NCH, h = ((u_) / NCH) & 3, dir = ((u_) / (NCH * 4)) & 1, b = (u_) / (NCH * 8); \
        const bool isc = tcx < NCH_C; const int tc = isc ? tcx : tcx - NCH_C; const int nch = isc ? NCH_C : NCH_L; const int len = nch * 64; \
        const int row_seq0 = isc ? T_L + b * LC : b * SEQ
    v4u rw[3][3]; float rb0 = 0.f, rb1 = 0.f, rb2 = 0.f;
#define DN_LOAD(u_) do { if ((u_) < NB * 2 * 4 * NCH) { DN_DECODE(u_); int t_ = tid0; LAUNDER_V(t_); const int c = t_ >> 3, d0 = (t_ & 7) * 8; const int tl = tc * 64 + (dir ? 63 - c : c); const size_t r = (size_t)row_seq0 + tl; \
        const bool hp = tl > 0, hn = tl < len - 1; \
        _Pragma("unroll") for (int w3 = 0; w3 < 3; ++w3) { const bf16* p = proj + r * N_PROJ + C_DQKV + w3 * 256 + h * 64 + d0; \
            rw[w3][1] = *(const v4u*)p; rw[w3][0] = (v4u){0u, 0u, 0u, 0u}; rw[w3][2] = (v4u){0u, 0u, 0u, 0u}; if (hp) rw[w3][0] = *(const v4u*)(p - N_PROJ); if (hn) rw[w3][2] = *(const v4u*)(p + N_PROJ); } \
        rb0 = BA[r * 16 + dir * 4 + h]; \
        if (t_ < 64) { const int tl2 = tc * 64 + (dir ? 63 - t_ : t_); const float* ba = BA + ((size_t)row_seq0 + tl2) * 16; rb1 = ba[dir * 4 + h]; rb2 = ba[8 + dir * 4 + h]; } } } while (0)
    DN_LOAD(C.bid);
    for (int u = C.bid; u < NB * 2 * 4 * NCH; u += C.G) {
        DN_DECODE(u);
        const int sc = (isc ? 0 : NCH_C) + (dir ? nch - 1 - tc : tc);
        { FRESH_TID(); const int c = tid >> 3, part = tid & 7, d0 = part * 8;
          float y[3][8];
#pragma unroll
          for (int w3 = 0; w3 < 3; ++w3) { const int col = w3 * 256 + h * 64 + d0;
              const v4u xc = rw[w3][1], xp = rw[w3][0], xn = rw[w3][2];
              const unsigned xcw[4] = {xc.x, xc.y, xc.z, xc.w}, xpw[4] = {xp.x, xp.y, xp.z, xp.w}, xnw[4] = {xn.x, xn.y, xn.z, xn.w};
#pragma unroll
              for (int e = 0; e < 8; ++e) { const float a = (e & 1) ? bfhi(xpw[e >> 1]) : bflo(xpw[e >> 1]), m = (e & 1) ? bfhi(xcw[e >> 1]) : bflo(xcw[e >> 1]), n = (e & 1) ? bfhi(xnw[e >> 1]) : bflo(xnw[e >> 1]);
                  y[w3][e] = siluf_(cw[col + e] * a + cw[768 + col + e] * m + cw[1536 + col + e] * n); } }
          const float ba_b = rb0, ba_b2 = rb1, ba_a2 = rb2;
          DN_LOAD(u + C.G);
          float sq = 0.f, sk = 0.f;
#pragma unroll
          for (int e = 0; e < 8; ++e) { sq += y[0][e] * y[0][e]; sk += y[1][e] * y[1][e]; }
          sq = group_sum<8>(sq); sk = group_sum<8>(sk);
          const float rq = __builtin_amdgcn_rsqf(sq + NORM_EPS) * 0.125f, rk = __builtin_amdgcn_rsqf(sk + NORM_EPS);
          const float betac = sigmoidf_(ba_b);
#pragma unroll
          for (int e = 0; e < 8; ++e) { y[0][e] *= rq; y[1][e] *= rk; kT[(d0 + e) * HP + c] = (bf16)f2bf(y[1][e]); RT[(d0 + e) * HP + c] = (bf16)f2bf(betac * y[2][e]); }
          *(LAS v4u*)(qN + c * HP + d0) = (v4u){pk2(y[0][0], y[0][1]), pk2(y[0][2], y[0][3]), pk2(y[0][4], y[0][5]), pk2(y[0][6], y[0][7])};
          *(LAS v4u*)(kN + c * HP + d0) = (v4u){pk2(y[1][0], y[1][1]), pk2(y[1][2], y[1][3]), pk2(y[1][4], y[1][5]), pk2(y[1][6], y[1][7])};
          *(LAS v4u*)(QKd + c * HP + d0) = (v4u){0u, 0u, 0u, 0u};
          { LAS f32x4* z = (LAS f32x4*)TI; z[tid] = (f32x4){0.f, 0.f, 0.f, 0.f}; z[tid + 512] = (f32x4){0.f, 0.f, 0.f, 0.f}; if (tid < 64) z[tid + 1024] = (f32x4){0.f, 0.f, 0.f, 0.f}; }
          if (tid < 64) { const int c2 = tid;
              const float bt = sigmoidf_(ba_b2);
              float sg = gpar[dir * 4 + h] * softplusf_(ba_a2 + gpar[8 + dir * 4 + h]);
#pragma unroll
              for (int o = 1; o < 64; o <<= 1) { const float t = __shfl_up(sg, o); if (c2 >= o) sg += t; }
              const float G = __shfl(sg, 63); const float ec = fast_exp(sg);
              betav[c2] = bt; cum[c2] = sg; ecum[c2] = ec; dvec[c2] = fast_exp(G - sg); bec[c2] = bt * ec; } }
        DN_BAR();
        for (int rp_ = 0; rp_ < 1 + (((D1REP) >> 1) & 1); ++rp_) {
        { FRESH_TID(); const int lane = tid & 63, wv = __builtin_amdgcn_readfirstlane(tid >> 6), l15 = lane & 15, q = lane >> 4;
          { const int k = tid >> 3, c0 = (tid & 7) * 8; const v4u kk4 = *(const LAS v4u*)(kT + k * HP + c0); const unsigned kw[4] = {kk4.x, kk4.y, kk4.z, kk4.w}; unsigned ow[4];
#pragma unroll
            for (int e = 0; e < 4; ++e) ow[e] = pk2(bflo(kw[e]) * bec[c0 + 2 * e], bfhi(kw[e]) * bec[c0 + 2 * e + 1]);
            *(LAS v4u*)(RT + (64 + k) * HP + c0) = (v4u){ow[0], ow[1], ow[2], ow[3]}; }
#pragma unroll
          for (int tt = 0; tt < 3; ++tt) { const int t = wv + 8 * tt; if (t >= 20) break;
              const bool isq = t >= 10; const int idx = isq ? t - 10 : t; const int ti = (idx >= 6) ? 3 : (idx >= 3) ? 2 : (idx >= 1) ? 1 : 0; const int tj = idx - ti * (ti + 1) / 2;
              const LAS bf16* asrc = (isq ? qN : kN) + (16 * ti + l15) * HP + 8 * q; const LAS bf16* bsrc = kN + (16 * tj + l15) * HP + 8 * q;
              f32x4 acc = {0.f, 0.f, 0.f, 0.f};
              acc = mfma16(*(const LAS bf16x8*)asrc, *(const LAS bf16x8*)bsrc, acc); acc = mfma16(*(const LAS bf16x8*)(asrc + 32), *(const LAS bf16x8*)(bsrc + 32), acc);
              const int j = 16 * tj + l15; const float cj = cum[j];
#pragma unroll
              for (int r = 0; r < 4; ++r) { const int i = 16 * ti + 4 * q + r; const float dec = fast_exp(cum[i] - cj);
                  if (isq) QKd[i * HP + j] = (bf16)f2bf((i >= j) ? acc[r] * dec : 0.f); else Am[i * DP + j] = (i > j) ? acc[r] * dec * betav[i] : 0.f; } } }
        DN_BAR();
        }
        for (int rp_ = 0; rp_ < 1 + (((D1REP) >> 2) & 1); ++rp_) {
        { FRESH_TID(); if (tid < 64) { const int bb = tid >> 4, col = tid & 15; float x[16];
#pragma unroll
            for (int r = 0; r < 16; ++r) { float s = (r == col) ? 1.f : 0.f;
#pragma unroll
                for (int s2 = 0; s2 < r; ++s2) s -= Am[(16 * bb + r) * DP + 16 * bb + s2] * x[s2];
                x[r] = s; }
#pragma unroll
            for (int r = 0; r < 16; ++r) TI[(16 * bb + r) * DP + 16 * bb + col] = x[r]; } }
        DN_BAR();
        }
        for (int rp_ = 0; rp_ < 1 + (((D1REP) >> 3) & 1); ++rp_) {
        { FRESH_TID(); const int p = tid >> 8, r = (tid >> 4) & 15, c = tid & 15; float e = 0.f;
#pragma unroll
          for (int s2 = 0; s2 < 16; ++s2) e += Am[(32 * p + 16 + r) * DP + 32 * p + s2] * TI[(32 * p + s2) * DP + 32 * p + c];
          TMP[(p * 16 + r) * 17 + c] = e;
          DN_BAR();
          float f = 0.f;
#pragma unroll
          for (int s2 = 0; s2 < 16; ++s2) f -= TI[(32 * p + 16 + r) * DP + 32 * p + 16 + s2] * TMP[(p * 16 + s2) * 17 + c];
          TI[(32 * p + 16 + r) * DP + 32 * p + c] = f; }
        DN_BAR();
        }
        for (int rp_ = 0; rp_ < 1 + (((D1REP) >> 4) & 1); ++rp_) {
        { FRESH_TID(); const int r = tid >> 4, c2 = (tid & 15) * 2; float e0 = 0.f, e1 = 0.f;
#pragma unroll 8
          for (int s2 = 0; s2 < 32; ++s2) { const float a = Am[(32 + r) * DP + s2]; e0 += a * TI[s2 * DP + c2]; e1 += a * TI[s2 * DP + c2 + 1]; }
          TMP[r * 36 + c2] = e0; TMP[r * 36 + c2 + 1] = e1;
          DN_BAR();
          float f0 = 0.f, f1 = 0.f;
#pragma unroll 8
          for (int s2 = 0; s2 < 32; ++s2) { const float a = TI[(32 + r) * DP + 32 + s2]; f0 -= a * TMP[s2 * 36 + c2]; f1 -= a * TMP[s2 * 36 + c2 + 1]; }
          TI[(32 + r) * DP + c2] = f0; TI[(32 + r) * DP + c2 + 1] = f1; }
        DN_BAR();
        }
        for (int rp_ = 0; rp_ < 1 + (((D1REP) >> 5) & 1); ++rp_) {
        { FRESH_TID(); const int c = tid >> 3, c0 = (tid & 7) * 8; float x[8];
#pragma unroll
          for (int e = 0; e < 8; ++e) x[e] = (c0 + e <= c) ? TI[c * DP + c0 + e] : 0.f;
          *(LAS v4u*)(TiB + c * HP + c0) = (v4u){pk2(x[0], x[1]), pk2(x[2], x[3]), pk2(x[4], x[5]), pk2(x[6], x[7])}; }
        DN_BAR();
        }
        { FRESH_TID(); const int lane = tid & 63, wv = __builtin_amdgcn_readfirstlane(tid >> 6), l15 = lane & 15, q = lane >> 4;
          f32x4 xa[4]; const LAS bf16* bsrc = RT + (16 * wv + l15) * HP + 8 * q; const bf16x8 b0 = *(const LAS bf16x8*)bsrc, b1 = *(const LAS bf16x8*)(bsrc + 32);
#pragma unroll
          for (int m = 0; m < 4; ++m) { const LAS bf16* asrc = TiB + (16 * m + l15) * HP + 8 * q; f32x4 a_ = {0.f, 0.f, 0.f, 0.f};
              a_ = mfma16(*(const LAS bf16x8*)asrc, b0, a_); xa[m] = mfma16(*(const LAS bf16x8*)(asrc + 32), b1, a_); }
          DN_BAR();
          const int col = 16 * wv + l15;
#pragma unroll
          for (int m = 0; m < 4; ++m) { const int c0 = 16 * m + 4 * q; const f32x4 x = xa[m];
              *(LAS v2u*)(XT + col * HP + c0) = (v2u){pk2(x.x, x.y), pk2(x.z, x.w)};
              *(LAS v2u*)(XdT + col * HP + c0) = (v2u){pk2(x.x * dvec[c0], x.y * dvec[c0 + 1]), pk2(x.z * dvec[c0 + 2], x.w * dvec[c0 + 3])}; } }
        DN_BAR();
        for (int rp_ = 0; rp_ < 1 + (((D1REP) >> 7) & 1); ++rp_) {
        { FRESH_TID(); const int lane = tid & 63, wv = __builtin_amdgcn_readfirstlane(tid >> 6), l15 = lane & 15, q = lane >> 4;
          unsigned char* ub = WSP(unsigned char, WS_DNF + dn_unit_off(b, dir, h, sc));
          const float eG = ecum[63];
#define DN_MM(dst, Ap, Bp) do { f32x4 a_ = {0.f, 0.f, 0.f, 0.f}; a_ = mfma16(*(const LAS bf16x8*)(Ap), *(const LAS bf16x8*)(Bp), a_); dst = mfma16(*(const LAS bf16x8*)((Ap) + 32), *(const LAS bf16x8*)((Bp) + 32), a_); } while (0)
#pragma unroll
          for (int t2 = 0; t2 < 2; ++t2) { const int t = 2 * wv + t2, m = t >> 2, n = t & 3; f32x4 acc;
              DN_MM(acc, kT + (16 * m + l15) * HP + 8 * q, XdT + (16 * n + l15) * HP + 8 * q);
              *(v2u*)(ub + 16384 + (size_t)((n * 4 + m) * 64 + lane) * 8) = (v2u){pk2(acc.x, acc.y), pk2(acc.z, acc.w)};
              DN_MM(acc, QKd + (16 * m + l15) * HP + 8 * q, XT + (16 * n + l15) * HP + 8 * q);
              *(v2u*)(ub + 24576 + (size_t)((n * 4 + m) * 64 + lane) * 8) = (v2u){pk2(acc.x, acc.y), pk2(acc.z, acc.w)}; }
          { const int n = wv >> 1, kk2 = wv & 1; f32x4 z0, z1, y0, y1;
            DN_MM(z0, XdT + (64 + 16 * (2 * kk2) + l15) * HP + 8 * q, kT + (16 * n + l15) * HP + 8 * q);
            DN_MM(z1, XdT + (64 + 16 * (2 * kk2 + 1) + l15) * HP + 8 * q, kT + (16 * n + l15) * HP + 8 * q);
            DN_MM(y0, XT + (64 + 16 * (2 * kk2) + l15) * HP + 8 * q, QKd + (16 * n + l15) * HP + 8 * q);
            DN_MM(y1, XT + (64 + 16 * (2 * kk2 + 1) + l15) * HP + 8 * q, QKd + (16 * n + l15) * HP + 8 * q);
            const int rowi = 16 * n + l15; float mv[8], qv[8]; const float ec = ecum[rowi];
#pragma unroll
            for (int e = 0; e < 8; ++e) { const int kp = 16 * (2 * kk2 + (e >> 2)) + 4 * q + (e & 3); const float zz = (e < 4) ? z0[e & 3] : z1[e & 3], yy = (e < 4) ? y0[e & 3] : y1[e & 3];
                mv[e] = ((kp == rowi) ? eG : 0.f) - zz; qv[e] = ec * bf2f(qN[rowi * HP + kp]) - yy; }
            *(v4u*)(ub + (size_t)((n * 2 + kk2) * 64 + lane) * 16) = (v4u){pk2(mv[0], mv[1]), pk2(mv[2], mv[3]), pk2(mv[4], mv[5]), pk2(mv[6], mv[7])};
            *(v4u*)(ub + 8192 + (size_t)((n * 2 + kk2) * 64 + lane) * 16) = (v4u){pk2(qv[0], qv[1]), pk2(qv[2], qv[3]), pk2(qv[4], qv[5]), pk2(qv[6], qv[7])}; }
#undef DN_MM
        }
        DN_BAR();
        }
    }
}
#undef FRESH_TID
#undef DN_BAR
#undef DN_LOAD
#undef DN_DECODE
DEVI bf16x8 dn_pack(const f32x4& a, const f32x4& b) { const v4u o = {pk2(a.x, a.y), pk2(a.z, a.w), pk2(b.x, b.y), pk2(b.z, b.w)}; return __builtin_bit_cast(bf16x8, o); }
#define SCAN_BAR() asm volatile("s_waitcnt lgkmcnt(0)\n\ts_barrier" ::: "memory")
DEVI unsigned cvtpk(float lo, float hi) { return pk2(lo, hi); }
DEVI bf16x8 dn_pack_hw(const f32x4& a, const f32x4& b) { const v4u o = {cvtpk(a.x, a.y), cvtpk(a.z, a.w), cvtpk(b.x, b.y), cvtpk(b.z, b.w)}; return __builtin_bit_cast(bf16x8, o); }
DEVI void ph_dn_scan(const Ctx& C, int layer) {
    constexpr int SLOTB = 24576, NS = 4, P = 8, NLD = 384, NPC = 4;
    static_assert(NCH % P == 0 || NCH % P == P / 2, "scan pipeline depth: whole groups of P steps plus at most one half group");
    const int lane = C.lane, q = lane >> 4, v16 = lane & 15;
    bf16* DNO = WSP(bf16, WS_DNO);
    for (int u = C.bid; u < NB * 2 * 4 * 2; u += C.G) {
        const int vp = u & 1, h = (u >> 1) & 3, dir = (u >> 3) & 1, b = u >> 4;
        const unsigned char* base = WSP(const unsigned char, WS_DNF + dn_unit_off(b, dir, h, 0));
        if (C.wave < 2) {
            const int vs = 2 * vp + C.wave;
            bf16x8 sf[2]; { const v4u z = {0u, 0u, 0u, 0u}; sf[0] = __builtin_bit_cast(bf16x8, z); sf[1] = sf[0]; }
            bf16* ob = DNO + (size_t)dir * T_ALL * 256 + h * 64 + vs * 16 + v16;
            SCAN_BAR();
#define SCAN_SEG(SGN, SC0, NCHS, SEQ0, LEN) do { \
            bf16* pm[4]; \
            _Pragma("unroll") for (int m = 0; m < 4; ++m) pm[m] = ob + ((long)(SEQ0) + ((SGN) < 0 ? (LEN) - 1 : 0) + (SGN) * (16 * m + 4 * q)) * 256; \
            _Pragma("unroll 1") for (int s2 = 0; s2 < (NCHS); ++s2) { \
                const LAS unsigned char* sl = C.lds + (((SC0) + s2) % NS) * SLOTB; \
                f32x4 o[4], d[4]; \
                _Pragma("unroll") for (int m = 0; m < 4; ++m) { \
                    const bf16x8 ma0 = *(const LAS bf16x8*)(sl + ((m * 2 + 0) * 64 + lane) * 16), ma1 = *(const LAS bf16x8*)(sl + ((m * 2 + 1) * 64 + lane) * 16); \
                    const bf16x8 qa0 = *(const LAS bf16x8*)(sl + 8192 + ((m * 2 + 0) * 64 + lane) * 16), qa1 = *(const LAS bf16x8*)(sl + 8192 + ((m * 2 + 1) * 64 + lane) * 16); \
                    const v2u ncp = *(const LAS v2u*)(sl + 16384 + ((C.wave * 4 + m) * 64 + lane) * 8), ocp = *(const LAS v2u*)(sl + 20480 + ((C.wave * 4 + m) * 64 + lane) * 8); \
                    const f32x4 nc = {bflo(ncp.x), bfhi(ncp.x), bflo(ncp.y), bfhi(ncp.y)}, oc = {bflo(ocp.x), bfhi(ocp.x), bflo(ocp.y), bfhi(ocp.y)}; \
                    d[m] = __builtin_amdgcn_mfma_f32_16x16x32_bf16(ma0, sf[0], nc, 0, 0, 0); d[m] = __builtin_amdgcn_mfma_f32_16x16x32_bf16(ma1, sf[1], d[m], 0, 0, 0); \
                    o[m] = __builtin_amdgcn_mfma_f32_16x16x32_bf16(qa0, sf[0], oc, 0, 0, 0); o[m] = __builtin_amdgcn_mfma_f32_16x16x32_bf16(qa1, sf[1], o[m], 0, 0, 0); } \
                sf[0] = dn_pack_hw(d[0], d[1]); sf[1] = dn_pack_hw(d[2], d[3]); \
                _Pragma("unroll") for (int m = 0; m < 4; ++m) { \
                    _Pragma("unroll") for (int i = 0; i < 4; ++i) pm[m][(SGN) * i * 256] = (bf16)f2bf(o[m][i]); \
                    pm[m] += (SGN) * 64 * 256; } \
                SCAN_BAR(); } } while (0)
            if (dir == 0) { SCAN_SEG(1, 0, NCH_C, T_L + b * LC, LC); SCAN_SEG(1, NCH_C, NCH_L, b * SEQ, SEQ); }
            else          { SCAN_SEG(-1, 0, NCH_C, T_L + b * LC, LC); SCAN_SEG(-1, NCH_C, NCH_L, b * SEQ, SEQ); }
#undef SCAN_SEG
        } else {
            const int lid = C.tid - 128;
            unsigned so[NPC], dofs[NPC];
#pragma unroll
            for (int i = 0; i < NPC; ++i) { const int pp = lid + NLD * i;
                so[i] = (pp < 1024) ? (unsigned)pp * 16u : (pp < 1280) ? 16384u + (unsigned)(vp * 256 + (pp - 1024)) * 16u : 24576u + (unsigned)(vp * 256 + (pp - 1280)) * 16u; dofs[i] = (unsigned)pp * 16u; }
            v4u buf[P][NPC];
#pragma unroll
            for (int s2 = 0; s2 < P; ++s2)
#pragma unroll
                for (int i = 0; i < NPC; ++i) buf[s2][i] = *(const v4u*)(base + (size_t)s2 * DN_UNIT_BYTES + so[i]);
#pragma unroll
            for (int i = 0; i < NPC; ++i) *(LAS v4u*)(C.lds + dofs[i]) = buf[0][i];
            SCAN_BAR();
#define SCAN_LD_STEP(j) do { const int step = sc + (j); const int nxt = (step + P < NCH) ? step + P : NCH - 1; \
                    _Pragma("unroll") for (int i = 0; i < NPC; ++i) buf[(j)][i] = *(const v4u*)(base + (size_t)nxt * DN_UNIT_BYTES + so[i]); \
                    LAS unsigned char* sl = C.lds + ((step + 1) % NS) * SLOTB; \
                    _Pragma("unroll") for (int i = 0; i < NPC; ++i) *(LAS v4u*)(sl + dofs[i]) = buf[((j) + 1) % P][i]; \
                    SCAN_BAR(); } while (0)
            int sc = 0;
#pragma unroll 1
            for (; sc + P <= NCH; sc += P) {
#pragma unroll
                for (int j = 0; j < P; ++j) SCAN_LD_STEP(j);
            }
            if (NCH % P) {
#pragma unroll
                for (int j = 0; j < P / 2; ++j) SCAN_LD_STEP(j);
            }
#undef SCAN_LD_STEP
        }
    }
}
#undef SCAN_BAR

DEVI void ph_finalize(const Ctx& C, int layer, int ntok) {
    const int lane = C.lane;
    const bf16* DNO = WSP(const bf16, WS_DNO); const bf16* proj = WSP(const bf16, WS_PROJ); bf16* mix = WSP(bf16, WS_MIX);
    const f32x4 ong = *(const f32x4*)(INP(23) + layer * 64 + ((4 * lane) & 63));
    constexpr int RU = 4; const int rstep = C.G * 8;
    for (int r0 = C.bid * 8 + C.wave; r0 < ntok; r0 += RU * rstep) {
        v2u zz[RU], d0[RU], d1[RU];
#pragma unroll
        for (int u2 = 0; u2 < RU; ++u2) { const int rr = r0 + u2 * rstep; const size_t r = rr < ntok ? rr : r0;
            d0[u2] = *(const v2u*)(DNO + r * 256 + 4 * lane); d1[u2] = *(const v2u*)(DNO + ((size_t)T_ALL + r) * 256 + 4 * lane);
            zz[u2] = *(const v2u*)(proj + r * N_PROJ + C_DZ + 4 * lane); }
#pragma unroll
        for (int u2 = 0; u2 < RU; ++u2) { const int rr = r0 + u2 * rstep; if (rr >= ntok) continue; const size_t r = rr;
            const f32x4 od = (f32x4){bflo(d0[u2].x), bfhi(d0[u2].x), bflo(d0[u2].y), bfhi(d0[u2].y)} + (f32x4){bflo(d1[u2].x), bfhi(d1[u2].x), bflo(d1[u2].y), bfhi(d1[u2].y)};
            const float ss = group_sum<16>((od.x * od.x + od.y * od.y) + (od.z * od.z + od.w * od.w));
            const float rinv = __builtin_amdgcn_rsqf(ss * (1.f / 64.f) + NORM_EPS);
            const f32x4 z = (f32x4){siluf_(bflo(zz[u2].x)), siluf_(bfhi(zz[u2].x)), siluf_(bflo(zz[u2].y)), siluf_(bfhi(zz[u2].y))};
            const f32x4 o = od * rinv * ong * z; v2u w; w.x = pk2(o.x, o.y); w.y = pk2(o.z, o.w); *(v2u*)(mix + r * D + 768 + 4 * lane) = w; }
    }
}

DEVI void ph_router(const Ctx& C, int layer, int ntok) {
    LAS float* lgt = (LAS float*)C.lds;
    LAS int* cnt = (LAS int*)(lgt + 8 * 16 * 33);
    if (C.tid < 32) cnt[C.tid] = 0;
    __syncthreads();
    const int nt = ntok / 16; const int t0 = (int)((long)C.bid * nt / C.G), t1 = (int)((long)(C.bid + 1) * nt / C.G);
    const float* gn = INP(7) + (size_t)layer * D;
    const int l15 = C.lane & 15, q = C.lane >> 4; LAS float* lg_w = lgt + C.wave * 16 * 33;
    const int nrem = (t1 - t0) & 7; const int t1w = nrem <= 2 ? t1 - nrem : t1;
    for (int t = t0 + C.wave; t < t1w; t += 8) {
        const int row0 = 16 * t, mrow = mod_row(row0);
        const bf16* xa = WSP(const bf16, WS_XRES) + (size_t)(row0 + l15) * D + 8 * q;
        const bf16* wb = (const bf16*)(WSP(const float, WS_RWP) + ((size_t)(layer * 9 + mrow) * NE + l15) * D) + 8 * q;
        f32x4 acc0 = {0.f, 0.f, 0.f, 0.f}, acc1 = {0.f, 0.f, 0.f, 0.f}; float ssq = 0.f;
#pragma unroll 4
        for (int kk = 0; kk < 32; ++kk) { const v4u aw = *(const v4u*)(xa + 32 * kk); const bf16x8 av = __builtin_bit_cast(bf16x8, aw);
            const bf16x8 h0 = *(const bf16x8*)(wb + 32 * kk), l0 = *(const bf16x8*)(wb + D + 32 * kk), h1 = *(const bf16x8*)(wb + (size_t)32 * D + 32 * kk), l1 = *(const bf16x8*)(wb + (size_t)33 * D + 32 * kk);
            ssq += ((bflo(aw.x) * bflo(aw.x) + bfhi(aw.x) * bfhi(aw.x)) + (bflo(aw.y) * bflo(aw.y) + bfhi(aw.y) * bfhi(aw.y))) + ((bflo(aw.z) * bflo(aw.z) + bfhi(aw.z) * bfhi(aw.z)) + (bflo(aw.w) * bflo(aw.w) + bfhi(aw.w) * bfhi(aw.w)));
            acc0 = __builtin_amdgcn_mfma_f32_16x16x32_bf16(av, h0, acc0, 0, 0, 0); acc1 = __builtin_amdgcn_mfma_f32_16x16x32_bf16(av, h1, acc1, 0, 0, 0);
            acc0 = __builtin_amdgcn_mfma_f32_16x16x32_bf16(av, l0, acc0, 0, 0, 0); acc1 = __builtin_amdgcn_mfma_f32_16x16x32_bf16(av, l1, acc1, 0, 0, 0); }
        ssq += __shfl_xor(ssq, 16); ssq += __shfl_xor(ssq, 32);
        const float rinv = __builtin_amdgcn_rsqf(ssq * (1.f / D) + NORM_EPS);
        const float* rb = WSP(const float, WS_RBP) + (size_t)(layer * 9 + mrow) * NE;
        const float bb0 = rb[l15], bb1 = rb[16 + l15];
#pragma unroll
        for (int r = 0; r < 4; ++r) { const float ri = __shfl(rinv, 4 * q + r); lg_w[(4 * q + r) * 33 + l15] = acc0[r] * ri + bb0; lg_w[(4 * q + r) * 33 + 16 + l15] = acc1[r] * ri + bb1; }
        LDS_WAIT();
        if (C.lane < 16) { const int r = row0 + C.lane; float lg[32];
#pragma unroll
            for (int e = 0; e < 32; ++e) lg[e] = lg_w[C.lane * 33 + e];
            int te[4]; float tv[4];
#pragma unroll
            for (int k = 0; k < 4; ++k) { float best = -INFINITY; int bi = 0;
#pragma unroll
                for (int e = 0; e < 32; ++e) if (lg[e] > best) { best = lg[e]; bi = e; }
#pragma unroll
                for (int e = 0; e < 32; ++e) lg[e] = (e == bi) ? -INFINITY : lg[e];
                te[k] = bi; tv[k] = best; }
            float ex[4], es = 0.f;
#pragma unroll
            for (int k = 0; k < 4; ++k) { ex[k] = fast_exp(tv[k] - tv[0]); es += ex[k]; }
            const float ri = 1.f / es;
#pragma unroll
            for (int k = 0; k < 4; ++k) { const int pos = __hip_atomic_fetch_add(&cnt[te[k]], 1, __ATOMIC_RELAXED, __HIP_MEMORY_SCOPE_WORKGROUP);
                WSP(int, WS_TOKE)[(size_t)r * 4 + k] = te[k]; WSP(float, WS_TOKG)[(size_t)r * 4 + k] = ex[k] * ri; WSP(int, WS_TOKP)[(size_t)r * 4 + k] = pos; } }
        LDS_WAIT();
        { const float* sh = mod_vec(C, layer, mrow, 3); const float* scl = mod_vec(C, layer, mrow, 4);
          f32x4 gm[4], sv[4];
#pragma unroll
          for (int j = 0; j < 4; ++j) { const int col = ((j & 2) ? 512 : 0) + 8 * C.lane + 4 * (j & 1); gm[j] = *(const f32x4*)(gn + col) * (*(const f32x4*)(scl + col) + 1.0f); sv[j] = *(const f32x4*)(sh + col); }
#pragma unroll 1
          for (int rr = 0; rr < 16; rr += 2) { v4u xw[2][2];
#pragma unroll
              for (int u2 = 0; u2 < 2; ++u2) { const bf16* xr = WSP(const bf16, WS_XRES) + (size_t)(row0 + rr + u2) * D; xw[u2][0] = *(const v4u*)(xr + 8 * C.lane); xw[u2][1] = *(const v4u*)(xr + 512 + 8 * C.lane); }
#pragma unroll
              for (int u2 = 0; u2 < 2; ++u2) { const float ri = __shfl(rinv, rr + u2); f32x4 f[4];
                  f[0] = (f32x4){bflo(xw[u2][0].x), bfhi(xw[u2][0].x), bflo(xw[u2][0].y), bfhi(xw[u2][0].y)} * ri * gm[0] + sv[0]; f[1] = (f32x4){bflo(xw[u2][0].z), bfhi(xw[u2][0].z), bflo(xw[u2][0].w), bfhi(xw[u2][0].w)} * ri * gm[1] + sv[1];
                  f[2] = (f32x4){bflo(xw[u2][1].x), bfhi(xw[u2][1].x), bflo(xw[u2][1].y), bfhi(xw[u2][1].y)} * ri * gm[2] + sv[2]; f[3] = (f32x4){bflo(xw[u2][1].z), bfhi(xw[u2][1].z), bflo(xw[u2][1].w), bfhi(xw[u2][1].w)} * ri * gm[3] + sv[3];
                  bf16* fr_ = WSP(bf16, WS_F) + (size_t)(row0 + rr + u2) * D;
                  *(v4u*)(fr_ + 8 * C.lane) = (v4u){pk2(f[0].x, f[0].y), pk2(f[0].z, f[0].w), pk2(f[1].x, f[1].y), pk2(f[1].z, f[1].w)};
                  *(v4u*)(fr_ + 512 + 8 * C.lane) = (v4u){pk2(f[2].x, f[2].y), pk2(f[2].z, f[2].w), pk2(f[3].x, f[3].y), pk2(f[3].z, f[3].w)}; } } }
    }
    LAS float* ssqp = (LAS float*)(cnt + 32); LAS float* rinvs = ssqp + 128;
    for (int t = t1w; t < t1; ++t) {
        const int row0 = 16 * t, mrow = mod_row(row0);
        { const bf16* xa = WSP(const bf16, WS_XRES) + (size_t)(row0 + l15) * D + 8 * q + 128 * C.wave;
          const bf16* wb = (const bf16*)(WSP(const float, WS_RWP) + ((size_t)(layer * 9 + mrow) * NE + l15) * D) + 8 * q + 128 * C.wave;
          f32x4 acc0 = {0.f, 0.f, 0.f, 0.f}, acc1 = {0.f, 0.f, 0.f, 0.f}; float ssq = 0.f;
#pragma unroll
          for (int kk = 0; kk < 4; ++kk) { const v4u aw = *(const v4u*)(xa + 32 * kk); const bf16x8 av = __builtin_bit_cast(bf16x8, aw);
              const bf16x8 h0 = *(const bf16x8*)(wb + 32 * kk), l0 = *(const bf16x8*)(wb + D + 32 * kk), h1 = *(const bf16x8*)(wb + (size_t)32 * D + 32 * kk), l1 = *(const bf16x8*)(wb + (size_t)33 * D + 32 * kk);
              ssq += ((bflo(aw.x) * bflo(aw.x) + bfhi(aw.x) * bfhi(aw.x)) + (bflo(aw.y) * bflo(aw.y) + bfhi(aw.y) * bfhi(aw.y))) + ((bflo(aw.z) * bflo(aw.z) + bfhi(aw.z) * bfhi(aw.z)) + (bflo(aw.w) * bflo(aw.w) + bfhi(aw.w) * bfhi(aw.w)));
              acc0 = __builtin_amdgcn_mfma_f32_16x16x32_bf16(av, h0, acc0, 0, 0, 0); acc1 = __builtin_amdgcn_mfma_f32_16x16x32_bf16(av, h1, acc1, 0, 0, 0);
              acc0 = __builtin_amdgcn_mfma_f32_16x16x32_bf16(av, l0, acc0, 0, 0, 0); acc1 = __builtin_amdgcn_mfma_f32_16x16x32_bf16(av, l1, acc1, 0, 0, 0); }
          ssq += __shfl_xor(ssq, 16); ssq += __shfl_xor(ssq, 32);
          if (q == 0) ssqp[C.wave * 16 + l15] = ssq;
#pragma unroll
          for (int r = 0; r < 4; ++r) { lg_w[(4 * q + r) * 33 + l15] = acc0[r]; lg_w[(4 * q + r) * 33 + 16 + l15] = acc1[r]; } }
        __syncthreads();
        if (C.wave == 0) {
            float s = 0.f;
#pragma unroll
            for (int w = 0; w < 8; ++w) s += ssqp[w * 16 + l15];
            const float rinv = __builtin_amdgcn_rsqf(s * (1.f / D) + NORM_EPS);
            if (q == 0) rinvs[l15] = rinv;
            const float* rb = WSP(const float, WS_RBP) + (size_t)(layer * 9 + mrow) * NE;
            const float bb0 = rb[l15], bb1 = rb[16 + l15];
            float a0[4], a1[4];
#pragma unroll
            for (int r = 0; r < 4; ++r) { a0[r] = 0.f; a1[r] = 0.f;
#pragma unroll
                for (int w = 0; w < 8; ++w) { a0[r] += lgt[w * 16 * 33 + (4 * q + r) * 33 + l15]; a1[r] += lgt[w * 16 * 33 + (4 * q + r) * 33 + 16 + l15]; } }
#pragma unroll
            for (int r = 0; r < 4; ++r) { const float ri = __shfl(rinv, 4 * q + r); lgt[(4 * q + r) * 33 + l15] = a0[r] * ri + bb0; lgt[(4 * q + r) * 33 + 16 + l15] = a1[r] * ri + bb1; }
            LDS_WAIT();
            if (C.lane < 16) { const int r = row0 + C.lane; float lg[32];
#pragma unroll
                for (int e = 0; e < 32; ++e) lg[e] = lgt[C.lane * 33 + e];
                int te[4]; float tv[4];
#pragma unroll
                for (int k = 0; k < 4; ++k) { float best = -INFINITY; int bi = 0;
#pragma unroll
                    for (int e = 0; e < 32; ++e) if (lg[e] > best) { best = lg[e]; bi = e; }
#pragma unroll
                    for (int e = 0; e < 32; ++e) lg[e] = (e == bi) ? -INFINITY : lg[e];
                    te[k] = bi; tv[k] = best; }
                float ex[4], es = 0.f;
#pragma unroll
                for (int k = 0; k < 4; ++k) { ex[k] = fast_exp(tv[k] - tv[0]); es += ex[k]; }
                const float ri = 1.f / es;
#pragma unroll
                for (int k = 0; k < 4; ++k) { const int pos = __hip_atomic_fetch_add(&cnt[te[k]], 1, __ATOMIC_RELAXED, __HIP_MEMORY_SCOPE_WORKGROUP);
                    WSP(int, WS_TOKE)[(size_t)r * 4 + k] = te[k]; WSP(float, WS_TOKG)[(size_t)r * 4 + k] = ex[k] * ri; WSP(int, WS_TOKP)[(size_t)r * 4 + k] = pos; } }
        }
        __syncthreads();
        { const float* sh = mod_vec(C, layer, mrow, 3); const float* scl = mod_vec(C, layer, mrow, 4);
          v4u xw[2][2];
#pragma unroll
          for (int u2 = 0; u2 < 2; ++u2) { const bf16* xr = WSP(const bf16, WS_XRES) + (size_t)(row0 + 2 * C.wave + u2) * D; xw[u2][0] = *(const v4u*)(xr + 8 * C.lane); xw[u2][1] = *(const v4u*)(xr + 512 + 8 * C.lane); }
          f32x4 gm[4], sv[4];
#pragma unroll
          for (int j = 0; j < 4; ++j) { const int col = ((j & 2) ? 512 : 0) + 8 * C.lane + 4 * (j & 1); gm[j] = *(const f32x4*)(gn + col) * (*(const f32x4*)(scl + col) + 1.0f); sv[j] = *(const f32x4*)(sh + col); }
#pragma unroll
          for (int u2 = 0; u2 < 2; ++u2) { const float ri = rinvs[2 * C.wave + u2]; f32x4 f[4];
              f[0] = (f32x4){bflo(xw[u2][0].x), bfhi(xw[u2][0].x), bflo(xw[u2][0].y), bfhi(xw[u2][0].y)} * ri * gm[0] + sv[0]; f[1] = (f32x4){bflo(xw[u2][0].z), bfhi(xw[u2][0].z), bflo(xw[u2][0].w), bfhi(xw[u2][0].w)} * ri * gm[1] + sv[1];
              f[2] = (f32x4){bflo(xw[u2][1].x), bfhi(xw[u2][1].x), bflo(xw[u2][1].y), bfhi(xw[u2][1].y)} * ri * gm[2] + sv[2]; f[3] = (f32x4){bflo(xw[u2][1].z), bfhi(xw[u2][1].z), bflo(xw[u2][1].w), bfhi(xw[u2][1].w)} * ri * gm[3] + sv[3];
              bf16* fr_ = WSP(bf16, WS_F) + (size_t)(row0 + 2 * C.wave + u2) * D;
              *(v4u*)(fr_ + 8 * C.lane) = (v4u){pk2(f[0].x, f[0].y), pk2(f[0].z, f[0].w), pk2(f[1].x, f[1].y), pk2(f[1].z, f[1].w)};
              *(v4u*)(fr_ + 512 + 8 * C.lane) = (v4u){pk2(f[2].x, f[2].y), pk2(f[2].z, f[2].w), pk2(f[3].x, f[3].y), pk2(f[3].z, f[3].w)}; } }
        __syncthreads();
    }
    __syncthreads();
    if (C.tid < 32) WSP(int, WS_BCNT)[C.bid * 32 + C.tid] = cnt[C.tid];
}

DEVI void ph_slots(const Ctx& C, int layer, int ntok) {
    LAS int* tot = (LAS int*)C.lds; LAS int* myoff = tot + 32; LAS int* base = tot + 64; LAS int* part = tot + 96;
    {
      const int e = C.tid & 31, grp = C.tid >> 5; int t = 0, o = 0; const int* bc = WSP(const int, WS_BCNT) + e;
#pragma unroll 4
      for (int b2 = grp; b2 < C.G; b2 += 16) { const int c = bc[b2 * 32]; t += c; if (b2 < C.bid) o += c; }
      part[grp * 64 + e] = t; part[grp * 64 + 32 + e] = o; }
    __syncthreads();
    if (C.tid < 64) { int a = 0;
#pragma unroll
        for (int g = 0; g < 16; ++g) a += part[g * 64 + C.tid];
        if (C.tid < 32) tot[C.tid] = a; else myoff[C.tid - 32] = a; }
    __syncthreads();
    if (C.tid == 0) { int acc = 0;
        for (int e = 0; e < 32; ++e) { base[e] = acc; acc += ((tot[e] + 255) >> 8) << 8; }
        if (C.bid == 0) WSP(int, WS_TEXP)[0] = acc >> 8; }
    __syncthreads();
    int* rowmap = WSP(int, WS_ROWMAP);
    for (int e = C.bid; e < 32; e += C.G) { const int lo = base[e] + tot[e], ntl = (tot[e] + 255) >> 8, hi2 = base[e] + (ntl << 8);
        if (C.tid < ntl) WSP(int, WS_TEXP)[1 + (base[e] >> 8) + C.tid] = e;
        for (int i = 512 + C.tid; i < ntl; i += 512) WSP(int, WS_TEXP)[1 + (base[e] >> 8) + i] = e;
        for (int i = lo + C.tid; i < hi2; i += 512) rowmap[i] = 0; }
    const int nt = ntok / 16; const int r0 = 16 * (int)((long)C.bid * nt / C.G), r1 = 16 * (int)((long)(C.bid + 1) * nt / C.G);
    for (int i = r0 * 4 + C.tid; i < r1 * 4; i += 512) { const int e = WSP(const int, WS_TOKE)[i]; const int slot = base[e] + myoff[e] + WSP(const int, WS_TOKP)[i];
        WSP(int, WS_SLOT)[i] = slot; rowmap[slot] = i >> 2; }
}

DEVI void ph_attention(const Ctx& C, bool need_ctx, int layer) {
    const attn_body::bf16* QL = WSP(const attn_body::bf16, WS_QL); const attn_body::bf16* QC = WSP(const attn_body::bf16, WS_QC);
    const attn_body::bf16* KB = WSP(const attn_body::bf16, WS_K); const attn_body::bf16* VB = WSP(const attn_body::bf16, WS_V);
    attn_body::bf16* mix = WSP(attn_body::bf16, WS_MIX);
    constexpr int NQL = SEQ / 128, NQC = LC / 128, UL = NB * 6 * NQL, UC = NB * 6 * NQC;
    const float lam_init = 0.8f - 0.6f * fast_exp(-0.3f * (float)layer); float lam;
    { float p1 = 0.f, p2 = 0.f; if (C.lane < 32) { p1 = INP(15)[layer * 32 + C.lane] * INP(16)[layer * 32 + C.lane]; p2 = INP(17)[layer * 32 + C.lane] * INP(18)[layer * 32 + C.lane]; }
      lam = fast_exp(wave_sum(p1)) - fast_exp(wave_sum(p2)) + lam_init; }
    const float post = 1.f - lam_init; const float* subln = INP(19) + layer * 64;
    const int total = UL + (need_ctx ? UC : 0);
    const int conv_at = (layer + 1 < DEPTH) ? (int)(C.bid % 6) : -1; int ui = 0; bool conv_done = false;
    const int conv0_at = (layer == 0) ? (int)((C.bid + 3) % 6) : -1; bool conv0_done = false;
    for (int u = (C.bid + C.G / 2) % C.G; u < total; u += C.G, ++ui) {
        if (ui == conv_at) { __syncthreads(); convert_layer_weights(C, layer + 1, 2); __syncthreads(); conv_done = true; }
        if (ui == conv0_at) { __syncthreads(); convert_layer_weights(C, 0, 1); __syncthreads(); conv0_done = true; }
        const bool isc = u >= UL; int qb, bp;
        if (!isc && (C.G & 7) == 0 && NQL == 32 && C.G == 256) { const int w = u % C.G, rnd = u / C.G; bp = rnd * 8 + (w & 7); qb = w >> 3; }
        else { const int v = isc ? u - UL : u; const int nq = isc ? NQC : NQL; qb = v % nq; bp = v / nq; }
        const int p = bp % 6, b = bp / 6;
        const int slen = isc ? LC : SEQ; const attn_body::bf16* Qbase = isc ? QC : QL;
        const attn_body::bf16* Qa = Qbase + ((size_t)(b * 12 + 2 * p) * slen + qb * 128) * 64; const attn_body::bf16* Qb = Qa + (size_t)slen * 64;
        const attn_body::bf16* Kh = KB + ((size_t)(b * 6 + p) * NKEY + (isc ? SEQ : 0)) * 64; const attn_body::bf16* Vh = VB + ((size_t)(b * 6 + p) * NKEY + (isc ? SEQ : 0)) * 64;
        const size_t row0 = (size_t)(isc ? T_L + b * LC : b * SEQ) + qb * 128;
        attn_body::bf16 *Oa, *Ob; int opitch;
        if (p < 2) { Oa = mix + row0 * D + (2 * p) * 64; Ob = Oa + 64; opitch = D; }
        else { Oa = mix + row0 * D + 512 + (p - 2) * 64; Ob = Oa; opitch = D; }
        const int ntile = isc ? LC / 64 : NKEY / 64;
        if (p < 2) attn_body::attn_unit<8, 0>(Qa, Qb, Kh, Vh, Oa, Ob, opitch, ntile, (char*)C.lds, lam, post, subln);
        else if (C.wave < 4) attn_body::attn_unit<8, 1>(Qa, Qb, Kh, Vh, Oa, Ob, opitch, ntile, (char*)C.lds, lam, post, subln);
        else attn_body::attn_unit<8, 2>(Qa, Qb, Kh, Vh, Oa, Ob, opitch, ntile, (char*)C.lds, lam, post, subln);
    }
    if (conv_at >= 0 && !conv_done) { __syncthreads(); convert_layer_weights(C, layer + 1, 2); __syncthreads(); }
    if (conv0_at >= 0 && !conv0_done) { __syncthreads(); convert_layer_weights(C, 0, 1); __syncthreads(); }
}

DEVI void ph_outproj_ctx(const Ctx& C, int layer) {
    const int l15 = C.lane & 15, q = C.lane >> 4, ks = C.wave & 3, ch = C.wave >> 2;
    const float* g = mod_vec(C, layer, 8, 2);
    LAS float* P = (LAS float*)C.lds; constexpr int PP = 132;
    for (int tile = C.bid; tile < (NB * LC / 64) * (D / 128); tile += C.G) {
        const int r0 = (tile >> 3) * 64, c0 = (tile & 7) * 128;
        const bf16* a = WSP(const bf16, WS_MIX) + (size_t)(T_L + r0 + l15) * D + 256 * ks + 8 * q;
        const bf16* b = WSP(const bf16, WS_WOUT) + (size_t)layer * D * D + (size_t)(c0 + 64 * ch + l15) * D + 256 * ks + 8 * q;
        f32x4 acc[4][4];
#pragma unroll
        for (int m = 0; m < 4; ++m)
#pragma unroll
            for (int n = 0; n < 4; ++n) acc[m][n] = (f32x4){0.f, 0.f, 0.f, 0.f};
#pragma unroll 4
        for (int kk = 0; kk < 8; ++kk) { bf16x8 av[4], bv[4];
#pragma unroll
            for (int m = 0; m < 4; ++m) av[m] = *(const bf16x8*)(a + (size_t)16 * m * D + 32 * kk);
#pragma unroll
            for (int n = 0; n < 4; ++n) bv[n] = *(const bf16x8*)(b + (size_t)16 * n * D + 32 * kk);
#pragma unroll
            for (int m = 0; m < 4; ++m)
#pragma unroll
                for (int n = 0; n < 4; ++n) acc[m][n] = __builtin_amdgcn_mfma_f32_16x16x32_bf16(bv[n], av[m], acc[m][n], 0, 0, 0); }
#pragma unroll
        for (int m = 0; m < 4; ++m)
#pragma unroll
            for (int n = 0; n < 4; ++n) *(LAS f32x4*)(P + (size_t)(ks * 64 + 16 * m + l15) * PP + 64 * ch + 16 * n + 4 * q) = acc[m][n];
        __syncthreads();
        { const int row = C.tid >> 3, cg = (C.tid & 7) * 16; f32x4 s[4];
#pragma unroll
          for (int i = 0; i < 4; ++i) { const LAS float* pp = P + (size_t)row * PP + cg + 4 * i;
              s[i] = (*(const LAS f32x4*)pp + *(const LAS f32x4*)(pp + 64 * PP)) + (*(const LAS f32x4*)(pp + 128 * PP) + *(const LAS f32x4*)(pp + 192 * PP)); }
          const size_t ro = (size_t)(r0 + row) * D + c0 + cg; bf16* xo = WSP(bf16, WS_XRES) + (size_t)T_L * D + ro;
          f32x4 xi[4];
          if (layer == 0) {
#pragma unroll
              for (int i = 0; i < 4; ++i) xi[i] = *(const f32x4*)(INP(2) + ro + 4 * i); }
          else { const v4u w0 = *(const v4u*)xo, w1 = *(const v4u*)(xo + 8);
              xi[0] = (f32x4){bflo(w0.x), bfhi(w0.x), bflo(w0.y), bfhi(w0.y)}; xi[1] = (f32x4){bflo(w0.z), bfhi(w0.z), bflo(w0.w), bfhi(w0.w)};
              xi[2] = (f32x4){bflo(w1.x), bfhi(w1.x), bflo(w1.y), bfhi(w1.y)}; xi[3] = (f32x4){bflo(w1.z), bfhi(w1.z), bflo(w1.w), bfhi(w1.w)}; }
          f32x4 v[4];
#pragma unroll
          for (int i = 0; i < 4; ++i) v[i] = xi[i] + *(const f32x4*)(g + c0 + cg + 4 * i) * s[i];
          *(v4u*)xo = (v4u){pk2(v[0].x, v[0].y), pk2(v[0].z, v[0].w), pk2(v[1].x, v[1].y), pk2(v[1].z, v[1].w)};
          *(v4u*)(xo + 8) = (v4u){pk2(v[2].x, v[2].y), pk2(v[2].z, v[2].w), pk2(v[3].x, v[3].y), pk2(v[3].z, v[3].w)}; }
        __syncthreads();
    }
}

constexpr int PH_PER_LAYER = 10, N_PHASES = 2 + DEPTH * PH_PER_LAYER;
struct Args { const float* in[31]; float* out; unsigned char* ws; int ph_lo, ph_hi; };
template <int MASK> __global__ void __launch_bounds__(512, 2) mk_fwd(Args args) {
    extern __shared__ __attribute__((aligned(16))) unsigned char lds_raw[];
    { LAS unsigned long long* pt = (LAS unsigned long long*)((LAS unsigned char*)lds_raw + PTR_OFF);
      if (threadIdx.x == 0) {
#pragma unroll
          for (int i = 0; i < 31; ++i) pt[i] = (unsigned long long)args.in[i]; } }
    volatile LAS unsigned* MISC = (volatile LAS unsigned*)((LAS unsigned char*)lds_raw + MISC_OFF);
    if (threadIdx.x < 32) MISC[threadIdx.x] = 0u;
    __syncthreads();
#define CTX() Ctx C; { int t_ = threadIdx.x; LAUNDER_V(t_); C.tid = t_; C.lane = t_ & 63; C.wave = __builtin_amdgcn_readfirstlane(t_ >> 6); int b_ = blockIdx.x; LAUNDER_S(b_); C.bid = b_; \
    int g_ = gridDim.x; LAUNDER_S(g_); C.G = g_; unsigned long long w_ = (unsigned long long)args.ws; LAUNDER_S(w_); C.wsi = w_; C.out = (float*)(GAS float*)(unsigned long long)args.out; C.lds = (LAS unsigned char*)lds_raw; }
    const int lo = args.ph_lo, hi = args.ph_hi;
#if MK_N_LAUNCHES == 1
    XcdBarrier bar = xcd_barrier_post((unsigned*)(args.ws + WS_CTL) + CW_BAR, MISC + 8);
#define GRID_BAR() xcd_barrier(bar)
#else
#define GRID_BAR() do {} while (0)
#endif
#define PHON(b) (((MASK) >> (b)) & 1)
#ifndef REP_MASK
#define REP_MASK 0
#endif
#define REP(b) for (int rp_ = 0; rp_ < 1 + (((REP_MASK) >> (b)) & 1); ++rp_)
#define REPX(b, cond) for (int rp_ = 0; rp_ < 1 + ((((REP_MASK) >> (b)) & 1) && (cond)); ++rp_)
#define IN(k) (lo <= (k) && (k) < hi)
#define SEAM(k) do { if (IN(k) && IN((k) + 1)) { GRID_BAR(); if (((REP_MASK) >> 17) & 1) GRID_BAR(); } } while (0)
    if (PHON(0) && IN(0)) REP(0) { CTX(); p0_prologue(C); } SEAM(0);
#define LAYER_BODY(layer) { \
        const int p0 = 1 + layer * PH_PER_LAYER; const bool need_ctx = layer < DEPTH - 1; const int ntok = need_ctx ? T_ALL : T_L; \
        if (PHON(1) && IN(p0 + 0)) REPX(15, layer == 0) { CTX(); ph_norm_mix(C, layer); } SEAM(p0 + 0); \
        if (PHON(2) && IN(p0 + 1)) REP(2) { CTX(); pg8::Gemm g{WSP(const pg8::bf16_t, WS_H), WSP(const pg8::bf16_t, WS_WIN) + (size_t)layer * N_PROJ * D, T_ALL, N_PROJ, D}; \
            pg8::StaticOrder S; S.init(T_ALL, N_PROJ, C.G, C.bid); pg8::EpiBf16<0> E{WSP(pg8::bf16_t, WS_PROJ), N_PROJ, nullptr, 0, 0, 1.f}; \
            pg8::gemm_phase<pg8::EpiBf16<0>, pg8::StaticOrder, true, true>(C.lds, g, S, E); } SEAM(p0 + 1); \
        if (IN(p0 + 2)) { if (PHON(3)) REP(3) { CTX(); ph_attn_prep(C, layer); } if (PHON(5)) REP(5) { CTX(); ph_dn_chunk(C, layer); } } SEAM(p0 + 2); \
        if (IN(p0 + 3)) { if (PHON(6)) REP(6) { CTX(); ph_dn_scan(C, layer); } __syncthreads(); if (PHON(4)) REP(4) { CTX(); ph_gmlp(C, layer, ntok); } __syncthreads(); if (PHON(7)) REP(7) { CTX(); ph_attention(C, need_ctx, layer); } } SEAM(p0 + 3); \
        if (PHON(8) && IN(p0 + 4)) REP(8) { CTX(); ph_finalize(C, layer, ntok); } SEAM(p0 + 4); \
        if (PHON(9) && IN(p0 + 5)) REPX(14, layer == 0) { CTX(); pg8::Gemm g{WSP(const pg8::bf16_t, WS_MIX), WSP(const pg8::bf16_t, WS_WOUT) + (size_t)layer * D * D, T_L, D, D}; \
            pg8::StaticOrder S; S.init(T_L, D, C.G, C.bid); \
            if (layer == 0) { pg8::EpiOutRes<true> E{INP(0), INP(2), WSP(pg8::bf16_t, WS_XRES), WSP(const float, WS_MOD) + (size_t)layer * 9 * 6 * D}; \
                pg8::gemm_phase<pg8::EpiOutRes<true>, pg8::StaticOrder, true, true>(C.lds, g, S, E); } \
            else { pg8::EpiOutRes<false> E{WSP(const pg8::bf16_t, WS_XRES), WSP(const pg8::bf16_t, WS_XRES) + (size_t)T_L * D, WSP(pg8::bf16_t, WS_XRES), WSP(const float, WS_MOD) + (size_t)layer * 9 * 6 * D}; \
                pg8::gemm_phase<pg8::EpiOutRes<false>, pg8::StaticOrder, true, true>(C.lds, g, S, E); } \
            if (need_ctx) ph_outproj_ctx(C, layer); } SEAM(p0 + 5); \
        if (PHON(10) && IN(p0 + 6)) REP(10) { CTX(); ph_router(C, layer, ntok); } SEAM(p0 + 6); \
        if (PHON(11) && IN(p0 + 7)) REP(11) { CTX(); ph_slots(C, layer, ntok); } SEAM(p0 + 7); \
        if (PHON(12) && IN(p0 + 8)) REP(12) { CTX(); pg8::Gemm g{WSP(const pg8::bf16_t, WS_F), WSP(const pg8::bf16_t, WS_WUP) + (size_t)layer * NE * 2 * DE * D, P_ROWS, NE * 2 * DE, D, WSP(const int, WS_ROWMAP)}; \
            pg8::MoeOrder S; S.init(WSP(const int, WS_TEXP), 8, C.G, C.bid); pg8::EpiSwiglu E{WSP(pg8::bf16_t, WS_HID), INP(27) + (size_t)layer * NE * 2 * DE}; \
            pg8::gemm_phase<pg8::EpiSwiglu, pg8::MoeOrder, true, true, true>(C.lds, g, S, E); } SEAM(p0 + 8); \
        if (PHON(13) && IN(p0 + 9)) REP(13) { CTX(); pg8::Gemm g{WSP(const pg8::bf16_t, WS_HID), WSP(const pg8::bf16_t, WS_WDN) + (size_t)layer * NE * D * DE, P_ROWS, NE * D, DE}; \
            pg8::MoeOrder S; S.init(WSP(const int, WS_TEXP), 4, C.G, C.bid); pg8::EpiDown E{WSP(unsigned char, WS_YS), INP(29) + (size_t)layer * NE * D}; \
            pg8::gemm_phase<pg8::EpiDown, pg8::MoeOrder, true, true>(C.lds, g, S, E); } SEAM(p0 + 9); \
    }
    static_assert(DEPTH <= 4, "layer sites");
    if constexpr (DEPTH > 0) LAYER_BODY(0)
    if constexpr (DEPTH > 1) LAYER_BODY(1)
    if constexpr (DEPTH > 2) LAYER_BODY(2)
    if constexpr (DEPTH > 3) LAYER_BODY(3)
#undef LAYER_BODY
    if (PHON(1) && IN(N_PHASES - 1)) REP(16) { CTX(); ph_norm_mix(C, DEPTH); }
#undef IN
#undef SEAM
}

#ifndef EMU
#ifndef FULL_MASK_V
#define FULL_MASK_V 0x3fff
#endif
constexpr int FULL_MASK = FULL_MASK_V;
typedef void (*kern_t)(Args);
static int phase_mask(int p) {
    if (p == 0) return 1; if (p == N_PHASES - 1) return 2;
    const int k = (p - 1) % PH_PER_LAYER; const int m[10] = {2, 4, 8 | 32, 16 | 64 | 128, 256, 512, 1024, 2048, 4096, 8192}; return m[k];
}
static kern_t kern_of_mask(int m) {
    switch (m) {
#if MK_N_LAUNCHES == 1
        case FULL_MASK: return mk_fwd<FULL_MASK>;
#else
        case 1: return mk_fwd<1>; case 2: return mk_fwd<2>; case 4: return mk_fwd<4>; case 8: return mk_fwd<8>; case 16: return mk_fwd<16>; case 32: return mk_fwd<32>; case 192: return mk_fwd<192>; case 256: return mk_fwd<256>;
        case 512: return mk_fwd<512>; case 1024: return mk_fwd<1024>; case 2048: return mk_fwd<2048>; case 4096: return mk_fwd<4096>; case 8192: return mk_fwd<8192>;
#endif
        default: return nullptr;
    }
}
extern "C" void kernel_launch(void* const* d_in, const int* in_sizes, int n_in, void* d_out, int out_size, void* d_ws, size_t ws_size, hipStream_t stream) {
    static int grid = 0;
    if (grid == 0) {
        if (n_in != 31 || in_sizes[0] != T_L * D || out_size != T_L * D || ws_size < WS_END) { fprintf(stderr, "kernel_launch: shape/workspace mismatch (n_in %d, in0 %d, out %d, ws %zu, need %zu)\n", n_in, n_in > 0 ? in_sizes[0] : -1, out_size, ws_size, (size_t)WS_END); grid = -1; return; }
        int dev = 0, cus = 0;
        if (hipGetDevice(&dev) != hipSuccess || hipDeviceGetAttribute(&cus, hipDeviceAttributeMultiprocessorCount, dev) != hipSuccess) { grid = -1; return; }
#if MK_N_LAUNCHES == 1
        const int masks[1] = {FULL_MASK}; const int nm = 1;
#else
        const int masks[13] = {1, 2, 4, 8, 16, 32, 192, 256, 512, 1024, 2048, 4096, 8192}; const int nm = 13;
#endif
        for (int i = 0; i < nm; ++i) {
            if (hipFuncSetAttribute((const void*)kern_of_mask(masks[i]), hipFuncAttributeMaxDynamicSharedMemorySize, LDS_BYTES) != hipSuccess) { fprintf(stderr, "kernel_launch: hipFuncSetAttribute failed\n"); grid = -1; return; }
            int per_cu = 0;
            if (hipOccupancyMaxActiveBlocksPerMultiprocessor(&per_cu, (const void*)kern_of_mask(masks[i]), 512, LDS_BYTES) != hipSuccess || per_cu < 1) fprintf(stderr, "kernel_launch: occupancy query reports %d for mask %d\n", per_cu, masks[i]);
        }
        (void)hipGetLastError();
        grid = cus;
        if (grid > 1024) grid = 1024;
    }
    if (grid < 0) return;
    if (hipMemsetAsync((char*)d_ws + WS_CTL, 0, (CW_BAR + XCD_BAR_WORDS) * sizeof(unsigned), stream) != hipSuccess) return;
    Args a{};
    for (int i = 0; i < 31; ++i) a.in[i] = (const float*)d_in[i];
    a.out = (float*)d_out; a.ws = (unsigned char*)d_ws;
#if MK_N_LAUNCHES == 1
    a.ph_lo = 0; a.ph_hi = N_PHASES;
    hipLaunchKernelGGL(mk_fwd<FULL_MASK>, dim3(grid), dim3(512), LDS_BYTES, stream, a);
#else
    for (int p = 0; p < N_PHASES; ++p) { a.ph_lo = p; a.ph_hi = p + 1; const int pm = phase_mask(p);
        for (int bit = 0; bit < 14; ++bit) { int m = pm & (1 << bit); if (!m) continue; if (m == 64 || m == 128) { if (m == 128) continue; m = 192; } hipLaunchKernelGGL(kern_of_mask(m), dim3(grid), dim3(512), LDS_BYTES, stream, a); } }
#endif
}
#endif
```

```cpp
#ifndef EMU
#include <hip/hip_runtime.h>
#include <cstdio>
#include <cstdint>
#endif

#ifndef MK_N_LAUNCHES
#define MK_N_LAUNCHES 1
#endif

#ifndef CFG_BATCH
#define CFG_BATCH 8
#define CFG_SEQ 4096
#define CFG_CTX 256
#define CFG_DEPTH 4
#endif
constexpr int NB = CFG_BATCH, SEQ = CFG_SEQ, LC = CFG_CTX, DEPTH = CFG_DEPTH, D = 1024;
constexpr int GRID_W = 64;
constexpr int T_L = NB * SEQ, T_C = NB * LC, T_ALL = T_L + T_C;
constexpr int D_IN = 2832, N_PROJ = 2816;
constexpr int NKEY = SEQ + LC;
constexpr int NE = 32, TOPK = 4, DE = 1024;
constexpr int NCH_L = SEQ / 64, NCH_C = LC / 64, NCH = NCH_L + NCH_C;
constexpr int MAX_TILES = (T_ALL * TOPK) / 256 + NE;
constexpr int P_ROWS = MAX_TILES * 256;
constexpr float NORM_EPS = 1e-6f;
static_assert(SEQ % 256 == 0 && LC % 128 == 0 && T_ALL % 256 == 0 && (T_ALL * TOPK) % 256 == 0, "tiling");
constexpr int C_AQ = 0, C_AK = 256, C_AV = 384, C_BU = 512, C_BV = 768, C_CQ = 1024, C_CK = 1280, C_CV = 1536, C_DQKV = 1792, C_DZ = 2560, C_DB = 2816, C_DA = 2824;

#ifndef EMU
#define GAS __attribute__((address_space(1)))
#define LAS __attribute__((address_space(3)))
#define DEVI __device__ __forceinline__
#define LDS_WAIT() asm volatile("s_waitcnt lgkmcnt(0)" ::: "memory")
#define VM_WAIT() asm volatile("s_waitcnt vmcnt(0)" ::: "memory")
#define LAUNDER_V(x) asm volatile("" : "+v"(x))
#define LAUNDER_S(x) asm volatile("" : "+s"(x))
#endif
typedef unsigned short bf16;
typedef unsigned v4u __attribute__((ext_vector_type(4)));
typedef unsigned v2u __attribute__((ext_vector_type(2)));
typedef float f32x4 __attribute__((ext_vector_type(4)));
typedef float f32x2 __attribute__((ext_vector_type(2)));
typedef short bf16x8 __attribute__((ext_vector_type(8)));
typedef GAS unsigned gu32;
#define RLX_AGENT __ATOMIC_RELAXED, __HIP_MEMORY_SCOPE_AGENT
typedef __bf16 hbf2_t __attribute__((ext_vector_type(2)));
DEVI unsigned pk2(float lo, float hi) { const f32x2 v = {lo, hi}; return __builtin_bit_cast(unsigned, __builtin_convertvector(v, hbf2_t)); }
DEVI unsigned f2bf(float f) { return pk2(f, 0.f) & 0xffffu; }
DEVI float bf2f(unsigned h) { return __builtin_bit_cast(float, (h & 0xffffu) << 16); }
DEVI float bflo(unsigned w) { return __builtin_bit_cast(float, w << 16); }
DEVI float bfhi(unsigned w) { return __builtin_bit_cast(float, w & 0xffff0000u); }
DEVI float fast_exp(float x) { return __builtin_amdgcn_exp2f(x * 1.4426950408889634f); }
DEVI float fast_rcp(float x) { return __builtin_amdgcn_rcpf(x); }
DEVI float sigmoidf_(float x) { return fast_rcp(1.f + fast_exp(-x)); }
DEVI float siluf_(float x) { return x * sigmoidf_(x); }
DEVI float tanh_fast(float x) { const float e = fast_exp(-2.f * __builtin_fabsf(x)); const float t = (1.f - e) * fast_rcp(1.f + e); return x < 0.f ? -t : t; }
DEVI float gelu_tanh(float x) { return 0.5f * x * (1.f + tanh_fast(0.7978845608028654f * (x + 0.044715f * x * x * x))); }
DEVI float softplusf_(float x) { return x > 20.f ? x : __builtin_amdgcn_logf(1.f + fast_exp(x)) * 0.6931471805599453f; }
DEVI float wave_sum(float v) {
#pragma unroll
    for (int o = 1; o < 64; o <<= 1) v += __shfl_xor(v, o);
    return v;
}
template <int W> DEVI float group_sum(float v) {
#pragma unroll
    for (int o = 1; o < W; o <<= 1) v += __shfl_xor(v, o);
    return v;
}

constexpr size_t al256(size_t x) { return (x + 255) & ~(size_t)255; }
constexpr size_t WS_CTL = 0, CTL_ZERO_BYTES = 1u << 20;
constexpr size_t WS_MOD   = CTL_ZERO_BYTES;
constexpr size_t WS_WIN   = WS_MOD   + al256((size_t)DEPTH * 9 * 6 * D * 4);
constexpr size_t WS_WOUT  = WS_WIN   + al256((size_t)DEPTH * N_PROJ * D * 2);
constexpr size_t WS_WUP   = WS_WOUT  + al256((size_t)DEPTH * D * D * 2);
constexpr size_t WS_WDN   = WS_WUP   + al256((size_t)DEPTH * NE * 2 * DE * D * 2);
constexpr size_t WS_H     = WS_WDN   + al256((size_t)DEPTH * NE * D * DE * 2);
constexpr size_t WS_F     = WS_H     + al256((size_t)T_ALL * D * 2);
constexpr size_t WS_BA    = WS_F     + al256((size_t)T_ALL * D * 2);
constexpr size_t WS_PROJ  = WS_BA    + al256((size_t)T_ALL * 16 * 4);
constexpr size_t WS_XRES  = WS_PROJ  + al256((size_t)T_ALL * N_PROJ * 2);
constexpr size_t WS_MIX   = WS_XRES  + al256((size_t)T_ALL * D * 4);
constexpr size_t WS_QL    = WS_MIX   + al256((size_t)T_ALL * D * 2);
constexpr size_t WS_QC    = WS_QL    + al256((size_t)NB * 12 * SEQ * 64 * 2);
constexpr size_t WS_K     = WS_QC    + al256((size_t)NB * 12 * LC * 64 * 2);
constexpr size_t WS_V     = WS_K     + al256((size_t)NB * 6 * NKEY * 64 * 2);
constexpr size_t WS_OD    = WS_V     + al256((size_t)NB * 6 * NKEY * 64 * 2);
constexpr size_t WS_DNO   = WS_OD    + al256((size_t)2 * T_ALL * 256 * 2);
constexpr size_t WS_DNF   = WS_DNO   + al256((size_t)2 * T_ALL * 256 * 4);
constexpr size_t DN_UNIT_BYTES = 32768;
constexpr size_t WS_HID   = WS_DNF   + al256((size_t)NB * 2 * 4 * NCH * DN_UNIT_BYTES);
constexpr size_t WS_YS    = WS_HID   + al256((size_t)P_ROWS * DE * 2);
constexpr size_t WS_TOKE  = WS_YS    + al256((size_t)P_ROWS * D * 2);
constexpr size_t WS_TOKG  = WS_TOKE  + al256((size_t)T_ALL * 4 * 4);
constexpr size_t WS_TOKP  = WS_TOKG  + al256((size_t)T_ALL * 4 * 4);
constexpr size_t WS_SLOT  = WS_TOKP  + al256((size_t)T_ALL * 4 * 4);
constexpr size_t WS_BCNT  = WS_SLOT  + al256((size_t)T_ALL * 4 * 4);
constexpr size_t WS_TEXP  = WS_BCNT  + al256((size_t)1024 * 32 * 4);
constexpr size_t WS_RWP   = WS_TEXP  + al256((size_t)(MAX_TILES + 64) * 4);
constexpr size_t WS_RBP   = WS_RWP   + al256((size_t)DEPTH * 9 * NE * D * 4);
constexpr size_t WS_ROWMAP = WS_RBP  + al256((size_t)DEPTH * 9 * NE * 4);
constexpr size_t WS_ROPE  = WS_ROWMAP + al256((size_t)P_ROWS * 4);
constexpr size_t WS_END   = WS_ROPE  + al256((size_t)SEQ * 96 * 4);
constexpr size_t WS_W16   = WS_OD;
static_assert((size_t)DEPTH * 16 * D * 4 <= (size_t)2 * T_ALL * 256 * 2, "W16 fits the OD region");
constexpr int CW_TMO = 0, CW_CODE = 1, CW_BAR = 4096;
namespace pg8 {
#define PG8_LAS __attribute__((address_space(3)))
typedef unsigned short bf16_t;
typedef short bf16x8 __attribute__((ext_vector_type(8)));
typedef float f32x4 __attribute__((ext_vector_type(4)));
typedef unsigned u32x4 __attribute__((ext_vector_type(4)));
constexpr int BM = 256, BK = 64, HALF = 128, HTB = HALF * BK * 2  , STAGE_BYTES = 8 * HTB, NXCD = 8, WGM = 8;

__host__ __device__ __forceinline__ int lds_byte(int r, int c) { const int st = (r >> 4) * 2 + (c >> 5), rr = r & 15, cc = c & 31, ob = rr * 64 + cc * 2; return st * 1024 + (ob ^ (((ob >> 9) & 1) << 5)); }
__host__ __device__ __forceinline__ void stage_rc(int b, int& R, int& C) { const int st = b / 1024, sb = b % 1024, swz = sb ^ (((sb >> 9) & 1) << 5); R = (st >> 1) * 16 + swz / 64; C = (st & 1) * 32 + (swz % 64) / 2; }
__host__ __device__ __forceinline__ int perm32(int rho) { const int n = rho >> 4, i = rho & 15; return 8 * (i >> 2) + 4 * n + (i & 3); }

struct Unit { int pm, pn; };
struct Gemm { const bf16_t* A; const bf16_t* Bt; int M, N, K; const int* rowmap = nullptr; };

struct StaticOrder {
    int nM, nN, nwg, G, c;
    __host__ __device__ void init(int M, int N, int G_, int c_) { nM = M / BM; nN = N / BM; nwg = nM * nN; G = G_; c = c_; }
    __host__ __device__ bool next(int i, Unit& u) const {
        const long L = (long)i * G + c; if (L >= nwg) return false;
        int wgid = (int)L; { const int q = nwg / NXCD, r = nwg % NXCD, xcd = wgid % NXCD, off = wgid / NXCD; wgid = (xcd < r ? xcd * (q + 1) : r * (q + 1) + (xcd - r) * q) + off; }
        const int nig = WGM * nN, gid = wgid / nig, fm = gid * WGM, gsz = (nM - fm) < WGM ? (nM - fm) : WGM;
        u.pm = fm + ((wgid % nig) % gsz); u.pn = (wgid % nig) / gsz; return true;
    }
    __device__ __forceinline__ void a_ready(const Unit&) const {}
    __device__ __forceinline__ void done(const Unit&) const {}
};

#ifndef EMU
__device__ __forceinline__ unsigned cvt_pk_bf16(float lo, float hi) { unsigned r; asm volatile("v_cvt_pk_bf16_f32 %0, %1, %2" : "=v"(r) : "v"(lo), "v"(hi)); return r; }
#else
__device__ __forceinline__ unsigned cvt_pk_bf16(float lo, float hi) { return pk2(lo, hi); }
#endif
typedef float f32x2 __attribute__((ext_vector_type(2)));
__device__ __forceinline__ f32x2 gelu_pk(f32x2 v) {
    const f32x2 av = __builtin_elementwise_abs(v), d = av * 0.2316418882f + 1.0f;
    f32x2 t; t.x = __builtin_amdgcn_rcpf(d.x); t.y = __builtin_amdgcn_rcpf(d.y);
    f32x2 q = t * 0.5307027145f + (-0.7265760135f); q = q * t + 0.7107068705f; q = q * t + (-0.142248368f); q = q * t + 0.127414796f; q = q * t;
    const f32x2 s = (v * v) * (-0.72134752044f);
    f32x2 e; e.x = __builtin_amdgcn_exp2f(s.x); e.y = __builtin_amdgcn_exp2f(s.y);
    const f32x2 m = v * (q * e), r = v - m;
    f32x2 o; o.x = v.x < 0.f ? m.x : r.x; o.y = v.y < 0.f ? m.y : r.y; return o;
}

template <int ACT  > struct EpiBf16 {
    static constexpr bool PERM = true, AFTER_DRAIN = false; static_assert(ACT == 0 || ACT == 1, "EpiBf16: ACT is 0 (none) or 1 (gelu_pk)");
    bf16_t* O; int ldc; const float* bias; int split_cols; size_t split_stride; float scale0;
    __device__ __forceinline__ void operator()(const f32x4 (&acc)[2][2][4][2], const Unit& u, int wr, int wc, int fr, int fq) const {
        const int row0 = u.pm * BM + wr * 64 + fr; int colt = u.pn * BM; bf16_t* base = O;
        float sc = 1.f; if (split_cols) { const int t = colt / split_cols; base += (size_t)t * split_stride; colt -= t * split_cols; if (t == 0) sc = scale0; }
        const int col0 = colt + wc * 32 + 8 * fq, bcol0 = u.pn * BM + wc * 32 + 8 * fq;
        f32x4 bv[2][2];
#pragma unroll
        for (int bj = 0; bj < 2; ++bj)
#pragma unroll
            for (int n = 0; n < 2; ++n) bv[bj][n] = bias ? *(const f32x4*)(bias + bcol0 + bj * HALF + 4 * n) : (f32x4){0.f, 0.f, 0.f, 0.f};
#pragma unroll
        for (int ai = 0; ai < 2; ++ai)
#pragma unroll
            for (int m = 0; m < 4; ++m) { bf16_t* rowp = base + (size_t)(row0 + ai * HALF + m * 16) * ldc + col0;
#pragma unroll
                for (int bj = 0; bj < 2; ++bj) { f32x4 v0 = acc[ai][bj][m][0] + bv[bj][0], v1 = acc[ai][bj][m][1] + bv[bj][1];
                    if (ACT == 1) { f32x2 a = gelu_pk((f32x2){v0[0], v0[1]}), b = gelu_pk((f32x2){v0[2], v0[3]}), c = gelu_pk((f32x2){v1[0], v1[1]}), d = gelu_pk((f32x2){v1[2], v1[3]});
                        v0 = (f32x4){a.x, a.y, b.x, b.y}; v1 = (f32x4){c.x, c.y, d.x, d.y}; }
                    v0 = v0 * sc; v1 = v1 * sc; u32x4 w; w.x = cvt_pk_bf16(v0[0], v0[1]); w.y = cvt_pk_bf16(v0[2], v0[3]); w.z = cvt_pk_bf16(v1[0], v1[1]); w.w = cvt_pk_bf16(v1[2], v1[3]);
                    *(u32x4*)(rowp + bj * HALF) = w; } }
    }
};

template <bool IN_F32> struct EpiOutRes {
    static constexpr bool PERM = true, AFTER_DRAIN = false;
    const void* xin_l; const void* xin_c;
    bf16_t* xres; const float* mod;
    __device__ __forceinline__ void operator()(const f32x4 (&acc)[2][2][4][2], const Unit& u, int wr, int wc, int fr, int fq) const {
        const int rowt = u.pm * BM; const bool isc = rowt >= T_L; const int mrow = isc ? 8 : rowt / SEQ;
        const float* g = mod + (size_t)(mrow * 6 + 2) * D;
        const size_t inoff = isc ? (size_t)(rowt - T_L) * D : (size_t)rowt * D;
        const float* xf = (const float*)(isc ? xin_c : xin_l) + inoff; const bf16_t* xb = (const bf16_t*)(isc ? xin_c : xin_l) + inoff;
        bf16_t* xo = xres + (size_t)rowt * D;
        const int col0 = u.pn * BM + wc * 32 + 8 * fq;
        f32x4 gv[2][2];
#pragma unroll
        for (int bj = 0; bj < 2; ++bj)
#pragma unroll
            for (int n = 0; n < 2; ++n) gv[bj][n] = *(const f32x4*)(g + col0 + bj * HALF + 4 * n);
#pragma unroll
        for (int ai = 0; ai < 2; ++ai)
#pragma unroll
          for (int mp = 0; mp < 2; ++mp) {
            f32x4 xi[2][2][2];
#pragma unroll
            for (int m2 = 0; m2 < 2; ++m2) { const size_t ro = (size_t)(ai * HALF + wr * 64 + (2 * mp + m2) * 16 + fr) * D + col0;
#pragma unroll
                for (int bj = 0; bj < 2; ++bj) {
                    if constexpr (IN_F32) { xi[m2][bj][0] = *(const f32x4*)(xf + ro + bj * HALF); xi[m2][bj][1] = *(const f32x4*)(xf + ro + bj * HALF + 4); }
                    else { const u32x4 w = *(const u32x4*)(xb + ro + bj * HALF);
                        xi[m2][bj][0] = (f32x4){bflo(w.x), bfhi(w.x), bflo(w.y), bfhi(w.y)}; xi[m2][bj][1] = (f32x4){bflo(w.z), bfhi(w.z), bflo(w.w), bfhi(w.w)}; } } }
#pragma unroll
            for (int m2 = 0; m2 < 2; ++m2) { const int m = 2 * mp + m2; const size_t ro = (size_t)(ai * HALF + wr * 64 + m * 16 + fr) * D + col0;
#pragma unroll
                for (int bj = 0; bj < 2; ++bj) { const f32x4 v0 = xi[m2][bj][0] + gv[bj][0] * acc[ai][bj][m][0], v1 = xi[m2][bj][1] + gv[bj][1] * acc[ai][bj][m][1];
                    u32x4 w; w.x = cvt_pk_bf16(v0[0], v0[1]); w.y = cvt_pk_bf16(v0[2], v0[3]); w.z = cvt_pk_bf16(v1[0], v1[1]); w.w = cvt_pk_bf16(v1[2], v1[3]);
                    *(u32x4*)(xo + ro + bj * HALF) = w; } } }
    }
};
struct EpiSwiglu {
    static constexpr bool PERM = true, AFTER_DRAIN = false;
    bf16_t* hid; const float* bup;
    __device__ __forceinline__ void operator()(const f32x4 (&acc)[2][2][4][2], const Unit& u, int wr, int wc, int fr, int fq) const {
        const int e = u.pn >> 3, j = u.pn & 7; const int h0 = j * HALF + wc * 32 + 8 * fq;
        const float* bg = bup + (size_t)e * 2 * DE + h0; const float* bu = bg + DE;
        f32x4 vg[2], vu[2];
#pragma unroll
        for (int n = 0; n < 2; ++n) { vg[n] = *(const f32x4*)(bg + 4 * n); vu[n] = *(const f32x4*)(bu + 4 * n); }
#pragma unroll
        for (int ai = 0; ai < 2; ++ai)
#pragma unroll
            for (int m = 0; m < 4; ++m) { const size_t row = (size_t)u.pm * BM + ai * HALF + wr * 64 + m * 16 + fr; float o[8];
#pragma unroll
                for (int n = 0; n < 2; ++n) { const f32x4 gt = acc[ai][0][m][n] + vg[n], up = acc[ai][1][m][n] + vu[n];
#pragma unroll
                    for (int i = 0; i < 4; ++i) { const float gg = __builtin_fminf(gt[i], 7.0f); const float uu = __builtin_fminf(__builtin_fmaxf(up[i], -7.0f), 7.0f);
                        o[4 * n + i] = gg * sigmoidf_(1.702f * gg) * (uu + 1.0f); } }
                u32x4 w; w.x = cvt_pk_bf16(o[0], o[1]); w.y = cvt_pk_bf16(o[2], o[3]); w.z = cvt_pk_bf16(o[4], o[5]); w.w = cvt_pk_bf16(o[6], o[7]);
                *(u32x4*)(hid + row * DE + h0) = w; }
    }
};
struct EpiDown {
    static constexpr bool PERM = true, AFTER_DRAIN = false;
    unsigned char* ys; const float* bdn;
    __device__ __forceinline__ void operator()(const f32x4 (&acc)[2][2][4][2], const Unit& u, int wr, int wc, int fr, int fq) const {
        typedef unsigned u32x2v __attribute__((ext_vector_type(2)));
        const int e = u.pn >> 2, j = u.pn & 3; const int col0 = j * BM + wc * 32 + 8 * fq;
        f32x4 bv[2][2];
#pragma unroll
        for (int bj = 0; bj < 2; ++bj)
#pragma unroll
            for (int n = 0; n < 2; ++n) bv[bj][n] = *(const f32x4*)(bdn + (size_t)e * D + col0 + bj * HALF + 4 * n);
#pragma unroll
        for (int ai = 0; ai < 2; ++ai)
#pragma unroll
            for (int m = 0; m < 4; ++m) { const size_t row = (size_t)u.pm * BM + ai * HALF + wr * 64 + m * 16 + fr;
#pragma unroll
                for (int bj = 0; bj < 2; ++bj) { const f32x4 v0 = acc[ai][bj][m][0] + bv[bj][0], v1 = acc[ai][bj][m][1] + bv[bj][1];
                    int w0 = 0, w1 = 0;
                    w0 = __builtin_amdgcn_cvt_pk_fp8_f32(v0[0], v0[1], w0, false); w0 = __builtin_amdgcn_cvt_pk_fp8_f32(v0[2], v0[3], w0, true);
                    w1 = __builtin_amdgcn_cvt_pk_fp8_f32(v1[0], v1[1], w1, false); w1 = __builtin_amdgcn_cvt_pk_fp8_f32(v1[2], v1[3], w1, true);
                    *(u32x2v*)(ys + row * D + col0 + bj * HALF) = (u32x2v){(unsigned)w0, (unsigned)w1}; } }
    }
};
struct MoeOrder {
    const int* texp; int ntiles, nN, nwg, G, c;
    __device__ __forceinline__ void init(const int* texp_, int nN_, int G_, int c_) { texp = texp_; ntiles = texp_[0]; nN = nN_; nwg = ntiles * nN_; G = G_; c = c_; }
    __device__ __forceinline__ bool next(int i, Unit& u) const {
        const long L = (long)i * G + c; if (L >= nwg) return false;
        int wgid = (int)L; { const int q = nwg / NXCD, r = nwg % NXCD, xcd = wgid % NXCD, off = wgid / NXCD; wgid = (xcd < r ? xcd * (q + 1) : r * (q + 1) + (xcd - r) * q) + off; }
        const int nig = WGM * nN, gid = wgid / nig, fm = gid * WGM, gsz = (ntiles - fm) < WGM ? (ntiles - fm) : WGM;
        const int pm = fm + ((wgid % nig) % gsz); u.pm = pm; u.pn = texp[1 + pm] * nN + (wgid % nig) / gsz; return true;
    }
    __device__ __forceinline__ void a_ready(const Unit&) const {}
    __device__ __forceinline__ void done(const Unit&) const {}
};
#ifndef EMU
template <class Epi, class Sched, bool ALIGN_EPI = false, bool SP2 = false, bool GATHER = false>
__device__ __forceinline__ void gemm_phase(PG8_LAS unsigned char* lds, const Gemm g, const Sched& S, const Epi& E) {
    int tid_ = threadIdx.x; asm volatile("" : "+v"(tid_));
    const int tid = tid_, wid = __builtin_amdgcn_readfirstlane(tid >> 6), lane = tid & 63, wr = wid >> 2, wc = wid & 3, fr = lane & 15, fq = lane >> 4;
    const int K = g.K, nt = K / BK;
    unsigned voffA[2], voffB[2]; int gR[2], gC[2];
#pragma unroll
    for (int i = 0; i < 2; ++i) { int R, C; stage_rc(tid * 16 + i * 8192, R, C); const int Rb = Epi::PERM ? ((R & ~31) + perm32(R & 31)) : R;
        voffA[i] = (unsigned)(R * K + C) * 2u; voffB[i] = (unsigned)(Rb * K + C) * 2u; gR[i] = R; gC[i] = C; }
    unsigned voffC[2][2], voffN[2][2];
#define PG8_GOFF(dst, pm_) do { _Pragma("unroll") for (int h_ = 0; h_ < 2; ++h_) _Pragma("unroll") for (int i_ = 0; i_ < 2; ++i_) \
        dst[h_][i_] = (unsigned)(g.rowmap[(size_t)(pm_) * BM + h_ * HALF + gR[i_]] * K + gC[i_]) * 2u; } while (0)
    const size_t kstep = (size_t)(BK * 2);
    const size_t hstep = (size_t)HALF * K * 2;
    const size_t tstep = 2 * hstep;
    const unsigned ldsw = (unsigned)wid * 1024u;
    const int aoff = lds_byte(wr * 64 + fr, fq * 8), boff = lds_byte(wc * 32 + fr, fq * 8);
#define PG8_SA(b, h) (((b) * 2 + (h)) * HTB)
#define PG8_SB(b, h) ((4 + (b) * 2 + (h)) * HTB)
#define PG8_STAGE(bufoff, gbase, voff) do { _Pragma("unroll") for (int _i = 0; _i < 2; ++_i) \
        __builtin_amdgcn_global_load_lds((const unsigned*)((const char*)(gbase) + (voff)[_i]), (PG8_LAS unsigned*)(lds + (bufoff) + ldsw + _i * 8192), 16, 0, 0); } while (0)
#define PG8_LDA(dst, b, h) do { _Pragma("unroll") for (int m = 0; m < 4; ++m) _Pragma("unroll") for (int k = 0; k < 2; ++k) dst[m][k] = *(const PG8_LAS bf16x8*)(lds + PG8_SA(b, h) + aoff + m * 2048 + k * 1024); } while (0)
#define PG8_LDB(dst, b, h) do { _Pragma("unroll") for (int n = 0; n < 2; ++n) _Pragma("unroll") for (int k = 0; k < 2; ++k) dst[n][k] = *(const PG8_LAS bf16x8*)(lds + PG8_SB(b, h) + boff + n * 2048 + k * 1024); } while (0)
#define PG8_MMA(ai, bj, At, Bt) do { __builtin_amdgcn_s_setprio(1); _Pragma("unroll") for (int m = 0; m < 4; ++m) _Pragma("unroll") for (int n = 0; n < 2; ++n) _Pragma("unroll") for (int k = 0; k < 2; ++k) \
        acc[ai][bj][m][n] = __builtin_amdgcn_mfma_f32_16x16x32_bf16(Bt[n][k], At[m][k], acc[ai][bj][m][n], 0, 0, 0); __builtin_amdgcn_s_setprio(0); } while (0)
#define PG8_WAIT_V(n) asm volatile("s_waitcnt vmcnt(" #n ")" ::: "memory")
#define PG8_WAIT_L(n) asm volatile("s_waitcnt lgkmcnt(" #n ")" ::: "memory")
#define PG8_BAR __builtin_amdgcn_s_barrier()
#define PG8_SCHED __builtin_amdgcn_sched_barrier(0)
#define PG8_STAGEA(bufoff, gbase, h, nx) do { if constexpr (GATHER) { _Pragma("unroll") for (int _i = 0; _i < 2; ++_i) { const unsigned o_ = (nx) ? voffN[h][_i] : voffC[h][_i]; \
        __builtin_amdgcn_global_load_lds((const unsigned*)((const char*)(gbase) + o_), (PG8_LAS unsigned*)(lds + (bufoff) + ldsw + _i * 8192), 16, 0, 0); } } \
    else { PG8_STAGE(bufoff, (gbase) + (h) * hstep, voffA); } } while (0)
    Unit cur, nxt; int ui = 0;
    if (!S.next(0, cur)) return;
    f32x4 acc[2][2][4][2];
#pragma unroll
    for (int a = 0; a < 2; ++a)
#pragma unroll
        for (int b = 0; b < 2; ++b)
#pragma unroll
            for (int m = 0; m < 4; ++m)
#pragma unroll
                for (int n = 0; n < 2; ++n) acc[a][b][m][n] = (f32x4){0.f, 0.f, 0.f, 0.f};
    bf16x8 At[4][2], B0[2][2], B1[2][2];
    const char* cA = (const char*)g.A + (GATHER ? (size_t)0 : (size_t)cur.pm * tstep); if constexpr (GATHER) { PG8_GOFF(voffC, cur.pm); }
    const char* cB = (const char*)g.Bt + (size_t)cur.pn * tstep;
    S.a_ready(cur);
    if constexpr (SP2) {
        PG8_STAGE(PG8_SB(0, 0), cB, voffB); PG8_STAGE(PG8_SB(0, 1), cB + hstep, voffB); PG8_STAGEA(PG8_SA(0, 0), cA, 0, false); PG8_STAGEA(PG8_SA(0, 1), cA, 1, false);
        if (wr == 1) PG8_BAR;
        PG8_WAIT_V(2); PG8_BAR;
        PG8_STAGE(PG8_SB(1, 0), cB + kstep, voffB); PG8_STAGEA(PG8_SA(1, 0), cA + kstep, 0, false); PG8_STAGE(PG8_SB(1, 1), cB + hstep + kstep, voffB);
        PG8_WAIT_V(6); PG8_BAR;
    } else {
        PG8_STAGE(PG8_SB(0, 0), cB, voffB); PG8_STAGEA(PG8_SA(0, 0), cA, 0, false); PG8_STAGE(PG8_SB(0, 1), cB + hstep, voffB); PG8_STAGEA(PG8_SA(0, 1), cA, 1, false);
        if (wr == 1) PG8_BAR;
        PG8_WAIT_V(4); PG8_BAR;
        PG8_STAGE(PG8_SB(1, 0), cB + kstep, voffB); PG8_STAGEA(PG8_SA(1, 0), cA + kstep, 0, false); PG8_STAGE(PG8_SB(1, 1), cB + hstep + kstep, voffB);
        PG8_WAIT_V(6); PG8_BAR;
    }
    for (;;) {
        const bool has_next = S.next(ui + 1, nxt);
        if constexpr (GATHER) { if (has_next) { PG8_GOFF(voffN, nxt.pm); } else { _Pragma("unroll") for (int h_ = 0; h_ < 2; ++h_) _Pragma("unroll") for (int i_ = 0; i_ < 2; ++i_) voffN[h_][i_] = voffC[h_][i_]; } }
        const char* nA = (has_next && !GATHER) ? (const char*)g.A + (size_t)nxt.pm * tstep : cA; const char* nB = has_next ? (const char*)g.Bt + (size_t)nxt.pn * tstep : cB;
        for (int t = 0; t < nt; t += 2) {
            const bool last = (t == nt - 2);
            const char* a1 = cA + (size_t)(t + 1) * kstep;
            const char* a2 = last ? nA : cA + (size_t)(t + 2) * kstep; const char* b2 = last ? nB : cB + (size_t)(t + 2) * kstep;
            const char* a3 = a2 + kstep; const char* b3 = b2 + kstep;
            if (last && has_next) S.a_ready(nxt);
            if constexpr (SP2) {
            PG8_LDB(B0, 0, 0); PG8_LDB(B1, 0, 1); PG8_SCHED; PG8_LDA(At, 0, 0); PG8_STAGEA(PG8_SA(1, 1), a1, 1, false);
            PG8_WAIT_V(8); PG8_WAIT_L(0); PG8_BAR; PG8_MMA(0, 0, At, B0); PG8_MMA(0, 1, At, B1); PG8_BAR; PG8_SCHED;
            PG8_LDA(At, 0, 1); PG8_STAGE(PG8_SB(0, 0), b2, voffB); PG8_STAGE(PG8_SB(0, 1), b2 + hstep, voffB); PG8_STAGEA(PG8_SA(0, 0), a2, 0, last);
            PG8_WAIT_V(8); PG8_WAIT_L(0); PG8_BAR; PG8_MMA(1, 0, At, B0); PG8_MMA(1, 1, At, B1); PG8_BAR; PG8_SCHED;
            PG8_LDB(B0, 1, 0); PG8_LDB(B1, 1, 1); PG8_SCHED; PG8_LDA(At, 1, 0); PG8_STAGEA(PG8_SA(0, 1), a2, 1, last);
            PG8_WAIT_V(8); PG8_WAIT_L(0); PG8_BAR; PG8_MMA(0, 0, At, B0); PG8_MMA(0, 1, At, B1); PG8_BAR; PG8_SCHED;
            PG8_LDA(At, 1, 1); PG8_STAGE(PG8_SB(1, 0), b3, voffB); PG8_STAGE(PG8_SB(1, 1), b3 + hstep, voffB); PG8_STAGEA(PG8_SA(1, 0), a3, 0, last);
            PG8_WAIT_V(8); PG8_WAIT_L(0); PG8_BAR; PG8_MMA(1, 0, At, B0); PG8_MMA(1, 1, At, B1); PG8_BAR; PG8_SCHED;
            } else {
            PG8_LDB(B0, 0, 0); PG8_SCHED; PG8_LDA(At, 0, 0); PG8_STAGEA(PG8_SA(1, 1), a1, 1, false);
            PG8_WAIT_L(8); PG8_BAR; PG8_WAIT_L(0); PG8_MMA(0, 0, At, B0); PG8_BAR; PG8_SCHED;
            PG8_LDB(B1, 0, 1); PG8_STAGE(PG8_SB(0, 0), b2, voffB);
            PG8_BAR; PG8_WAIT_L(0); PG8_MMA(0, 1, At, B1); PG8_BAR;
            PG8_LDA(At, 0, 1); PG8_STAGEA(PG8_SA(0, 0), a2, 0, last);
            PG8_BAR; PG8_WAIT_L(0); PG8_MMA(1, 0, At, B0); PG8_BAR; PG8_SCHED;
            PG8_STAGE(PG8_SB(0, 1), b2 + hstep, voffB);
            PG8_WAIT_V(6); PG8_BAR; PG8_MMA(1, 1, At, B1); PG8_BAR;
            PG8_LDB(B0, 1, 0); PG8_SCHED; PG8_LDA(At, 1, 0); PG8_STAGEA(PG8_SA(0, 1), a2, 1, last);
            PG8_WAIT_L(8); PG8_BAR; PG8_WAIT_L(0); PG8_MMA(0, 0, At, B0); PG8_BAR; PG8_SCHED;
            PG8_LDB(B1, 1, 1); PG8_STAGE(PG8_SB(1, 0), b3, voffB);
            PG8_BAR; PG8_WAIT_L(0); PG8_MMA(0, 1, At, B1); PG8_BAR;
            PG8_LDA(At, 1, 1); PG8_STAGEA(PG8_SA(1, 0), a3, 0, last);
            PG8_BAR; PG8_WAIT_L(0); PG8_MMA(1, 0, At, B0); PG8_BAR; PG8_SCHED;
            PG8_STAGE(PG8_SB(1, 1), b3 + hstep, voffB);
            PG8_WAIT_V(6); PG8_BAR; PG8_MMA(1, 1, At, B1); PG8_BAR;
            }
        }
        if constexpr (ALIGN_EPI) { if (wr == 0) PG8_BAR; }
        if constexpr (!Epi::AFTER_DRAIN) { E(acc, cur, wr, wc, fr, fq); S.done(cur); }
        if (!has_next) break;
#pragma unroll
        for (int a = 0; a < 2; ++a)
#pragma unroll
            for (int b = 0; b < 2; ++b)
#pragma unroll
                for (int m = 0; m < 4; ++m)
#pragma unroll
                    for (int n = 0; n < 2; ++n) acc[a][b][m][n] = (f32x4){0.f, 0.f, 0.f, 0.f};
        cur = nxt; cA = nA; cB = nB; ++ui;
        if constexpr (GATHER) { _Pragma("unroll") for (int h_ = 0; h_ < 2; ++h_) _Pragma("unroll") for (int i_ = 0; i_ < 2; ++i_) voffC[h_][i_] = voffN[h_][i_]; }
        if constexpr (ALIGN_EPI) { if (wr == 1) PG8_BAR; }
    }
    PG8_WAIT_V(0);
    if constexpr (!ALIGN_EPI) { if (wr == 0) PG8_BAR; }
    PG8_BAR;
    if constexpr (Epi::AFTER_DRAIN) { E.fused(acc, cur, wr, wc, fr, fq, lds, wid, lane); S.done(cur); }
#undef PG8_SA
#undef PG8_SB
#undef PG8_STAGE
#undef PG8_STAGEA
#undef PG8_GOFF
#undef PG8_LDA
#undef PG8_LDB
#undef PG8_MMA
#undef PG8_WAIT_V
#undef PG8_WAIT_L
#undef PG8_BAR
#undef PG8_SCHED
}
#else
EMU_GEMM_PHASE
#endif
}
#ifndef EMU
namespace attn_body {
using bf16=unsigned short;
using bf16x8=__attribute__((ext_vector_type(8)))short;
using s16x4=__attribute__((ext_vector_type(4)))short;
using f32x16=__attribute__((ext_vector_type(16)))float;
using u32x4=__attribute__((ext_vector_type(4)))unsigned;
constexpr int D=64,DM=64;
constexpr int NW=8,QBLK=32,QB=QBLK*NW,KVBLK=64;
__device__ __forceinline__ int crow(int r,int hi){return (r&3)+8*(r>>2)+4*hi;}
#define SBAR() __builtin_amdgcn_sched_barrier(0)
constexpr int NSLOT=3, SLOTB=8192;
constexpr int LDS_K=0, LDS_V=NSLOT*SLOTB, LDS_WS=2*NSLOT*SLOTB, LDS_OST=LDS_WS+NW*64*4, LDS_BYTES=LDS_OST+NW*4096;
__device__ __forceinline__ void glds16(const void*gsrc,unsigned lds_dst){unsigned keep;
  asm volatile("s_mov_b32 %0, m0\n\ts_mov_b32 m0, %2\n\ts_nop 0\n\tglobal_load_lds_dwordx4 %1, off\n\ts_mov_b32 m0, %0":"=&s"(keep):"v"(gsrc),"s"(lds_dst):"memory");}
__device__ __forceinline__ float max3f(float a,float b,float c){float r;asm("v_max3_f32 %0, %1, %2, %3":"=v"(r):"v"(a),"v"(b),"v"(c));return r;}
__device__ __forceinline__ float max2f(float a,float b){float r;asm("v_max_f32_e32 %0, %1, %2":"=v"(r):"v"(a),"v"(b));return r;}
__device__ __forceinline__ float fadd_s(float a,float b){float r;asm("v_add_f32_e32 %0, %1, %2":"=v"(r):"v"(a),"v"(b));return r;}
__device__ __forceinline__ float fsub_s(float a,float b){float r;asm("v_sub_f32_e32 %0, %1, %2":"=v"(r):"v"(a),"v"(b));return r;}
typedef float f32x2_t __attribute__((ext_vector_type(2))); typedef __bf16 bf16x2_t __attribute__((ext_vector_type(2)));
__device__ __forceinline__ unsigned cvtpk_s(float lo,float hi){f32x2_t v={lo,hi};bf16x2_t b=__builtin_convertvector(v,bf16x2_t);return __builtin_bit_cast(unsigned,b);}
#define WAIT_BAR(N) asm volatile("s_waitcnt vmcnt(" #N ") lgkmcnt(0)\n\ts_barrier":::"memory")

template<int MODE> __device__ __forceinline__ constexpr bool d0_on(int d0){ return MODE==0 || (MODE==1 && d0<2) || (MODE==2 && d0>=2); }
template<int MODE> __device__ __forceinline__ void qkt(f32x16&p0,f32x16&p1,const char*Kslot,const bf16x8*qr,const f32x16&negm,int r32,int hi){
  const char*kb=Kslot+hi*1024+r32*16;
  constexpr int D0A=(MODE==2)?2:0, D0B=(MODE==1)?2:4;
  #pragma unroll
  for(int d0=D0A;d0<D0B;++d0){
    const bf16x8 b0=*reinterpret_cast<const bf16x8*>(kb+d0*2048);
    const bf16x8 b1=*reinterpret_cast<const bf16x8*>(kb+d0*2048+512);
    if(d0==D0A){p0=__builtin_amdgcn_mfma_f32_32x32x16_bf16(b0,qr[d0],negm,0,0,0);p1=__builtin_amdgcn_mfma_f32_32x32x16_bf16(b1,qr[d0],negm,0,0,0);}
    else{p0=__builtin_amdgcn_mfma_f32_32x32x16_bf16(b0,qr[d0],p0,0,0,0);p1=__builtin_amdgcn_mfma_f32_32x32x16_bf16(b1,qr[d0],p1,0,0,0);}}
}
template<int MODE,int IDX> __device__ __forceinline__ void qk_mf(f32x16&Cx,const bf16x8&k,const bf16x8&q,const f32x16&negm){
  if constexpr(d0_on<MODE>(IDX>>1)){ constexpr bool first=((IDX>>1)==((MODE==2)?2:0));
    if constexpr(first) Cx=__builtin_amdgcn_mfma_f32_32x32x16_bf16(k,q,negm,0,0,0); else Cx=__builtin_amdgcn_mfma_f32_32x32x16_bf16(k,q,Cx,0,0,0); }
}
typedef __attribute__((address_space(3))) const char* lds_cptr;
typedef short v4i16_t __attribute__((ext_vector_type(4)));
template<int MODE> __device__ __forceinline__ void kload8(bf16x8*kf,lds_cptr kp){
  #pragma unroll
  for(int j=0;j<4;++j) if(d0_on<MODE>(j)){ kf[2*j]=*(const __attribute__((address_space(3))) bf16x8*)(kp+j*2048); kf[2*j+1]=*(const __attribute__((address_space(3))) bf16x8*)(kp+j*2048+512); }
}
__device__ __forceinline__ void kload2(bf16x8*kf,lds_cptr kp,int j){ kf[2*j]=*(const __attribute__((address_space(3))) bf16x8*)(kp+j*2048); kf[2*j+1]=*(const __attribute__((address_space(3))) bf16x8*)(kp+j*2048+512); }
__device__ __forceinline__ s16x4 vtr(lds_cptr p){ return __builtin_bit_cast(s16x4,__builtin_amdgcn_ds_read_tr16_b64_v4i16((__attribute__((address_space(3))) v4i16_t*)p)); }
__device__ __forceinline__ float rowmax(const f32x16&p0,const f32x16&p1){
  float a=max3f(p0[0],p0[1],p1[0]),b=max3f(p0[2],p0[3],p1[1]);a=max3f(a,p1[2],p1[3]);
  #pragma unroll
  for(int r=4;r<16;r+=4){a=max3f(a,p0[r],p0[r+1]);b=max3f(b,p0[r+2],p0[r+3]);a=max3f(a,p1[r],p1[r+1]);b=max3f(b,p1[r+2],p1[r+3]);}
  const float m=max2f(a,b);
  auto rr=__builtin_amdgcn_permlane32_swap(__float_as_uint(m),__float_as_uint(m),false,false);
  return max2f(__uint_as_float(rr[0]),__uint_as_float(rr[1]));
}
__device__ __forceinline__ void pv(f32x16*o,int vb,bf16x8 pa0,bf16x8 pa1,bf16x8 pa2,bf16x8 pa3){
  #pragma unroll
  for(int d0=0;d0<2;++d0){s16x4 lo[4],hi[4];
    #pragma unroll
    for(int ks=0;ks<4;++ks){
      asm volatile("ds_read_b64_tr_b16 %0,%1 offset:%c2":"=&v"(lo[ks]):"v"(vb),"i"(d0*4096+ks*1024):"memory");
      asm volatile("ds_read_b64_tr_b16 %0,%1 offset:%c2":"=&v"(hi[ks]):"v"(vb),"i"(d0*4096+ks*1024+512):"memory");}
    asm volatile("s_waitcnt lgkmcnt(0)":::"memory");SBAR();
    #define PK(k) (bf16x8){lo[k][0],lo[k][1],lo[k][2],lo[k][3],hi[k][0],hi[k][1],hi[k][2],hi[k][3]}
    o[d0]=__builtin_amdgcn_mfma_f32_32x32x16_bf16(pa0,PK(0),o[d0],0,0,0);
    o[d0]=__builtin_amdgcn_mfma_f32_32x32x16_bf16(pa1,PK(1),o[d0],0,0,0);
    o[d0]=__builtin_amdgcn_mfma_f32_32x32x16_bf16(pa2,PK(2),o[d0],0,0,0);
    o[d0]=__builtin_amdgcn_mfma_f32_32x32x16_bf16(pa3,PK(3),o[d0],0,0,0);
    #undef PK
  }
}

#ifndef ATTN_STORE16
#define ATTN_STORE16(p,v) (*(u32x4*)(p)=(v))
#endif
template<int THRL,int MODE> __device__ __forceinline__ void attn_unit(const bf16*Qa,const bf16*Qb,const bf16*__restrict__ Kh,const bf16*__restrict__ Vh,bf16*Oa,bf16*Ob,int opitch,int NT,char*shm,float lam,float post,const float*subln){
  int tid_=threadIdx.x; asm volatile("":"+v"(tid_)); const int tid=tid_,lane=tid&63,r32=lane&31,hi=lane>>5; const int wid=__builtin_amdgcn_readfirstlane(tid>>6);
  const bf16*Qw=(wid<4?Qa:Qb)+(long)((wid&3)*QBLK)*DM;
  const unsigned lds0=(unsigned)(uintptr_t)shm;
  float*wsf=(float*)(shm+LDS_WS)+wid*64;
  const bf16*ksrc=Kh+(long)lane*DM+wid*8;
  const bf16*vsrc=Vh+(long)(16*(wid&3)+(lane>>2))*DM+(wid>>2)*32+(lane&3)*8;
  const unsigned kdst=lds0+LDS_K+wid*1024, vdst=lds0+LDS_V+wid*1024;
  #define DMA_K(t,slot) glds16(ksrc+(long)(t)*KVBLK*DM,(unsigned)__builtin_amdgcn_readfirstlane(kdst+(slot)))
  #define DMA_V(t,slot) glds16(vsrc+(long)(t)*KVBLK*DM,(unsigned)__builtin_amdgcn_readfirstlane(vdst+(slot)))
  const int vb0=(int)(lds0+LDS_V)+((lane>>4)&1)*32+(lane&3)*8+(4*hi+((lane&15)>>2))*64;
  const char*Kbase=shm+LDS_K; bf16x8 kf[8];
  const lds_cptr shm3=(lds_cptr)shm; const lds_cptr kp0=shm3+LDS_K+hi*1024+r32*16; const lds_cptr vp0=shm3+LDS_V+((lane>>4)&1)*32+(lane&3)*8+(4*hi+((lane&15)>>2))*64;
  DMA_K(0,0);DMA_V(0,0);DMA_K(1,SLOTB);
  bf16x8 qr[4];
  #pragma unroll
  for(int d0=0;d0<4;++d0)qr[d0]=*reinterpret_cast<const bf16x8*>(&Qw[(long)r32*DM+d0*16+hi*8]);
  float mhat=0.f,l_reg=0.f;f32x16 o[2];o[0]=f32x16{};o[1]=f32x16{};f32x16 negm=f32x16{};asm volatile("":"+v"(negm));
  #define CMASK(P0,P1,t) do{}while(0)
  bool resc=false;
  #define START(P0,P1) do{ const float rm=rowmax(P0,P1); resc=false; \
    { const float dl=rm; mhat=fadd_s(mhat,dl); \
      _Pragma("unroll") for(int r=0;r<16;++r){P0[r]=fsub_s(P0[r],dl);P1[r]=fsub_s(P1[r],dl);} \
      _Pragma("unroll") for(int r=0;r<16;++r)negm[r]=-mhat; asm volatile("":"+v"(negm)); } \
    _Pragma("unroll") for(int r=0;r<16;++r)P0[r]=__builtin_amdgcn_exp2f(P0[r]); }while(0)
  #define RESC() do{ if(resc){ asm volatile("s_waitcnt lgkmcnt(0)":::"memory"); \
      _Pragma("unroll") for(int d_=0;d_<2;++d_) _Pragma("unroll") for(int r=0;r<16;++r)o[d_][r]*=wsf[crow(r,hi)]; } }while(0)
  f32x16 pA0,pA1,pB0,pB1;
  int sl_prev=0,sl_cur=0,sl_next=SLOTB;
  #define ROT() do{sl_prev=sl_cur;sl_cur=sl_next;sl_next=(sl_next==(NSLOT-1)*SLOTB)?0:sl_next+SLOTB;}while(0)
  DMA_K(2,2*SLOTB);
  WAIT_BAR(3);
  qkt<MODE>(pA0,pA1,Kbase,qr,negm,r32,hi);asm volatile("s_nop 15\n\ts_nop 7":"+v"(pA0),"+v"(pA1));CMASK(pA0,pA1,0);
  START(pA0,pA1);
  _Pragma("unroll") for(int r=0;r<16;++r)pA1[r]=__builtin_amdgcn_exp2f(pA1[r]);
  WAIT_BAR(0);
  DMA_K(3,0);DMA_V(1,SLOTB);
  ROT();
  kload8<MODE>(kf,kp0+sl_cur);
  WAIT_BAR(2);
  s16x4 vlo[8],vhi[8]; u32x4 pw0,pw1,pw2,pw3;
  #define PKW(P,B) cvtpk_s(P[B],P[B+1])
  #define PAF(k) __builtin_bit_cast(bf16x8,pw##k)
  #define VFR(i) (bf16x8){vlo[i][0],vlo[i][1],vlo[i][2],vlo[i][3],vhi[i][0],vhi[i][1],vhi[i][2],vhi[i][3]}
  #define PIN(x) asm volatile("":"+v"(x))
  #define MX3(a,b,c) __builtin_fmaxf(__builtin_fmaxf((a),(b)),(c))
  #define GAPA(MF,A0,A1,A2,A3,W0,W1,PW) do{ MF; sacc+=A0; sacc+=A1; sacc+=A2; sacc+=A3; PIN(sacc); W0; W1; PIN(PW); SBAR(); }while(0)
  #define EX(v) __builtin_amdgcn_exp2f(v)
  #define GAPB(MF,X,B) do{ MF; X[B]=EX(X[B]); X[B+1]=EX(X[B+1]); X[B+2]=EX(X[B+2]); X[B+3]=EX(X[B+3]); PIN(X); SBAR(); }while(0)
  #define VRD(i) do{ vlo[i]=vtr(vp_+(((i)>>2)*4096+((i)&3)*1024)); vhi[i]=vtr(vp_+(((i)>>2)*4096+((i)&3)*1024+512)); }while(0)
  #define KRD(G,j) do{ if((G)&&d0_on<MODE>(j)){ kload2(kf,kp0+sl_next,j); SBAR(); } }while(0)
  #define STEP(C0,C1,P0,P1,t,GK,GV,GL) do{ SBAR(); \
    const lds_cptr vp_=vp0+sl_prev; \
    VRD(0); SBAR(); float sacc=(P0[0]+P0[1]); \
    GAPA((qk_mf<MODE,0>(C0,kf[0],qr[0],negm)), P0[2],P0[3],P0[4],P0[5],     pw0[0]=PKW(P0,0), pw0[1]=PKW(P0,2), pw0); \
    VRD(4); SBAR(); GAPA((qk_mf<MODE,1>(C1,kf[1],qr[0],negm)), P0[6],P0[7],P0[8],P0[9],     pw0[2]=PKW(P0,4), pw0[3]=PKW(P0,6), pw0); \
    VRD(1); SBAR(); GAPA((qk_mf<MODE,2>(C0,kf[2],qr[1],negm)),   P0[10],P0[11],P0[12],P0[13], pw1[0]=PKW(P0,8), pw1[1]=PKW(P0,10), pw1); \
    VRD(5); SBAR(); GAPA((qk_mf<MODE,3>(C1,kf[3],qr[1],negm)),   P0[14],P0[15],P1[0],P1[1],   pw1[2]=PKW(P0,12),pw1[3]=PKW(P0,14), pw1); \
    VRD(2); SBAR(); GAPA((qk_mf<MODE,4>(C0,kf[4],qr[2],negm)),   P1[2],P1[3],P1[4],P1[5],     pw2[0]=PKW(P1,0), pw2[1]=PKW(P1,2), pw2); \
    VRD(6); SBAR(); GAPA((qk_mf<MODE,5>(C1,kf[5],qr[2],negm)),   P1[6],P1[7],P1[8],P1[9],     pw2[2]=PKW(P1,4), pw2[3]=PKW(P1,6), pw2); \
    VRD(3); SBAR(); GAPA((qk_mf<MODE,6>(C0,kf[6],qr[3],negm)),   P1[10],P1[11],P1[12],P1[13], pw3[0]=PKW(P1,8), pw3[1]=PKW(P1,10), pw3); \
    VRD(7); SBAR(); GAPA((qk_mf<MODE,7>(C1,kf[7],qr[3],negm)),   P1[14],P1[15],0.f,0.f,       pw3[2]=PKW(P1,12),pw3[3]=PKW(P1,14), pw3); \
    l_reg+=sacc; \
    if(GK){DMA_K((t)+3,sl_cur);} if(GV){DMA_V((t)+1,sl_next);} \
    CMASK(C0,C1,t); \
    { float a=MX3(C0[0],C0[1],C1[0]),b=MX3(C0[2],C0[3],C1[1]); a=MX3(a,C1[2],C1[3]); \
      _Pragma("unroll") for(int r=4;r<16;r+=4){a=MX3(a,C0[r],C0[r+1]);b=MX3(b,C0[r+2],C0[r+3]);a=MX3(a,C1[r],C1[r+1]);b=MX3(b,C1[r+2],C1[r+3]);} \
      float rm=__builtin_fmaxf(a,b); { auto rr=__builtin_amdgcn_permlane32_swap(__float_as_uint(rm),__float_as_uint(rm),false,false); rm=__builtin_fmaxf(__uint_as_float(rr[0]),__uint_as_float(rr[1])); } \
      resc=false; \
      if(__builtin_expect(__any(rm>(float)THRL),0)){ const float dl=__builtin_fmaxf(rm,0.f); mhat+=dl; \
        _Pragma("unroll") for(int r=0;r<16;++r){C0[r]-=dl;C1[r]-=dl;} \
        _Pragma("unroll") for(int r=0;r<16;++r)negm[r]=-mhat; asm volatile("":"+v"(negm)); \
        const float f=__builtin_amdgcn_exp2f(-dl); l_reg*=f; if(hi==0)wsf[r32]=f; resc=true; } } \
    SBAR(); \
    GAPB(o[0]=__builtin_amdgcn_mfma_f32_32x32x16_bf16(PAF(0),VFR(0),o[0],0,0,0), C0,0); \
    GAPB(o[1]=__builtin_amdgcn_mfma_f32_32x32x16_bf16(PAF(0),VFR(4),o[1],0,0,0), C0,4); \
    KRD(GL,0); GAPB(o[0]=__builtin_amdgcn_mfma_f32_32x32x16_bf16(PAF(1),VFR(1),o[0],0,0,0), C0,8); \
    KRD(GL,1); GAPB(o[1]=__builtin_amdgcn_mfma_f32_32x32x16_bf16(PAF(1),VFR(5),o[1],0,0,0), C0,12); \
    KRD(GL,2); GAPB(o[0]=__builtin_amdgcn_mfma_f32_32x32x16_bf16(PAF(2),VFR(2),o[0],0,0,0), C1,0); \
    KRD(GL,3); GAPB(o[1]=__builtin_amdgcn_mfma_f32_32x32x16_bf16(PAF(2),VFR(6),o[1],0,0,0), C1,4); \
    GAPB(o[0]=__builtin_amdgcn_mfma_f32_32x32x16_bf16(PAF(3),VFR(3),o[0],0,0,0), C1,8); \
    GAPB(o[1]=__builtin_amdgcn_mfma_f32_32x32x16_bf16(PAF(3),VFR(7),o[1],0,0,0), C1,12); \
    }while(0)
  int t=1;
  for(;t+5<NT;t+=2){
    STEP(pB0,pB1,pA0,pA1,t,true,true,true);     WAIT_BAR(2); RESC(); ROT();
    STEP(pA0,pA1,pB0,pB1,t+1,true,true,true);   WAIT_BAR(2); RESC(); ROT();
  }
  #define ENDW(tt) do{ if((tt)+3<NT){WAIT_BAR(2);} else if((tt)+2<NT){WAIT_BAR(1);} else {WAIT_BAR(0);} }while(0)
  for(;t+1<NT;t+=2){
    STEP(pB0,pB1,pA0,pA1,t,(t+3<NT),(t+1<NT),(t+1<NT));       ENDW(t);   RESC(); ROT();
    STEP(pA0,pA1,pB0,pB1,t+1,(t+4<NT),(t+2<NT),(t+2<NT));     ENDW(t+1); RESC(); ROT();
  }
  STEP(pB0,pB1,pA0,pA1,NT-1,false,false,false); RESC();
  { float sacc=pB0[0]+pB0[1]; _Pragma("unroll") for(int r=2;r<16;++r)sacc+=pB0[r]; _Pragma("unroll") for(int r=0;r<16;++r)sacc+=pB1[r]; l_reg+=sacc;
    pw0=(u32x4){PKW(pB0,0),PKW(pB0,2),PKW(pB0,4),PKW(pB0,6)};pw1=(u32x4){PKW(pB0,8),PKW(pB0,10),PKW(pB0,12),PKW(pB0,14)};pw2=(u32x4){PKW(pB1,0),PKW(pB1,2),PKW(pB1,4),PKW(pB1,6)};pw3=(u32x4){PKW(pB1,8),PKW(pB1,10),PKW(pB1,12),PKW(pB1,14)};
    SBAR(); pv(o,vb0+sl_cur,PAF(0),PAF(1),PAF(2),PAF(3)); }
  #undef PKW
  #undef PAF
  #undef VFR
  #undef PIN
  #undef MX3
  #undef GAPA
  #undef GAPB
  #undef EX
  #undef VRD
  #undef KRD
  #undef STEP
  #undef ENDW
  {auto rr=__builtin_amdgcn_permlane32_swap(__float_as_uint(l_reg),__float_as_uint(l_reg),false,false);l_reg=__uint_as_float(rr[0])+__uint_as_float(rr[1]);}
  if(hi==0)wsf[32+r32]=l_reg;asm volatile("s_waitcnt lgkmcnt(0)":::"memory");
  float rli[16];
  #pragma unroll
  for(int r=0;r<16;++r)rli[r]=__builtin_amdgcn_rcpf(wsf[32+crow(r,hi)]);
  bf16*Ow=(wid<4?Oa:Ob)+(long)((wid&3)*QBLK)*opitch;
  { bf16*stg=(bf16*)(shm+LDS_OST)+wid*2048;
    #pragma unroll
    for(int r=0;r<16;++r){const int orow=crow(r,hi);
      #pragma unroll
      for(int d0=0;d0<2;++d0)stg[orow*64+d0*32+r32]=(bf16)f2bf(o[d0][r]*rli[r]);}
    asm volatile("s_waitcnt lgkmcnt(0)":::"memory");
    if constexpr(MODE==0){
      #pragma unroll
      for(int i=0;i<4;++i){const int row=i*8+(lane>>3),ch=lane&7; const u32x4 v=*(const u32x4*)(stg+row*64+ch*8); ATTN_STORE16(Ow+(long)row*opitch+ch*8,v);}
    } else {
      asm volatile("s_barrier":::"memory");
      if constexpr(MODE==1){ const bf16*stg2=stg+4*2048; const int ch=lane&7; float sb[8];
        #pragma unroll
        for(int e=0;e<8;++e)sb[e]=subln[ch*8+e]*post;
        #pragma unroll
        for(int i=0;i<4;++i){const int row=i*8+(lane>>3); const u32x4 v1=*(const u32x4*)(stg+row*64+ch*8),v2=*(const u32x4*)(stg2+row*64+ch*8);
          float od[8]; float ss=0.f;
          #pragma unroll
          for(int e=0;e<4;++e){ od[2*e]=bflo(v1[e])-lam*bflo(v2[e]); od[2*e+1]=bfhi(v1[e])-lam*bfhi(v2[e]); ss+=od[2*e]*od[2*e]+od[2*e+1]*od[2*e+1]; }
          ss+=__shfl_xor(ss,1); ss+=__shfl_xor(ss,2); ss+=__shfl_xor(ss,4);
          const float rn=__builtin_amdgcn_rsqf(ss*(1.f/64.f)+1e-6f);
          u32x4 w; w[0]=pk2(od[0]*rn*sb[0],od[1]*rn*sb[1]); w[1]=pk2(od[2]*rn*sb[2],od[3]*rn*sb[3]); w[2]=pk2(od[4]*rn*sb[4],od[5]*rn*sb[5]); w[3]=pk2(od[6]*rn*sb[6],od[7]*rn*sb[7]);
          ATTN_STORE16(Ow+(long)row*opitch+ch*8,w);} }
    } }
  asm volatile("s_waitcnt lgkmcnt(0)\n\ts_barrier":::"memory");
  #undef DMA_K
  #undef DMA_V
  #undef CMASK
  #undef START
  #undef RESC
  #undef ROT
}
constexpr int ATTN_LDS_BYTES=LDS_BYTES;
#undef SBAR
#undef WAIT_BAR
}
#else
EMU_ATTN_BODY
#endif
#ifndef EMU
#define XB_TMO      128
#define XB_XCNT(j)  (256  + 64 * (j))
#define XB_XSUB(j)  (1280 + 64 * (j))
#define XB_XGEN(j)  (2304 + 64 * (j))
#define XB_TOP      3328
#define XB_TOPGEN   3392
#define XCD_BAR_WORDS 3456
#define XB_SPIN_CAP (1u << 18)

__device__ __forceinline__ unsigned xb_ld(unsigned* p)              { return __hip_atomic_load(p, __ATOMIC_RELAXED, __HIP_MEMORY_SCOPE_AGENT); }
__device__ __forceinline__ unsigned xb_add(unsigned* p, unsigned v) { return __hip_atomic_fetch_add(p, v, __ATOMIC_RELAXED, __HIP_MEMORY_SCOPE_AGENT); }
__device__ __forceinline__ unsigned xb_xcc_id() { return (unsigned)__builtin_amdgcn_s_getreg((3 << 11) | 20) & 0xFu; }
#define XB_SPIN(cond, bar) do { unsigned _sp = 0; while (cond) { __builtin_amdgcn_s_sleep(1); \
    if ((++_sp & 255u) == 0u) { if (xb_ld(&(bar)[XB_TMO])) break; if (_sp > XB_SPIN_CAP) { atomicAdd(&(bar)[XB_TMO], 1u); break; } } } } while (0)

struct XcdBarrier {
    unsigned* bar; unsigned x;
    volatile LAS unsigned* st;
};

__device__ __forceinline__ XcdBarrier xcd_barrier_post(unsigned* bar, volatile LAS unsigned* st) {
    XcdBarrier b; b.bar = bar; b.x = xb_xcc_id(); b.st = st;
    if (threadIdx.x == 0) (void)xb_add(&bar[XB_XCNT(b.x)], 1u);
    return b;
}
__device__ __forceinline__ void xcd_barrier_complete(unsigned* bar, unsigned x, unsigned& nloc, unsigned& nx) {
    const unsigned G = gridDim.x * gridDim.y * gridDim.z;
    unsigned sum, cnt, mine, sp = 0u;
    for (;;) {
        sum = 0u; cnt = 0u; mine = 0u;
#pragma unroll
        for (unsigned j = 0; j < 16; ++j) { const unsigned c = xb_ld(&bar[XB_XCNT(j)]); sum += c; cnt += (c > 0u) ? 1u : 0u; mine = (j == x) ? c : mine; }
        if (sum == G) break;
        __builtin_amdgcn_s_sleep(1);
        if ((++sp & 255u) == 0u) { if (xb_ld(&bar[XB_TMO])) break; if (sp > XB_SPIN_CAP) { atomicAdd(&bar[XB_TMO], 1u); break; } }
    }
    nloc = mine > 0u ? mine : 1u; nx = cnt > 0u ? cnt : 1u;
}

__device__ __forceinline__ void xcd_barrier(const XcdBarrier& b) {
    asm volatile("s_waitcnt vmcnt(0)" ::: "memory");
    __syncthreads();
    if (threadIdx.x == 0) {
        unsigned* bar = b.bar;
        __builtin_amdgcn_s_waitcnt(0);
        unsigned nloc = b.st[0], nx = b.st[1];
        if (nloc == 0u) { xcd_barrier_complete(bar, b.x, nloc, nx); b.st[0] = nloc; b.st[1] = nx; }
        const unsigned old = xb_add(&bar[XB_XSUB(b.x)], 1u);
        const unsigned gen = old / nloc;
        if (old + 1u == (gen + 1u) * nloc) {
            __builtin_amdgcn_fence(__ATOMIC_RELEASE, "agent");
            asm volatile("s_waitcnt vmcnt(0)" ::: "memory");
            const unsigned og = xb_add(&bar[XB_TOP], 1u);
            const unsigned tg = og / nx;
            if (og + 1u == (tg + 1u) * nx) xb_add(&bar[XB_TOPGEN], 1u);
            else XB_SPIN(xb_ld(&bar[XB_TOPGEN]) == tg, bar);
            __builtin_amdgcn_fence(__ATOMIC_ACQUIRE, "agent");
            xb_add(&bar[XB_XGEN(b.x)], 1u);
            asm volatile("s_waitcnt vmcnt(0)" ::: "memory");
        } else {
            XB_SPIN(xb_ld(&bar[XB_XGEN(b.x)]) == gen, bar);
            __builtin_amdgcn_fence(__ATOMIC_ACQUIRE, "agent");
            asm volatile("s_waitcnt vmcnt(0)" ::: "memory");
        }
    }
    __syncthreads();
}
#endif

constexpr int LDS_BYTES = 147456;
constexpr int MISC_OFF = 139264;
constexpr int PTR_OFF = MISC_OFF + 256;
struct Ctx {
    LAS unsigned char* lds;
    int tid, lane, wave, bid, G;
    float* out; unsigned long long wsi;
};
DEVI const float* inp_ptr(const Ctx& C, int i) {
    const unsigned long long v = ((const LAS unsigned long long*)(C.lds + PTR_OFF))[i];
    const unsigned lo = __builtin_amdgcn_readfirstlane((unsigned)v), hi = __builtin_amdgcn_readfirstlane((unsigned)(v >> 32));
    return (const float*)(const GAS float*)(((unsigned long long)hi << 32) | lo);
}
#define INP(i) inp_ptr(C, i)
#define WSP(T, off) ((T*)(GAS T*)(C.wsi + (unsigned long long)(off)))
DEVI int mod_row(int r) { return r < T_L ? r / SEQ : 8; }
DEVI const float* mod_vec(const Ctx& C, int layer, int mrow, int which) { return WSP(const float, WS_MOD) + ((size_t)(layer * 9 + mrow) * 6 + which) * D; }

DEVI void transpose_item(const float* W, int ldw, int k0, int n0, bf16* WT, int orow0, int Kp, LAS float* scr, int lane) {
    { const int kr = lane >> 3, c4 = (lane & 7) * 4; f32x4 v[8];
#pragma unroll
      for (int i = 0; i < 8; ++i) v[i] = *(const f32x4*)(W + (size_t)(k0 + 8 * i + kr) * ldw + n0 + c4);
#pragma unroll
      for (int i = 0; i < 8; ++i) { LAS float* d = scr + (8 * i + kr) * 33 + c4; d[0] = v[i].x; d[1] = v[i].y; d[2] = v[i].z; d[3] = v[i].w; } }
    LDS_WAIT();
    const int c = lane & 7;
#pragma unroll
    for (int j = 0; j < 4; ++j) { const int n = (lane >> 3) + 8 * j; const LAS float* s = scr + (8 * c) * 33 + n;
        v4u o; o.x = pk2(s[0 * 33], s[1 * 33]); o.y = pk2(s[2 * 33], s[3 * 33]); o.z = pk2(s[4 * 33], s[5 * 33]); o.w = pk2(s[6 * 33], s[7 * 33]);
        *(v4u*)(WT + (size_t)(orow0 + n) * Kp + k0 + 8 * c) = o; }
    LDS_WAIT();
}
DEVI void convert_layer_weights(const Ctx& C, int layer, int part) {
    LAS float* scr = (LAS float*)(C.lds + C.wave * 16384);
    const int gw = C.bid * 8 + C.wave, NGW = C.G * 8;
    constexpr int I_IN = 16 * (N_PROJ / 32), I_OUT = 16 * (D / 32), I_UP = NE * 16 * (2 * DE / 32), I_DN = NE * 16 * (D / 32), I_LAYER = I_IN + I_OUT + I_UP + I_DN;
    const int it_lo = (part == 1) ? I_IN + I_OUT : 0, it_hi = (part == 0) ? I_IN + I_OUT : I_LAYER;
    for (int it = it_lo + gw; it < it_hi; it += NGW) {
        int r = it;
        if (r < I_IN) { const int kb = r / (N_PROJ / 32), nb = r % (N_PROJ / 32);
            transpose_item(INP(8) + (size_t)layer * D * D_IN, D_IN, 64 * kb, 32 * nb, WSP(bf16, WS_WIN) + (size_t)layer * N_PROJ * D, 32 * nb, D, scr, C.lane); continue; }
        r -= I_IN;
        if (r < I_OUT) { const int kb = r / (D / 32), nb = r % (D / 32);
            transpose_item(INP(9) + (size_t)layer * D * D, D, 64 * kb, 32 * nb, WSP(bf16, WS_WOUT) + (size_t)layer * D * D, 32 * nb, D, scr, C.lane); continue; }
        r -= I_OUT;
        if (r < I_UP) { const int e = r / (16 * 64), q = r % (16 * 64), kb = q / 64, nb = q % 64; const int n0 = 32 * nb;
            const int orow = (n0 < DE) ? (n0 / 128) * 256 + (n0 % 128) : ((n0 - DE) / 128) * 256 + 128 + ((n0 - DE) % 128);
            transpose_item(INP(26) + ((size_t)layer * NE + e) * D * 2 * DE, 2 * DE, 64 * kb, n0, WSP(bf16, WS_WUP) + ((size_t)layer * NE + e) * 2 * DE * D, orow, D, scr, C.lane); continue; }
        r -= I_UP;
        { const int e = r / (16 * 32), q = r % (16 * 32), kb = q / 32, nb = q % 32;
            transpose_item(INP(28) + ((size_t)layer * NE + e) * DE * D, D, 64 * kb, 32 * nb, WSP(bf16, WS_WDN) + ((size_t)layer * NE + e) * D * DE, 32 * nb, DE, scr, C.lane); }
    }
}
DEVI void p0_prologue(const Ctx& C) {
    convert_layer_weights(C, 0, 0);
    for (int i = C.bid * 512 + C.tid; i < DEPTH * 16 * D; i += C.G * 512) { const int l = i / (16 * D), j = (i / D) & 15, k = i % D; WSP(float, WS_W16)[i] = INP(8)[((size_t)l * D + k) * D_IN + N_PROJ + j]; }
    {
      float* tab = WSP(float, WS_ROPE);
      for (int i = C.bid * 512 + C.tid; i < SEQ * 48; i += C.G * 512) { const int t = i / 48, j = i % 48; const float rp = (float)(t / GRID_W), cp = (float)(t % GRID_W); float c, s;
          if (j < 32) { const float ang = (j < 16 ? rp : cp) * __builtin_amdgcn_exp2f(-(float)(j & 15) * (13.287712379549449f / 16.f)); const float tt = __builtin_amdgcn_fractf(ang * 0.15915494309189535f); c = __builtin_amdgcn_cosf(tt); s = __builtin_amdgcn_sinf(tt);
              tab[(size_t)t * 32 + j] = c; tab[(size_t)SEQ * 32 + (size_t)t * 32 + j] = s; }
          else { const int i2 = j - 32; const float ang = (i2 < 8 ? rp : cp) * __builtin_amdgcn_exp2f(-(float)(i2 & 7) * (13.287712379549449f / 8.f)); const float tt = __builtin_amdgcn_fractf(ang * 0.15915494309189535f); c = __builtin_amdgcn_cosf(tt); s = __builtin_amdgcn_sinf(tt);
              tab[(size_t)SEQ * 64 + (size_t)t * 16 + i2] = c; tab[(size_t)SEQ * 80 + (size_t)t * 16 + i2] = s; } } }
    __syncthreads();
    LAS float* sc = (LAS float*)C.lds;
    LAS float* red = sc + 9 * D;
    for (int i = C.tid; i < 9 * D; i += 512) { const int r = i / D, k = i % D; float v = 0.f; if (r < NB) v = INP(1)[r * D + k]; else if (r == 8) v = INP(3)[k]; sc[i] = siluf_(v); }
    __syncthreads();
    for (int u = C.bid; u < DEPTH * 96; u += C.G) {
        const int layer = u / 96, n0 = (u % 96) * 64, col = C.tid & 63, kg = C.tid >> 6;
        const float* w = INP(4) + (size_t)layer * D * 6 * D + n0 + col;
        float acc[9];
#pragma unroll
        for (int r = 0; r < 9; ++r) acc[r] = 0.f;
#pragma unroll 8
        for (int k = kg * 128; k < kg * 128 + 128; ++k) { const float wv = w[(size_t)k * 6 * D];
#pragma unroll
            for (int r = 0; r < 9; ++r) acc[r] += sc[r * D + k] * wv; }
#pragma unroll
        for (int r = 0; r < 9; ++r) red[(kg * 9 + r) * 64 + col] = acc[r];
        __syncthreads();
        for (int i = C.tid; i < 9 * 64; i += 512) { const int r = i >> 6, c2 = i & 63; float s = 0.f;
#pragma unroll
            for (int g = 0; g < 8; ++g) s += red[(g * 9 + r) * 64 + c2];
            WSP(float, WS_MOD)[((size_t)(layer * 9 + r)) * 6 * D + n0 + c2] = s + INP(5)[(size_t)layer * 6 * D + n0 + c2]; }
        __syncthreads();
    }
}

DEVI void ph_norm_mix(const Ctx& C, int layer) {
    const bool fin = (layer == DEPTH);
    const int nrows = fin ? T_L : T_ALL;
    if (layer == 0) {
        for (int it = C.bid * 8 + C.wave; it < DEPTH * 9 * NE; it += C.G * 8) {
            const int e = it % NE, m = (it / NE) % 9, l = it / (NE * 9);
            const float* gn = INP(7) + (size_t)l * D; const float* sh = mod_vec(C, l, m, 3); const float* scl = mod_vec(C, l, m, 4); const float* rw = INP(24) + (size_t)l * D * NE + e;
            float* dst = WSP(float, WS_RWP) + (size_t)it * D; float bsum = 0.f;
#pragma unroll 4
            for (int j = 0; j < 16; ++j) { const int k = 64 * j + C.lane; const float w = rw[(size_t)k * NE]; const float tv = gn[k] * (1.f + scl[k]) * w; const unsigned hb = f2bf(tv);
                ((unsigned short*)dst)[k] = (unsigned short)hb; ((unsigned short*)dst)[D + k] = (unsigned short)f2bf(tv - bflo(hb)); bsum += sh[k] * w; }
            bsum = wave_sum(bsum); if (C.lane == 0) WSP(float, WS_RBP)[it] = bsum + INP(25)[l * NE + e];
        }
    }
    LAS float* w16 = (LAS float*)C.lds;
    if (!fin) { const f32x4* src = (const f32x4*)(WSP(const float, WS_W16) + (size_t)layer * 16 * D);
#pragma unroll
        for (int i = 0; i < 16 * D / 4 / 512; ++i) ((LAS f32x4*)w16)[C.tid + 512 * i] = src[C.tid + 512 * i]; }
    __syncthreads();
    const float* gmain = fin ? INP(30) : INP(6) + (size_t)layer * D;
    const int rstep = C.G * 8;
    int s4[2][4]; float g4[2][4];
#define NM_SLOTS(dst_s, dst_g, rbase) do { _Pragma("unroll") for (int u2 = 0; u2 < 2; ++u2) { const int rr_ = (rbase) + u2 * rstep; const int rc_ = rr_ < nrows ? rr_ : 0; \
        const int* sl_ = WSP(const int, WS_SLOT) + (size_t)rc_ * 4; const float* gl_ = WSP(const float, WS_TOKG) + (size_t)rc_ * 4; \
        _Pragma("unroll") for (int k = 0; k < 4; ++k) { dst_s[u2][k] = sl_[k]; dst_g[u2][k] = gl_[k]; } } } while (0)
    if (layer != 0) NM_SLOTS(s4, g4, C.bid * 8 + C.wave);
#define NMC(j) ((((j) & 2) ? 512 : 0) + 8 * C.lane + 4 * ((j) & 1))
    for (int ra = C.bid * 8 + C.wave; ra < nrows; ra += 2 * rstep) {
        f32x4 v[2][4]; int mrow[2]; bool live[2];
        int s4n[2][4]; float g4n[2][4];
        if (layer != 0) NM_SLOTS(s4n, g4n, ra + 2 * rstep);
#pragma unroll
        for (int u2 = 0; u2 < 2; ++u2) { const int r = ra + u2 * rstep; live[u2] = r < nrows; const int rc = live[u2] ? r : 0; mrow[u2] = mod_row(rc);
            if (layer == 0) { const float* xr = (rc < T_L) ? INP(0) + (size_t)rc * D : INP(2) + (size_t)(rc - T_L) * D;
#pragma unroll
                for (int j = 0; j < 4; ++j) v[u2][j] = *(const f32x4*)(xr + NMC(j));
            } else {
                const bf16* xr = WSP(const bf16, WS_XRES) + (size_t)rc * D; const float* g2 = mod_vec(C, layer - 1, mrow[u2], 5);
                f32x4 xv[4]; { const v4u xa = *(const v4u*)(xr + 8 * C.lane), xb = *(const v4u*)(xr + 512 + 8 * C.lane);
                    xv[0] = (f32x4){bflo(xa.x), bfhi(xa.x), bflo(xa.y), bfhi(xa.y)}; xv[1] = (f32x4){bflo(xa.z), bfhi(xa.z), bflo(xa.w), bfhi(xa.w)};
                    xv[2] = (f32x4){bflo(xb.x), bfhi(xb.x), bflo(xb.y), bfhi(xb.y)}; xv[3] = (f32x4){bflo(xb.z), bfhi(xb.z), bflo(xb.w), bfhi(xb.w)}; }
                f32x4 a[4];
#pragma unroll
                for (int j = 0; j < 4; ++j) a[j] = (f32x4){0.f, 0.f, 0.f, 0.f};
#pragma unroll
                for (int k = 0; k < 4; ++k) { const unsigned char* yr = WSP(const unsigned char, WS_YS) + (size_t)s4[u2][k] * D; const v2u ya = *(const v2u*)(yr + 8 * C.lane), yb = *(const v2u*)(yr + 512 + 8 * C.lane); const float gk = g4[u2][k];
                    const f32x2 p0 = __builtin_amdgcn_cvt_pk_f32_fp8((int)ya.x, false), p1 = __builtin_amdgcn_cvt_pk_f32_fp8((int)ya.x, true), p2 = __builtin_amdgcn_cvt_pk_f32_fp8((int)ya.y, false), p3 = __builtin_amdgcn_cvt_pk_f32_fp8((int)ya.y, true);
                    const f32x2 q0 = __builtin_amdgcn_cvt_pk_f32_fp8((int)yb.x, false), q1 = __builtin_amdgcn_cvt_pk_f32_fp8((int)yb.x, true), q2 = __builtin_amdgcn_cvt_pk_f32_fp8((int)yb.y, false), q3 = __builtin_amdgcn_cvt_pk_f32_fp8((int)yb.y, true);
                    a[0] += (f32x4){p0.x, p0.y, p1.x, p1.y} * gk; a[1] += (f32x4){p2.x, p2.y, p3.x, p3.y} * gk;
                    a[2] += (f32x4){q0.x, q0.y, q1.x, q1.y} * gk; a[3] += (f32x4){q2.x, q2.y, q3.x, q3.y} * gk; }
#pragma unroll
                for (int j = 0; j < 4; ++j) v[u2][j] = xv[j] + *(const f32x4*)(g2 + NMC(j)) * a[j];
            } }
        float rinv[2];
#pragma unroll
        for (int u2 = 0; u2 < 2; ++u2) { float ss = 0.f;
#pragma unroll
            for (int j = 0; j < 4; ++j) ss += (v[u2][j].x * v[u2][j].x + v[u2][j].y * v[u2][j].y) + (v[u2][j].z * v[u2][j].z + v[u2][j].w * v[u2][j].w);
            rinv[u2] = __builtin_amdgcn_rsqf(wave_sum(ss) * (1.f / D) + NORM_EPS); }
#pragma unroll
        for (int u2 = 0; u2 < 2; ++u2) { const int r = ra + u2 * rstep; if (!live[u2]) continue;
            if (fin) {
#pragma unroll
                for (int j = 0; j < 4; ++j) *(f32x4*)(C.out + (size_t)r * D + NMC(j)) = v[u2][j] * rinv[u2] * *(const f32x4*)(gmain + NMC(j));
                continue; }
            if (layer != 0) { bf16* xw = WSP(bf16, WS_XRES) + (size_t)r * D;
                *(v4u*)(xw + 8 * C.lane) = (v4u){pk2(v[u2][0].x, v[u2][0].y), pk2(v[u2][0].z, v[u2][0].w), pk2(v[u2][1].x, v[u2][1].y), pk2(v[u2][1].z, v[u2][1].w)};
                *(v4u*)(xw + 512 + 8 * C.lane) = (v4u){pk2(v[u2][2].x, v[u2][2].y), pk2(v[u2][2].z, v[u2][2].w), pk2(v[u2][3].x, v[u2][3].y), pk2(v[u2][3].z, v[u2][3].w)}; }
            const float* sh = mod_vec(C, layer, mrow[u2], 0); const float* scl = mod_vec(C, layer, mrow[u2], 1);
            f32x4 hv4[4]; float mine = 0.f;
#pragma unroll
            for (int j = 0; j < 4; ++j) hv4[j] = v[u2][j] * rinv[u2] * *(const f32x4*)(gmain + NMC(j)) * (*(const f32x4*)(scl + NMC(j)) + 1.0f) + *(const f32x4*)(sh + NMC(j));
            { bf16* hr = WSP(bf16, WS_H) + (size_t)r * D;
              *(v4u*)(hr + 8 * C.lane) = (v4u){pk2(hv4[0].x, hv4[0].y), pk2(hv4[0].z, hv4[0].w), pk2(hv4[1].x, hv4[1].y), pk2(hv4[1].z, hv4[1].w)};
              *(v4u*)(hr + 512 + 8 * C.lane) = (v4u){pk2(hv4[2].x, hv4[2].y), pk2(hv4[2].z, hv4[2].w), pk2(hv4[3].x, hv4[3].y), pk2(hv4[3].z, hv4[3].w)}; }
#pragma unroll 2
            for (int i = 0; i < 16; ++i) { float pp = 0.f;
#pragma unroll
                for (int j = 0; j < 4; ++j) { const f32x4 w = *(const LAS f32x4*)(w16 + i * D + NMC(j)); pp += (hv4[j].x * w.x + hv4[j].y * w.y) + (hv4[j].z * w.z + hv4[j].w * w.w); }
                pp = wave_sum(pp); if (C.lane == i) mine = pp; }
            if (C.lane < 16) WSP(float, WS_BA)[(size_t)r * 16 + C.lane] = mine; }
        if (layer != 0) {
#pragma unroll
            for (int u2 = 0; u2 < 2; ++u2)
#pragma unroll
                for (int k = 0; k < 4; ++k) { s4[u2][k] = s4n[u2][k]; g4[u2][k] = g4n[u2][k]; } }
    }
#undef NMC
#undef NM_SLOTS
}

DEVI void u8f(const v4u& w, float (&x)[8]) { x[0] = bflo(w.x); x[1] = bfhi(w.x); x[2] = bflo(w.y); x[3] = bfhi(w.y); x[4] = bflo(w.z); x[5] = bfhi(w.z); x[6] = bflo(w.w); x[7] = bfhi(w.w); }
DEVI v4u f8u(const float (&x)[8]) { return (v4u){pk2(x[0], x[1]), pk2(x[2], x[3]), pk2(x[4], x[5]), pk2(x[6], x[7])}; }
DEVI void ph_attn_prep(const Ctx& C, int layer) {
    const bf16* proj = WSP(const bf16, WS_PROJ);
    bf16* QL = WSP(bf16, WS_QL); bf16* QC = WSP(bf16, WS_QC); bf16* KB = WSP(bf16, WS_K); bf16* VB = WSP(bf16, WS_V);
    const float* tab = WSP(const float, WS_ROPE);
    const int lane = C.lane, l7 = lane & 7, d0 = 8 * l7;
    constexpr float C2A = 0.125f * 1.4426950408889634f, C2D = 0.17677669529663687f * 1.4426950408889634f;
    float gA[8];
    { const float* gn = (lane < 32 ? INP(10) : INP(11)) + layer * 64 + d0;
#pragma unroll
      for (int e = 0; e < 8; ++e) gA[e] = gn[e]; }
    const bool lowA = d0 < 32; const int jA = d0 & 31;
    const int i0 = 8 * (lane & 3); const bool lowD = i0 < 16; const int iD = i0 & 15, mp = l7 >> 2;
    constexpr int RU = 2; const int rstep = C.G * 8;
    for (int rbase = C.bid * 8 + C.wave; rbase < T_ALL; rbase += RU * rstep) {
        v4u pa[RU], pc1[RU], pc2[RU]; f32x4 ca[RU][2], sa[RU][2], cd[RU][2], sd[RU][2];
#pragma unroll
        for (int u2 = 0; u2 < RU; ++u2) { const int rr = rbase + u2 * rstep; const int r = rr < T_ALL ? rr : rbase; const bf16* pr = proj + (size_t)r * N_PROJ;
            pa[u2] = *(const v4u*)(pr + 8 * lane); pc1[u2] = *(const v4u*)(pr + C_CQ + 8 * lane); pc2[u2] = *(const v4u*)(pr + C_CV + 8 * (lane & 31));
            const int t = r < T_L ? r % SEQ : 0;
            ca[u2][0] = *(const f32x4*)(tab + (size_t)t * 32 + jA); ca[u2][1] = *(const f32x4*)(tab + (size_t)t * 32 + jA + 4);
            sa[u2][0] = *(const f32x4*)(tab + (size_t)SEQ * 32 + (size_t)t * 32 + jA); sa[u2][1] = *(const f32x4*)(tab + (size_t)SEQ * 32 + (size_t)t * 32 + jA + 4);
            cd[u2][0] = *(const f32x4*)(tab + (size_t)SEQ * 64 + (size_t)t * 16 + iD); cd[u2][1] = *(const f32x4*)(tab + (size_t)SEQ * 64 + (size_t)t * 16 + iD + 4);
            sd[u2][0] = *(const f32x4*)(tab + (size_t)SEQ * 80 + (size_t)t * 16 + iD); sd[u2][1] = *(const f32x4*)(tab + (size_t)SEQ * 80 + (size_t)t * 16 + iD + 4); }
#pragma unroll
        for (int u2 = 0; u2 < RU; ++u2) { const int r = rbase + u2 * rstep; if (r >= T_ALL) continue;
            const bool lat = r < T_L; const int b = lat ? r / SEQ : (r - T_L) / LC; const int t = lat ? r % SEQ : (r - T_L) % LC; const int pos = lat ? t : SEQ + t;
            { float x[8]; u8f(pa[u2], x);
              if (lane < 48) { float ss = 0.f;
#pragma unroll
                  for (int e = 0; e < 8; ++e) ss += x[e] * x[e];
                  const float rinv = __builtin_amdgcn_rsqf(group_sum<8>(ss) * (1.f / 64.f) + NORM_EPS);
#pragma unroll
                  for (int e = 0; e < 8; ++e) x[e] *= rinv * gA[e]; }
              float o[8];
#pragma unroll
              for (int e = 0; e < 8; ++e) { const float pe = __shfl_xor(x[e], 4); const float c = lat ? ca[u2][e >> 2][e & 3] : 1.f, s = lat ? sa[u2][e >> 2][e & 3] : 0.f;
                  o[e] = lowA ? x[e] * c - pe * s : pe * s + x[e] * c; }
              if (lane < 32) { const int hq = lane >> 3;
#pragma unroll
                  for (int e = 0; e < 8; ++e) o[e] *= C2A;
                  bf16* q = lat ? QL + ((size_t)(b * 12 + hq) * SEQ + t) * 64 : QC + ((size_t)(b * 12 + hq) * LC + t) * 64; *(v4u*)(q + d0) = f8u(o); }
              else if (lane < 48) { const int kvh = (lane - 32) >> 3; *(v4u*)(KB + ((size_t)(b * 6 + kvh) * NKEY + pos) * 64 + d0) = f8u(o); }
              else { const int kvh = (lane - 48) >> 3; *(v4u*)(VB + ((size_t)(b * 6 + kvh) * NKEY + pos) * 64 + d0) = pa[u2]; } }
            { float x[8]; u8f(pc1[u2], x); float o[8];
#pragma unroll
              for (int e = 0; e < 8; ++e) { const float pe = __shfl_xor(x[e], 2); const float c = lat ? cd[u2][e >> 2][e & 3] : 1.f, s = lat ? sd[u2][e >> 2][e & 3] : 0.f;
                  o[e] = lowD ? x[e] * c - pe * s : pe * s + x[e] * c; }
              const int hc = (lane & 31) >> 3;
              if (lane < 32) { const int vh = 4 + 2 * hc + mp;
#pragma unroll
                  for (int e = 0; e < 8; ++e) o[e] *= C2D;
                  bf16* q = lat ? QL + ((size_t)(b * 12 + vh) * SEQ + t) * 64 : QC + ((size_t)(b * 12 + vh) * LC + t) * 64;
                  *(v4u*)(q + mp * 32 + i0) = f8u(o); *(v4u*)(q + (1 - mp) * 32 + i0) = (v4u){0u, 0u, 0u, 0u}; }
              else { *(v4u*)(KB + ((size_t)(b * 6 + 2 + hc) * NKEY + pos) * 64 + d0) = f8u(o); } }
            if (lane < 32) { const int hv = lane >> 3; *(v4u*)(VB + ((size_t)(b * 6 + 2 + hv) * NKEY + pos) * 64 + d0) = pc2[u2]; }
        }
    }
}

DEVI void ph_gmlp(const Ctx& C, int layer, int ntok) {
    constexpr int VP = 136, SP = 68;
    LAS bf16* vnT = (LAS bf16*)C.lds;
    LAS float* rinv = (LAS float*)(vnT + 64 * VP);
    LAS float* spT = rinv + 128;
    const bf16* proj = WSP(const bf16, WS_PROJ); bf16* mix = WSP(bf16, WS_MIX);
    const float* gvn = INP(12) + layer * 256;
    const int tid0 = C.tid;
    constexpr int NSCAN = NB * 16; const int total = (ntok / 128) * 4; const bool split = C.G > NSCAN && total > 2 * NSCAN;
    const int ufirst = !split ? C.bid : (C.bid < NSCAN ? C.bid : 2 * NSCAN + (C.bid - NSCAN)), ustride = !split ? C.G : (C.bid < NSCAN ? NSCAN : C.G - NSCAN), uend = (split && C.bid < NSCAN) ? 2 * NSCAN : total;
    for (int u = ufirst; u < uend; u += ustride) {
        int tid = tid0; LAUNDER_V(tid);
        const int chunk = u >> 2, g = u & 3; const int row0 = chunk * 128;
        const int lane = tid & 63, wv = __builtin_amdgcn_readfirstlane(tid >> 6), l15 = lane & 15, q = lane >> 4;
        bf16x8 afr[4];
        { const float* wsr = INP(13) + ((size_t)layer * 4 + g) * 128 * 128 + (size_t)(16 * wv + l15) * 128 + 8 * q;
#pragma unroll
          for (int kk = 0; kk < 4; ++kk) { const f32x4 a0 = *(const f32x4*)(wsr + 32 * kk), a1 = *(const f32x4*)(wsr + 32 * kk + 4);
              const v4u ap = {pk2(a0.x, a0.y), pk2(a0.z, a0.w), pk2(a1.x, a1.y), pk2(a1.z, a1.w)}; afr[kk] = __builtin_bit_cast(bf16x8, ap); } }
        { const int tok = tid >> 2, qd = tid & 3; const bf16* p = proj + (size_t)(row0 + tok) * N_PROJ + C_BV + qd * 64; float ss = 0.f;
#pragma unroll
          for (int c8 = 0; c8 < 8; ++c8) { const v4u w = *(const v4u*)(p + c8 * 8);
              const float a0 = gelu_tanh(bflo(w.x)), a1 = gelu_tanh(bfhi(w.x)), a2 = gelu_tanh(bflo(w.y)), a3 = gelu_tanh(bfhi(w.y)), a4 = gelu_tanh(bflo(w.z)), a5 = gelu_tanh(bfhi(w.z)), a6 = gelu_tanh(bflo(w.w)), a7 = gelu_tanh(bfhi(w.w));
              ss += (a0 * a0 + a1 * a1) + (a2 * a2 + a3 * a3) + (a4 * a4 + a5 * a5) + (a6 * a6 + a7 * a7); }
          ss = group_sum<4>(ss); if (qd == 0) rinv[tok] = __builtin_amdgcn_rsqf(ss * (1.f / 256.f) + NORM_EPS); }
        __syncthreads();
        { const int tok = tid >> 2, c0 = (tid & 3) * 16; const bf16* p = proj + (size_t)(row0 + tok) * N_PROJ + C_BV + g * 64 + c0; const float ri = rinv[tok];
          const v4u w0 = *(const v4u*)p, w1 = *(const v4u*)(p + 8); const unsigned ww[8] = {w0.x, w0.y, w0.z, w0.w, w1.x, w1.y, w1.z, w1.w};
#pragma unroll
          for (int c = 0; c < 16; ++c) { const float x = (c & 1) ? bfhi(ww[c >> 1]) : bflo(ww[c >> 1]); vnT[(c0 + c) * VP + tok] = (bf16)f2bf(gelu_tanh(x) * ri * gvn[g * 64 + c0 + c]); } }
        __syncthreads();
        { f32x4 acc[4];
#pragma unroll
          for (int n = 0; n < 4; ++n) acc[n] = (f32x4){0.f, 0.f, 0.f, 0.f};
#pragma unroll
          for (int kk = 0; kk < 4; ++kk)
#pragma unroll
              for (int n = 0; n < 4; ++n) acc[n] = __builtin_amdgcn_mfma_f32_16x16x32_bf16(afr[kk], *(const LAS bf16x8*)(vnT + (16 * n + l15) * VP + 32 * kk + 8 * q), acc[n], 0, 0, 0);
          const float* bs = INP(14) + ((size_t)layer * 4 + g) * 128;
#pragma unroll
          for (int r = 0; r < 4; ++r) { const int tok = 16 * wv + 4 * q + r; const float bb = bs[tok];
#pragma unroll
              for (int n = 0; n < 4; ++n) spT[tok * SP + 16 * n + l15] = acc[n][r] + bb; } }
        __syncthreads();
        { const int tok = tid >> 2, c0 = (tid & 3) * 16; const size_t rowp = (size_t)(row0 + tok);
          const bf16* pu = proj + rowp * N_PROJ + C_BU + g * 64 + c0; const v4u u0 = *(const v4u*)pu, u1 = *(const v4u*)(pu + 8); const unsigned uw[8] = {u0.x, u0.y, u0.z, u0.w, u1.x, u1.y, u1.z, u1.w};
          float o[16];
#pragma unroll
          for (int c4 = 0; c4 < 4; ++c4) { const f32x4 sp = *(const LAS f32x4*)(spT + tok * SP + c0 + 4 * c4);
              o[4 * c4 + 0] = gelu_tanh(bflo(uw[2 * c4])) * sp.x; o[4 * c4 + 1] = gelu_tanh(bfhi(uw[2 * c4])) * sp.y; o[4 * c4 + 2] = gelu_tanh(bflo(uw[2 * c4 + 1])) * sp.z; o[4 * c4 + 3] = gelu_tanh(bfhi(uw[2 * c4 + 1])) * sp.w; }
          bf16* po = mix + rowp * D + 256 + g * 64 + c0;
          *(v4u*)po = (v4u){pk2(o[0], o[1]), pk2(o[2], o[3]), pk2(o[4], o[5]), pk2(o[6], o[7])}; *(v4u*)(po + 8) = (v4u){pk2(o[8], o[9]), pk2(o[10], o[11]), pk2(o[12], o[13]), pk2(o[14], o[15])}; }
        __syncthreads();
    }
}

DEVI int dn_kmap(int kk, int q, int j) { return 16 * (2 * kk + (j >> 2)) + 4 * q + (j & 3); }
DEVI size_t dn_unit_off(int b, int dir, int h, int sc) { return ((size_t)((b * 2 + dir) * 4 + h) * NCH + sc) * DN_UNIT_BYTES; }
constexpr int DP = 68, XP = 132, HP = 72;
DEVI f32x4 mfma16(bf16x8 a, bf16x8 b, f32x4 c) { return __builtin_amdgcn_mfma_f32_16x16x32_bf16(a, b, c, 0, 0, 0); }
#ifndef D1REP
#define D1REP 0
#endif
#define DN_BAR() asm volatile("s_waitcnt lgkmcnt(0)\n\ts_barrier" ::: "memory")
DEVI void ph_dn_chunk(const Ctx& C, int layer) {
    LAS bf16* kN = (LAS bf16*)C.lds;
    LAS bf16* qN = kN + 64 * HP;
    LAS bf16* kT = qN + 64 * HP;
    LAS bf16* QKd = kT + 64 * HP;
    LAS bf16* RT = QKd + 64 * HP;
    LAS bf16* XT = RT;
    LAS bf16* TiB = RT + 128 * HP;
    LAS float* Am = (LAS float*)(TiB + 64 * HP);
    LAS float* TI = Am + 64 * DP;
    LAS bf16* XdT = (LAS bf16*)Am;
    LAS float* TMP = TI + 64 * DP;
    LAS float* vec = TMP + 1280;
    LAS float* betav = vec; LAS float* cum = vec + 64; LAS float* ecum = vec + 128; LAS float* dvec = vec + 192; LAS float* bec = vec + 256;
    LAS float* cwl = vec + 320;
    LAS float* gpar = cwl + 2304;
    static_assert(128 * HP * 2 <= 2 * 64 * DP * 4 && (4 * 64 * HP + 128 * HP + 64 * HP) * 2 + (2 * 64 * DP + 1280 + 320 + 2304 + 16) * 4 <= MISC_OFF, "D1 LDS");
    const bf16* proj = WSP(const bf16, WS_PROJ); const float* BA = WSP(const float, WS_BA);
    { const float* cwg = INP(20) + (size_t)layer * 3 * 768; for (int i = C.tid; i < 2304; i += 512) cwl[i] = cwg[i];
      if (C.tid < 8) gpar[C.tid] = -fast_exp(INP(21)[layer * 8 + C.tid]); else if (C.tid < 16) gpar[C.tid] = INP(22)[layer * 8 + C.tid - 8]; }
    __syncthreads();
    const LAS float* cw = cwl;
    const int tid0 = C.tid;
#define FRESH_TID() int tid = tid0; LAUNDER_V(tid)
#define DN_DECODE(u_) const int tcx = (u_) % NCH, h = ((u_) / NCH) & 3, dir = ((u_) / (NCH * 4)) & 1, b = (u_) / (NCH * 8); \
        const bool isc = tcx < NCH_C; const int tc = isc ? tcx : tcx - NCH_C; const int nch = isc ? NCH_C : NCH_L; const int len = nch * 64; \
        const int row_seq0 = isc ? T_L + b * LC : b * SEQ
    v4u rw[3][3]; float rb0 = 0.f, rb1 = 0.f, rb2 = 0.f;
#define DN_LOAD(u_) do { if ((u_) < NB * 2 * 4 * NCH) { DN_DECODE(u_); int t_ = tid0; LAUNDER_V(t_); const int c = t_ >> 3, d0 = (t_ & 7) * 8; const int tl = tc * 64 + (dir ? 63 - c : c); const size_t r = (size_t)row_seq0 + tl; \
        const bool hp = tl > 0, hn = tl < len - 1; \
        _Pragma("unroll") for (int w3 = 0; w3 < 3; ++w3) { const bf16* p = proj + r * N_PROJ + C_DQKV + w3 * 256 + h * 64 + d0; \
            rw[w3][1] = *(const v4u*)p; rw[w3][0] = (v4u){0u, 0u, 0u, 0u}; rw[w3][2] = (v4u){0u, 0u, 0u, 0u}; if (hp) rw[w3][0] = *(const v4u*)(p - N_PROJ); if (hn) rw[w3][2] = *(const v4u*)(p + N_PROJ); } \
        rb0 = BA[r * 16 + dir * 4 + h]; \
        if (t_ < 64) { const int tl2 = tc * 64 + (dir ? 63 - t_ : t_); const float* ba = BA + ((size_t)row_seq0 + tl2) * 16; rb1 = ba[dir * 4 + h]; rb2 = ba[8 + dir * 4 + h]; } } } while (0)
    DN_LOAD(C.bid);
    for (int u = C.bid; u < NB * 2 * 4 * NCH; u += C.G) {
        DN_DECODE(u);
        const int sc = (isc ? 0 : NCH_C) + (dir ? nch - 1 - tc : tc);
        { FRESH_TID(); const int c = tid >> 3, part = tid & 7, d0 = part * 8;
          float y[3][8];
#pragma unroll
          for (int w3 = 0; w3 < 3; ++w3) { const int col = w3 * 256 + h * 64 + d0;
              const v4u xc = rw[w3][1], xp = rw[w3][0], xn = rw[w3][2];
              const unsigned xcw[4] = {xc.x, xc.y, xc.z, xc.w}, xpw[4] = {xp.x, xp.y, xp.z, xp.w}, xnw[4] = {xn.x, xn.y, xn.z, xn.w};
#pragma unroll
              for (int e = 0; e < 8; ++e) { const float a = (e & 1) ? bfhi(xpw[e >> 1]) : bflo(xpw[e >> 1]), m = (e & 1) ? bfhi(xcw[e >> 1]) : bflo(xcw[e >> 1]), n = (e & 1) ? bfhi(xnw[e >> 1]) : bflo(xnw[e >> 1]);
                  y[w3][e] = siluf_(cw[col + e] * a + cw[768 + col + e] * m + cw[1536 + col + e] * n); } }
          const float ba_b = rb0, ba_b2 = rb1, ba_a2 = rb2;
          DN_LOAD(u + C.G);
          float sq = 0.f, sk = 0.f;
#pragma unroll
          for (int e = 0; e < 8; ++e) { sq += y[0][e] * y[0][e]; sk += y[1][e] * y[1][e]; }
          sq = group_sum<8>(sq); sk = group_sum<8>(sk);
          const float rq = __builtin_amdgcn_rsqf(sq + NORM_EPS) * 0.125f, rk = __builtin_amdgcn_rsqf(sk + NORM_EPS);
          const float betac = sigmoidf_(ba_b);
#pragma unroll
          for (int e = 0; e < 8; ++e) { y[0][e] *= rq; y[1][e] *= rk; kT[(d0 + e) * HP + c] = (bf16)f2bf(y[1][e]); RT[(d0 + e) * HP + c] = (bf16)f2bf(betac * y[2][e]); }
          *(LAS v4u*)(qN + c * HP + d0) = (v4u){pk2(y[0][0], y[0][1]), pk2(y[0][2], y[0][3]), pk2(y[0][4], y[0][5]), pk2(y[0][6], y[0][7])};
          *(LAS v4u*)(kN + c * HP + d0) = (v4u){pk2(y[1][0], y[1][1]), pk2(y[1][2], y[1][3]), pk2(y[1][4], y[1][5]), pk2(y[1][6], y[1][7])};
          *(LAS v4u*)(QKd + c * HP + d0) = (v4u){0u, 0u, 0u, 0u};
          { LAS f32x4* z = (LAS f32x4*)TI; z[tid] = (f32x4){0.f, 0.f, 0.f, 0.f}; z[tid + 512] = (f32x4){0.f, 0.f, 0.f, 0.f}; if (tid < 64) z[tid + 1024] = (f32x4){0.f, 0.f, 0.f, 0.f}; }
          if (tid < 64) { const int c2 = tid;
              const float bt = sigmoidf_(ba_b2);
              float sg = gpar[dir * 4 + h] * softplusf_(ba_a2 + gpar[8 + dir * 4 + h]);
#pragma unroll
              for (int o = 1; o < 64; o <<= 1) { const float t = __shfl_up(sg, o); if (c2 >= o) sg += t; }
              const float G = __shfl(sg, 63); const float ec = fast_exp(sg);
              betav[c2] = bt; cum[c2] = sg; ecum[c2] = ec; dvec[c2] = fast_exp(G - sg); bec[c2] = bt * ec; } }
        DN_BAR();
        for (int rp_ = 0; rp_ < 1 + (((D1REP) >> 1) & 1); ++rp_) {
        { FRESH_TID(); const int lane = tid & 63, wv = __builtin_amdgcn_readfirstlane(tid >> 6), l15 = lane & 15, q = lane >> 4;
          { const int k = tid >> 3, c0 = (tid & 7) * 8; const v4u kk4 = *(const LAS v4u*)(kT + k * HP + c0); const unsigned kw[4] = {kk4.x, kk4.y, kk4.z, kk4.w}; unsigned ow[4];
#pragma unroll
            for (int e = 0; e < 4; ++e) ow[e] = pk2(bflo(kw[e]) * bec[c0 + 2 * e], bfhi(kw[e]) * bec[c0 + 2 * e + 1]);
            *(LAS v4u*)(RT + (64 + k) * HP + c0) = (v4u){ow[0], ow[1], ow[2], ow[3]}; }
#pragma unroll
          for (int tt = 0; tt < 3; ++tt) { const int t = wv + 8 * tt; if (t >= 20) break;
              const bool isq = t >= 10; const int idx = isq ? t - 10 : t; const int ti = (idx >= 6) ? 3 : (idx >= 3) ? 2 : (idx >= 1) ? 1 : 0; const int tj = idx - ti * (ti + 1) / 2;
              const LAS bf16* asrc = (isq ? qN : kN) + (16 * ti + l15) * HP + 8 * q; const LAS bf16* bsrc = kN + (16 * tj + l15) * HP + 8 * q;
              f32x4 acc = {0.f, 0.f, 0.f, 0.f};
              acc = mfma16(*(const LAS bf16x8*)asrc, *(const LAS bf16x8*)bsrc, acc); acc = mfma16(*(const LAS bf16x8*)(asrc + 32), *(const LAS bf16x8*)(bsrc + 32), acc);
              const int j = 16 * tj + l15; const float cj = cum[j];
#pragma unroll
              for (int r = 0; r < 4; ++r) { const int i = 16 * ti + 4 * q + r; const float dec = fast_exp(cum[i] - cj);
                  if (isq) QKd[i * HP + j] = (bf16)f2bf((i >= j) ? acc[r] * dec : 0.f); else Am[i * DP + j] = (i > j) ? acc[r] * dec * betav[i] : 0.f; } } }
        DN_BAR();
        }
        for (int rp_ = 0; rp_ < 1 + (((D1REP) >> 2) & 1); ++rp_) {
        { FRESH_TID(); if (tid < 64) { const int bb = tid >> 4, col = tid & 15; float x[16];
#pragma unroll
            for (int r = 0; r < 16; ++r) { float s = (r == col) ? 1.f : 0.f;
#pragma unroll
                for (int s2 = 0; s2 < r; ++s2) s -= Am[(16 * bb + r) * DP + 16 * bb + s2] * x[s2];
                x[r] = s; }
#pragma unroll
            for (int r = 0; r < 16; ++r) TI[(16 * bb + r) * DP + 16 * bb + col] = x[r]; } }
        DN_BAR();
        }
        for (int rp_ = 0; rp_ < 1 + (((D1REP) >> 3) & 1); ++rp_) {
        { FRESH_TID(); const int p = tid >> 8, r = (tid >> 4) & 15, c = tid & 15; float e = 0.f;
#pragma unroll
          for (int s2 = 0; s2 < 16; ++s2) e += Am[(32 * p + 16 + r) * DP + 32 * p + s2] * TI[(32 * p + s2) * DP + 32 * p + c];
          TMP[(p * 16 + r) * 17 + c] = e;
          DN_BAR();
          float f = 0.f;
#pragma unroll
          for (int s2 = 0; s2 < 16; ++s2) f -= TI[(32 * p + 16 + r) * DP + 32 * p + 16 + s2] * TMP[(p * 16 + s2) * 17 + c];
          TI[(32 * p + 16 + r) * DP + 32 * p + c] = f; }
        DN_BAR();
        }
        for (int rp_ = 0; rp_ < 1 + (((D1REP) >> 4) & 1); ++rp_) {
        { FRESH_TID(); const int r = tid >> 4, c2 = (tid & 15) * 2; float e0 = 0.f, e1 = 0.f;
#pragma unroll 8
          for (int s2 = 0; s2 < 32; ++s2) { const float a = Am[(32 + r) * DP + s2]; e0 += a * TI[s2 * DP + c2]; e1 += a * TI[s2 * DP + c2 + 1]; }
          TMP[r * 36 + c2] = e0; TMP[r * 36 + c2 + 1] = e1;
          DN_BAR();
          float f0 = 0.f, f1 = 0.f;
#pragma unroll 8
          for (int s2 = 0; s2 < 32; ++s2) { const float a = TI[(32 + r) * DP + 32 + s2]; f0 -= a * TMP[s2 * 36 + c2]; f1 -= a * TMP[s2 * 36 + c2 + 1]; }
          TI[(32 + r) * DP + c2] = f0; TI[(32 + r) * DP + c2 + 1] = f1; }
        DN_BAR();
        }
        for (int rp_ = 0; rp_ < 1 + (((D1REP) >> 5) & 1); ++rp_) {
        { FRESH_TID(); const int c = tid >> 3, c0 = (tid & 7) * 8; float x[8];
#pragma unroll
          for (int e = 0; e < 8; ++e) x[e] = (c0 + e <= c) ? TI[c * DP + c0 + e] : 0.f;
          *(LAS v4u*)(TiB + c * HP + c0) = (v4u){pk2(x[0], x[1]), pk2(x[2], x[3]), pk2(x[4], x[5]), pk2(x[6], x[7])}; }
        DN_BAR();
        }
        { FRESH_TID(); const int lane = tid & 63, wv = __builtin_amdgcn_readfirstlane(tid >> 6), l15 = lane & 15, q = lane >> 4;
          f32x4 xa[4]; const LAS bf16* bsrc = RT + (16 * wv + l15) * HP + 8 * q; const bf16x8 b0 = *(const LAS bf16x8*)bsrc, b1 = *(const LAS bf16x8*)(bsrc + 32);
#pragma unroll
          for (int m = 0; m < 4; ++m) { const LAS bf16* asrc = TiB + (16 * m + l15) * HP + 8 * q; f32x4 a_ = {0.f, 0.f, 0.f, 0.f};
              a_ = mfma16(*(const LAS bf16x8*)asrc, b0, a_); xa[m] = mfma16(*(const LAS bf16x8*)(asrc + 32), b1, a_); }
          DN_BAR();
          const int col = 16 * wv + l15;
#pragma unroll
          for (int m = 0; m < 4; ++m) { const int c0 = 16 * m + 4 * q; const f32x4 x = xa[m];
              *(LAS v2u*)(XT + col * HP + c0) = (v2u){pk2(x.x, x.y), pk2(x.z, x.w)};
              *(LAS v2u*)(XdT + col * HP + c0) = (v2u){pk2(x.x * dvec[c0], x.y * dvec[c0 + 1]), pk2(x.z * dvec[c0 + 2], x.w * dvec[c0 + 3])}; } }
        DN_BAR();
        for (int rp_ = 0; rp_ < 1 + (((D1REP) >> 7) & 1); ++rp_) {
        { FRESH_TID(); const int lane = tid & 63, wv = __builtin_amdgcn_readfirstlane(tid >> 6), l15 = lane & 15, q = lane >> 4;
          unsigned char* ub = WSP(unsigned char, WS_DNF + dn_unit_off(b, dir, h, sc));
          const float eG = ecum[63];
#define DN_MM(dst, Ap, Bp) do { f32x4 a_ = {0.f, 0.f, 0.f, 0.f}; a_ = mfma16(*(const LAS bf16x8*)(Ap), *(const LAS bf16x8*)(Bp), a_); dst = mfma16(*(const LAS bf16x8*)((Ap) + 32), *(const LAS bf16x8*)((Bp) + 32), a_); } while (0)
#pragma unroll
          for (int t2 = 0; t2 < 2; ++t2) { const int t = 2 * wv + t2, m = t >> 2, n = t & 3; f32x4 acc;
              DN_MM(acc, kT + (16 * m + l15) * HP + 8 * q, XdT + (16 * n + l15) * HP + 8 * q);
              *(v2u*)(ub + 16384 + (size_t)((n * 4 + m) * 64 + lane) * 8) = (v2u){pk2(acc.x, acc.y), pk2(acc.z, acc.w)};
              DN_MM(acc, QKd + (16 * m + l15) * HP + 8 * q, XT + (16 * n + l15) * HP + 8 * q);
              *(v2u*)(ub + 24576 + (size_t)((n * 4 + m) * 64 + lane) * 8) = (v2u){pk2(acc.x, acc.y), pk2(acc.z, acc.w)}; }
          { const int n = wv >> 1, kk2 = wv & 1; f32x4 z0, z1, y0, y1;
            DN_MM(z0, XdT + (64 + 16 * (2 * kk2) + l15) * HP + 8 * q, kT + (16 * n + l15) * HP + 8 * q);
            DN_MM(z1, XdT + (64 + 16 * (2 * kk2 + 1) + l15) * HP + 8 * q, kT + (16 * n + l15) * HP + 8 * q);
            DN_MM(y0, XT + (64 + 16 * (2 * kk2) + l15) * HP + 8 * q, QKd + (16 * n + l15) * HP + 8 * q);
            DN_MM(y1, XT + (64 + 16 * (2 * kk2 + 1) + l15) * HP + 8 * q, QKd + (16 * n + l15) * HP + 8 * q);
            const int rowi = 16 * n + l15; float mv[8], qv[8]; const float ec = ecum[rowi];
#pragma unroll
            for (int e = 0; e < 8; ++e) { const int kp = 16 * (2 * kk2 + (e >> 2)) + 4 * q + (e & 3); const float zz = (e < 4) ? z0[e & 3] : z1[e & 3], yy = (e < 4) ? y0[e & 3] : y1[e & 3];
                mv[e] = ((kp == rowi) ? eG : 0.f) - zz; qv[e] = ec * bf2f(qN[rowi * HP + kp]) - yy; }
            *(v4u*)(ub + (size_t)((n * 2 + kk2) * 64 + lane) * 16) = (v4u){pk2(mv[0], mv[1]), pk2(mv[2], mv[3]), pk2(mv[4], mv[5]), pk2(mv[6], mv[7])};
            *(v4u*)(ub + 8192 + (size_t)((n * 2 + kk2) * 64 + lane) * 16) = (v4u){pk2(qv[0], qv[1]), pk2(qv[2], qv[3]), pk2(qv[4], qv[5]), pk2(qv[6], qv[7])}; }
#undef DN_MM
        }
        DN_BAR();
        }
    }
}
#undef FRESH_TID
#undef DN_BAR
#undef DN_LOAD
#undef DN_DECODE
DEVI bf16x8 dn_pack(const f32x4& a, const f32x4& b) { const v4u o = {pk2(a.x, a.y), pk2(a.z, a.w), pk2(b.x, b.y), pk2(b.z, b.w)}; return __builtin_bit_cast(bf16x8, o); }
#define SCAN_BAR() asm volatile("s_waitcnt lgkmcnt(0)\n\ts_barrier" ::: "memory")
DEVI unsigned cvtpk(float lo, float hi) { return pk2(lo, hi); }
DEVI bf16x8 dn_pack_hw(const f32x4& a, const f32x4& b) { const v4u o = {cvtpk(a.x, a.y), cvtpk(a.z, a.w), cvtpk(b.x, b.y), cvtpk(b.z, b.w)}; return __builtin_bit_cast(bf16x8, o); }
DEVI void ph_dn_scan(const Ctx& C, int layer) {
    constexpr int SLOTB = 24576, NS = 4, P = 8, NLD = 384, NPC = 4;
    static_assert(NCH % P == 0 || NCH % P == P / 2, "scan pipeline depth: whole groups of P steps plus at most one half group");
    const int lane = C.lane, q = lane >> 4, v16 = lane & 15;
    bf16* DNO = WSP(bf16, WS_DNO);
    for (int u = C.bid; u < NB * 2 * 4 * 2; u += C.G) {
        const int vp = u & 1, h = (u >> 1) & 3, dir = (u >> 3) & 1, b = u >> 4;
        const unsigned char* base = WSP(const unsigned char, WS_DNF + dn_unit_off(b, dir, h, 0));
        if (C.wave < 2) {
            const int vs = 2 * vp + C.wave;
            bf16x8 sf[2]; { const v4u z = {0u, 0u, 0u, 0u}; sf[0] = __builtin_bit_cast(bf16x8, z); sf[1] = sf[0]; }
            bf16* ob = DNO + (size_t)dir * T_ALL * 256 + h * 64 + vs * 16 + v16;
            SCAN_BAR();
#define SCAN_SEG(SGN, SC0, NCHS, SEQ0, LEN) do { \
            bf16* pm[4]; \
            _Pragma("unroll") for (int m = 0; m < 4; ++m) pm[m] = ob + ((long)(SEQ0) + ((SGN) < 0 ? (LEN) - 1 : 0) + (SGN) * (16 * m + 4 * q)) * 256; \
            _Pragma("unroll 1") for (int s2 = 0; s2 < (NCHS); ++s2) { \
                const LAS unsigned char* sl = C.lds + (((SC0) + s2) % NS) * SLOTB; \
                f32x4 o[4], d[4]; \
                _Pragma("unroll") for (int m = 0; m < 4; ++m) { \
                    const bf16x8 ma0 = *(const LAS bf16x8*)(sl + ((m * 2 + 0) * 64 + lane) * 16), ma1 = *(const LAS bf16x8*)(sl + ((m * 2 + 1) * 64 + lane) * 16); \
                    const bf16x8 qa0 = *(const LAS bf16x8*)(sl + 8192 + ((m * 2 + 0) * 64 + lane) * 16), qa1 = *(const LAS bf16x8*)(sl + 8192 + ((m * 2 + 1) * 64 + lane) * 16); \
                    const v2u ncp = *(const LAS v2u*)(sl + 16384 + ((C.wave * 4 + m) * 64 + lane) * 8), ocp = *(const LAS v2u*)(sl + 20480 + ((C.wave * 4 + m) * 64 + lane) * 8); \
                    const f32x4 nc = {bflo(ncp.x), bfhi(ncp.x), bflo(ncp.y), bfhi(ncp.y)}, oc = {bflo(ocp.x), bfhi(ocp.x), bflo(ocp.y), bfhi(ocp.y)}; \
                    d[m] = __builtin_amdgcn_mfma_f32_16x16x32_bf16(ma0, sf[0], nc, 0, 0, 0); d[m] = __builtin_amdgcn_mfma_f32_16x16x32_bf16(ma1, sf[1], d[m], 0, 0, 0); \
                    o[m] = __builtin_amdgcn_mfma_f32_16x16x32_bf16(qa0, sf[0], oc, 0, 0, 0); o[m] = __builtin_amdgcn_mfma_f32_16x16x32_bf16(qa1, sf[1], o[m], 0, 0, 0); } \
                sf[0] = dn_pack_hw(d[0], d[1]); sf[1] = dn_pack_hw(d[2], d[3]); \
                _Pragma("unroll") for (int m = 0; m < 4; ++m) { \
                    _Pragma("unroll") for (int i = 0; i < 4; ++i) pm[m][(SGN) * i * 256] = (bf16)f2bf(o[m][i]); \
                    pm[m] += (SGN) * 64 * 256; } \
                SCAN_BAR(); } } while (0)
            if (dir == 0) { SCAN_SEG(1, 0, NCH_C, T_L + b * LC, LC); SCAN_SEG(1, NCH_C, NCH_L, b * SEQ, SEQ); }
            else          { SCAN_SEG(-1, 0, NCH_C, T_L + b * LC, LC); SCAN_SEG(-1, NCH_C, NCH_L, b * SEQ, SEQ); }
#undef SCAN_SEG
        } else {
            const int lid = C.tid - 128;
            unsigned so[NPC], dofs[NPC];
#pragma unroll
            for (int i = 0; i < NPC; ++i) { const int pp = lid + NLD * i;
                so[i] = (pp < 1024) ? (unsigned)pp * 16u : (pp < 1280) ? 16384u + (unsigned)(vp * 256 + (pp - 1024)) * 16u : 24576u + (unsigned)(vp * 256 + (pp - 1280)) * 16u; dofs[i] = (unsigned)pp * 16u; }
            v4u buf[P][NPC];
#pragma unroll
            for (int s2 = 0; s2 < P; ++s2)
#pragma unroll
                for (int i = 0; i < NPC; ++i) buf[s2][i] = *(const v4u*)(base + (size_t)s2 * DN_UNIT_BYTES + so[i]);
#pragma unroll
            for (int i = 0; i < NPC; ++i) *(LAS v4u*)(C.lds + dofs[i]) = buf[0][i];
            SCAN_BAR();
#define SCAN_LD_STEP(j) do { const int step = sc + (j); const int nxt = (step + P < NCH) ? step + P : NCH - 1; \
                    _Pragma("unroll") for (int i = 0; i < NPC; ++i) buf[(j)][i] = *(const v4u*)(base + (size_t)nxt * DN_UNIT_BYTES + so[i]); \
                    LAS unsigned char* sl = C.lds + ((step + 1) % NS) * SLOTB; \
                    _Pragma("unroll") for (int i = 0; i < NPC; ++i) *(LAS v4u*)(sl + dofs[i]) = buf[((j) + 1) % P][i]; \
                    SCAN_BAR(); } while (0)
            int sc = 0;
#pragma unroll 1
            for (; sc + P <= NCH; sc += P) {
#pragma unroll
                for (int j = 0; j < P; ++j) SCAN_LD_STEP(j);
            }
            if (NCH % P) {
#pragma unroll
                for (int j = 0; j < P / 2; ++j) SCAN_LD_STEP(j);
            }
#undef SCAN_LD_STEP
        }
    }
}
#undef SCAN_BAR

DEVI void ph_finalize(const Ctx& C, int layer, int ntok) {
    const int lane = C.lane;
    const bf16* DNO = WSP(const bf16, WS_DNO); const bf16* proj = WSP(const bf16, WS_PROJ); bf16* mix = WSP(bf16, WS_MIX);
    const f32x4 ong = *(const f32x4*)(INP(23) + layer * 64 + ((4 * lane) & 63));
    constexpr int RU = 4; const int rstep = C.G * 8;
    for (int r0 = C.bid * 8 + C.wave; r0 < ntok; r0 += RU * rstep) {
        v2u zz[RU], d0[RU], d1[RU];
#pragma unroll
        for (int u2 = 0; u2 < RU; ++u2) { const int rr = r0 + u2 * rstep; const size_t r = rr < ntok ? rr : r0;
            d0[u2] = *(const v2u*)(DNO + r * 256 + 4 * lane); d1[u2] = *(const v2u*)(DNO + ((size_t)T_ALL + r) * 256 + 4 * lane);
            zz[u2] = *(const v2u*)(proj + r * N_PROJ + C_DZ + 4 * lane); }
#pragma unroll
        for (int u2 = 0; u2 < RU; ++u2) { const int rr = r0 + u2 * rstep; if (rr >= ntok) continue; const size_t r = rr;
            const f32x4 od = (f32x4){bflo(d0[u2].x), bfhi(d0[u2].x), bflo(d0[u2].y), bfhi(d0[u2].y)} + (f32x4){bflo(d1[u2].x), bfhi(d1[u2].x), bflo(d1[u2].y), bfhi(d1[u2].y)};
            const float ss = group_sum<16>((od.x * od.x + od.y * od.y) + (od.z * od.z + od.w * od.w));
            const float rinv = __builtin_amdgcn_rsqf(ss * (1.f / 64.f) + NORM_EPS);
            const f32x4 z = (f32x4){siluf_(bflo(zz[u2].x)), siluf_(bfhi(zz[u2].x)), siluf_(bflo(zz[u2].y)), siluf_(bfhi(zz[u2].y))};
            const f32x4 o = od * rinv * ong * z; v2u w; w.x = pk2(o.x, o.y); w.y = pk2(o.z, o.w); *(v2u*)(mix + r * D + 768 + 4 * lane) = w; }
    }
}

DEVI void ph_router(const Ctx& C, int layer, int ntok) {
    LAS float* lgt = (LAS float*)C.lds;
    LAS int* cnt = (LAS int*)(lgt + 8 * 16 * 33);
    if (C.tid < 32) cnt[C.tid] = 0;
    __syncthreads();
    const int nt = ntok / 16; const int t0 = (int)((long)C.bid * nt / C.G), t1 = (int)((long)(C.bid + 1) * nt / C.G);
    const float* gn = INP(7) + (size_t)layer * D;
    const int l15 = C.lane & 15, q = C.lane >> 4; LAS float* lg_w = lgt + C.wave * 16 * 33;
    const int nrem = (t1 - t0) & 7; const int t1w = nrem <= 2 ? t1 - nrem : t1;
    for (int t = t0 + C.wave; t < t1w; t += 8) {
        const int row0 = 16 * t, mrow = mod_row(row0);
        const bf16* xa = WSP(const bf16, WS_XRES) + (size_t)(row0 + l15) * D + 8 * q;
        const bf16* wb = (const bf16*)(WSP(const float, WS_RWP) + ((size_t)(layer * 9 + mrow) * NE + l15) * D) + 8 * q;
        f32x4 acc0 = {0.f, 0.f, 0.f, 0.f}, acc1 = {0.f, 0.f, 0.f, 0.f}; float ssq = 0.f;
#pragma unroll 4
        for (int kk = 0; kk < 32; ++kk) { const v4u aw = *(const v4u*)(xa + 32 * kk); const bf16x8 av = __builtin_bit_cast(bf16x8, aw);
            const bf16x8 h0 = *(const bf16x8*)(wb + 32 * kk), l0 = *(const bf16x8*)(wb + D + 32 * kk), h1 = *(const bf16x8*)(wb + (size_t)32 * D + 32 * kk), l1 = *(const bf16x8*)(wb + (size_t)33 * D + 32 * kk);
            ssq += ((bflo(aw.x) * bflo(aw.x) + bfhi(aw.x) * bfhi(aw.x)) + (bflo(aw.y) * bflo(aw.y) + bfhi(aw.y) * bfhi(aw.y))) + ((bflo(aw.z) * bflo(aw.z) + bfhi(aw.z) * bfhi(aw.z)) + (bflo(aw.w) * bflo(aw.w) + bfhi(aw.w) * bfhi(aw.w)));
            acc0 = __builtin_amdgcn_mfma_f32_16x16x32_bf16(av, h0, acc0, 0, 0, 0); acc1 = __builtin_amdgcn_mfma_f32_16x16x32_bf16(av, h1, acc1, 0, 0, 0);
            acc0 = __builtin_amdgcn_mfma_f32_16x16x32_bf16(av, l0, acc0, 0, 0, 0); acc1 = __builtin_amdgcn_mfma_f32_16x16x32_bf16(av, l1, acc1, 0, 0, 0); }
        ssq += __shfl_xor(ssq, 16); ssq += __shfl_xor(ssq, 32);
        const float rinv = __builtin_amdgcn_rsqf(ssq * (1.f / D) + NORM_EPS);
        const float* rb = WSP(const float, WS_RBP) + (size_t)(layer * 9 + mrow) * NE;
        const float bb0 = rb[l15], bb1 = rb[16 + l15];
#pragma unroll
        for (int r = 0; r < 4; ++r) { const float ri = __shfl(rinv, 4 * q + r); lg_w[(4 * q + r) * 33 + l15] = acc0[r] * ri + bb0; lg_w[(4 * q + r) * 33 + 16 + l15] = acc1[r] * ri + bb1; }
        LDS_WAIT();
        if (C.lane < 16) { const int r = row0 + C.lane; float lg[32];
#pragma unroll
            for (int e = 0; e < 32; ++e) lg[e] = lg_w[C.lane * 33 + e];
            int te[4]; float tv[4];
#pragma unroll
            for (int k = 0; k < 4; ++k) { float best = -INFINITY; int bi = 0;
#pragma unroll
                for (int e = 0; e < 32; ++e) if (lg[e] > best) { best = lg[e]; bi = e; }
#pragma unroll
                for (int e = 0; e < 32; ++e) lg[e] = (e == bi) ? -INFINITY : lg[e];
                te[k] = bi; tv[k] = best; }
            float ex[4], es = 0.f;
#pragma unroll
            for (int k = 0; k < 4; ++k) { ex[k] = fast_exp(tv[k] - tv[0]); es += ex[k]; }
            const float ri = 1.f / es;
#pragma unroll
            for (int k = 0; k < 4; ++k) { const int pos = __hip_atomic_fetch_add(&cnt[te[k]], 1, __ATOMIC_RELAXED, __HIP_MEMORY_SCOPE_WORKGROUP);
                WSP(int, WS_TOKE)[(size_t)r * 4 + k] = te[k]; WSP(float, WS_TOKG)[(size_t)r * 4 + k] = ex[k] * ri; WSP(int, WS_TOKP)[(size_t)r * 4 + k] = pos; } }
        LDS_WAIT();
        { const float* sh = mod_vec(C, layer, mrow, 3); const float* scl = mod_vec(C, layer, mrow, 4);
          f32x4 gm[4], sv[4];
#pragma unroll
          for (int j = 0; j < 4; ++j) { const int col = ((j & 2) ? 512 : 0) + 8 * C.lane + 4 * (j & 1); gm[j] = *(const f32x4*)(gn + col) * (*(const f32x4*)(scl + col) + 1.0f); sv[j] = *(const f32x4*)(sh + col); }
#pragma unroll 1
          for (int rr = 0; rr < 16; rr += 2) { v4u xw[2][2];
#pragma unroll
              for (int u2 = 0; u2 < 2; ++u2) { const bf16* xr = WSP(const bf16, WS_XRES) + (size_t)(row0 + rr + u2) * D; xw[u2][0] = *(const v4u*)(xr + 8 * C.lane); xw[u2][1] = *(const v4u*)(xr + 512 + 8 * C.lane); }
#pragma unroll
              for (int u2 = 0; u2 < 2; ++u2) { const float ri = __shfl(rinv, rr + u2); f32x4 f[4];
                  f[0] = (f32x4){bflo(xw[u2][0].x), bfhi(xw[u2][0].x), bflo(xw[u2][0].y), bfhi(xw[u2][0].y)} * ri * gm[0] + sv[0]; f[1] = (f32x4){bflo(xw[u2][0].z), bfhi(xw[u2][0].z), bflo(xw[u2][0].w), bfhi(xw[u2][0].w)} * ri * gm[1] + sv[1];
                  f[2] = (f32x4){bflo(xw[u2][1].x), bfhi(xw[u2][1].x), bflo(xw[u2][1].y), bfhi(xw[u2][1].y)} * ri * gm[2] + sv[2]; f[3] = (f32x4){bflo(xw[u2][1].z), bfhi(xw[u2][1].z), bflo(xw[u2][1].w), bfhi(xw[u2][1].w)} * ri * gm[3] + sv[3];
                  bf16* fr_ = WSP(bf16, WS_F) + (size_t)(row0 + rr + u2) * D;
                  *(v4u*)(fr_ + 8 * C.lane) = (v4u){pk2(f[0].x, f[0].y), pk2(f[0].z, f[0].w), pk2(f[1].x, f[1].y), pk2(f[1].z, f[1].w)};
                  *(v4u*)(fr_ + 512 + 8 * C.lane) = (v4u){pk2(f[2].x, f[2].y), pk2(f[2].z, f[2].w), pk2(f[3].x, f[3].y), pk2(f[3].z, f[3].w)}; } } }
    }
    LAS float* ssqp = (LAS float*)(cnt + 32); LAS float* rinvs = ssqp + 128;
    for (int t = t1w; t < t1; ++t) {
        const int row0 = 16 * t, mrow = mod_row(row0);
        { const bf16* xa = WSP(const bf16, WS_XRES) + (size_t)(row0 + l15) * D + 8 * q + 128 * C.wave;
          const bf16* wb = (const bf16*)(WSP(const float, WS_RWP) + ((size_t)(layer * 9 + mrow) * NE + l15) * D) + 8 * q + 128 * C.wave;
          f32x4 acc0 = {0.f, 0.f, 0.f, 0.f}, acc1 = {0.f, 0.f, 0.f, 0.f}; float ssq = 0.f;
#pragma unroll
          for (int kk = 0; kk < 4; ++kk) { const v4u aw = *(const v4u*)(xa + 32 * kk); const bf16x8 av = __builtin_bit_cast(bf16x8, aw);
              const bf16x8 h0 = *(const bf16x8*)(wb + 32 * kk), l0 = *(const bf16x8*)(wb + D + 32 * kk), h1 = *(const bf16x8*)(wb + (size_t)32 * D + 32 * kk), l1 = *(const bf16x8*)(wb + (size_t)33 * D + 32 * kk);
              ssq += ((bflo(aw.x) * bflo(aw.x) + bfhi(aw.x) * bfhi(aw.x)) + (bflo(aw.y) * bflo(aw.y) + bfhi(aw.y) * bfhi(aw.y))) + ((bflo(aw.z) * bflo(aw.z) + bfhi(aw.z) * bfhi(aw.z)) + (bflo(aw.w) * bflo(aw.w) + bfhi(aw.w) * bfhi(aw.w)));
              acc0 = __builtin_amdgcn_mfma_f32_16x16x32_bf16(av, h0, acc0, 0, 0, 0); acc1 = __builtin_amdgcn_mfma_f32_16x16x32_bf16(av, h1, acc1, 0, 0, 0);
              acc0 = __builtin_amdgcn_mfma_f32_16x16x32_bf16(av, l0, acc0, 0, 0, 0); acc1 = __builtin_amdgcn_mfma_f32_16x16x32_bf16(av, l1, acc1, 0, 0, 0); }
          ssq += __shfl_xor(ssq, 16); ssq += __shfl_xor(ssq, 32);
          if (q == 0) ssqp[C.wave * 16 + l15] = ssq;
#pragma unroll
          for (int r = 0; r < 4; ++r) { lg_w[(4 * q + r) * 33 + l15] = acc0[r]; lg_w[(4 * q + r) * 33 + 16 + l15] = acc1[r]; } }
        __syncthreads();
        if (C.wave == 0) {
            float s = 0.f;
#pragma unroll
            for (int w = 0; w < 8; ++w) s += ssqp[w * 16 + l15];
            const float rinv = __builtin_amdgcn_rsqf(s * (1.f / D) + NORM_EPS);
            if (q == 0) rinvs[l15] = rinv;
            const float* rb = WSP(const float, WS_RBP) + (size_t)(layer * 9 + mrow) * NE;
            const float bb0 = rb[l15], bb1 = rb[16 + l15];
            float a0[4], a1[4];
#pragma unroll
            for (int r = 0; r < 4; ++r) { a0[r] = 0.f; a1[r] = 0.f;
#pragma unroll
                for (int w = 0; w < 8; ++w) { a0[r] += lgt[w * 16 * 33 + (4 * q + r) * 33 + l15]; a1[r] += lgt[w * 16 * 33 + (4 * q + r) * 33 + 16 + l15]; } }
#pragma unroll
            for (int r = 0; r < 4; ++r) { const float ri = __shfl(rinv, 4 * q + r); lgt[(4 * q + r) * 33 + l15] = a0[r] * ri + bb0; lgt[(4 * q + r) * 33 + 16 + l15] = a1[r] * ri + bb1; }
            LDS_WAIT();
            if (C.lane < 16) { const int r = row0 + C.lane; float lg[32];
#pragma unroll
                for (int e = 0; e < 32; ++e) lg[e] = lgt[C.lane * 33 + e];
                int te[4]; float tv[4];
#pragma unroll
                for (int k = 0; k < 4; ++k) { float best = -INFINITY; int bi = 0;
#pragma unroll
                    for (int e = 0; e < 32; ++e) if (lg[e] > best) { best = lg[e]; bi = e; }
#pragma unroll
                    for (int e = 0; e < 32; ++e) lg[e] = (e == bi) ? -INFINITY : lg[e];
                    te[k] = bi; tv[k] = best; }
                float ex[4], es = 0.f;
#pragma unroll
                for (int k = 0; k < 4; ++k) { ex[k] = fast_exp(tv[k] - tv[0]); es += ex[k]; }
                const float ri = 1.f / es;
#pragma unroll
                for (int k = 0; k < 4; ++k) { const int pos = __hip_atomic_fetch_add(&cnt[te[k]], 1, __ATOMIC_RELAXED, __HIP_MEMORY_SCOPE_WORKGROUP);
                    WSP(int, WS_TOKE)[(size_t)r * 4 + k] = te[k]; WSP(float, WS_TOKG)[(size_t)r * 4 + k] = ex[k] * ri; WSP(int, WS_TOKP)[(size_t)r * 4 + k] = pos; } }
        }
        __syncthreads();
        { const float* sh = mod_vec(C, layer, mrow, 3); const float* scl = mod_vec(C, layer, mrow, 4);
          v4u xw[2][2];
#pragma unroll
          for (int u2 = 0; u2 < 2; ++u2) { const bf16* xr = WSP(const bf16, WS_XRES) + (size_t)(row0 + 2 * C.wave + u2) * D; xw[u2][0] = *(const v4u*)(xr + 8 * C.lane); xw[u2][1] = *(const v4u*)(xr + 512 + 8 * C.lane); }
          f32x4 gm[4], sv[4];
#pragma unroll
          for (int j = 0; j < 4; ++j) { const int col = ((j & 2) ? 512 : 0) + 8 * C.lane + 4 * (j & 1); gm[j] = *(const f32x4*)(gn + col) * (*(const f32x4*)(scl + col) + 1.0f); sv[j] = *(const f32x4*)(sh + col); }
#pragma unroll
          for (int u2 = 0; u2 < 2; ++u2) { const float ri = rinvs[2 * C.wave + u2]; f32x4 f[4];
              f[0] = (f32x4){bflo(xw[u2][0].x), bfhi(xw[u2][0].x), bflo(xw[u2][0].y), bfhi(xw[u2][0].y)} * ri * gm[0] + sv[0]; f[1] = (f32x4){bflo(xw[u2][0].z), bfhi(xw[u2][0].z), bflo(xw[u2][0].w), bfhi(xw[u2][0].w)} * ri * gm[1] + sv[1];
              f[2] = (f32x4){bflo(xw[u2][1].x), bfhi(xw[u2][1].x), bflo(xw[u2][1].y), bfhi(xw[u2][1].y)} * ri * gm[2] + sv[2]; f[3] = (f32x4){bflo(xw[u2][1].z), bfhi(xw[u2][1].z), bflo(xw[u2][1].w), bfhi(xw[u2][1].w)} * ri * gm[3] + sv[3];
              bf16* fr_ = WSP(bf16, WS_F) + (size_t)(row0 + 2 * C.wave + u2) * D;
              *(v4u*)(fr_ + 8 * C.lane) = (v4u){pk2(f[0].x, f[0].y), pk2(f[0].z, f[0].w), pk2(f[1].x, f[1].y), pk2(f[1].z, f[1].w)};
              *(v4u*)(fr_ + 512 + 8 * C.lane) = (v4u){pk2(f[2].x, f[2].y), pk2(f[2].z, f[2].w), pk2(f[3].x, f[3].y), pk2(f[3].z, f[3].w)}; } }
        __syncthreads();
    }
    __syncthreads();
    if (C.tid < 32) WSP(int, WS_BCNT)[C.bid * 32 + C.tid] = cnt[C.tid];
}

DEVI void ph_slots(const Ctx& C, int layer, int ntok) {
    LAS int* tot = (LAS int*)C.lds; LAS int* myoff = tot + 32; LAS int* base = tot + 64; LAS int* part = tot + 96;
    {
      const int e = C.tid & 31, grp = C.tid >> 5; int t = 0, o = 0; const int* bc = WSP(const int, WS_BCNT) + e;
#pragma unroll 16
      for (int b2 = grp; b2 < C.G; b2 += 16) { const int c = bc[b2 * 32]; t += c; if (b2 < C.bid) o += c; }
      part[grp * 64 + e] = t; part[grp * 64 + 32 + e] = o; }
    __syncthreads();
    if (C.tid < 64) { int a = 0;
#pragma unroll
        for (int g = 0; g < 16; ++g) a += part[g * 64 + C.tid];
        if (C.tid < 32) tot[C.tid] = a; else myoff[C.tid - 32] = a; }
    __syncthreads();
    if (C.tid == 0) { int acc = 0;
        for (int e = 0; e < 32; ++e) { base[e] = acc; acc += ((tot[e] + 255) >> 8) << 8; }
        if (C.bid == 0) WSP(int, WS_TEXP)[0] = acc >> 8; }
    __syncthreads();
    int* rowmap = WSP(int, WS_ROWMAP);
    for (int e = C.bid; e < 32; e += C.G) { const int lo = base[e] + tot[e], ntl = (tot[e] + 255) >> 8, hi2 = base[e] + (ntl << 8);
        if (C.tid < ntl) WSP(int, WS_TEXP)[1 + (base[e] >> 8) + C.tid] = e;
        for (int i = 512 + C.tid; i < ntl; i += 512) WSP(int, WS_TEXP)[1 + (base[e] >> 8) + i] = e;
        for (int i = lo + C.tid; i < hi2; i += 512) rowmap[i] = 0; }
    const int nt = ntok / 16; const int r0 = 16 * (int)((long)C.bid * nt / C.G), r1 = 16 * (int)((long)(C.bid + 1) * nt / C.G);
    for (int i = r0 * 4 + C.tid; i < r1 * 4; i += 512) { const int e = WSP(const int, WS_TOKE)[i]; const int slot = base[e] + myoff[e] + WSP(const int, WS_TOKP)[i];
        WSP(int, WS_SLOT)[i] = slot; rowmap[slot] = i >> 2; }
}

DEVI void ph_attention(const Ctx& C, bool need_ctx, int layer) {
    const attn_body::bf16* QL = WSP(const attn_body::bf16, WS_QL); const attn_body::bf16* QC = WSP(const attn_body::bf16, WS_QC);
    const attn_body::bf16* KB = WSP(const attn_body::bf16, WS_K); const attn_body::bf16* VB = WSP(const attn_body::bf16, WS_V);
    attn_body::bf16* mix = WSP(attn_body::bf16, WS_MIX);
    constexpr int NQL = SEQ / 128, NQC = LC / 128, UL = NB * 6 * NQL, UC = NB * 6 * NQC;
    const float lam_init = 0.8f - 0.6f * fast_exp(-0.3f * (float)layer); float lam;
    { float p1 = 0.f, p2 = 0.f; if (C.lane < 32) { p1 = INP(15)[layer * 32 + C.lane] * INP(16)[layer * 32 + C.lane]; p2 = INP(17)[layer * 32 + C.lane] * INP(18)[layer * 32 + C.lane]; }
      lam = fast_exp(wave_sum(p1)) - fast_exp(wave_sum(p2)) + lam_init; }
    const float post = 1.f - lam_init; const float* subln = INP(19) + layer * 64;
    const int total = UL + (need_ctx ? UC : 0);
    const int conv_at = (layer + 1 < DEPTH) ? (int)(C.bid % 6) : -1; int ui = 0; bool conv_done = false;
    const int conv0_at = (layer == 0) ? (int)((C.bid + 3) % 6) : -1; bool conv0_done = false;
    for (int u = (C.bid + C.G / 2) % C.G; u < total; u += C.G, ++ui) {
        if (ui == conv_at) { __syncthreads(); convert_layer_weights(C, layer + 1, 2); __syncthreads(); conv_done = true; }
        if (ui == conv0_at) { __syncthreads(); convert_layer_weights(C, 0, 1); __syncthreads(); conv0_done = true; }
        const bool isc = u >= UL; int qb, bp;
        if (!isc && (C.G & 7) == 0 && NQL == 32 && C.G == 256) { const int w = u % C.G, rnd = u / C.G; bp = rnd * 8 + (w & 7); qb = w >> 3; }
        else { const int v = isc ? u - UL : u; const int nq = isc ? NQC : NQL; qb = v % nq; bp = v / nq; }
        const int p = bp % 6, b = bp / 6;
        const int slen = isc ? LC : SEQ; const attn_body::bf16* Qbase = isc ? QC : QL;
        const attn_body::bf16* Qa = Qbase + ((size_t)(b * 12 + 2 * p) * slen + qb * 128) * 64; const attn_body::bf16* Qb = Qa + (size_t)slen * 64;
        const attn_body::bf16* Kh = KB + ((size_t)(b * 6 + p) * NKEY + (isc ? SEQ : 0)) * 64; const attn_body::bf16* Vh = VB + ((size_t)(b * 6 + p) * NKEY + (isc ? SEQ : 0)) * 64;
        const size_t row0 = (size_t)(isc ? T_L + b * LC : b * SEQ) + qb * 128;
        attn_body::bf16 *Oa, *Ob; int opitch;
        if (p < 2) { Oa = mix + row0 * D + (2 * p) * 64; Ob = Oa + 64; opitch = D; }
        else { Oa = mix + row0 * D + 512 + (p - 2) * 64; Ob = Oa; opitch = D; }
        const int ntile = isc ? LC / 64 : NKEY / 64;
        if (p < 2) attn_body::attn_unit<8, 0>(Qa, Qb, Kh, Vh, Oa, Ob, opitch, ntile, (char*)C.lds, lam, post, subln);
        else if (C.wave < 4) attn_body::attn_unit<8, 1>(Qa, Qb, Kh, Vh, Oa, Ob, opitch, ntile, (char*)C.lds, lam, post, subln);
        else attn_body::attn_unit<8, 2>(Qa, Qb, Kh, Vh, Oa, Ob, opitch, ntile, (char*)C.lds, lam, post, subln);
    }
    if (conv_at >= 0 && !conv_done) { __syncthreads(); convert_layer_weights(C, layer + 1, 2); __syncthreads(); }
    if (conv0_at >= 0 && !conv0_done) { __syncthreads(); convert_layer_weights(C, 0, 1); __syncthreads(); }
}

DEVI void ph_outproj_ctx(const Ctx& C, int layer) {
    const int l15 = C.lane & 15, q = C.lane >> 4, ks = C.wave & 3, ch = C.wave >> 2;
    const float* g = mod_vec(C, layer, 8, 2);
    LAS float* P = (LAS float*)C.lds; constexpr int PP = 132;
    for (int tile = C.bid; tile < (NB * LC / 64) * (D / 128); tile += C.G) {
        const int r0 = (tile >> 3) * 64, c0 = (tile & 7) * 128;
        const bf16* a = WSP(const bf16, WS_MIX) + (size_t)(T_L + r0 + l15) * D + 256 * ks + 8 * q;
        const bf16* b = WSP(const bf16, WS_WOUT) + (size_t)layer * D * D + (size_t)(c0 + 64 * ch + l15) * D + 256 * ks + 8 * q;
        f32x4 acc[4][4];
#pragma unroll
        for (int m = 0; m < 4; ++m)
#pragma unroll
            for (int n = 0; n < 4; ++n) acc[m][n] = (f32x4){0.f, 0.f, 0.f, 0.f};
#pragma unroll 4
        for (int kk = 0; kk < 8; ++kk) { bf16x8 av[4], bv[4];
#pragma unroll
            for (int m = 0; m < 4; ++m) av[m] = *(const bf16x8*)(a + (size_t)16 * m * D + 32 * kk);
#pragma unroll
            for (int n = 0; n < 4; ++n) bv[n] = *(const bf16x8*)(b + (size_t)16 * n * D + 32 * kk);
#pragma unroll
            for (int m = 0; m < 4; ++m)
#pragma unroll
                for (int n = 0; n < 4; ++n) acc[m][n] = __builtin_amdgcn_mfma_f32_16x16x32_bf16(bv[n], av[m], acc[m][n], 0, 0, 0); }
#pragma unroll
        for (int m = 0; m < 4; ++m)
#pragma unroll
            for (int n = 0; n < 4; ++n) *(LAS f32x4*)(P + (size_t)(ks * 64 + 16 * m + l15) * PP + 64 * ch + 16 * n + 4 * q) = acc[m][n];
        __syncthreads();
        { const int row = C.tid >> 3, cg = (C.tid & 7) * 16; f32x4 s[4];
#pragma unroll
          for (int i = 0; i < 4; ++i) { const LAS float* pp = P + (size_t)row * PP + cg + 4 * i;
              s[i] = (*(const LAS f32x4*)pp + *(const LAS f32x4*)(pp + 64 * PP)) + (*(const LAS f32x4*)(pp + 128 * PP) + *(const LAS f32x4*)(pp + 192 * PP)); }
          const size_t ro = (size_t)(r0 + row) * D + c0 + cg; bf16* xo = WSP(bf16, WS_XRES) + (size_t)T_L * D + ro;
          f32x4 xi[4];
          if (layer == 0) {
#pragma unroll
              for (int i = 0; i < 4; ++i) xi[i] = *(const f32x4*)(INP(2) + ro + 4 * i); }
          else { const v4u w0 = *(const v4u*)xo, w1 = *(const v4u*)(xo + 8);
              xi[0] = (f32x4){bflo(w0.x), bfhi(w0.x), bflo(w0.y), bfhi(w0.y)}; xi[1] = (f32x4){bflo(w0.z), bfhi(w0.z), bflo(w0.w), bfhi(w0.w)};
              xi[2] = (f32x4){bflo(w1.x), bfhi(w1.x), bflo(w1.y), bfhi(w1.y)}; xi[3] = (f32x4){bflo(w1.z), bfhi(w1.z), bflo(w1.w), bfhi(w1.w)}; }
          f32x4 v[4];
#pragma unroll
          for (int i = 0; i < 4; ++i) v[i] = xi[i] + *(const f32x4*)(g + c0 + cg + 4 * i) * s[i];
          *(v4u*)xo = (v4u){pk2(v[0].x, v[0].y), pk2(v[0].z, v[0].w), pk2(v[1].x, v[1].y), pk2(v[1].z, v[1].w)};
          *(v4u*)(xo + 8) = (v4u){pk2(v[2].x, v[2].y), pk2(v[2].z, v[2].w), pk2(v[3].x, v[3].y), pk2(v[3].z, v[3].w)}; }
        __syncthreads();
    }
}

constexpr int PH_PER_LAYER = 10, N_PHASES = 2 + DEPTH * PH_PER_LAYER;
struct Args { const float* in[31]; float* out; unsigned char* ws; int ph_lo, ph_hi; };
template <int MASK> __global__ void __launch_bounds__(512, 2) mk_fwd(Args args) {
    extern __shared__ __attribute__((aligned(16))) unsigned char lds_raw[];
    { LAS unsigned long long* pt = (LAS unsigned long long*)((LAS unsigned char*)lds_raw + PTR_OFF);
      if (threadIdx.x == 0) {
#pragma unroll
          for (int i = 0; i < 31; ++i) pt[i] = (unsigned long long)args.in[i]; } }
    volatile LAS unsigned* MISC = (volatile LAS unsigned*)((LAS unsigned char*)lds_raw + MISC_OFF);
    if (threadIdx.x < 32) MISC[threadIdx.x] = 0u;
    __syncthreads();
#define CTX() Ctx C; { int t_ = threadIdx.x; LAUNDER_V(t_); C.tid = t_; C.lane = t_ & 63; C.wave = __builtin_amdgcn_readfirstlane(t_ >> 6); int b_ = blockIdx.x; LAUNDER_S(b_); C.bid = b_; \
    int g_ = gridDim.x; LAUNDER_S(g_); C.G = g_; unsigned long long w_ = (unsigned long long)args.ws; LAUNDER_S(w_); C.wsi = w_; C.out = (float*)(GAS float*)(unsigned long long)args.out; C.lds = (LAS unsigned char*)lds_raw; }
    const int lo = args.ph_lo, hi = args.ph_hi;
#if MK_N_LAUNCHES == 1
    XcdBarrier bar = xcd_barrier_post((unsigned*)(args.ws + WS_CTL) + CW_BAR, MISC + 8);
#define GRID_BAR() xcd_barrier(bar)
#else
#define GRID_BAR() do {} while (0)
#endif
#define PHON(b) (((MASK) >> (b)) & 1)
#ifndef REP_MASK
#define REP_MASK 0
#endif
#define REP(b) for (int rp_ = 0; rp_ < 1 + (((REP_MASK) >> (b)) & 1); ++rp_)
#define REPX(b, cond) for (int rp_ = 0; rp_ < 1 + ((((REP_MASK) >> (b)) & 1) && (cond)); ++rp_)
#define IN(k) (lo <= (k) && (k) < hi)
#define SEAM(k) do { if (IN(k) && IN((k) + 1)) { GRID_BAR(); if (((REP_MASK) >> 17) & 1) GRID_BAR(); } } while (0)
    if (PHON(0) && IN(0)) REP(0) { CTX(); p0_prologue(C); } SEAM(0);
#define LAYER_BODY(layer) { \
        const int p0 = 1 + layer * PH_PER_LAYER; const bool need_ctx = layer < DEPTH - 1; const int ntok = need_ctx ? T_ALL : T_L; \
        if (PHON(1) && IN(p0 + 0)) REPX(15, layer == 0) { CTX(); ph_norm_mix(C, layer); } SEAM(p0 + 0); \
        if (PHON(2) && IN(p0 + 1)) REP(2) { CTX(); pg8::Gemm g{WSP(const pg8::bf16_t, WS_H), WSP(const pg8::bf16_t, WS_WIN) + (size_t)layer * N_PROJ * D, T_ALL, N_PROJ, D}; \
            pg8::StaticOrder S; S.init(T_ALL, N_PROJ, C.G, C.bid); pg8::EpiBf16<0> E{WSP(pg8::bf16_t, WS_PROJ), N_PROJ, nullptr, 0, 0, 1.f}; \
            pg8::gemm_phase<pg8::EpiBf16<0>, pg8::StaticOrder, true, true>(C.lds, g, S, E); } SEAM(p0 + 1); \
        if (IN(p0 + 2)) { if (PHON(3)) REP(3) { CTX(); ph_attn_prep(C, layer); } if (PHON(5)) REP(5) { CTX(); ph_dn_chunk(C, layer); } } SEAM(p0 + 2); \
        if (IN(p0 + 3)) { if (PHON(6)) REP(6) { CTX(); ph_dn_scan(C, layer); } __syncthreads(); if (PHON(4)) REP(4) { CTX(); ph_gmlp(C, layer, ntok); } __syncthreads(); if (PHON(7)) REP(7) { CTX(); ph_attention(C, need_ctx, layer); } } SEAM(p0 + 3); \
        if (PHON(8) && IN(p0 + 4)) REP(8) { CTX(); ph_finalize(C, layer, ntok); } SEAM(p0 + 4); \
        if (PHON(9) && IN(p0 + 5)) REPX(14, layer == 0) { CTX(); pg8::Gemm g{WSP(const pg8::bf16_t, WS_MIX), WSP(const pg8::bf16_t, WS_WOUT) + (size_t)layer * D * D, T_L, D, D}; \
            pg8::StaticOrder S; S.init(T_L, D, C.G, C.bid); \
            if (layer == 0) { pg8::EpiOutRes<true> E{INP(0), INP(2), WSP(pg8::bf16_t, WS_XRES), WSP(const float, WS_MOD) + (size_t)layer * 9 * 6 * D}; \
                pg8::gemm_phase<pg8::EpiOutRes<true>, pg8::StaticOrder, true, true>(C.lds, g, S, E); } \
            else { pg8::EpiOutRes<false> E{WSP(const pg8::bf16_t, WS_XRES), WSP(const pg8::bf16_t, WS_XRES) + (size_t)T_L * D, WSP(pg8::bf16_t, WS_XRES), WSP(const float, WS_MOD) + (size_t)layer * 9 * 6 * D}; \
                pg8::gemm_phase<pg8::EpiOutRes<false>, pg8::StaticOrder, true, true>(C.lds, g, S, E); } \
            if (need_ctx) ph_outproj_ctx(C, layer); } SEAM(p0 + 5); \
        if (PHON(10) && IN(p0 + 6)) REP(10) { CTX(); ph_router(C, layer, ntok); } SEAM(p0 + 6); \
        if (PHON(11) && IN(p0 + 7)) REP(11) { CTX(); ph_slots(C, layer, ntok); } SEAM(p0 + 7); \
        if (PHON(12) && IN(p0 + 8)) REP(12) { CTX(); pg8::Gemm g{WSP(const pg8::bf16_t, WS_F), WSP(const pg8::bf16_t, WS_WUP) + (size_t)layer * NE * 2 * DE * D, P_ROWS, NE * 2 * DE, D, WSP(const int, WS_ROWMAP)}; \
            pg8::MoeOrder S; S.init(WSP(const int, WS_TEXP), 8, C.G, C.bid); pg8::EpiSwiglu E{WSP(pg8::bf16_t, WS_HID), INP(27) + (size_t)layer * NE * 2 * DE}; \
            pg8::gemm_phase<pg8::EpiSwiglu, pg8::MoeOrder, true, true, true>(C.lds, g, S, E); } SEAM(p0 + 8); \
        if (PHON(13) && IN(p0 + 9)) REP(13) { CTX(); pg8::Gemm g{WSP(const pg8::bf16_t, WS_HID), WSP(const pg8::bf16_t, WS_WDN) + (size_t)layer * NE * D * DE, P_ROWS, NE * D, DE}; \
            pg8::MoeOrder S; S.init(WSP(const int, WS_TEXP), 4, C.G, C.bid); pg8::EpiDown E{WSP(unsigned char, WS_YS), INP(29) + (size_t)layer * NE * D}; \
            pg8::gemm_phase<pg8::EpiDown, pg8::MoeOrder, true, true>(C.lds, g, S, E); } SEAM(p0 + 9); \
    }
    static_assert(DEPTH <= 4, "layer sites");
    if constexpr (DEPTH > 0) LAYER_BODY(0)
    if constexpr (DEPTH > 1) LAYER_BODY(1)
    if constexpr (DEPTH > 2) LAYER_BODY(2)
    if constexpr (DEPTH > 3) LAYER_BODY(3)
#undef LAYER_BODY
    if (PHON(1) && IN(N_PHASES - 1)) REP(16) { CTX(); ph_norm_mix(C, DEPTH); }
#undef IN
#undef SEAM
}

#ifndef EMU
#ifndef FULL_MASK_V
#define FULL_MASK_V 0x3fff
#endif
constexpr int FULL_MASK = FULL_MASK_V;
typedef void (*kern_t)(Args);
static int phase_mask(int p) {
    if (p == 0) return 1; if (p == N_PHASES - 1) return 2;
    const int k = (p - 1) % PH_PER_LAYER; const int m[10] = {2, 4, 8 | 32, 16 | 64 | 128, 256, 512, 1024, 2048, 4096, 8192}; return m[k];
}
static kern_t kern_of_mask(int m) {
    switch (m) {
#if MK_N_LAUNCHES == 1
        case FULL_MASK: return mk_fwd<FULL_MASK>;
#else
        case 1: return mk_fwd<1>; case 2: return mk_fwd<2>; case 4: return mk_fwd<4>; case 8: return mk_fwd<8>; case 16: return mk_fwd<16>; case 32: return mk_fwd<32>; case 192: return mk_fwd<192>; case 256: return mk_fwd<256>;
        case 512: return mk_fwd<512>; case 1024: return mk_fwd<1024>; case 2048: return mk_fwd<2048>; case 4096: return mk_fwd<4096>; case 8192: return mk_fwd<8192>;
#endif
        default: return nullptr;
    }
}
extern "C" void kernel_launch(void* const* d_in, const int* in_sizes, int n_in, void* d_out, int out_size, void* d_ws, size_t ws_size, hipStream_t stream) {
    static int grid = 0;
    if (grid == 0) {
        if (n_in != 31 || in_sizes[0] != T_L * D || out_size != T_L * D || ws_size < WS_END) { fprintf(stderr, "kernel_launch: shape/workspace mismatch (n_in %d, in0 %d, out %d, ws %zu, need %zu)\n", n_in, n_in > 0 ? in_sizes[0] : -1, out_size, ws_size, (size_t)WS_END); grid = -1; return; }
        int dev = 0, cus = 0;
        if (hipGetDevice(&dev) != hipSuccess || hipDeviceGetAttribute(&cus, hipDeviceAttributeMultiprocessorCount, dev) != hipSuccess) { grid = -1; return; }
#if MK_N_LAUNCHES == 1
        const int masks[1] = {FULL_MASK}; const int nm = 1;
#else
        const int masks[13] = {1, 2, 4, 8, 16, 32, 192, 256, 512, 1024, 2048, 4096, 8192}; const int nm = 13;
#endif
        for (int i = 0; i < nm; ++i) {
            if (hipFuncSetAttribute((const void*)kern_of_mask(masks[i]), hipFuncAttributeMaxDynamicSharedMemorySize, LDS_BYTES) != hipSuccess) { fprintf(stderr, "kernel_launch: hipFuncSetAttribute failed\n"); grid = -1; return; }
            int per_cu = 0;
            if (hipOccupancyMaxActiveBlocksPerMultiprocessor(&per_cu, (const void*)kern_of_mask(masks[i]), 512, LDS_BYTES) != hipSuccess || per_cu < 1) fprintf(stderr, "kernel_launch: occupancy query reports %d for mask %d\n", per_cu, masks[i]);
        }
        (void)hipGetLastError();
        grid = cus;
        if (grid > 1024) grid = 1024;
    }
    if (grid < 0) return;
    if (hipMemsetAsync((char*)d_ws + WS_CTL, 0, (CW_BAR + XCD_BAR_WORDS) * sizeof(unsigned), stream) != hipSuccess) return;
    Args a{};
    for (int i = 0; i < 31; ++i) a.in[i] = (const float*)d_in[i];
    a.out = (float*)d_out; a.ws = (unsigned char*)d_ws;
#if MK_N_LAUNCHES == 1
    a.ph_lo = 0; a.ph_hi = N_PHASES;
    hipLaunchKernelGGL(mk_fwd<FULL_MASK>, dim3(grid), dim3(512), LDS_BYTES, stream, a);
#else
    for (int p = 0; p < N_PHASES; ++p) { a.ph_lo = p; a.ph_hi = p + 1; const int pm = phase_mask(p);
        for (int bit = 0; bit < 14; ++bit) { int m = pm & (1 << bit); if (!m) continue; if (m == 64 || m == 128) { if (m == 128) continue; m = 192; } hipLaunchKernelGGL(kern_of_mask(m), dim3(grid), dim3(512), LDS_BYTES, stream, a); } }
#endif
}
#endif
```
